# Optimizing an MI355X kernel written in HIP

```python
import jax, jax.numpy as jnp
from jax import lax
import numpy as np

D_MODEL = 1024
BATCH = 4
SEQ = 4096
DEPTH = 1

D_MIX = D_MODEL
POOL_WIDTH = D_MIX // 2
POOL_WINDOWS = (2, 4, 8, 16)
POOL_GROUPS = len(POOL_WINDOWS)
POOL_GROUP_DIM = POOL_WIDTH // POOL_GROUPS
GLA_WIDTH = D_MIX - POOL_WIDTH
GLA_HEADS = 4
GLA_DK_TOTAL = GLA_WIDTH // 2
GLA_DK = GLA_DK_TOTAL // GLA_HEADS
GLA_DV = GLA_WIDTH // GLA_HEADS
GLA_GATE_RANK = 16
GLA_GATE_NORMALIZER = 16.0
GLA_CHUNK = 16
IN_SIZES = (POOL_WIDTH, GLA_DK_TOTAL, GLA_DK_TOTAL, GLA_WIDTH, GLA_WIDTH, GLA_GATE_RANK)
D_IN = sum(IN_SIZES)
N_EXPERTS = 256
TOP_K = 8
N_GROUPS = 8
TOPK_GROUPS = 4
EXPERT_DIM = D_MODEL // 4
SHARED_DIM = EXPERT_DIM
ROUTED_SCALE = 2.5
MOE_BLOCK = 128
DEEPNORM_ALPHA = (2.0 * DEPTH) ** 0.25
DEEPNORM_BETA = (8.0 * DEPTH) ** -0.25
LN_EPS = 1e-5
RMS_EPS = 1e-5

kernel_name = 'hybrid_pool_gla_moe_deepnorm'

F32 = jnp.float32


def _layernorm(x, g, b):
    xf = x.astype(F32)
    mu = jnp.mean(xf, axis=-1, keepdims=True)
    var = jnp.mean(jnp.square(xf - mu), axis=-1, keepdims=True)
    return ((xf - mu) * lax.rsqrt(var + LN_EPS) * g.astype(F32) + b.astype(F32)).astype(x.dtype)


def _pool_mixer(p, pool_w_group, pool_scale):
    B, S, _ = p.shape
    pf = p.astype(F32).reshape(B, S, POOL_GROUPS, POOL_GROUP_DIM)
    c0 = jnp.concatenate([jnp.zeros((B, 1, POOL_GROUPS, POOL_GROUP_DIM), F32), jnp.cumsum(pf, axis=1)], axis=1)
    t = jnp.arange(S)
    means = []
    for g, w in enumerate(POOL_WINDOWS):
        cg = c0[:, :, g]
        lower = jnp.concatenate([jnp.zeros((B, w - 1, POOL_GROUP_DIM), F32), cg[:, :S + 1 - w]], axis=1)
        cnt = jnp.minimum(t + 1, w).astype(F32)
        means.append((cg[:, 1:] - lower) / cnt[None, :, None])
    mixed = jnp.stack(means, axis=2) - pf
    out = jnp.einsum('bsgc,gcd->bsgd', mixed, pool_w_group.astype(F32))
    out = out * pool_scale.astype(F32).reshape(POOL_GROUPS, POOL_GROUP_DIM)
    return out.reshape(B, S, POOL_WIDTH)


def _gla_mixer(q, k, v, r, g_low, gate_w2, gate_b, norm_w):
    B, S, _ = q.shape
    H, C = GLA_HEADS, GLA_CHUNK
    N = S // C
    q = q.astype(F32).reshape(B, N, C, H, GLA_DK) * (GLA_DK ** -0.5)
    k = k.astype(F32).reshape(B, N, C, H, GLA_DK)
    v = v.astype(F32).reshape(B, N, C, H, GLA_DV)
    gk = jax.nn.log_sigmoid(g_low.astype(F32) @ gate_w2.astype(F32) + gate_b.astype(F32)) / GLA_GATE_NORMALIZER
    b = jnp.cumsum(gk.reshape(B, N, C, H, GLA_DK), axis=2)
    causal = jnp.tril(jnp.ones((C, C), dtype=bool))
    diff = b[:, :, :, None] - b[:, :, None, :]
    decay = jnp.exp(jnp.where(causal[None, None, :, :, None, None], diff, -jnp.inf))
    scores = jnp.einsum('bnihd,bnjhd,bnijhd->bnhij', q, k, decay)
    o_intra = jnp.einsum('bnhij,bnjhe->bnihe', scores, v)
    b_last = b[:, :, -1]
    q_dec = q * jnp.exp(b)
    k_dec = k * jnp.exp(b_last[:, :, None] - b)
    kv = jnp.einsum('bnjhd,bnjhe->bnhde', k_dec, v)
    chunk_decay = jnp.exp(b_last)

    def step(state, inp):
        q_c, kv_c, dec_c = inp
        o = jnp.einsum('bihd,bhde->bihe', q_c, state)
        return state * dec_c[..., None] + kv_c, o

    state0 = jnp.zeros((B, H, GLA_DK, GLA_DV), F32)
    _, o_inter = lax.scan(step, state0, (jnp.moveaxis(q_dec, 1, 0), jnp.moveaxis(kv, 1, 0), jnp.moveaxis(chunk_decay, 1, 0)))
    o = (o_intra + jnp.moveaxis(o_inter, 0, 1)).reshape(B, S, H, GLA_DV)
    o = o * lax.rsqrt(jnp.mean(jnp.square(o), axis=-1, keepdims=True) + RMS_EPS) * norm_w.astype(F32)
    return o.reshape(B, S, GLA_WIDTH) * jax.nn.silu(r.astype(F32))


def _swiglu(x, wg, wu, wd):
    return (jax.nn.silu(x @ wg) * (x @ wu)) @ wd


def _route(h_flat, router_w, router_bias):
    T = h_flat.shape[0]
    scores = jax.nn.sigmoid(h_flat.astype(F32) @ router_w.astype(F32))
    biased = scores + router_bias.astype(F32)
    grp = biased.reshape(T, N_GROUPS, N_EXPERTS // N_GROUPS)
    grp_score = jnp.sum(lax.top_k(grp, 2)[0], axis=-1)
    _, top_grp = lax.top_k(grp_score, TOPK_GROUPS)
    grp_mask = jnp.sum(jax.nn.one_hot(top_grp, N_GROUPS, dtype=F32), axis=1) > 0
    expert_mask = jnp.repeat(grp_mask, N_EXPERTS // N_GROUPS, axis=1)
    _, idx = lax.top_k(jnp.where(expert_mask, biased, -jnp.inf), TOP_K)
    w = jnp.take_along_axis(scores, idx, axis=1)
    w = w / jnp.sum(w, axis=-1, keepdims=True) * ROUTED_SCALE
    return idx.astype(jnp.int32), w


def _routed_experts(h_flat, idx, w, wg, wu, wd):
    T, D = h_flat.shape
    A = T * TOP_K
    flat_e = idx.reshape(A)
    flat_tok = jnp.arange(A, dtype=jnp.int32) // TOP_K
    flat_w = w.reshape(A)
    order = jnp.argsort(flat_e)
    se, st, sw = flat_e[order], flat_tok[order], flat_w[order]
    counts = jnp.zeros((N_EXPERTS,), jnp.int32).at[flat_e].add(1)
    padded = (counts + MOE_BLOCK - 1) // MOE_BLOCK * MOE_BLOCK
    group_start = jnp.cumsum(counts) - counts
    padded_end = jnp.cumsum(padded)
    padded_start = padded_end - padded
    pos = padded_start[se] + jnp.arange(A, dtype=jnp.int32) - group_start[se]
    n_blocks = (A + N_EXPERTS * (MOE_BLOCK - 1)) // MOE_BLOCK
    P = n_blocks * MOE_BLOCK
    row_tok = jnp.full((P,), T, jnp.int32).at[pos].set(st)
    row_w = jnp.zeros((P,), F32).at[pos].set(sw)
    block_rows = jnp.arange(n_blocks, dtype=jnp.int32) * MOE_BLOCK
    block_e = jnp.minimum(jnp.searchsorted(padded_end, block_rows, side='right'), N_EXPERTS - 1).astype(jnp.int32)
    h_pad = jnp.concatenate([h_flat, jnp.zeros((1, D), h_flat.dtype)], axis=0)

    def block_fn(args):
        tok, e = args
        return _swiglu(h_pad[tok], wg[e], wu[e], wd[e])

    out = lax.map(block_fn, (row_tok.reshape(n_blocks, MOE_BLOCK), block_e))
    out = out.reshape(P, D).astype(F32) * row_w[:, None]
    return jax.ops.segment_sum(out, row_tok, num_segments=T + 1)[:T].astype(h_flat.dtype)


def setup_inputs(seed: int = 0) -> dict:
    key = jax.random.key(seed)
    ks = jax.random.split(key, 20)

    def nrm(k, shape, scale):
        return jax.random.normal(k, shape, F32) * scale

    beta = DEEPNORM_BETA
    col_scale = jnp.concatenate([
        jnp.full((POOL_WIDTH,), beta, F32), jnp.ones((2 * GLA_DK_TOTAL,), F32),
        jnp.full((GLA_WIDTH,), beta, F32), jnp.ones((GLA_WIDTH + GLA_GATE_RANK,), F32)])
    return {
        'x': nrm(ks[0], (BATCH, SEQ, D_MODEL), 1.0),
        'w_in': nrm(ks[1], (DEPTH, D_MODEL, D_IN), D_MODEL ** -0.5) * col_scale,
        'gla_gate_w2': nrm(ks[2], (DEPTH, GLA_GATE_RANK, GLA_DK_TOTAL), GLA_GATE_RANK ** -0.5),
        'gla_gate_b': nrm(ks[3], (DEPTH, GLA_DK_TOTAL), 0.1),
        'gla_norm_w': 1.0 + nrm(ks[4], (DEPTH, GLA_DV), 0.02),
        'pool_w_group': nrm(ks[5], (DEPTH, POOL_GROUPS, POOL_GROUP_DIM, POOL_GROUP_DIM), POOL_GROUP_DIM ** -0.5),
        'pool_scale': 1.0 + nrm(ks[6], (DEPTH, POOL_WIDTH), 0.1),
        'w_out': nrm(ks[7], (DEPTH, D_MIX, D_MODEL), D_MIX ** -0.5 * beta),
        'ln1_g': 1.0 + nrm(ks[8], (DEPTH, D_MODEL), 0.02),
        'ln1_b': nrm(ks[9], (DEPTH, D_MODEL), 0.02),
        'router_w': nrm(ks[10], (DEPTH, D_MODEL, N_EXPERTS), D_MODEL ** -0.5),
        'router_bias': nrm(ks[11], (DEPTH, N_EXPERTS), 0.01),
        'w_exp_gate': nrm(ks[12], (DEPTH, N_EXPERTS, D_MODEL, EXPERT_DIM), D_MODEL ** -0.5 * beta),
        'w_exp_up': nrm(ks[13], (DEPTH, N_EXPERTS, D_MODEL, EXPERT_DIM), D_MODEL ** -0.5 * beta),
        'w_exp_down': nrm(ks[14], (DEPTH, N_EXPERTS, EXPERT_DIM, D_MODEL), EXPERT_DIM ** -0.5 * beta),
        'w_sh_gate': nrm(ks[15], (DEPTH, D_MODEL, SHARED_DIM), D_MODEL ** -0.5 * beta),
        'w_sh_up': nrm(ks[16], (DEPTH, D_MODEL, SHARED_DIM), D_MODEL ** -0.5 * beta),
        'w_sh_down': nrm(ks[17], (DEPTH, SHARED_DIM, D_MODEL), SHARED_DIM ** -0.5 * beta),
        'ln2_g': 1.0 + nrm(ks[18], (DEPTH, D_MODEL), 0.02),
        'ln2_b': nrm(ks[19], (DEPTH, D_MODEL), 0.02),
    }


def reference(x, w_in, gla_gate_w2, gla_gate_b, gla_norm_w, pool_w_group, pool_scale, w_out, ln1_g, ln1_b,
              router_w, router_bias, w_exp_gate, w_exp_up, w_exp_down, w_sh_gate, w_sh_up, w_sh_down, ln2_g, ln2_b):
    B, S, D = x.shape
    offsets = np.cumsum(IN_SIZES)[:-1].tolist()
    h = x
    for l in range(DEPTH):
        proj = h @ w_in[l]
        p, q, k, v, r, g_low = jnp.split(proj, offsets, axis=-1)
        pool_out = _pool_mixer(p, pool_w_group[l], pool_scale[l])
        gla_out = _gla_mixer(q, k, v, r, g_low, gla_gate_w2[l], gla_gate_b[l], gla_norm_w[l])
        mixed = jnp.concatenate([pool_out, gla_out], axis=-1).astype(h.dtype) @ w_out[l]
        h = _layernorm(DEEPNORM_ALPHA * h + mixed, ln1_g[l], ln1_b[l])
        h_flat = h.reshape(B * S, D)
        idx, gate = _route(h_flat, router_w[l], router_bias[l])
        routed = _routed_experts(h_flat, idx, gate.astype(h.dtype), w_exp_gate[l], w_exp_up[l], w_exp_down[l])
        shared = _swiglu(h_flat, w_sh_gate[l], w_sh_up[l], w_sh_down[l])
        h = _layernorm(DEEPNORM_ALPHA * h + (routed + shared).reshape(B, S, D), ln2_g[l], ln2_b[l])
    return h
```

```cpp
#include <hip/hip_runtime.h>
#include <stdint.h>
#include <cstdio>

#define DI __device__ __forceinline__
typedef unsigned short bf16_t;

constexpr int T = 16384, D = 1024, SEQ = 4096;
constexpr int DIN = 2064, NPROJ = 2048;
constexpr int P_OFF = 0, Q_OFF = 512, K_OFF = 768, V_OFF = 1024, R_OFF = 1536, GL_OFF = 2048;
constexpr int SC = 64;
constexpr int NSC = SEQ / SC;
constexpr int NE = 256, TOPK = 8, EDIM = 256;
constexpr int A_TOT = T * TOPK;
constexpr int LCAP = T;
constexpr float ALPHA = 1.189207115002721f;
constexpr float LN_EPS = 1e-5f, RMS_EPS = 1e-5f;
constexpr int NT = 512;

constexpr size_t MiB = 1u << 20;
constexpr size_t OFF_CTL = 0;
constexpr size_t OFF_XB = 1 * MiB;
constexpr size_t OFF_GLOW = OFF_XB + 32 * MiB;
constexpr size_t OFF_PROJ = OFF_GLOW + 1 * MiB;
constexpr size_t OFF_G = OFF_PROJ + 64 * MiB;
constexpr size_t OFF_SLOC = OFF_G + 16 * MiB;
constexpr size_t OFF_DEC = OFF_SLOC + 32 * MiB;
constexpr size_t OFF_SIN = OFF_DEC + 1 * MiB;
constexpr size_t OFF_MIX = OFF_SIN + 32 * MiB;
constexpr size_t OFF_H32 = OFF_MIX + 32 * MiB;
constexpr size_t OFF_HB = OFF_H32 + 64 * MiB;
constexpr size_t OFF_SCORES = OFF_HB + 32 * MiB;
constexpr size_t OFF_WBUF = OFF_SCORES + 16 * MiB;
constexpr size_t OFF_LIST = OFF_WBUF + 1 * MiB;
constexpr size_t OFF_HID = OFF_LIST + 16 * MiB;
constexpr size_t OFF_Y = OFF_HID + 76 * MiB;
constexpr size_t WS_NEED = OFF_Y + 304 * MiB;
constexpr int CW_CNT = 1024;

struct Params {
    const float *x, *w_in, *gate_w2, *gate_b, *norm_w, *pool_w, *pool_scale, *w_out, *ln1_g, *ln1_b;
    const float *router_w, *router_bias, *wg, *wu, *wd, *sg, *su, *sd, *ln2_g, *ln2_b;
    float* out;
    unsigned char* ws;
};

DI float bf2f(bf16_t v) { return __uint_as_float(((unsigned)v) << 16); }
DI bf16_t f2bf(float f) { unsigned u = __float_as_uint(f); u += 0x7fffu + ((u >> 16) & 1u); return (bf16_t)(u >> 16); }
DI unsigned pk2(float lo, float hi) { return (unsigned)f2bf(lo) | ((unsigned)f2bf(hi) << 16); }
DI float wave_sum(float v) {
#pragma unroll
    for (int o = 1; o < 64; o <<= 1) v += __shfl_xor(v, o);
    return v;
}
DI float sigmoidf_(float v) { return 1.f / (1.f + __expf(-v)); }
DI float logsigmoidf_(float z) { return fminf(z, 0.f) - log1pf(__expf(-fabsf(z))); }

constexpr int GT_LDS_FLOATS = 16 * 132 + 2 * 16 * 68;
template <bool DUAL, class AF, class BF, class EPI>
DI void gemm_tile_valu(int K, const AF& af, const BF& bfn, const EPI& epi, float* lds) {
    float* As = lds; float* Bs = lds + 16 * 132; float* Bs2 = Bs + 16 * 68;
    const int tid = threadIdx.x, ty = tid >> 4, tx = tid & 15;
    float acc[4][4], acc2[4][4];
#pragma unroll
    for (int i = 0; i < 4; ++i)
#pragma unroll
        for (int j = 0; j < 4; ++j) { acc[i][j] = 0.f; acc2[i][j] = 0.f; }
    for (int k0 = 0; k0 < K; k0 += 16) {
#pragma unroll
        for (int i = 0; i < 4; ++i) { const int e = tid + 512 * i, r = e >> 4, kk = e & 15; As[kk * 132 + r] = af(r, k0 + kk); }
#pragma unroll
        for (int i = 0; i < 2; ++i) { const int e = tid + 512 * i, kk = e >> 6, c = e & 63; Bs[kk * 68 + c] = bfn(0, k0 + kk, c); if (DUAL) Bs2[kk * 68 + c] = bfn(1, k0 + kk, c); }
        __syncthreads();
#pragma unroll
        for (int kk = 0; kk < 16; ++kk) {
            const float4 a = *(const float4*)&As[kk * 132 + ty * 4];
            const float4 b = *(const float4*)&Bs[kk * 68 + tx * 4];
            const float av[4] = {a.x, a.y, a.z, a.w}, bv[4] = {b.x, b.y, b.z, b.w};
#pragma unroll
            for (int i = 0; i < 4; ++i)
#pragma unroll
                for (int j = 0; j < 4; ++j) acc[i][j] += av[i] * bv[j];
            if (DUAL) {
                const float4 b2 = *(const float4*)&Bs2[kk * 68 + tx * 4];
                const float b2v[4] = {b2.x, b2.y, b2.z, b2.w};
#pragma unroll
                for (int i = 0; i < 4; ++i)
#pragma unroll
                    for (int j = 0; j < 4; ++j) acc2[i][j] += av[i] * b2v[j];
            }
        }
        __syncthreads();
    }
#pragma unroll
    for (int i = 0; i < 4; ++i)
#pragma unroll
        for (int j = 0; j < 4; ++j) epi(ty * 4 + i, tx * 4 + j, acc[i][j], acc2[i][j]);
}

DI void phase_prep(const Params& p, int bid, int nblk, float* lds) {
    const int lane = threadIdx.x & 63, wave = threadIdx.x >> 6;
    bf16_t* xb = (bf16_t*)(p.ws + OFF_XB); float* glow = (float*)(p.ws + OFF_GLOW);
    for (int row = bid * 8 + wave; row < T; row += nblk * 8) {
        const float4* xr = (const float4*)(p.x + (size_t)row * D);
        float acc[16];
#pragma unroll
        for (int n = 0; n < 16; ++n) acc[n] = 0.f;
#pragma unroll
        for (int j = 0; j < 4; ++j) {
            const float4 v = xr[lane + 64 * j];
            uint2 o; o.x = pk2(v.x, v.y); o.y = pk2(v.z, v.w);
            ((uint2*)(xb + (size_t)row * D))[lane + 64 * j] = o;
            const float vv[4] = {v.x, v.y, v.z, v.w};
#pragma unroll
            for (int c = 0; c < 4; ++c) {
                const int col = 4 * (lane + 64 * j) + c;
                const float4* wr = (const float4*)(p.w_in + (size_t)col * DIN + GL_OFF);
#pragma unroll
                for (int q = 0; q < 4; ++q) { const float4 w = wr[q]; acc[4 * q] += vv[c] * w.x; acc[4 * q + 1] += vv[c] * w.y; acc[4 * q + 2] += vv[c] * w.z; acc[4 * q + 3] += vv[c] * w.w; }
            }
        }
        float mine = 0.f;
#pragma unroll
        for (int n = 0; n < 16; ++n) { const float s = wave_sum(acc[n]); if (lane == n) mine = s; }
        if (lane < 16) glow[(size_t)row * 16 + lane] = mine;
    }
}

DI void phase_proj(const Params& p, int bid, int nblk, float* lds) {
    const bf16_t* xb = (const bf16_t*)(p.ws + OFF_XB); bf16_t* proj = (bf16_t*)(p.ws + OFF_PROJ);
    for (int u = bid; u < 128 * 32; u += nblk) {
        const int mt = u >> 5, nt = u & 31;
        auto af = [&](int r, int k) { return bf2f(xb[(size_t)(mt * 128 + r) * D + k]); };
        auto bfn = [&](int, int k, int c) { return p.w_in[(size_t)k * DIN + nt * 64 + c]; };
        auto epi = [&](int r, int c, float v, float) { proj[(size_t)(mt * 128 + r) * NPROJ + nt * 64 + c] = f2bf(v); };
        gemm_tile_valu<false>(D, af, bfn, epi, lds);
    }
}

DI void phase_pool(const Params& p, int bid, int nblk, float* lds) {
    const bf16_t* proj = (const bf16_t*)(p.ws + OFF_PROJ); bf16_t* mix = (bf16_t*)(p.ws + OFF_MIX);
    for (int u = bid; u < 128 * 8; u += nblk) {
        const int mt = u >> 3, g = (u >> 1) & 3, nt = u & 1, w = 2 << g;
        auto af = [&](int r, int k) {
            const int t = mt * 128 + r, s = t & (SEQ - 1), cnt = min(s + 1, w);
            const bf16_t* pp = proj + (size_t)t * NPROJ + P_OFF + g * 128 + k;
            float sum = 0.f;
            for (int j = 0; j < cnt; ++j) sum += bf2f(pp[-(ptrdiff_t)j * NPROJ]);
            return sum / (float)cnt - bf2f(pp[0]);
        };
        auto bfn = [&](int, int k, int c) { return p.pool_w[(size_t)g * 16384 + k * 128 + nt * 64 + c]; };
        auto epi = [&](int r, int c, float v, float) { const int col = g * 128 + nt * 64 + c; mix[(size_t)(mt * 128 + r) * D + col] = f2bf(v * p.pool_scale[col]); };
        gemm_tile_valu<false>(128, af, bfn, epi, lds);
    }
}

constexpr int GLA1_LDS_FLOATS = 4096 * 2 + 8192;
DI void phase_gla1(const Params& p, int bid, int nblk, float* lds) {
    const int tid = threadIdx.x;
    const bf16_t* proj = (const bf16_t*)(p.ws + OFF_PROJ); const float* glow = (const float*)(p.ws + OFF_GLOW);
    float* Gbuf = (float*)(p.ws + OFF_G); float* Sloc = (float*)(p.ws + OFF_SLOC); float* dec = (float*)(p.ws + OFF_DEC);
    float* G = lds; float* Kh = lds + 4096; float* V = lds + 8192;
    for (int unit = bid; unit < 1024; unit += nblk) {
        const int bh = unit >> 6, n = unit & 63, b = bh >> 2, h = bh & 3, t0 = b * SEQ + n * SC;
        for (int e = tid; e < 4096; e += NT) {
            const int i = e >> 6, d = e & 63;
            float z = p.gate_b[h * 64 + d];
#pragma unroll
            for (int r = 0; r < 16; ++r) z += glow[(size_t)(t0 + i) * 16 + r] * p.gate_w2[r * 256 + h * 64 + d];
            G[e] = logsigmoidf_(z) * (1.f / 16.f);
        }
        __syncthreads();
        if (tid < 64) { float run = 0.f; for (int i = 0; i < 64; ++i) { run += G[i * 64 + tid]; G[i * 64 + tid] = run; } }
        __syncthreads();
        for (int e = tid; e < 4096; e += NT) {
            const int i = e >> 6, d = e & 63; const float g = G[e], gl = G[63 * 64 + d];
            Gbuf[(size_t)(t0 + i) * 256 + h * 64 + d] = g;
            Kh[e] = bf2f(proj[(size_t)(t0 + i) * NPROJ + K_OFF + h * 64 + d]) * __expf(gl - g);
        }
        for (int e = tid; e < 8192; e += NT) { const int i = e >> 7, c = e & 127; V[e] = bf2f(proj[(size_t)(t0 + i) * NPROJ + V_OFF + h * 128 + c]); }
        if (tid < 64) dec[unit * 64 + tid] = __expf(G[63 * 64 + tid]);
        __syncthreads();
        {
            const int d = tid >> 3, e0 = (tid & 7) * 16; float acc[16];
#pragma unroll
            for (int c = 0; c < 16; ++c) acc[c] = 0.f;
            for (int i = 0; i < 64; ++i) { const float a = Kh[i * 64 + d];
#pragma unroll
                for (int c = 0; c < 16; ++c) acc[c] += a * V[i * 128 + e0 + c]; }
#pragma unroll
            for (int c = 0; c < 16; ++c) Sloc[(size_t)unit * 8192 + d * 128 + e0 + c] = acc[c];
        }
        __syncthreads();
    }
}

DI void phase_gla2(const Params& p, int bid, int nblk, float* lds) {
    const float* Sloc = (const float*)(p.ws + OFF_SLOC); const float* dec = (const float*)(p.ws + OFF_DEC); float* Sin = (float*)(p.ws + OFF_SIN);
    for (int gid = bid * NT + threadIdx.x; gid < 16 * 8192; gid += nblk * NT) {
        const int bh = gid >> 13, el = gid & 8191, d = el >> 7; float st = 0.f;
        for (int n = 0; n < NSC; ++n) { const int u = bh * 64 + n; Sin[(size_t)u * 8192 + el] = st; st = st * dec[u * 64 + d] + Sloc[(size_t)u * 8192 + el]; }
    }
}

constexpr int GLA3_LDS_FLOATS = 64 * 65 * 2 + 4096 + 8192 * 2;
DI void phase_gla3(const Params& p, int bid, int nblk, float* lds) {
    const int tid = threadIdx.x;
    const bf16_t* proj = (const bf16_t*)(p.ws + OFF_PROJ); const float* Gbuf = (const float*)(p.ws + OFF_G); const float* Sin = (const float*)(p.ws + OFF_SIN);
    bf16_t* mix = (bf16_t*)(p.ws + OFF_MIX);
    float* Qt = lds; float* Kt = lds + 64 * 65; float* P = lds + 2 * 64 * 65; float* V = P + 4096; float* Sn = V + 8192;
    for (int unit = bid; unit < 1024; unit += nblk) {
        const int bh = unit >> 6, n = unit & 63, b = bh >> 2, h = bh & 3, t0 = b * SEQ + n * SC;
        for (int e = tid; e < 4096; e += NT) {
            const int i = e >> 6, d = e & 63; const float g = Gbuf[(size_t)(t0 + i) * 256 + h * 64 + d];
            const float q = bf2f(proj[(size_t)(t0 + i) * NPROJ + Q_OFF + h * 64 + d]), k = bf2f(proj[(size_t)(t0 + i) * NPROJ + K_OFF + h * 64 + d]);
            Qt[i * 65 + d] = q * 0.125f * __expf(g); Kt[i * 65 + d] = k * __expf(-g);
        }
        for (int e = tid; e < 8192; e += NT) { const int i = e >> 7, c = e & 127; V[e] = bf2f(proj[(size_t)(t0 + i) * NPROJ + V_OFF + h * 128 + c]); Sn[e] = Sin[(size_t)unit * 8192 + e]; }
        __syncthreads();
        for (int e = tid; e < 4096; e += NT) {
            const int i = e >> 6, j = e & 63; float v = 0.f;
            if (j <= i) for (int d = 0; d < 64; ++d) v += Qt[i * 65 + d] * Kt[j * 65 + d];
            P[e] = v;
        }
        __syncthreads();
        {
            const int i = tid >> 3, e0 = (tid & 7) * 16; float acc[16];
#pragma unroll
            for (int c = 0; c < 16; ++c) acc[c] = 0.f;
            for (int j = 0; j <= i; ++j) { const float pv = P[i * 64 + j];
#pragma unroll
                for (int c = 0; c < 16; ++c) acc[c] += pv * V[j * 128 + e0 + c]; }
            for (int d = 0; d < 64; ++d) { const float qv = Qt[i * 65 + d];
#pragma unroll
                for (int c = 0; c < 16; ++c) acc[c] += qv * Sn[d * 128 + e0 + c]; }
            float ss = 0.f;
#pragma unroll
            for (int c = 0; c < 16; ++c) ss += acc[c] * acc[c];
            ss += __shfl_xor(ss, 1); ss += __shfl_xor(ss, 2); ss += __shfl_xor(ss, 4);
            const float inv = rsqrtf(ss * (1.f / 128.f) + RMS_EPS);
#pragma unroll
            for (int c = 0; c < 16; ++c) {
                const int col = h * 128 + e0 + c; const float rv = bf2f(proj[(size_t)(t0 + i) * NPROJ + R_OFF + col]);
                mix[(size_t)(t0 + i) * D + 512 + col] = f2bf(acc[c] * inv * p.norm_w[e0 + c] * (rv * sigmoidf_(rv)));
            }
        }
        __syncthreads();
    }
}

DI void phase_out(const Params& p, int bid, int nblk, float* lds) {
    const bf16_t* mix = (const bf16_t*)(p.ws + OFF_MIX); float* h32 = (float*)(p.ws + OFF_H32);
    for (int u = bid; u < 128 * 16; u += nblk) {
        const int mt = u >> 4, nt = u & 15;
        auto af = [&](int r, int k) { return bf2f(mix[(size_t)(mt * 128 + r) * D + k]); };
        auto bfn = [&](int, int k, int c) { return p.w_out[(size_t)k * D + nt * 64 + c]; };
        auto epi = [&](int r, int c, float v, float) { const size_t o = (size_t)(mt * 128 + r) * D + nt * 64 + c; h32[o] = ALPHA * p.x[o] + v; };
        gemm_tile_valu<false>(D, af, bfn, epi, lds);
    }
}

DI void ln_row(float (&v)[16], const float* g, const float* b, int lane) {
    float s = 0.f;
#pragma unroll
    for (int i = 0; i < 16; ++i) s += v[i];
    const float mean = wave_sum(s) * (1.f / D); float q = 0.f;
#pragma unroll
    for (int i = 0; i < 16; ++i) { v[i] -= mean; q += v[i] * v[i]; }
    const float rstd = rsqrtf(wave_sum(q) * (1.f / D) + LN_EPS);
#pragma unroll
    for (int j = 0; j < 4; ++j) {
        const float4 gg = ((const float4*)g)[lane + 64 * j], bb = ((const float4*)b)[lane + 64 * j];
        v[4 * j] = v[4 * j] * rstd * gg.x + bb.x; v[4 * j + 1] = v[4 * j + 1] * rstd * gg.y + bb.y;
        v[4 * j + 2] = v[4 * j + 2] * rstd * gg.z + bb.z; v[4 * j + 3] = v[4 * j + 3] * rstd * gg.w + bb.w;
    }
}

DI void phase_ln1(const Params& p, int bid, int nblk, float* lds) {
    const int lane = threadIdx.x & 63, wave = threadIdx.x >> 6;
    float* h32 = (float*)(p.ws + OFF_H32); bf16_t* hb = (bf16_t*)(p.ws + OFF_HB);
    for (int row = bid * 8 + wave; row < T; row += nblk * 8) {
        float4* hr = (float4*)(h32 + (size_t)row * D); float v[16];
#pragma unroll
        for (int j = 0; j < 4; ++j) { const float4 a = hr[lane + 64 * j]; v[4 * j] = a.x; v[4 * j + 1] = a.y; v[4 * j + 2] = a.z; v[4 * j + 3] = a.w; }
        ln_row(v, p.ln1_g, p.ln1_b, lane);
#pragma unroll
        for (int j = 0; j < 4; ++j) {
            hr[lane + 64 * j] = make_float4(v[4 * j], v[4 * j + 1], v[4 * j + 2], v[4 * j + 3]);
            uint2 o; o.x = pk2(v[4 * j], v[4 * j + 1]); o.y = pk2(v[4 * j + 2], v[4 * j + 3]);
            ((uint2*)(hb + (size_t)row * D))[lane + 64 * j] = o;
        }
    }
}

DI void phase_router(const Params& p, int bid, int nblk, float* lds) {
    const float* h32 = (const float*)(p.ws + OFF_H32); float* scores = (float*)(p.ws + OFF_SCORES);
    for (int u = bid; u < 128 * 4; u += nblk) {
        const int mt = u >> 2, nt = u & 3;
        auto af = [&](int r, int k) { return h32[(size_t)(mt * 128 + r) * D + k]; };
        auto bfn = [&](int, int k, int c) { return p.router_w[(size_t)k * NE + nt * 64 + c]; };
        auto epi = [&](int r, int c, float v, float) { scores[(size_t)(mt * 128 + r) * NE + nt * 64 + c] = sigmoidf_(v); };
        gemm_tile_valu<false>(D, af, bfn, epi, lds);
    }
}

DI void phase_topk(const Params& p, int bid, int nblk, float* lds) {
    const int lane = threadIdx.x & 63, wave = threadIdx.x >> 6;
    const float* scores = (const float*)(p.ws + OFF_SCORES); float* wbuf = (float*)(p.ws + OFF_WBUF);
    int* list = (int*)(p.ws + OFF_LIST); unsigned* cnt = (unsigned*)(p.ws + OFF_CTL) + CW_CNT;
    const float NEG = -__builtin_inff();
    for (int t = bid * 8 + wave; t < T; t += nblk * 8) {
        const float4 sv = ((const float4*)(scores + (size_t)t * NE))[lane], bv = ((const float4*)p.router_bias)[lane];
        const float s[4] = {sv.x, sv.y, sv.z, sv.w};
        float cand[4] = {sv.x + bv.x, sv.y + bv.y, sv.z + bv.z, sv.w + bv.w};
        float m1 = NEG, m2 = NEG;
#pragma unroll
        for (int j = 0; j < 4; ++j) { const float v = cand[j]; if (v > m1) { m2 = m1; m1 = v; } else if (v > m2) m2 = v; }
#pragma unroll
        for (int off = 1; off < 8; off <<= 1) {
            const float o1 = __shfl_xor(m1, off), o2 = __shfl_xor(m2, off);
            const float n1 = fmaxf(m1, o1), n2 = fmaxf(fminf(m1, o1), fmaxf(m2, o2)); m1 = n1; m2 = n2;
        }
        const float gs = m1 + m2; const int mygrp = lane >> 3; int rank = 0;
#pragma unroll
        for (int g2 = 0; g2 < 8; ++g2) { const float og = __shfl(gs, g2 * 8); if (og > gs || (og == gs && g2 < mygrp)) ++rank; }
        if (rank >= 4) { cand[0] = NEG; cand[1] = NEG; cand[2] = NEG; cand[3] = NEG; }
        int my_e = 0; float my_w = 0.f, wsum = 0.f;
#pragma unroll
        for (int k = 0; k < TOPK; ++k) {
            float bvv = cand[0]; int bj = 0;
#pragma unroll
            for (int j = 1; j < 4; ++j) if (cand[j] > bvv) { bvv = cand[j]; bj = j; }
            int bi = 4 * lane + bj;
#pragma unroll
            for (int off = 32; off >= 1; off >>= 1) {
                const float ov = __shfl_xor(bvv, off); const int oi = __shfl_xor(bi, off);
                if (ov > bvv || (ov == bvv && oi < bi)) { bvv = ov; bi = oi; }
            }
            const int wj = bi & 3, wl = bi >> 2;
            const float mys = wj == 0 ? s[0] : (wj == 1 ? s[1] : (wj == 2 ? s[2] : s[3]));
            const float wk = __shfl(mys, wl);
            wsum += wk;
            if (lane == k) { my_e = bi; my_w = wk; }
            if (lane == wl) {
#pragma unroll
                for (int j = 0; j < 4; ++j) if (j == wj) cand[j] = NEG;
            }
        }
        if (lane < TOPK) {
            const unsigned pos = atomicAdd(&cnt[my_e], 1u);
            list[(size_t)my_e * LCAP + pos] = t * TOPK + lane;
            wbuf[(size_t)t * TOPK + lane] = my_w / wsum * 2.5f;
        }
    }
}

DI void build_tables(const Params& p, int* toff, int* roff) {
    const unsigned* cnt = (const unsigned*)(p.ws + OFF_CTL) + CW_CNT;
    if (threadIdx.x == 0) {
        int ta = 0, ra = 0;
        for (int e = 0; e < NE; ++e) { const int c = (int)cnt[e]; toff[e] = ta; roff[e] = ra; ta += (c + 127) >> 7; ra += c; }
        toff[NE] = ta; roff[NE] = ra;
    }
    __syncthreads();
}
DI int find_expert(const int* toff, int tile) { int lo = 0, hi = NE - 1; while (lo < hi) { const int mid = (lo + hi + 1) >> 1; if (toff[mid] <= tile) lo = mid; else hi = mid - 1; } return lo; }

constexpr int EXP_LDS_FLOATS = GT_LDS_FLOATS + 2 * 260 + 128;
DI void phase_e1(const Params& p, int bid, int nblk, float* lds) {
    int* toff = (int*)(lds + GT_LDS_FLOATS); int* roff = toff + 260; int* rowa = roff + 260;
    const bf16_t* hb = (const bf16_t*)(p.ws + OFF_HB); bf16_t* hid = (bf16_t*)(p.ws + OFF_HID); const int* list = (const int*)(p.ws + OFF_LIST);
    const unsigned* cnt = (const unsigned*)(p.ws + OFF_CTL) + CW_CNT;
    build_tables(p, toff, roff);
    const int ntile = toff[NE], units = (ntile + 128) * 4;
    for (int u = bid; u < units; u += nblk) {
        const int tile = u >> 2, nt = u & 3; int e, mt, rows, rowbase; const float *wg, *wu;
        if (tile < ntile) { e = find_expert(toff, tile); mt = tile - toff[e]; rows = min(128, (int)cnt[e] - mt * 128); rowbase = roff[e] + mt * 128; wg = p.wg + (size_t)e * 262144; wu = p.wu + (size_t)e * 262144; }
        else { e = NE; mt = tile - ntile; rows = 128; rowbase = A_TOT + mt * 128; wg = p.sg; wu = p.su; }
        if (threadIdx.x < 128) { const int r = threadIdx.x; rowa[r] = (e < NE) ? (r < rows ? (list[(size_t)e * LCAP + mt * 128 + r] >> 3) : 0) : (mt * 128 + r); }
        __syncthreads();
        auto af = [&](int r, int k) { return bf2f(hb[(size_t)rowa[r] * D + k]); };
        auto bfn = [&](int which, int k, int c) { return (which ? wu : wg)[(size_t)k * EDIM + nt * 64 + c]; };
        auto epi = [&](int r, int c, float g, float uu) { if (r < rows) hid[(size_t)(rowbase + r) * EDIM + nt * 64 + c] = f2bf(g * sigmoidf_(g) * uu); };
        gemm_tile_valu<true>(D, af, bfn, epi, lds);
        __syncthreads();
    }
}

DI void phase_e2(const Params& p, int bid, int nblk, float* lds) {
    int* toff = (int*)(lds + GT_LDS_FLOATS); int* roff = toff + 260; int* rowa = roff + 260;
    const bf16_t* hid = (const bf16_t*)(p.ws + OFF_HID); bf16_t* Y = (bf16_t*)(p.ws + OFF_Y); const int* list = (const int*)(p.ws + OFF_LIST);
    const unsigned* cnt = (const unsigned*)(p.ws + OFF_CTL) + CW_CNT;
    build_tables(p, toff, roff);
    const int ntile = toff[NE], units = (ntile + 128) * 16;
    for (int u = bid; u < units; u += nblk) {
        const int tile = u >> 4, nt = u & 15; int e, mt, rows, rowbase; const float* wd;
        if (tile < ntile) { e = find_expert(toff, tile); mt = tile - toff[e]; rows = min(128, (int)cnt[e] - mt * 128); rowbase = roff[e] + mt * 128; wd = p.wd + (size_t)e * 262144; }
        else { e = NE; mt = tile - ntile; rows = 128; rowbase = A_TOT + mt * 128; wd = p.sd; }
        if (threadIdx.x < 128) { const int r = threadIdx.x; rowa[r] = (e < NE) ? (r < rows ? list[(size_t)e * LCAP + mt * 128 + r] : 0) : (A_TOT + mt * 128 + r); }
        __syncthreads();
        auto af = [&](int r, int k) { return r < rows ? bf2f(hid[(size_t)(rowbase + r) * EDIM + k]) : 0.f; };
        auto bfn = [&](int, int k, int c) { return wd[(size_t)k * D + nt * 64 + c]; };
        auto epi = [&](int r, int c, float v, float) { if (r < rows) Y[(size_t)rowa[r] * D + nt * 64 + c] = f2bf(v); };
        gemm_tile_valu<false>(EDIM, af, bfn, epi, lds);
        __syncthreads();
    }
}

DI void phase_combine(const Params& p, int bid, int nblk, float* lds) {
    const int lane = threadIdx.x & 63, wave = threadIdx.x >> 6;
    const float* h32 = (const float*)(p.ws + OFF_H32); const bf16_t* Y = (const bf16_t*)(p.ws + OFF_Y); const float* wbuf = (const float*)(p.ws + OFF_WBUF);
    for (int t = bid * 8 + wave; t < T; t += nblk * 8) {
        float v[16];
#pragma unroll
        for (int j = 0; j < 4; ++j) { const float4 a = ((const float4*)(h32 + (size_t)t * D))[lane + 64 * j]; v[4 * j] = ALPHA * a.x; v[4 * j + 1] = ALPHA * a.y; v[4 * j + 2] = ALPHA * a.z; v[4 * j + 3] = ALPHA * a.w; }
#pragma unroll
        for (int k = 0; k < 9; ++k) {
            const size_t row = k < 8 ? (size_t)t * TOPK + k : (size_t)A_TOT + t; const float w = k < 8 ? wbuf[(size_t)t * TOPK + k] : 1.f;
#pragma unroll
            for (int j = 0; j < 4; ++j) {
                const uint2 y = ((const uint2*)(Y + row * D))[lane + 64 * j];
                v[4 * j] += w * __uint_as_float(y.x << 16); v[4 * j + 1] += w * __uint_as_float(y.x & 0xffff0000u);
                v[4 * j + 2] += w * __uint_as_float(y.y << 16); v[4 * j + 3] += w * __uint_as_float(y.y & 0xffff0000u);
            }
        }
        ln_row(v, p.ln2_g, p.ln2_b, lane);
#pragma unroll
        for (int j = 0; j < 4; ++j) ((float4*)(p.out + (size_t)t * D))[lane + 64 * j] = make_float4(v[4 * j], v[4 * j + 1], v[4 * j + 2], v[4 * j + 3]);
    }
}

template <int PH>
__global__ void __launch_bounds__(NT) phase_kernel(Params p) {
    extern __shared__ __attribute__((aligned(16))) float lds[];
    const int bid = blockIdx.x, nblk = gridDim.x;
    if (PH == 0) phase_prep(p, bid, nblk, lds);
    if (PH == 1) phase_proj(p, bid, nblk, lds);
    if (PH == 2) phase_pool(p, bid, nblk, lds);
    if (PH == 3) phase_gla1(p, bid, nblk, lds);
    if (PH == 4) phase_gla2(p, bid, nblk, lds);
    if (PH == 5) phase_gla3(p, bid, nblk, lds);
    if (PH == 6) phase_out(p, bid, nblk, lds);
    if (PH == 7) phase_ln1(p, bid, nblk, lds);
    if (PH == 8) phase_router(p, bid, nblk, lds);
    if (PH == 9) phase_topk(p, bid, nblk, lds);
    if (PH == 10) phase_e1(p, bid, nblk, lds);
    if (PH == 11) phase_e2(p, bid, nblk, lds);
    if (PH == 12) phase_combine(p, bid, nblk, lds);
}

template <int PH>
static void launch_phase(const Params& p, int grid, int lds_floats, hipStream_t stream) {
    static bool attr_set = false;
    const int bytes = lds_floats * 4;
    if (!attr_set) { (void)hipFuncSetAttribute((const void*)phase_kernel<PH>, hipFuncAttributeMaxDynamicSharedMemorySize, bytes); attr_set = true; }
    hipLaunchKernelGGL(phase_kernel<PH>, dim3(grid), dim3(NT), bytes, stream, p);
}

extern "C" void kernel_launch(void* const* d_in, const int* in_sizes, int n_in, void* d_out, int out_size, void* d_ws, size_t ws_size, hipStream_t stream) {
    if (n_in != 20 || ws_size < WS_NEED) { fprintf(stderr, "kernel_launch: unexpected n_in %d or ws_size %zu (< %zu)\n", n_in, ws_size, (size_t)WS_NEED); return; }
    Params p{};
    const float** pp = (const float**)&p;
    for (int i = 0; i < 20; ++i) pp[i] = (const float*)d_in[i];
    p.out = (float*)d_out; p.ws = (unsigned char*)d_ws;
    (void)hipMemsetAsync((char*)d_ws + OFF_CTL, 0, 1 * MiB, stream);
    const int G = 2048;
    launch_phase<0>(p, G, 16, stream);
    launch_phase<1>(p, G, GT_LDS_FLOATS, stream);
    launch_phase<2>(p, 1024, GT_LDS_FLOATS, stream);
    launch_phase<3>(p, 1024, GLA1_LDS_FLOATS, stream);
    launch_phase<4>(p, 256, 16, stream);
    launch_phase<5>(p, 1024, GLA3_LDS_FLOATS, stream);
    launch_phase<6>(p, G, GT_LDS_FLOATS, stream);
    launch_phase<7>(p, G, 16, stream);
    launch_phase<8>(p, 512, GT_LDS_FLOATS, stream);
    launch_phase<9>(p, G, 16, stream);
    launch_phase<10>(p, G, EXP_LDS_FLOATS, stream);
    launch_phase<11>(p, G, EXP_LDS_FLOATS, stream);
    launch_phase<12>(p, G, 16, stream);
}
```

```cpp
#include <hip/hip_runtime.h>
#include <stdint.h>
#include <cstdio>

#define DI __device__ __forceinline__
typedef unsigned short bf16_t;

constexpr int T = 16384, D = 1024, SEQ = 4096;
constexpr int DIN = 2064, NPROJ = 2048;
constexpr int P_OFF = 0, Q_OFF = 512, K_OFF = 768, V_OFF = 1024, R_OFF = 1536, GL_OFF = 2048;
constexpr int SC = 64;
constexpr int NSC = SEQ / SC;
constexpr int NE = 256, TOPK = 8, EDIM = 256;
constexpr int A_TOT = T * TOPK;
constexpr int LCAP = T;
constexpr float ALPHA = 1.189207115002721f;
constexpr float LN_EPS = 1e-5f, RMS_EPS = 1e-5f;
constexpr int NT = 512;

constexpr size_t MiB = 1u << 20;
constexpr size_t OFF_CTL = 0;
constexpr size_t OFF_XB = 1 * MiB;
constexpr size_t OFF_GLOW = OFF_XB + 32 * MiB;
constexpr size_t OFF_PROJ = OFF_GLOW + 1 * MiB;
constexpr size_t OFF_G = OFF_PROJ + 64 * MiB;
constexpr size_t OFF_SLOC = OFF_G + 16 * MiB;
constexpr size_t OFF_DEC = OFF_SLOC + 32 * MiB;
constexpr size_t OFF_SIN = OFF_DEC + 1 * MiB;
constexpr size_t OFF_MIX = OFF_SIN + 32 * MiB;
constexpr size_t OFF_H32 = OFF_MIX + 32 * MiB;
constexpr size_t OFF_HB = OFF_H32 + 64 * MiB;
constexpr size_t OFF_SCORES = OFF_HB + 32 * MiB;
constexpr size_t OFF_WBUF = OFF_SCORES + 16 * MiB;
constexpr size_t OFF_LIST = OFF_WBUF + 1 * MiB;
constexpr size_t OFF_HID = OFF_LIST + 16 * MiB;
constexpr size_t OFF_Y = OFF_HID + 76 * MiB;
constexpr size_t WS_NEED = OFF_Y + 304 * MiB;
constexpr int CW_CNT = 1024;

struct Params {
    const float *x, *w_in, *gate_w2, *gate_b, *norm_w, *pool_w, *pool_scale, *w_out, *ln1_g, *ln1_b;
    const float *router_w, *router_bias, *wg, *wu, *wd, *sg, *su, *sd, *ln2_g, *ln2_b;
    float* out;
    unsigned char* ws;
};

DI float bf2f(bf16_t v) { return __uint_as_float(((unsigned)v) << 16); }
DI bf16_t f2bf(float f) { unsigned u = __float_as_uint(f); u += 0x7fffu + ((u >> 16) & 1u); return (bf16_t)(u >> 16); }
DI unsigned pk2(float lo, float hi) { return (unsigned)f2bf(lo) | ((unsigned)f2bf(hi) << 16); }
DI float wave_sum(float v) {
#pragma unroll
    for (int o = 1; o < 64; o <<= 1) v += __shfl_xor(v, o);
    return v;
}
DI float sigmoidf_(float v) { return 1.f / (1.f + __expf(-v)); }
DI float logsigmoidf_(float z) { return fminf(z, 0.f) - log1pf(__expf(-fabsf(z))); }

constexpr int GT_LDS_FLOATS = 16 * 132 + 2 * 16 * 68;
template <bool DUAL, class AF, class BF, class EPI>
DI void gemm_tile_valu(int K, const AF& af, const BF& bfn, const EPI& epi, float* lds) {
    float* As = lds; float* Bs = lds + 16 * 132; float* Bs2 = Bs + 16 * 68;
    const int tid = threadIdx.x, ty = tid >> 4, tx = tid & 15;
    float acc[4][4], acc2[4][4];
#pragma unroll
    for (int i = 0; i < 4; ++i)
#pragma unroll
        for (int j = 0; j < 4; ++j) { acc[i][j] = 0.f; acc2[i][j] = 0.f; }
    for (int k0 = 0; k0 < K; k0 += 16) {
#pragma unroll
        for (int i = 0; i < 4; ++i) { const int e = tid + 512 * i, r = e >> 4, kk = e & 15; As[kk * 132 + r] = af(r, k0 + kk); }
#pragma unroll
        for (int i = 0; i < 2; ++i) { const int e = tid + 512 * i, kk = e >> 6, c = e & 63; Bs[kk * 68 + c] = bfn(0, k0 + kk, c); if (DUAL) Bs2[kk * 68 + c] = bfn(1, k0 + kk, c); }
        __syncthreads();
#pragma unroll
        for (int kk = 0; kk < 16; ++kk) {
            const float4 a = *(const float4*)&As[kk * 132 + ty * 4];
            const float4 b = *(const float4*)&Bs[kk * 68 + tx * 4];
            const float av[4] = {a.x, a.y, a.z, a.w}, bv[4] = {b.x, b.y, b.z, b.w};
#pragma unroll
            for (int i = 0; i < 4; ++i)
#pragma unroll
                for (int j = 0; j < 4; ++j) acc[i][j] += av[i] * bv[j];
            if (DUAL) {
                const float4 b2 = *(const float4*)&Bs2[kk * 68 + tx * 4];
                const float b2v[4] = {b2.x, b2.y, b2.z, b2.w};
#pragma unroll
                for (int i = 0; i < 4; ++i)
#pragma unroll
                    for (int j = 0; j < 4; ++j) acc2[i][j] += av[i] * b2v[j];
            }
        }
        __syncthreads();
    }
#pragma unroll
    for (int i = 0; i < 4; ++i)
#pragma unroll
        for (int j = 0; j < 4; ++j) epi(ty * 4 + i, tx * 4 + j, acc[i][j], acc2[i][j]);
}

DI void phase_prep(const Params& p, int bid, int nblk, float* lds) {
    const int lane = threadIdx.x & 63, wave = threadIdx.x >> 6;
    bf16_t* xb = (bf16_t*)(p.ws + OFF_XB); float* glow = (float*)(p.ws + OFF_GLOW);
    for (int row = bid * 8 + wave; row < T; row += nblk * 8) {
        const float4* xr = (const float4*)(p.x + (size_t)row * D);
        float acc[16];
#pragma unroll
        for (int n = 0; n < 16; ++n) acc[n] = 0.f;
#pragma unroll
        for (int j = 0; j < 4; ++j) {
            const float4 v = xr[lane + 64 * j];
            uint2 o; o.x = pk2(v.x, v.y); o.y = pk2(v.z, v.w);
            ((uint2*)(xb + (size_t)row * D))[lane + 64 * j] = o;
            const float vv[4] = {v.x, v.y, v.z, v.w};
#pragma unroll
            for (int c = 0; c < 4; ++c) {
                const int col = 4 * (lane + 64 * j) + c;
                const float4* wr = (const float4*)(p.w_in + (size_t)col * DIN + GL_OFF);
#pragma unroll
                for (int q = 0; q < 4; ++q) { const float4 w = wr[q]; acc[4 * q] += vv[c] * w.x; acc[4 * q + 1] += vv[c] * w.y; acc[4 * q + 2] += vv[c] * w.z; acc[4 * q + 3] += vv[c] * w.w; }
            }
        }
        float mine = 0.f;
#pragma unroll
        for (int n = 0; n < 16; ++n) { const float s = wave_sum(acc[n]); if (lane == n) mine = s; }
        if (lane < 16) glow[(size_t)row * 16 + lane] = mine;
    }
}

DI void phase_proj(const Params& p, int bid, int nblk, float* lds) {
    const bf16_t* xb = (const bf16_t*)(p.ws + OFF_XB); bf16_t* proj = (bf16_t*)(p.ws + OFF_PROJ);
    for (int u = bid; u < 128 * 32; u += nblk) {
        const int mt = u >> 5, nt = u & 31;
        auto af = [&](int r, int k) { return bf2f(xb[(size_t)(mt * 128 + r) * D + k]); };
        auto bfn = [&](int, int k, int c) { return p.w_in[(size_t)k * DIN + nt * 64 + c]; };
        auto epi = [&](int r, int c, float v, float) { proj[(size_t)(mt * 128 + r) * NPROJ + nt * 64 + c] = f2bf(v); };
        gemm_tile_valu<false>(D, af, bfn, epi, lds);
    }
}

DI void phase_pool(const Params& p, int bid, int nblk, float* lds) {
    const bf16_t* proj = (const bf16_t*)(p.ws + OFF_PROJ); bf16_t* mix = (bf16_t*)(p.ws + OFF_MIX);
    for (int u = bid; u < 128 * 8; u += nblk) {
        const int mt = u >> 3, g = (u >> 1) & 3, nt = u & 1, w = 2 << g;
        auto af = [&](int r, int k) {
            const int t = mt * 128 + r, s = t & (SEQ - 1), cnt = min(s + 1, w);
            const bf16_t* pp = proj + (size_t)t * NPROJ + P_OFF + g * 128 + k;
            float sum = 0.f;
            for (int j = 0; j < cnt; ++j) sum += bf2f(pp[-(ptrdiff_t)j * NPROJ]);
            return sum / (float)cnt - bf2f(pp[0]);
        };
        auto bfn = [&](int, int k, int c) { return p.pool_w[(size_t)g * 16384 + k * 128 + nt * 64 + c]; };
        auto epi = [&](int r, int c, float v, float) { const int col = g * 128 + nt * 64 + c; mix[(size_t)(mt * 128 + r) * D + col] = f2bf(v * p.pool_scale[col]); };
        gemm_tile_valu<false>(128, af, bfn, epi, lds);
    }
}

constexpr int GLA1_LDS_FLOATS = 4096 * 2 + 8192;
DI void phase_gla1(const Params& p, int bid, int nblk, float* lds) {
    const int tid = threadIdx.x;
    const bf16_t* proj = (const bf16_t*)(p.ws + OFF_PROJ); const float* glow = (const float*)(p.ws + OFF_GLOW);
    float* Gbuf = (float*)(p.ws + OFF_G); float* Sloc = (float*)(p.ws + OFF_SLOC); float* dec = (float*)(p.ws + OFF_DEC);
    float* G = lds; float* Kh = lds + 4096; float* V = lds + 8192;
    for (int unit = bid; unit < 1024; unit += nblk) {
        const int bh = unit >> 6, n = unit & 63, b = bh >> 2, h = bh & 3, t0 = b * SEQ + n * SC;
        for (int e = tid; e < 4096; e += NT) {
            const int i = e >> 6, d = e & 63;
            float z = p.gate_b[h * 64 + d];
#pragma unroll
            for (int r = 0; r < 16; ++r) z += glow[(size_t)(t0 + i) * 16 + r] * p.gate_w2[r * 256 + h * 64 + d];
            G[e] = logsigmoidf_(z) * (1.f / 16.f);
        }
        __syncthreads();
        if (tid < 64) { float run = 0.f; for (int i = 0; i < 64; ++i) { run += G[i * 64 + tid]; G[i * 64 + tid] = run; } }
        __syncthreads();
        for (int e = tid; e < 4096; e += NT) {
            const int i = e >> 6, d = e & 63; const float g = G[e], gl = G[63 * 64 + d];
            Gbuf[(size_t)(t0 + i) * 256 + h * 64 + d] = g;
            Kh[e] = bf2f(proj[(size_t)(t0 + i) * NPROJ + K_OFF + h * 64 + d]) * __expf(gl - g);
        }
        for (int e = tid; e < 8192; e += NT) { const int i = e >> 7, c = e & 127; V[e] = bf2f(proj[(size_t)(t0 + i) * NPROJ + V_OFF + h * 128 + c]); }
        if (tid < 64) dec[unit * 64 + tid] = __expf(G[63 * 64 + tid]);
        __syncthreads();
        {
            const int d = tid >> 3, e0 = (tid & 7) * 16; float acc[16];
#pragma unroll
            for (int c = 0; c < 16; ++c) acc[c] = 0.f;
            for (int i = 0; i < 64; ++i) { const float a = Kh[i * 64 + d];
#pragma unroll
                for (int c = 0; c < 16; ++c) acc[c] += a * V[i * 128 + e0 + c]; }
#pragma unroll
            for (int c = 0; c < 16; ++c) Sloc[(size_t)unit * 8192 + d * 128 + e0 + c] = acc[c];
        }
        __syncthreads();
    }
}

DI void phase_gla2(const Params& p, int bid, int nblk, float* lds) {
    const float* Sloc = (const float*)(p.ws + OFF_SLOC); const float* dec = (const float*)(p.ws + OFF_DEC); float* Sin = (float*)(p.ws + OFF_SIN);
    for (int gid = bid * NT + threadIdx.x; gid < 16 * 8192; gid += nblk * NT) {
        const int bh = gid >> 13, el = gid & 8191, d = el >> 7; float st = 0.f;
        for (int n = 0; n < NSC; ++n) { const int u = bh * 64 + n; Sin[(size_t)u * 8192 + el] = st; st = st * dec[u * 64 + d] + Sloc[(size_t)u * 8192 + el]; }
    }
}

constexpr int GLA3_LDS_FLOATS = 64 * 65 * 2 + 4096 + 8192 * 2;
DI void phase_gla3(const Params& p, int bid, int nblk, float* lds) {
    const int tid = threadIdx.x;
    const bf16_t* proj = (const bf16_t*)(p.ws + OFF_PROJ); const float* Gbuf = (const float*)(p.ws + OFF_G); const float* Sin = (const float*)(p.ws + OFF_SIN);
    bf16_t* mix = (bf16_t*)(p.ws + OFF_MIX);
    float* Qt = lds; float* Kt = lds + 64 * 65; float* P = lds + 2 * 64 * 65; float* V = P + 4096; float* Sn = V + 8192;
    for (int unit = bid; unit < 1024; unit += nblk) {
        const int bh = unit >> 6, n = unit & 63, b = bh >> 2, h = bh & 3, t0 = b * SEQ + n * SC;
        for (int e = tid; e < 4096; e += NT) {
            const int i = e >> 6, d = e & 63; const float g = Gbuf[(size_t)(t0 + i) * 256 + h * 64 + d];
            const float q = bf2f(proj[(size_t)(t0 + i) * NPROJ + Q_OFF + h * 64 + d]), k = bf2f(proj[(size_t)(t0 + i) * NPROJ + K_OFF + h * 64 + d]);
            Qt[i * 65 + d] = q * 0.125f * __expf(g); Kt[i * 65 + d] = k * __expf(-g);
        }
        for (int e = tid; e < 8192; e += NT) { const int i = e >> 7, c = e & 127; V[e] = bf2f(proj[(size_t)(t0 + i) * NPROJ + V_OFF + h * 128 + c]); Sn[e] = Sin[(size_t)unit * 8192 + e]; }
        __syncthreads();
        for (int e = tid; e < 4096; e += NT) {
            const int i = e >> 6, j = e & 63; float v = 0.f;
            if (j <= i) for (int d = 0; d < 64; ++d) v += Qt[i * 65 + d] * Kt[j * 65 + d];
            P[e] = v;
        }
        __syncthreads();
        {
            const int i = tid >> 3, e0 = (tid & 7) * 16; float acc[16];
#pragma unroll
            for (int c = 0; c < 16; ++c) acc[c] = 0.f;
            for (int j = 0; j <= i; ++j) { const float pv = P[i * 64 + j];
#pragma unroll
                for (int c = 0; c < 16; ++c) acc[c] += pv * V[j * 128 + e0 + c]; }
            for (int d = 0; d < 64; ++d) { const float qv = Qt[i * 65 + d];
#pragma unroll
                for (int c = 0; c < 16; ++c) acc[c] += qv * Sn[d * 128 + e0 + c]; }
            float ss = 0.f;
#pragma unroll
            for (int c = 0; c < 16; ++c) ss += acc[c] * acc[c];
            ss += __shfl_xor(ss, 1); ss += __shfl_xor(ss, 2); ss += __shfl_xor(ss, 4);
            const float inv = rsqrtf(ss * (1.f / 128.f) + RMS_EPS);
#pragma unroll
            for (int c = 0; c < 16; ++c) {
                const int col = h * 128 + e0 + c; const float rv = bf2f(proj[(size_t)(t0 + i) * NPROJ + R_OFF + col]);
                mix[(size_t)(t0 + i) * D + 512 + col] = f2bf(acc[c] * inv * p.norm_w[e0 + c] * (rv * sigmoidf_(rv)));
            }
        }
        __syncthreads();
    }
}

DI void phase_out(const Params& p, int bid, int nblk, float* lds) {
    const bf16_t* mix = (const bf16_t*)(p.ws + OFF_MIX); float* h32 = (float*)(p.ws + OFF_H32);
    for (int u = bid; u < 128 * 16; u += nblk) {
        const int mt = u >> 4, nt = u & 15;
        auto af = [&](int r, int k) { return bf2f(mix[(size_t)(mt * 128 + r) * D + k]); };
        auto bfn = [&](int, int k, int c) { return p.w_out[(size_t)k * D + nt * 64 + c]; };
        auto epi = [&](int r, int c, float v, float) { const size_t o = (size_t)(mt * 128 + r) * D + nt * 64 + c; h32[o] = ALPHA * p.x[o] + v; };
        gemm_tile_valu<false>(D, af, bfn, epi, lds);
    }
}

DI void ln_row(float (&v)[16], const float* g, const float* b, int lane) {
    float s = 0.f;
#pragma unroll
    for (int i = 0; i < 16; ++i) s += v[i];
    const float mean = wave_sum(s) * (1.f / D); float q = 0.f;
#pragma unroll
    for (int i = 0; i < 16; ++i) { v[i] -= mean; q += v[i] * v[i]; }
    const float rstd = rsqrtf(wave_sum(q) * (1.f / D) + LN_EPS);
#pragma unroll
    for (int j = 0; j < 4; ++j) {
        const float4 gg = ((const float4*)g)[lane + 64 * j], bb = ((const float4*)b)[lane + 64 * j];
        v[4 * j] = v[4 * j] * rstd * gg.x + bb.x; v[4 * j + 1] = v[4 * j + 1] * rstd * gg.y + bb.y;
        v[4 * j + 2] = v[4 * j + 2] * rstd * gg.z + bb.z; v[4 * j + 3] = v[4 * j + 3] * rstd * gg.w + bb.w;
    }
}

DI void phase_ln1(const Params& p, int bid, int nblk, float* lds) {
    const int lane = threadIdx.x & 63, wave = threadIdx.x >> 6;
    float* h32 = (float*)(p.ws + OFF_H32); bf16_t* hb = (bf16_t*)(p.ws + OFF_HB);
    for (int row = bid * 8 + wave; row < T; row += nblk * 8) {
        float4* hr = (float4*)(h32 + (size_t)row * D); float v[16];
#pragma unroll
        for (int j = 0; j < 4; ++j) { const float4 a = hr[lane + 64 * j]; v[4 * j] = a.x; v[4 * j + 1] = a.y; v[4 * j + 2] = a.z; v[4 * j + 3] = a.w; }
        ln_row(v, p.ln1_g, p.ln1_b, lane);
#pragma unroll
        for (int j = 0; j < 4; ++j) {
            hr[lane + 64 * j] = make_float4(v[4 * j], v[4 * j + 1], v[4 * j + 2], v[4 * j + 3]);
            uint2 o; o.x = pk2(v[4 * j], v[4 * j + 1]); o.y = pk2(v[4 * j + 2], v[4 * j + 3]);
            ((uint2*)(hb + (size_t)row * D))[lane + 64 * j] = o;
        }
    }
}

DI void phase_router(const Params& p, int bid, int nblk, float* lds) {
    const float* h32 = (const float*)(p.ws + OFF_H32); float* scores = (float*)(p.ws + OFF_SCORES);
    for (int u = bid; u < 128 * 4; u += nblk) {
        const int mt = u >> 2, nt = u & 3;
        auto af = [&](int r, int k) { return h32[(size_t)(mt * 128 + r) * D + k]; };
        auto bfn = [&](int, int k, int c) { return p.router_w[(size_t)k * NE + nt * 64 + c]; };
        auto epi = [&](int r, int c, float v, float) { scores[(size_t)(mt * 128 + r) * NE + nt * 64 + c] = sigmoidf_(v); };
        gemm_tile_valu<false>(D, af, bfn, epi, lds);
    }
}

DI void phase_topk(const Params& p, int bid, int nblk, float* lds) {
    const int lane = threadIdx.x & 63, wave = threadIdx.x >> 6;
    const float* scores = (const float*)(p.ws + OFF_SCORES); float* wbuf = (float*)(p.ws + OFF_WBUF);
    int* list = (int*)(p.ws + OFF_LIST); unsigned* cnt = (unsigned*)(p.ws + OFF_CTL) + CW_CNT;
    const float NEG = -__builtin_inff();
    for (int t = bid * 8 + wave; t < T; t += nblk * 8) {
        const float4 sv = ((const float4*)(scores + (size_t)t * NE))[lane], bv = ((const float4*)p.router_bias)[lane];
        const float s[4] = {sv.x, sv.y, sv.z, sv.w};
        float cand[4] = {sv.x + bv.x, sv.y + bv.y, sv.z + bv.z, sv.w + bv.w};
        float m1 = NEG, m2 = NEG;
#pragma unroll
        for (int j = 0; j < 4; ++j) { const float v = cand[j]; if (v > m1) { m2 = m1; m1 = v; } else if (v > m2) m2 = v; }
#pragma unroll
        for (int off = 1; off < 8; off <<= 1) {
            const float o1 = __shfl_xor(m1, off), o2 = __shfl_xor(m2, off);
            const float n1 = fmaxf(m1, o1), n2 = fmaxf(fminf(m1, o1), fmaxf(m2, o2)); m1 = n1; m2 = n2;
        }
        const float gs = m1 + m2; const int mygrp = lane >> 3; int rank = 0;
#pragma unroll
        for (int g2 = 0; g2 < 8; ++g2) { const float og = __shfl(gs, g2 * 8); if (og > gs || (og == gs && g2 < mygrp)) ++rank; }
        if (rank >= 4) { cand[0] = NEG; cand[1] = NEG; cand[2] = NEG; cand[3] = NEG; }
        int my_e = 0; float my_w = 0.f, wsum = 0.f;
#pragma unroll
        for (int k = 0; k < TOPK; ++k) {
            float bvv = cand[0]; int bj = 0;
#pragma unroll
            for (int j = 1; j < 4; ++j) if (cand[j] > bvv) { bvv = cand[j]; bj = j; }
            int bi = 4 * lane + bj;
#pragma unroll
            for (int off = 32; off >= 1; off >>= 1) {
                const float ov = __shfl_xor(bvv, off); const int oi = __shfl_xor(bi, off);
                if (ov > bvv || (ov == bvv && oi < bi)) { bvv = ov; bi = oi; }
            }
            const int wj = bi & 3, wl = bi >> 2;
            const float mys = wj == 0 ? s[0] : (wj == 1 ? s[1] : (wj == 2 ? s[2] : s[3]));
            const float wk = __shfl(mys, wl);
            wsum += wk;
            if (lane == k) { my_e = bi; my_w = wk; }
            if (lane == wl) {
#pragma unroll
                for (int j = 0; j < 4; ++j) if (j == wj) cand[j] = NEG;
            }
        }
        if (lane < TOPK) {
            const unsigned pos = atomicAdd(&cnt[my_e], 1u);
            list[(size_t)my_e * LCAP + pos] = t * TOPK + lane;
            wbuf[(size_t)t * TOPK + lane] = my_w / wsum * 2.5f;
        }
    }
}

DI void build_tables(const Params& p, int* toff, int* roff) {
    const unsigned* cnt = (const unsigned*)(p.ws + OFF_CTL) + CW_CNT;
    if (threadIdx.x == 0) {
        int ta = 0, ra = 0;
        for (int e = 0; e < NE; ++e) { const int c = (int)cnt[e]; toff[e] = ta; roff[e] = ra; ta += (c + 127) >> 7; ra += c; }
        toff[NE] = ta; roff[NE] = ra;
    }
    __syncthreads();
}
DI int find_expert(const int* toff, int tile) { int lo = 0, hi = NE - 1; while (lo < hi) { const int mid = (lo + hi + 1) >> 1; if (toff[mid] <= tile) lo = mid; else hi = mid - 1; } return lo; }

constexpr int EXP_LDS_FLOATS = GT_LDS_FLOATS + 2 * 260 + 128;
DI void phase_e1(const Params& p, int bid, int nblk, float* lds) {
    int* toff = (int*)(lds + GT_LDS_FLOATS); int* roff = toff + 260; int* rowa = roff + 260;
    const bf16_t* hb = (const bf16_t*)(p.ws + OFF_HB); bf16_t* hid = (bf16_t*)(p.ws + OFF_HID); const int* list = (const int*)(p.ws + OFF_LIST);
    const unsigned* cnt = (const unsigned*)(p.ws + OFF_CTL) + CW_CNT;
    build_tables(p, toff, roff);
    const int ntile = toff[NE], units = (ntile + 128) * 4;
    for (int u = bid; u < units; u += nblk) {
        const int tile = u >> 2, nt = u & 3; int e, mt, rows, rowbase; const float *wg, *wu;
        if (tile < ntile) { e = find_expert(toff, tile); mt = tile - toff[e]; rows = min(128, (int)cnt[e] - mt * 128); rowbase = roff[e] + mt * 128; wg = p.wg + (size_t)e * 262144; wu = p.wu + (size_t)e * 262144; }
        else { e = NE; mt = tile - ntile; rows = 128; rowbase = A_TOT + mt * 128; wg = p.sg; wu = p.su; }
        if (threadIdx.x < 128) { const int r = threadIdx.x; rowa[r] = (e < NE) ? (r < rows ? (list[(size_t)e * LCAP + mt * 128 + r] >> 3) : 0) : (mt * 128 + r); }
        __syncthreads();
        auto af = [&](int r, int k) { return bf2f(hb[(size_t)rowa[r] * D + k]); };
        auto bfn = [&](int which, int k, int c) { return (which ? wu : wg)[(size_t)k * EDIM + nt * 64 + c]; };
        auto epi = [&](int r, int c, float g, float uu) { if (r < rows) hid[(size_t)(rowbase + r) * EDIM + nt * 64 + c] = f2bf(g * sigmoidf_(g) * uu); };
        gemm_tile_valu<true>(D, af, bfn, epi, lds);
        __syncthreads();
    }
}

DI void phase_e2(const Params& p, int bid, int nblk, float* lds) {
    int* toff = (int*)(lds + GT_LDS_FLOATS); int* roff = toff + 260; int* rowa = roff + 260;
    const bf16_t* hid = (const bf16_t*)(p.ws + OFF_HID); bf16_t* Y = (bf16_t*)(p.ws + OFF_Y); const int* list = (const int*)(p.ws + OFF_LIST);
    const unsigned* cnt = (const unsigned*)(p.ws + OFF_CTL) + CW_CNT;
    build_tables(p, toff, roff);
    const int ntile = toff[NE], units = (ntile + 128) * 16;
    for (int u = bid; u < units; u += nblk) {
        const int tile = u >> 4, nt = u & 15; int e, mt, rows, rowbase; const float* wd;
        if (tile < ntile) { e = find_expert(toff, tile); mt = tile - toff[e]; rows = min(128, (int)cnt[e] - mt * 128); rowbase = roff[e] + mt * 128; wd = p.wd + (size_t)e * 262144; }
        else { e = NE; mt = tile - ntile; rows = 128; rowbase = A_TOT + mt * 128; wd = p.sd; }
        if (threadIdx.x < 128) { const int r = threadIdx.x; rowa[r] = (e < NE) ? (r < rows ? list[(size_t)e * LCAP + mt * 128 + r] : 0) : (A_TOT + mt * 128 + r); }
        __syncthreads();
        auto af = [&](int r, int k) { return r < rows ? bf2f(hid[(size_t)(rowbase + r) * EDIM + k]) : 0.f; };
        auto bfn = [&](int, int k, int c) { return wd[(size_t)k * D + nt * 64 + c]; };
        auto epi = [&](int r, int c, float v, float) { if (r < rows) Y[(size_t)rowa[r] * D + nt * 64 + c] = f2bf(v); };
        gemm_tile_valu<false>(EDIM, af, bfn, epi, lds);
        __syncthreads();
    }
}

DI void phase_combine(const Params& p, int bid, int nblk, float* lds) {
    const int lane = threadIdx.x & 63, wave = threadIdx.x >> 6;
    const float* h32 = (const float*)(p.ws + OFF_H32); const bf16_t* Y = (const bf16_t*)(p.ws + OFF_Y); const float* wbuf = (const float*)(p.ws + OFF_WBUF);
    for (int t = bid * 8 + wave; t < T; t += nblk * 8) {
        float v[16];
#pragma unroll
        for (int j = 0; j < 4; ++j) { const float4 a = ((const float4*)(h32 + (size_t)t * D))[lane + 64 * j]; v[4 * j] = ALPHA * a.x; v[4 * j + 1] = ALPHA * a.y; v[4 * j + 2] = ALPHA * a.z; v[4 * j + 3] = ALPHA * a.w; }
#pragma unroll
        for (int k = 0; k < 9; ++k) {
            const size_t row = k < 8 ? (size_t)t * TOPK + k : (size_t)A_TOT + t; const float w = k < 8 ? wbuf[(size_t)t * TOPK + k] : 1.f;
#pragma unroll
            for (int j = 0; j < 4; ++j) {
                const uint2 y = ((const uint2*)(Y + row * D))[lane + 64 * j];
                v[4 * j] += w * __uint_as_float(y.x << 16); v[4 * j + 1] += w * __uint_as_float(y.x & 0xffff0000u);
                v[4 * j + 2] += w * __uint_as_float(y.y << 16); v[4 * j + 3] += w * __uint_as_float(y.y & 0xffff0000u);
            }
        }
        ln_row(v, p.ln2_g, p.ln2_b, lane);
#pragma unroll
        for (int j = 0; j < 4; ++j) ((float4*)(p.out + (size_t)t * D))[lane + 64 * j] = make_float4(v[4 * j], v[4 * j + 1], v[4 * j + 2], v[4 * j + 3]);
    }
}

#define LAS __attribute__((address_space(3)))
#define XB_TMO      128
#define XB_XCNT(j)  (256  + 64 * (j))
#define XB_XSUB(j)  (1280 + 64 * (j))
#define XB_XGEN(j)  (2304 + 64 * (j))
#define XB_TOP      3328
#define XB_TOPGEN   3392
#define XCD_BAR_WORDS 3456
#define XB_SPIN_CAP (1u << 22)
constexpr int CW_BAR = 4096;
DI unsigned xb_ld(unsigned* p) { return __hip_atomic_load(p, __ATOMIC_RELAXED, __HIP_MEMORY_SCOPE_AGENT); }
DI unsigned xb_add(unsigned* p, unsigned v) { return __hip_atomic_fetch_add(p, v, __ATOMIC_RELAXED, __HIP_MEMORY_SCOPE_AGENT); }
DI unsigned xb_xcc_id() { return (unsigned)__builtin_amdgcn_s_getreg((3 << 11) | 20) & 0xFu; }
#define XB_SPIN(cond, bar) do { unsigned _sp = 0; while (cond) { __builtin_amdgcn_s_sleep(1); \
    if ((++_sp & 255u) == 0u) { if (xb_ld(&(bar)[XB_TMO])) break; if (_sp > XB_SPIN_CAP) { atomicAdd(&(bar)[XB_TMO], 1u); break; } } } } while (0)
struct XcdBarrier { unsigned* bar; unsigned x; volatile LAS unsigned* st; };
DI XcdBarrier xcd_barrier_post(unsigned* bar, volatile LAS unsigned* st) {
    XcdBarrier b; b.bar = bar; b.x = xb_xcc_id(); b.st = st;
    if (threadIdx.x == 0) (void)xb_add(&bar[XB_XCNT(b.x)], 1u);
    return b;
}
DI void xcd_barrier_complete(unsigned* bar, unsigned x, unsigned& nloc, unsigned& nx) {
    const unsigned G = gridDim.x * gridDim.y * gridDim.z;
    unsigned sum, cnt, mine, sp = 0u;
    for (;;) {
        sum = 0u; cnt = 0u; mine = 0u;
#pragma unroll
        for (unsigned j = 0; j < 16; ++j) { const unsigned c = xb_ld(&bar[XB_XCNT(j)]); sum += c; cnt += (c > 0u) ? 1u : 0u; mine = (j == x) ? c : mine; }
        if (sum == G) break;
        __builtin_amdgcn_s_sleep(1);
        if ((++sp & 255u) == 0u) { if (xb_ld(&bar[XB_TMO])) break; if (sp > XB_SPIN_CAP) { atomicAdd(&bar[XB_TMO], 1u); break; } }
    }
    nloc = mine > 0u ? mine : 1u; nx = cnt > 0u ? cnt : 1u;
}
DI void xcd_barrier(const XcdBarrier& b) {
    asm volatile("s_waitcnt vmcnt(0)" ::: "memory");
    __syncthreads();
    if (threadIdx.x == 0) {
        unsigned* bar = b.bar;
        __builtin_amdgcn_s_waitcnt(0);
        unsigned nloc = b.st[0], nx = b.st[1];
        if (nloc == 0u) { xcd_barrier_complete(bar, b.x, nloc, nx); b.st[0] = nloc; b.st[1] = nx; }
        const unsigned old = xb_add(&bar[XB_XSUB(b.x)], 1u);
        const unsigned gen = old / nloc;
        if (old + 1u == (gen + 1u) * nloc) {
            __builtin_amdgcn_fence(__ATOMIC_RELEASE, "agent");
            asm volatile("s_waitcnt vmcnt(0)" ::: "memory");
            const unsigned og = xb_add(&bar[XB_TOP], 1u);
            const unsigned tg = og / nx;
            if (og + 1u == (tg + 1u) * nx) xb_add(&bar[XB_TOPGEN], 1u);
            else XB_SPIN(xb_ld(&bar[XB_TOPGEN]) == tg, bar);
            __builtin_amdgcn_fence(__ATOMIC_ACQUIRE, "agent");
            xb_add(&bar[XB_XGEN(b.x)], 1u);
            asm volatile("s_waitcnt vmcnt(0)" ::: "memory");
        } else {
            XB_SPIN(xb_ld(&bar[XB_XGEN(b.x)]) == gen, bar);
            __builtin_amdgcn_fence(__ATOMIC_ACQUIRE, "agent");
            asm volatile("s_waitcnt vmcnt(0)" ::: "memory");
        }
    }
    __syncthreads();
}

constexpr int LDS_BYTES = 120 * 1024;
constexpr int LDS_BAR_OFF = LDS_BYTES - 16;
__global__ void __launch_bounds__(NT) fwd_megakernel(Params p) {
    extern __shared__ __attribute__((aligned(16))) float lds[];
    const int bid = blockIdx.x, nblk = gridDim.x;
    volatile LAS unsigned* st = (volatile LAS unsigned*)((LAS unsigned char*)lds + LDS_BAR_OFF);
    if (threadIdx.x < 4) st[threadIdx.x] = 0u;
    __syncthreads();
    XcdBarrier bar = xcd_barrier_post((unsigned*)(p.ws + OFF_CTL) + CW_BAR, st);
    phase_prep(p, bid, nblk, lds);      xcd_barrier(bar);
    phase_proj(p, bid, nblk, lds);      xcd_barrier(bar);
    phase_pool(p, bid, nblk, lds);
    phase_gla1(p, bid, nblk, lds);      xcd_barrier(bar);
    phase_gla2(p, bid, nblk, lds);      xcd_barrier(bar);
    phase_gla3(p, bid, nblk, lds);      xcd_barrier(bar);
    phase_out(p, bid, nblk, lds);       xcd_barrier(bar);
    phase_ln1(p, bid, nblk, lds);       xcd_barrier(bar);
    phase_router(p, bid, nblk, lds);    xcd_barrier(bar);
    phase_topk(p, bid, nblk, lds);      xcd_barrier(bar);
    phase_e1(p, bid, nblk, lds);        xcd_barrier(bar);
    phase_e2(p, bid, nblk, lds);        xcd_barrier(bar);
    phase_combine(p, bid, nblk, lds);
}

extern "C" void kernel_launch(void* const* d_in, const int* in_sizes, int n_in, void* d_out, int out_size, void* d_ws, size_t ws_size, hipStream_t stream) {
    static int grid = 0;
    if (grid == 0) {
        if (n_in != 20 || ws_size < WS_NEED) { fprintf(stderr, "kernel_launch: unexpected n_in %d or ws_size %zu (< %zu)\n", n_in, ws_size, (size_t)WS_NEED); grid = -1; return; }
        int dev = 0, cus = 0, per_cu = 0;
        (void)hipGetDevice(&dev); (void)hipDeviceGetAttribute(&cus, hipDeviceAttributeMultiprocessorCount, dev);
        (void)hipFuncSetAttribute((const void*)fwd_megakernel, hipFuncAttributeMaxDynamicSharedMemorySize, LDS_BYTES);
        (void)hipOccupancyMaxActiveBlocksPerMultiprocessor(&per_cu, (const void*)fwd_megakernel, NT, LDS_BYTES);
        if (per_cu < 1 || cus < 1) { fprintf(stderr, "kernel_launch: occupancy query says %d blocks/CU on %d CUs\n", per_cu, cus); grid = -1; return; }
        grid = cus;
    }
    if (grid < 0) return;
    (void)hipMemsetAsync((char*)d_ws + OFF_CTL, 0, 64 * 1024, stream);
    Params p{};
    const float** pp = (const float**)&p;
    for (int i = 0; i < 20; ++i) pp[i] = (const float*)d_in[i];
    p.out = (float*)d_out; p.ws = (unsigned char*)d_ws;
    void* args[] = {&p};
    hipError_t e = hipLaunchCooperativeKernel((const void*)fwd_megakernel, dim3(grid), dim3(NT), args, LDS_BYTES, stream);
    if (e != hipSuccess) fprintf(stderr, "cooperative launch failed: %s (grid %d)\n", hipGetErrorString(e), grid);
}
```

```cpp
#include <hip/hip_runtime.h>
#include <stdint.h>
#include <cstdio>

#define DI __device__ __forceinline__
typedef unsigned short bf16_t;

constexpr int T = 16384, D = 1024, SEQ = 4096;
constexpr int DIN = 2064, NPROJ = 2048;
constexpr int P_OFF = 0, Q_OFF = 512, K_OFF = 768, V_OFF = 1024, R_OFF = 1536, GL_OFF = 2048;
constexpr int SC = 64;
constexpr int NSC = SEQ / SC;
constexpr int NE = 256, TOPK = 8, EDIM = 256;
constexpr int A_TOT = T * TOPK;
constexpr int LCAP = T;
constexpr float ALPHA = 1.189207115002721f;
constexpr float LN_EPS = 1e-5f, RMS_EPS = 1e-5f;
constexpr int NT = 512;

constexpr size_t MiB = 1u << 20;
constexpr size_t OFF_CTL = 0;
constexpr size_t OFF_XB = 1 * MiB;
constexpr size_t OFF_GLOW = OFF_XB + 32 * MiB;
constexpr size_t OFF_PROJ = OFF_GLOW + 1 * MiB;
constexpr size_t OFF_G = OFF_PROJ + 64 * MiB;
constexpr size_t OFF_SLOC = OFF_G + 16 * MiB;
constexpr size_t OFF_DEC = OFF_SLOC + 32 * MiB;
constexpr size_t OFF_SIN = OFF_DEC + 1 * MiB;
constexpr size_t OFF_MIX = OFF_SIN + 32 * MiB;
constexpr size_t OFF_H32 = OFF_MIX + 32 * MiB;
constexpr size_t OFF_HB = OFF_H32 + 64 * MiB;
constexpr size_t OFF_SCORES = OFF_HB + 32 * MiB;
constexpr size_t OFF_WBUF = OFF_SCORES + 16 * MiB;
constexpr size_t OFF_LIST = OFF_WBUF + 1 * MiB;
constexpr size_t OFF_HID = OFF_LIST + 16 * MiB;
constexpr size_t OFF_Y = OFF_HID + 76 * MiB;
constexpr size_t OFF_PM = OFF_Y + 304 * MiB;
constexpr size_t WS_NEED = OFF_PM + 16 * MiB;
constexpr int CW_CNT = 1024;

struct Params {
    const float *x, *w_in, *gate_w2, *gate_b, *norm_w, *pool_w, *pool_scale, *w_out, *ln1_g, *ln1_b;
    const float *router_w, *router_bias, *wg, *wu, *wd, *sg, *su, *sd, *ln2_g, *ln2_b;
    float* out;
    unsigned char* ws;
};

DI float bf2f(bf16_t v) { return __uint_as_float(((unsigned)v) << 16); }
DI bf16_t f2bf(float f) { unsigned u = __float_as_uint(f); u += 0x7fffu + ((u >> 16) & 1u); return (bf16_t)(u >> 16); }
DI unsigned pk2(float lo, float hi) { return (unsigned)f2bf(lo) | ((unsigned)f2bf(hi) << 16); }
DI float wave_sum(float v) {
#pragma unroll
    for (int o = 1; o < 64; o <<= 1) v += __shfl_xor(v, o);
    return v;
}
DI float sigmoidf_(float v) { return 1.f / (1.f + __expf(-v)); }
DI float logsigmoidf_(float z) { return fminf(z, 0.f) - log1pf(__expf(-fabsf(z))); }

constexpr int GT_LDS_FLOATS = 16 * 132 + 2 * 16 * 68;
template <bool DUAL, class AF, class BF, class EPI>
DI void gemm_tile_valu(int K, const AF& af, const BF& bfn, const EPI& epi, float* lds) {
    float* As = lds; float* Bs = lds + 16 * 132; float* Bs2 = Bs + 16 * 68;
    const int tid = threadIdx.x, ty = tid >> 4, tx = tid & 15;
    float acc[4][4], acc2[4][4];
#pragma unroll
    for (int i = 0; i < 4; ++i)
#pragma unroll
        for (int j = 0; j < 4; ++j) { acc[i][j] = 0.f; acc2[i][j] = 0.f; }
    for (int k0 = 0; k0 < K; k0 += 16) {
#pragma unroll
        for (int i = 0; i < 4; ++i) { const int e = tid + 512 * i, r = e >> 4, kk = e & 15; As[kk * 132 + r] = af(r, k0 + kk); }
#pragma unroll
        for (int i = 0; i < 2; ++i) { const int e = tid + 512 * i, kk = e >> 6, c = e & 63; Bs[kk * 68 + c] = bfn(0, k0 + kk, c); if (DUAL) Bs2[kk * 68 + c] = bfn(1, k0 + kk, c); }
        __syncthreads();
#pragma unroll
        for (int kk = 0; kk < 16; ++kk) {
            const float4 a = *(const float4*)&As[kk * 132 + ty * 4];
            const float4 b = *(const float4*)&Bs[kk * 68 + tx * 4];
            const float av[4] = {a.x, a.y, a.z, a.w}, bv[4] = {b.x, b.y, b.z, b.w};
#pragma unroll
            for (int i = 0; i < 4; ++i)
#pragma unroll
                for (int j = 0; j < 4; ++j) acc[i][j] += av[i] * bv[j];
            if (DUAL) {
                const float4 b2 = *(const float4*)&Bs2[kk * 68 + tx * 4];
                const float b2v[4] = {b2.x, b2.y, b2.z, b2.w};
#pragma unroll
                for (int i = 0; i < 4; ++i)
#pragma unroll
                    for (int j = 0; j < 4; ++j) acc2[i][j] += av[i] * b2v[j];
            }
        }
        __syncthreads();
    }
#pragma unroll
    for (int i = 0; i < 4; ++i)
#pragma unroll
        for (int j = 0; j < 4; ++j) epi(ty * 4 + i, tx * 4 + j, acc[i][j], acc2[i][j]);
}


typedef __bf16 bf16x8 __attribute__((ext_vector_type(8)));
typedef float f32x16 __attribute__((ext_vector_type(16)));
typedef float f32x4 __attribute__((ext_vector_type(4)));
template <int BM, bool DUAL, int LDB, int WN, class RowFn, class Epi>
DI void gemm_mfma(const bf16_t* Ab, const RowFn& rowoff, const float* B0, const float* B1, int K, const Epi& epi, unsigned char* lds) {
    constexpr int MT = BM / 32, NI = BM / 64, BUFB = BM * 128;
    const int tid = threadIdx.x, lane = tid & 63, w = __builtin_amdgcn_readfirstlane(tid >> 6), h = lane >> 5, l31 = lane & 31;
    const bool active = w < WN;
    unsigned aoff[NI];
#pragma unroll
    for (int i = 0; i < NI; ++i) aoff[i] = rowoff((tid >> 3) + 64 * i) + (tid & 7) * 8;
    const unsigned wr0 = (tid >> 3) * 128 + (((tid & 7) ^ ((tid >> 4) & 7)) << 4);
    const unsigned rdbase = l31 * 128, sw = (l31 >> 1) & 7;
    const float* bp;
    if (DUAL) bp = ((lane & 16) ? B1 : B0) + w * 16 + (lane & 15) + (size_t)(8 * h) * LDB;
    else bp = B0 + w * 32 + l31 + (size_t)(8 * h) * LDB;
    f32x16 acc[MT];
#pragma unroll
    for (int i = 0; i < MT; ++i)
#pragma unroll
        for (int r = 0; r < 16; ++r) acc[i][r] = 0.f;
    uint4 areg[NI]; float breg[4][8];
    const int nk = K / 64;
#pragma unroll
    for (int i = 0; i < NI; ++i) areg[i] = *(const uint4*)(Ab + aoff[i]);
    if (active) {
#pragma unroll
        for (int s = 0; s < 4; ++s)
#pragma unroll
            for (int j = 0; j < 8; ++j) breg[s][j] = bp[(size_t)(s * 16 + j) * LDB];
    }
#pragma unroll
    for (int i = 0; i < NI; ++i) *(uint4*)(lds + wr0 + i * 8192) = areg[i];
    __syncthreads();
    for (int kt = 0; kt < nk; ++kt) {
        const unsigned char* buf = lds + (kt & 1) * BUFB;
        unsigned char* nbuf = lds + ((kt + 1) & 1) * BUFB;
        const bool more = kt + 1 < nk;
        if (more) {
#pragma unroll
            for (int i = 0; i < NI; ++i) areg[i] = *(const uint4*)(Ab + aoff[i] + (kt + 1) * 64);
        }
        if (active) {
#pragma unroll
            for (int s = 0; s < 4; ++s) {
                bf16x8 bfrag;
#pragma unroll
                for (int j = 0; j < 8; ++j) bfrag[j] = (__bf16)breg[s][j];
                if (more) {
#pragma unroll
                    for (int j = 0; j < 8; ++j) breg[s][j] = bp[(size_t)((kt + 1) * 64 + s * 16 + j) * LDB];
                }
                const unsigned ro = rdbase + ((((unsigned)(2 * s + h)) ^ sw) << 4);
#pragma unroll
                for (int mi = 0; mi < MT; ++mi) {
                    const bf16x8 af = *(const bf16x8*)(buf + mi * 4096 + ro);
                    acc[mi] = __builtin_amdgcn_mfma_f32_32x32x16_bf16(bfrag, af, acc[mi], 0, 0, 0);
                }
            }
        }
        if (more) {
#pragma unroll
            for (int i = 0; i < NI; ++i) *(uint4*)(nbuf + wr0 + i * 8192) = areg[i];
        }
        __syncthreads();
    }
    if (active) {
#pragma unroll
        for (int mi = 0; mi < MT; ++mi) {
            const int row = mi * 32 + l31;
            if (DUAL) {
#pragma unroll
                for (int q = 0; q < 2; ++q) {
                    const f32x4 g = {acc[mi][4 * q], acc[mi][4 * q + 1], acc[mi][4 * q + 2], acc[mi][4 * q + 3]};
                    const f32x4 u = {acc[mi][8 + 4 * q], acc[mi][9 + 4 * q], acc[mi][10 + 4 * q], acc[mi][11 + 4 * q]};
                    epi(row, w * 16 + 8 * q + 4 * h, g, u);
                }
            } else {
#pragma unroll
                for (int q = 0; q < 4; ++q) {
                    const f32x4 v = {acc[mi][4 * q], acc[mi][4 * q + 1], acc[mi][4 * q + 2], acc[mi][4 * q + 3]};
                    epi(row, w * 32 + 8 * q + 4 * h, v, v);
                }
            }
            asm volatile("" ::: "memory");
        }
    }
}

DI void phase_prep(const Params& p, int bid, int nblk, float* lds) {
    const int lane = threadIdx.x & 63, wave = threadIdx.x >> 6;
    bf16_t* xb = (bf16_t*)(p.ws + OFF_XB); float* glow = (float*)(p.ws + OFF_GLOW);
    for (int row = bid * 8 + wave; row < T; row += nblk * 8) {
        const float4* xr = (const float4*)(p.x + (size_t)row * D);
        float acc[16];
#pragma unroll
        for (int n = 0; n < 16; ++n) acc[n] = 0.f;
#pragma unroll
        for (int j = 0; j < 4; ++j) {
            const float4 v = xr[lane + 64 * j];
            uint2 o; o.x = pk2(v.x, v.y); o.y = pk2(v.z, v.w);
            ((uint2*)(xb + (size_t)row * D))[lane + 64 * j] = o;
            const float vv[4] = {v.x, v.y, v.z, v.w};
#pragma unroll
            for (int c = 0; c < 4; ++c) {
                const int col = 4 * (lane + 64 * j) + c;
                const float4* wr = (const float4*)(p.w_in + (size_t)col * DIN + GL_OFF);
#pragma unroll
                for (int q = 0; q < 4; ++q) { const float4 w = wr[q]; acc[4 * q] += vv[c] * w.x; acc[4 * q + 1] += vv[c] * w.y; acc[4 * q + 2] += vv[c] * w.z; acc[4 * q + 3] += vv[c] * w.w; }
            }
        }
        float mine = 0.f;
#pragma unroll
        for (int n = 0; n < 16; ++n) { const float s = wave_sum(acc[n]); if (lane == n) mine = s; }
        if (lane < 16) glow[(size_t)row * 16 + lane] = mine;
    }
}

DI void phase_proj(const Params& p, int bid, int nblk, float* lds) {
    const bf16_t* xb = (const bf16_t*)(p.ws + OFF_XB); bf16_t* proj = (bf16_t*)(p.ws + OFF_PROJ);
    for (int u = bid; u < 64 * 8; u += nblk) {
        const int mt = u >> 3, nt = u & 7;
        auto rowoff = [&](int r) { return (unsigned)((mt * 256 + r) * D); };
        auto epi = [&](int r, int c, f32x4 v, f32x4) { uint2 o; o.x = pk2(v[0], v[1]); o.y = pk2(v[2], v[3]); *(uint2*)(proj + (size_t)(mt * 256 + r) * NPROJ + nt * 256 + c) = o; };
        gemm_mfma<256, false, DIN, 8>(xb, rowoff, p.w_in + nt * 256, nullptr, D, epi, (unsigned char*)lds);
    }
}

DI void phase_poolmean(const Params& p, int bid, int nblk, float* lds) {
    const bf16_t* proj = (const bf16_t*)(p.ws + OFF_PROJ); bf16_t* pm = (bf16_t*)(p.ws + OFF_PM);
    for (int e = bid * NT + threadIdx.x; e < T * 256; e += nblk * NT) {
        const int t = e >> 8, c2 = (e & 255) * 2, g = c2 >> 7, w = 2 << g, s = t & (SEQ - 1), cnt = min(s + 1, w);
        const unsigned* pp = (const unsigned*)(proj + (size_t)t * NPROJ + P_OFF + c2);
        const unsigned own = pp[0]; float s0 = 0.f, s1 = 0.f;
        for (int j = 0; j < cnt; ++j) { const unsigned v = pp[-(ptrdiff_t)j * (NPROJ / 2)]; s0 += __uint_as_float(v << 16); s1 += __uint_as_float(v & 0xffff0000u); }
        const float inv = 1.f / (float)cnt;
        *(unsigned*)(pm + (size_t)t * 512 + c2) = pk2(s0 * inv - __uint_as_float(own << 16), s1 * inv - __uint_as_float(own & 0xffff0000u));
    }
}
DI void phase_pool(const Params& p, int bid, int nblk, float* lds) {
    const bf16_t* pm = (const bf16_t*)(p.ws + OFF_PM); bf16_t* mix = (bf16_t*)(p.ws + OFF_MIX);
    for (int u = bid; u < 64 * 4; u += nblk) {
        const int mt = u >> 2, g = u & 3;
        auto rowoff = [&](int r) { return (unsigned)((mt * 256 + r) * 512 + g * 128); };
        auto epi = [&](int r, int c, f32x4 v, f32x4) { const int col = g * 128 + c; const float4 sc = *(const float4*)(p.pool_scale + col); uint2 o; o.x = pk2(v[0] * sc.x, v[1] * sc.y); o.y = pk2(v[2] * sc.z, v[3] * sc.w); *(uint2*)(mix + (size_t)(mt * 256 + r) * D + col) = o; };
        gemm_mfma<256, false, 128, 4>(pm, rowoff, p.pool_w + (size_t)g * 16384, nullptr, 128, epi, (unsigned char*)lds);
    }
}

constexpr int GLA1_LDS_FLOATS = 4096 * 2 + 8192;
DI void phase_gla1(const Params& p, int bid, int nblk, float* lds) {
    const int tid = threadIdx.x;
    const bf16_t* proj = (const bf16_t*)(p.ws + OFF_PROJ); const float* glow = (const float*)(p.ws + OFF_GLOW);
    float* Gbuf = (float*)(p.ws + OFF_G); float* Sloc = (float*)(p.ws + OFF_SLOC); float* dec = (float*)(p.ws + OFF_DEC);
    float* G = lds; float* Kh = lds + 4096; float* V = lds + 8192;
    for (int unit = bid; unit < 1024; unit += nblk) {
        const int bh = unit >> 6, n = unit & 63, b = bh >> 2, h = bh & 3, t0 = b * SEQ + n * SC;
        for (int e = tid; e < 4096; e += NT) {
            const int i = e >> 6, d = e & 63;
            float z = p.gate_b[h * 64 + d];
#pragma unroll
            for (int r = 0; r < 16; ++r) z += glow[(size_t)(t0 + i) * 16 + r] * p.gate_w2[r * 256 + h * 64 + d];
            G[e] = logsigmoidf_(z) * (1.f / 16.f);
        }
        __syncthreads();
        if (tid < 64) { float run = 0.f; for (int i = 0; i < 64; ++i) { run += G[i * 64 + tid]; G[i * 64 + tid] = run; } }
        __syncthreads();
        for (int e = tid; e < 4096; e += NT) {
            const int i = e >> 6, d = e & 63; const float g = G[e], gl = G[63 * 64 + d];
            Gbuf[(size_t)(t0 + i) * 256 + h * 64 + d] = g;
            Kh[e] = bf2f(proj[(size_t)(t0 + i) * NPROJ + K_OFF + h * 64 + d]) * __expf(gl - g);
        }
        for (int e = tid; e < 8192; e += NT) { const int i = e >> 7, c = e & 127; V[e] = bf2f(proj[(size_t)(t0 + i) * NPROJ + V_OFF + h * 128 + c]); }
        if (tid < 64) dec[unit * 64 + tid] = __expf(G[63 * 64 + tid]);
        __syncthreads();
        {
            const int d = tid >> 3, e0 = (tid & 7) * 16; float acc[16];
#pragma unroll
            for (int c = 0; c < 16; ++c) acc[c] = 0.f;
            for (int i = 0; i < 64; ++i) { const float a = Kh[i * 64 + d];
#pragma unroll
                for (int c = 0; c < 16; ++c) acc[c] += a * V[i * 128 + e0 + c]; }
#pragma unroll
            for (int c = 0; c < 16; ++c) Sloc[(size_t)unit * 8192 + d * 128 + e0 + c] = acc[c];
        }
        __syncthreads();
    }
}

DI void phase_gla2(const Params& p, int bid, int nblk, float* lds) {
    const float* Sloc = (const float*)(p.ws + OFF_SLOC); const float* dec = (const float*)(p.ws + OFF_DEC); float* Sin = (float*)(p.ws + OFF_SIN);
    for (int gid = bid * NT + threadIdx.x; gid < 16 * 8192; gid += nblk * NT) {
        const int bh = gid >> 13, el = gid & 8191, d = el >> 7; float st = 0.f;
        for (int n = 0; n < NSC; ++n) { const int u = bh * 64 + n; Sin[(size_t)u * 8192 + el] = st; st = st * dec[u * 64 + d] + Sloc[(size_t)u * 8192 + el]; }
    }
}

constexpr int GLA3_LDS_FLOATS = 64 * 65 * 2 + 4096 + 8192 * 2;
DI void phase_gla3(const Params& p, int bid, int nblk, float* lds) {
    const int tid = threadIdx.x;
    const bf16_t* proj = (const bf16_t*)(p.ws + OFF_PROJ); const float* Gbuf = (const float*)(p.ws + OFF_G); const float* Sin = (const float*)(p.ws + OFF_SIN);
    bf16_t* mix = (bf16_t*)(p.ws + OFF_MIX);
    float* Qt = lds; float* Kt = lds + 64 * 65; float* P = lds + 2 * 64 * 65; float* V = P + 4096; float* Sn = V + 8192;
    for (int unit = bid; unit < 1024; unit += nblk) {
        const int bh = unit >> 6, n = unit & 63, b = bh >> 2, h = bh & 3, t0 = b * SEQ + n * SC;
        for (int e = tid; e < 4096; e += NT) {
            const int i = e >> 6, d = e & 63; const float g = Gbuf[(size_t)(t0 + i) * 256 + h * 64 + d];
            const float q = bf2f(proj[(size_t)(t0 + i) * NPROJ + Q_OFF + h * 64 + d]), k = bf2f(proj[(size_t)(t0 + i) * NPROJ + K_OFF + h * 64 + d]);
            Qt[i * 65 + d] = q * 0.125f * __expf(g); Kt[i * 65 + d] = k * __expf(-g);
        }
        for (int e = tid; e < 8192; e += NT) { const int i = e >> 7, c = e & 127; V[e] = bf2f(proj[(size_t)(t0 + i) * NPROJ + V_OFF + h * 128 + c]); Sn[e] = Sin[(size_t)unit * 8192 + e]; }
        __syncthreads();
        for (int e = tid; e < 4096; e += NT) {
            const int i = e >> 6, j = e & 63; float v = 0.f;
            if (j <= i) for (int d = 0; d < 64; ++d) v += Qt[i * 65 + d] * Kt[j * 65 + d];
            P[e] = v;
        }
        __syncthreads();
        {
            const int i = tid >> 3, e0 = (tid & 7) * 16; float acc[16];
#pragma unroll
            for (int c = 0; c < 16; ++c) acc[c] = 0.f;
            for (int j = 0; j <= i; ++j) { const float pv = P[i * 64 + j];
#pragma unroll
                for (int c = 0; c < 16; ++c) acc[c] += pv * V[j * 128 + e0 + c]; }
            for (int d = 0; d < 64; ++d) { const float qv = Qt[i * 65 + d];
#pragma unroll
                for (int c = 0; c < 16; ++c) acc[c] += qv * Sn[d * 128 + e0 + c]; }
            float ss = 0.f;
#pragma unroll
            for (int c = 0; c < 16; ++c) ss += acc[c] * acc[c];
            ss += __shfl_xor(ss, 1); ss += __shfl_xor(ss, 2); ss += __shfl_xor(ss, 4);
            const float inv = rsqrtf(ss * (1.f / 128.f) + RMS_EPS);
#pragma unroll
            for (int c = 0; c < 16; ++c) {
                const int col = h * 128 + e0 + c; const float rv = bf2f(proj[(size_t)(t0 + i) * NPROJ + R_OFF + col]);
                mix[(size_t)(t0 + i) * D + 512 + col] = f2bf(acc[c] * inv * p.norm_w[e0 + c] * (rv * sigmoidf_(rv)));
            }
        }
        __syncthreads();
    }
}

DI void phase_out(const Params& p, int bid, int nblk, float* lds) {
    const bf16_t* mix = (const bf16_t*)(p.ws + OFF_MIX); float* h32 = (float*)(p.ws + OFF_H32);
    for (int u = bid; u < 64 * 4; u += nblk) {
        const int mt = u >> 2, nt = u & 3;
        auto rowoff = [&](int r) { return (unsigned)((mt * 256 + r) * D); };
        auto epi = [&](int r, int c, f32x4 v, f32x4) { const size_t o = (size_t)(mt * 256 + r) * D + nt * 256 + c; const float4 xv = *(const float4*)(p.x + o); *(float4*)(h32 + o) = make_float4(ALPHA * xv.x + v[0], ALPHA * xv.y + v[1], ALPHA * xv.z + v[2], ALPHA * xv.w + v[3]); };
        gemm_mfma<256, false, D, 8>(mix, rowoff, p.w_out + nt * 256, nullptr, D, epi, (unsigned char*)lds);
    }
}

DI void ln_row(float (&v)[16], const float* g, const float* b, int lane) {
    float s = 0.f;
#pragma unroll
    for (int i = 0; i < 16; ++i) s += v[i];
    const float mean = wave_sum(s) * (1.f / D); float q = 0.f;
#pragma unroll
    for (int i = 0; i < 16; ++i) { v[i] -= mean; q += v[i] * v[i]; }
    const float rstd = rsqrtf(wave_sum(q) * (1.f / D) + LN_EPS);
#pragma unroll
    for (int j = 0; j < 4; ++j) {
        const float4 gg = ((const float4*)g)[lane + 64 * j], bb = ((const float4*)b)[lane + 64 * j];
        v[4 * j] = v[4 * j] * rstd * gg.x + bb.x; v[4 * j + 1] = v[4 * j + 1] * rstd * gg.y + bb.y;
        v[4 * j + 2] = v[4 * j + 2] * rstd * gg.z + bb.z; v[4 * j + 3] = v[4 * j + 3] * rstd * gg.w + bb.w;
    }
}

DI void phase_ln1(const Params& p, int bid, int nblk, float* lds) {
    const int lane = threadIdx.x & 63, wave = threadIdx.x >> 6;
    float* h32 = (float*)(p.ws + OFF_H32); bf16_t* hb = (bf16_t*)(p.ws + OFF_HB);
    for (int row = bid * 8 + wave; row < T; row += nblk * 8) {
        float4* hr = (float4*)(h32 + (size_t)row * D); float v[16];
#pragma unroll
        for (int j = 0; j < 4; ++j) { const float4 a = hr[lane + 64 * j]; v[4 * j] = a.x; v[4 * j + 1] = a.y; v[4 * j + 2] = a.z; v[4 * j + 3] = a.w; }
        ln_row(v, p.ln1_g, p.ln1_b, lane);
#pragma unroll
        for (int j = 0; j < 4; ++j) {
            hr[lane + 64 * j] = make_float4(v[4 * j], v[4 * j + 1], v[4 * j + 2], v[4 * j + 3]);
            uint2 o; o.x = pk2(v[4 * j], v[4 * j + 1]); o.y = pk2(v[4 * j + 2], v[4 * j + 3]);
            ((uint2*)(hb + (size_t)row * D))[lane + 64 * j] = o;
        }
    }
}

DI void phase_router(const Params& p, int bid, int nblk, float* lds) {
    const bf16_t* hb = (const bf16_t*)(p.ws + OFF_HB); float* scores = (float*)(p.ws + OFF_SCORES);
    for (int u = bid; u < 128; u += nblk) {
        const int mt = u;
        auto rowoff = [&](int r) { return (unsigned)((mt * 128 + r) * D); };
        auto epi = [&](int r, int c, f32x4 v, f32x4) { *(float4*)(scores + (size_t)(mt * 128 + r) * NE + c) = make_float4(sigmoidf_(v[0]), sigmoidf_(v[1]), sigmoidf_(v[2]), sigmoidf_(v[3])); };
        gemm_mfma<128, false, NE, 8>(hb, rowoff, p.router_w, nullptr, D, epi, (unsigned char*)lds);
    }
}

DI void phase_topk(const Params& p, int bid, int nblk, float* lds) {
    const int lane = threadIdx.x & 63, wave = threadIdx.x >> 6;
    const float* scores = (const float*)(p.ws + OFF_SCORES); float* wbuf = (float*)(p.ws + OFF_WBUF);
    int* list = (int*)(p.ws + OFF_LIST); unsigned* cnt = (unsigned*)(p.ws + OFF_CTL) + CW_CNT;
    const float NEG = -__builtin_inff();
    for (int t = bid * 8 + wave; t < T; t += nblk * 8) {
        const float4 sv = ((const float4*)(scores + (size_t)t * NE))[lane], bv = ((const float4*)p.router_bias)[lane];
        const float s[4] = {sv.x, sv.y, sv.z, sv.w};
        float cand[4] = {sv.x + bv.x, sv.y + bv.y, sv.z + bv.z, sv.w + bv.w};
        float m1 = NEG, m2 = NEG;
#pragma unroll
        for (int j = 0; j < 4; ++j) { const float v = cand[j]; if (v > m1) { m2 = m1; m1 = v; } else if (v > m2) m2 = v; }
#pragma unroll
        for (int off = 1; off < 8; off <<= 1) {
            const float o1 = __shfl_xor(m1, off), o2 = __shfl_xor(m2, off);
            const float n1 = fmaxf(m1, o1), n2 = fmaxf(fminf(m1, o1), fmaxf(m2, o2)); m1 = n1; m2 = n2;
        }
        const float gs = m1 + m2; const int mygrp = lane >> 3; int rank = 0;
#pragma unroll
        for (int g2 = 0; g2 < 8; ++g2) { const float og = __shfl(gs, g2 * 8); if (og > gs || (og == gs && g2 < mygrp)) ++rank; }
        if (rank >= 4) { cand[0] = NEG; cand[1] = NEG; cand[2] = NEG; cand[3] = NEG; }
        int my_e = 0; float my_w = 0.f, wsum = 0.f;
#pragma unroll
        for (int k = 0; k < TOPK; ++k) {
            float bvv = cand[0]; int bj = 0;
#pragma unroll
            for (int j = 1; j < 4; ++j) if (cand[j] > bvv) { bvv = cand[j]; bj = j; }
            int bi = 4 * lane + bj;
#pragma unroll
            for (int off = 32; off >= 1; off >>= 1) {
                const float ov = __shfl_xor(bvv, off); const int oi = __shfl_xor(bi, off);
                if (ov > bvv || (ov == bvv && oi < bi)) { bvv = ov; bi = oi; }
            }
            const int wj = bi & 3, wl = bi >> 2;
            const float mys = wj == 0 ? s[0] : (wj == 1 ? s[1] : (wj == 2 ? s[2] : s[3]));
            const float wk = __shfl(mys, wl);
            wsum += wk;
            if (lane == k) { my_e = bi; my_w = wk; }
            if (lane == wl) {
#pragma unroll
                for (int j = 0; j < 4; ++j) if (j == wj) cand[j] = NEG;
            }
        }
        if (lane < TOPK) {
            const unsigned pos = atomicAdd(&cnt[my_e], 1u);
            list[(size_t)my_e * LCAP + pos] = t * TOPK + lane;
            wbuf[(size_t)t * TOPK + lane] = my_w / wsum * 2.5f;
        }
    }
}

constexpr int EXP_TAB_OFF = 65536;
DI void build_tables(const Params& p, int* toff, int* roff) {
    const unsigned* cnt = (const unsigned*)(p.ws + OFF_CTL) + CW_CNT;
    if (threadIdx.x == 0) {
        int ta = 0, ra = 0;
        for (int e = 0; e < NE; ++e) { const int c = (int)cnt[e]; toff[e] = ta; roff[e] = ra; ta += (((c + 127) >> 7) + 1) >> 1; ra += c; }
        toff[NE] = ta; roff[NE] = ra;
    }
    __syncthreads();
}
DI int find_expert(const int* toff, int tile) { int lo = 0, hi = NE - 1; while (lo < hi) { const int mid = (lo + hi + 1) >> 1; if (toff[mid] <= tile) lo = mid; else hi = mid - 1; } return lo; }
struct ExpUnit { int e, row0, rows, bm, rowbase; };
DI ExpUnit exp_unit(const Params& p, const int* toff, const int* roff, int tile, int ntile) {
    const unsigned* cnt = (const unsigned*)(p.ws + OFF_CTL) + CW_CNT;
    ExpUnit u;
    if (tile < ntile) {
        u.e = find_expert(toff, tile); const int ui = tile - toff[u.e], c = (int)cnt[u.e];
        u.row0 = ui * 256; u.rows = min(256, c - u.row0); u.bm = u.rows > 128 ? 256 : 128; u.rowbase = roff[u.e] + u.row0;
    } else { u.e = NE; u.row0 = (tile - ntile) * 256; u.rows = 256; u.bm = 256; u.rowbase = A_TOT + u.row0; }
    u.e = __builtin_amdgcn_readfirstlane(u.e); u.row0 = __builtin_amdgcn_readfirstlane(u.row0); u.rows = __builtin_amdgcn_readfirstlane(u.rows);
    u.bm = __builtin_amdgcn_readfirstlane(u.bm); u.rowbase = __builtin_amdgcn_readfirstlane(u.rowbase);
    return u;
}

DI void phase_e1(const Params& p, int bid, int nblk, float* lds) {
    int* toff = (int*)((unsigned char*)lds + EXP_TAB_OFF); int* roff = toff + 260;
    const bf16_t* hb = (const bf16_t*)(p.ws + OFF_HB); bf16_t* hid = (bf16_t*)(p.ws + OFF_HID); const int* list = (const int*)(p.ws + OFF_LIST);
    build_tables(p, toff, roff);
    const int ntile = toff[NE], units = (ntile + T / 256) * 2;
    for (int u = bid; u < units; u += nblk) {
        const int tile = u >> 1, nt = u & 1;
        const ExpUnit x = exp_unit(p, toff, roff, tile, ntile);
        const float* wg = x.e < NE ? p.wg + (size_t)x.e * 262144 : p.sg; const float* wu = x.e < NE ? p.wu + (size_t)x.e * 262144 : p.su;
        auto rowoff = [&](int r) { const int tok = x.e < NE ? (r < x.rows ? (list[(size_t)x.e * LCAP + x.row0 + r] >> 3) : 0) : (x.row0 + r); return (unsigned)(tok * D); };
        auto epi = [&](int r, int c, f32x4 g, f32x4 uu) { if (r < x.rows) { uint2 o; o.x = pk2(g[0] * sigmoidf_(g[0]) * uu[0], g[1] * sigmoidf_(g[1]) * uu[1]); o.y = pk2(g[2] * sigmoidf_(g[2]) * uu[2], g[3] * sigmoidf_(g[3]) * uu[3]); *(uint2*)(hid + (size_t)(x.rowbase + r) * EDIM + nt * 128 + c) = o; } };
        if (x.bm == 256) gemm_mfma<256, true, EDIM, 8>(hb, rowoff, wg + nt * 128, wu + nt * 128, D, epi, (unsigned char*)lds);
        else gemm_mfma<128, true, EDIM, 8>(hb, rowoff, wg + nt * 128, wu + nt * 128, D, epi, (unsigned char*)lds);
    }
}

DI void phase_e2(const Params& p, int bid, int nblk, float* lds) {
    int* toff = (int*)((unsigned char*)lds + EXP_TAB_OFF); int* roff = toff + 260; int* rowa = roff + 260;
    const bf16_t* hid = (const bf16_t*)(p.ws + OFF_HID); bf16_t* Y = (bf16_t*)(p.ws + OFF_Y); const int* list = (const int*)(p.ws + OFF_LIST);
    build_tables(p, toff, roff);
    const int ntile = toff[NE], units = (ntile + T / 256) * 4;
    for (int u = bid; u < units; u += nblk) {
        const int tile = u >> 2, nt = u & 3;
        const ExpUnit x = exp_unit(p, toff, roff, tile, ntile);
        const float* wd = x.e < NE ? p.wd + (size_t)x.e * 262144 : p.sd;
        if (threadIdx.x < 256) { const int r = threadIdx.x; rowa[r] = x.e < NE ? (r < x.rows ? list[(size_t)x.e * LCAP + x.row0 + r] : 0) : (A_TOT + x.row0 + r); }
        __syncthreads();
        auto rowoff = [&](int r) { return (unsigned)((x.rowbase + min(r, x.rows - 1)) * EDIM); };
        auto epi = [&](int r, int c, f32x4 v, f32x4) { if (r < x.rows) { uint2 o; o.x = pk2(v[0], v[1]); o.y = pk2(v[2], v[3]); *(uint2*)(Y + (size_t)rowa[r] * D + nt * 256 + c) = o; } };
        if (x.bm == 256) gemm_mfma<256, false, D, 8>(hid, rowoff, wd + nt * 256, nullptr, EDIM, epi, (unsigned char*)lds);
        else gemm_mfma<128, false, D, 8>(hid, rowoff, wd + nt * 256, nullptr, EDIM, epi, (unsigned char*)lds);
        __syncthreads();
    }
}

DI void phase_combine(const Params& p, int bid, int nblk, float* lds) {
    const int lane = threadIdx.x & 63, wave = threadIdx.x >> 6;
    const float* h32 = (const float*)(p.ws + OFF_H32); const bf16_t* Y = (const bf16_t*)(p.ws + OFF_Y); const float* wbuf = (const float*)(p.ws + OFF_WBUF);
    for (int t = bid * 8 + wave; t < T; t += nblk * 8) {
        float v[16];
#pragma unroll
        for (int j = 0; j < 4; ++j) { const float4 a = ((const float4*)(h32 + (size_t)t * D))[lane + 64 * j]; v[4 * j] = ALPHA * a.x; v[4 * j + 1] = ALPHA * a.y; v[4 * j + 2] = ALPHA * a.z; v[4 * j + 3] = ALPHA * a.w; }
#pragma unroll
        for (int k = 0; k < 9; ++k) {
            const size_t row = k < 8 ? (size_t)t * TOPK + k : (size_t)A_TOT + t; const float w = k < 8 ? wbuf[(size_t)t * TOPK + k] : 1.f;
#pragma unroll
            for (int j = 0; j < 4; ++j) {
                const uint2 y = ((const uint2*)(Y + row * D))[lane + 64 * j];
                v[4 * j] += w * __uint_as_float(y.x << 16); v[4 * j + 1] += w * __uint_as_float(y.x & 0xffff0000u);
                v[4 * j + 2] += w * __uint_as_float(y.y << 16); v[4 * j + 3] += w * __uint_as_float(y.y & 0xffff0000u);
            }
        }
        ln_row(v, p.ln2_g, p.ln2_b, lane);
#pragma unroll
        for (int j = 0; j < 4; ++j) ((float4*)(p.out + (size_t)t * D))[lane + 64 * j] = make_float4(v[4 * j], v[4 * j + 1], v[4 * j + 2], v[4 * j + 3]);
    }
}

#define LAS __attribute__((address_space(3)))
#define XB_TMO      128
#define XB_XCNT(j)  (256  + 64 * (j))
#define XB_XSUB(j)  (1280 + 64 * (j))
#define XB_XGEN(j)  (2304 + 64 * (j))
#define XB_TOP      3328
#define XB_TOPGEN   3392
#define XCD_BAR_WORDS 3456
#define XB_SPIN_CAP (1u << 22)
constexpr int CW_BAR = 4096;
DI unsigned xb_ld(unsigned* p) { return __hip_atomic_load(p, __ATOMIC_RELAXED, __HIP_MEMORY_SCOPE_AGENT); }
DI unsigned xb_add(unsigned* p, unsigned v) { return __hip_atomic_fetch_add(p, v, __ATOMIC_RELAXED, __HIP_MEMORY_SCOPE_AGENT); }
DI unsigned xb_xcc_id() { return (unsigned)__builtin_amdgcn_s_getreg((3 << 11) | 20) & 0xFu; }
#define XB_SPIN(cond, bar) do { unsigned _sp = 0; while (cond) { __builtin_amdgcn_s_sleep(1); \
    if ((++_sp & 255u) == 0u) { if (xb_ld(&(bar)[XB_TMO])) break; if (_sp > XB_SPIN_CAP) { atomicAdd(&(bar)[XB_TMO], 1u); break; } } } } while (0)
struct XcdBarrier { unsigned* bar; unsigned x; volatile LAS unsigned* st; };
DI XcdBarrier xcd_barrier_post(unsigned* bar, volatile LAS unsigned* st) {
    XcdBarrier b; b.bar = bar; b.x = xb_xcc_id(); b.st = st;
    if (threadIdx.x == 0) (void)xb_add(&bar[XB_XCNT(b.x)], 1u);
    return b;
}
DI void xcd_barrier_complete(unsigned* bar, unsigned x, unsigned& nloc, unsigned& nx) {
    const unsigned G = gridDim.x * gridDim.y * gridDim.z;
    unsigned sum, cnt, mine, sp = 0u;
    for (;;) {
        sum = 0u; cnt = 0u; mine = 0u;
#pragma unroll
        for (unsigned j = 0; j < 16; ++j) { const unsigned c = xb_ld(&bar[XB_XCNT(j)]); sum += c; cnt += (c > 0u) ? 1u : 0u; mine = (j == x) ? c : mine; }
        if (sum == G) break;
        __builtin_amdgcn_s_sleep(1);
        if ((++sp & 255u) == 0u) { if (xb_ld(&bar[XB_TMO])) break; if (sp > XB_SPIN_CAP) { atomicAdd(&bar[XB_TMO], 1u); break; } }
    }
    nloc = mine > 0u ? mine : 1u; nx = cnt > 0u ? cnt : 1u;
}
DI void xcd_barrier(const XcdBarrier& b) {
    asm volatile("s_waitcnt vmcnt(0)" ::: "memory");
    __syncthreads();
    if (threadIdx.x == 0) {
        unsigned* bar = b.bar;
        __builtin_amdgcn_s_waitcnt(0);
        unsigned nloc = b.st[0], nx = b.st[1];
        if (nloc == 0u) { xcd_barrier_complete(bar, b.x, nloc, nx); b.st[0] = nloc; b.st[1] = nx; }
        const unsigned old = xb_add(&bar[XB_XSUB(b.x)], 1u);
        const unsigned gen = old / nloc;
        if (old + 1u == (gen + 1u) * nloc) {
            __builtin_amdgcn_fence(__ATOMIC_RELEASE, "agent");
            asm volatile("s_waitcnt vmcnt(0)" ::: "memory");
            const unsigned og = xb_add(&bar[XB_TOP], 1u);
            const unsigned tg = og / nx;
            if (og + 1u == (tg + 1u) * nx) xb_add(&bar[XB_TOPGEN], 1u);
            else XB_SPIN(xb_ld(&bar[XB_TOPGEN]) == tg, bar);
            __builtin_amdgcn_fence(__ATOMIC_ACQUIRE, "agent");
            xb_add(&bar[XB_XGEN(b.x)], 1u);
            asm volatile("s_waitcnt vmcnt(0)" ::: "memory");
        } else {
            XB_SPIN(xb_ld(&bar[XB_XGEN(b.x)]) == gen, bar);
            __builtin_amdgcn_fence(__ATOMIC_ACQUIRE, "agent");
            asm volatile("s_waitcnt vmcnt(0)" ::: "memory");
        }
    }
    __syncthreads();
}

constexpr int LDS_BYTES = 120 * 1024;
constexpr int LDS_BAR_OFF = LDS_BYTES - 16;
__global__ void __launch_bounds__(NT) fwd_megakernel(Params p) {
    extern __shared__ __attribute__((aligned(16))) float lds[];
    const int bid = blockIdx.x, nblk = gridDim.x;
    volatile LAS unsigned* st = (volatile LAS unsigned*)((LAS unsigned char*)lds + LDS_BAR_OFF);
    if (threadIdx.x < 4) st[threadIdx.x] = 0u;
    __syncthreads();
    XcdBarrier bar = xcd_barrier_post((unsigned*)(p.ws + OFF_CTL) + CW_BAR, st);
    phase_prep(p, bid, nblk, lds);      xcd_barrier(bar);
    phase_proj(p, bid, nblk, lds);      xcd_barrier(bar);
    phase_poolmean(p, bid, nblk, lds);
    phase_gla1(p, bid, nblk, lds);      xcd_barrier(bar);
    phase_pool(p, bid, nblk, lds);
    phase_gla2(p, bid, nblk, lds);      xcd_barrier(bar);
    phase_gla3(p, bid, nblk, lds);      xcd_barrier(bar);
    phase_out(p, bid, nblk, lds);       xcd_barrier(bar);
    phase_ln1(p, bid, nblk, lds);       xcd_barrier(bar);
    phase_router(p, bid, nblk, lds);    xcd_barrier(bar);
    phase_topk(p, bid, nblk, lds);      xcd_barrier(bar);
    phase_e1(p, bid, nblk, lds);        xcd_barrier(bar);
    phase_e2(p, bid, nblk, lds);        xcd_barrier(bar);
    phase_combine(p, bid, nblk, lds);
}

extern "C" void kernel_launch(void* const* d_in, const int* in_sizes, int n_in, void* d_out, int out_size, void* d_ws, size_t ws_size, hipStream_t stream) {
    static int grid = 0;
    if (grid == 0) {
        if (n_in != 20 || ws_size < WS_NEED) { fprintf(stderr, "kernel_launch: unexpected n_in %d or ws_size %zu (< %zu)\n", n_in, ws_size, (size_t)WS_NEED); grid = -1; return; }
        int dev = 0, cus = 0, per_cu = 0;
        (void)hipGetDevice(&dev); (void)hipDeviceGetAttribute(&cus, hipDeviceAttributeMultiprocessorCount, dev);
        (void)hipFuncSetAttribute((const void*)fwd_megakernel, hipFuncAttributeMaxDynamicSharedMemorySize, LDS_BYTES);
        (void)hipOccupancyMaxActiveBlocksPerMultiprocessor(&per_cu, (const void*)fwd_megakernel, NT, LDS_BYTES);
        if (per_cu < 1 || cus < 1) { fprintf(stderr, "kernel_launch: occupancy query says %d blocks/CU on %d CUs\n", per_cu, cus); grid = -1; return; }
        grid = cus;
    }
    if (grid < 0) return;
    (void)hipMemsetAsync((char*)d_ws + OFF_CTL, 0, 64 * 1024, stream);
    Params p{};
    const float** pp = (const float**)&p;
    for (int i = 0; i < 20; ++i) pp[i] = (const float*)d_in[i];
    p.out = (float*)d_out; p.ws = (unsigned char*)d_ws;
    void* args[] = {&p};
    hipError_t e = hipLaunchCooperativeKernel((const void*)fwd_megakernel, dim3(grid), dim3(NT), args, LDS_BYTES, stream);
    if (e != hipSuccess) fprintf(stderr, "cooperative launch failed: %s (grid %d)\n", hipGetErrorString(e), grid);
}
```

```cpp
#include <hip/hip_runtime.h>
#include <stdint.h>
#include <cstdio>

#define DI __device__ __forceinline__
typedef unsigned short bf16_t;

constexpr int T = 16384, D = 1024, SEQ = 4096;
constexpr int DIN = 2064, NPROJ = 2048;
constexpr int P_OFF = 0, Q_OFF = 512, K_OFF = 768, V_OFF = 1024, R_OFF = 1536, GL_OFF = 2048;
constexpr int SC = 64;
constexpr int NSC = SEQ / SC;
constexpr int NE = 256, TOPK = 8, EDIM = 256;
constexpr int A_TOT = T * TOPK;
constexpr int LCAP = T;
constexpr float ALPHA = 1.189207115002721f;
constexpr float LN_EPS = 1e-5f, RMS_EPS = 1e-5f;
constexpr int NT = 512;

constexpr size_t MiB = 1u << 20;
constexpr size_t OFF_CTL = 0;
constexpr size_t OFF_XB = 1 * MiB;
constexpr size_t OFF_GLOW = OFF_XB + 32 * MiB;
constexpr size_t OFF_PROJ = OFF_GLOW + 1 * MiB;
constexpr size_t OFF_G = OFF_PROJ + 64 * MiB;
constexpr size_t OFF_SLOC = OFF_G + 16 * MiB;
constexpr size_t OFF_DEC = OFF_SLOC + 32 * MiB;
constexpr size_t OFF_SIN = OFF_DEC + 1 * MiB;
constexpr size_t OFF_MIX = OFF_SIN + 32 * MiB;
constexpr size_t OFF_H32 = OFF_MIX + 32 * MiB;
constexpr size_t OFF_HB = OFF_H32 + 64 * MiB;
constexpr size_t OFF_SCORES = OFF_HB + 32 * MiB;
constexpr size_t OFF_WBUF = OFF_SCORES + 16 * MiB;
constexpr size_t OFF_LIST = OFF_WBUF + 1 * MiB;
constexpr size_t OFF_HID = OFF_LIST + 16 * MiB;
constexpr size_t OFF_Y = OFF_HID + 76 * MiB;
constexpr size_t OFF_PM = OFF_Y + 304 * MiB;
constexpr size_t WS_NEED = OFF_PM + 16 * MiB;
constexpr int CW_CNT = 1024;

struct Params {
    const float *x, *w_in, *gate_w2, *gate_b, *norm_w, *pool_w, *pool_scale, *w_out, *ln1_g, *ln1_b;
    const float *router_w, *router_bias, *wg, *wu, *wd, *sg, *su, *sd, *ln2_g, *ln2_b;
    float* out;
    unsigned char* ws;
};

DI float bf2f(bf16_t v) { return __uint_as_float(((unsigned)v) << 16); }
DI bf16_t f2bf(float f) { unsigned u = __float_as_uint(f); u += 0x7fffu + ((u >> 16) & 1u); return (bf16_t)(u >> 16); }
DI unsigned pk2(float lo, float hi) { return (unsigned)f2bf(lo) | ((unsigned)f2bf(hi) << 16); }
DI float wave_sum(float v) {
#pragma unroll
    for (int o = 1; o < 64; o <<= 1) v += __shfl_xor(v, o);
    return v;
}
DI float sigmoidf_(float v) { return 1.f / (1.f + __expf(-v)); }
DI float logsigmoidf_(float z) { return fminf(z, 0.f) - log1pf(__expf(-fabsf(z))); }

constexpr int GT_LDS_FLOATS = 16 * 132 + 2 * 16 * 68;
template <bool DUAL, class AF, class BF, class EPI>
DI void gemm_tile_valu(int K, const AF& af, const BF& bfn, const EPI& epi, float* lds) {
    float* As = lds; float* Bs = lds + 16 * 132; float* Bs2 = Bs + 16 * 68;
    const int tid = threadIdx.x, ty = tid >> 4, tx = tid & 15;
    float acc[4][4], acc2[4][4];
#pragma unroll
    for (int i = 0; i < 4; ++i)
#pragma unroll
        for (int j = 0; j < 4; ++j) { acc[i][j] = 0.f; acc2[i][j] = 0.f; }
    for (int k0 = 0; k0 < K; k0 += 16) {
#pragma unroll
        for (int i = 0; i < 4; ++i) { const int e = tid + 512 * i, r = e >> 4, kk = e & 15; As[kk * 132 + r] = af(r, k0 + kk); }
#pragma unroll
        for (int i = 0; i < 2; ++i) { const int e = tid + 512 * i, kk = e >> 6, c = e & 63; Bs[kk * 68 + c] = bfn(0, k0 + kk, c); if (DUAL) Bs2[kk * 68 + c] = bfn(1, k0 + kk, c); }
        __syncthreads();
#pragma unroll
        for (int kk = 0; kk < 16; ++kk) {
            const float4 a = *(const float4*)&As[kk * 132 + ty * 4];
            const float4 b = *(const float4*)&Bs[kk * 68 + tx * 4];
            const float av[4] = {a.x, a.y, a.z, a.w}, bv[4] = {b.x, b.y, b.z, b.w};
#pragma unroll
            for (int i = 0; i < 4; ++i)
#pragma unroll
                for (int j = 0; j < 4; ++j) acc[i][j] += av[i] * bv[j];
            if (DUAL) {
                const float4 b2 = *(const float4*)&Bs2[kk * 68 + tx * 4];
                const float b2v[4] = {b2.x, b2.y, b2.z, b2.w};
#pragma unroll
                for (int i = 0; i < 4; ++i)
#pragma unroll
                    for (int j = 0; j < 4; ++j) acc2[i][j] += av[i] * b2v[j];
            }
        }
        __syncthreads();
    }
#pragma unroll
    for (int i = 0; i < 4; ++i)
#pragma unroll
        for (int j = 0; j < 4; ++j) epi(ty * 4 + i, tx * 4 + j, acc[i][j], acc2[i][j]);
}


typedef __bf16 bf16x8 __attribute__((ext_vector_type(8)));
typedef __bf16 bf16x4 __attribute__((ext_vector_type(4)));
typedef short s16x4 __attribute__((ext_vector_type(4)));
typedef float f32x4 __attribute__((ext_vector_type(4)));
typedef unsigned u32x4 __attribute__((ext_vector_type(4)));
#define LAS3 __attribute__((address_space(3)))
DI const float* uniform_ptr(const float* p) {
    const unsigned long long v = (unsigned long long)p;
    const unsigned lo = __builtin_amdgcn_readfirstlane((unsigned)v), hi = __builtin_amdgcn_readfirstlane((unsigned)(v >> 32));
    return (const float*)(((unsigned long long)hi << 32) | lo);
}
#define MFMA16(a, b, c) __builtin_amdgcn_mfma_f32_16x16x32_bf16((a), (b), (c), 0, 0, 0)
constexpr int GEMM_LDS_BYTES = 131072;
template <bool DUAL, int LDB, int WN, class RowFn, class Epi>
DI void gemm_mfma(const bf16_t* Ab, const RowFn& rowoff, const float* B0, const float* B1, unsigned bbytes, int K, int rows, const Epi& epi, unsigned char* lds) {
    int tid_ = threadIdx.x; asm volatile("" : "+v"(tid_));
    const int tid = tid_, lane = tid & 63, w = __builtin_amdgcn_readfirstlane(tid >> 6), wm = w >> 2, wn = w & 3, l15 = lane & 15, kg = lane >> 4;
    const bool active = wn < WN;
    const int nrow_w = min(max(rows - 128 * wm, 0), 128), ngrp = (((nrow_w + 15) >> 4) + 1) >> 1;
    unsigned aoff[4];
#pragma unroll
    for (int i = 0; i < 4; ++i) aoff[i] = (rowoff(min((tid >> 3) + 64 * i, rows - 1)) + (tid & 7) * 8) * 2u;
    const __amdgpu_buffer_rsrc_t ar = __builtin_amdgcn_make_buffer_rsrc((void*)Ab, 0, 0x7fffffff, 0x00020000);
    const unsigned awr = (tid >> 3) * 128 + (((tid & 7) ^ ((tid >> 4) & 7)) << 4);
    const float* bsrc = uniform_ptr(DUAL ? ((w >> 2) ? B1 : B0) : B0);
    const __amdgpu_buffer_rsrc_t br = __builtin_amdgcn_make_buffer_rsrc((void*)bsrc, 0, bbytes, 0x00020000);
    const unsigned bvoff = DUAL ? (unsigned)(((lane >> 5) * LDB + (lane & 31) * 4) * 4) : (unsigned)(lane * 16);
    const int krow0 = DUAL ? 2 * (w & 3) : w;
    unsigned bwr_e, bwr_o;
    {
        const int kb = krow0 + (DUAL ? (lane >> 5) : 0), n = DUAL ? (w >> 2) * 128 + 4 * (lane & 31) : 4 * lane;
        const unsigned I = n >> 7, ch = (n & 127) >> 3, half = (n >> 2) & 1, xe = ((kb & 3) << 2) | (kb >> 2);
        bwr_e = 65536u + I * 16384u + 256u * kb + 16u * (ch ^ xe) + 8u * half;
        bwr_o = 65536u + I * 16384u + 256u * kb + 16u * (ch ^ (xe ^ 2u)) + 8u * half;
    }
    const unsigned sw = (l15 >> 1) & 7;
    const unsigned ard0 = (128 * wm + l15) * 128 + ((((unsigned)kg) ^ sw) << 4), ard1 = (128 * wm + l15) * 128 + ((((unsigned)(4 + kg)) ^ sw) << 4);
    unsigned trd0, trd1;
    {
        const unsigned q = l15 >> 2, pp = l15 & 3, cbase = (DUAL ? 4u * wn : 8u * (wn & 1)) + (pp >> 1), ibase = DUAL ? 0u : (unsigned)(wn >> 1);
        const unsigned x0 = (q << 2) | ((2u * kg) & 3u), x1 = (q << 2) | ((2u * kg + 1u) & 3u);
        trd0 = 65536u + ibase * 16384u + 256u * (8u * kg + q) + 16u * (cbase ^ x0) + 8u * (pp & 1);
        trd1 = 65536u + ibase * 16384u + 256u * (8u * kg + 4u + q) + 16u * (cbase ^ x1) + 8u * (pp & 1);
    }
    f32x4 acc[8][4];
#pragma unroll
    for (int i = 0; i < 8; ++i)
#pragma unroll
        for (int f = 0; f < 4; ++f) acc[i][f] = (f32x4){0.f, 0.f, 0.f, 0.f};
    u32x4 areg[4], breg[8];
    const int nk = K / 64;
#define A_LOAD(kt) { _Pragma("unroll") for (int i = 0; i < 4; ++i) areg[i] = __builtin_bit_cast(u32x4, __builtin_amdgcn_raw_buffer_load_b128(ar, aoff[i], (kt) * 128, 0)); }
#define B_LOAD(kt) { _Pragma("unroll") for (int i = 0; i < 8; ++i) breg[i] = __builtin_bit_cast(u32x4, __builtin_amdgcn_raw_buffer_load_b128(br, bvoff, ((kt) * 64 + krow0 + 8 * i) * (LDB * 4), 0)); }
#define AB_WRITE(st) { _Pragma("unroll") for (int i = 0; i < 4; ++i) *(u32x4*)(lds + (st) * 32768 + awr + i * 8192) = areg[i]; \
        _Pragma("unroll") for (int i = 0; i < 8; ++i) { const f32x4 v = __builtin_bit_cast(f32x4, breg[i]); bf16x4 o; o[0] = (__bf16)v[0]; o[1] = (__bf16)v[1]; o[2] = (__bf16)v[2]; o[3] = (__bf16)v[3]; \
            *(bf16x4*)(lds + (st) * 32768 + ((i & 1) ? bwr_o : bwr_e) + i * 2048) = o; } }
    A_LOAD(0) B_LOAD(0) AB_WRITE(0)
    __syncthreads();
#pragma unroll 1
    for (int kt = 0; kt < nk; ++kt) {
        const int st = kt & 1;
        const bool more = kt + 1 < nk;
        if (more) { A_LOAD(kt + 1) B_LOAD(kt + 1) }
        if (active && ngrp > 0) {
            const unsigned char* abuf = lds + st * 32768;
            const unsigned tb0 = trd0 + st * 32768, tb1 = trd1 + st * 32768;
            bf16x8 fa[2], fb[2], wf[4];
#define TF_LOAD(dst, ks, g) { _Pragma("unroll") for (int q_ = 0; q_ < 2; ++q_) dst[q_] = *(const bf16x8*)(abuf + ((g) * 2 + q_) * 2048 + ((ks) ? ard1 : ard0)); }
#define WF_LOAD(ks) { _Pragma("unroll") for (int f = 0; f < 4; ++f) { \
                const unsigned fx = DUAL ? ((f & 1) << 5) : (f << 5), fo = (DUAL ? (f >> 1) * 16384 : 0) + (ks) * 8192; \
                const s16x4 lo = __builtin_amdgcn_ds_read_tr16_b64_v4i16((LAS3 s16x4*)(lds + ((tb0 ^ fx) + fo))); \
                const s16x4 hi = __builtin_amdgcn_ds_read_tr16_b64_v4i16((LAS3 s16x4*)(lds + ((tb1 ^ fx) + fo))); \
                wf[f] = __builtin_bit_cast(bf16x8, __builtin_shufflevector(lo, hi, 0, 1, 2, 3, 4, 5, 6, 7)); } }
#define STAGE_MMA(srcf, g) { _Pragma("unroll") for (int q_ = 0; q_ < 2; ++q_) _Pragma("unroll") for (int f = 0; f < 4; ++f) acc[(g) * 2 + q_][f] = MFMA16(wf[f], srcf[q_], acc[(g) * 2 + q_][f]); }
#define STAGE(ks, g, cur, nxt) if ((g) < ngrp) { \
                if ((g) + 1 < 4 && (g) + 1 < ngrp) TF_LOAD(nxt, ks, (g) + 1) \
                __builtin_amdgcn_sched_barrier(0); \
                STAGE_MMA(cur, g) \
                __builtin_amdgcn_sched_barrier(0); }
#pragma unroll
            for (int ks = 0; ks < 2; ++ks) {
                WF_LOAD(ks)
                TF_LOAD(fa, ks, 0)
                STAGE(ks, 0, fa, fb)
                STAGE(ks, 1, fb, fa)
                STAGE(ks, 2, fa, fb)
                STAGE(ks, 3, fb, fa)
            }
#undef TF_LOAD
#undef WF_LOAD
#undef STAGE_MMA
#undef STAGE
        }
        if (more) AB_WRITE(st ^ 1)
        __syncthreads();
    }
#undef A_LOAD
#undef B_LOAD
#undef AB_WRITE
    if (active) {
#pragma unroll
        for (int mt = 0; mt < 8; ++mt) {
            if ((mt >> 1) < ngrp) {
                int l15e = l15; asm volatile("" : "+v"(l15e));
                const int row = 128 * wm + mt * 16 + l15e;
                if (DUAL) { epi(row, 32 * wn + 4 * kg, acc[mt][0], acc[mt][2]); epi(row, 32 * wn + 16 + 4 * kg, acc[mt][1], acc[mt][3]); }
                else {
#pragma unroll
                    for (int f = 0; f < 4; ++f) epi(row, 64 * wn + 16 * f + 4 * kg, acc[mt][f], acc[mt][f]);
                }
            }
            asm volatile("" ::: "memory");
        }
    }
}

DI void phase_prep(const Params& p, int bid, int nblk, float* lds) {
    const int tid = threadIdx.x, lane = tid & 63, wave = tid >> 6;
    bf16_t* xb = (bf16_t*)(p.ws + OFF_XB); float* glow = (float*)(p.ws + OFF_GLOW);
    f32x4* Wl = (f32x4*)lds;
    for (int idx = tid; idx < 4096; idx += NT) {
        const int k = idx >> 2, q = idx & 3, ln = (k >> 2) & 63, j = k >> 8, c = k & 3;
        Wl[((j * 4 + c) * 4 + q) * 64 + ln] = *(const f32x4*)(p.w_in + (size_t)k * DIN + GL_OFF + 4 * q);
    }
    __syncthreads();
    for (int row0 = (bid * 8 + wave) * 4; row0 < T; row0 += nblk * 32) {
        asm volatile("" ::: "memory");
        f32x4 xv[4][4];
#pragma unroll
        for (int r = 0; r < 4; ++r)
#pragma unroll
            for (int j = 0; j < 4; ++j) {
                xv[r][j] = ((const f32x4*)(p.x + (size_t)(row0 + r) * D))[lane + 64 * j];
                uint2 o; o.x = pk2(xv[r][j][0], xv[r][j][1]); o.y = pk2(xv[r][j][2], xv[r][j][3]);
                ((uint2*)(xb + (size_t)(row0 + r) * D))[lane + 64 * j] = o;
            }
        float acc[4][16];
#pragma unroll
        for (int r = 0; r < 4; ++r)
#pragma unroll
            for (int n = 0; n < 16; ++n) acc[r][n] = 0.f;
#pragma unroll
        for (int j = 0; j < 4; ++j)
#pragma unroll
            for (int c = 0; c < 4; ++c) {
                float wv[16];
#pragma unroll
                for (int q = 0; q < 4; ++q) { const f32x4 w4 = Wl[((j * 4 + c) * 4 + q) * 64 + lane]; wv[4 * q] = w4[0]; wv[4 * q + 1] = w4[1]; wv[4 * q + 2] = w4[2]; wv[4 * q + 3] = w4[3]; }
#pragma unroll
                for (int r = 0; r < 4; ++r) {
                    const float xs = xv[r][j][c];
#pragma unroll
                    for (int n = 0; n < 16; ++n) acc[r][n] += xs * wv[n];
                }
            }
#define RS_STEP(N, OFF) { const bool up = (lane & (OFF)) != 0; _Pragma("unroll") for (int i = 0; i < (N); ++i) { \
            const float a = acc[i / 16][i % 16], b = acc[(i + (N)) / 16][(i + (N)) % 16]; const float snd = up ? a : b, kp = up ? b : a; \
            acc[i / 16][i % 16] = kp + __shfl_xor(snd, (OFF)); } }
        RS_STEP(32, 32) RS_STEP(16, 16) RS_STEP(8, 8) RS_STEP(4, 4) RS_STEP(2, 2) RS_STEP(1, 1)
#undef RS_STEP
        glow[(size_t)row0 * 16 + lane] = acc[0][0];
    }
    __syncthreads();
}

DI void phase_proj(const Params& p, int bid, int nblk, float* lds) {
    const bf16_t* xb = (const bf16_t*)(p.ws + OFF_XB); bf16_t* proj = (bf16_t*)(p.ws + OFF_PROJ);
    for (int u = bid; u < 64 * 8; u += nblk) {
        const int mt = u >> 3, nt = u & 7;
        auto rowoff = [&](int r) { return (unsigned)((mt * 256 + r) * D); };
        auto epi = [&](int r, int c, f32x4 v, f32x4) { uint2 o; o.x = pk2(v[0], v[1]); o.y = pk2(v[2], v[3]); *(uint2*)(proj + (size_t)(mt * 256 + r) * NPROJ + nt * 256 + c) = o; };
        gemm_mfma<false, DIN, 4>(xb, rowoff, p.w_in + nt * 256, nullptr, (unsigned)(((size_t)D * DIN - nt * 256) * 4), D, 256, epi, (unsigned char*)lds);
    }
}

template <int W>
DI void poolmean_item(const bf16_t* proj, bf16_t* pm, int t0, int c2) {
    const int s0 = t0 & (SEQ - 1);
    float p0[48], p1[48]; unsigned raw[32];
    p0[0] = 0.f; p1[0] = 0.f;
#pragma unroll
    for (int i = 0; i < 47; ++i) {
        unsigned v = 0u;
        if (i >= 15 || s0 > 0) v = *(const unsigned*)(proj + (size_t)(t0 - 15 + i) * NPROJ + P_OFF + c2);
        if (i >= 15) raw[i - 15] = v;
        p0[i + 1] = p0[i] + __uint_as_float(v << 16); p1[i + 1] = p1[i] + __uint_as_float(v & 0xffff0000u);
    }
#pragma unroll
    for (int i = 0; i < 32; ++i) {
        const int s = s0 + i; const float inv = 1.f / (float)min(s + 1, W);
        const float m0 = (p0[i + 16] - p0[i + 16 - W]) * inv - __uint_as_float(raw[i] << 16);
        const float m1 = (p1[i + 16] - p1[i + 16 - W]) * inv - __uint_as_float(raw[i] & 0xffff0000u);
        *(unsigned*)(pm + (size_t)(t0 + i) * 512 + c2) = pk2(m0, m1);
    }
}
DI void phase_poolmean(const Params& p, int bid, int nblk, float* lds) {
    const bf16_t* proj = (const bf16_t*)(p.ws + OFF_PROJ); bf16_t* pm = (bf16_t*)(p.ws + OFF_PM);
    for (int item = bid * NT + threadIdx.x; item < 256 * (T / 32); item += nblk * NT) {
        const int pair = item & 255, t0 = (item >> 8) * 32, c2 = pair * 2, g = __builtin_amdgcn_readfirstlane(pair >> 6);
        if (g == 0) poolmean_item<2>(proj, pm, t0, c2);
        else if (g == 1) poolmean_item<4>(proj, pm, t0, c2);
        else if (g == 2) poolmean_item<8>(proj, pm, t0, c2);
        else poolmean_item<16>(proj, pm, t0, c2);
    }
}
DI void phase_pool(const Params& p, int bid, int nblk, float* lds) {
    const bf16_t* pm = (const bf16_t*)(p.ws + OFF_PM); bf16_t* mix = (bf16_t*)(p.ws + OFF_MIX);
    for (int u = bid; u < 64 * 4; u += nblk) {
        const int mt = u >> 2, g = u & 3;
        auto rowoff = [&](int r) { return (unsigned)((mt * 256 + r) * 512 + g * 128); };
        auto epi = [&](int r, int c, f32x4 v, f32x4) { const int col = g * 128 + c; const float4 sc = *(const float4*)(p.pool_scale + col); uint2 o; o.x = pk2(v[0] * sc.x, v[1] * sc.y); o.y = pk2(v[2] * sc.z, v[3] * sc.w); *(uint2*)(mix + (size_t)(mt * 256 + r) * D + col) = o; };
        gemm_mfma<false, 128, 2>(pm, rowoff, p.pool_w + (size_t)g * 16384, nullptr, (unsigned)((4 - g) * 16384 * 4), 128, 256, epi, (unsigned char*)lds);
    }
}

DI unsigned f1_off(unsigned row, unsigned chunk) { return row * 128u + ((chunk ^ ((row >> 1) & 7u)) << 4); }
DI unsigned f2_off(unsigned row, unsigned ch) { return 256u * row + 16u * (ch ^ (((row & 3u) << 2) | ((row >> 2) & 3u))); }
DI bf16x8 f1_frag(const unsigned char* img, int tile, int ks, int lane) { return *(const bf16x8*)(img + f1_off(16 * tile + (lane & 15), 4 * ks + (lane >> 4))); }
DI bf16x8 f2_frag(const unsigned char* img, int c, int ks, int lane) {
    const unsigned g = lane >> 4, q = (lane & 15) >> 2, pp = lane & 3;
    const unsigned a0 = f2_off(32 * ks + 8 * g + q, 2 * c + (pp >> 1)) + 8 * (pp & 1), a1 = f2_off(32 * ks + 8 * g + 4 + q, 2 * c + (pp >> 1)) + 8 * (pp & 1);
    const s16x4 lo = __builtin_amdgcn_ds_read_tr16_b64_v4i16((LAS3 s16x4*)(img + a0)), hi = __builtin_amdgcn_ds_read_tr16_b64_v4i16((LAS3 s16x4*)(img + a1));
    return __builtin_bit_cast(bf16x8, __builtin_shufflevector(lo, hi, 0, 1, 2, 3, 4, 5, 6, 7));
}
DI float bfbits2f(unsigned short v) { return __uint_as_float(((unsigned)v) << 16); }
typedef unsigned short u16x8 __attribute__((ext_vector_type(8)));
typedef unsigned short u16x4 __attribute__((ext_vector_type(4)));

DI void phase_gla1(const Params& p, int bid, int nblk, float* ldsf) {
    unsigned char* lds = (unsigned char*)ldsf;
    int tid_ = threadIdx.x; asm volatile("" : "+v"(tid_));
    const int tid = tid_, lane = tid & 63, w = __builtin_amdgcn_readfirstlane(tid >> 6), t = tid >> 3, ch = tid & 7;
    const bf16_t* proj = (const bf16_t*)(p.ws + OFF_PROJ); const float* glow = (const float*)(p.ws + OFF_GLOW);
    float* Gbuf = (float*)(p.ws + OFF_G); float* Sloc = (float*)(p.ws + OFF_SLOC); float* dec = (float*)(p.ws + OFF_DEC);
    float* G = (float*)lds; unsigned char* Kimg = lds + 16384; unsigned char* Vimg = lds + 32768; float* W2l = (float*)(lds + 49152); float* segtot = (float*)(lds + 53248);
    for (int unit = bid; unit < 1024; unit += nblk) {
        const int bh = unit >> 6, n = unit & 63, b = bh >> 2, h = bh & 3, t0 = b * SEQ + n * SC;
        for (int i = tid; i < 1024; i += NT) W2l[i] = p.gate_w2[(i >> 6) * 256 + h * 64 + (i & 63)];
#pragma unroll
        for (int i = 0; i < 2; ++i) { const int idx = tid + NT * i, tr = idx >> 4, c16 = idx & 15;
            *(u32x4*)(Vimg + f2_off(tr, c16)) = *(const u32x4*)(proj + (size_t)(t0 + tr) * NPROJ + V_OFF + h * 128 + 8 * c16); }
        __syncthreads();
        {
            float gl[16];
#pragma unroll
            for (int q = 0; q < 4; ++q) { const f32x4 v = *(const f32x4*)(glow + (size_t)(t0 + t) * 16 + 4 * q); gl[4 * q] = v[0]; gl[4 * q + 1] = v[1]; gl[4 * q + 2] = v[2]; gl[4 * q + 3] = v[3]; }
#pragma unroll
            for (int dd = 0; dd < 8; ++dd) { const int d = 8 * ch + dd; float z = p.gate_b[h * 64 + d];
#pragma unroll
                for (int r = 0; r < 16; ++r) z += gl[r] * W2l[r * 64 + d];
                G[t * 64 + d] = logsigmoidf_(z) * (1.f / 16.f); }
        }
        __syncthreads();
        {
            const int seg = tid >> 6, d = tid & 63; float run = 0.f;
#pragma unroll
            for (int tt = 0; tt < 8; ++tt) { run += G[(8 * seg + tt) * 64 + d]; G[(8 * seg + tt) * 64 + d] = run; }
            segtot[seg * 64 + d] = run;
            __syncthreads();
            float pre = 0.f;
            for (int s2 = 0; s2 < seg; ++s2) pre += segtot[s2 * 64 + d];
#pragma unroll
            for (int tt = 0; tt < 8; ++tt) G[(8 * seg + tt) * 64 + d] += pre;
        }
        __syncthreads();
        {
            const f32x4 g0 = *(const f32x4*)(G + t * 64 + 8 * ch), g1 = *(const f32x4*)(G + t * 64 + 8 * ch + 4);
            const f32x4 l0 = *(const f32x4*)(G + 63 * 64 + 8 * ch), l1 = *(const f32x4*)(G + 63 * 64 + 8 * ch + 4);
            *(f32x4*)(Gbuf + (size_t)(t0 + t) * 256 + h * 64 + 8 * ch) = g0; *(f32x4*)(Gbuf + (size_t)(t0 + t) * 256 + h * 64 + 8 * ch + 4) = g1;
            const u16x8 kv = *(const u16x8*)(proj + (size_t)(t0 + t) * NPROJ + K_OFF + h * 64 + 8 * ch);
            bf16x8 o;
#pragma unroll
            for (int dd = 0; dd < 4; ++dd) { o[dd] = (__bf16)(bfbits2f(kv[dd]) * __expf(l0[dd] - g0[dd])); o[dd + 4] = (__bf16)(bfbits2f(kv[dd + 4]) * __expf(l1[dd] - g1[dd])); }
            *(bf16x8*)(Kimg + f2_off(t, ch)) = o;
            if (t == 63) {
#pragma unroll
                for (int dd = 0; dd < 4; ++dd) { dec[unit * 64 + 8 * ch + dd] = __expf(l0[dd]); dec[unit * 64 + 8 * ch + 4 + dd] = __expf(l1[dd]); }
            }
        }
        __syncthreads();
        {
            f32x4 acc[4];
#pragma unroll
            for (int dt = 0; dt < 4; ++dt) acc[dt] = (f32x4){0.f, 0.f, 0.f, 0.f};
#pragma unroll
            for (int ks = 0; ks < 2; ++ks) {
                const bf16x8 xv = f2_frag(Vimg, w, ks, lane);
#pragma unroll
                for (int dt = 0; dt < 4; ++dt) acc[dt] = MFMA16(xv, f2_frag(Kimg, dt, ks, lane), acc[dt]);
            }
#pragma unroll
            for (int dt = 0; dt < 4; ++dt) *(f32x4*)(Sloc + (size_t)unit * 8192 + (16 * dt + (lane & 15)) * 128 + 16 * w + 4 * (lane >> 4)) = acc[dt];
        }
        __syncthreads();
    }
}

DI void phase_gla2(const Params& p, int bid, int nblk, float* lds) {
    const float* Sloc = (const float*)(p.ws + OFF_SLOC); const float* dec = (const float*)(p.ws + OFF_DEC); bf16_t* Sin = (bf16_t*)(p.ws + OFF_SIN);
    for (int gid = bid * NT + threadIdx.x; gid < 16 * 8192; gid += nblk * NT) {
        const int bh = gid >> 13, el = gid & 8191, d = el >> 7; float st = 0.f;
#pragma unroll 8
        for (int n = 0; n < NSC; ++n) { const int u = bh * 64 + n; Sin[(size_t)u * 8192 + el] = f2bf(st); st = st * dec[u * 64 + d] + Sloc[(size_t)u * 8192 + el]; }
    }
}

DI void phase_gla3(const Params& p, int bid, int nblk, float* ldsf) {
    unsigned char* lds = (unsigned char*)ldsf;
    int tid_ = threadIdx.x; asm volatile("" : "+v"(tid_));
    const int tid = tid_, lane = tid & 63, w = __builtin_amdgcn_readfirstlane(tid >> 6), t = tid >> 3, ch = tid & 7, l15 = lane & 15, kg = lane >> 4;
    const bf16_t* proj = (const bf16_t*)(p.ws + OFF_PROJ); const float* Gbuf = (const float*)(p.ws + OFF_G); const bf16_t* Sin = (const bf16_t*)(p.ws + OFF_SIN);
    bf16_t* mix = (bf16_t*)(p.ws + OFF_MIX);
    unsigned char* Qimg = lds; unsigned char* Kimg = lds + 8192; unsigned char* Pimg = lds + 16384; unsigned char* Vimg = lds + 24576; unsigned char* Simg = lds + 40960;
    float* part = (float*)(lds + 57344);
    for (int unit = bid; unit < 1024; unit += nblk) {
        const int bh = unit >> 6, n = unit & 63, b = bh >> 2, h = bh & 3, t0 = b * SEQ + n * SC;
        {
            const f32x4 g0 = *(const f32x4*)(Gbuf + (size_t)(t0 + t) * 256 + h * 64 + 8 * ch), g1 = *(const f32x4*)(Gbuf + (size_t)(t0 + t) * 256 + h * 64 + 8 * ch + 4);
            const u16x8 qv = *(const u16x8*)(proj + (size_t)(t0 + t) * NPROJ + Q_OFF + h * 64 + 8 * ch), kv = *(const u16x8*)(proj + (size_t)(t0 + t) * NPROJ + K_OFF + h * 64 + 8 * ch);
            bf16x8 qo, ko;
#pragma unroll
            for (int dd = 0; dd < 4; ++dd) {
                qo[dd] = (__bf16)(bfbits2f(qv[dd]) * 0.125f * __expf(g0[dd])); qo[dd + 4] = (__bf16)(bfbits2f(qv[dd + 4]) * 0.125f * __expf(g1[dd]));
                ko[dd] = (__bf16)(bfbits2f(kv[dd]) * __expf(-g0[dd])); ko[dd + 4] = (__bf16)(bfbits2f(kv[dd + 4]) * __expf(-g1[dd]));
            }
            *(bf16x8*)(Qimg + f1_off(t, ch)) = qo; *(bf16x8*)(Kimg + f1_off(t, ch)) = ko;
        }
#pragma unroll
        for (int i = 0; i < 2; ++i) { const int idx = tid + NT * i, tr = idx >> 4, c16 = idx & 15;
            *(u32x4*)(Vimg + f2_off(tr, c16)) = *(const u32x4*)(proj + (size_t)(t0 + tr) * NPROJ + V_OFF + h * 128 + 8 * c16);
            *(u32x4*)(Simg + f2_off(tr, c16)) = *(const u32x4*)(Sin + (size_t)unit * 8192 + tr * 128 + 8 * c16); }
        __syncthreads();
        {
            const int it = w >> 1;
#pragma unroll
            for (int jj = 0; jj < 2; ++jj) {
                const int jt = 2 * (w & 1) + jj; f32x4 acc = {0.f, 0.f, 0.f, 0.f};
                if (jt <= it) {
#pragma unroll
                    for (int ks = 0; ks < 2; ++ks) acc = MFMA16(f1_frag(Kimg, jt, ks, lane), f1_frag(Qimg, it, ks, lane), acc);
                    if (jt == it) {
#pragma unroll
                        for (int r = 0; r < 4; ++r) if (4 * kg + r > l15) acc[r] = 0.f;
                    }
                }
                bf16x4 o; o[0] = (__bf16)acc[0]; o[1] = (__bf16)acc[1]; o[2] = (__bf16)acc[2]; o[3] = (__bf16)acc[3];
                *(bf16x4*)(Pimg + f1_off(16 * it + l15, 2 * jt + (kg >> 1)) + 8 * (kg & 1)) = o;
            }
        }
        __syncthreads();
        {
            f32x4 acc[4];
#pragma unroll
            for (int it = 0; it < 4; ++it) acc[it] = (f32x4){0.f, 0.f, 0.f, 0.f};
#pragma unroll
            for (int ks = 0; ks < 2; ++ks) {
                const bf16x8 xv = f2_frag(Vimg, w, ks, lane), xs = f2_frag(Simg, w, ks, lane);
#pragma unroll
                for (int it = 0; it < 4; ++it) {
                    if (2 * ks <= it) acc[it] = MFMA16(xv, f1_frag(Pimg, it, ks, lane), acc[it]);
                    acc[it] = MFMA16(xs, f1_frag(Qimg, it, ks, lane), acc[it]);
                }
            }
#pragma unroll
            for (int it = 0; it < 4; ++it) {
                float ss = acc[it][0] * acc[it][0] + acc[it][1] * acc[it][1] + acc[it][2] * acc[it][2] + acc[it][3] * acc[it][3];
                ss += __shfl_xor(ss, 16); ss += __shfl_xor(ss, 32);
                if (kg == 0) part[w * 64 + 16 * it + l15] = ss;
            }
            __syncthreads();
            const int e0 = 16 * w + 4 * kg; const f32x4 nw = *(const f32x4*)(p.norm_w + e0);
#pragma unroll
            for (int it = 0; it < 4; ++it) {
                const int i = 16 * it + l15; float tot = 0.f;
#pragma unroll
                for (int w2 = 0; w2 < 8; ++w2) tot += part[w2 * 64 + i];
                const float inv = rsqrtf(tot * (1.f / 128.f) + RMS_EPS);
                const u16x4 rv = *(const u16x4*)(proj + (size_t)(t0 + i) * NPROJ + R_OFF + h * 128 + e0);
                bf16x4 o;
#pragma unroll
                for (int r = 0; r < 4; ++r) { const float rr = bfbits2f(rv[r]); o[r] = (__bf16)(acc[it][r] * inv * nw[r] * (rr * sigmoidf_(rr))); }
                *(bf16x4*)(mix + (size_t)(t0 + i) * D + 512 + h * 128 + e0) = o;
            }
        }
        __syncthreads();
    }
}

DI void phase_out(const Params& p, int bid, int nblk, float* lds) {
    const bf16_t* mix = (const bf16_t*)(p.ws + OFF_MIX); float* h32 = (float*)(p.ws + OFF_H32);
    for (int u = bid; u < 64 * 4; u += nblk) {
        const int mt = u >> 2, nt = u & 3;
        auto rowoff = [&](int r) { return (unsigned)((mt * 256 + r) * D); };
        auto epi = [&](int r, int c, f32x4 v, f32x4) { const size_t o = (size_t)(mt * 256 + r) * D + nt * 256 + c; const float4 xv = *(const float4*)(p.x + o); *(float4*)(h32 + o) = make_float4(ALPHA * xv.x + v[0], ALPHA * xv.y + v[1], ALPHA * xv.z + v[2], ALPHA * xv.w + v[3]); };
        gemm_mfma<false, D, 4>(mix, rowoff, p.w_out + nt * 256, nullptr, (unsigned)(((size_t)D * D - nt * 256) * 4), D, 256, epi, (unsigned char*)lds);
    }
}

DI void ln_row(float (&v)[16], const float* g, const float* b, int lane) {
    float s = 0.f;
#pragma unroll
    for (int i = 0; i < 16; ++i) s += v[i];
    const float mean = wave_sum(s) * (1.f / D); float q = 0.f;
#pragma unroll
    for (int i = 0; i < 16; ++i) { v[i] -= mean; q += v[i] * v[i]; }
    const float rstd = rsqrtf(wave_sum(q) * (1.f / D) + LN_EPS);
#pragma unroll
    for (int j = 0; j < 4; ++j) {
        const float4 gg = ((const float4*)g)[lane + 64 * j], bb = ((const float4*)b)[lane + 64 * j];
        v[4 * j] = v[4 * j] * rstd * gg.x + bb.x; v[4 * j + 1] = v[4 * j + 1] * rstd * gg.y + bb.y;
        v[4 * j + 2] = v[4 * j + 2] * rstd * gg.z + bb.z; v[4 * j + 3] = v[4 * j + 3] * rstd * gg.w + bb.w;
    }
}

DI void phase_ln1(const Params& p, int bid, int nblk, float* lds) {
    const int lane = threadIdx.x & 63, wave = threadIdx.x >> 6;
    float* h32 = (float*)(p.ws + OFF_H32); bf16_t* hb = (bf16_t*)(p.ws + OFF_HB);
    for (int row = bid * 8 + wave; row < T; row += nblk * 8) {
        float4* hr = (float4*)(h32 + (size_t)row * D); float v[16];
#pragma unroll
        for (int j = 0; j < 4; ++j) { const float4 a = hr[lane + 64 * j]; v[4 * j] = a.x; v[4 * j + 1] = a.y; v[4 * j + 2] = a.z; v[4 * j + 3] = a.w; }
        ln_row(v, p.ln1_g, p.ln1_b, lane);
#pragma unroll
        for (int j = 0; j < 4; ++j) {
            hr[lane + 64 * j] = make_float4(v[4 * j], v[4 * j + 1], v[4 * j + 2], v[4 * j + 3]);
            uint2 o; o.x = pk2(v[4 * j], v[4 * j + 1]); o.y = pk2(v[4 * j + 2], v[4 * j + 3]);
            ((uint2*)(hb + (size_t)row * D))[lane + 64 * j] = o;
        }
    }
}

DI void phase_router(const Params& p, int bid, int nblk, float* lds) {
    const bf16_t* hb = (const bf16_t*)(p.ws + OFF_HB); float* scores = (float*)(p.ws + OFF_SCORES);
    for (int u = bid; u < 128; u += nblk) {
        const int mt = u;
        auto rowoff = [&](int r) { return (unsigned)((mt * 128 + r) * D); };
        auto epi = [&](int r, int c, f32x4 v, f32x4) { *(float4*)(scores + (size_t)(mt * 128 + r) * NE + c) = make_float4(sigmoidf_(v[0]), sigmoidf_(v[1]), sigmoidf_(v[2]), sigmoidf_(v[3])); };
        gemm_mfma<false, NE, 4>(hb, rowoff, p.router_w, nullptr, (unsigned)(D * NE * 4), D, 128, epi, (unsigned char*)lds);
    }
}

DI void phase_topk(const Params& p, int bid, int nblk, float* lds) {
    const int lane = threadIdx.x & 63, wave = threadIdx.x >> 6;
    const float* scores = (const float*)(p.ws + OFF_SCORES); float* wbuf = (float*)(p.ws + OFF_WBUF);
    int* list = (int*)(p.ws + OFF_LIST); unsigned* cnt = (unsigned*)(p.ws + OFF_CTL) + CW_CNT;
    const float NEG = -__builtin_inff();
    for (int t = bid * 8 + wave; t < T; t += nblk * 8) {
        const float4 sv = ((const float4*)(scores + (size_t)t * NE))[lane], bv = ((const float4*)p.router_bias)[lane];
        const float s[4] = {sv.x, sv.y, sv.z, sv.w};
        float cand[4] = {sv.x + bv.x, sv.y + bv.y, sv.z + bv.z, sv.w + bv.w};
        float m1 = NEG, m2 = NEG;
#pragma unroll
        for (int j = 0; j < 4; ++j) { const float v = cand[j]; if (v > m1) { m2 = m1; m1 = v; } else if (v > m2) m2 = v; }
#pragma unroll
        for (int off = 1; off < 8; off <<= 1) {
            const float o1 = __shfl_xor(m1, off), o2 = __shfl_xor(m2, off);
            const float n1 = fmaxf(m1, o1), n2 = fmaxf(fminf(m1, o1), fmaxf(m2, o2)); m1 = n1; m2 = n2;
        }
        const float gs = m1 + m2; const int mygrp = lane >> 3; int rank = 0;
#pragma unroll
        for (int g2 = 0; g2 < 8; ++g2) { const float og = __shfl(gs, g2 * 8); if (og > gs || (og == gs && g2 < mygrp)) ++rank; }
        if (rank >= 4) { cand[0] = NEG; cand[1] = NEG; cand[2] = NEG; cand[3] = NEG; }
        int my_e = 0; float my_w = 0.f, wsum = 0.f;
#pragma unroll
        for (int k = 0; k < TOPK; ++k) {
            float bvv = cand[0]; int bj = 0;
#pragma unroll
            for (int j = 1; j < 4; ++j) if (cand[j] > bvv) { bvv = cand[j]; bj = j; }
            int bi = 4 * lane + bj;
#pragma unroll
            for (int off = 32; off >= 1; off >>= 1) {
                const float ov = __shfl_xor(bvv, off); const int oi = __shfl_xor(bi, off);
                if (ov > bvv || (ov == bvv && oi < bi)) { bvv = ov; bi = oi; }
            }
            const int wj = bi & 3, wl = bi >> 2;
            const float mys = wj == 0 ? s[0] : (wj == 1 ? s[1] : (wj == 2 ? s[2] : s[3]));
            const float wk = __shfl(mys, wl);
            wsum += wk;
            if (lane == k) { my_e = bi; my_w = wk; }
            if (lane == wl) {
#pragma unroll
                for (int j = 0; j < 4; ++j) if (j == wj) cand[j] = NEG;
            }
        }
        if (lane < TOPK) {
            const unsigned pos = atomicAdd(&cnt[my_e], 1u);
            list[(size_t)my_e * LCAP + pos] = t * TOPK + lane;
            wbuf[(size_t)t * TOPK + lane] = my_w / wsum * 2.5f;
        }
    }
}

constexpr int EXP_TAB_OFF = GEMM_LDS_BYTES;
DI void build_tables(const Params& p, int* toff, int* roff) {
    const unsigned* cnt = (const unsigned*)(p.ws + OFF_CTL) + CW_CNT;
    if (threadIdx.x == 0) {
        int ta = 0, ra = 0;
        for (int e = 0; e < NE; ++e) { const int c = (int)cnt[e]; toff[e] = ta; roff[e] = ra; ta += (c + 255) >> 8; ra += c; }
        toff[NE] = ta; roff[NE] = ra;
    }
    __syncthreads();
}
DI int find_expert(const int* toff, int tile) { int lo = 0, hi = NE - 1; while (lo < hi) { const int mid = (lo + hi + 1) >> 1; if (toff[mid] <= tile) lo = mid; else hi = mid - 1; } return lo; }
struct ExpUnit { int e, row0, rows, rowbase; };
DI ExpUnit exp_unit(const Params& p, const int* toff, const int* roff, int tile, int ntile) {
    const unsigned* cnt = (const unsigned*)(p.ws + OFF_CTL) + CW_CNT;
    ExpUnit u;
    if (tile < ntile) {
        u.e = find_expert(toff, tile); const int ui = tile - toff[u.e], c = (int)cnt[u.e];
        u.row0 = ui * 256; u.rows = min(256, c - u.row0); u.rowbase = roff[u.e] + u.row0;
    } else { u.e = NE; u.row0 = (tile - ntile) * 256; u.rows = 256; u.rowbase = A_TOT + u.row0; }
    u.e = __builtin_amdgcn_readfirstlane(u.e); u.row0 = __builtin_amdgcn_readfirstlane(u.row0); u.rows = __builtin_amdgcn_readfirstlane(u.rows);
    u.rowbase = __builtin_amdgcn_readfirstlane(u.rowbase);
    return u;
}

DI void phase_e1(const Params& p, int bid, int nblk, float* lds) {
    int* toff = (int*)((unsigned char*)lds + EXP_TAB_OFF); int* roff = toff + 260;
    const bf16_t* hb = (const bf16_t*)(p.ws + OFF_HB); bf16_t* hid = (bf16_t*)(p.ws + OFF_HID); const int* list = (const int*)(p.ws + OFF_LIST);
    build_tables(p, toff, roff);
    const int ntile = toff[NE], units = (ntile + T / 256) * 2;
    for (int u = bid; u < units; u += nblk) {
        const int tile = u >> 1, nt = u & 1;
        const ExpUnit x = exp_unit(p, toff, roff, tile, ntile);
        const float* wg = x.e < NE ? p.wg + (size_t)x.e * 262144 : p.sg; const float* wu = x.e < NE ? p.wu + (size_t)x.e * 262144 : p.su;
        auto rowoff = [&](int r) { const int tok = x.e < NE ? (list[(size_t)x.e * LCAP + x.row0 + r] >> 3) : (x.row0 + r); return (unsigned)(tok * D); };
        auto epi = [&](int r, int c, f32x4 g, f32x4 uu) { if (r < x.rows) { uint2 o; o.x = pk2(g[0] * sigmoidf_(g[0]) * uu[0], g[1] * sigmoidf_(g[1]) * uu[1]); o.y = pk2(g[2] * sigmoidf_(g[2]) * uu[2], g[3] * sigmoidf_(g[3]) * uu[3]); *(uint2*)(hid + (size_t)(x.rowbase + r) * EDIM + nt * 128 + c) = o; } };
        gemm_mfma<true, EDIM, 4>(hb, rowoff, wg + nt * 128, wu + nt * 128, (unsigned)((D * EDIM - nt * 128) * 4), D, x.rows, epi, (unsigned char*)lds);
    }
}

DI void phase_e2(const Params& p, int bid, int nblk, float* lds) {
    int* toff = (int*)((unsigned char*)lds + EXP_TAB_OFF); int* roff = toff + 260; int* rowa = roff + 260;
    const bf16_t* hid = (const bf16_t*)(p.ws + OFF_HID); bf16_t* Y = (bf16_t*)(p.ws + OFF_Y); const int* list = (const int*)(p.ws + OFF_LIST);
    build_tables(p, toff, roff);
    const int ntile = toff[NE], units = (ntile + T / 256) * 4;
    for (int u = bid; u < units; u += nblk) {
        const int tile = u >> 2, nt = u & 3;
        const ExpUnit x = exp_unit(p, toff, roff, tile, ntile);
        const float* wd = x.e < NE ? p.wd + (size_t)x.e * 262144 : p.sd;
        if (threadIdx.x < 256) { const int r = threadIdx.x; rowa[r] = x.e < NE ? (r < x.rows ? list[(size_t)x.e * LCAP + x.row0 + r] : 0) : (A_TOT + x.row0 + r); }
        __syncthreads();
        auto rowoff = [&](int r) { return (unsigned)((x.rowbase + r) * EDIM); };
        auto epi = [&](int r, int c, f32x4 v, f32x4) { if (r < x.rows) { uint2 o; o.x = pk2(v[0], v[1]); o.y = pk2(v[2], v[3]); *(uint2*)(Y + (size_t)rowa[r] * D + nt * 256 + c) = o; } };
        gemm_mfma<false, D, 4>(hid, rowoff, wd + nt * 256, nullptr, (unsigned)((EDIM * D - nt * 256) * 4), EDIM, x.rows, epi, (unsigned char*)lds);
        __syncthreads();
    }
}

DI void phase_combine(const Params& p, int bid, int nblk, float* lds) {
    const int lane = threadIdx.x & 63, wave = threadIdx.x >> 6;
    const float* h32 = (const float*)(p.ws + OFF_H32); const bf16_t* Y = (const bf16_t*)(p.ws + OFF_Y); const float* wbuf = (const float*)(p.ws + OFF_WBUF);
    for (int t = bid * 8 + wave; t < T; t += nblk * 8) {
        float v[16];
#pragma unroll
        for (int j = 0; j < 4; ++j) { const float4 a = ((const float4*)(h32 + (size_t)t * D))[lane + 64 * j]; v[4 * j] = ALPHA * a.x; v[4 * j + 1] = ALPHA * a.y; v[4 * j + 2] = ALPHA * a.z; v[4 * j + 3] = ALPHA * a.w; }
#pragma unroll
        for (int k = 0; k < 9; ++k) {
            const size_t row = k < 8 ? (size_t)t * TOPK + k : (size_t)A_TOT + t; const float w = k < 8 ? wbuf[(size_t)t * TOPK + k] : 1.f;
#pragma unroll
            for (int j = 0; j < 4; ++j) {
                const uint2 y = ((const uint2*)(Y + row * D))[lane + 64 * j];
                v[4 * j] += w * __uint_as_float(y.x << 16); v[4 * j + 1] += w * __uint_as_float(y.x & 0xffff0000u);
                v[4 * j + 2] += w * __uint_as_float(y.y << 16); v[4 * j + 3] += w * __uint_as_float(y.y & 0xffff0000u);
            }
        }
        ln_row(v, p.ln2_g, p.ln2_b, lane);
#pragma unroll
        for (int j = 0; j < 4; ++j) ((float4*)(p.out + (size_t)t * D))[lane + 64 * j] = make_float4(v[4 * j], v[4 * j + 1], v[4 * j + 2], v[4 * j + 3]);
    }
}

#define LAS __attribute__((address_space(3)))
#define XB_TMO      128
#define XB_XCNT(j)  (256  + 64 * (j))
#define XB_XSUB(j)  (1280 + 64 * (j))
#define XB_XGEN(j)  (2304 + 64 * (j))
#define XB_TOP      3328
#define XB_TOPGEN   3392
#define XCD_BAR_WORDS 3456
#define XB_SPIN_CAP (1u << 22)
constexpr int CW_BAR = 4096;
DI unsigned xb_ld(unsigned* p) { return __hip_atomic_load(p, __ATOMIC_RELAXED, __HIP_MEMORY_SCOPE_AGENT); }
DI unsigned xb_add(unsigned* p, unsigned v) { return __hip_atomic_fetch_add(p, v, __ATOMIC_RELAXED, __HIP_MEMORY_SCOPE_AGENT); }
DI unsigned xb_xcc_id() { return (unsigned)__builtin_amdgcn_s_getreg((3 << 11) | 20) & 0xFu; }
#define XB_SPIN(cond, bar) do { unsigned _sp = 0; while (cond) { __builtin_amdgcn_s_sleep(1); \
    if ((++_sp & 255u) == 0u) { if (xb_ld(&(bar)[XB_TMO])) break; if (_sp > XB_SPIN_CAP) { atomicAdd(&(bar)[XB_TMO], 1u); break; } } } } while (0)
struct XcdBarrier { unsigned* bar; unsigned x; volatile LAS unsigned* st; };
DI XcdBarrier xcd_barrier_post(unsigned* bar, volatile LAS unsigned* st) {
    XcdBarrier b; b.bar = bar; b.x = xb_xcc_id(); b.st = st;
    if (threadIdx.x == 0) (void)xb_add(&bar[XB_XCNT(b.x)], 1u);
    return b;
}
DI void xcd_barrier_complete(unsigned* bar, unsigned x, unsigned& nloc, unsigned& nx) {
    const unsigned G = gridDim.x * gridDim.y * gridDim.z;
    unsigned sum, cnt, mine, sp = 0u;
    for (;;) {
        sum = 0u; cnt = 0u; mine = 0u;
#pragma unroll
        for (unsigned j = 0; j < 16; ++j) { const unsigned c = xb_ld(&bar[XB_XCNT(j)]); sum += c; cnt += (c > 0u) ? 1u : 0u; mine = (j == x) ? c : mine; }
        if (sum == G) break;
        __builtin_amdgcn_s_sleep(1);
        if ((++sp & 255u) == 0u) { if (xb_ld(&bar[XB_TMO])) break; if (sp > XB_SPIN_CAP) { atomicAdd(&bar[XB_TMO], 1u); break; } }
    }
    nloc = mine > 0u ? mine : 1u; nx = cnt > 0u ? cnt : 1u;
}
DI void xcd_barrier(const XcdBarrier& b) {
    asm volatile("s_waitcnt vmcnt(0)" ::: "memory");
    __syncthreads();
    if (threadIdx.x == 0) {
        unsigned* bar = b.bar;
        __builtin_amdgcn_s_waitcnt(0);
        unsigned nloc = b.st[0], nx = b.st[1];
        if (nloc == 0u) { xcd_barrier_complete(bar, b.x, nloc, nx); b.st[0] = nloc; b.st[1] = nx; }
        const unsigned old = xb_add(&bar[XB_XSUB(b.x)], 1u);
        const unsigned gen = old / nloc;
        if (old + 1u == (gen + 1u) * nloc) {
            __builtin_amdgcn_fence(__ATOMIC_RELEASE, "agent");
            asm volatile("s_waitcnt vmcnt(0)" ::: "memory");
            const unsigned og = xb_add(&bar[XB_TOP], 1u);
            const unsigned tg = og / nx;
            if (og + 1u == (tg + 1u) * nx) xb_add(&bar[XB_TOPGEN], 1u);
            else XB_SPIN(xb_ld(&bar[XB_TOPGEN]) == tg, bar);
            __builtin_amdgcn_fence(__ATOMIC_ACQUIRE, "agent");
            xb_add(&bar[XB_XGEN(b.x)], 1u);
            asm volatile("s_waitcnt vmcnt(0)" ::: "memory");
        } else {
            XB_SPIN(xb_ld(&bar[XB_XGEN(b.x)]) == gen, bar);
            __builtin_amdgcn_fence(__ATOMIC_ACQUIRE, "agent");
            asm volatile("s_waitcnt vmcnt(0)" ::: "memory");
        }
    }
    __syncthreads();
}

constexpr int LDS_BYTES = 136 * 1024;
constexpr int LDS_BAR_OFF = LDS_BYTES - 16;
__global__ void __launch_bounds__(NT) fwd_megakernel(Params p) {
    extern __shared__ __attribute__((aligned(16))) float lds[];
    const int bid = blockIdx.x, nblk = gridDim.x;
    volatile LAS unsigned* st = (volatile LAS unsigned*)((LAS unsigned char*)lds + LDS_BAR_OFF);
    if (threadIdx.x < 4) st[threadIdx.x] = 0u;
    __syncthreads();
    XcdBarrier bar = xcd_barrier_post((unsigned*)(p.ws + OFF_CTL) + CW_BAR, st);
    phase_prep(p, bid, nblk, lds);      xcd_barrier(bar);
    phase_proj(p, bid, nblk, lds);      xcd_barrier(bar);
    phase_poolmean(p, bid, nblk, lds);
    phase_gla1(p, bid, nblk, lds);      xcd_barrier(bar);
    phase_pool(p, bid, nblk, lds);
    phase_gla2(p, bid, nblk, lds);      xcd_barrier(bar);
    phase_gla3(p, bid, nblk, lds);      xcd_barrier(bar);
    phase_out(p, bid, nblk, lds);       xcd_barrier(bar);
    phase_ln1(p, bid, nblk, lds);       xcd_barrier(bar);
    phase_router(p, bid, nblk, lds);    xcd_barrier(bar);
    phase_topk(p, bid, nblk, lds);      xcd_barrier(bar);
    phase_e1(p, bid, nblk, lds);        xcd_barrier(bar);
    phase_e2(p, bid, nblk, lds);        xcd_barrier(bar);
    phase_combine(p, bid, nblk, lds);
}

extern "C" void kernel_launch(void* const* d_in, const int* in_sizes, int n_in, void* d_out, int out_size, void* d_ws, size_t ws_size, hipStream_t stream) {
    static int grid = 0;
    if (grid == 0) {
        if (n_in != 20 || ws_size < WS_NEED) { fprintf(stderr, "kernel_launch: unexpected n_in %d or ws_size %zu (< %zu)\n", n_in, ws_size, (size_t)WS_NEED); grid = -1; return; }
        int dev = 0, cus = 0, per_cu = 0;
        (void)hipGetDevice(&dev); (void)hipDeviceGetAttribute(&cus, hipDeviceAttributeMultiprocessorCount, dev);
        (void)hipFuncSetAttribute((const void*)fwd_megakernel, hipFuncAttributeMaxDynamicSharedMemorySize, LDS_BYTES);
        (void)hipOccupancyMaxActiveBlocksPerMultiprocessor(&per_cu, (const void*)fwd_megakernel, NT, LDS_BYTES);
        if (per_cu < 1 || cus < 1) { fprintf(stderr, "kernel_launch: occupancy query says %d blocks/CU on %d CUs\n", per_cu, cus); grid = -1; return; }
        grid = cus;
    }
    if (grid < 0) return;
    (void)hipMemsetAsync((char*)d_ws + OFF_CTL, 0, 64 * 1024, stream);
    Params p{};
    const float** pp = (const float**)&p;
    for (int i = 0; i < 20; ++i) pp[i] = (const float*)d_in[i];
    p.out = (float*)d_out; p.ws = (unsigned char*)d_ws;
    void* args[] = {&p};
    hipError_t e = hipLaunchCooperativeKernel((const void*)fwd_megakernel, dim3(grid), dim3(NT), args, LDS_BYTES, stream);
    if (e != hipSuccess) fprintf(stderr, "cooperative launch failed: %s (grid %d)\n", hipGetErrorString(e), grid);
}
```

```cpp
#include <hip/hip_runtime.h>
#include <stdint.h>
#include <cstdio>

#define DI __device__ __forceinline__
typedef unsigned short bf16_t;

constexpr int T = 16384, D = 1024, SEQ = 4096;
constexpr int DIN = 2064, NPROJ = 2048;
constexpr int P_OFF = 0, Q_OFF = 512, K_OFF = 768, V_OFF = 1024, R_OFF = 1536, GL_OFF = 2048;
constexpr int SC = 64;
constexpr int NSC = SEQ / SC;
constexpr int NE = 256, TOPK = 8, EDIM = 256;
constexpr int A_TOT = T * TOPK;
constexpr int LCAP = T;
constexpr float ALPHA = 1.189207115002721f;
constexpr float LN_EPS = 1e-5f, RMS_EPS = 1e-5f;
constexpr int NT = 512;

constexpr size_t MiB = 1u << 20;
constexpr size_t OFF_CTL = 0;
constexpr size_t OFF_XB = 1 * MiB;
constexpr size_t OFF_GLOW = OFF_XB + 32 * MiB;
constexpr size_t OFF_PROJ = OFF_GLOW + 1 * MiB;
constexpr size_t OFF_G = OFF_PROJ + 64 * MiB;
constexpr size_t OFF_SLOC = OFF_G + 16 * MiB;
constexpr size_t OFF_DEC = OFF_SLOC + 32 * MiB;
constexpr size_t OFF_SIN = OFF_DEC + 1 * MiB;
constexpr size_t OFF_MIX = OFF_SIN + 32 * MiB;
constexpr size_t OFF_H32 = OFF_MIX + 32 * MiB;
constexpr size_t OFF_HB = OFF_H32 + 64 * MiB;
constexpr size_t OFF_SCORES = OFF_HB + 32 * MiB;
constexpr size_t OFF_WBUF = OFF_SCORES + 16 * MiB;
constexpr size_t OFF_LIST = OFF_WBUF + 1 * MiB;
constexpr size_t OFF_HID = OFF_LIST + 16 * MiB;
constexpr size_t OFF_Y = OFF_HID + 76 * MiB;
constexpr size_t OFF_PM = OFF_Y + 304 * MiB;
constexpr size_t WS_NEED = OFF_PM + 16 * MiB;
constexpr int CW_CNT = 1024;

struct Params {
    const float *x, *w_in, *gate_w2, *gate_b, *norm_w, *pool_w, *pool_scale, *w_out, *ln1_g, *ln1_b;
    const float *router_w, *router_bias, *wg, *wu, *wd, *sg, *su, *sd, *ln2_g, *ln2_b;
    float* out;
    unsigned char* ws;
};

DI float bf2f(bf16_t v) { return __uint_as_float(((unsigned)v) << 16); }
DI bf16_t f2bf(float f) { unsigned u = __float_as_uint(f); u += 0x7fffu + ((u >> 16) & 1u); return (bf16_t)(u >> 16); }
DI unsigned pk2(float lo, float hi) { return (unsigned)f2bf(lo) | ((unsigned)f2bf(hi) << 16); }
DI float wave_sum(float v) {
#pragma unroll
    for (int o = 1; o < 64; o <<= 1) v += __shfl_xor(v, o);
    return v;
}
DI float sigmoidf_(float v) { return 1.f / (1.f + __expf(-v)); }
DI float logsigmoidf_(float z) { return fminf(z, 0.f) - log1pf(__expf(-fabsf(z))); }

constexpr int GT_LDS_FLOATS = 16 * 132 + 2 * 16 * 68;
template <bool DUAL, class AF, class BF, class EPI>
DI void gemm_tile_valu(int K, const AF& af, const BF& bfn, const EPI& epi, float* lds) {
    float* As = lds; float* Bs = lds + 16 * 132; float* Bs2 = Bs + 16 * 68;
    const int tid = threadIdx.x, ty = tid >> 4, tx = tid & 15;
    float acc[4][4], acc2[4][4];
#pragma unroll
    for (int i = 0; i < 4; ++i)
#pragma unroll
        for (int j = 0; j < 4; ++j) { acc[i][j] = 0.f; acc2[i][j] = 0.f; }
    for (int k0 = 0; k0 < K; k0 += 16) {
#pragma unroll
        for (int i = 0; i < 4; ++i) { const int e = tid + 512 * i, r = e >> 4, kk = e & 15; As[kk * 132 + r] = af(r, k0 + kk); }
#pragma unroll
        for (int i = 0; i < 2; ++i) { const int e = tid + 512 * i, kk = e >> 6, c = e & 63; Bs[kk * 68 + c] = bfn(0, k0 + kk, c); if (DUAL) Bs2[kk * 68 + c] = bfn(1, k0 + kk, c); }
        __syncthreads();
#pragma unroll
        for (int kk = 0; kk < 16; ++kk) {
            const float4 a = *(const float4*)&As[kk * 132 + ty * 4];
            const float4 b = *(const float4*)&Bs[kk * 68 + tx * 4];
            const float av[4] = {a.x, a.y, a.z, a.w}, bv[4] = {b.x, b.y, b.z, b.w};
#pragma unroll
            for (int i = 0; i < 4; ++i)
#pragma unroll
                for (int j = 0; j < 4; ++j) acc[i][j] += av[i] * bv[j];
            if (DUAL) {
                const float4 b2 = *(const float4*)&Bs2[kk * 68 + tx * 4];
                const float b2v[4] = {b2.x, b2.y, b2.z, b2.w};
#pragma unroll
                for (int i = 0; i < 4; ++i)
#pragma unroll
                    for (int j = 0; j < 4; ++j) acc2[i][j] += av[i] * b2v[j];
            }
        }
        __syncthreads();
    }
#pragma unroll
    for (int i = 0; i < 4; ++i)
#pragma unroll
        for (int j = 0; j < 4; ++j) epi(ty * 4 + i, tx * 4 + j, acc[i][j], acc2[i][j]);
}


typedef __bf16 bf16x8 __attribute__((ext_vector_type(8)));
typedef __bf16 bf16x4 __attribute__((ext_vector_type(4)));
typedef short s16x4 __attribute__((ext_vector_type(4)));
typedef float f32x4 __attribute__((ext_vector_type(4)));
typedef unsigned u32x4 __attribute__((ext_vector_type(4)));
#define LAS3 __attribute__((address_space(3)))
DI const float* uniform_ptr(const float* p) {
    const unsigned long long v = (unsigned long long)p;
    const unsigned lo = __builtin_amdgcn_readfirstlane((unsigned)v), hi = __builtin_amdgcn_readfirstlane((unsigned)(v >> 32));
    return (const float*)(((unsigned long long)hi << 32) | lo);
}
#define MFMA16(a, b, c) __builtin_amdgcn_mfma_f32_16x16x32_bf16((a), (b), (c), 0, 0, 0)
constexpr int GEMM_LDS_BYTES = 65536;
DI unsigned a_swz(unsigned x) { return (0x78u >> (2u * x)) & 3u; }
template <bool DUAL, int LDB, int WN, class RowFn, class Epi>
DI void gemm_mfma(const bf16_t* Ab, const RowFn& rowoff, const float* B0, const float* B1, unsigned bbytes, int K, int rows, const Epi& epi, unsigned char* lds) {
    int tid_ = threadIdx.x; asm volatile("" : "+v"(tid_));
    const int tid = tid_, lane = tid & 63, w = __builtin_amdgcn_readfirstlane(tid >> 6), wm = w >> 2, wn = w & 3, l15 = lane & 15, kg = lane >> 4, t256 = tid & 255;
    const bool active = wn < WN;
    const int nrow_w = min(max(rows - 128 * wm, 0), 128), ngrp = (((nrow_w + 15) >> 4) + 1) >> 1;
    unsigned aoff[2];
#pragma unroll
    for (int i = 0; i < 2; ++i) aoff[i] = (rowoff(min(128 * wm + (t256 >> 2) + 64 * i, rows - 1)) + (t256 & 3) * 8) * 2u;
    const __amdgpu_buffer_rsrc_t ar = __builtin_amdgcn_make_buffer_rsrc((void*)Ab, 0, 0x7fffffff, 0x00020000);
    const unsigned awr = (128 * wm + (t256 >> 2)) * 64 + ((((unsigned)(t256 & 3)) ^ a_swz((t256 >> 4) & 3)) << 4);
    const float* bsrc = uniform_ptr(DUAL ? ((wn >> 1) ? B1 : B0) : B0);
    const __amdgpu_buffer_rsrc_t br = __builtin_amdgcn_make_buffer_rsrc((void*)bsrc, 0, bbytes, 0x00020000);
    const unsigned bvoff = DUAL ? (unsigned)(((lane >> 5) * LDB + (lane & 31) * 4) * 4) : (unsigned)(lane * 16);
    const int krow0 = DUAL ? 16 * wm + 8 * (wn & 1) : 16 * wm + wn;
    constexpr int KSTEP = DUAL ? 2 : 4;
    unsigned bwr[4];
#pragma unroll
    for (int i = 0; i < 4; ++i) {
        const int kb = krow0 + KSTEP * i + (DUAL ? (lane >> 5) : 0), n = DUAL ? (wn >> 1) * 128 + 4 * (lane & 31) : 4 * lane;
        const unsigned I = n >> 7, ch = (n & 127) >> 3, half = (n >> 2) & 1, xx = ((kb & 3) << 2) | ((kb >> 2) & 3);
        bwr[i] = 32768u + I * 8192u + 256u * kb + 16u * (ch ^ xx) + 8u * half;
    }
    const unsigned ard = (128 * wm + l15) * 64 + ((((unsigned)kg) ^ a_swz((l15 >> 2) & 3)) << 4);
    unsigned trd0, trd1;
    {
        const unsigned q = l15 >> 2, pp = l15 & 3, cbase = (DUAL ? 4u * wn : 8u * (wn & 1)) + (pp >> 1), ibase = DUAL ? 0u : (unsigned)(wn >> 1);
        const unsigned x0 = (q << 2) | ((2u * kg) & 3u), x1 = (q << 2) | ((2u * kg + 1u) & 3u);
        trd0 = 32768u + ibase * 8192u + 256u * (8u * kg + q) + 16u * (cbase ^ x0) + 8u * (pp & 1);
        trd1 = 32768u + ibase * 8192u + 256u * (8u * kg + 4u + q) + 16u * (cbase ^ x1) + 8u * (pp & 1);
    }
    f32x4 acc[8][4];
#pragma unroll
    for (int i = 0; i < 8; ++i)
#pragma unroll
        for (int f = 0; f < 4; ++f) acc[i][f] = (f32x4){0.f, 0.f, 0.f, 0.f};
    u32x4 ra[2][2], rb[2][4];
    const int nj = K / 32;
#define LOAD_SET(S, j) { _Pragma("unroll") for (int i = 0; i < 2; ++i) ra[S][i] = __builtin_bit_cast(u32x4, __builtin_amdgcn_raw_buffer_load_b128(ar, aoff[i], (j) * 64, 0)); \
        _Pragma("unroll") for (int i = 0; i < 4; ++i) rb[S][i] = __builtin_bit_cast(u32x4, __builtin_amdgcn_raw_buffer_load_b128(br, bvoff, ((j) * 32 + krow0 + KSTEP * i) * (LDB * 4), 0)); }
#define WRITE_SET(S, st) { _Pragma("unroll") for (int i = 0; i < 2; ++i) *(u32x4*)(lds + (st) * 16384 + awr + i * 4096) = ra[S][i]; \
        _Pragma("unroll") for (int i = 0; i < 4; ++i) { const f32x4 v = __builtin_bit_cast(f32x4, rb[S][i]); bf16x4 o; o[0] = (__bf16)v[0]; o[1] = (__bf16)v[1]; o[2] = (__bf16)v[2]; o[3] = (__bf16)v[3]; \
            *(bf16x4*)(lds + (st) * 16384 + bwr[i]) = o; } }
#define W_PHASE(S, st, jw, jl) { if ((jw) < nj) WRITE_SET(S, st) if ((jl) < nj) LOAD_SET(S, jl) }
#define TF_LOAD(dst, st, g) { _Pragma("unroll") for (int q_ = 0; q_ < 2; ++q_) dst[q_] = *(const bf16x8*)(lds + (st) * 16384 + ((g) * 2 + q_) * 1024 + ard); }
#define WF_LOAD(st) { _Pragma("unroll") for (int f = 0; f < 4; ++f) { \
        const unsigned fx = DUAL ? ((f & 1) << 5) : (f << 5), fo = (DUAL ? (f >> 1) * 8192 : 0) + (st) * 16384; \
        const s16x4 lo = __builtin_amdgcn_ds_read_tr16_b64_v4i16((LAS3 s16x4*)(lds + ((trd0 ^ fx) + fo))); \
        const s16x4 hi = __builtin_amdgcn_ds_read_tr16_b64_v4i16((LAS3 s16x4*)(lds + ((trd1 ^ fx) + fo))); \
        wf[f] = __builtin_bit_cast(bf16x8, __builtin_shufflevector(lo, hi, 0, 1, 2, 3, 4, 5, 6, 7)); } }
#define STAGE_MMA(srcf, g) { _Pragma("unroll") for (int q_ = 0; q_ < 2; ++q_) _Pragma("unroll") for (int f = 0; f < 4; ++f) acc[(g) * 2 + q_][f] = MFMA16(wf[f], srcf[q_], acc[(g) * 2 + q_][f]); }
#define STAGE(st, g, cur, nxt) if ((g) < ngrp) { \
        if ((g) + 1 < 4 && (g) + 1 < ngrp) TF_LOAD(nxt, st, (g) + 1) \
        __builtin_amdgcn_sched_barrier(0); \
        STAGE_MMA(cur, g) \
        __builtin_amdgcn_sched_barrier(0); }
#define COMPUTE(st) if (active && ngrp > 0) { bf16x8 fa[2], fb[2], wf[4]; WF_LOAD(st) TF_LOAD(fa, st, 0) STAGE(st, 0, fa, fb) STAGE(st, 1, fb, fa) STAGE(st, 2, fa, fb) STAGE(st, 3, fb, fa) }
    if (wm == 0) { LOAD_SET(0, 0) LOAD_SET(1, 1) WRITE_SET(0, 0) if (2 < nj) LOAD_SET(0, 2) }
    else         { LOAD_SET(1, 0) LOAD_SET(0, 1) WRITE_SET(1, 0) if (2 < nj) LOAD_SET(1, 2) }
    __syncthreads();
    if (wm == 1) { WRITE_SET(0, 1) if (3 < nj) LOAD_SET(0, 3) __syncthreads(); }
    const int sA = wm ? 0 : 1, sB = wm ? 1 : 0;
#pragma unroll 1
    for (int j = 0; j < nj; j += 2) {
        COMPUTE(0)
        __syncthreads();
        W_PHASE(1, sA, j + 1 + wm, j + 3 + wm)
        __syncthreads();
        COMPUTE(1)
        __syncthreads();
        W_PHASE(0, sB, j + 2 + wm, j + 4 + wm)
        __syncthreads();
    }
    if (wm == 0) __syncthreads();
#undef LOAD_SET
#undef WRITE_SET
#undef W_PHASE
#undef TF_LOAD
#undef WF_LOAD
#undef STAGE_MMA
#undef STAGE
#undef COMPUTE
    if (active) {
#pragma unroll
        for (int mt = 0; mt < 8; ++mt) {
            if ((mt >> 1) < ngrp) {
                int l15e = l15; asm volatile("" : "+v"(l15e));
                const int row = 128 * wm + mt * 16 + l15e;
                if (DUAL) { epi(row, 32 * wn + 4 * kg, acc[mt][0], acc[mt][2]); epi(row, 32 * wn + 16 + 4 * kg, acc[mt][1], acc[mt][3]); }
                else {
#pragma unroll
                    for (int f = 0; f < 4; ++f) epi(row, 64 * wn + 16 * f + 4 * kg, acc[mt][f], acc[mt][f]);
                }
            }
            asm volatile("" ::: "memory");
        }
    }
}

DI void phase_prep(const Params& p, int bid, int nblk, float* lds) {
    const int tid = threadIdx.x, lane = tid & 63, wave = tid >> 6;
    bf16_t* xb = (bf16_t*)(p.ws + OFF_XB); float* glow = (float*)(p.ws + OFF_GLOW);
    f32x4* Wl = (f32x4*)lds;
    for (int idx = tid; idx < 4096; idx += NT) {
        const int k = idx >> 2, q = idx & 3, ln = (k >> 2) & 63, j = k >> 8, c = k & 3;
        Wl[((j * 4 + c) * 4 + q) * 64 + ln] = *(const f32x4*)(p.w_in + (size_t)k * DIN + GL_OFF + 4 * q);
    }
    __syncthreads();
    for (int row0 = (bid * 8 + wave) * 4; row0 < T; row0 += nblk * 32) {
        asm volatile("" ::: "memory");
        f32x4 xv[4][4];
#pragma unroll
        for (int r = 0; r < 4; ++r)
#pragma unroll
            for (int j = 0; j < 4; ++j) {
                xv[r][j] = ((const f32x4*)(p.x + (size_t)(row0 + r) * D))[lane + 64 * j];
                uint2 o; o.x = pk2(xv[r][j][0], xv[r][j][1]); o.y = pk2(xv[r][j][2], xv[r][j][3]);
                ((uint2*)(xb + (size_t)(row0 + r) * D))[lane + 64 * j] = o;
            }
        float acc[4][16];
#pragma unroll
        for (int r = 0; r < 4; ++r)
#pragma unroll
            for (int n = 0; n < 16; ++n) acc[r][n] = 0.f;
#pragma unroll
        for (int j = 0; j < 4; ++j)
#pragma unroll
            for (int c = 0; c < 4; ++c) {
                float wv[16];
#pragma unroll
                for (int q = 0; q < 4; ++q) { const f32x4 w4 = Wl[((j * 4 + c) * 4 + q) * 64 + lane]; wv[4 * q] = w4[0]; wv[4 * q + 1] = w4[1]; wv[4 * q + 2] = w4[2]; wv[4 * q + 3] = w4[3]; }
#pragma unroll
                for (int r = 0; r < 4; ++r) {
                    const float xs = xv[r][j][c];
#pragma unroll
                    for (int n = 0; n < 16; ++n) acc[r][n] += xs * wv[n];
                }
            }
#define RS_STEP(N, OFF) { const bool up = (lane & (OFF)) != 0; _Pragma("unroll") for (int i = 0; i < (N); ++i) { \
            const float a = acc[i / 16][i % 16], b = acc[(i + (N)) / 16][(i + (N)) % 16]; const float snd = up ? a : b, kp = up ? b : a; \
            acc[i / 16][i % 16] = kp + __shfl_xor(snd, (OFF)); } }
        RS_STEP(32, 32) RS_STEP(16, 16) RS_STEP(8, 8) RS_STEP(4, 4) RS_STEP(2, 2) RS_STEP(1, 1)
#undef RS_STEP
        glow[(size_t)row0 * 16 + lane] = acc[0][0];
    }
    __syncthreads();
}

DI void phase_proj(const Params& p, int bid, int nblk, float* lds) {
    const bf16_t* xb = (const bf16_t*)(p.ws + OFF_XB); bf16_t* proj = (bf16_t*)(p.ws + OFF_PROJ);
    for (int u = bid; u < 64 * 8; u += nblk) {
        const int mt = u >> 3, nt = u & 7;
        auto rowoff = [&](int r) { return (unsigned)((mt * 256 + r) * D); };
        auto epi = [&](int r, int c, f32x4 v, f32x4) { uint2 o; o.x = pk2(v[0], v[1]); o.y = pk2(v[2], v[3]); *(uint2*)(proj + (size_t)(mt * 256 + r) * NPROJ + nt * 256 + c) = o; };
        gemm_mfma<false, DIN, 4>(xb, rowoff, p.w_in + nt * 256, nullptr, (unsigned)(((size_t)D * DIN - nt * 256) * 4), D, 256, epi, (unsigned char*)lds);
    }
}

template <int W>
DI void poolmean_item(const bf16_t* proj, bf16_t* pm, int t0, int c2) {
    const int s0 = t0 & (SEQ - 1);
    float p0[48], p1[48]; unsigned raw[32];
    p0[0] = 0.f; p1[0] = 0.f;
#pragma unroll
    for (int i = 0; i < 47; ++i) {
        unsigned v = 0u;
        if (i >= 15 || s0 > 0) v = *(const unsigned*)(proj + (size_t)(t0 - 15 + i) * NPROJ + P_OFF + c2);
        if (i >= 15) raw[i - 15] = v;
        p0[i + 1] = p0[i] + __uint_as_float(v << 16); p1[i + 1] = p1[i] + __uint_as_float(v & 0xffff0000u);
    }
#pragma unroll
    for (int i = 0; i < 32; ++i) {
        const int s = s0 + i; const float inv = 1.f / (float)min(s + 1, W);
        const float m0 = (p0[i + 16] - p0[i + 16 - W]) * inv - __uint_as_float(raw[i] << 16);
        const float m1 = (p1[i + 16] - p1[i + 16 - W]) * inv - __uint_as_float(raw[i] & 0xffff0000u);
        *(unsigned*)(pm + (size_t)(t0 + i) * 512 + c2) = pk2(m0, m1);
    }
}
DI void phase_poolmean(const Params& p, int bid, int nblk, float* lds) {
    const bf16_t* proj = (const bf16_t*)(p.ws + OFF_PROJ); bf16_t* pm = (bf16_t*)(p.ws + OFF_PM);
    for (int item = bid * NT + threadIdx.x; item < 256 * (T / 32); item += nblk * NT) {
        const int pair = item & 255, t0 = (item >> 8) * 32, c2 = pair * 2, g = __builtin_amdgcn_readfirstlane(pair >> 6);
        if (g == 0) poolmean_item<2>(proj, pm, t0, c2);
        else if (g == 1) poolmean_item<4>(proj, pm, t0, c2);
        else if (g == 2) poolmean_item<8>(proj, pm, t0, c2);
        else poolmean_item<16>(proj, pm, t0, c2);
    }
}
DI void phase_pool(const Params& p, int bid, int nblk, float* lds) {
    const bf16_t* pm = (const bf16_t*)(p.ws + OFF_PM); bf16_t* mix = (bf16_t*)(p.ws + OFF_MIX);
    for (int u = bid; u < 64 * 4; u += nblk) {
        const int mt = u >> 2, g = u & 3;
        auto rowoff = [&](int r) { return (unsigned)((mt * 256 + r) * 512 + g * 128); };
        auto epi = [&](int r, int c, f32x4 v, f32x4) { const int col = g * 128 + c; const float4 sc = *(const float4*)(p.pool_scale + col); uint2 o; o.x = pk2(v[0] * sc.x, v[1] * sc.y); o.y = pk2(v[2] * sc.z, v[3] * sc.w); *(uint2*)(mix + (size_t)(mt * 256 + r) * D + col) = o; };
        gemm_mfma<false, 128, 2>(pm, rowoff, p.pool_w + (size_t)g * 16384, nullptr, (unsigned)((4 - g) * 16384 * 4), 128, 256, epi, (unsigned char*)lds);
    }
}

DI unsigned f1_off(unsigned row, unsigned chunk) { return row * 128u + ((chunk ^ ((row >> 1) & 7u)) << 4); }
DI unsigned f2_off(unsigned row, unsigned ch) { return 256u * row + 16u * (ch ^ (((row & 3u) << 2) | ((row >> 2) & 3u))); }
DI bf16x8 f1_frag(const unsigned char* img, int tile, int ks, int lane) { return *(const bf16x8*)(img + f1_off(16 * tile + (lane & 15), 4 * ks + (lane >> 4))); }
DI bf16x8 f2_frag(const unsigned char* img, int c, int ks, int lane) {
    const unsigned g = lane >> 4, q = (lane & 15) >> 2, pp = lane & 3;
    const unsigned a0 = f2_off(32 * ks + 8 * g + q, 2 * c + (pp >> 1)) + 8 * (pp & 1), a1 = f2_off(32 * ks + 8 * g + 4 + q, 2 * c + (pp >> 1)) + 8 * (pp & 1);
    const s16x4 lo = __builtin_amdgcn_ds_read_tr16_b64_v4i16((LAS3 s16x4*)(img + a0)), hi = __builtin_amdgcn_ds_read_tr16_b64_v4i16((LAS3 s16x4*)(img + a1));
    return __builtin_bit_cast(bf16x8, __builtin_shufflevector(lo, hi, 0, 1, 2, 3, 4, 5, 6, 7));
}
DI float bfbits2f(unsigned short v) { return __uint_as_float(((unsigned)v) << 16); }
typedef unsigned short u16x8 __attribute__((ext_vector_type(8)));
typedef unsigned short u16x4 __attribute__((ext_vector_type(4)));

DI void phase_gla1(const Params& p, int bid, int nblk, float* ldsf) {
    unsigned char* lds = (unsigned char*)ldsf;
    int tid_ = threadIdx.x; asm volatile("" : "+v"(tid_));
    const int tid = tid_, lane = tid & 63, w = __builtin_amdgcn_readfirstlane(tid >> 6), t = tid >> 3, ch = tid & 7;
    const bf16_t* proj = (const bf16_t*)(p.ws + OFF_PROJ); const float* glow = (const float*)(p.ws + OFF_GLOW);
    float* Gbuf = (float*)(p.ws + OFF_G); float* Sloc = (float*)(p.ws + OFF_SLOC); float* dec = (float*)(p.ws + OFF_DEC);
    float* G = (float*)lds; unsigned char* Kimg = lds + 16384; unsigned char* Vimg = lds + 32768; float* W2l = (float*)(lds + 49152); float* segtot = (float*)(lds + 53248);
    for (int unit = bid; unit < 1024; unit += nblk) {
        const int bh = unit >> 6, n = unit & 63, b = bh >> 2, h = bh & 3, t0 = b * SEQ + n * SC;
        for (int i = tid; i < 1024; i += NT) W2l[i] = p.gate_w2[(i >> 6) * 256 + h * 64 + (i & 63)];
#pragma unroll
        for (int i = 0; i < 2; ++i) { const int idx = tid + NT * i, tr = idx >> 4, c16 = idx & 15;
            *(u32x4*)(Vimg + f2_off(tr, c16)) = *(const u32x4*)(proj + (size_t)(t0 + tr) * NPROJ + V_OFF + h * 128 + 8 * c16); }
        __syncthreads();
        {
            float gl[16];
#pragma unroll
            for (int q = 0; q < 4; ++q) { const f32x4 v = *(const f32x4*)(glow + (size_t)(t0 + t) * 16 + 4 * q); gl[4 * q] = v[0]; gl[4 * q + 1] = v[1]; gl[4 * q + 2] = v[2]; gl[4 * q + 3] = v[3]; }
#pragma unroll
            for (int dd = 0; dd < 8; ++dd) { const int d = 8 * ch + dd; float z = p.gate_b[h * 64 + d];
#pragma unroll
                for (int r = 0; r < 16; ++r) z += gl[r] * W2l[r * 64 + d];
                G[t * 64 + d] = logsigmoidf_(z) * (1.f / 16.f); }
        }
        __syncthreads();
        {
            const int seg = tid >> 6, d = tid & 63; float run = 0.f;
#pragma unroll
            for (int tt = 0; tt < 8; ++tt) { run += G[(8 * seg + tt) * 64 + d]; G[(8 * seg + tt) * 64 + d] = run; }
            segtot[seg * 64 + d] = run;
            __syncthreads();
            float pre = 0.f;
            for (int s2 = 0; s2 < seg; ++s2) pre += segtot[s2 * 64 + d];
#pragma unroll
            for (int tt = 0; tt < 8; ++tt) G[(8 * seg + tt) * 64 + d] += pre;
        }
        __syncthreads();
        {
            const f32x4 g0 = *(const f32x4*)(G + t * 64 + 8 * ch), g1 = *(const f32x4*)(G + t * 64 + 8 * ch + 4);
            const f32x4 l0 = *(const f32x4*)(G + 63 * 64 + 8 * ch), l1 = *(const f32x4*)(G + 63 * 64 + 8 * ch + 4);
            *(f32x4*)(Gbuf + (size_t)(t0 + t) * 256 + h * 64 + 8 * ch) = g0; *(f32x4*)(Gbuf + (size_t)(t0 + t) * 256 + h * 64 + 8 * ch + 4) = g1;
            const u16x8 kv = *(const u16x8*)(proj + (size_t)(t0 + t) * NPROJ + K_OFF + h * 64 + 8 * ch);
            bf16x8 o;
#pragma unroll
            for (int dd = 0; dd < 4; ++dd) { o[dd] = (__bf16)(bfbits2f(kv[dd]) * __expf(l0[dd] - g0[dd])); o[dd + 4] = (__bf16)(bfbits2f(kv[dd + 4]) * __expf(l1[dd] - g1[dd])); }
            *(bf16x8*)(Kimg + f2_off(t, ch)) = o;
            if (t == 63) {
#pragma unroll
                for (int dd = 0; dd < 4; ++dd) { dec[unit * 64 + 8 * ch + dd] = __expf(l0[dd]); dec[unit * 64 + 8 * ch + 4 + dd] = __expf(l1[dd]); }
            }
        }
        __syncthreads();
        {
            f32x4 acc[4];
#pragma unroll
            for (int dt = 0; dt < 4; ++dt) acc[dt] = (f32x4){0.f, 0.f, 0.f, 0.f};
#pragma unroll
            for (int ks = 0; ks < 2; ++ks) {
                const bf16x8 xv = f2_frag(Vimg, w, ks, lane);
#pragma unroll
                for (int dt = 0; dt < 4; ++dt) acc[dt] = MFMA16(xv, f2_frag(Kimg, dt, ks, lane), acc[dt]);
            }
#pragma unroll
            for (int dt = 0; dt < 4; ++dt) *(f32x4*)(Sloc + (size_t)unit * 8192 + (16 * dt + (lane & 15)) * 128 + 16 * w + 4 * (lane >> 4)) = acc[dt];
        }
        __syncthreads();
    }
}

DI void phase_gla2(const Params& p, int bid, int nblk, float* lds) {
    const float* Sloc = (const float*)(p.ws + OFF_SLOC); const float* dec = (const float*)(p.ws + OFF_DEC); bf16_t* Sin = (bf16_t*)(p.ws + OFF_SIN);
    for (int gid = bid * NT + threadIdx.x; gid < 16 * 8192; gid += nblk * NT) {
        const int bh = gid >> 13, el = gid & 8191, d = el >> 7; float st = 0.f;
        for (int n0 = 0; n0 < NSC; n0 += 16) {
            float sl[16], dc[16]; bf16_t so[16];
#pragma unroll
            for (int i = 0; i < 16; ++i) { const int u = bh * 64 + n0 + i; sl[i] = Sloc[(size_t)u * 8192 + el]; dc[i] = dec[u * 64 + d]; }
#pragma unroll
            for (int i = 0; i < 16; ++i) { so[i] = f2bf(st); st = st * dc[i] + sl[i]; }
#pragma unroll
            for (int i = 0; i < 16; ++i) Sin[(size_t)(bh * 64 + n0 + i) * 8192 + el] = so[i];
        }
    }
}

DI void phase_gla3(const Params& p, int bid, int nblk, float* ldsf) {
    unsigned char* lds = (unsigned char*)ldsf;
    int tid_ = threadIdx.x; asm volatile("" : "+v"(tid_));
    const int tid = tid_, lane = tid & 63, w = __builtin_amdgcn_readfirstlane(tid >> 6), t = tid >> 3, ch = tid & 7, l15 = lane & 15, kg = lane >> 4;
    const bf16_t* proj = (const bf16_t*)(p.ws + OFF_PROJ); const float* Gbuf = (const float*)(p.ws + OFF_G); const bf16_t* Sin = (const bf16_t*)(p.ws + OFF_SIN);
    bf16_t* mix = (bf16_t*)(p.ws + OFF_MIX);
    unsigned char* Qimg = lds; unsigned char* Kimg = lds + 8192; unsigned char* Pimg = lds + 16384; unsigned char* Vimg = lds + 24576; unsigned char* Simg = lds + 40960;
    float* part = (float*)(lds + 57344);
    for (int unit = bid; unit < 1024; unit += nblk) {
        const int bh = unit >> 6, n = unit & 63, b = bh >> 2, h = bh & 3, t0 = b * SEQ + n * SC;
        {
            const f32x4 g0 = *(const f32x4*)(Gbuf + (size_t)(t0 + t) * 256 + h * 64 + 8 * ch), g1 = *(const f32x4*)(Gbuf + (size_t)(t0 + t) * 256 + h * 64 + 8 * ch + 4);
            const u16x8 qv = *(const u16x8*)(proj + (size_t)(t0 + t) * NPROJ + Q_OFF + h * 64 + 8 * ch), kv = *(const u16x8*)(proj + (size_t)(t0 + t) * NPROJ + K_OFF + h * 64 + 8 * ch);
            bf16x8 qo, ko;
#pragma unroll
            for (int dd = 0; dd < 4; ++dd) {
                qo[dd] = (__bf16)(bfbits2f(qv[dd]) * 0.125f * __expf(g0[dd])); qo[dd + 4] = (__bf16)(bfbits2f(qv[dd + 4]) * 0.125f * __expf(g1[dd]));
                ko[dd] = (__bf16)(bfbits2f(kv[dd]) * __expf(-g0[dd])); ko[dd + 4] = (__bf16)(bfbits2f(kv[dd + 4]) * __expf(-g1[dd]));
            }
            *(bf16x8*)(Qimg + f1_off(t, ch)) = qo; *(bf16x8*)(Kimg + f1_off(t, ch)) = ko;
        }
#pragma unroll
        for (int i = 0; i < 2; ++i) { const int idx = tid + NT * i, tr = idx >> 4, c16 = idx & 15;
            *(u32x4*)(Vimg + f2_off(tr, c16)) = *(const u32x4*)(proj + (size_t)(t0 + tr) * NPROJ + V_OFF + h * 128 + 8 * c16);
            *(u32x4*)(Simg + f2_off(tr, c16)) = *(const u32x4*)(Sin + (size_t)unit * 8192 + tr * 128 + 8 * c16); }
        __syncthreads();
        {
            const int it = w >> 1;
#pragma unroll
            for (int jj = 0; jj < 2; ++jj) {
                const int jt = 2 * (w & 1) + jj; f32x4 acc = {0.f, 0.f, 0.f, 0.f};
                if (jt <= it) {
#pragma unroll
                    for (int ks = 0; ks < 2; ++ks) acc = MFMA16(f1_frag(Kimg, jt, ks, lane), f1_frag(Qimg, it, ks, lane), acc);
                    if (jt == it) {
#pragma unroll
                        for (int r = 0; r < 4; ++r) if (4 * kg + r > l15) acc[r] = 0.f;
                    }
                }
                bf16x4 o; o[0] = (__bf16)acc[0]; o[1] = (__bf16)acc[1]; o[2] = (__bf16)acc[2]; o[3] = (__bf16)acc[3];
                *(bf16x4*)(Pimg + f1_off(16 * it + l15, 2 * jt + (kg >> 1)) + 8 * (kg & 1)) = o;
            }
        }
        __syncthreads();
        {
            f32x4 acc[4];
#pragma unroll
            for (int it = 0; it < 4; ++it) acc[it] = (f32x4){0.f, 0.f, 0.f, 0.f};
#pragma unroll
            for (int ks = 0; ks < 2; ++ks) {
                const bf16x8 xv = f2_frag(Vimg, w, ks, lane), xs = f2_frag(Simg, w, ks, lane);
#pragma unroll
                for (int it = 0; it < 4; ++it) {
                    if (2 * ks <= it) acc[it] = MFMA16(xv, f1_frag(Pimg, it, ks, lane), acc[it]);
                    acc[it] = MFMA16(xs, f1_frag(Qimg, it, ks, lane), acc[it]);
                }
            }
#pragma unroll
            for (int it = 0; it < 4; ++it) {
                float ss = acc[it][0] * acc[it][0] + acc[it][1] * acc[it][1] + acc[it][2] * acc[it][2] + acc[it][3] * acc[it][3];
                ss += __shfl_xor(ss, 16); ss += __shfl_xor(ss, 32);
                if (kg == 0) part[w * 64 + 16 * it + l15] = ss;
            }
            __syncthreads();
            const int e0 = 16 * w + 4 * kg; const f32x4 nw = *(const f32x4*)(p.norm_w + e0);
#pragma unroll
            for (int it = 0; it < 4; ++it) {
                const int i = 16 * it + l15; float tot = 0.f;
#pragma unroll
                for (int w2 = 0; w2 < 8; ++w2) tot += part[w2 * 64 + i];
                const float inv = rsqrtf(tot * (1.f / 128.f) + RMS_EPS);
                const u16x4 rv = *(const u16x4*)(proj + (size_t)(t0 + i) * NPROJ + R_OFF + h * 128 + e0);
                bf16x4 o;
#pragma unroll
                for (int r = 0; r < 4; ++r) { const float rr = bfbits2f(rv[r]); o[r] = (__bf16)(acc[it][r] * inv * nw[r] * (rr * sigmoidf_(rr))); }
                *(bf16x4*)(mix + (size_t)(t0 + i) * D + 512 + h * 128 + e0) = o;
            }
        }
        __syncthreads();
    }
}

DI void phase_out(const Params& p, int bid, int nblk, float* lds) {
    const bf16_t* mix = (const bf16_t*)(p.ws + OFF_MIX); float* h32 = (float*)(p.ws + OFF_H32);
    for (int u = bid; u < 64 * 4; u += nblk) {
        const int mt = u >> 2, nt = u & 3;
        auto rowoff = [&](int r) { return (unsigned)((mt * 256 + r) * D); };
        auto epi = [&](int r, int c, f32x4 v, f32x4) { const size_t o = (size_t)(mt * 256 + r) * D + nt * 256 + c; const float4 xv = *(const float4*)(p.x + o); *(float4*)(h32 + o) = make_float4(ALPHA * xv.x + v[0], ALPHA * xv.y + v[1], ALPHA * xv.z + v[2], ALPHA * xv.w + v[3]); };
        gemm_mfma<false, D, 4>(mix, rowoff, p.w_out + nt * 256, nullptr, (unsigned)(((size_t)D * D - nt * 256) * 4), D, 256, epi, (unsigned char*)lds);
    }
}

DI void ln_row(float (&v)[16], const float* g, const float* b, int lane) {
    float s = 0.f;
#pragma unroll
    for (int i = 0; i < 16; ++i) s += v[i];
    const float mean = wave_sum(s) * (1.f / D); float q = 0.f;
#pragma unroll
    for (int i = 0; i < 16; ++i) { v[i] -= mean; q += v[i] * v[i]; }
    const float rstd = rsqrtf(wave_sum(q) * (1.f / D) + LN_EPS);
#pragma unroll
    for (int j = 0; j < 4; ++j) {
        const float4 gg = ((const float4*)g)[lane + 64 * j], bb = ((const float4*)b)[lane + 64 * j];
        v[4 * j] = v[4 * j] * rstd * gg.x + bb.x; v[4 * j + 1] = v[4 * j + 1] * rstd * gg.y + bb.y;
        v[4 * j + 2] = v[4 * j + 2] * rstd * gg.z + bb.z; v[4 * j + 3] = v[4 * j + 3] * rstd * gg.w + bb.w;
    }
}

DI void ln1_rows(const Params& p, int r0, int nrows) {
    int tid_ = threadIdx.x; asm volatile("" : "+v"(tid_));
    const int lane = tid_ & 63, wave = tid_ >> 6;
    float* h32 = (float*)(p.ws + OFF_H32); bf16_t* hb = (bf16_t*)(p.ws + OFF_HB);
    for (int row = r0 + wave; row < r0 + nrows; row += 8) {
        float4* hr = (float4*)(h32 + (size_t)row * D); float v[16];
#pragma unroll
        for (int j = 0; j < 4; ++j) { const float4 a = hr[lane + 64 * j]; v[4 * j] = a.x; v[4 * j + 1] = a.y; v[4 * j + 2] = a.z; v[4 * j + 3] = a.w; }
        ln_row(v, p.ln1_g, p.ln1_b, lane);
#pragma unroll
        for (int j = 0; j < 4; ++j) {
            hr[lane + 64 * j] = make_float4(v[4 * j], v[4 * j + 1], v[4 * j + 2], v[4 * j + 3]);
            uint2 o; o.x = pk2(v[4 * j], v[4 * j + 1]); o.y = pk2(v[4 * j + 2], v[4 * j + 3]);
            ((uint2*)(hb + (size_t)row * D))[lane + 64 * j] = o;
        }
    }
}

DI void topk_rows(const Params& p, int r0, int nrows) {
    int tid_ = threadIdx.x; asm volatile("" : "+v"(tid_));
    const int lane = tid_ & 63, wave = tid_ >> 6;
    const float* scores = (const float*)(p.ws + OFF_SCORES); float* wbuf = (float*)(p.ws + OFF_WBUF);
    int* list = (int*)(p.ws + OFF_LIST); unsigned* cnt = (unsigned*)(p.ws + OFF_CTL) + CW_CNT;
    const float NEG = -__builtin_inff();
    for (int t = r0 + wave; t < r0 + nrows; t += 8) {
        const float4 sv = ((const float4*)(scores + (size_t)t * NE))[lane], bv = ((const float4*)p.router_bias)[lane];
        const float s[4] = {sv.x, sv.y, sv.z, sv.w};
        float cand[4] = {sv.x + bv.x, sv.y + bv.y, sv.z + bv.z, sv.w + bv.w};
        float m1 = NEG, m2 = NEG;
#pragma unroll
        for (int j = 0; j < 4; ++j) { const float v = cand[j]; if (v > m1) { m2 = m1; m1 = v; } else if (v > m2) m2 = v; }
#pragma unroll
        for (int off = 1; off < 8; off <<= 1) {
            const float o1 = __shfl_xor(m1, off), o2 = __shfl_xor(m2, off);
            const float n1 = fmaxf(m1, o1), n2 = fmaxf(fminf(m1, o1), fmaxf(m2, o2)); m1 = n1; m2 = n2;
        }
        const float gs = m1 + m2; const int mygrp = lane >> 3; int rank = 0;
#pragma unroll
        for (int g2 = 0; g2 < 8; ++g2) { const float og = __shfl(gs, g2 * 8); if (og > gs || (og == gs && g2 < mygrp)) ++rank; }
        if (rank >= 4) { cand[0] = NEG; cand[1] = NEG; cand[2] = NEG; cand[3] = NEG; }
        int my_e = 0; float my_w = 0.f, wsum = 0.f;
#pragma unroll
        for (int k = 0; k < TOPK; ++k) {
            float bvv = cand[0]; int bj = 0;
#pragma unroll
            for (int j = 1; j < 4; ++j) if (cand[j] > bvv) { bvv = cand[j]; bj = j; }
            int bi = 4 * lane + bj;
#pragma unroll
            for (int off = 32; off >= 1; off >>= 1) {
                const float ov = __shfl_xor(bvv, off); const int oi = __shfl_xor(bi, off);
                if (ov > bvv || (ov == bvv && oi < bi)) { bvv = ov; bi = oi; }
            }
            const int wj = bi & 3, wl = bi >> 2;
            const float mys = wj == 0 ? s[0] : (wj == 1 ? s[1] : (wj == 2 ? s[2] : s[3]));
            const float wk = __shfl(mys, wl);
            wsum += wk;
            if (lane == k) { my_e = bi; my_w = wk; }
            if (lane == wl) {
#pragma unroll
                for (int j = 0; j < 4; ++j) if (j == wj) cand[j] = NEG;
            }
        }
        if (lane < TOPK) {
            const unsigned pos = atomicAdd(&cnt[my_e], 1u);
            list[(size_t)my_e * LCAP + pos] = t * TOPK + lane;
            wbuf[(size_t)t * TOPK + lane] = my_w / wsum * 2.5f;
        }
    }
}

DI void phase_route(const Params& p, int bid, int nblk, float* lds) {
    const bf16_t* hb = (const bf16_t*)(p.ws + OFF_HB); float* scores = (float*)(p.ws + OFF_SCORES);
    for (int mt = bid; mt < T / 64; mt += nblk) {
        ln1_rows(p, mt * 64, 64);
        __syncthreads();
        auto rowoff = [&](int r) { return (unsigned)((mt * 64 + r) * D); };
        auto epi = [&](int r, int c, f32x4 v, f32x4) { *(float4*)(scores + (size_t)(mt * 64 + r) * NE + c) = make_float4(sigmoidf_(v[0]), sigmoidf_(v[1]), sigmoidf_(v[2]), sigmoidf_(v[3])); };
        gemm_mfma<false, NE, 4>(hb, rowoff, p.router_w, nullptr, (unsigned)(D * NE * 4), D, 64, epi, (unsigned char*)lds);
        __syncthreads();
        topk_rows(p, mt * 64, 64);
        __syncthreads();
    }
}

constexpr int EXP_TAB_OFF = GEMM_LDS_BYTES;
DI void build_tables(const Params& p, int* toff, int* roff) {
    const unsigned* cnt = (const unsigned*)(p.ws + OFF_CTL) + CW_CNT;
    int* cl = roff + 260;
    if (threadIdx.x < NE) cl[threadIdx.x] = (int)__hip_atomic_load(cnt + threadIdx.x, __ATOMIC_RELAXED, __HIP_MEMORY_SCOPE_AGENT);
    __syncthreads();
    if (threadIdx.x <= NE) {
        int ta = 0, ra = 0;
        for (int e = 0; e < (int)threadIdx.x; ++e) { const int c = cl[e]; ta += (c + 255) >> 8; ra += c; }
        toff[threadIdx.x] = ta; roff[threadIdx.x] = ra;
    }
    __syncthreads();
}
DI int find_expert(const int* toff, int tile) { int lo = 0, hi = NE - 1; while (lo < hi) { const int mid = (lo + hi + 1) >> 1; if (toff[mid] <= tile) lo = mid; else hi = mid - 1; } return lo; }
struct ExpUnit { int e, row0, rows, rowbase; };
DI ExpUnit exp_unit(const Params& p, const int* toff, const int* roff, int tile, int ntile) {
    const unsigned* cnt = (const unsigned*)(p.ws + OFF_CTL) + CW_CNT;
    ExpUnit u;
    if (tile < ntile) {
        u.e = find_expert(toff, tile); const int ui = tile - toff[u.e], c = (int)cnt[u.e];
        u.row0 = ui * 256; u.rows = min(256, c - u.row0); u.rowbase = roff[u.e] + u.row0;
    } else { u.e = NE; u.row0 = (tile - ntile) * 256; u.rows = 256; u.rowbase = A_TOT + u.row0; }
    u.e = __builtin_amdgcn_readfirstlane(u.e); u.row0 = __builtin_amdgcn_readfirstlane(u.row0); u.rows = __builtin_amdgcn_readfirstlane(u.rows);
    u.rowbase = __builtin_amdgcn_readfirstlane(u.rowbase);
    return u;
}

DI void phase_e1(const Params& p, int bid, int nblk, float* lds) {
    int* toff = (int*)((unsigned char*)lds + EXP_TAB_OFF); int* roff = toff + 260;
    const bf16_t* hb = (const bf16_t*)(p.ws + OFF_HB); bf16_t* hid = (bf16_t*)(p.ws + OFF_HID); const int* list = (const int*)(p.ws + OFF_LIST);
    build_tables(p, toff, roff);
    const int ntile = toff[NE], units = (ntile + T / 256) * 2;
    const int vb = (nblk & 7) ? bid : (bid & 7) * (nblk >> 3) + (bid >> 3);
    for (int u = vb; u < units; u += nblk) {
        int tile, nt;
        if (u < 2 * ntile) { const int e = find_expert(toff, u >> 1), ne = toff[e + 1] - toff[e], u2 = u - 2 * toff[e]; nt = u2 / ne; tile = toff[e] + (u2 - nt * ne); }
        else { const int us = u - 2 * ntile; nt = us / (T / 256); tile = ntile + (us - nt * (T / 256)); }
        const ExpUnit x = exp_unit(p, toff, roff, tile, ntile);
        const float* wg = x.e < NE ? p.wg + (size_t)x.e * 262144 : p.sg; const float* wu = x.e < NE ? p.wu + (size_t)x.e * 262144 : p.su;
        auto rowoff = [&](int r) { const int tok = x.e < NE ? (list[(size_t)x.e * LCAP + x.row0 + r] >> 3) : (x.row0 + r); return (unsigned)(tok * D); };
        auto epi = [&](int r, int c, f32x4 g, f32x4 uu) { if (r < x.rows) { uint2 o; o.x = pk2(g[0] * sigmoidf_(g[0]) * uu[0], g[1] * sigmoidf_(g[1]) * uu[1]); o.y = pk2(g[2] * sigmoidf_(g[2]) * uu[2], g[3] * sigmoidf_(g[3]) * uu[3]); *(uint2*)(hid + (size_t)(x.rowbase + r) * EDIM + nt * 128 + c) = o; } };
        gemm_mfma<true, EDIM, 4>(hb, rowoff, wg + nt * 128, wu + nt * 128, (unsigned)((D * EDIM - nt * 128) * 4), D, x.rows, epi, (unsigned char*)lds);
    }
}

DI void phase_e2(const Params& p, int bid, int nblk, float* lds) {
    int* toff = (int*)((unsigned char*)lds + EXP_TAB_OFF); int* roff = toff + 260; int* rowa = roff + 520;
    const bf16_t* hid = (const bf16_t*)(p.ws + OFF_HID); bf16_t* Y = (bf16_t*)(p.ws + OFF_Y); const int* list = (const int*)(p.ws + OFF_LIST);
    build_tables(p, toff, roff);
    const int ntile = toff[NE], units = (ntile + T / 256) * 4;
    const int vb = (nblk & 7) ? bid : (bid & 7) * (nblk >> 3) + (bid >> 3);
    for (int u = vb; u < units; u += nblk) {
        int tile, nt;
        if (u < 4 * ntile) { const int e = find_expert(toff, u >> 2), ne = toff[e + 1] - toff[e], u2 = u - 4 * toff[e]; nt = u2 / ne; tile = toff[e] + (u2 - nt * ne); }
        else { const int us = u - 4 * ntile; nt = us / (T / 256); tile = ntile + (us - nt * (T / 256)); }
        const ExpUnit x = exp_unit(p, toff, roff, tile, ntile);
        const float* wd = x.e < NE ? p.wd + (size_t)x.e * 262144 : p.sd;
        if (threadIdx.x < 256) { const int r = threadIdx.x; rowa[r] = x.e < NE ? (r < x.rows ? list[(size_t)x.e * LCAP + x.row0 + r] : 0) : (A_TOT + x.row0 + r); }
        __syncthreads();
        auto rowoff = [&](int r) { return (unsigned)((x.rowbase + r) * EDIM); };
        auto epi = [&](int r, int c, f32x4 v, f32x4) { if (r < x.rows) { uint2 o; o.x = pk2(v[0], v[1]); o.y = pk2(v[2], v[3]); *(uint2*)(Y + (size_t)rowa[r] * D + nt * 256 + c) = o; } };
        gemm_mfma<false, D, 4>(hid, rowoff, wd + nt * 256, nullptr, (unsigned)((EDIM * D - nt * 256) * 4), EDIM, x.rows, epi, (unsigned char*)lds);
        __syncthreads();
    }
}

DI void phase_combine(const Params& p, int bid, int nblk, float* lds) {
    const int lane = threadIdx.x & 63, wave = threadIdx.x >> 6;
    const float* h32 = (const float*)(p.ws + OFF_H32); const bf16_t* Y = (const bf16_t*)(p.ws + OFF_Y); const float* wbuf = (const float*)(p.ws + OFF_WBUF);
    for (int t = bid * 8 + wave; t < T; t += nblk * 8) {
        float v[16];
#pragma unroll
        for (int j = 0; j < 4; ++j) { const float4 a = ((const float4*)(h32 + (size_t)t * D))[lane + 64 * j]; v[4 * j] = ALPHA * a.x; v[4 * j + 1] = ALPHA * a.y; v[4 * j + 2] = ALPHA * a.z; v[4 * j + 3] = ALPHA * a.w; }
#pragma unroll
        for (int k = 0; k < 9; ++k) {
            const size_t row = k < 8 ? (size_t)t * TOPK + k : (size_t)A_TOT + t; const float w = k < 8 ? wbuf[(size_t)t * TOPK + k] : 1.f;
#pragma unroll
            for (int j = 0; j < 4; ++j) {
                const uint2 y = ((const uint2*)(Y + row * D))[lane + 64 * j];
                v[4 * j] += w * __uint_as_float(y.x << 16); v[4 * j + 1] += w * __uint_as_float(y.x & 0xffff0000u);
                v[4 * j + 2] += w * __uint_as_float(y.y << 16); v[4 * j + 3] += w * __uint_as_float(y.y & 0xffff0000u);
            }
        }
        ln_row(v, p.ln2_g, p.ln2_b, lane);
#pragma unroll
        for (int j = 0; j < 4; ++j) ((float4*)(p.out + (size_t)t * D))[lane + 64 * j] = make_float4(v[4 * j], v[4 * j + 1], v[4 * j + 2], v[4 * j + 3]);
    }
}

#define LAS __attribute__((address_space(3)))
#define XB_TMO      128
#define XB_XCNT(j)  (256  + 64 * (j))
#define XB_XSUB(j)  (1280 + 64 * (j))
#define XB_XGEN(j)  (2304 + 64 * (j))
#define XB_TOP      3328
#define XB_TOPGEN   3392
#define XCD_BAR_WORDS 3456
#define XB_SPIN_CAP (1u << 22)
constexpr int CW_BAR = 4096;
DI unsigned xb_ld(unsigned* p) { return __hip_atomic_load(p, __ATOMIC_RELAXED, __HIP_MEMORY_SCOPE_AGENT); }
DI unsigned xb_add(unsigned* p, unsigned v) { return __hip_atomic_fetch_add(p, v, __ATOMIC_RELAXED, __HIP_MEMORY_SCOPE_AGENT); }
DI unsigned xb_xcc_id() { return (unsigned)__builtin_amdgcn_s_getreg((3 << 11) | 20) & 0xFu; }
#define XB_SPIN(cond, bar) do { unsigned _sp = 0; while (cond) { __builtin_amdgcn_s_sleep(1); \
    if ((++_sp & 255u) == 0u) { if (xb_ld(&(bar)[XB_TMO])) break; if (_sp > XB_SPIN_CAP) { atomicAdd(&(bar)[XB_TMO], 1u); break; } } } } while (0)
struct XcdBarrier { unsigned* bar; unsigned x; volatile LAS unsigned* st; };
DI XcdBarrier xcd_barrier_post(unsigned* bar, volatile LAS unsigned* st) {
    XcdBarrier b; b.bar = bar; b.x = xb_xcc_id(); b.st = st;
    if (threadIdx.x == 0) (void)xb_add(&bar[XB_XCNT(b.x)], 1u);
    return b;
}
DI void xcd_barrier_complete(unsigned* bar, unsigned x, unsigned& nloc, unsigned& nx) {
    const unsigned G = gridDim.x * gridDim.y * gridDim.z;
    unsigned sum, cnt, mine, sp = 0u;
    for (;;) {
        sum = 0u; cnt = 0u; mine = 0u;
#pragma unroll
        for (unsigned j = 0; j < 16; ++j) { const unsigned c = xb_ld(&bar[XB_XCNT(j)]); sum += c; cnt += (c > 0u) ? 1u : 0u; mine = (j == x) ? c : mine; }
        if (sum == G) break;
        __builtin_amdgcn_s_sleep(1);
        if ((++sp & 255u) == 0u) { if (xb_ld(&bar[XB_TMO])) break; if (sp > XB_SPIN_CAP) { atomicAdd(&bar[XB_TMO], 1u); break; } }
    }
    nloc = mine > 0u ? mine : 1u; nx = cnt > 0u ? cnt : 1u;
}
DI void xcd_barrier(const XcdBarrier& b) {
    asm volatile("s_waitcnt vmcnt(0)" ::: "memory");
    __syncthreads();
    if (threadIdx.x == 0) {
        unsigned* bar = b.bar;
        __builtin_amdgcn_s_waitcnt(0);
        unsigned nloc = b.st[0], nx = b.st[1];
        if (nloc == 0u) { xcd_barrier_complete(bar, b.x, nloc, nx); b.st[0] = nloc; b.st[1] = nx; }
        const unsigned old = xb_add(&bar[XB_XSUB(b.x)], 1u);
        const unsigned gen = old / nloc;
        if (old + 1u == (gen + 1u) * nloc) {
            __builtin_amdgcn_fence(__ATOMIC_RELEASE, "agent");
            asm volatile("s_waitcnt vmcnt(0)" ::: "memory");
            const unsigned og = xb_add(&bar[XB_TOP], 1u);
            const unsigned tg = og / nx;
            if (og + 1u == (tg + 1u) * nx) xb_add(&bar[XB_TOPGEN], 1u);
            else XB_SPIN(xb_ld(&bar[XB_TOPGEN]) == tg, bar);
            __builtin_amdgcn_fence(__ATOMIC_ACQUIRE, "agent");
            xb_add(&bar[XB_XGEN(b.x)], 1u);
            asm volatile("s_waitcnt vmcnt(0)" ::: "memory");
        } else {
            XB_SPIN(xb_ld(&bar[XB_XGEN(b.x)]) == gen, bar);
            __builtin_amdgcn_fence(__ATOMIC_ACQUIRE, "agent");
            asm volatile("s_waitcnt vmcnt(0)" ::: "memory");
        }
    }
    __syncthreads();
}

constexpr int LDS_BYTES = 136 * 1024;
constexpr int LDS_BAR_OFF = LDS_BYTES - 16;
__global__ void __launch_bounds__(NT) fwd_megakernel(Params p) {
    extern __shared__ __attribute__((aligned(16))) float lds[];
    const int bid = blockIdx.x, nblk = gridDim.x;
    volatile LAS unsigned* st = (volatile LAS unsigned*)((LAS unsigned char*)lds + LDS_BAR_OFF);
    if (threadIdx.x < 4) st[threadIdx.x] = 0u;
    __syncthreads();
    XcdBarrier bar = xcd_barrier_post((unsigned*)(p.ws + OFF_CTL) + CW_BAR, st);
    phase_prep(p, bid, nblk, lds);      xcd_barrier(bar);
    phase_proj(p, bid, nblk, lds);      xcd_barrier(bar);
    phase_poolmean(p, bid, nblk, lds);
    phase_gla1(p, bid, nblk, lds);      xcd_barrier(bar);
    phase_pool(p, bid, nblk, lds);
    phase_gla2(p, bid, nblk, lds);      xcd_barrier(bar);
    phase_gla3(p, bid, nblk, lds);      xcd_barrier(bar);
    phase_out(p, bid, nblk, lds);       xcd_barrier(bar);
    phase_route(p, bid, nblk, lds);     xcd_barrier(bar);
    phase_e1(p, bid, nblk, lds);        xcd_barrier(bar);
    phase_e2(p, bid, nblk, lds);        xcd_barrier(bar);
    phase_combine(p, bid, nblk, lds);
}

extern "C" void kernel_launch(void* const* d_in, const int* in_sizes, int n_in, void* d_out, int out_size, void* d_ws, size_t ws_size, hipStream_t stream) {
    static int grid = 0;
    if (grid == 0) {
        if (n_in != 20 || ws_size < WS_NEED) { fprintf(stderr, "kernel_launch: unexpected n_in %d or ws_size %zu (< %zu)\n", n_in, ws_size, (size_t)WS_NEED); grid = -1; return; }
        int dev = 0, cus = 0, per_cu = 0;
        (void)hipGetDevice(&dev); (void)hipDeviceGetAttribute(&cus, hipDeviceAttributeMultiprocessorCount, dev);
        (void)hipFuncSetAttribute((const void*)fwd_megakernel, hipFuncAttributeMaxDynamicSharedMemorySize, LDS_BYTES);
        (void)hipOccupancyMaxActiveBlocksPerMultiprocessor(&per_cu, (const void*)fwd_megakernel, NT, LDS_BYTES);
        if (per_cu < 1 || cus < 1) { fprintf(stderr, "kernel_launch: occupancy query says %d blocks/CU on %d CUs\n", per_cu, cus); grid = -1; return; }
        grid = cus;
    }
    if (grid < 0) return;
    (void)hipMemsetAsync((char*)d_ws + OFF_CTL, 0, 64 * 1024, stream);
    Params p{};
    const float** pp = (const float**)&p;
    for (int i = 0; i < 20; ++i) pp[i] = (const float*)d_in[i];
    p.out = (float*)d_out; p.ws = (unsigned char*)d_ws;
    void* args[] = {&p};
    hipError_t e = hipLaunchCooperativeKernel((const void*)fwd_megakernel, dim3(grid), dim3(NT), args, LDS_BYTES, stream);
    if (e != hipSuccess) fprintf(stderr, "cooperative launch failed: %s (grid %d)\n", hipGetErrorString(e), grid);
}
```

```cpp
#include <hip/hip_runtime.h>
#include <stdint.h>
#include <cstdio>

#define DI __device__ __forceinline__
typedef unsigned short bf16_t;

constexpr int T = 16384, D = 1024, SEQ = 4096;
constexpr int DIN = 2064, NPROJ = 2048;
constexpr int P_OFF = 0, Q_OFF = 512, K_OFF = 768, V_OFF = 1024, R_OFF = 1536, GL_OFF = 2048;
constexpr int SC = 64;
constexpr int NSC = SEQ / SC;
constexpr int NE = 256, TOPK = 8, EDIM = 256;
constexpr int A_TOT = T * TOPK;
constexpr int LCAP = T;
constexpr float ALPHA = 1.189207115002721f;
constexpr float LN_EPS = 1e-5f, RMS_EPS = 1e-5f;
constexpr int NT = 512;

constexpr size_t MiB = 1u << 20;
constexpr size_t OFF_CTL = 0;
constexpr size_t OFF_XB = 1 * MiB;
constexpr size_t OFF_GLOW = OFF_XB + 32 * MiB;
constexpr size_t OFF_PROJ = OFF_GLOW + 1 * MiB;
constexpr size_t OFF_G = OFF_PROJ + 64 * MiB;
constexpr size_t OFF_SLOC = OFF_G + 16 * MiB;
constexpr size_t OFF_DEC = OFF_SLOC + 32 * MiB;
constexpr size_t OFF_SIN = OFF_DEC + 1 * MiB;
constexpr size_t OFF_MIX = OFF_SIN + 32 * MiB;
constexpr size_t OFF_H32 = OFF_MIX + 32 * MiB;
constexpr size_t OFF_HB = OFF_H32 + 64 * MiB;
constexpr size_t OFF_SCORES = OFF_HB + 32 * MiB;
constexpr size_t OFF_WBUF = OFF_SCORES + 16 * MiB;
constexpr size_t OFF_LIST = OFF_WBUF + 1 * MiB;
constexpr size_t OFF_HID = OFF_LIST + 16 * MiB;
constexpr size_t OFF_Y = OFF_HID + 76 * MiB;
constexpr size_t OFF_PM = OFF_Y + 304 * MiB;
constexpr size_t OFF_WB_IN = OFF_PM + 16 * MiB;
constexpr size_t OFF_WB_OUT = OFF_WB_IN + 4 * MiB;
constexpr size_t OFF_WB_RT = OFF_WB_OUT + 2 * MiB;
constexpr size_t OFF_WB_SGU = OFF_WB_RT + 1 * MiB;
constexpr size_t OFF_WB_SD = OFF_WB_SGU + 1 * MiB;
constexpr size_t WS_NEED = OFF_WB_SD + 1 * MiB;
constexpr int CW_CNT = 1024;

struct Params {
    const float *x, *w_in, *gate_w2, *gate_b, *norm_w, *pool_w, *pool_scale, *w_out, *ln1_g, *ln1_b;
    const float *router_w, *router_bias, *wg, *wu, *wd, *sg, *su, *sd, *ln2_g, *ln2_b;
    float* out;
    unsigned char* ws;
};

DI float bf2f(bf16_t v) { return __uint_as_float(((unsigned)v) << 16); }
DI bf16_t f2bf(float f) { unsigned u = __float_as_uint(f); u += 0x7fffu + ((u >> 16) & 1u); return (bf16_t)(u >> 16); }
DI unsigned pk2(float lo, float hi) { return (unsigned)f2bf(lo) | ((unsigned)f2bf(hi) << 16); }
DI float wave_sum(float v) {
#pragma unroll
    for (int o = 1; o < 64; o <<= 1) v += __shfl_xor(v, o);
    return v;
}
DI float sigmoidf_(float v) { return 1.f / (1.f + __expf(-v)); }
DI float logsigmoidf_(float z) { return fminf(z, 0.f) - log1pf(__expf(-fabsf(z))); }

constexpr int GT_LDS_FLOATS = 16 * 132 + 2 * 16 * 68;
template <bool DUAL, class AF, class BF, class EPI>
DI void gemm_tile_valu(int K, const AF& af, const BF& bfn, const EPI& epi, float* lds) {
    float* As = lds; float* Bs = lds + 16 * 132; float* Bs2 = Bs + 16 * 68;
    const int tid = threadIdx.x, ty = tid >> 4, tx = tid & 15;
    float acc[4][4], acc2[4][4];
#pragma unroll
    for (int i = 0; i < 4; ++i)
#pragma unroll
        for (int j = 0; j < 4; ++j) { acc[i][j] = 0.f; acc2[i][j] = 0.f; }
    for (int k0 = 0; k0 < K; k0 += 16) {
#pragma unroll
        for (int i = 0; i < 4; ++i) { const int e = tid + 512 * i, r = e >> 4, kk = e & 15; As[kk * 132 + r] = af(r, k0 + kk); }
#pragma unroll
        for (int i = 0; i < 2; ++i) { const int e = tid + 512 * i, kk = e >> 6, c = e & 63; Bs[kk * 68 + c] = bfn(0, k0 + kk, c); if (DUAL) Bs2[kk * 68 + c] = bfn(1, k0 + kk, c); }
        __syncthreads();
#pragma unroll
        for (int kk = 0; kk < 16; ++kk) {
            const float4 a = *(const float4*)&As[kk * 132 + ty * 4];
            const float4 b = *(const float4*)&Bs[kk * 68 + tx * 4];
            const float av[4] = {a.x, a.y, a.z, a.w}, bv[4] = {b.x, b.y, b.z, b.w};
#pragma unroll
            for (int i = 0; i < 4; ++i)
#pragma unroll
                for (int j = 0; j < 4; ++j) acc[i][j] += av[i] * bv[j];
            if (DUAL) {
                const float4 b2 = *(const float4*)&Bs2[kk * 68 + tx * 4];
                const float b2v[4] = {b2.x, b2.y, b2.z, b2.w};
#pragma unroll
                for (int i = 0; i < 4; ++i)
#pragma unroll
                    for (int j = 0; j < 4; ++j) acc2[i][j] += av[i] * b2v[j];
            }
        }
        __syncthreads();
    }
#pragma unroll
    for (int i = 0; i < 4; ++i)
#pragma unroll
        for (int j = 0; j < 4; ++j) epi(ty * 4 + i, tx * 4 + j, acc[i][j], acc2[i][j]);
}


typedef __bf16 bf16x8 __attribute__((ext_vector_type(8)));
typedef __bf16 bf16x4 __attribute__((ext_vector_type(4)));
typedef short s16x4 __attribute__((ext_vector_type(4)));
typedef float f32x4 __attribute__((ext_vector_type(4)));
typedef unsigned u32x4 __attribute__((ext_vector_type(4)));
#define LAS3 __attribute__((address_space(3)))
DI const float* uniform_ptr(const float* p) {
    const unsigned long long v = (unsigned long long)p;
    const unsigned lo = __builtin_amdgcn_readfirstlane((unsigned)v), hi = __builtin_amdgcn_readfirstlane((unsigned)(v >> 32));
    return (const float*)(((unsigned long long)hi << 32) | lo);
}
#define MFMA16(a, b, c) __builtin_amdgcn_mfma_f32_16x16x32_bf16((a), (b), (c), 0, 0, 0)
constexpr int GEMM_LDS_BYTES = 65536;
DI unsigned a_swz(unsigned x) { return (0x78u >> (2u * x)) & 3u; }
struct GemmRegs { u32x4 ra[2][2], rb[2][4]; };
template <bool DUAL, bool BK16, bool F32OUT, int LDB, int WN, class RowFn, class RowFnN, class Pre, class Fin>
DI void gemm_core(u32x4 (&Rra)[2][2], u32x4 (&Rrb)[2][4], unsigned (&aoffc)[2], bool preloaded, const bf16_t* Ab, const RowFn& rowoff, const float* B0, const float* B1, unsigned bbytes, int K, int rows,
                  bool has_next, const RowFnN& rowoff_n, const float* B0n, const float* B1n, unsigned bbytes_n, int rows_n, const Pre& pre, const Fin& fin, unsigned char* lds) {
    int tid_ = threadIdx.x; asm volatile("" : "+v"(tid_));
    const int tid = tid_, lane = tid & 63, w = __builtin_amdgcn_readfirstlane(tid >> 6), wm = w >> 2, wn = w & 3, l15 = lane & 15, kg = lane >> 4, t256 = tid & 255;
    const bool active = wn < WN;
    const int nrow_w = min(max(rows - 128 * wm, 0), 128), ngrp = (((nrow_w + 15) >> 4) + 1) >> 1;
    unsigned aoff[2];
#pragma unroll
    for (int i = 0; i < 2; ++i) aoff[i] = preloaded ? aoffc[i] : (rowoff(min(128 * wm + (t256 >> 2) + 64 * i, rows - 1)) + (t256 & 3) * 8) * 2u;
    const __amdgpu_buffer_rsrc_t ar = __builtin_amdgcn_make_buffer_rsrc((void*)Ab, 0, 0x7fffffff, 0x00020000);
    const unsigned awr = (128 * wm + (t256 >> 2)) * 64 + ((((unsigned)(t256 & 3)) ^ a_swz((t256 >> 4) & 3)) << 4);
    constexpr int NB = BK16 ? 2 : 4;
    const float* bsrc = uniform_ptr(DUAL && !BK16 ? ((wn >> 1) ? B1 : B0) : B0);
    const __amdgpu_buffer_rsrc_t br = __builtin_amdgcn_make_buffer_rsrc((void*)bsrc, 0, bbytes, 0x00020000);
    const unsigned bvoff = BK16 ? (unsigned)(((lane >> 5) * LDB + (lane & 31) * 8) * 2) : (DUAL ? (unsigned)(((lane >> 5) * LDB + (lane & 31) * 4) * 4) : (unsigned)(lane * 16));
    const int krow0 = BK16 ? 16 * wm + 2 * wn : (DUAL ? 16 * wm + 8 * (wn & 1) : 16 * wm + wn);
    constexpr int KSTEP = BK16 ? 8 : (DUAL ? 2 : 4), ESZ = BK16 ? 2 : 4;
    unsigned aoff_n[2];
#pragma unroll
    for (int i = 0; i < 2; ++i) aoff_n[i] = has_next ? (rowoff_n(min(128 * wm + (t256 >> 2) + 64 * i, rows_n - 1)) + (t256 & 3) * 8) * 2u : 0u;
    const float* bsrc_n = uniform_ptr(has_next ? (DUAL && !BK16 ? ((wn >> 1) ? B1n : B0n) : B0n) : bsrc);
    const __amdgpu_buffer_rsrc_t br_n = __builtin_amdgcn_make_buffer_rsrc((void*)bsrc_n, 0, has_next ? bbytes_n : bbytes, 0x00020000);
    unsigned bwr[NB];
#pragma unroll
    for (int i = 0; i < NB; ++i) {
        const int kb = krow0 + KSTEP * i + ((BK16 || DUAL) ? (lane >> 5) : 0);
        const int n = BK16 ? 8 * (lane & 31) : (DUAL ? (wn >> 1) * 128 + 4 * (lane & 31) : 4 * lane);
        const unsigned I = n >> 7, ch = (n & 127) >> 3, half = BK16 ? 0u : (unsigned)((n >> 2) & 1), xx = ((kb & 3) << 2) | ((kb >> 2) & 3);
        bwr[i] = 32768u + I * 8192u + 256u * kb + 16u * (ch ^ xx) + 8u * half;
    }
    const unsigned ard = (128 * wm + l15) * 64 + ((((unsigned)kg) ^ a_swz((l15 >> 2) & 3)) << 4);
    unsigned trd0, trd1;
    {
        const unsigned q = l15 >> 2, pp = l15 & 3, cbase = (DUAL ? 4u * wn : 8u * (wn & 1)) + (pp >> 1), ibase = DUAL ? 0u : (unsigned)(wn >> 1);
        const unsigned x0 = (q << 2) | ((2u * kg) & 3u), x1 = (q << 2) | ((2u * kg + 1u) & 3u);
        trd0 = 32768u + ibase * 8192u + 256u * (8u * kg + q) + 16u * (cbase ^ x0) + 8u * (pp & 1);
        trd1 = 32768u + ibase * 8192u + 256u * (8u * kg + 4u + q) + 16u * (cbase ^ x1) + 8u * (pp & 1);
    }
    f32x4 acc[8][4];
#pragma unroll
    for (int i = 0; i < 8; ++i)
#pragma unroll
        for (int f = 0; f < 4; ++f) acc[i][f] = (f32x4){0.f, 0.f, 0.f, 0.f};
    const int nj = K / 32;
#define LOAD_SET(S, j) { _Pragma("unroll") for (int i = 0; i < 2; ++i) Rra[S][i] = __builtin_bit_cast(u32x4, __builtin_amdgcn_raw_buffer_load_b128(ar, aoff[i], (j) * 64, 0)); \
        _Pragma("unroll") for (int i = 0; i < NB; ++i) Rrb[S][i] = __builtin_bit_cast(u32x4, __builtin_amdgcn_raw_buffer_load_b128(br, bvoff, ((j) * 32 + krow0 + KSTEP * i) * (LDB * ESZ), 0)); }
#define LOAD_SET_N(S, j) { _Pragma("unroll") for (int i = 0; i < 2; ++i) Rra[S][i] = __builtin_bit_cast(u32x4, __builtin_amdgcn_raw_buffer_load_b128(ar, aoff_n[i], (j) * 64, 0)); \
        _Pragma("unroll") for (int i = 0; i < NB; ++i) Rrb[S][i] = __builtin_bit_cast(u32x4, __builtin_amdgcn_raw_buffer_load_b128(br_n, bvoff, ((j) * 32 + krow0 + KSTEP * i) * (LDB * ESZ), 0)); }
#define WRITE_SET(S, st) { _Pragma("unroll") for (int i = 0; i < 2; ++i) *(u32x4*)(lds + (st) * 16384 + awr + i * 4096) = Rra[S][i]; \
        _Pragma("unroll") for (int i = 0; i < NB; ++i) { if (BK16) *(u32x4*)(lds + (st) * 16384 + bwr[i]) = Rrb[S][i]; else { \
            const f32x4 v = __builtin_bit_cast(f32x4, Rrb[S][i]); bf16x4 o; o[0] = (__bf16)v[0]; o[1] = (__bf16)v[1]; o[2] = (__bf16)v[2]; o[3] = (__bf16)v[3]; \
            *(bf16x4*)(lds + (st) * 16384 + bwr[i]) = o; } } }
#define W_PHASE(S, st, jw, jl) { if ((jw) < nj) WRITE_SET(S, st) if ((jl) < nj) LOAD_SET(S, jl) else if (has_next && (jl) < nj + 2) LOAD_SET_N(S, (jl) - nj) }
#define TF_LOAD(dst, st, g) { _Pragma("unroll") for (int q_ = 0; q_ < 2; ++q_) dst[q_] = *(const bf16x8*)(lds + (st) * 16384 + ((g) * 2 + q_) * 1024 + ard); }
#define WF_LOAD(st) { _Pragma("unroll") for (int f = 0; f < 4; ++f) { \
        const unsigned fx = DUAL ? ((f & 1) << 5) : (f << 5), fo = (DUAL ? (f >> 1) * 8192 : 0) + (st) * 16384; \
        const s16x4 lo = __builtin_amdgcn_ds_read_tr16_b64_v4i16((LAS3 s16x4*)(lds + ((trd0 ^ fx) + fo))); \
        const s16x4 hi = __builtin_amdgcn_ds_read_tr16_b64_v4i16((LAS3 s16x4*)(lds + ((trd1 ^ fx) + fo))); \
        wf[f] = __builtin_bit_cast(bf16x8, __builtin_shufflevector(lo, hi, 0, 1, 2, 3, 4, 5, 6, 7)); } }
#define STAGE_MMA(srcf, g) { _Pragma("unroll") for (int q_ = 0; q_ < 2; ++q_) _Pragma("unroll") for (int f = 0; f < 4; ++f) acc[(g) * 2 + q_][f] = MFMA16(wf[f], srcf[q_], acc[(g) * 2 + q_][f]); }
#define STAGE(st, g, cur, nxt) if ((g) < ngrp) { \
        if ((g) + 1 < 4 && (g) + 1 < ngrp) TF_LOAD(nxt, st, (g) + 1) \
        __builtin_amdgcn_sched_barrier(0); \
        STAGE_MMA(cur, g) \
        __builtin_amdgcn_sched_barrier(0); }
#define COMPUTE(st) if (active && ngrp > 0) { bf16x8 fa[2], fb[2], wf[4]; WF_LOAD(st) TF_LOAD(fa, st, 0) STAGE(st, 0, fa, fb) STAGE(st, 1, fb, fa) STAGE(st, 2, fa, fb) STAGE(st, 3, fb, fa) }
    constexpr bool STAGGER = !BK16;
    const int sg = STAGGER ? wm : 0;
    if (!preloaded) { LOAD_SET(0, sg) LOAD_SET(1, 1 - sg) }
    if (sg == 0) { WRITE_SET(0, 0) LOAD_SET(0, 2) }
    else         { WRITE_SET(1, 0) LOAD_SET(1, 2) }
    __syncthreads();
    if (sg == 1) { WRITE_SET(0, 1) LOAD_SET(0, 3) __syncthreads(); }
    const int sA = sg ? 0 : 1, sB = sg ? 1 : 0;
#pragma unroll 1
    for (int j = 0; j < nj; j += 2) {
        COMPUTE(0)
        if (STAGGER) __syncthreads();
        W_PHASE(1, sA, j + 1 + sg, j + 3 + sg)
        __syncthreads();
        COMPUTE(1)
        if (STAGGER) __syncthreads();
        W_PHASE(0, sB, j + 2 + sg, j + 4 + sg)
        __syncthreads();
    }
    if (STAGGER && wm == 0) __syncthreads();
#undef LOAD_SET
#undef LOAD_SET_N
#undef WRITE_SET
#undef W_PHASE
#undef TF_LOAD
#undef WF_LOAD
#undef STAGE_MMA
#undef STAGE
#undef COMPUTE
    aoffc[0] = aoff_n[0]; aoffc[1] = aoff_n[1];
    {
        constexpr int NF = DUAL ? 2 : 4, ROWB = NF * 16 * (F32OUT ? 4 : 2), NCH = ROWB / 16, RPR = 8192 / ROWB, RPI = 64 / NCH, NROUND = 128 / RPR;
        unsigned char* stg = lds + w * 8192;
        int l15e = l15; asm volatile("" : "+v"(l15e));
        const int colbase = (DUAL ? 32 : 64) * wn;
#pragma unroll
        for (int rd = 0; rd < NROUND; ++rd) {
            if (active) {
#pragma unroll
                for (int mt = rd * (RPR / 16); mt < (rd + 1) * (RPR / 16); ++mt) {
                    if ((mt >> 1) < ngrp) {
                        const int rloc = mt * 16 - rd * RPR + l15e, row = 128 * wm + mt * 16 + l15e;
#pragma unroll
                        for (int f = 0; f < NF; ++f) {
                            const f32x4 v = DUAL ? pre(row, colbase + 16 * f + 4 * kg, acc[mt][f], acc[mt][f + 2]) : pre(row, colbase + 16 * f + 4 * kg, acc[mt][f], acc[mt][f]);
                            if (F32OUT) *(f32x4*)(stg + rloc * ROWB + ((((unsigned)(4 * f + kg)) ^ (unsigned)(rloc & (NCH - 1))) << 4)) = v;
                            else { bf16x4 o; o[0] = (__bf16)v[0]; o[1] = (__bf16)v[1]; o[2] = (__bf16)v[2]; o[3] = (__bf16)v[3];
                                *(bf16x4*)(stg + rloc * ROWB + ((((unsigned)(2 * f + (kg >> 1))) ^ (unsigned)(rloc & (NCH - 1))) << 4) + 8 * (kg & 1)) = o; }
                        }
                    }
                }
                asm volatile("s_waitcnt lgkmcnt(0)" ::: "memory");
#pragma unroll
                for (int it = 0; it < RPR / RPI; ++it) {
                    const int rloc = it * RPI + lane / NCH, c = lane % NCH, row = 128 * wm + rd * RPR + rloc;
                    const u32x4 dv = *(const u32x4*)(stg + rloc * ROWB + ((((unsigned)c) ^ (unsigned)(rloc & (NCH - 1))) << 4));
                    if (row < rows) fin(row, colbase + c * (F32OUT ? 4 : 8), dv);
                }
                asm volatile("s_waitcnt lgkmcnt(0)" ::: "memory");
            }
        }
    }
    __syncthreads();
}

template <bool DUAL, bool BK16, bool F32OUT, int LDB, int WN, class RowFn, class Pre, class Fin>
DI void gemm_mfma(const bf16_t* Ab, const RowFn& rowoff, const float* B0, const float* B1, unsigned bbytes, int K, int rows, const Pre& pre, const Fin& fin, unsigned char* lds) {
    u32x4 ra[2][2], rb[2][4]; unsigned ao[2] = {0u, 0u};
    gemm_core<DUAL, BK16, F32OUT, LDB, WN>(ra, rb, ao, false, Ab, rowoff, B0, B1, bbytes, K, rows, false, rowoff, B0, B1, bbytes, rows, pre, fin, lds);
}
#define PRE_ID [](int, int, f32x4 v, f32x4) { return v; }

DI void phase_prep(const Params& p, int bid, int nblk, float* lds) {
    const int tid = threadIdx.x, lane = tid & 63, wave = tid >> 6;
    bf16_t* xb = (bf16_t*)(p.ws + OFF_XB); float* glow = (float*)(p.ws + OFF_GLOW);
    f32x4* Wl = (f32x4*)lds;
    for (int idx = tid; idx < 4096; idx += NT) {
        const int k = idx >> 2, q = idx & 3, ln = (k >> 2) & 63, j = k >> 8, c = k & 3;
        Wl[((j * 4 + c) * 4 + q) * 64 + ln] = *(const f32x4*)(p.w_in + (size_t)k * DIN + GL_OFF + 4 * q);
    }
    __syncthreads();
    for (int row0 = (bid * 8 + wave) * 4; row0 < T; row0 += nblk * 32) {
        asm volatile("" ::: "memory");
        f32x4 xv[4][4];
#pragma unroll
        for (int r = 0; r < 4; ++r)
#pragma unroll
            for (int j = 0; j < 4; ++j) {
                xv[r][j] = ((const f32x4*)(p.x + (size_t)(row0 + r) * D))[lane + 64 * j];
                uint2 o; o.x = pk2(xv[r][j][0], xv[r][j][1]); o.y = pk2(xv[r][j][2], xv[r][j][3]);
                ((uint2*)(xb + (size_t)(row0 + r) * D))[lane + 64 * j] = o;
            }
        float acc[4][16];
#pragma unroll
        for (int r = 0; r < 4; ++r)
#pragma unroll
            for (int n = 0; n < 16; ++n) acc[r][n] = 0.f;
#pragma unroll
        for (int j = 0; j < 4; ++j)
#pragma unroll
            for (int c = 0; c < 4; ++c) {
                float wv[16];
#pragma unroll
                for (int q = 0; q < 4; ++q) { const f32x4 w4 = Wl[((j * 4 + c) * 4 + q) * 64 + lane]; wv[4 * q] = w4[0]; wv[4 * q + 1] = w4[1]; wv[4 * q + 2] = w4[2]; wv[4 * q + 3] = w4[3]; }
#pragma unroll
                for (int r = 0; r < 4; ++r) {
                    const float xs = xv[r][j][c];
#pragma unroll
                    for (int n = 0; n < 16; ++n) acc[r][n] += xs * wv[n];
                }
            }
#define RS_STEP(N, OFF) { const bool up = (lane & (OFF)) != 0; _Pragma("unroll") for (int i = 0; i < (N); ++i) { \
            const float a = acc[i / 16][i % 16], b = acc[(i + (N)) / 16][(i + (N)) % 16]; const float snd = up ? a : b, kp = up ? b : a; \
            acc[i / 16][i % 16] = kp + __shfl_xor(snd, (OFF)); } }
        RS_STEP(32, 32) RS_STEP(16, 16) RS_STEP(8, 8) RS_STEP(4, 4) RS_STEP(2, 2) RS_STEP(1, 1)
#undef RS_STEP
        glow[(size_t)row0 * 16 + lane] = acc[0][0];
    }
    {
        bf16_t* wbin = (bf16_t*)(p.ws + OFF_WB_IN); bf16_t* wbout = (bf16_t*)(p.ws + OFF_WB_OUT); bf16_t* wbrt = (bf16_t*)(p.ws + OFF_WB_RT);
        bf16_t* wbsgu = (bf16_t*)(p.ws + OFF_WB_SGU); bf16_t* wbsd = (bf16_t*)(p.ws + OFF_WB_SD);
        constexpr int N_IN = 1024 * 512, N_OUT = 1024 * 256, N_RT = 1024 * 64, N_SGU = 1024 * 128, N_SD = 256 * 256;
        for (int it = bid * NT + tid; it < N_IN + N_OUT + N_RT + N_SGU + N_SD; it += nblk * NT) {
            const float* s; bf16_t* d; int r = it;
            if (r < N_IN) { const int k = r >> 9, c = (r & 511) * 4; s = p.w_in + (size_t)k * DIN + c; d = wbin + (size_t)k * 2048 + c; }
            else if ((r -= N_IN) < N_OUT) { s = p.w_out + (size_t)r * 4; d = wbout + (size_t)r * 4; }
            else if ((r -= N_OUT) < N_RT) { s = p.router_w + (size_t)r * 4; d = wbrt + (size_t)r * 4; }
            else if ((r -= N_RT) < N_SGU) { const int k = r >> 7, c = (r & 127) * 4, nt = c >> 8, h = (c >> 7) & 1, cc = c & 127; s = (h ? p.su : p.sg) + (size_t)k * EDIM + nt * 128 + cc; d = wbsgu + (size_t)k * 512 + c; }
            else { r -= N_SGU; s = p.sd + (size_t)r * 4; d = wbsd + (size_t)r * 4; }
            const f32x4 v = *(const f32x4*)s; uint2 o; o.x = pk2(v[0], v[1]); o.y = pk2(v[2], v[3]); *(uint2*)d = o;
        }
    }
    __syncthreads();
}

DI void phase_proj(const Params& p, int bid, int nblk, float* lds) {
    const bf16_t* xb = (const bf16_t*)(p.ws + OFF_XB); bf16_t* proj = (bf16_t*)(p.ws + OFF_PROJ); const bf16_t* wbin = (const bf16_t*)(p.ws + OFF_WB_IN);
    u32x4 ra[2][2], rb[2][4]; unsigned ao[2] = {0u, 0u}; bool pre = false;
    for (int u = bid; u < 64 * 8; u += nblk) {
        const int mt = u >> 3, nt = u & 7, un = u + nblk, mtn = un >> 3, ntn = un & 7; const bool hn = un < 64 * 8;
        auto rowoff = [&](int r) { return (unsigned)((mt * 256 + r) * D); };
        auto rowoff_n = [&](int r) { return (unsigned)((mtn * 256 + r) * D); };
        auto fin = [&](int r, int c, u32x4 dv) { *(u32x4*)(proj + (size_t)(mt * 256 + r) * NPROJ + nt * 256 + c) = dv; };
        gemm_core<false, true, false, NPROJ, 4>(ra, rb, ao, pre, xb, rowoff, (const float*)(wbin + nt * 256), nullptr, (unsigned)(((size_t)D * NPROJ - nt * 256) * 2), D, 256,
                                 hn, rowoff_n, (const float*)(wbin + ntn * 256), nullptr, (unsigned)(((size_t)D * NPROJ - ntn * 256) * 2), 256, PRE_ID, fin, (unsigned char*)lds);
        pre = hn;
    }
}

template <int W>
DI void poolmean_item(const bf16_t* proj, bf16_t* pm, int t0, int c2) {
    const int s0 = t0 & (SEQ - 1);
    float p0[48], p1[48]; unsigned raw[32];
    p0[0] = 0.f; p1[0] = 0.f;
#pragma unroll
    for (int i = 0; i < 47; ++i) {
        unsigned v = 0u;
        if (i >= 15 || s0 > 0) v = *(const unsigned*)(proj + (size_t)(t0 - 15 + i) * NPROJ + P_OFF + c2);
        if (i >= 15) raw[i - 15] = v;
        p0[i + 1] = p0[i] + __uint_as_float(v << 16); p1[i + 1] = p1[i] + __uint_as_float(v & 0xffff0000u);
    }
#pragma unroll
    for (int i = 0; i < 32; ++i) {
        const int s = s0 + i; const float inv = 1.f / (float)min(s + 1, W);
        const float m0 = (p0[i + 16] - p0[i + 16 - W]) * inv - __uint_as_float(raw[i] << 16);
        const float m1 = (p1[i + 16] - p1[i + 16 - W]) * inv - __uint_as_float(raw[i] & 0xffff0000u);
        *(unsigned*)(pm + (size_t)(t0 + i) * 512 + c2) = pk2(m0, m1);
    }
}
DI void phase_poolmean(const Params& p, int bid, int nblk, float* lds) {
    const bf16_t* proj = (const bf16_t*)(p.ws + OFF_PROJ); bf16_t* pm = (bf16_t*)(p.ws + OFF_PM);
    for (int item = bid * NT + threadIdx.x; item < 256 * (T / 32); item += nblk * NT) {
        const int pair = item & 255, t0 = (item >> 8) * 32, c2 = pair * 2, g = __builtin_amdgcn_readfirstlane(pair >> 6);
        if (g == 0) poolmean_item<2>(proj, pm, t0, c2);
        else if (g == 1) poolmean_item<4>(proj, pm, t0, c2);
        else if (g == 2) poolmean_item<8>(proj, pm, t0, c2);
        else poolmean_item<16>(proj, pm, t0, c2);
    }
}
DI void phase_pool(const Params& p, int bid, int nblk, float* lds) {
    const bf16_t* pm = (const bf16_t*)(p.ws + OFF_PM); bf16_t* mix = (bf16_t*)(p.ws + OFF_MIX);
    for (int u = bid; u < 64 * 4; u += nblk) {
        const int mt = u >> 2, g = u & 3;
        auto rowoff = [&](int r) { return (unsigned)((mt * 256 + r) * 512 + g * 128); };
        auto pre = [&](int r, int c, f32x4 v, f32x4) { const f32x4 sc = *(const f32x4*)(p.pool_scale + g * 128 + c); return v * sc; };
        auto fin = [&](int r, int c, u32x4 dv) { *(u32x4*)(mix + (size_t)(mt * 256 + r) * D + g * 128 + c) = dv; };
        gemm_mfma<false, false, false, 128, 2>(pm, rowoff, p.pool_w + (size_t)g * 16384, nullptr, (unsigned)((4 - g) * 16384 * 4), 128, 256, pre, fin, (unsigned char*)lds);
    }
}

DI unsigned f1_off(unsigned row, unsigned chunk) { return row * 128u + ((chunk ^ ((row >> 1) & 7u)) << 4); }
DI unsigned f2_off(unsigned row, unsigned ch) { return 256u * row + 16u * (ch ^ (((row & 3u) << 2) | ((row >> 2) & 3u))); }
DI bf16x8 f1_frag(const unsigned char* img, int tile, int ks, int lane) { return *(const bf16x8*)(img + f1_off(16 * tile + (lane & 15), 4 * ks + (lane >> 4))); }
DI bf16x8 f2_frag(const unsigned char* img, int c, int ks, int lane) {
    const unsigned g = lane >> 4, q = (lane & 15) >> 2, pp = lane & 3;
    const unsigned a0 = f2_off(32 * ks + 8 * g + q, 2 * c + (pp >> 1)) + 8 * (pp & 1), a1 = f2_off(32 * ks + 8 * g + 4 + q, 2 * c + (pp >> 1)) + 8 * (pp & 1);
    const s16x4 lo = __builtin_amdgcn_ds_read_tr16_b64_v4i16((LAS3 s16x4*)(img + a0)), hi = __builtin_amdgcn_ds_read_tr16_b64_v4i16((LAS3 s16x4*)(img + a1));
    return __builtin_bit_cast(bf16x8, __builtin_shufflevector(lo, hi, 0, 1, 2, 3, 4, 5, 6, 7));
}
DI float bfbits2f(unsigned short v) { return __uint_as_float(((unsigned)v) << 16); }
typedef unsigned short u16x8 __attribute__((ext_vector_type(8)));
typedef unsigned short u16x4 __attribute__((ext_vector_type(4)));

DI void phase_gla1(const Params& p, int bid, int nblk, float* ldsf) {
    unsigned char* lds = (unsigned char*)ldsf;
    int tid_ = threadIdx.x; asm volatile("" : "+v"(tid_));
    const int tid = tid_, lane = tid & 63, w = __builtin_amdgcn_readfirstlane(tid >> 6), t = tid >> 3, ch = tid & 7;
    const bf16_t* proj = (const bf16_t*)(p.ws + OFF_PROJ); const float* glow = (const float*)(p.ws + OFF_GLOW);
    float* Gbuf = (float*)(p.ws + OFF_G); float* Sloc = (float*)(p.ws + OFF_SLOC); float* dec = (float*)(p.ws + OFF_DEC);
    float* G = (float*)lds; unsigned char* Kimg = lds + 16384; unsigned char* Vimg = lds + 32768; float* W2l = (float*)(lds + 49152); float* segtot = (float*)(lds + 53248);
    for (int unit = bid; unit < 1024; unit += nblk) {
        const int bh = unit >> 6, n = unit & 63, b = bh >> 2, h = bh & 3, t0 = b * SEQ + n * SC;
        for (int i = tid; i < 1024; i += NT) W2l[i] = p.gate_w2[(i >> 6) * 256 + h * 64 + (i & 63)];
#pragma unroll
        for (int i = 0; i < 2; ++i) { const int idx = tid + NT * i, tr = idx >> 4, c16 = idx & 15;
            *(u32x4*)(Vimg + f2_off(tr, c16)) = *(const u32x4*)(proj + (size_t)(t0 + tr) * NPROJ + V_OFF + h * 128 + 8 * c16); }
        __syncthreads();
        {
            float gl[16];
#pragma unroll
            for (int q = 0; q < 4; ++q) { const f32x4 v = *(const f32x4*)(glow + (size_t)(t0 + t) * 16 + 4 * q); gl[4 * q] = v[0]; gl[4 * q + 1] = v[1]; gl[4 * q + 2] = v[2]; gl[4 * q + 3] = v[3]; }
#pragma unroll
            for (int dd = 0; dd < 8; ++dd) { const int d = 8 * ch + dd; float z = p.gate_b[h * 64 + d];
#pragma unroll
                for (int r = 0; r < 16; ++r) z += gl[r] * W2l[r * 64 + d];
                G[t * 64 + d] = logsigmoidf_(z) * (1.f / 16.f); }
        }
        __syncthreads();
        {
            const int seg = tid >> 6, d = tid & 63; float run = 0.f;
#pragma unroll
            for (int tt = 0; tt < 8; ++tt) { run += G[(8 * seg + tt) * 64 + d]; G[(8 * seg + tt) * 64 + d] = run; }
            segtot[seg * 64 + d] = run;
            __syncthreads();
            float pre = 0.f;
            for (int s2 = 0; s2 < seg; ++s2) pre += segtot[s2 * 64 + d];
#pragma unroll
            for (int tt = 0; tt < 8; ++tt) G[(8 * seg + tt) * 64 + d] += pre;
        }
        __syncthreads();
        {
            const f32x4 g0 = *(const f32x4*)(G + t * 64 + 8 * ch), g1 = *(const f32x4*)(G + t * 64 + 8 * ch + 4);
            const f32x4 l0 = *(const f32x4*)(G + 63 * 64 + 8 * ch), l1 = *(const f32x4*)(G + 63 * 64 + 8 * ch + 4);
            *(f32x4*)(Gbuf + (size_t)(t0 + t) * 256 + h * 64 + 8 * ch) = g0; *(f32x4*)(Gbuf + (size_t)(t0 + t) * 256 + h * 64 + 8 * ch + 4) = g1;
            const u16x8 kv = *(const u16x8*)(proj + (size_t)(t0 + t) * NPROJ + K_OFF + h * 64 + 8 * ch);
            bf16x8 o;
#pragma unroll
            for (int dd = 0; dd < 4; ++dd) { o[dd] = (__bf16)(bfbits2f(kv[dd]) * __expf(l0[dd] - g0[dd])); o[dd + 4] = (__bf16)(bfbits2f(kv[dd + 4]) * __expf(l1[dd] - g1[dd])); }
            *(bf16x8*)(Kimg + f2_off(t, ch)) = o;
            if (t == 63) {
#pragma unroll
                for (int dd = 0; dd < 4; ++dd) { dec[unit * 64 + 8 * ch + dd] = __expf(l0[dd]); dec[unit * 64 + 8 * ch + 4 + dd] = __expf(l1[dd]); }
            }
        }
        __syncthreads();
        {
            f32x4 acc[4];
#pragma unroll
            for (int dt = 0; dt < 4; ++dt) acc[dt] = (f32x4){0.f, 0.f, 0.f, 0.f};
#pragma unroll
            for (int ks = 0; ks < 2; ++ks) {
                const bf16x8 xv = f2_frag(Vimg, w, ks, lane);
#pragma unroll
                for (int dt = 0; dt < 4; ++dt) acc[dt] = MFMA16(xv, f2_frag(Kimg, dt, ks, lane), acc[dt]);
            }
#pragma unroll
            for (int dt = 0; dt < 4; ++dt) *(f32x4*)(Sloc + (size_t)unit * 8192 + (16 * dt + (lane & 15)) * 128 + 16 * w + 4 * (lane >> 4)) = acc[dt];
        }
        __syncthreads();
    }
}

DI void phase_gla2(const Params& p, int bid, int nblk, float* lds) {
    const float* Sloc = (const float*)(p.ws + OFF_SLOC); const float* dec = (const float*)(p.ws + OFF_DEC); bf16_t* Sin = (bf16_t*)(p.ws + OFF_SIN);
    for (int gid = bid * NT + threadIdx.x; gid < 16 * 8192; gid += nblk * NT) {
        const int bh = gid >> 13, el = gid & 8191, d = el >> 7; float st = 0.f;
        for (int n0 = 0; n0 < NSC; n0 += 16) {
            float sl[16], dc[16]; bf16_t so[16];
#pragma unroll
            for (int i = 0; i < 16; ++i) { const int u = bh * 64 + n0 + i; sl[i] = Sloc[(size_t)u * 8192 + el]; dc[i] = dec[u * 64 + d]; }
#pragma unroll
            for (int i = 0; i < 16; ++i) { so[i] = f2bf(st); st = st * dc[i] + sl[i]; }
#pragma unroll
            for (int i = 0; i < 16; ++i) Sin[(size_t)(bh * 64 + n0 + i) * 8192 + el] = so[i];
        }
    }
}

DI void phase_gla3(const Params& p, int bid, int nblk, float* ldsf) {
    unsigned char* lds = (unsigned char*)ldsf;
    int tid_ = threadIdx.x; asm volatile("" : "+v"(tid_));
    const int tid = tid_, lane = tid & 63, w = __builtin_amdgcn_readfirstlane(tid >> 6), t = tid >> 3, ch = tid & 7, l15 = lane & 15, kg = lane >> 4;
    const bf16_t* proj = (const bf16_t*)(p.ws + OFF_PROJ); const float* Gbuf = (const float*)(p.ws + OFF_G); const bf16_t* Sin = (const bf16_t*)(p.ws + OFF_SIN);
    bf16_t* mix = (bf16_t*)(p.ws + OFF_MIX);
    unsigned char* Qimg = lds; unsigned char* Kimg = lds + 8192; unsigned char* Pimg = lds + 16384; unsigned char* Vimg = lds + 24576; unsigned char* Simg = lds + 40960;
    float* part = (float*)(lds + 57344);
    for (int unit = bid; unit < 1024; unit += nblk) {
        const int bh = unit >> 6, n = unit & 63, b = bh >> 2, h = bh & 3, t0 = b * SEQ + n * SC;
        {
            const f32x4 g0 = *(const f32x4*)(Gbuf + (size_t)(t0 + t) * 256 + h * 64 + 8 * ch), g1 = *(const f32x4*)(Gbuf + (size_t)(t0 + t) * 256 + h * 64 + 8 * ch + 4);
            const u16x8 qv = *(const u16x8*)(proj + (size_t)(t0 + t) * NPROJ + Q_OFF + h * 64 + 8 * ch), kv = *(const u16x8*)(proj + (size_t)(t0 + t) * NPROJ + K_OFF + h * 64 + 8 * ch);
            bf16x8 qo, ko;
#pragma unroll
            for (int dd = 0; dd < 4; ++dd) {
                qo[dd] = (__bf16)(bfbits2f(qv[dd]) * 0.125f * __expf(g0[dd])); qo[dd + 4] = (__bf16)(bfbits2f(qv[dd + 4]) * 0.125f * __expf(g1[dd]));
                ko[dd] = (__bf16)(bfbits2f(kv[dd]) * __expf(-g0[dd])); ko[dd + 4] = (__bf16)(bfbits2f(kv[dd + 4]) * __expf(-g1[dd]));
            }
            *(bf16x8*)(Qimg + f1_off(t, ch)) = qo; *(bf16x8*)(Kimg + f1_off(t, ch)) = ko;
        }
#pragma unroll
        for (int i = 0; i < 2; ++i) { const int idx = tid + NT * i, tr = idx >> 4, c16 = idx & 15;
            *(u32x4*)(Vimg + f2_off(tr, c16)) = *(const u32x4*)(proj + (size_t)(t0 + tr) * NPROJ + V_OFF + h * 128 + 8 * c16);
            *(u32x4*)(Simg + f2_off(tr, c16)) = *(const u32x4*)(Sin + (size_t)unit * 8192 + tr * 128 + 8 * c16); }
        __syncthreads();
        {
            const int it = w >> 1;
#pragma unroll
            for (int jj = 0; jj < 2; ++jj) {
                const int jt = 2 * (w & 1) + jj; f32x4 acc = {0.f, 0.f, 0.f, 0.f};
                if (jt <= it) {
#pragma unroll
                    for (int ks = 0; ks < 2; ++ks) acc = MFMA16(f1_frag(Kimg, jt, ks, lane), f1_frag(Qimg, it, ks, lane), acc);
                    if (jt == it) {
#pragma unroll
                        for (int r = 0; r < 4; ++r) if (4 * kg + r > l15) acc[r] = 0.f;
                    }
                }
                bf16x4 o; o[0] = (__bf16)acc[0]; o[1] = (__bf16)acc[1]; o[2] = (__bf16)acc[2]; o[3] = (__bf16)acc[3];
                *(bf16x4*)(Pimg + f1_off(16 * it + l15, 2 * jt + (kg >> 1)) + 8 * (kg & 1)) = o;
            }
        }
        __syncthreads();
        {
            f32x4 acc[4];
#pragma unroll
            for (int it = 0; it < 4; ++it) acc[it] = (f32x4){0.f, 0.f, 0.f, 0.f};
#pragma unroll
            for (int ks = 0; ks < 2; ++ks) {
                const bf16x8 xv = f2_frag(Vimg, w, ks, lane), xs = f2_frag(Simg, w, ks, lane);
#pragma unroll
                for (int it = 0; it < 4; ++it) {
                    if (2 * ks <= it) acc[it] = MFMA16(xv, f1_frag(Pimg, it, ks, lane), acc[it]);
                    acc[it] = MFMA16(xs, f1_frag(Qimg, it, ks, lane), acc[it]);
                }
            }
#pragma unroll
            for (int it = 0; it < 4; ++it) {
                float ss = acc[it][0] * acc[it][0] + acc[it][1] * acc[it][1] + acc[it][2] * acc[it][2] + acc[it][3] * acc[it][3];
                ss += __shfl_xor(ss, 16); ss += __shfl_xor(ss, 32);
                if (kg == 0) part[w * 64 + 16 * it + l15] = ss;
            }
            __syncthreads();
            const int e0 = 16 * w + 4 * kg; const f32x4 nw = *(const f32x4*)(p.norm_w + e0);
#pragma unroll
            for (int it = 0; it < 4; ++it) {
                const int i = 16 * it + l15; float tot = 0.f;
#pragma unroll
                for (int w2 = 0; w2 < 8; ++w2) tot += part[w2 * 64 + i];
                const float inv = rsqrtf(tot * (1.f / 128.f) + RMS_EPS);
                const u16x4 rv = *(const u16x4*)(proj + (size_t)(t0 + i) * NPROJ + R_OFF + h * 128 + e0);
                bf16x4 o;
#pragma unroll
                for (int r = 0; r < 4; ++r) { const float rr = bfbits2f(rv[r]); o[r] = (__bf16)(acc[it][r] * inv * nw[r] * (rr * sigmoidf_(rr))); }
                *(bf16x4*)(mix + (size_t)(t0 + i) * D + 512 + h * 128 + e0) = o;
            }
        }
        __syncthreads();
    }
}

DI void phase_out(const Params& p, int bid, int nblk, float* lds) {
    const bf16_t* mix = (const bf16_t*)(p.ws + OFF_MIX); float* h32 = (float*)(p.ws + OFF_H32);
    for (int u = bid; u < 64 * 4; u += nblk) {
        const int mt = u >> 2, nt = u & 3;
        auto rowoff = [&](int r) { return (unsigned)((mt * 256 + r) * D); };
        auto fin = [&](int r, int c, u32x4 dv) { const size_t o = (size_t)(mt * 256 + r) * D + nt * 256 + c; const f32x4 xv = *(const f32x4*)(p.x + o); *(f32x4*)(h32 + o) = xv * ALPHA + __builtin_bit_cast(f32x4, dv); };
        gemm_mfma<false, true, true, D, 4>(mix, rowoff, (const float*)((const bf16_t*)(p.ws + OFF_WB_OUT) + nt * 256), nullptr, (unsigned)(((size_t)D * D - nt * 256) * 2), D, 256, PRE_ID, fin, (unsigned char*)lds);
    }
}

DI void ln_row(float (&v)[16], const float* g, const float* b, int lane) {
    float s = 0.f;
#pragma unroll
    for (int i = 0; i < 16; ++i) s += v[i];
    const float mean = wave_sum(s) * (1.f / D); float q = 0.f;
#pragma unroll
    for (int i = 0; i < 16; ++i) { v[i] -= mean; q += v[i] * v[i]; }
    const float rstd = rsqrtf(wave_sum(q) * (1.f / D) + LN_EPS);
#pragma unroll
    for (int j = 0; j < 4; ++j) {
        const float4 gg = ((const float4*)g)[lane + 64 * j], bb = ((const float4*)b)[lane + 64 * j];
        v[4 * j] = v[4 * j] * rstd * gg.x + bb.x; v[4 * j + 1] = v[4 * j + 1] * rstd * gg.y + bb.y;
        v[4 * j + 2] = v[4 * j + 2] * rstd * gg.z + bb.z; v[4 * j + 3] = v[4 * j + 3] * rstd * gg.w + bb.w;
    }
}

DI void ln1_rows(const Params& p, int r0, int nrows) {
    int tid_ = threadIdx.x; asm volatile("" : "+v"(tid_));
    const int lane = tid_ & 63, wave = tid_ >> 6;
    float* h32 = (float*)(p.ws + OFF_H32); bf16_t* hb = (bf16_t*)(p.ws + OFF_HB);
    for (int row = r0 + wave; row < r0 + nrows; row += 8) {
        float4* hr = (float4*)(h32 + (size_t)row * D); float v[16];
#pragma unroll
        for (int j = 0; j < 4; ++j) { const float4 a = hr[lane + 64 * j]; v[4 * j] = a.x; v[4 * j + 1] = a.y; v[4 * j + 2] = a.z; v[4 * j + 3] = a.w; }
        ln_row(v, p.ln1_g, p.ln1_b, lane);
#pragma unroll
        for (int j = 0; j < 4; ++j) {
            hr[lane + 64 * j] = make_float4(v[4 * j], v[4 * j + 1], v[4 * j + 2], v[4 * j + 3]);
            uint2 o; o.x = pk2(v[4 * j], v[4 * j + 1]); o.y = pk2(v[4 * j + 2], v[4 * j + 3]);
            ((uint2*)(hb + (size_t)row * D))[lane + 64 * j] = o;
        }
    }
}

DI void topk_rows(const Params& p, int r0, int nrows) {
    int tid_ = threadIdx.x; asm volatile("" : "+v"(tid_));
    const int lane = tid_ & 63, wave = tid_ >> 6;
    const float* scores = (const float*)(p.ws + OFF_SCORES); float* wbuf = (float*)(p.ws + OFF_WBUF);
    int* list = (int*)(p.ws + OFF_LIST); unsigned* cnt = (unsigned*)(p.ws + OFF_CTL) + CW_CNT;
    const float NEG = -__builtin_inff();
    for (int t = r0 + wave; t < r0 + nrows; t += 8) {
        const float4 sv = ((const float4*)(scores + (size_t)t * NE))[lane], bv = ((const float4*)p.router_bias)[lane];
        const float s[4] = {sv.x, sv.y, sv.z, sv.w};
        float cand[4] = {sv.x + bv.x, sv.y + bv.y, sv.z + bv.z, sv.w + bv.w};
        float m1 = NEG, m2 = NEG;
#pragma unroll
        for (int j = 0; j < 4; ++j) { const float v = cand[j]; if (v > m1) { m2 = m1; m1 = v; } else if (v > m2) m2 = v; }
#pragma unroll
        for (int off = 1; off < 8; off <<= 1) {
            const float o1 = __shfl_xor(m1, off), o2 = __shfl_xor(m2, off);
            const float n1 = fmaxf(m1, o1), n2 = fmaxf(fminf(m1, o1), fmaxf(m2, o2)); m1 = n1; m2 = n2;
        }
        const float gs = m1 + m2; const int mygrp = lane >> 3; int rank = 0;
#pragma unroll
        for (int g2 = 0; g2 < 8; ++g2) { const float og = __shfl(gs, g2 * 8); if (og > gs || (og == gs && g2 < mygrp)) ++rank; }
        if (rank >= 4) { cand[0] = NEG; cand[1] = NEG; cand[2] = NEG; cand[3] = NEG; }
        int my_e = 0; float my_w = 0.f, wsum = 0.f;
#pragma unroll
        for (int k = 0; k < TOPK; ++k) {
            float bvv = cand[0]; int bj = 0;
#pragma unroll
            for (int j = 1; j < 4; ++j) if (cand[j] > bvv) { bvv = cand[j]; bj = j; }
            int bi = 4 * lane + bj;
#pragma unroll
            for (int off = 32; off >= 1; off >>= 1) {
                const float ov = __shfl_xor(bvv, off); const int oi = __shfl_xor(bi, off);
                if (ov > bvv || (ov == bvv && oi < bi)) { bvv = ov; bi = oi; }
            }
            const int wj = bi & 3, wl = bi >> 2;
            const float mys = wj == 0 ? s[0] : (wj == 1 ? s[1] : (wj == 2 ? s[2] : s[3]));
            const float wk = __shfl(mys, wl);
            wsum += wk;
            if (lane == k) { my_e = bi; my_w = wk; }
            if (lane == wl) {
#pragma unroll
                for (int j = 0; j < 4; ++j) if (j == wj) cand[j] = NEG;
            }
        }
        if (lane < TOPK) {
            const unsigned pos = atomicAdd(&cnt[my_e], 1u);
            list[(size_t)my_e * LCAP + pos] = t * TOPK + lane;
            wbuf[(size_t)t * TOPK + lane] = my_w / wsum * 2.5f;
        }
    }
}

DI void phase_route(const Params& p, int bid, int nblk, float* lds) {
    const bf16_t* hb = (const bf16_t*)(p.ws + OFF_HB); float* scores = (float*)(p.ws + OFF_SCORES);
    for (int mt = bid; mt < T / 64; mt += nblk) {
        ln1_rows(p, mt * 64, 64);
        __syncthreads();
        auto rowoff = [&](int r) { return (unsigned)((mt * 64 + r) * D); };
        auto pre = [&](int r, int c, f32x4 v, f32x4) { return (f32x4){sigmoidf_(v[0]), sigmoidf_(v[1]), sigmoidf_(v[2]), sigmoidf_(v[3])}; };
        auto fin = [&](int r, int c, u32x4 dv) { *(u32x4*)(scores + (size_t)(mt * 64 + r) * NE + c) = dv; };
        gemm_mfma<false, true, true, NE, 4>(hb, rowoff, (const float*)(p.ws + OFF_WB_RT), nullptr, (unsigned)(D * NE * 2), D, 64, pre, fin, (unsigned char*)lds);
        __syncthreads();
        topk_rows(p, mt * 64, 64);
        __syncthreads();
    }
}

constexpr int EXP_TAB_OFF = GEMM_LDS_BYTES;
DI void build_tables(const Params& p, int* toff, int* roff) {
    const unsigned* cnt = (const unsigned*)(p.ws + OFF_CTL) + CW_CNT;
    int* cl = roff + 260;
    if (threadIdx.x < NE) cl[threadIdx.x] = (int)__hip_atomic_load(cnt + threadIdx.x, __ATOMIC_RELAXED, __HIP_MEMORY_SCOPE_AGENT);
    __syncthreads();
    if (threadIdx.x <= NE) {
        int ta = 0, ra = 0;
        for (int e = 0; e < (int)threadIdx.x; ++e) { const int c = cl[e]; ta += (c + 255) >> 8; ra += c; }
        toff[threadIdx.x] = ta; roff[threadIdx.x] = ra;
    }
    __syncthreads();
}
DI int find_expert(const int* toff, int tile) { int lo = 0, hi = NE - 1; while (lo < hi) { const int mid = (lo + hi + 1) >> 1; if (toff[mid] <= tile) lo = mid; else hi = mid - 1; } return lo; }
struct ExpUnit { int e, row0, rows, rowbase; };
DI ExpUnit exp_unit(const Params& p, const int* toff, const int* roff, int tile, int ntile) {
    const unsigned* cnt = (const unsigned*)(p.ws + OFF_CTL) + CW_CNT;
    ExpUnit u;
    if (tile < ntile) {
        u.e = find_expert(toff, tile); const int ui = tile - toff[u.e], c = (int)cnt[u.e];
        u.row0 = ui * 256; u.rows = min(256, c - u.row0); u.rowbase = roff[u.e] + u.row0;
    } else { u.e = NE; u.row0 = (tile - ntile) * 256; u.rows = 256; u.rowbase = A_TOT + u.row0; }
    u.e = __builtin_amdgcn_readfirstlane(u.e); u.row0 = __builtin_amdgcn_readfirstlane(u.row0); u.rows = __builtin_amdgcn_readfirstlane(u.rows);
    u.rowbase = __builtin_amdgcn_readfirstlane(u.rowbase);
    return u;
}

template <int NTL>
DI void exp_decode(const int* toff, int ntile, int u, int& tile, int& nt) {
    if (u < NTL * ntile) { const int e = find_expert(toff, u / NTL), ne = toff[e + 1] - toff[e], u2 = u - NTL * toff[e]; nt = u2 / ne; tile = toff[e] + (u2 - nt * ne); }
    else { const int us = u - NTL * ntile; nt = us / (T / 256); tile = ntile + (us - nt * (T / 256)); }
}

DI void phase_e1(const Params& p, int bid, int nblk, float* lds) {
    int* toff = (int*)((unsigned char*)lds + EXP_TAB_OFF); int* roff = toff + 260;
    const bf16_t* hb = (const bf16_t*)(p.ws + OFF_HB); bf16_t* hid = (bf16_t*)(p.ws + OFF_HID); const int* list = (const int*)(p.ws + OFF_LIST);
    build_tables(p, toff, roff);
    const int ntile = toff[NE], units = (ntile + T / 256) * 2;
    const int vb = (nblk & 7) ? bid : (bid & 7) * (nblk >> 3) + (bid >> 3);
    u32x4 ra[2][2], rb[2][4]; unsigned ao[2] = {0u, 0u}; bool pre = false;
    int tile_n = 0, nt_n = 0; ExpUnit xn;
    if (vb < units) { exp_decode<2>(toff, ntile, vb, tile_n, nt_n); xn = exp_unit(p, toff, roff, tile_n, ntile); }
    for (int u = vb; u < units; u += nblk) {
        const int nt = nt_n; const ExpUnit x = xn; const bool hn = u + nblk < units;
        if (hn) { exp_decode<2>(toff, ntile, u + nblk, tile_n, nt_n); xn = exp_unit(p, toff, roff, tile_n, ntile); }
        const float* wg = x.e < NE ? p.wg + (size_t)x.e * 262144 : p.sg; const float* wu = x.e < NE ? p.wu + (size_t)x.e * 262144 : p.su;
        const float* wgn = xn.e < NE ? p.wg + (size_t)xn.e * 262144 : p.sg; const float* wun = xn.e < NE ? p.wu + (size_t)xn.e * 262144 : p.su;
        auto rowoff = [&](int r) { const int tok = x.e < NE ? (list[(size_t)x.e * LCAP + x.row0 + r] >> 3) : (x.row0 + r); return (unsigned)(tok * D); };
        auto rowoff_n = [&](int r) { const int tok = xn.e < NE ? (list[(size_t)xn.e * LCAP + xn.row0 + r] >> 3) : (xn.row0 + r); return (unsigned)(tok * D); };
        auto prf = [&](int r, int c, f32x4 g, f32x4 uu) { return (f32x4){g[0] * sigmoidf_(g[0]) * uu[0], g[1] * sigmoidf_(g[1]) * uu[1], g[2] * sigmoidf_(g[2]) * uu[2], g[3] * sigmoidf_(g[3]) * uu[3]}; };
        auto fin = [&](int r, int c, u32x4 dv) { *(u32x4*)(hid + (size_t)(x.rowbase + r) * EDIM + nt * 128 + c) = dv; };
        gemm_core<true, false, false, EDIM, 4>(ra, rb, ao, pre, hb, rowoff, wg + nt * 128, wu + nt * 128, (unsigned)((D * EDIM - nt * 128) * 4), D, x.rows,
                                 hn, rowoff_n, wgn + nt_n * 128, wun + nt_n * 128, (unsigned)((D * EDIM - nt_n * 128) * 4), xn.rows, prf, fin, (unsigned char*)lds);
        pre = hn;
    }
}

DI void phase_e2(const Params& p, int bid, int nblk, float* lds) {
    int* toff = (int*)((unsigned char*)lds + EXP_TAB_OFF); int* roff = toff + 260; int* rowa = roff + 520;
    const bf16_t* hid = (const bf16_t*)(p.ws + OFF_HID); bf16_t* Y = (bf16_t*)(p.ws + OFF_Y); const int* list = (const int*)(p.ws + OFF_LIST);
    build_tables(p, toff, roff);
    const int ntile = toff[NE], units = (ntile + T / 256) * 4;
    const int vb = (nblk & 7) ? bid : (bid & 7) * (nblk >> 3) + (bid >> 3);
    u32x4 ra[2][2], rb[2][4]; unsigned ao[2] = {0u, 0u}; bool pre = false;
    int tile_n = 0, nt_n = 0; ExpUnit xn;
    if (vb < units) { exp_decode<4>(toff, ntile, vb, tile_n, nt_n); xn = exp_unit(p, toff, roff, tile_n, ntile); }
    for (int u = vb; u < units; u += nblk) {
        const int nt = nt_n; const ExpUnit x = xn; const bool hn = u + nblk < units;
        if (hn) { exp_decode<4>(toff, ntile, u + nblk, tile_n, nt_n); xn = exp_unit(p, toff, roff, tile_n, ntile); }
        const float* wd = x.e < NE ? p.wd + (size_t)x.e * 262144 : p.sd; const float* wdn = xn.e < NE ? p.wd + (size_t)xn.e * 262144 : p.sd;
        if (threadIdx.x < 256) { const int r = threadIdx.x; rowa[r] = x.e < NE ? (r < x.rows ? list[(size_t)x.e * LCAP + x.row0 + r] : 0) : (A_TOT + x.row0 + r); }
        __syncthreads();
        auto rowoff = [&](int r) { return (unsigned)((x.rowbase + r) * EDIM); };
        auto rowoff_n = [&](int r) { return (unsigned)((xn.rowbase + r) * EDIM); };
        auto fin = [&](int r, int c, u32x4 dv) { *(u32x4*)(Y + (size_t)rowa[r] * D + nt * 256 + c) = dv; };
        gemm_core<false, false, false, D, 4>(ra, rb, ao, pre, hid, rowoff, wd + nt * 256, nullptr, (unsigned)((EDIM * D - nt * 256) * 4), EDIM, x.rows,
                               hn, rowoff_n, wdn + nt_n * 256, nullptr, (unsigned)((EDIM * D - nt_n * 256) * 4), xn.rows, PRE_ID, fin, (unsigned char*)lds);
        pre = hn;
        __syncthreads();
    }
}

DI void phase_combine(const Params& p, int bid, int nblk, float* lds) {
    const int lane = threadIdx.x & 63, wave = threadIdx.x >> 6;
    const float* h32 = (const float*)(p.ws + OFF_H32); const bf16_t* Y = (const bf16_t*)(p.ws + OFF_Y); const float* wbuf = (const float*)(p.ws + OFF_WBUF);
    for (int t = bid * 8 + wave; t < T; t += nblk * 8) {
        float v[16];
#pragma unroll
        for (int j = 0; j < 4; ++j) { const float4 a = ((const float4*)(h32 + (size_t)t * D))[lane + 64 * j]; v[4 * j] = ALPHA * a.x; v[4 * j + 1] = ALPHA * a.y; v[4 * j + 2] = ALPHA * a.z; v[4 * j + 3] = ALPHA * a.w; }
#pragma unroll
        for (int k = 0; k < 9; ++k) {
            const size_t row = k < 8 ? (size_t)t * TOPK + k : (size_t)A_TOT + t; const float w = k < 8 ? wbuf[(size_t)t * TOPK + k] : 1.f;
#pragma unroll
            for (int j = 0; j < 4; ++j) {
                const uint2 y = ((const uint2*)(Y + row * D))[lane + 64 * j];
                v[4 * j] += w * __uint_as_float(y.x << 16); v[4 * j + 1] += w * __uint_as_float(y.x & 0xffff0000u);
                v[4 * j + 2] += w * __uint_as_float(y.y << 16); v[4 * j + 3] += w * __uint_as_float(y.y & 0xffff0000u);
            }
        }
        ln_row(v, p.ln2_g, p.ln2_b, lane);
#pragma unroll
        for (int j = 0; j < 4; ++j) ((float4*)(p.out + (size_t)t * D))[lane + 64 * j] = make_float4(v[4 * j], v[4 * j + 1], v[4 * j + 2], v[4 * j + 3]);
    }
}

#define LAS __attribute__((address_space(3)))
#define XB_TMO      128
#define XB_XCNT(j)  (256  + 64 * (j))
#define XB_XSUB(j)  (1280 + 64 * (j))
#define XB_XGEN(j)  (2304 + 64 * (j))
#define XB_TOP      3328
#define XB_TOPGEN   3392
#define XCD_BAR_WORDS 3456
#define XB_SPIN_CAP (1u << 22)
constexpr int CW_BAR = 4096;
DI unsigned xb_ld(unsigned* p) { return __hip_atomic_load(p, __ATOMIC_RELAXED, __HIP_MEMORY_SCOPE_AGENT); }
DI unsigned xb_add(unsigned* p, unsigned v) { return __hip_atomic_fetch_add(p, v, __ATOMIC_RELAXED, __HIP_MEMORY_SCOPE_AGENT); }
DI unsigned xb_xcc_id() { return (unsigned)__builtin_amdgcn_s_getreg((3 << 11) | 20) & 0xFu; }
#define XB_SPIN(cond, bar) do { unsigned _sp = 0; while (cond) { __builtin_amdgcn_s_sleep(1); \
    if ((++_sp & 255u) == 0u) { if (xb_ld(&(bar)[XB_TMO])) break; if (_sp > XB_SPIN_CAP) { atomicAdd(&(bar)[XB_TMO], 1u); break; } } } } while (0)
struct XcdBarrier { unsigned* bar; unsigned x; volatile LAS unsigned* st; };
DI XcdBarrier xcd_barrier_post(unsigned* bar, volatile LAS unsigned* st) {
    XcdBarrier b; b.bar = bar; b.x = xb_xcc_id(); b.st = st;
    if (threadIdx.x == 0) (void)xb_add(&bar[XB_XCNT(b.x)], 1u);
    return b;
}
DI void xcd_barrier_complete(unsigned* bar, unsigned x, unsigned& nloc, unsigned& nx) {
    const unsigned G = gridDim.x * gridDim.y * gridDim.z;
    unsigned sum, cnt, mine, sp = 0u;
    for (;;) {
        sum = 0u; cnt = 0u; mine = 0u;
#pragma unroll
        for (unsigned j = 0; j < 16; ++j) { const unsigned c = xb_ld(&bar[XB_XCNT(j)]); sum += c; cnt += (c > 0u) ? 1u : 0u; mine = (j == x) ? c : mine; }
        if (sum == G) break;
        __builtin_amdgcn_s_sleep(1);
        if ((++sp & 255u) == 0u) { if (xb_ld(&bar[XB_TMO])) break; if (sp > XB_SPIN_CAP) { atomicAdd(&bar[XB_TMO], 1u); break; } }
    }
    nloc = mine > 0u ? mine : 1u; nx = cnt > 0u ? cnt : 1u;
}
DI void xcd_barrier(const XcdBarrier& b) {
    asm volatile("s_waitcnt vmcnt(0)" ::: "memory");
    __syncthreads();
    if (threadIdx.x == 0) {
        unsigned* bar = b.bar;
        __builtin_amdgcn_s_waitcnt(0);
        unsigned nloc = b.st[0], nx = b.st[1];
        if (nloc == 0u) { xcd_barrier_complete(bar, b.x, nloc, nx); b.st[0] = nloc; b.st[1] = nx; }
        const unsigned old = xb_add(&bar[XB_XSUB(b.x)], 1u);
        const unsigned gen = old / nloc;
        if (old + 1u == (gen + 1u) * nloc) {
            __builtin_amdgcn_fence(__ATOMIC_RELEASE, "agent");
            asm volatile("s_waitcnt vmcnt(0)" ::: "memory");
            const unsigned og = xb_add(&bar[XB_TOP], 1u);
            const unsigned tg = og / nx;
            if (og + 1u == (tg + 1u) * nx) xb_add(&bar[XB_TOPGEN], 1u);
            else XB_SPIN(xb_ld(&bar[XB_TOPGEN]) == tg, bar);
            __builtin_amdgcn_fence(__ATOMIC_ACQUIRE, "agent");
            xb_add(&bar[XB_XGEN(b.x)], 1u);
            asm volatile("s_waitcnt vmcnt(0)" ::: "memory");
        } else {
            XB_SPIN(xb_ld(&bar[XB_XGEN(b.x)]) == gen, bar);
            __builtin_amdgcn_fence(__ATOMIC_ACQUIRE, "agent");
            asm volatile("s_waitcnt vmcnt(0)" ::: "memory");
        }
    }
    __syncthreads();
}

constexpr int LDS_BYTES = 136 * 1024;
constexpr int LDS_BAR_OFF = LDS_BYTES - 16;
__global__ void __launch_bounds__(NT) fwd_megakernel(Params p) {
    extern __shared__ __attribute__((aligned(16))) float lds[];
    const int bid = blockIdx.x, nblk = gridDim.x;
    volatile LAS unsigned* st = (volatile LAS unsigned*)((LAS unsigned char*)lds + LDS_BAR_OFF);
    if (threadIdx.x < 4) st[threadIdx.x] = 0u;
    __syncthreads();
    XcdBarrier bar = xcd_barrier_post((unsigned*)(p.ws + OFF_CTL) + CW_BAR, st);
    phase_prep(p, bid, nblk, lds);      xcd_barrier(bar);
    phase_proj(p, bid, nblk, lds);      xcd_barrier(bar);
    phase_poolmean(p, bid, nblk, lds);
    phase_gla1(p, bid, nblk, lds);      xcd_barrier(bar);
    phase_pool(p, bid, nblk, lds);
    phase_gla2(p, bid, nblk, lds);      xcd_barrier(bar);
    phase_gla3(p, bid, nblk, lds);      xcd_barrier(bar);
    phase_out(p, bid, nblk, lds);       xcd_barrier(bar);
    phase_route(p, bid, nblk, lds);     xcd_barrier(bar);
    phase_e1(p, bid, nblk, lds);        xcd_barrier(bar);
    phase_e2(p, bid, nblk, lds);        xcd_barrier(bar);
    phase_combine(p, bid, nblk, lds);
}

extern "C" void kernel_launch(void* const* d_in, const int* in_sizes, int n_in, void* d_out, int out_size, void* d_ws, size_t ws_size, hipStream_t stream) {
    static int grid = 0;
    if (grid == 0) {
        if (n_in != 20 || ws_size < WS_NEED) { fprintf(stderr, "kernel_launch: unexpected n_in %d or ws_size %zu (< %zu)\n", n_in, ws_size, (size_t)WS_NEED); grid = -1; return; }
        int dev = 0, cus = 0, per_cu = 0;
        (void)hipGetDevice(&dev); (void)hipDeviceGetAttribute(&cus, hipDeviceAttributeMultiprocessorCount, dev);
        (void)hipFuncSetAttribute((const void*)fwd_megakernel, hipFuncAttributeMaxDynamicSharedMemorySize, LDS_BYTES);
        (void)hipOccupancyMaxActiveBlocksPerMultiprocessor(&per_cu, (const void*)fwd_megakernel, NT, LDS_BYTES);
        if (per_cu < 1 || cus < 1) { fprintf(stderr, "kernel_launch: occupancy query says %d blocks/CU on %d CUs\n", per_cu, cus); grid = -1; return; }
        grid = cus;
    }
    if (grid < 0) return;
    (void)hipMemsetAsync((char*)d_ws + OFF_CTL, 0, 64 * 1024, stream);
    Params p{};
    const float** pp = (const float**)&p;
    for (int i = 0; i < 20; ++i) pp[i] = (const float*)d_in[i];
    p.out = (float*)d_out; p.ws = (unsigned char*)d_ws;
    void* args[] = {&p};
    hipError_t e = hipLaunchCooperativeKernel((const void*)fwd_megakernel, dim3(grid), dim3(NT), args, LDS_BYTES, stream);
    if (e != hipSuccess) fprintf(stderr, "cooperative launch failed: %s (grid %d)\n", hipGetErrorString(e), grid);
}
```

```cpp
#include <hip/hip_runtime.h>
#include <stdint.h>
#include <cstdio>

#define DI __device__ __forceinline__
typedef unsigned short bf16_t;

constexpr int T = 16384, D = 1024, SEQ = 4096;
constexpr int DIN = 2064, NPROJ = 2048;
constexpr int P_OFF = 0, Q_OFF = 512, K_OFF = 768, V_OFF = 1024, R_OFF = 1536, GL_OFF = 2048;
constexpr int SC = 64;
constexpr int NSC = SEQ / SC;
constexpr int NE = 256, TOPK = 8, EDIM = 256;
constexpr int A_TOT = T * TOPK;
constexpr int LCAP = T;
constexpr float ALPHA = 1.189207115002721f;
constexpr float LN_EPS = 1e-5f, RMS_EPS = 1e-5f;
constexpr int NT = 512;

constexpr size_t MiB = 1u << 20;
constexpr size_t OFF_CTL = 0;
constexpr size_t OFF_XB = 1 * MiB;
constexpr size_t OFF_GLOW = OFF_XB + 32 * MiB;
constexpr size_t OFF_PROJ = OFF_GLOW + 1 * MiB;
constexpr size_t OFF_G = OFF_PROJ + 64 * MiB;
constexpr size_t OFF_SLOC = OFF_G + 16 * MiB;
constexpr size_t OFF_DEC = OFF_SLOC + 32 * MiB;
constexpr size_t OFF_SIN = OFF_DEC + 1 * MiB;
constexpr size_t OFF_MIX = OFF_SIN + 32 * MiB;
constexpr size_t OFF_H32 = OFF_MIX + 32 * MiB;
constexpr size_t OFF_HB = OFF_H32 + 64 * MiB;
constexpr size_t OFF_SCORES = OFF_HB + 32 * MiB;
constexpr size_t OFF_WBUF = OFF_SCORES + 16 * MiB;
constexpr size_t OFF_LIST = OFF_WBUF + 1 * MiB;
constexpr size_t OFF_HID = OFF_LIST + 16 * MiB;
constexpr size_t OFF_Y = OFF_HID + 76 * MiB;
constexpr size_t OFF_PM = OFF_Y + 304 * MiB;
constexpr size_t OFF_WB_IN = OFF_PM + 16 * MiB;
constexpr size_t OFF_WB_OUT = OFF_WB_IN + 4 * MiB;
constexpr size_t OFF_WB_RT = OFF_WB_OUT + 2 * MiB;
constexpr size_t OFF_WB_SGU = OFF_WB_RT + 1 * MiB;
constexpr size_t OFF_WB_SD = OFF_WB_SGU + 1 * MiB;
constexpr size_t WS_NEED = OFF_WB_SD + 1 * MiB;
constexpr int CW_CNT = 1024;

struct Params {
    const float *x, *w_in, *gate_w2, *gate_b, *norm_w, *pool_w, *pool_scale, *w_out, *ln1_g, *ln1_b;
    const float *router_w, *router_bias, *wg, *wu, *wd, *sg, *su, *sd, *ln2_g, *ln2_b;
    float* out;
    unsigned char* ws;
};

DI float bf2f(bf16_t v) { return __uint_as_float(((unsigned)v) << 16); }
DI bf16_t f2bf(float f) { unsigned u = __float_as_uint(f); u += 0x7fffu + ((u >> 16) & 1u); return (bf16_t)(u >> 16); }
DI unsigned pk2(float lo, float hi) { return (unsigned)f2bf(lo) | ((unsigned)f2bf(hi) << 16); }
DI float wave_sum(float v) {
#pragma unroll
    for (int o = 1; o < 64; o <<= 1) v += __shfl_xor(v, o);
    return v;
}
DI float sigmoidf_(float v) { return 1.f / (1.f + __expf(-v)); }
DI float logsigmoidf_(float z) { return fminf(z, 0.f) - log1pf(__expf(-fabsf(z))); }

constexpr int GT_LDS_FLOATS = 16 * 132 + 2 * 16 * 68;
template <bool DUAL, class AF, class BF, class EPI>
DI void gemm_tile_valu(int K, const AF& af, const BF& bfn, const EPI& epi, float* lds) {
    float* As = lds; float* Bs = lds + 16 * 132; float* Bs2 = Bs + 16 * 68;
    const int tid = threadIdx.x, ty = tid >> 4, tx = tid & 15;
    float acc[4][4], acc2[4][4];
#pragma unroll
    for (int i = 0; i < 4; ++i)
#pragma unroll
        for (int j = 0; j < 4; ++j) { acc[i][j] = 0.f; acc2[i][j] = 0.f; }
    for (int k0 = 0; k0 < K; k0 += 16) {
#pragma unroll
        for (int i = 0; i < 4; ++i) { const int e = tid + 512 * i, r = e >> 4, kk = e & 15; As[kk * 132 + r] = af(r, k0 + kk); }
#pragma unroll
        for (int i = 0; i < 2; ++i) { const int e = tid + 512 * i, kk = e >> 6, c = e & 63; Bs[kk * 68 + c] = bfn(0, k0 + kk, c); if (DUAL) Bs2[kk * 68 + c] = bfn(1, k0 + kk, c); }
        __syncthreads();
#pragma unroll
        for (int kk = 0; kk < 16; ++kk) {
            const float4 a = *(const float4*)&As[kk * 132 + ty * 4];
            const float4 b = *(const float4*)&Bs[kk * 68 + tx * 4];
            const float av[4] = {a.x, a.y, a.z, a.w}, bv[4] = {b.x, b.y, b.z, b.w};
#pragma unroll
            for (int i = 0; i < 4; ++i)
#pragma unroll
                for (int j = 0; j < 4; ++j) acc[i][j] += av[i] * bv[j];
            if (DUAL) {
                const float4 b2 = *(const float4*)&Bs2[kk * 68 + tx * 4];
                const float b2v[4] = {b2.x, b2.y, b2.z, b2.w};
#pragma unroll
                for (int i = 0; i < 4; ++i)
#pragma unroll
                    for (int j = 0; j < 4; ++j) acc2[i][j] += av[i] * b2v[j];
            }
        }
        __syncthreads();
    }
#pragma unroll
    for (int i = 0; i < 4; ++i)
#pragma unroll
        for (int j = 0; j < 4; ++j) epi(ty * 4 + i, tx * 4 + j, acc[i][j], acc2[i][j]);
}


typedef __bf16 bf16x8 __attribute__((ext_vector_type(8)));
typedef __bf16 bf16x4 __attribute__((ext_vector_type(4)));
typedef short s16x4 __attribute__((ext_vector_type(4)));
typedef float f32x4 __attribute__((ext_vector_type(4)));
typedef unsigned u32x4 __attribute__((ext_vector_type(4)));
#define LAS3 __attribute__((address_space(3)))
DI const float* uniform_ptr(const float* p) {
    const unsigned long long v = (unsigned long long)p;
    const unsigned lo = __builtin_amdgcn_readfirstlane((unsigned)v), hi = __builtin_amdgcn_readfirstlane((unsigned)(v >> 32));
    return (const float*)(((unsigned long long)hi << 32) | lo);
}
#define MFMA16(a, b, c) __builtin_amdgcn_mfma_f32_16x16x32_bf16((a), (b), (c), 0, 0, 0)
constexpr int GEMM_LDS_BYTES = 65536;
DI unsigned a_swz(unsigned x) { return (0x78u >> (2u * x)) & 3u; }
struct GemmRegs { u32x4 ra[2][2], rb[2][4]; };
template <bool DUAL, bool BK16, int OUTB, int LDB, int WN, class RowFn, class RowFnN, class Pre, class Fin>
DI void gemm_core(u32x4 (&Rra)[2][2], u32x4 (&Rrb)[2][4], unsigned (&aoffc)[2], bool preloaded, const bf16_t* Ab, const RowFn& rowoff, const float* B0, const float* B1, unsigned bbytes, int K, int rows,
                  bool has_next, const RowFnN& rowoff_n, const float* B0n, const float* B1n, unsigned bbytes_n, int rows_n, const Pre& pre, const Fin& fin, unsigned char* lds) {
    int tid_ = threadIdx.x; asm volatile("" : "+v"(tid_));
    const int tid = tid_, lane = tid & 63, w = __builtin_amdgcn_readfirstlane(tid >> 6), wm = w >> 2, wn = w & 3, l15 = lane & 15, kg = lane >> 4, t256 = tid & 255;
    const bool active = wn < WN;
    const int nrow_w = min(max(rows - 128 * wm, 0), 128), ngrp = (((nrow_w + 15) >> 4) + 1) >> 1;
    unsigned aoff[2];
#pragma unroll
    for (int i = 0; i < 2; ++i) aoff[i] = preloaded ? aoffc[i] : (rowoff(min(128 * wm + (t256 >> 2) + 64 * i, rows - 1)) + (t256 & 3) * 8) * 2u;
    const __amdgpu_buffer_rsrc_t ar = __builtin_amdgcn_make_buffer_rsrc((void*)Ab, 0, 0x7fffffff, 0x00020000);
    const unsigned awr = (128 * wm + (t256 >> 2)) * 64 + ((((unsigned)(t256 & 3)) ^ a_swz((t256 >> 4) & 3)) << 4);
    constexpr int NB = BK16 ? 2 : 4;
    const float* bsrc = uniform_ptr(DUAL && !BK16 ? ((wn >> 1) ? B1 : B0) : B0);
    const __amdgpu_buffer_rsrc_t br = __builtin_amdgcn_make_buffer_rsrc((void*)bsrc, 0, bbytes, 0x00020000);
    const unsigned bvoff = BK16 ? (unsigned)(((lane >> 5) * LDB + (lane & 31) * 8) * 2) : (DUAL ? (unsigned)(((lane >> 5) * LDB + (lane & 31) * 4) * 4) : (unsigned)(lane * 16));
    const int krow0 = BK16 ? 16 * wm + 2 * wn : (DUAL ? 16 * wm + 8 * (wn & 1) : 16 * wm + wn);
    constexpr int KSTEP = BK16 ? 8 : (DUAL ? 2 : 4), ESZ = BK16 ? 2 : 4;
    unsigned aoff_n[2];
#pragma unroll
    for (int i = 0; i < 2; ++i) aoff_n[i] = has_next ? (rowoff_n(min(128 * wm + (t256 >> 2) + 64 * i, rows_n - 1)) + (t256 & 3) * 8) * 2u : 0u;
    const float* bsrc_n = uniform_ptr(has_next ? (DUAL && !BK16 ? ((wn >> 1) ? B1n : B0n) : B0n) : bsrc);
    const __amdgpu_buffer_rsrc_t br_n = __builtin_amdgcn_make_buffer_rsrc((void*)bsrc_n, 0, has_next ? bbytes_n : bbytes, 0x00020000);
    unsigned bwr[NB];
#pragma unroll
    for (int i = 0; i < NB; ++i) {
        const int kb = krow0 + KSTEP * i + ((BK16 || DUAL) ? (lane >> 5) : 0);
        const int n = BK16 ? 8 * (lane & 31) : (DUAL ? (wn >> 1) * 128 + 4 * (lane & 31) : 4 * lane);
        const unsigned I = n >> 7, ch = (n & 127) >> 3, half = BK16 ? 0u : (unsigned)((n >> 2) & 1), xx = ((kb & 3) << 2) | ((kb >> 2) & 3);
        bwr[i] = 32768u + I * 8192u + 256u * kb + 16u * (ch ^ xx) + 8u * half;
    }
    const unsigned ard = (128 * wm + l15) * 64 + ((((unsigned)kg) ^ a_swz((l15 >> 2) & 3)) << 4);
    unsigned trd0, trd1;
    {
        const unsigned q = l15 >> 2, pp = l15 & 3, cbase = (DUAL ? 4u * wn : 8u * (wn & 1)) + (pp >> 1), ibase = DUAL ? 0u : (unsigned)(wn >> 1);
        const unsigned x0 = (q << 2) | ((2u * kg) & 3u), x1 = (q << 2) | ((2u * kg + 1u) & 3u);
        trd0 = 32768u + ibase * 8192u + 256u * (8u * kg + q) + 16u * (cbase ^ x0) + 8u * (pp & 1);
        trd1 = 32768u + ibase * 8192u + 256u * (8u * kg + 4u + q) + 16u * (cbase ^ x1) + 8u * (pp & 1);
    }
    f32x4 acc[8][4];
#pragma unroll
    for (int i = 0; i < 8; ++i)
#pragma unroll
        for (int f = 0; f < 4; ++f) acc[i][f] = (f32x4){0.f, 0.f, 0.f, 0.f};
    const int nj = K / 32;
#define LOAD_SET(S, j) { _Pragma("unroll") for (int i = 0; i < 2; ++i) Rra[S][i] = __builtin_bit_cast(u32x4, __builtin_amdgcn_raw_buffer_load_b128(ar, aoff[i], (j) * 64, 0)); \
        _Pragma("unroll") for (int i = 0; i < NB; ++i) Rrb[S][i] = __builtin_bit_cast(u32x4, __builtin_amdgcn_raw_buffer_load_b128(br, bvoff, ((j) * 32 + krow0 + KSTEP * i) * (LDB * ESZ), 0)); }
#define LOAD_SET_N(S, j) { _Pragma("unroll") for (int i = 0; i < 2; ++i) Rra[S][i] = __builtin_bit_cast(u32x4, __builtin_amdgcn_raw_buffer_load_b128(ar, aoff_n[i], (j) * 64, 0)); \
        _Pragma("unroll") for (int i = 0; i < NB; ++i) Rrb[S][i] = __builtin_bit_cast(u32x4, __builtin_amdgcn_raw_buffer_load_b128(br_n, bvoff, ((j) * 32 + krow0 + KSTEP * i) * (LDB * ESZ), 0)); }
#define WRITE_SET(S, st) { _Pragma("unroll") for (int i = 0; i < 2; ++i) *(u32x4*)(lds + (st) * 16384 + awr + i * 4096) = Rra[S][i]; \
        _Pragma("unroll") for (int i = 0; i < NB; ++i) { if (BK16) *(u32x4*)(lds + (st) * 16384 + bwr[i]) = Rrb[S][i]; else { \
            const f32x4 v = __builtin_bit_cast(f32x4, Rrb[S][i]); bf16x4 o; o[0] = (__bf16)v[0]; o[1] = (__bf16)v[1]; o[2] = (__bf16)v[2]; o[3] = (__bf16)v[3]; \
            *(bf16x4*)(lds + (st) * 16384 + bwr[i]) = o; } } }
#define W_PHASE(S, st, jw, jl) { if ((jw) < nj) WRITE_SET(S, st) if ((jl) < nj) LOAD_SET(S, jl) else if (has_next && (jl) < nj + 2) LOAD_SET_N(S, (jl) - nj) }
#define TF_LOAD(dst, st, g) { _Pragma("unroll") for (int q_ = 0; q_ < 2; ++q_) dst[q_] = *(const bf16x8*)(lds + (st) * 16384 + ((g) * 2 + q_) * 1024 + ard); }
#define WF_LOAD(st) { _Pragma("unroll") for (int f = 0; f < 4; ++f) { \
        const unsigned fx = DUAL ? ((f & 1) << 5) : (f << 5), fo = (DUAL ? (f >> 1) * 8192 : 0) + (st) * 16384; \
        const s16x4 lo = __builtin_amdgcn_ds_read_tr16_b64_v4i16((LAS3 s16x4*)(lds + ((trd0 ^ fx) + fo))); \
        const s16x4 hi = __builtin_amdgcn_ds_read_tr16_b64_v4i16((LAS3 s16x4*)(lds + ((trd1 ^ fx) + fo))); \
        wf[f] = __builtin_bit_cast(bf16x8, __builtin_shufflevector(lo, hi, 0, 1, 2, 3, 4, 5, 6, 7)); } }
#define STAGE_MMA(srcf, g) { _Pragma("unroll") for (int q_ = 0; q_ < 2; ++q_) _Pragma("unroll") for (int f = 0; f < 4; ++f) acc[(g) * 2 + q_][f] = MFMA16(wf[f], srcf[q_], acc[(g) * 2 + q_][f]); }
#define STAGE(st, g, cur, nxt) if ((g) < ngrp) { \
        if ((g) + 1 < 4 && (g) + 1 < ngrp) TF_LOAD(nxt, st, (g) + 1) \
        __builtin_amdgcn_sched_barrier(0); \
        STAGE_MMA(cur, g) \
        __builtin_amdgcn_sched_barrier(0); }
#define COMPUTE(st) if (active && ngrp > 0) { bf16x8 fa[2], fb[2], wf[4]; WF_LOAD(st) TF_LOAD(fa, st, 0) STAGE(st, 0, fa, fb) STAGE(st, 1, fb, fa) STAGE(st, 2, fa, fb) STAGE(st, 3, fb, fa) }
    constexpr bool STAGGER = !BK16;
    const int sg = STAGGER ? wm : 0;
    if (!preloaded) { LOAD_SET(0, sg) LOAD_SET(1, 1 - sg) }
    if (sg == 0) { WRITE_SET(0, 0) LOAD_SET(0, 2) }
    else         { WRITE_SET(1, 0) LOAD_SET(1, 2) }
    __syncthreads();
    if (sg == 1) { WRITE_SET(0, 1) LOAD_SET(0, 3) __syncthreads(); }
    const int sA = sg ? 0 : 1, sB = sg ? 1 : 0;
#pragma unroll 1
    for (int j = 0; j < nj; j += 2) {
        COMPUTE(0)
        if (STAGGER) __syncthreads();
        W_PHASE(1, sA, j + 1 + sg, j + 3 + sg)
        __syncthreads();
        COMPUTE(1)
        if (STAGGER) __syncthreads();
        W_PHASE(0, sB, j + 2 + sg, j + 4 + sg)
        __syncthreads();
    }
    if (STAGGER && wm == 0) __syncthreads();
#undef LOAD_SET
#undef LOAD_SET_N
#undef WRITE_SET
#undef W_PHASE
#undef TF_LOAD
#undef WF_LOAD
#undef STAGE_MMA
#undef STAGE
#undef COMPUTE
    aoffc[0] = aoff_n[0]; aoffc[1] = aoff_n[1];
    {
        constexpr int NF = DUAL ? 2 : 4, ROWB = NF * 16 * OUTB, NCH = ROWB / 16, RPR = (8192 / ROWB) < 128 ? (8192 / ROWB) : 128, RPI = 64 / NCH, NROUND = 128 / RPR;
        constexpr float FP8_SCALE = 128.f;
        unsigned char* stg = lds + w * 8192;
        int l15e = l15; asm volatile("" : "+v"(l15e));
        const int colbase = (DUAL ? 32 : 64) * wn;
#pragma unroll
        for (int rd = 0; rd < NROUND; ++rd) {
            if (active) {
#pragma unroll
                for (int mt = rd * (RPR / 16); mt < (rd + 1) * (RPR / 16); ++mt) {
                    if ((mt >> 1) < ngrp) {
                        const int rloc = mt * 16 - rd * RPR + l15e, row = 128 * wm + mt * 16 + l15e;
#pragma unroll
                        for (int f = 0; f < NF; ++f) {
                            const f32x4 v = DUAL ? pre(row, colbase + 16 * f + 4 * kg, acc[mt][f], acc[mt][f + 2]) : pre(row, colbase + 16 * f + 4 * kg, acc[mt][f], acc[mt][f]);
                            if (OUTB == 4) *(f32x4*)(stg + rloc * ROWB + ((((unsigned)(4 * f + kg)) ^ (unsigned)(rloc & (NCH - 1))) << 4)) = v;
                            else if (OUTB == 2) { bf16x4 o; o[0] = (__bf16)v[0]; o[1] = (__bf16)v[1]; o[2] = (__bf16)v[2]; o[3] = (__bf16)v[3];
                                *(bf16x4*)(stg + rloc * ROWB + ((((unsigned)(2 * f + (kg >> 1))) ^ (unsigned)(rloc & (NCH - 1))) << 4) + 8 * (kg & 1)) = o; }
                            else { int pk = 0; pk = __builtin_amdgcn_cvt_pk_fp8_f32(v[0] * FP8_SCALE, v[1] * FP8_SCALE, pk, false); pk = __builtin_amdgcn_cvt_pk_fp8_f32(v[2] * FP8_SCALE, v[3] * FP8_SCALE, pk, true);
                                *(int*)(stg + rloc * ROWB + ((((unsigned)f) ^ (unsigned)(rloc & (NCH - 1))) << 4) + 4 * kg) = pk; }
                        }
                    }
                }
                asm volatile("s_waitcnt lgkmcnt(0)" ::: "memory");
#pragma unroll
                for (int it = 0; it < RPR / RPI; ++it) {
                    const int rloc = it * RPI + lane / NCH, c = lane % NCH, row = 128 * wm + rd * RPR + rloc;
                    const u32x4 dv = *(const u32x4*)(stg + rloc * ROWB + ((((unsigned)c) ^ (unsigned)(rloc & (NCH - 1))) << 4));
                    if (row < rows) fin(row, colbase + c * (16 / OUTB), dv);
                }
                asm volatile("s_waitcnt lgkmcnt(0)" ::: "memory");
            }
        }
    }
    __syncthreads();
}

template <bool DUAL, bool BK16, int OUTB, int LDB, int WN, class RowFn, class Pre, class Fin>
DI void gemm_mfma(const bf16_t* Ab, const RowFn& rowoff, const float* B0, const float* B1, unsigned bbytes, int K, int rows, const Pre& pre, const Fin& fin, unsigned char* lds) {
    u32x4 ra[2][2], rb[2][4]; unsigned ao[2] = {0u, 0u};
    gemm_core<DUAL, BK16, OUTB, LDB, WN>(ra, rb, ao, false, Ab, rowoff, B0, B1, bbytes, K, rows, false, rowoff, B0, B1, bbytes, rows, pre, fin, lds);
}
#define PRE_ID [](int, int, f32x4 v, f32x4) { return v; }

DI void phase_prep(const Params& p, int bid, int nblk, float* lds) {
    const int tid = threadIdx.x, lane = tid & 63, wave = tid >> 6;
    bf16_t* xb = (bf16_t*)(p.ws + OFF_XB); float* glow = (float*)(p.ws + OFF_GLOW);
    f32x4* Wl = (f32x4*)lds;
    for (int idx = tid; idx < 4096; idx += NT) {
        const int k = idx >> 2, q = idx & 3, ln = (k >> 2) & 63, j = k >> 8, c = k & 3;
        Wl[((j * 4 + c) * 4 + q) * 64 + ln] = *(const f32x4*)(p.w_in + (size_t)k * DIN + GL_OFF + 4 * q);
    }
    __syncthreads();
    for (int row0 = (bid * 8 + wave) * 4; row0 < T; row0 += nblk * 32) {
        asm volatile("" ::: "memory");
        f32x4 xv[4][4];
#pragma unroll
        for (int r = 0; r < 4; ++r)
#pragma unroll
            for (int j = 0; j < 4; ++j) {
                xv[r][j] = ((const f32x4*)(p.x + (size_t)(row0 + r) * D))[lane + 64 * j];
                uint2 o; o.x = pk2(xv[r][j][0], xv[r][j][1]); o.y = pk2(xv[r][j][2], xv[r][j][3]);
                ((uint2*)(xb + (size_t)(row0 + r) * D))[lane + 64 * j] = o;
            }
        float acc[4][16];
#pragma unroll
        for (int r = 0; r < 4; ++r)
#pragma unroll
            for (int n = 0; n < 16; ++n) acc[r][n] = 0.f;
#pragma unroll
        for (int j = 0; j < 4; ++j)
#pragma unroll
            for (int c = 0; c < 4; ++c) {
                float wv[16];
#pragma unroll
                for (int q = 0; q < 4; ++q) { const f32x4 w4 = Wl[((j * 4 + c) * 4 + q) * 64 + lane]; wv[4 * q] = w4[0]; wv[4 * q + 1] = w4[1]; wv[4 * q + 2] = w4[2]; wv[4 * q + 3] = w4[3]; }
#pragma unroll
                for (int r = 0; r < 4; ++r) {
                    const float xs = xv[r][j][c];
#pragma unroll
                    for (int n = 0; n < 16; ++n) acc[r][n] += xs * wv[n];
                }
            }
#define RS_STEP(N, OFF) { const bool up = (lane & (OFF)) != 0; _Pragma("unroll") for (int i = 0; i < (N); ++i) { \
            const float a = acc[i / 16][i % 16], b = acc[(i + (N)) / 16][(i + (N)) % 16]; const float snd = up ? a : b, kp = up ? b : a; \
            acc[i / 16][i % 16] = kp + __shfl_xor(snd, (OFF)); } }
        RS_STEP(32, 32) RS_STEP(16, 16) RS_STEP(8, 8) RS_STEP(4, 4) RS_STEP(2, 2) RS_STEP(1, 1)
#undef RS_STEP
        glow[(size_t)row0 * 16 + lane] = acc[0][0];
    }
    {
        bf16_t* wbin = (bf16_t*)(p.ws + OFF_WB_IN); bf16_t* wbout = (bf16_t*)(p.ws + OFF_WB_OUT); bf16_t* wbrt = (bf16_t*)(p.ws + OFF_WB_RT);
        bf16_t* wbsgu = (bf16_t*)(p.ws + OFF_WB_SGU); bf16_t* wbsd = (bf16_t*)(p.ws + OFF_WB_SD);
        constexpr int N_IN = 1024 * 512, N_OUT = 1024 * 256, N_RT = 1024 * 64, N_SGU = 1024 * 128, N_SD = 256 * 256;
        for (int it = bid * NT + tid; it < N_IN + N_OUT + N_RT + N_SGU + N_SD; it += nblk * NT) {
            const float* s; bf16_t* d; int r = it;
            if (r < N_IN) { const int k = r >> 9, c = (r & 511) * 4; s = p.w_in + (size_t)k * DIN + c; d = wbin + (size_t)k * 2048 + c; }
            else if ((r -= N_IN) < N_OUT) { s = p.w_out + (size_t)r * 4; d = wbout + (size_t)r * 4; }
            else if ((r -= N_OUT) < N_RT) { s = p.router_w + (size_t)r * 4; d = wbrt + (size_t)r * 4; }
            else if ((r -= N_RT) < N_SGU) { const int k = r >> 7, c = (r & 127) * 4, nt = c >> 8, h = (c >> 7) & 1, cc = c & 127; s = (h ? p.su : p.sg) + (size_t)k * EDIM + nt * 128 + cc; d = wbsgu + (size_t)k * 512 + c; }
            else { r -= N_SGU; s = p.sd + (size_t)r * 4; d = wbsd + (size_t)r * 4; }
            const f32x4 v = *(const f32x4*)s; uint2 o; o.x = pk2(v[0], v[1]); o.y = pk2(v[2], v[3]); *(uint2*)d = o;
        }
    }
    __syncthreads();
}

DI void phase_proj(const Params& p, int bid, int nblk, float* lds) {
    const bf16_t* xb = (const bf16_t*)(p.ws + OFF_XB); bf16_t* proj = (bf16_t*)(p.ws + OFF_PROJ); const bf16_t* wbin = (const bf16_t*)(p.ws + OFF_WB_IN);
    u32x4 ra[2][2], rb[2][4]; unsigned ao[2] = {0u, 0u}; bool pre = false;
    for (int u = bid; u < 64 * 8; u += nblk) {
        const int mt = u >> 3, nt = u & 7, un = u + nblk, mtn = un >> 3, ntn = un & 7; const bool hn = un < 64 * 8;
        auto rowoff = [&](int r) { return (unsigned)((mt * 256 + r) * D); };
        auto rowoff_n = [&](int r) { return (unsigned)((mtn * 256 + r) * D); };
        auto fin = [&](int r, int c, u32x4 dv) { *(u32x4*)(proj + (size_t)(mt * 256 + r) * NPROJ + nt * 256 + c) = dv; };
        gemm_core<false, true, 2, NPROJ, 4>(ra, rb, ao, pre, xb, rowoff, (const float*)(wbin + nt * 256), nullptr, (unsigned)(((size_t)D * NPROJ - nt * 256) * 2), D, 256,
                                 hn, rowoff_n, (const float*)(wbin + ntn * 256), nullptr, (unsigned)(((size_t)D * NPROJ - ntn * 256) * 2), 256, PRE_ID, fin, (unsigned char*)lds);
        pre = hn;
    }
}

template <int W>
DI void poolmean_item(const bf16_t* proj, bf16_t* pm, int t0, int c2) {
    const int s0 = t0 & (SEQ - 1);
    float p0[48], p1[48]; unsigned raw[32];
    p0[0] = 0.f; p1[0] = 0.f;
#pragma unroll
    for (int i = 0; i < 47; ++i) {
        unsigned v = 0u;
        if (i >= 15 || s0 > 0) v = *(const unsigned*)(proj + (size_t)(t0 - 15 + i) * NPROJ + P_OFF + c2);
        if (i >= 15) raw[i - 15] = v;
        p0[i + 1] = p0[i] + __uint_as_float(v << 16); p1[i + 1] = p1[i] + __uint_as_float(v & 0xffff0000u);
    }
#pragma unroll
    for (int i = 0; i < 32; ++i) {
        const int s = s0 + i; const float inv = 1.f / (float)min(s + 1, W);
        const float m0 = (p0[i + 16] - p0[i + 16 - W]) * inv - __uint_as_float(raw[i] << 16);
        const float m1 = (p1[i + 16] - p1[i + 16 - W]) * inv - __uint_as_float(raw[i] & 0xffff0000u);
        *(unsigned*)(pm + (size_t)(t0 + i) * 512 + c2) = pk2(m0, m1);
    }
}
DI void phase_poolmean(const Params& p, int bid, int nblk, float* lds) {
    const bf16_t* proj = (const bf16_t*)(p.ws + OFF_PROJ); bf16_t* pm = (bf16_t*)(p.ws + OFF_PM);
    for (int item = bid * NT + threadIdx.x; item < 256 * (T / 32); item += nblk * NT) {
        const int pair = item & 255, t0 = (item >> 8) * 32, c2 = pair * 2, g = __builtin_amdgcn_readfirstlane(pair >> 6);
        if (g == 0) poolmean_item<2>(proj, pm, t0, c2);
        else if (g == 1) poolmean_item<4>(proj, pm, t0, c2);
        else if (g == 2) poolmean_item<8>(proj, pm, t0, c2);
        else poolmean_item<16>(proj, pm, t0, c2);
    }
}
DI void phase_pool(const Params& p, int bid, int nblk, float* lds) {
    const bf16_t* pm = (const bf16_t*)(p.ws + OFF_PM); bf16_t* mix = (bf16_t*)(p.ws + OFF_MIX);
    for (int u = bid; u < 64 * 4; u += nblk) {
        const int mt = u >> 2, g = u & 3;
        auto rowoff = [&](int r) { return (unsigned)((mt * 256 + r) * 512 + g * 128); };
        auto pre = [&](int r, int c, f32x4 v, f32x4) { const f32x4 sc = *(const f32x4*)(p.pool_scale + g * 128 + c); return v * sc; };
        auto fin = [&](int r, int c, u32x4 dv) { *(u32x4*)(mix + (size_t)(mt * 256 + r) * D + g * 128 + c) = dv; };
        gemm_mfma<false, false, 2, 128, 2>(pm, rowoff, p.pool_w + (size_t)g * 16384, nullptr, (unsigned)((4 - g) * 16384 * 4), 128, 256, pre, fin, (unsigned char*)lds);
    }
}

DI unsigned f1_off(unsigned row, unsigned chunk) { return row * 128u + ((chunk ^ ((row >> 1) & 7u)) << 4); }
DI unsigned f2_off(unsigned row, unsigned ch) { return 256u * row + 16u * (ch ^ (((row & 3u) << 2) | ((row >> 2) & 3u))); }
DI bf16x8 f1_frag(const unsigned char* img, int tile, int ks, int lane) { return *(const bf16x8*)(img + f1_off(16 * tile + (lane & 15), 4 * ks + (lane >> 4))); }
DI bf16x8 f2_frag(const unsigned char* img, int c, int ks, int lane) {
    const unsigned g = lane >> 4, q = (lane & 15) >> 2, pp = lane & 3;
    const unsigned a0 = f2_off(32 * ks + 8 * g + q, 2 * c + (pp >> 1)) + 8 * (pp & 1), a1 = f2_off(32 * ks + 8 * g + 4 + q, 2 * c + (pp >> 1)) + 8 * (pp & 1);
    const s16x4 lo = __builtin_amdgcn_ds_read_tr16_b64_v4i16((LAS3 s16x4*)(img + a0)), hi = __builtin_amdgcn_ds_read_tr16_b64_v4i16((LAS3 s16x4*)(img + a1));
    return __builtin_bit_cast(bf16x8, __builtin_shufflevector(lo, hi, 0, 1, 2, 3, 4, 5, 6, 7));
}
DI float bfbits2f(unsigned short v) { return __uint_as_float(((unsigned)v) << 16); }
typedef unsigned short u16x8 __attribute__((ext_vector_type(8)));
typedef unsigned short u16x4 __attribute__((ext_vector_type(4)));

DI void phase_gla1(const Params& p, int bid, int nblk, float* ldsf) {
    unsigned char* lds = (unsigned char*)ldsf;
    int tid_ = threadIdx.x; asm volatile("" : "+v"(tid_));
    const int tid = tid_, lane = tid & 63, w = __builtin_amdgcn_readfirstlane(tid >> 6), t = tid >> 3, ch = tid & 7;
    const bf16_t* proj = (const bf16_t*)(p.ws + OFF_PROJ); const float* glow = (const float*)(p.ws + OFF_GLOW);
    float* Gbuf = (float*)(p.ws + OFF_G); float* Sloc = (float*)(p.ws + OFF_SLOC); float* dec = (float*)(p.ws + OFF_DEC);
    float* G = (float*)lds; unsigned char* Kimg = lds + 16384; unsigned char* Vimg = lds + 32768; float* W2l = (float*)(lds + 49152); float* segtot = (float*)(lds + 53248);
    for (int unit = bid; unit < 1024; unit += nblk) {
        const int bh = unit >> 6, n = unit & 63, b = bh >> 2, h = bh & 3, t0 = b * SEQ + n * SC;
        for (int i = tid; i < 1024; i += NT) W2l[i] = p.gate_w2[(i >> 6) * 256 + h * 64 + (i & 63)];
#pragma unroll
        for (int i = 0; i < 2; ++i) { const int idx = tid + NT * i, tr = idx >> 4, c16 = idx & 15;
            *(u32x4*)(Vimg + f2_off(tr, c16)) = *(const u32x4*)(proj + (size_t)(t0 + tr) * NPROJ + V_OFF + h * 128 + 8 * c16); }
        __syncthreads();
        {
            float gl[16];
#pragma unroll
            for (int q = 0; q < 4; ++q) { const f32x4 v = *(const f32x4*)(glow + (size_t)(t0 + t) * 16 + 4 * q); gl[4 * q] = v[0]; gl[4 * q + 1] = v[1]; gl[4 * q + 2] = v[2]; gl[4 * q + 3] = v[3]; }
#pragma unroll
            for (int dd = 0; dd < 8; ++dd) { const int d = 8 * ch + dd; float z = p.gate_b[h * 64 + d];
#pragma unroll
                for (int r = 0; r < 16; ++r) z += gl[r] * W2l[r * 64 + d];
                G[t * 64 + d] = logsigmoidf_(z) * (1.f / 16.f); }
        }
        __syncthreads();
        {
            const int seg = tid >> 6, d = tid & 63; float run = 0.f;
#pragma unroll
            for (int tt = 0; tt < 8; ++tt) { run += G[(8 * seg + tt) * 64 + d]; G[(8 * seg + tt) * 64 + d] = run; }
            segtot[seg * 64 + d] = run;
            __syncthreads();
            float pre = 0.f;
            for (int s2 = 0; s2 < seg; ++s2) pre += segtot[s2 * 64 + d];
#pragma unroll
            for (int tt = 0; tt < 8; ++tt) G[(8 * seg + tt) * 64 + d] += pre;
        }
        __syncthreads();
        {
            const f32x4 g0 = *(const f32x4*)(G + t * 64 + 8 * ch), g1 = *(const f32x4*)(G + t * 64 + 8 * ch + 4);
            const f32x4 l0 = *(const f32x4*)(G + 63 * 64 + 8 * ch), l1 = *(const f32x4*)(G + 63 * 64 + 8 * ch + 4);
            *(f32x4*)(Gbuf + (size_t)(t0 + t) * 256 + h * 64 + 8 * ch) = g0; *(f32x4*)(Gbuf + (size_t)(t0 + t) * 256 + h * 64 + 8 * ch + 4) = g1;
            const u16x8 kv = *(const u16x8*)(proj + (size_t)(t0 + t) * NPROJ + K_OFF + h * 64 + 8 * ch);
            bf16x8 o;
#pragma unroll
            for (int dd = 0; dd < 4; ++dd) { o[dd] = (__bf16)(bfbits2f(kv[dd]) * __expf(l0[dd] - g0[dd])); o[dd + 4] = (__bf16)(bfbits2f(kv[dd + 4]) * __expf(l1[dd] - g1[dd])); }
            *(bf16x8*)(Kimg + f2_off(t, ch)) = o;
            if (t == 63) {
#pragma unroll
                for (int dd = 0; dd < 4; ++dd) { dec[unit * 64 + 8 * ch + dd] = __expf(l0[dd]); dec[unit * 64 + 8 * ch + 4 + dd] = __expf(l1[dd]); }
            }
        }
        __syncthreads();
        {
            f32x4 acc[4];
#pragma unroll
            for (int dt = 0; dt < 4; ++dt) acc[dt] = (f32x4){0.f, 0.f, 0.f, 0.f};
#pragma unroll
            for (int ks = 0; ks < 2; ++ks) {
                const bf16x8 xv = f2_frag(Vimg, w, ks, lane);
#pragma unroll
                for (int dt = 0; dt < 4; ++dt) acc[dt] = MFMA16(xv, f2_frag(Kimg, dt, ks, lane), acc[dt]);
            }
#pragma unroll
            for (int dt = 0; dt < 4; ++dt) *(f32x4*)(Sloc + (size_t)unit * 8192 + (16 * dt + (lane & 15)) * 128 + 16 * w + 4 * (lane >> 4)) = acc[dt];
        }
        __syncthreads();
    }
}

DI void phase_gla2(const Params& p, int bid, int nblk, float* lds) {
    const float* Sloc = (const float*)(p.ws + OFF_SLOC); const float* dec = (const float*)(p.ws + OFF_DEC); bf16_t* Sin = (bf16_t*)(p.ws + OFF_SIN);
    for (int gid = bid * NT + threadIdx.x; gid < 16 * 8192; gid += nblk * NT) {
        const int bh = gid >> 13, el = gid & 8191, d = el >> 7; float st = 0.f;
        for (int n0 = 0; n0 < NSC; n0 += 16) {
            float sl[16], dc[16]; bf16_t so[16];
#pragma unroll
            for (int i = 0; i < 16; ++i) { const int u = bh * 64 + n0 + i; sl[i] = Sloc[(size_t)u * 8192 + el]; dc[i] = dec[u * 64 + d]; }
#pragma unroll
            for (int i = 0; i < 16; ++i) { so[i] = f2bf(st); st = st * dc[i] + sl[i]; }
#pragma unroll
            for (int i = 0; i < 16; ++i) Sin[(size_t)(bh * 64 + n0 + i) * 8192 + el] = so[i];
        }
    }
}

DI void phase_gla3(const Params& p, int bid, int nblk, float* ldsf) {
    unsigned char* lds = (unsigned char*)ldsf;
    int tid_ = threadIdx.x; asm volatile("" : "+v"(tid_));
    const int tid = tid_, lane = tid & 63, w = __builtin_amdgcn_readfirstlane(tid >> 6), t = tid >> 3, ch = tid & 7, l15 = lane & 15, kg = lane >> 4;
    const bf16_t* proj = (const bf16_t*)(p.ws + OFF_PROJ); const float* Gbuf = (const float*)(p.ws + OFF_G); const bf16_t* Sin = (const bf16_t*)(p.ws + OFF_SIN);
    bf16_t* mix = (bf16_t*)(p.ws + OFF_MIX);
    unsigned char* Qimg = lds; unsigned char* Kimg = lds + 8192; unsigned char* Pimg = lds + 16384; unsigned char* Vimg = lds + 24576; unsigned char* Simg = lds + 40960;
    float* part = (float*)(lds + 57344);
    for (int unit = bid; unit < 1024; unit += nblk) {
        const int bh = unit >> 6, n = unit & 63, b = bh >> 2, h = bh & 3, t0 = b * SEQ + n * SC;
        {
            const f32x4 g0 = *(const f32x4*)(Gbuf + (size_t)(t0 + t) * 256 + h * 64 + 8 * ch), g1 = *(const f32x4*)(Gbuf + (size_t)(t0 + t) * 256 + h * 64 + 8 * ch + 4);
            const u16x8 qv = *(const u16x8*)(proj + (size_t)(t0 + t) * NPROJ + Q_OFF + h * 64 + 8 * ch), kv = *(const u16x8*)(proj + (size_t)(t0 + t) * NPROJ + K_OFF + h * 64 + 8 * ch);
            bf16x8 qo, ko;
#pragma unroll
            for (int dd = 0; dd < 4; ++dd) {
                qo[dd] = (__bf16)(bfbits2f(qv[dd]) * 0.125f * __expf(g0[dd])); qo[dd + 4] = (__bf16)(bfbits2f(qv[dd + 4]) * 0.125f * __expf(g1[dd]));
                ko[dd] = (__bf16)(bfbits2f(kv[dd]) * __expf(-g0[dd])); ko[dd + 4] = (__bf16)(bfbits2f(kv[dd + 4]) * __expf(-g1[dd]));
            }
            *(bf16x8*)(Qimg + f1_off(t, ch)) = qo; *(bf16x8*)(Kimg + f1_off(t, ch)) = ko;
        }
#pragma unroll
        for (int i = 0; i < 2; ++i) { const int idx = tid + NT * i, tr = idx >> 4, c16 = idx & 15;
            *(u32x4*)(Vimg + f2_off(tr, c16)) = *(const u32x4*)(proj + (size_t)(t0 + tr) * NPROJ + V_OFF + h * 128 + 8 * c16);
            *(u32x4*)(Simg + f2_off(tr, c16)) = *(const u32x4*)(Sin + (size_t)unit * 8192 + tr * 128 + 8 * c16); }
        __syncthreads();
        {
            const int it = w >> 1;
#pragma unroll
            for (int jj = 0; jj < 2; ++jj) {
                const int jt = 2 * (w & 1) + jj; f32x4 acc = {0.f, 0.f, 0.f, 0.f};
                if (jt <= it) {
#pragma unroll
                    for (int ks = 0; ks < 2; ++ks) acc = MFMA16(f1_frag(Kimg, jt, ks, lane), f1_frag(Qimg, it, ks, lane), acc);
                    if (jt == it) {
#pragma unroll
                        for (int r = 0; r < 4; ++r) if (4 * kg + r > l15) acc[r] = 0.f;
                    }
                }
                bf16x4 o; o[0] = (__bf16)acc[0]; o[1] = (__bf16)acc[1]; o[2] = (__bf16)acc[2]; o[3] = (__bf16)acc[3];
                *(bf16x4*)(Pimg + f1_off(16 * it + l15, 2 * jt + (kg >> 1)) + 8 * (kg & 1)) = o;
            }
        }
        __syncthreads();
        {
            f32x4 acc[4];
#pragma unroll
            for (int it = 0; it < 4; ++it) acc[it] = (f32x4){0.f, 0.f, 0.f, 0.f};
#pragma unroll
            for (int ks = 0; ks < 2; ++ks) {
                const bf16x8 xv = f2_frag(Vimg, w, ks, lane), xs = f2_frag(Simg, w, ks, lane);
#pragma unroll
                for (int it = 0; it < 4; ++it) {
                    if (2 * ks <= it) acc[it] = MFMA16(xv, f1_frag(Pimg, it, ks, lane), acc[it]);
                    acc[it] = MFMA16(xs, f1_frag(Qimg, it, ks, lane), acc[it]);
                }
            }
#pragma unroll
            for (int it = 0; it < 4; ++it) {
                float ss = acc[it][0] * acc[it][0] + acc[it][1] * acc[it][1] + acc[it][2] * acc[it][2] + acc[it][3] * acc[it][3];
                ss += __shfl_xor(ss, 16); ss += __shfl_xor(ss, 32);
                if (kg == 0) part[w * 64 + 16 * it + l15] = ss;
            }
            __syncthreads();
            const int e0 = 16 * w + 4 * kg; const f32x4 nw = *(const f32x4*)(p.norm_w + e0);
#pragma unroll
            for (int it = 0; it < 4; ++it) {
                const int i = 16 * it + l15; float tot = 0.f;
#pragma unroll
                for (int w2 = 0; w2 < 8; ++w2) tot += part[w2 * 64 + i];
                const float inv = rsqrtf(tot * (1.f / 128.f) + RMS_EPS);
                const u16x4 rv = *(const u16x4*)(proj + (size_t)(t0 + i) * NPROJ + R_OFF + h * 128 + e0);
                bf16x4 o;
#pragma unroll
                for (int r = 0; r < 4; ++r) { const float rr = bfbits2f(rv[r]); o[r] = (__bf16)(acc[it][r] * inv * nw[r] * (rr * sigmoidf_(rr))); }
                *(bf16x4*)(mix + (size_t)(t0 + i) * D + 512 + h * 128 + e0) = o;
            }
        }
        __syncthreads();
    }
}

DI void phase_out(const Params& p, int bid, int nblk, float* lds) {
    const bf16_t* mix = (const bf16_t*)(p.ws + OFF_MIX); float* h32 = (float*)(p.ws + OFF_H32);
    for (int u = bid; u < 64 * 4; u += nblk) {
        const int mt = u >> 2, nt = u & 3;
        auto rowoff = [&](int r) { return (unsigned)((mt * 256 + r) * D); };
        auto fin = [&](int r, int c, u32x4 dv) { const size_t o = (size_t)(mt * 256 + r) * D + nt * 256 + c; const f32x4 xv = *(const f32x4*)(p.x + o); *(f32x4*)(h32 + o) = xv * ALPHA + __builtin_bit_cast(f32x4, dv); };
        gemm_mfma<false, true, 4, D, 4>(mix, rowoff, (const float*)((const bf16_t*)(p.ws + OFF_WB_OUT) + nt * 256), nullptr, (unsigned)(((size_t)D * D - nt * 256) * 2), D, 256, PRE_ID, fin, (unsigned char*)lds);
    }
}

DI void ln_row(float (&v)[16], const float* g, const float* b, int lane) {
    float s = 0.f;
#pragma unroll
    for (int i = 0; i < 16; ++i) s += v[i];
    const float mean = wave_sum(s) * (1.f / D); float q = 0.f;
#pragma unroll
    for (int i = 0; i < 16; ++i) { v[i] -= mean; q += v[i] * v[i]; }
    const float rstd = rsqrtf(wave_sum(q) * (1.f / D) + LN_EPS);
#pragma unroll
    for (int j = 0; j < 4; ++j) {
        const float4 gg = ((const float4*)g)[lane + 64 * j], bb = ((const float4*)b)[lane + 64 * j];
        v[4 * j] = v[4 * j] * rstd * gg.x + bb.x; v[4 * j + 1] = v[4 * j + 1] * rstd * gg.y + bb.y;
        v[4 * j + 2] = v[4 * j + 2] * rstd * gg.z + bb.z; v[4 * j + 3] = v[4 * j + 3] * rstd * gg.w + bb.w;
    }
}

DI void ln1_rows(const Params& p, int r0, int nrows) {
    int tid_ = threadIdx.x; asm volatile("" : "+v"(tid_));
    const int lane = tid_ & 63, wave = tid_ >> 6;
    float* h32 = (float*)(p.ws + OFF_H32); bf16_t* hb = (bf16_t*)(p.ws + OFF_HB);
    for (int row = r0 + wave; row < r0 + nrows; row += 8) {
        float4* hr = (float4*)(h32 + (size_t)row * D); float v[16];
#pragma unroll
        for (int j = 0; j < 4; ++j) { const float4 a = hr[lane + 64 * j]; v[4 * j] = a.x; v[4 * j + 1] = a.y; v[4 * j + 2] = a.z; v[4 * j + 3] = a.w; }
        ln_row(v, p.ln1_g, p.ln1_b, lane);
#pragma unroll
        for (int j = 0; j < 4; ++j) {
            uint2 o; o.x = pk2(v[4 * j], v[4 * j + 1]); o.y = pk2(v[4 * j + 2], v[4 * j + 3]);
            ((uint2*)(hb + (size_t)row * D))[lane + 64 * j] = o;
        }
    }
}

DI void topk_rows(const Params& p, int r0, int nrows) {
    int tid_ = threadIdx.x; asm volatile("" : "+v"(tid_));
    const int lane = tid_ & 63, wave = tid_ >> 6;
    const float* scores = (const float*)(p.ws + OFF_SCORES); float* wbuf = (float*)(p.ws + OFF_WBUF);
    int* list = (int*)(p.ws + OFF_LIST); unsigned* cnt = (unsigned*)(p.ws + OFF_CTL) + CW_CNT;
    const float NEG = -__builtin_inff();
    for (int t = r0 + wave; t < r0 + nrows; t += 8) {
        const float4 sv = ((const float4*)(scores + (size_t)t * NE))[lane], bv = ((const float4*)p.router_bias)[lane];
        const float s[4] = {sv.x, sv.y, sv.z, sv.w};
        float cand[4] = {sv.x + bv.x, sv.y + bv.y, sv.z + bv.z, sv.w + bv.w};
        float m1 = NEG, m2 = NEG;
#pragma unroll
        for (int j = 0; j < 4; ++j) { const float v = cand[j]; if (v > m1) { m2 = m1; m1 = v; } else if (v > m2) m2 = v; }
#pragma unroll
        for (int off = 1; off < 8; off <<= 1) {
            const float o1 = __shfl_xor(m1, off), o2 = __shfl_xor(m2, off);
            const float n1 = fmaxf(m1, o1), n2 = fmaxf(fminf(m1, o1), fmaxf(m2, o2)); m1 = n1; m2 = n2;
        }
        const float gs = m1 + m2; const int mygrp = lane >> 3; int rank = 0;
#pragma unroll
        for (int g2 = 0; g2 < 8; ++g2) { const float og = __shfl(gs, g2 * 8); if (og > gs || (og == gs && g2 < mygrp)) ++rank; }
        if (rank >= 4) { cand[0] = NEG; cand[1] = NEG; cand[2] = NEG; cand[3] = NEG; }
        int my_e = 0; float my_w = 0.f, wsum = 0.f;
#pragma unroll
        for (int k = 0; k < TOPK; ++k) {
            float bvv = cand[0]; int bj = 0;
#pragma unroll
            for (int j = 1; j < 4; ++j) if (cand[j] > bvv) { bvv = cand[j]; bj = j; }
            int bi = 4 * lane + bj;
#pragma unroll
            for (int off = 32; off >= 1; off >>= 1) {
                const float ov = __shfl_xor(bvv, off); const int oi = __shfl_xor(bi, off);
                if (ov > bvv || (ov == bvv && oi < bi)) { bvv = ov; bi = oi; }
            }
            const int wj = bi & 3, wl = bi >> 2;
            const float mys = wj == 0 ? s[0] : (wj == 1 ? s[1] : (wj == 2 ? s[2] : s[3]));
            const float wk = __shfl(mys, wl);
            wsum += wk;
            if (lane == k) { my_e = bi; my_w = wk; }
            if (lane == wl) {
#pragma unroll
                for (int j = 0; j < 4; ++j) if (j == wj) cand[j] = NEG;
            }
        }
        if (lane < TOPK) {
            const unsigned pos = atomicAdd(&cnt[my_e], 1u);
            list[(size_t)my_e * LCAP + pos] = t * TOPK + lane;
            wbuf[(size_t)t * TOPK + lane] = my_w / wsum * 2.5f;
        }
    }
}

DI void phase_route(const Params& p, int bid, int nblk, float* lds) {
    const bf16_t* hb = (const bf16_t*)(p.ws + OFF_HB); float* scores = (float*)(p.ws + OFF_SCORES);
    for (int mt = bid; mt < T / 64; mt += nblk) {
        ln1_rows(p, mt * 64, 64);
        __syncthreads();
        auto rowoff = [&](int r) { return (unsigned)((mt * 64 + r) * D); };
        auto pre = [&](int r, int c, f32x4 v, f32x4) { return (f32x4){sigmoidf_(v[0]), sigmoidf_(v[1]), sigmoidf_(v[2]), sigmoidf_(v[3])}; };
        auto fin = [&](int r, int c, u32x4 dv) { *(u32x4*)(scores + (size_t)(mt * 64 + r) * NE + c) = dv; };
        gemm_mfma<false, true, 4, NE, 4>(hb, rowoff, (const float*)(p.ws + OFF_WB_RT), nullptr, (unsigned)(D * NE * 2), D, 64, pre, fin, (unsigned char*)lds);
        __syncthreads();
        topk_rows(p, mt * 64, 64);
        __syncthreads();
    }
}

constexpr int EXP_TAB_OFF = GEMM_LDS_BYTES;
DI void build_tables(const Params& p, int* toff, int* roff) {
    const unsigned* cnt = (const unsigned*)(p.ws + OFF_CTL) + CW_CNT;
    int* cl = roff + 260;
    if (threadIdx.x < NE) cl[threadIdx.x] = (int)__hip_atomic_load(cnt + threadIdx.x, __ATOMIC_RELAXED, __HIP_MEMORY_SCOPE_AGENT);
    __syncthreads();
    if (threadIdx.x <= NE) {
        int ta = 0, ra = 0;
        for (int e = 0; e < (int)threadIdx.x; ++e) { const int c = cl[e]; ta += (c + 255) >> 8; ra += c; }
        toff[threadIdx.x] = ta; roff[threadIdx.x] = ra;
    }
    __syncthreads();
}
DI int find_expert(const int* toff, int tile) { int lo = 0, hi = NE - 1; while (lo < hi) { const int mid = (lo + hi + 1) >> 1; if (toff[mid] <= tile) lo = mid; else hi = mid - 1; } return lo; }
struct ExpUnit { int e, row0, rows, rowbase; };
DI ExpUnit exp_unit(const Params& p, const int* toff, const int* roff, int tile, int ntile) {
    const unsigned* cnt = (const unsigned*)(p.ws + OFF_CTL) + CW_CNT;
    ExpUnit u;
    if (tile < ntile) {
        u.e = find_expert(toff, tile); const int ui = tile - toff[u.e], c = (int)cnt[u.e];
        u.row0 = ui * 256; u.rows = min(256, c - u.row0); u.rowbase = roff[u.e] + u.row0;
    } else { u.e = NE; u.row0 = (tile - ntile) * 256; u.rows = 256; u.rowbase = A_TOT + u.row0; }
    u.e = __builtin_amdgcn_readfirstlane(u.e); u.row0 = __builtin_amdgcn_readfirstlane(u.row0); u.rows = __builtin_amdgcn_readfirstlane(u.rows);
    u.rowbase = __builtin_amdgcn_readfirstlane(u.rowbase);
    return u;
}

template <int NTL>
DI void exp_decode(const int* toff, int ntile, int u, int& tile, int& nt) {
    if (u < NTL * ntile) { const int e = find_expert(toff, u / NTL), ne = toff[e + 1] - toff[e], u2 = u - NTL * toff[e]; nt = u2 / ne; tile = toff[e] + (u2 - nt * ne); }
    else { const int us = u - NTL * ntile; nt = us / (T / 256); tile = ntile + (us - nt * (T / 256)); }
}

DI void phase_e1(const Params& p, int bid, int nblk, float* lds) {
    int* toff = (int*)((unsigned char*)lds + EXP_TAB_OFF); int* roff = toff + 260;
    const bf16_t* hb = (const bf16_t*)(p.ws + OFF_HB); bf16_t* hid = (bf16_t*)(p.ws + OFF_HID); const int* list = (const int*)(p.ws + OFF_LIST);
    build_tables(p, toff, roff);
    const int ntile = toff[NE], units = (ntile + T / 256) * 2;
    const int vb = (nblk & 7) ? bid : (bid & 7) * (nblk >> 3) + (bid >> 3);
    u32x4 ra[2][2], rb[2][4]; unsigned ao[2] = {0u, 0u}; bool pre = false;
    int tile_n = 0, nt_n = 0; ExpUnit xn;
    if (vb < units) { exp_decode<2>(toff, ntile, vb, tile_n, nt_n); xn = exp_unit(p, toff, roff, tile_n, ntile); }
    for (int u = vb; u < units; u += nblk) {
        const int nt = nt_n; const ExpUnit x = xn; const bool hn = u + nblk < units;
        if (hn) { exp_decode<2>(toff, ntile, u + nblk, tile_n, nt_n); xn = exp_unit(p, toff, roff, tile_n, ntile); }
        const float* wg = x.e < NE ? p.wg + (size_t)x.e * 262144 : p.sg; const float* wu = x.e < NE ? p.wu + (size_t)x.e * 262144 : p.su;
        const float* wgn = xn.e < NE ? p.wg + (size_t)xn.e * 262144 : p.sg; const float* wun = xn.e < NE ? p.wu + (size_t)xn.e * 262144 : p.su;
        auto rowoff = [&](int r) { const int tok = x.e < NE ? (list[(size_t)x.e * LCAP + x.row0 + r] >> 3) : (x.row0 + r); return (unsigned)(tok * D); };
        auto rowoff_n = [&](int r) { const int tok = xn.e < NE ? (list[(size_t)xn.e * LCAP + xn.row0 + r] >> 3) : (xn.row0 + r); return (unsigned)(tok * D); };
        auto prf = [&](int r, int c, f32x4 g, f32x4 uu) { return (f32x4){g[0] * sigmoidf_(g[0]) * uu[0], g[1] * sigmoidf_(g[1]) * uu[1], g[2] * sigmoidf_(g[2]) * uu[2], g[3] * sigmoidf_(g[3]) * uu[3]}; };
        auto fin = [&](int r, int c, u32x4 dv) { *(u32x4*)(hid + (size_t)(x.rowbase + r) * EDIM + nt * 128 + c) = dv; };
        gemm_core<true, false, 2, EDIM, 4>(ra, rb, ao, pre, hb, rowoff, wg + nt * 128, wu + nt * 128, (unsigned)((D * EDIM - nt * 128) * 4), D, x.rows,
                                 hn, rowoff_n, wgn + nt_n * 128, wun + nt_n * 128, (unsigned)((D * EDIM - nt_n * 128) * 4), xn.rows, prf, fin, (unsigned char*)lds);
        pre = hn;
    }
}

DI void phase_e2(const Params& p, int bid, int nblk, float* lds) {
    int* toff = (int*)((unsigned char*)lds + EXP_TAB_OFF); int* roff = toff + 260; int* rowa = roff + 520;
    const bf16_t* hid = (const bf16_t*)(p.ws + OFF_HID); unsigned char* Y = p.ws + OFF_Y; const int* list = (const int*)(p.ws + OFF_LIST);
    build_tables(p, toff, roff);
    const int ntile = toff[NE], units = (ntile + T / 256) * 4;
    const int vb = (nblk & 7) ? bid : (bid & 7) * (nblk >> 3) + (bid >> 3);
    u32x4 ra[2][2], rb[2][4]; unsigned ao[2] = {0u, 0u}; bool pre = false;
    int tile_n = 0, nt_n = 0; ExpUnit xn;
    if (vb < units) { exp_decode<4>(toff, ntile, vb, tile_n, nt_n); xn = exp_unit(p, toff, roff, tile_n, ntile); }
    for (int u = vb; u < units; u += nblk) {
        const int nt = nt_n; const ExpUnit x = xn; const bool hn = u + nblk < units;
        if (hn) { exp_decode<4>(toff, ntile, u + nblk, tile_n, nt_n); xn = exp_unit(p, toff, roff, tile_n, ntile); }
        const float* wd = x.e < NE ? p.wd + (size_t)x.e * 262144 : p.sd; const float* wdn = xn.e < NE ? p.wd + (size_t)xn.e * 262144 : p.sd;
        if (threadIdx.x < 256) { const int r = threadIdx.x; rowa[r] = x.e < NE ? (r < x.rows ? list[(size_t)x.e * LCAP + x.row0 + r] : 0) : (A_TOT + x.row0 + r); }
        __syncthreads();
        auto rowoff = [&](int r) { return (unsigned)((x.rowbase + r) * EDIM); };
        auto rowoff_n = [&](int r) { return (unsigned)((xn.rowbase + r) * EDIM); };
        auto fin = [&](int r, int c, u32x4 dv) { *(u32x4*)(Y + (size_t)rowa[r] * D + nt * 256 + c) = dv; };
        gemm_core<false, false, 1, D, 4>(ra, rb, ao, pre, hid, rowoff, wd + nt * 256, nullptr, (unsigned)((EDIM * D - nt * 256) * 4), EDIM, x.rows,
                               hn, rowoff_n, wdn + nt_n * 256, nullptr, (unsigned)((EDIM * D - nt_n * 256) * 4), xn.rows, PRE_ID, fin, (unsigned char*)lds);
        pre = hn;
        __syncthreads();
    }
}

DI void phase_combine(const Params& p, int bid, int nblk, float* lds) {
    const int lane = threadIdx.x & 63, wave = threadIdx.x >> 6;
    const bf16_t* hb = (const bf16_t*)(p.ws + OFF_HB); const unsigned char* Y = p.ws + OFF_Y; const float* wbuf = (const float*)(p.ws + OFF_WBUF);
    typedef float f32x2 __attribute__((ext_vector_type(2)));
    for (int t = bid * 8 + wave; t < T; t += nblk * 8) {
        float v[16];
#pragma unroll
        for (int j = 0; j < 4; ++j) { const uint2 a = ((const uint2*)(hb + (size_t)t * D))[lane + 64 * j];
            v[4 * j] = ALPHA * __uint_as_float(a.x << 16); v[4 * j + 1] = ALPHA * __uint_as_float(a.x & 0xffff0000u);
            v[4 * j + 2] = ALPHA * __uint_as_float(a.y << 16); v[4 * j + 3] = ALPHA * __uint_as_float(a.y & 0xffff0000u); }
#pragma unroll
        for (int k = 0; k < 9; ++k) {
            const size_t row = k < 8 ? (size_t)t * TOPK + k : (size_t)A_TOT + t; const float w = (k < 8 ? wbuf[(size_t)t * TOPK + k] : 1.f) * (1.f / 128.f);
#pragma unroll
            for (int j = 0; j < 4; ++j) {
                const int y = ((const int*)(Y + row * D))[lane + 64 * j];
                const f32x2 lo = __builtin_amdgcn_cvt_pk_f32_fp8(y, false), hi = __builtin_amdgcn_cvt_pk_f32_fp8(y, true);
                v[4 * j] += w * lo[0]; v[4 * j + 1] += w * lo[1]; v[4 * j + 2] += w * hi[0]; v[4 * j + 3] += w * hi[1];
            }
        }
        ln_row(v, p.ln2_g, p.ln2_b, lane);
#pragma unroll
        for (int j = 0; j < 4; ++j) ((float4*)(p.out + (size_t)t * D))[lane + 64 * j] = make_float4(v[4 * j], v[4 * j + 1], v[4 * j + 2], v[4 * j + 3]);
    }
}

#define LAS __attribute__((address_space(3)))
#define XB_TMO      128
#define XB_XCNT(j)  (256  + 64 * (j))
#define XB_XSUB(j)  (1280 + 64 * (j))
#define XB_XGEN(j)  (2304 + 64 * (j))
#define XB_TOP      3328
#define XB_TOPGEN   3392
#define XCD_BAR_WORDS 3456
#define XB_SPIN_CAP (1u << 22)
constexpr int CW_BAR = 4096;
DI unsigned xb_ld(unsigned* p) { return __hip_atomic_load(p, __ATOMIC_RELAXED, __HIP_MEMORY_SCOPE_AGENT); }
DI unsigned xb_add(unsigned* p, unsigned v) { return __hip_atomic_fetch_add(p, v, __ATOMIC_RELAXED, __HIP_MEMORY_SCOPE_AGENT); }
DI unsigned xb_xcc_id() { return (unsigned)__builtin_amdgcn_s_getreg((3 << 11) | 20) & 0xFu; }
#define XB_SPIN(cond, bar) do { unsigned _sp = 0; while (cond) { __builtin_amdgcn_s_sleep(1); \
    if ((++_sp & 255u) == 0u) { if (xb_ld(&(bar)[XB_TMO])) break; if (_sp > XB_SPIN_CAP) { atomicAdd(&(bar)[XB_TMO], 1u); break; } } } } while (0)
struct XcdBarrier { unsigned* bar; unsigned x; volatile LAS unsigned* st; };
DI XcdBarrier xcd_barrier_post(unsigned* bar, volatile LAS unsigned* st) {
    XcdBarrier b; b.bar = bar; b.x = xb_xcc_id(); b.st = st;
    if (threadIdx.x == 0) (void)xb_add(&bar[XB_XCNT(b.x)], 1u);
    return b;
}
DI void xcd_barrier_complete(unsigned* bar, unsigned x, unsigned& nloc, unsigned& nx) {
    const unsigned G = gridDim.x * gridDim.y * gridDim.z;
    unsigned sum, cnt, mine, sp = 0u;
    for (;;) {
        sum = 0u; cnt = 0u; mine = 0u;
#pragma unroll
        for (unsigned j = 0; j < 16; ++j) { const unsigned c = xb_ld(&bar[XB_XCNT(j)]); sum += c; cnt += (c > 0u) ? 1u : 0u; mine = (j == x) ? c : mine; }
        if (sum == G) break;
        __builtin_amdgcn_s_sleep(1);
        if ((++sp & 255u) == 0u) { if (xb_ld(&bar[XB_TMO])) break; if (sp > XB_SPIN_CAP) { atomicAdd(&bar[XB_TMO], 1u); break; } }
    }
    nloc = mine > 0u ? mine : 1u; nx = cnt > 0u ? cnt : 1u;
}
DI void xcd_barrier(const XcdBarrier& b) {
    asm volatile("s_waitcnt vmcnt(0)" ::: "memory");
    __syncthreads();
    if (threadIdx.x == 0) {
        unsigned* bar = b.bar;
        __builtin_amdgcn_s_waitcnt(0);
        unsigned nloc = b.st[0], nx = b.st[1];
        if (nloc == 0u) { xcd_barrier_complete(bar, b.x, nloc, nx); b.st[0] = nloc; b.st[1] = nx; }
        const unsigned old = xb_add(&bar[XB_XSUB(b.x)], 1u);
        const unsigned gen = old / nloc;
        if (old + 1u == (gen + 1u) * nloc) {
            __builtin_amdgcn_fence(__ATOMIC_RELEASE, "agent");
            asm volatile("s_waitcnt vmcnt(0)" ::: "memory");
            const unsigned og = xb_add(&bar[XB_TOP], 1u);
            const unsigned tg = og / nx;
            if (og + 1u == (tg + 1u) * nx) xb_add(&bar[XB_TOPGEN], 1u);
            else XB_SPIN(xb_ld(&bar[XB_TOPGEN]) == tg, bar);
            __builtin_amdgcn_fence(__ATOMIC_ACQUIRE, "agent");
            xb_add(&bar[XB_XGEN(b.x)], 1u);
            asm volatile("s_waitcnt vmcnt(0)" ::: "memory");
        } else {
            XB_SPIN(xb_ld(&bar[XB_XGEN(b.x)]) == gen, bar);
            __builtin_amdgcn_fence(__ATOMIC_ACQUIRE, "agent");
            asm volatile("s_waitcnt vmcnt(0)" ::: "memory");
        }
    }
    __syncthreads();
}

constexpr int LDS_BYTES = 136 * 1024;
constexpr int LDS_BAR_OFF = LDS_BYTES - 16;
__global__ void __launch_bounds__(NT) fwd_megakernel(Params p) {
    extern __shared__ __attribute__((aligned(16))) float lds[];
    const int bid = blockIdx.x, nblk = gridDim.x;
    volatile LAS unsigned* st = (volatile LAS unsigned*)((LAS unsigned char*)lds + LDS_BAR_OFF);
    if (threadIdx.x < 4) st[threadIdx.x] = 0u;
    __syncthreads();
    XcdBarrier bar = xcd_barrier_post((unsigned*)(p.ws + OFF_CTL) + CW_BAR, st);
    phase_prep(p, bid, nblk, lds);      xcd_barrier(bar);
    phase_proj(p, bid, nblk, lds);      xcd_barrier(bar);
    phase_poolmean(p, bid, nblk, lds);
    phase_gla1(p, bid, nblk, lds);      xcd_barrier(bar);
    phase_pool(p, bid, nblk, lds);
    phase_gla2(p, bid, nblk, lds);      xcd_barrier(bar);
    phase_gla3(p, bid, nblk, lds);      xcd_barrier(bar);
    phase_out(p, bid, nblk, lds);       xcd_barrier(bar);
    phase_route(p, bid, nblk, lds);     xcd_barrier(bar);
    phase_e1(p, bid, nblk, lds);        xcd_barrier(bar);
    phase_e2(p, bid, nblk, lds);        xcd_barrier(bar);
    phase_combine(p, bid, nblk, lds);
}

extern "C" void kernel_launch(void* const* d_in, const int* in_sizes, int n_in, void* d_out, int out_size, void* d_ws, size_t ws_size, hipStream_t stream) {
    static int grid = 0;
    if (grid == 0) {
        if (n_in != 20 || ws_size < WS_NEED) { fprintf(stderr, "kernel_launch: unexpected n_in %d or ws_size %zu (< %zu)\n", n_in, ws_size, (size_t)WS_NEED); grid = -1; return; }
        int dev = 0, cus = 0, per_cu = 0;
        (void)hipGetDevice(&dev); (void)hipDeviceGetAttribute(&cus, hipDeviceAttributeMultiprocessorCount, dev);
        (void)hipFuncSetAttribute((const void*)fwd_megakernel, hipFuncAttributeMaxDynamicSharedMemorySize, LDS_BYTES);
        (void)hipOccupancyMaxActiveBlocksPerMultiprocessor(&per_cu, (const void*)fwd_megakernel, NT, LDS_BYTES);
        if (per_cu < 1 || cus < 1) { fprintf(stderr, "kernel_launch: occupancy query says %d blocks/CU on %d CUs\n", per_cu, cus); grid = -1; return; }
        grid = cus;
    }
    if (grid < 0) return;
    (void)hipMemsetAsync((char*)d_ws + OFF_CTL, 0, 64 * 1024, stream);
    Params p{};
    const float** pp = (const float**)&p;
    for (int i = 0; i < 20; ++i) pp[i] = (const float*)d_in[i];
    p.out = (float*)d_out; p.ws = (unsigned char*)d_ws;
    void* args[] = {&p};
    hipError_t e = hipLaunchCooperativeKernel((const void*)fwd_megakernel, dim3(grid), dim3(NT), args, LDS_BYTES, stream);
    if (e != hipSuccess) fprintf(stderr, "cooperative launch failed: %s (grid %d)\n", hipGetErrorString(e), grid);
}
```

```cpp
#include <hip/hip_runtime.h>
#include <stdint.h>
#include <cstdio>

#define DI __device__ __forceinline__
typedef unsigned short bf16_t;

constexpr int T = 16384, D = 1024, SEQ = 4096;
constexpr int DIN = 2064, NPROJ = 2048;
constexpr int P_OFF = 0, Q_OFF = 512, K_OFF = 768, V_OFF = 1024, R_OFF = 1536, GL_OFF = 2048;
constexpr int SC = 64;
constexpr int NSC = SEQ / SC;
constexpr int NE = 256, TOPK = 8, EDIM = 256;
constexpr int A_TOT = T * TOPK;
constexpr int LCAP = T;
constexpr float ALPHA = 1.189207115002721f;
constexpr float LN_EPS = 1e-5f, RMS_EPS = 1e-5f;
constexpr int NT = 512;

constexpr size_t MiB = 1u << 20;
constexpr size_t OFF_CTL = 0;
constexpr size_t OFF_XB = 1 * MiB;
constexpr size_t OFF_GLOW = OFF_XB + 32 * MiB;
constexpr size_t OFF_PROJ = OFF_GLOW + 1 * MiB;
constexpr size_t OFF_G = OFF_PROJ + 64 * MiB;
constexpr size_t OFF_SLOC = OFF_G + 16 * MiB;
constexpr size_t OFF_DEC = OFF_SLOC + 32 * MiB;
constexpr size_t OFF_SIN = OFF_DEC + 1 * MiB;
constexpr size_t OFF_MIX = OFF_SIN + 32 * MiB;
constexpr size_t OFF_H32 = OFF_MIX + 32 * MiB;
constexpr size_t OFF_HB = OFF_H32 + 64 * MiB;
constexpr size_t OFF_SCORES = OFF_HB + 32 * MiB;
constexpr size_t OFF_WBUF = OFF_SCORES + 16 * MiB;
constexpr size_t OFF_LIST = OFF_WBUF + 1 * MiB;
constexpr size_t OFF_HID = OFF_LIST + 16 * MiB;
constexpr size_t OFF_Y = OFF_HID + 76 * MiB;
constexpr size_t OFF_PM = OFF_Y + 304 * MiB;
constexpr size_t OFF_WB_IN = OFF_PM + 16 * MiB;
constexpr size_t OFF_WB_OUT = OFF_WB_IN + 4 * MiB;
constexpr size_t OFF_WB_RT = OFF_WB_OUT + 2 * MiB;
constexpr size_t OFF_WB_SGU = OFF_WB_RT + 1 * MiB;
constexpr size_t OFF_WB_SD = OFF_WB_SGU + 1 * MiB;
constexpr size_t WS_NEED = OFF_WB_SD + 1 * MiB;
constexpr int CW_CNT = 1024;

struct Params {
    const float *x, *w_in, *gate_w2, *gate_b, *norm_w, *pool_w, *pool_scale, *w_out, *ln1_g, *ln1_b;
    const float *router_w, *router_bias, *wg, *wu, *wd, *sg, *su, *sd, *ln2_g, *ln2_b;
    float* out;
    unsigned char* ws;
};

DI float bf2f(bf16_t v) { return __uint_as_float(((unsigned)v) << 16); }
DI bf16_t f2bf(float f) { unsigned u = __float_as_uint(f); u += 0x7fffu + ((u >> 16) & 1u); return (bf16_t)(u >> 16); }
DI unsigned pk2(float lo, float hi) { return (unsigned)f2bf(lo) | ((unsigned)f2bf(hi) << 16); }
DI float wave_sum(float v) {
#pragma unroll
    for (int o = 1; o < 64; o <<= 1) v += __shfl_xor(v, o);
    return v;
}
DI float sigmoidf_(float v) { return 1.f / (1.f + __expf(-v)); }
DI float logsigmoidf_(float z) { return fminf(z, 0.f) - log1pf(__expf(-fabsf(z))); }

constexpr int GT_LDS_FLOATS = 16 * 132 + 2 * 16 * 68;
template <bool DUAL, class AF, class BF, class EPI>
DI void gemm_tile_valu(int K, const AF& af, const BF& bfn, const EPI& epi, float* lds) {
    float* As = lds; float* Bs = lds + 16 * 132; float* Bs2 = Bs + 16 * 68;
    const int tid = threadIdx.x, ty = tid >> 4, tx = tid & 15;
    float acc[4][4], acc2[4][4];
#pragma unroll
    for (int i = 0; i < 4; ++i)
#pragma unroll
        for (int j = 0; j < 4; ++j) { acc[i][j] = 0.f; acc2[i][j] = 0.f; }
    for (int k0 = 0; k0 < K; k0 += 16) {
#pragma unroll
        for (int i = 0; i < 4; ++i) { const int e = tid + 512 * i, r = e >> 4, kk = e & 15; As[kk * 132 + r] = af(r, k0 + kk); }
#pragma unroll
        for (int i = 0; i < 2; ++i) { const int e = tid + 512 * i, kk = e >> 6, c = e & 63; Bs[kk * 68 + c] = bfn(0, k0 + kk, c); if (DUAL) Bs2[kk * 68 + c] = bfn(1, k0 + kk, c); }
        __syncthreads();
#pragma unroll
        for (int kk = 0; kk < 16; ++kk) {
            const float4 a = *(const float4*)&As[kk * 132 + ty * 4];
            const float4 b = *(const float4*)&Bs[kk * 68 + tx * 4];
            const float av[4] = {a.x, a.y, a.z, a.w}, bv[4] = {b.x, b.y, b.z, b.w};
#pragma unroll
            for (int i = 0; i < 4; ++i)
#pragma unroll
                for (int j = 0; j < 4; ++j) acc[i][j] += av[i] * bv[j];
            if (DUAL) {
                const float4 b2 = *(const float4*)&Bs2[kk * 68 + tx * 4];
                const float b2v[4] = {b2.x, b2.y, b2.z, b2.w};
#pragma unroll
                for (int i = 0; i < 4; ++i)
#pragma unroll
                    for (int j = 0; j < 4; ++j) acc2[i][j] += av[i] * b2v[j];
            }
        }
        __syncthreads();
    }
#pragma unroll
    for (int i = 0; i < 4; ++i)
#pragma unroll
        for (int j = 0; j < 4; ++j) epi(ty * 4 + i, tx * 4 + j, acc[i][j], acc2[i][j]);
}


typedef __bf16 bf16x8 __attribute__((ext_vector_type(8)));
typedef __bf16 bf16x4 __attribute__((ext_vector_type(4)));
typedef short s16x4 __attribute__((ext_vector_type(4)));
typedef float f32x4 __attribute__((ext_vector_type(4)));
typedef unsigned u32x4 __attribute__((ext_vector_type(4)));
#define LAS3 __attribute__((address_space(3)))
DI const float* uniform_ptr(const float* p) {
    const unsigned long long v = (unsigned long long)p;
    const unsigned lo = __builtin_amdgcn_readfirstlane((unsigned)v), hi = __builtin_amdgcn_readfirstlane((unsigned)(v >> 32));
    return (const float*)(((unsigned long long)hi << 32) | lo);
}
#define MFMA16(a, b, c) __builtin_amdgcn_mfma_f32_16x16x32_bf16((a), (b), (c), 0, 0, 0)
constexpr int GEMM_LDS_BYTES = 98304;
DI unsigned a_swz(unsigned x) { return (0x78u >> (2u * x)) & 3u; }
struct GemmRegs { u32x4 ra[2][2], rb[2][4]; };
template <bool DUAL, bool BK16, int OUTB, int LDB, int WN, class RowFn, class RowFnN, class Pre, class Fin>
DI void gemm_core(u32x4 (&Rra)[2][2], u32x4 (&Rrb)[2][4], unsigned (&aoffc)[2], bool preloaded, const bf16_t* Ab, const RowFn& rowoff, const float* B0, const float* B1, unsigned bbytes, int K, int rows,
                  bool has_next, const RowFnN& rowoff_n, const float* B0n, const float* B1n, unsigned bbytes_n, int rows_n, const Pre& pre, const Fin& fin, unsigned char* lds) {
    int tid_ = threadIdx.x; asm volatile("" : "+v"(tid_));
    const int tid = tid_, lane = tid & 63, w = __builtin_amdgcn_readfirstlane(tid >> 6), wm = w >> 2, wn = w & 3, l15 = lane & 15, kg = lane >> 4, t256 = tid & 255;
    const bool active = wn < WN;
    const int nrow_w = min(max(rows - 128 * wm, 0), 128), ngrp = (((nrow_w + 15) >> 4) + 1) >> 1;
    unsigned aoff[2];
#pragma unroll
    for (int i = 0; i < 2; ++i) aoff[i] = preloaded ? aoffc[i] : (rowoff(min(128 * wm + (t256 >> 2) + 64 * i, rows - 1)) + (t256 & 3) * 8) * 2u;
    const __amdgpu_buffer_rsrc_t ar = __builtin_amdgcn_make_buffer_rsrc((void*)Ab, 0, 0x7fffffff, 0x00020000);
    const unsigned awr = (128 * wm + (t256 >> 2)) * 64 + ((((unsigned)(t256 & 3)) ^ a_swz((t256 >> 4) & 3)) << 4);
    constexpr int NB = BK16 ? 2 : 4;
    const float* bsrc = uniform_ptr(DUAL && !BK16 ? ((wn >> 1) ? B1 : B0) : B0);
    const __amdgpu_buffer_rsrc_t br = __builtin_amdgcn_make_buffer_rsrc((void*)bsrc, 0, bbytes, 0x00020000);
    const unsigned bvoff = BK16 ? (unsigned)(((lane >> 5) * LDB + (lane & 31) * 8) * 2) : (DUAL ? (unsigned)(((lane >> 5) * LDB + (lane & 31) * 4) * 4) : (unsigned)(lane * 16));
    const int krow0 = BK16 ? 16 * wm + 2 * wn : (DUAL ? 16 * wm + 8 * (wn & 1) : 16 * wm + wn);
    constexpr int KSTEP = BK16 ? 8 : (DUAL ? 2 : 4), ESZ = BK16 ? 2 : 4;
    unsigned aoff_n[2];
#pragma unroll
    for (int i = 0; i < 2; ++i) aoff_n[i] = has_next ? (rowoff_n(min(128 * wm + (t256 >> 2) + 64 * i, rows_n - 1)) + (t256 & 3) * 8) * 2u : aoff[i];
    const float* bsrc_n = uniform_ptr(has_next ? (DUAL && !BK16 ? ((wn >> 1) ? B1n : B0n) : B0n) : bsrc);
    const __amdgpu_buffer_rsrc_t br_n = __builtin_amdgcn_make_buffer_rsrc((void*)bsrc_n, 0, has_next ? bbytes_n : bbytes, 0x00020000);
    unsigned bwr[NB];
#pragma unroll
    for (int i = 0; i < NB; ++i) {
        const int kb = krow0 + KSTEP * i + ((BK16 || DUAL) ? (lane >> 5) : 0);
        const int n = BK16 ? 8 * (lane & 31) : (DUAL ? (wn >> 1) * 128 + 4 * (lane & 31) : 4 * lane);
        const unsigned I = n >> 7, ch = (n & 127) >> 3, half = BK16 ? 0u : (unsigned)((n >> 2) & 1), xx = ((kb & 3) << 2) | ((kb >> 2) & 3);
        bwr[i] = 16384u + I * 8192u + 256u * kb + 16u * (ch ^ xx) + 8u * half;
    }
    const unsigned ard = (128 * wm + l15) * 64 + ((((unsigned)kg) ^ a_swz((l15 >> 2) & 3)) << 4);
    unsigned trd0, trd1;
    {
        const unsigned q = l15 >> 2, pp = l15 & 3, cbase = (DUAL ? 4u * wn : 8u * (wn & 1)) + (pp >> 1), ibase = DUAL ? 0u : (unsigned)(wn >> 1);
        const unsigned x0 = (q << 2) | ((2u * kg) & 3u), x1 = (q << 2) | ((2u * kg + 1u) & 3u);
        trd0 = 16384u + ibase * 8192u + 256u * (8u * kg + q) + 16u * (cbase ^ x0) + 8u * (pp & 1);
        trd1 = 16384u + ibase * 8192u + 256u * (8u * kg + 4u + q) + 16u * (cbase ^ x1) + 8u * (pp & 1);
    }
    f32x4 acc[8][4];
#pragma unroll
    for (int i = 0; i < 8; ++i)
#pragma unroll
        for (int f = 0; f < 4; ++f) acc[i][f] = (f32x4){0.f, 0.f, 0.f, 0.f};
    const int nj = K / 32;
#define LOAD_SET(S, j) { _Pragma("unroll") for (int i = 0; i < 2; ++i) Rra[S][i] = __builtin_bit_cast(u32x4, __builtin_amdgcn_raw_buffer_load_b128(ar, aoff[i], (j) * 64, 0)); \
        _Pragma("unroll") for (int i = 0; i < NB; ++i) Rrb[S][i] = __builtin_bit_cast(u32x4, __builtin_amdgcn_raw_buffer_load_b128(br, bvoff, ((j) * 32 + krow0 + KSTEP * i) * (LDB * ESZ), 0)); }
#define LOAD_SET_N(S, j) { _Pragma("unroll") for (int i = 0; i < 2; ++i) Rra[S][i] = __builtin_bit_cast(u32x4, __builtin_amdgcn_raw_buffer_load_b128(ar, aoff_n[i], (j) * 64, 0)); \
        _Pragma("unroll") for (int i = 0; i < NB; ++i) Rrb[S][i] = __builtin_bit_cast(u32x4, __builtin_amdgcn_raw_buffer_load_b128(br_n, bvoff, ((j) * 32 + krow0 + KSTEP * i) * (LDB * ESZ), 0)); }
#define WRITE_SET(S, st) { _Pragma("unroll") for (int i = 0; i < 2; ++i) *(u32x4*)(lds + (st) * 32768 + awr + i * 4096) = Rra[S][i]; \
        _Pragma("unroll") for (int i = 0; i < NB; ++i) { if (BK16) *(u32x4*)(lds + (st) * 32768 + bwr[i]) = Rrb[S][i]; else { \
            const f32x4 v = __builtin_bit_cast(f32x4, Rrb[S][i]); bf16x4 o; o[0] = (__bf16)v[0]; o[1] = (__bf16)v[1]; o[2] = (__bf16)v[2]; o[3] = (__bf16)v[3]; \
            *(bf16x4*)(lds + (st) * 32768 + ((!DUAL) ? ((bwr[0] ^ (unsigned)(i << 4)) + 1024u * i) : bwr[i])) = o; } } }
#define LOAD_SEL(S, jl) { const bool nx_ = (jl) >= nj; const int jt_ = nx_ ? (jl) - nj : (jl); \
        _Pragma("unroll") for (int i = 0; i < 2; ++i) Rra[S][i] = __builtin_bit_cast(u32x4, __builtin_amdgcn_raw_buffer_load_b128(ar, nx_ ? aoff_n[i] : aoff[i], jt_ * 64, 0)); \
        if (nx_) { _Pragma("unroll") for (int i = 0; i < NB; ++i) Rrb[S][i] = __builtin_bit_cast(u32x4, __builtin_amdgcn_raw_buffer_load_b128(br_n, bvoff, (jt_ * 32 + krow0 + KSTEP * i) * (LDB * ESZ), 0)); } \
        else { _Pragma("unroll") for (int i = 0; i < NB; ++i) Rrb[S][i] = __builtin_bit_cast(u32x4, __builtin_amdgcn_raw_buffer_load_b128(br, bvoff, (jt_ * 32 + krow0 + KSTEP * i) * (LDB * ESZ), 0)); } }
#define TF_LOAD(dst, st, g) { _Pragma("unroll") for (int q_ = 0; q_ < 2; ++q_) dst[q_] = *(const bf16x8*)(lds + (st) * 32768 + ((g) * 2 + q_) * 1024 + ard); }
#define WF_LOAD(st) { _Pragma("unroll") for (int f = 0; f < 4; ++f) { \
        const unsigned fx = DUAL ? ((f & 1) << 5) : (f << 5), fo = (DUAL ? (f >> 1) * 8192 : 0) + (st) * 32768; \
        const s16x4 lo = __builtin_amdgcn_ds_read_tr16_b64_v4i16((LAS3 s16x4*)(lds + ((trd0 ^ fx) + fo))); \
        const s16x4 hi = __builtin_amdgcn_ds_read_tr16_b64_v4i16((LAS3 s16x4*)(lds + ((trd1 ^ fx) + fo))); \
        wf[f] = __builtin_bit_cast(bf16x8, __builtin_shufflevector(lo, hi, 0, 1, 2, 3, 4, 5, 6, 7)); } }
#define STAGE_MMA(srcf, g) { _Pragma("unroll") for (int q_ = 0; q_ < 2; ++q_) _Pragma("unroll") for (int f = 0; f < 4; ++f) acc[(g) * 2 + q_][f] = MFMA16(wf[f], srcf[q_], acc[(g) * 2 + q_][f]); }
#define STAGE(st, g, cur, nxt) if ((g) < ngrp) { \
        if ((g) + 1 < 4 && (g) + 1 < ngrp) TF_LOAD(nxt, st, (g) + 1) \
        __builtin_amdgcn_sched_barrier(0); \
        STAGE_MMA(cur, g) \
        __builtin_amdgcn_sched_barrier(0); }
    const bool comp = active && ngrp > 0;
    bf16x8 fa[2], fb[2], wf[4];
#define PREFETCH(stn) if (comp) { WF_LOAD(stn) TF_LOAD(fa, stn, 0) }
#define TILE_W(st, S, jl) { const int st2_ = (st) >= 1 ? (st) - 1 : 2, st1_ = (st) == 2 ? 0 : (st) + 1; \
        if (comp) { STAGE(st, 0, fa, fb) STAGE(st, 1, fb, fa) STAGE(st, 2, fa, fb) STAGE(st, 3, fb, fa) } \
        if (STAGGER) __syncthreads(); \
        WRITE_SET(S, st2_) LOAD_SEL(S, jl) \
        PREFETCH(st1_) \
        __syncthreads(); }
    constexpr bool STAGGER = !BK16;
    if (!preloaded) { LOAD_SET(0, 0) LOAD_SET(1, 1) }
    WRITE_SET(0, 0) WRITE_SET(1, 1)
    LOAD_SEL(0, 2) LOAD_SEL(1, 3)
    __syncthreads();
    PREFETCH(0)
    if (STAGGER && wm == 1) __syncthreads();
    int st = 0;
#pragma unroll 1
    for (int j = 0; j < nj - 2; j += 2) {
        TILE_W(st, 0, j + 4)
        st = st == 2 ? 0 : st + 1;
        TILE_W(st, 1, j + 5)
        st = st == 2 ? 0 : st + 1;
    }
    {
        const int st1 = st == 2 ? 0 : st + 1;
        if (comp) { STAGE(st, 0, fa, fb) STAGE(st, 1, fb, fa) STAGE(st, 2, fa, fb) STAGE(st, 3, fb, fa) }
        if (STAGGER) __syncthreads();
        PREFETCH(st1)
        __syncthreads();
        if (comp) { STAGE(st1, 0, fa, fb) STAGE(st1, 1, fb, fa) STAGE(st1, 2, fa, fb) STAGE(st1, 3, fb, fa) }
        if (STAGGER) __syncthreads();
        __syncthreads();
    }
    if (STAGGER && wm == 0) __syncthreads();
#undef PREFETCH
#undef TILE_W
#undef LOAD_SET
#undef LOAD_SET_N
#undef LOAD_SEL
#undef WRITE_SET
#undef TF_LOAD
#undef WF_LOAD
#undef STAGE_MMA
#undef STAGE
    aoffc[0] = aoff_n[0]; aoffc[1] = aoff_n[1];
    {
        constexpr int NF = DUAL ? 2 : 4, ROWB = NF * 16 * OUTB, NCH = ROWB / 16, RPR = (8192 / ROWB) < 128 ? (8192 / ROWB) : 128, RPI = 64 / NCH, NROUND = 128 / RPR;
        constexpr float FP8_SCALE = 128.f;
        unsigned char* stg = lds + w * 8192;
        int l15e = l15; asm volatile("" : "+v"(l15e));
        const int colbase = (DUAL ? 32 : 64) * wn;
#pragma unroll
        for (int rd = 0; rd < NROUND; ++rd) {
            if (active) {
#pragma unroll
                for (int mt = rd * (RPR / 16); mt < (rd + 1) * (RPR / 16); ++mt) {
                    if ((mt >> 1) < ngrp) {
                        const int rloc = mt * 16 - rd * RPR + l15e, row = 128 * wm + mt * 16 + l15e;
#pragma unroll
                        for (int f = 0; f < NF; ++f) {
                            const f32x4 v = DUAL ? pre(row, colbase + 16 * f + 4 * kg, acc[mt][f], acc[mt][f + 2]) : pre(row, colbase + 16 * f + 4 * kg, acc[mt][f], acc[mt][f]);
                            if (OUTB == 4) *(f32x4*)(stg + rloc * ROWB + ((((unsigned)(4 * f + kg)) ^ (unsigned)(rloc & (NCH - 1))) << 4)) = v;
                            else if (OUTB == 2) { bf16x4 o; o[0] = (__bf16)v[0]; o[1] = (__bf16)v[1]; o[2] = (__bf16)v[2]; o[3] = (__bf16)v[3];
                                *(bf16x4*)(stg + rloc * ROWB + ((((unsigned)(2 * f + (kg >> 1))) ^ (unsigned)(rloc & (NCH - 1))) << 4) + 8 * (kg & 1)) = o; }
                            else { int pk = 0; pk = __builtin_amdgcn_cvt_pk_fp8_f32(v[0] * FP8_SCALE, v[1] * FP8_SCALE, pk, false); pk = __builtin_amdgcn_cvt_pk_fp8_f32(v[2] * FP8_SCALE, v[3] * FP8_SCALE, pk, true);
                                *(int*)(stg + rloc * ROWB + ((((unsigned)f) ^ (unsigned)(rloc & (NCH - 1))) << 4) + 4 * kg) = pk; }
                        }
                    }
                }
                asm volatile("s_waitcnt lgkmcnt(0)" ::: "memory");
#pragma unroll
                for (int it = 0; it < RPR / RPI; ++it) {
                    const int rloc = it * RPI + lane / NCH, c = lane % NCH, row = 128 * wm + rd * RPR + rloc;
                    const u32x4 dv = *(const u32x4*)(stg + rloc * ROWB + ((((unsigned)c) ^ (unsigned)(rloc & (NCH - 1))) << 4));
                    if (row < rows) fin(row, colbase + c * (16 / OUTB), dv);
                }
                asm volatile("s_waitcnt lgkmcnt(0)" ::: "memory");
            }
        }
    }
    __syncthreads();
}

template <bool DUAL, bool BK16, int OUTB, int LDB, int WN, class RowFn, class Pre, class Fin>
DI void gemm_mfma(const bf16_t* Ab, const RowFn& rowoff, const float* B0, const float* B1, unsigned bbytes, int K, int rows, const Pre& pre, const Fin& fin, unsigned char* lds) {
    u32x4 ra[2][2], rb[2][4]; unsigned ao[2] = {0u, 0u};
    gemm_core<DUAL, BK16, OUTB, LDB, WN>(ra, rb, ao, false, Ab, rowoff, B0, B1, bbytes, K, rows, false, rowoff, B0, B1, bbytes, rows, pre, fin, lds);
}
#define PRE_ID [](int, int, f32x4 v, f32x4) { return v; }

DI void phase_prep(const Params& p, int bid, int nblk, float* lds) {
    const int tid = threadIdx.x, lane = tid & 63, wave = tid >> 6;
    bf16_t* xb = (bf16_t*)(p.ws + OFF_XB); float* glow = (float*)(p.ws + OFF_GLOW);
    f32x4* Wl = (f32x4*)lds;
    for (int idx = tid; idx < 4096; idx += NT) {
        const int k = idx >> 2, q = idx & 3, ln = (k >> 2) & 63, j = k >> 8, c = k & 3;
        Wl[((j * 4 + c) * 4 + q) * 64 + ln] = *(const f32x4*)(p.w_in + (size_t)k * DIN + GL_OFF + 4 * q);
    }
    __syncthreads();
    for (int row0 = (bid * 8 + wave) * 4; row0 < T; row0 += nblk * 32) {
        asm volatile("" ::: "memory");
        f32x4 xv[4][4];
#pragma unroll
        for (int r = 0; r < 4; ++r)
#pragma unroll
            for (int j = 0; j < 4; ++j) {
                xv[r][j] = ((const f32x4*)(p.x + (size_t)(row0 + r) * D))[lane + 64 * j];
                uint2 o; o.x = pk2(xv[r][j][0], xv[r][j][1]); o.y = pk2(xv[r][j][2], xv[r][j][3]);
                ((uint2*)(xb + (size_t)(row0 + r) * D))[lane + 64 * j] = o;
            }
        float acc[4][16];
#pragma unroll
        for (int r = 0; r < 4; ++r)
#pragma unroll
            for (int n = 0; n < 16; ++n) acc[r][n] = 0.f;
#pragma unroll
        for (int j = 0; j < 4; ++j)
#pragma unroll
            for (int c = 0; c < 4; ++c) {
                float wv[16];
#pragma unroll
                for (int q = 0; q < 4; ++q) { const f32x4 w4 = Wl[((j * 4 + c) * 4 + q) * 64 + lane]; wv[4 * q] = w4[0]; wv[4 * q + 1] = w4[1]; wv[4 * q + 2] = w4[2]; wv[4 * q + 3] = w4[3]; }
#pragma unroll
                for (int r = 0; r < 4; ++r) {
                    const float xs = xv[r][j][c];
#pragma unroll
                    for (int n = 0; n < 16; ++n) acc[r][n] += xs * wv[n];
                }
            }
#define RS_STEP(N, OFF) { const bool up = (lane & (OFF)) != 0; _Pragma("unroll") for (int i = 0; i < (N); ++i) { \
            const float a = acc[i / 16][i % 16], b = acc[(i + (N)) / 16][(i + (N)) % 16]; const float snd = up ? a : b, kp = up ? b : a; \
            acc[i / 16][i % 16] = kp + __shfl_xor(snd, (OFF)); } }
        RS_STEP(32, 32) RS_STEP(16, 16) RS_STEP(8, 8) RS_STEP(4, 4) RS_STEP(2, 2) RS_STEP(1, 1)
#undef RS_STEP
        glow[(size_t)row0 * 16 + lane] = acc[0][0];
    }
    {
        bf16_t* wbin = (bf16_t*)(p.ws + OFF_WB_IN); bf16_t* wbout = (bf16_t*)(p.ws + OFF_WB_OUT); bf16_t* wbrt = (bf16_t*)(p.ws + OFF_WB_RT);
        bf16_t* wbsgu = (bf16_t*)(p.ws + OFF_WB_SGU); bf16_t* wbsd = (bf16_t*)(p.ws + OFF_WB_SD);
        constexpr int N_IN = 1024 * 512, N_OUT = 1024 * 256, N_RT = 1024 * 64, N_SGU = 1024 * 128, N_SD = 256 * 256;
        for (int it = bid * NT + tid; it < N_IN + N_OUT + N_RT + N_SGU + N_SD; it += nblk * NT) {
            const float* s; bf16_t* d; int r = it;
            if (r < N_IN) { const int k = r >> 9, c = (r & 511) * 4; s = p.w_in + (size_t)k * DIN + c; d = wbin + (size_t)k * 2048 + c; }
            else if ((r -= N_IN) < N_OUT) { s = p.w_out + (size_t)r * 4; d = wbout + (size_t)r * 4; }
            else if ((r -= N_OUT) < N_RT) { s = p.router_w + (size_t)r * 4; d = wbrt + (size_t)r * 4; }
            else if ((r -= N_RT) < N_SGU) { const int k = r >> 7, c = (r & 127) * 4, nt = c >> 8, h = (c >> 7) & 1, cc = c & 127; s = (h ? p.su : p.sg) + (size_t)k * EDIM + nt * 128 + cc; d = wbsgu + (size_t)k * 512 + c; }
            else { r -= N_SGU; s = p.sd + (size_t)r * 4; d = wbsd + (size_t)r * 4; }
            const f32x4 v = *(const f32x4*)s; uint2 o; o.x = pk2(v[0], v[1]); o.y = pk2(v[2], v[3]); *(uint2*)d = o;
        }
    }
    __syncthreads();
}

DI void phase_proj(const Params& p, int bid, int nblk, float* lds) {
    const bf16_t* xb = (const bf16_t*)(p.ws + OFF_XB); bf16_t* proj = (bf16_t*)(p.ws + OFF_PROJ); const bf16_t* wbin = (const bf16_t*)(p.ws + OFF_WB_IN);
    u32x4 ra[2][2], rb[2][4]; unsigned ao[2] = {0u, 0u}; bool pre = false;
    const bool xl = (nblk == 256);
    for (int u = bid; u < 64 * 8; u += nblk) {
        const int un = u + nblk; const bool hn = un < 64 * 8;
        const int mt = xl ? 32 * (u >> 8) + 4 * (u & 7) + ((u & 255) >> 6) : u >> 3, nt = xl ? ((u & 255) >> 3) & 7 : u & 7;
        const int mtn = xl ? 32 * (un >> 8) + 4 * (un & 7) + ((un & 255) >> 6) : un >> 3, ntn = xl ? ((un & 255) >> 3) & 7 : un & 7;
        auto rowoff = [&](int r) { return (unsigned)((mt * 256 + r) * D); };
        auto rowoff_n = [&](int r) { return (unsigned)((mtn * 256 + r) * D); };
        auto fin = [&](int r, int c, u32x4 dv) { *(u32x4*)(proj + (size_t)(mt * 256 + r) * NPROJ + nt * 256 + c) = dv; };
        gemm_core<false, true, 2, NPROJ, 4>(ra, rb, ao, pre, xb, rowoff, (const float*)(wbin + nt * 256), nullptr, (unsigned)(((size_t)D * NPROJ - nt * 256) * 2), D, 256,
                                 hn, rowoff_n, (const float*)(wbin + ntn * 256), nullptr, (unsigned)(((size_t)D * NPROJ - ntn * 256) * 2), 256, PRE_ID, fin, (unsigned char*)lds);
        pre = hn;
    }
}

template <int W>
DI void poolmean_item(const bf16_t* proj, bf16_t* pm, int t0, int c2) {
    const int s0 = t0 & (SEQ - 1);
    float p0[48], p1[48]; unsigned raw[32];
    p0[0] = 0.f; p1[0] = 0.f;
#pragma unroll
    for (int i = 0; i < 47; ++i) {
        unsigned v = 0u;
        if (i >= 15 || s0 > 0) v = *(const unsigned*)(proj + (size_t)(t0 - 15 + i) * NPROJ + P_OFF + c2);
        if (i >= 15) raw[i - 15] = v;
        p0[i + 1] = p0[i] + __uint_as_float(v << 16); p1[i + 1] = p1[i] + __uint_as_float(v & 0xffff0000u);
    }
#pragma unroll
    for (int i = 0; i < 32; ++i) {
        const int s = s0 + i; const float inv = 1.f / (float)min(s + 1, W);
        const float m0 = (p0[i + 16] - p0[i + 16 - W]) * inv - __uint_as_float(raw[i] << 16);
        const float m1 = (p1[i + 16] - p1[i + 16 - W]) * inv - __uint_as_float(raw[i] & 0xffff0000u);
        *(unsigned*)(pm + (size_t)(t0 + i) * 512 + c2) = pk2(m0, m1);
    }
}
DI void phase_poolmean(const Params& p, int bid, int nblk, float* lds) {
    const bf16_t* proj = (const bf16_t*)(p.ws + OFF_PROJ); bf16_t* pm = (bf16_t*)(p.ws + OFF_PM);
    for (int item = bid * NT + threadIdx.x; item < 256 * (T / 32); item += nblk * NT) {
        const int pair = item & 255, t0 = (item >> 8) * 32, c2 = pair * 2, g = __builtin_amdgcn_readfirstlane(pair >> 6);
        if (g == 0) poolmean_item<2>(proj, pm, t0, c2);
        else if (g == 1) poolmean_item<4>(proj, pm, t0, c2);
        else if (g == 2) poolmean_item<8>(proj, pm, t0, c2);
        else poolmean_item<16>(proj, pm, t0, c2);
    }
}
DI void phase_pool(const Params& p, int bid, int nblk, float* lds) {
    const bf16_t* pm = (const bf16_t*)(p.ws + OFF_PM); bf16_t* mix = (bf16_t*)(p.ws + OFF_MIX);
    for (int u = bid; u < 64 * 4; u += nblk) {
        const int mt = u >> 2, g = u & 3;
        auto rowoff = [&](int r) { return (unsigned)((mt * 256 + r) * 512 + g * 128); };
        auto pre = [&](int r, int c, f32x4 v, f32x4) { const f32x4 sc = *(const f32x4*)(p.pool_scale + g * 128 + c); return v * sc; };
        auto fin = [&](int r, int c, u32x4 dv) { *(u32x4*)(mix + (size_t)(mt * 256 + r) * D + g * 128 + c) = dv; };
        gemm_mfma<false, false, 2, 128, 2>(pm, rowoff, p.pool_w + (size_t)g * 16384, nullptr, (unsigned)((4 - g) * 16384 * 4), 128, 256, pre, fin, (unsigned char*)lds);
    }
}

DI unsigned f1_off(unsigned row, unsigned chunk) { return row * 128u + ((chunk ^ ((row >> 1) & 7u)) << 4); }
DI unsigned f2_off(unsigned row, unsigned ch) { return 256u * row + 16u * (ch ^ (((row & 3u) << 2) | ((row >> 2) & 3u))); }
DI bf16x8 f1_frag(const unsigned char* img, int tile, int ks, int lane) { return *(const bf16x8*)(img + f1_off(16 * tile + (lane & 15), 4 * ks + (lane >> 4))); }
DI bf16x8 f2_frag(const unsigned char* img, int c, int ks, int lane) {
    const unsigned g = lane >> 4, q = (lane & 15) >> 2, pp = lane & 3;
    const unsigned a0 = f2_off(32 * ks + 8 * g + q, 2 * c + (pp >> 1)) + 8 * (pp & 1), a1 = f2_off(32 * ks + 8 * g + 4 + q, 2 * c + (pp >> 1)) + 8 * (pp & 1);
    const s16x4 lo = __builtin_amdgcn_ds_read_tr16_b64_v4i16((LAS3 s16x4*)(img + a0)), hi = __builtin_amdgcn_ds_read_tr16_b64_v4i16((LAS3 s16x4*)(img + a1));
    return __builtin_bit_cast(bf16x8, __builtin_shufflevector(lo, hi, 0, 1, 2, 3, 4, 5, 6, 7));
}
DI float bfbits2f(unsigned short v) { return __uint_as_float(((unsigned)v) << 16); }
typedef unsigned short u16x8 __attribute__((ext_vector_type(8)));
typedef unsigned short u16x4 __attribute__((ext_vector_type(4)));

DI void phase_gla1(const Params& p, int bid, int nblk, float* ldsf) {
    unsigned char* lds = (unsigned char*)ldsf;
    int tid_ = threadIdx.x; asm volatile("" : "+v"(tid_));
    const int tid = tid_, lane = tid & 63, w = __builtin_amdgcn_readfirstlane(tid >> 6), t = tid >> 3, ch = tid & 7;
    const bf16_t* proj = (const bf16_t*)(p.ws + OFF_PROJ); const float* glow = (const float*)(p.ws + OFF_GLOW);
    float* Gbuf = (float*)(p.ws + OFF_G); float* Sloc = (float*)(p.ws + OFF_SLOC); float* dec = (float*)(p.ws + OFF_DEC);
    float* G = (float*)lds; unsigned char* Kimg = lds + 16384; unsigned char* Vimg = lds + 32768; float* W2l = (float*)(lds + 49152); float* segtot = (float*)(lds + 53248);
    for (int unit = bid; unit < 1024; unit += nblk) {
        const int bh = unit >> 6, n = unit & 63, b = bh >> 2, h = bh & 3, t0 = b * SEQ + n * SC;
        for (int i = tid; i < 1024; i += NT) W2l[i] = p.gate_w2[(i >> 6) * 256 + h * 64 + (i & 63)];
#pragma unroll
        for (int i = 0; i < 2; ++i) { const int idx = tid + NT * i, tr = idx >> 4, c16 = idx & 15;
            *(u32x4*)(Vimg + f2_off(tr, c16)) = *(const u32x4*)(proj + (size_t)(t0 + tr) * NPROJ + V_OFF + h * 128 + 8 * c16); }
        __syncthreads();
        {
            float gl[16];
#pragma unroll
            for (int q = 0; q < 4; ++q) { const f32x4 v = *(const f32x4*)(glow + (size_t)(t0 + t) * 16 + 4 * q); gl[4 * q] = v[0]; gl[4 * q + 1] = v[1]; gl[4 * q + 2] = v[2]; gl[4 * q + 3] = v[3]; }
#pragma unroll
            for (int dd = 0; dd < 8; ++dd) { const int d = 8 * ch + dd; float z = p.gate_b[h * 64 + d];
#pragma unroll
                for (int r = 0; r < 16; ++r) z += gl[r] * W2l[r * 64 + d];
                G[t * 64 + d] = logsigmoidf_(z) * (1.f / 16.f); }
        }
        __syncthreads();
        {
            const int seg = tid >> 6, d = tid & 63; float run = 0.f;
#pragma unroll
            for (int tt = 0; tt < 8; ++tt) { run += G[(8 * seg + tt) * 64 + d]; G[(8 * seg + tt) * 64 + d] = run; }
            segtot[seg * 64 + d] = run;
            __syncthreads();
            float pre = 0.f;
            for (int s2 = 0; s2 < seg; ++s2) pre += segtot[s2 * 64 + d];
#pragma unroll
            for (int tt = 0; tt < 8; ++tt) G[(8 * seg + tt) * 64 + d] += pre;
        }
        __syncthreads();
        {
            const f32x4 g0 = *(const f32x4*)(G + t * 64 + 8 * ch), g1 = *(const f32x4*)(G + t * 64 + 8 * ch + 4);
            const f32x4 l0 = *(const f32x4*)(G + 63 * 64 + 8 * ch), l1 = *(const f32x4*)(G + 63 * 64 + 8 * ch + 4);
            *(f32x4*)(Gbuf + (size_t)(t0 + t) * 256 + h * 64 + 8 * ch) = g0; *(f32x4*)(Gbuf + (size_t)(t0 + t) * 256 + h * 64 + 8 * ch + 4) = g1;
            const u16x8 kv = *(const u16x8*)(proj + (size_t)(t0 + t) * NPROJ + K_OFF + h * 64 + 8 * ch);
            bf16x8 o;
#pragma unroll
            for (int dd = 0; dd < 4; ++dd) { o[dd] = (__bf16)(bfbits2f(kv[dd]) * __expf(l0[dd] - g0[dd])); o[dd + 4] = (__bf16)(bfbits2f(kv[dd + 4]) * __expf(l1[dd] - g1[dd])); }
            *(bf16x8*)(Kimg + f2_off(t, ch)) = o;
            if (t == 63) {
#pragma unroll
                for (int dd = 0; dd < 4; ++dd) { dec[unit * 64 + 8 * ch + dd] = __expf(l0[dd]); dec[unit * 64 + 8 * ch + 4 + dd] = __expf(l1[dd]); }
            }
        }
        __syncthreads();
        {
            f32x4 acc[4];
#pragma unroll
            for (int dt = 0; dt < 4; ++dt) acc[dt] = (f32x4){0.f, 0.f, 0.f, 0.f};
#pragma unroll
            for (int ks = 0; ks < 2; ++ks) {
                const bf16x8 xv = f2_frag(Vimg, w, ks, lane);
#pragma unroll
                for (int dt = 0; dt < 4; ++dt) acc[dt] = MFMA16(xv, f2_frag(Kimg, dt, ks, lane), acc[dt]);
            }
#pragma unroll
            for (int dt = 0; dt < 4; ++dt) *(f32x4*)(Sloc + (size_t)unit * 8192 + (16 * dt + (lane & 15)) * 128 + 16 * w + 4 * (lane >> 4)) = acc[dt];
        }
        __syncthreads();
    }
}

DI void phase_gla2(const Params& p, int bid, int nblk, float* lds) {
    const float* Sloc = (const float*)(p.ws + OFF_SLOC); const float* dec = (const float*)(p.ws + OFF_DEC); bf16_t* Sin = (bf16_t*)(p.ws + OFF_SIN);
    for (int gid = bid * NT + threadIdx.x; gid < 16 * 8192; gid += nblk * NT) {
        const int bh = gid >> 13, el = gid & 8191, d = el >> 7; float st = 0.f;
        for (int n0 = 0; n0 < NSC; n0 += 16) {
            float sl[16], dc[16]; bf16_t so[16];
#pragma unroll
            for (int i = 0; i < 16; ++i) { const int u = bh * 64 + n0 + i; sl[i] = Sloc[(size_t)u * 8192 + el]; dc[i] = dec[u * 64 + d]; }
#pragma unroll
            for (int i = 0; i < 16; ++i) { so[i] = f2bf(st); st = st * dc[i] + sl[i]; }
#pragma unroll
            for (int i = 0; i < 16; ++i) Sin[(size_t)(bh * 64 + n0 + i) * 8192 + el] = so[i];
        }
    }
}

DI void phase_gla3(const Params& p, int bid, int nblk, float* ldsf) {
    unsigned char* lds = (unsigned char*)ldsf;
    int tid_ = threadIdx.x; asm volatile("" : "+v"(tid_));
    const int tid = tid_, lane = tid & 63, w = __builtin_amdgcn_readfirstlane(tid >> 6), t = tid >> 3, ch = tid & 7, l15 = lane & 15, kg = lane >> 4;
    const bf16_t* proj = (const bf16_t*)(p.ws + OFF_PROJ); const float* Gbuf = (const float*)(p.ws + OFF_G); const bf16_t* Sin = (const bf16_t*)(p.ws + OFF_SIN);
    bf16_t* mix = (bf16_t*)(p.ws + OFF_MIX);
    unsigned char* Qimg = lds; unsigned char* Kimg = lds + 8192; unsigned char* Pimg = lds + 16384; unsigned char* Vimg = lds + 24576; unsigned char* Simg = lds + 40960;
    float* part = (float*)(lds + 57344);
    for (int unit = bid; unit < 1024; unit += nblk) {
        const int bh = unit >> 6, n = unit & 63, b = bh >> 2, h = bh & 3, t0 = b * SEQ + n * SC;
        {
            const f32x4 g0 = *(const f32x4*)(Gbuf + (size_t)(t0 + t) * 256 + h * 64 + 8 * ch), g1 = *(const f32x4*)(Gbuf + (size_t)(t0 + t) * 256 + h * 64 + 8 * ch + 4);
            const u16x8 qv = *(const u16x8*)(proj + (size_t)(t0 + t) * NPROJ + Q_OFF + h * 64 + 8 * ch), kv = *(const u16x8*)(proj + (size_t)(t0 + t) * NPROJ + K_OFF + h * 64 + 8 * ch);
            bf16x8 qo, ko;
#pragma unroll
            for (int dd = 0; dd < 4; ++dd) {
                qo[dd] = (__bf16)(bfbits2f(qv[dd]) * 0.125f * __expf(g0[dd])); qo[dd + 4] = (__bf16)(bfbits2f(qv[dd + 4]) * 0.125f * __expf(g1[dd]));
                ko[dd] = (__bf16)(bfbits2f(kv[dd]) * __expf(-g0[dd])); ko[dd + 4] = (__bf16)(bfbits2f(kv[dd + 4]) * __expf(-g1[dd]));
            }
            *(bf16x8*)(Qimg + f1_off(t, ch)) = qo; *(bf16x8*)(Kimg + f1_off(t, ch)) = ko;
        }
#pragma unroll
        for (int i = 0; i < 2; ++i) { const int idx = tid + NT * i, tr = idx >> 4, c16 = idx & 15;
            *(u32x4*)(Vimg + f2_off(tr, c16)) = *(const u32x4*)(proj + (size_t)(t0 + tr) * NPROJ + V_OFF + h * 128 + 8 * c16);
            *(u32x4*)(Simg + f2_off(tr, c16)) = *(const u32x4*)(Sin + (size_t)unit * 8192 + tr * 128 + 8 * c16); }
        __syncthreads();
        {
            const int it = w >> 1;
#pragma unroll
            for (int jj = 0; jj < 2; ++jj) {
                const int jt = 2 * (w & 1) + jj; f32x4 acc = {0.f, 0.f, 0.f, 0.f};
                if (jt <= it) {
#pragma unroll
                    for (int ks = 0; ks < 2; ++ks) acc = MFMA16(f1_frag(Kimg, jt, ks, lane), f1_frag(Qimg, it, ks, lane), acc);
                    if (jt == it) {
#pragma unroll
                        for (int r = 0; r < 4; ++r) if (4 * kg + r > l15) acc[r] = 0.f;
                    }
                }
                bf16x4 o; o[0] = (__bf16)acc[0]; o[1] = (__bf16)acc[1]; o[2] = (__bf16)acc[2]; o[3] = (__bf16)acc[3];
                *(bf16x4*)(Pimg + f1_off(16 * it + l15, 2 * jt + (kg >> 1)) + 8 * (kg & 1)) = o;
            }
        }
        __syncthreads();
        {
            f32x4 acc[4];
#pragma unroll
            for (int it = 0; it < 4; ++it) acc[it] = (f32x4){0.f, 0.f, 0.f, 0.f};
#pragma unroll
            for (int ks = 0; ks < 2; ++ks) {
                const bf16x8 xv = f2_frag(Vimg, w, ks, lane), xs = f2_frag(Simg, w, ks, lane);
#pragma unroll
                for (int it = 0; it < 4; ++it) {
                    if (2 * ks <= it) acc[it] = MFMA16(xv, f1_frag(Pimg, it, ks, lane), acc[it]);
                    acc[it] = MFMA16(xs, f1_frag(Qimg, it, ks, lane), acc[it]);
                }
            }
#pragma unroll
            for (int it = 0; it < 4; ++it) {
                float ss = acc[it][0] * acc[it][0] + acc[it][1] * acc[it][1] + acc[it][2] * acc[it][2] + acc[it][3] * acc[it][3];
                ss += __shfl_xor(ss, 16); ss += __shfl_xor(ss, 32);
                if (kg == 0) part[w * 64 + 16 * it + l15] = ss;
            }
            __syncthreads();
            const int e0 = 16 * w + 4 * kg; const f32x4 nw = *(const f32x4*)(p.norm_w + e0);
#pragma unroll
            for (int it = 0; it < 4; ++it) {
                const int i = 16 * it + l15; float tot = 0.f;
#pragma unroll
                for (int w2 = 0; w2 < 8; ++w2) tot += part[w2 * 64 + i];
                const float inv = rsqrtf(tot * (1.f / 128.f) + RMS_EPS);
                const u16x4 rv = *(const u16x4*)(proj + (size_t)(t0 + i) * NPROJ + R_OFF + h * 128 + e0);
                bf16x4 o;
#pragma unroll
                for (int r = 0; r < 4; ++r) { const float rr = bfbits2f(rv[r]); o[r] = (__bf16)(acc[it][r] * inv * nw[r] * (rr * sigmoidf_(rr))); }
                *(bf16x4*)(mix + (size_t)(t0 + i) * D + 512 + h * 128 + e0) = o;
            }
        }
        __syncthreads();
    }
}

DI void phase_out(const Params& p, int bid, int nblk, float* lds) {
    const bf16_t* mix = (const bf16_t*)(p.ws + OFF_MIX); float* h32 = (float*)(p.ws + OFF_H32);
    for (int u = bid; u < 64 * 4; u += nblk) {
        const int mt = (nblk == 256) ? 8 * (u & 7) + (u >> 5) : u >> 2, nt = (nblk == 256) ? (u >> 3) & 3 : u & 3;
        auto rowoff = [&](int r) { return (unsigned)((mt * 256 + r) * D); };
        auto fin = [&](int r, int c, u32x4 dv) { const size_t o = (size_t)(mt * 256 + r) * D + nt * 256 + c; const f32x4 xv = *(const f32x4*)(p.x + o); *(f32x4*)(h32 + o) = xv * ALPHA + __builtin_bit_cast(f32x4, dv); };
        gemm_mfma<false, true, 4, D, 4>(mix, rowoff, (const float*)((const bf16_t*)(p.ws + OFF_WB_OUT) + nt * 256), nullptr, (unsigned)(((size_t)D * D - nt * 256) * 2), D, 256, PRE_ID, fin, (unsigned char*)lds);
    }
}

DI void ln_row(float (&v)[16], const float* g, const float* b, int lane) {
    float s = 0.f;
#pragma unroll
    for (int i = 0; i < 16; ++i) s += v[i];
    const float mean = wave_sum(s) * (1.f / D); float q = 0.f;
#pragma unroll
    for (int i = 0; i < 16; ++i) { v[i] -= mean; q += v[i] * v[i]; }
    const float rstd = rsqrtf(wave_sum(q) * (1.f / D) + LN_EPS);
#pragma unroll
    for (int j = 0; j < 4; ++j) {
        const float4 gg = ((const float4*)g)[lane + 64 * j], bb = ((const float4*)b)[lane + 64 * j];
        v[4 * j] = v[4 * j] * rstd * gg.x + bb.x; v[4 * j + 1] = v[4 * j + 1] * rstd * gg.y + bb.y;
        v[4 * j + 2] = v[4 * j + 2] * rstd * gg.z + bb.z; v[4 * j + 3] = v[4 * j + 3] * rstd * gg.w + bb.w;
    }
}

DI void ln1_rows(const Params& p, int r0, int nrows) {
    int tid_ = threadIdx.x; asm volatile("" : "+v"(tid_));
    const int lane = tid_ & 63, wave = tid_ >> 6;
    float* h32 = (float*)(p.ws + OFF_H32); bf16_t* hb = (bf16_t*)(p.ws + OFF_HB);
    for (int row = r0 + wave; row < r0 + nrows; row += 8) {
        float4* hr = (float4*)(h32 + (size_t)row * D); float v[16];
#pragma unroll
        for (int j = 0; j < 4; ++j) { const float4 a = hr[lane + 64 * j]; v[4 * j] = a.x; v[4 * j + 1] = a.y; v[4 * j + 2] = a.z; v[4 * j + 3] = a.w; }
        ln_row(v, p.ln1_g, p.ln1_b, lane);
#pragma unroll
        for (int j = 0; j < 4; ++j) {
            uint2 o; o.x = pk2(v[4 * j], v[4 * j + 1]); o.y = pk2(v[4 * j + 2], v[4 * j + 3]);
            ((uint2*)(hb + (size_t)row * D))[lane + 64 * j] = o;
        }
    }
}

DI void topk_rows(const Params& p, int r0, int nrows) {
    int tid_ = threadIdx.x; asm volatile("" : "+v"(tid_));
    const int lane = tid_ & 63, wave = tid_ >> 6;
    const float* scores = (const float*)(p.ws + OFF_SCORES); float* wbuf = (float*)(p.ws + OFF_WBUF);
    int* list = (int*)(p.ws + OFF_LIST); unsigned* cnt = (unsigned*)(p.ws + OFF_CTL) + CW_CNT;
    const float NEG = -__builtin_inff();
    for (int t = r0 + wave; t < r0 + nrows; t += 8) {
        const float4 sv = ((const float4*)(scores + (size_t)t * NE))[lane], bv = ((const float4*)p.router_bias)[lane];
        const float s[4] = {sv.x, sv.y, sv.z, sv.w};
        float cand[4] = {sv.x + bv.x, sv.y + bv.y, sv.z + bv.z, sv.w + bv.w};
        float m1 = NEG, m2 = NEG;
#pragma unroll
        for (int j = 0; j < 4; ++j) { const float v = cand[j]; if (v > m1) { m2 = m1; m1 = v; } else if (v > m2) m2 = v; }
#pragma unroll
        for (int off = 1; off < 8; off <<= 1) {
            const float o1 = __shfl_xor(m1, off), o2 = __shfl_xor(m2, off);
            const float n1 = fmaxf(m1, o1), n2 = fmaxf(fminf(m1, o1), fmaxf(m2, o2)); m1 = n1; m2 = n2;
        }
        const float gs = m1 + m2; const int mygrp = lane >> 3; int rank = 0;
#pragma unroll
        for (int g2 = 0; g2 < 8; ++g2) { const float og = __shfl(gs, g2 * 8); if (og > gs || (og == gs && g2 < mygrp)) ++rank; }
        if (rank >= 4) { cand[0] = NEG; cand[1] = NEG; cand[2] = NEG; cand[3] = NEG; }
        int my_e = 0; float my_w = 0.f, wsum = 0.f;
#pragma unroll
        for (int k = 0; k < TOPK; ++k) {
            float bvv = cand[0]; int bj = 0;
#pragma unroll
            for (int j = 1; j < 4; ++j) if (cand[j] > bvv) { bvv = cand[j]; bj = j; }
            int bi = 4 * lane + bj;
#pragma unroll
            for (int off = 32; off >= 1; off >>= 1) {
                const float ov = __shfl_xor(bvv, off); const int oi = __shfl_xor(bi, off);
                if (ov > bvv || (ov == bvv && oi < bi)) { bvv = ov; bi = oi; }
            }
            const int wj = bi & 3, wl = bi >> 2;
            const float mys = wj == 0 ? s[0] : (wj == 1 ? s[1] : (wj == 2 ? s[2] : s[3]));
            const float wk = __shfl(mys, wl);
            wsum += wk;
            if (lane == k) { my_e = bi; my_w = wk; }
            if (lane == wl) {
#pragma unroll
                for (int j = 0; j < 4; ++j) if (j == wj) cand[j] = NEG;
            }
        }
        if (lane < TOPK) {
            const unsigned pos = atomicAdd(&cnt[my_e], 1u);
            list[(size_t)my_e * LCAP + pos] = t * TOPK + lane;
            wbuf[(size_t)t * TOPK + lane] = my_w / wsum * 2.5f;
        }
    }
}

DI void phase_route(const Params& p, int bid, int nblk, float* lds) {
    const bf16_t* hb = (const bf16_t*)(p.ws + OFF_HB); float* scores = (float*)(p.ws + OFF_SCORES);
    for (int mt = bid; mt < T / 64; mt += nblk) {
        ln1_rows(p, mt * 64, 64);
        __syncthreads();
        auto rowoff = [&](int r) { return (unsigned)((mt * 64 + r) * D); };
        auto pre = [&](int r, int c, f32x4 v, f32x4) { return (f32x4){sigmoidf_(v[0]), sigmoidf_(v[1]), sigmoidf_(v[2]), sigmoidf_(v[3])}; };
        auto fin = [&](int r, int c, u32x4 dv) { *(u32x4*)(scores + (size_t)(mt * 64 + r) * NE + c) = dv; };
        gemm_mfma<false, true, 4, NE, 4>(hb, rowoff, (const float*)(p.ws + OFF_WB_RT), nullptr, (unsigned)(D * NE * 2), D, 64, pre, fin, (unsigned char*)lds);
        __syncthreads();
        topk_rows(p, mt * 64, 64);
        __syncthreads();
    }
}

constexpr int EXP_TAB_OFF = GEMM_LDS_BYTES;
DI void build_tables(const Params& p, int* toff, int* roff) {
    const unsigned* cnt = (const unsigned*)(p.ws + OFF_CTL) + CW_CNT;
    int* cl = roff + 260;
    if (threadIdx.x < NE) cl[threadIdx.x] = (int)__hip_atomic_load(cnt + threadIdx.x, __ATOMIC_RELAXED, __HIP_MEMORY_SCOPE_AGENT);
    __syncthreads();
    if (threadIdx.x <= NE) {
        int ta = 0, ra = 0;
        for (int e = 0; e < (int)threadIdx.x; ++e) { const int c = cl[e]; ta += (c + 255) >> 8; ra += c; }
        toff[threadIdx.x] = ta; roff[threadIdx.x] = ra;
    }
    __syncthreads();
}
DI int find_expert(const int* toff, int tile) { int lo = 0, hi = NE - 1; while (lo < hi) { const int mid = (lo + hi + 1) >> 1; if (toff[mid] <= tile) lo = mid; else hi = mid - 1; } return lo; }
struct ExpUnit { int e, row0, rows, rowbase; };
DI ExpUnit exp_unit(const Params& p, const int* toff, const int* roff, int tile, int ntile) {
    const unsigned* cnt = (const unsigned*)(p.ws + OFF_CTL) + CW_CNT;
    ExpUnit u;
    if (tile < ntile) {
        u.e = find_expert(toff, tile); const int ui = tile - toff[u.e], c = (int)cnt[u.e];
        u.row0 = ui * 256; u.rows = min(256, c - u.row0); u.rowbase = roff[u.e] + u.row0;
    } else { u.e = NE; u.row0 = (tile - ntile) * 256; u.rows = 256; u.rowbase = A_TOT + u.row0; }
    u.e = __builtin_amdgcn_readfirstlane(u.e); u.row0 = __builtin_amdgcn_readfirstlane(u.row0); u.rows = __builtin_amdgcn_readfirstlane(u.rows);
    u.rowbase = __builtin_amdgcn_readfirstlane(u.rowbase);
    return u;
}

template <int NTL>
DI void exp_decode(const int* toff, int ntile, int u, int& tile, int& nt) {
    if (u < NTL * ntile) { const int e = find_expert(toff, u / NTL), ne = toff[e + 1] - toff[e], u2 = u - NTL * toff[e]; nt = u2 / ne; tile = toff[e] + (u2 - nt * ne); }
    else { const int us = u - NTL * ntile; nt = us / (T / 256); tile = ntile + (us - nt * (T / 256)); }
}

DI void phase_e1(const Params& p, int bid, int nblk, float* lds) {
    int* toff = (int*)((unsigned char*)lds + EXP_TAB_OFF); int* roff = toff + 260;
    const bf16_t* hb = (const bf16_t*)(p.ws + OFF_HB); bf16_t* hid = (bf16_t*)(p.ws + OFF_HID); const int* list = (const int*)(p.ws + OFF_LIST);
    build_tables(p, toff, roff);
    const int ntile = toff[NE], units = (ntile + T / 256) * 2;
    const int vb = (nblk & 7) ? bid : (bid & 7) * (nblk >> 3) + (bid >> 3);
    u32x4 ra[2][2], rb[2][4]; unsigned ao[2] = {0u, 0u}; bool pre = false;
    int tile_n = 0, nt_n = 0; ExpUnit xn;
    if (vb < units) { exp_decode<2>(toff, ntile, vb, tile_n, nt_n); xn = exp_unit(p, toff, roff, tile_n, ntile); }
    for (int u = vb; u < units; u += nblk) {
        const int nt = nt_n; const ExpUnit x = xn; const bool hn = u + nblk < units;
        if (hn) { exp_decode<2>(toff, ntile, u + nblk, tile_n, nt_n); xn = exp_unit(p, toff, roff, tile_n, ntile); }
        const float* wg = x.e < NE ? p.wg + (size_t)x.e * 262144 : p.sg; const float* wu = x.e < NE ? p.wu + (size_t)x.e * 262144 : p.su;
        const float* wgn = xn.e < NE ? p.wg + (size_t)xn.e * 262144 : p.sg; const float* wun = xn.e < NE ? p.wu + (size_t)xn.e * 262144 : p.su;
        auto rowoff = [&](int r) { const int tok = x.e < NE ? (list[(size_t)x.e * LCAP + x.row0 + r] >> 3) : (x.row0 + r); return (unsigned)(tok * D); };
        auto rowoff_n = [&](int r) { const int tok = xn.e < NE ? (list[(size_t)xn.e * LCAP + xn.row0 + r] >> 3) : (xn.row0 + r); return (unsigned)(tok * D); };
        auto prf = [&](int r, int c, f32x4 g, f32x4 uu) { return (f32x4){g[0] * sigmoidf_(g[0]) * uu[0], g[1] * sigmoidf_(g[1]) * uu[1], g[2] * sigmoidf_(g[2]) * uu[2], g[3] * sigmoidf_(g[3]) * uu[3]}; };
        auto fin = [&](int r, int c, u32x4 dv) { *(u32x4*)(hid + (size_t)(x.rowbase + r) * EDIM + nt * 128 + c) = dv; };
        gemm_core<true, false, 2, EDIM, 4>(ra, rb, ao, pre, hb, rowoff, wg + nt * 128, wu + nt * 128, (unsigned)((D * EDIM - nt * 128) * 4), D, x.rows,
                                 hn, rowoff_n, wgn + nt_n * 128, wun + nt_n * 128, (unsigned)((D * EDIM - nt_n * 128) * 4), xn.rows, prf, fin, (unsigned char*)lds);
        pre = hn;
    }
}

DI void phase_e2(const Params& p, int bid, int nblk, float* lds) {
    int* toff = (int*)((unsigned char*)lds + EXP_TAB_OFF); int* roff = toff + 260; int* rowa = roff + 520;
    const bf16_t* hid = (const bf16_t*)(p.ws + OFF_HID); unsigned char* Y = p.ws + OFF_Y; const int* list = (const int*)(p.ws + OFF_LIST);
    build_tables(p, toff, roff);
    const int ntile = toff[NE], units = (ntile + T / 256) * 4;
    const int vb = (nblk & 7) ? bid : (bid & 7) * (nblk >> 3) + (bid >> 3);
    u32x4 ra[2][2], rb[2][4]; unsigned ao[2] = {0u, 0u}; bool pre = false;
    int tile_n = 0, nt_n = 0; ExpUnit xn;
    if (vb < units) { exp_decode<4>(toff, ntile, vb, tile_n, nt_n); xn = exp_unit(p, toff, roff, tile_n, ntile); }
    for (int u = vb; u < units; u += nblk) {
        const int nt = nt_n; const ExpUnit x = xn; const bool hn = u + nblk < units;
        if (hn) { exp_decode<4>(toff, ntile, u + nblk, tile_n, nt_n); xn = exp_unit(p, toff, roff, tile_n, ntile); }
        const float* wd = x.e < NE ? p.wd + (size_t)x.e * 262144 : p.sd; const float* wdn = xn.e < NE ? p.wd + (size_t)xn.e * 262144 : p.sd;
        if (threadIdx.x < 256) { const int r = threadIdx.x; rowa[r] = x.e < NE ? (r < x.rows ? list[(size_t)x.e * LCAP + x.row0 + r] : 0) : (A_TOT + x.row0 + r); }
        __syncthreads();
        auto rowoff = [&](int r) { return (unsigned)((x.rowbase + r) * EDIM); };
        auto rowoff_n = [&](int r) { return (unsigned)((xn.rowbase + r) * EDIM); };
        auto fin = [&](int r, int c, u32x4 dv) { *(u32x4*)(Y + (size_t)rowa[r] * D + nt * 256 + c) = dv; };
        gemm_core<false, false, 1, D, 4>(ra, rb, ao, pre, hid, rowoff, wd + nt * 256, nullptr, (unsigned)((EDIM * D - nt * 256) * 4), EDIM, x.rows,
                               hn, rowoff_n, wdn + nt_n * 256, nullptr, (unsigned)((EDIM * D - nt_n * 256) * 4), xn.rows, PRE_ID, fin, (unsigned char*)lds);
        pre = hn;
        __syncthreads();
    }
}

DI void phase_combine(const Params& p, int bid, int nblk, float* lds) {
    const int lane = threadIdx.x & 63, wave = threadIdx.x >> 6;
    const bf16_t* hb = (const bf16_t*)(p.ws + OFF_HB); const unsigned char* Y = p.ws + OFF_Y; const float* wbuf = (const float*)(p.ws + OFF_WBUF);
    typedef float f32x2 __attribute__((ext_vector_type(2)));
    for (int t = bid * 8 + wave; t < T; t += nblk * 8) {
        float v[16];
#pragma unroll
        for (int j = 0; j < 4; ++j) { const uint2 a = ((const uint2*)(hb + (size_t)t * D))[lane + 64 * j];
            v[4 * j] = ALPHA * __uint_as_float(a.x << 16); v[4 * j + 1] = ALPHA * __uint_as_float(a.x & 0xffff0000u);
            v[4 * j + 2] = ALPHA * __uint_as_float(a.y << 16); v[4 * j + 3] = ALPHA * __uint_as_float(a.y & 0xffff0000u); }
#pragma unroll
        for (int k = 0; k < 9; ++k) {
            const size_t row = k < 8 ? (size_t)t * TOPK + k : (size_t)A_TOT + t; const float w = (k < 8 ? wbuf[(size_t)t * TOPK + k] : 1.f) * (1.f / 128.f);
#pragma unroll
            for (int j = 0; j < 4; ++j) {
                const int y = ((const int*)(Y + row * D))[lane + 64 * j];
                const f32x2 lo = __builtin_amdgcn_cvt_pk_f32_fp8(y, false), hi = __builtin_amdgcn_cvt_pk_f32_fp8(y, true);
                v[4 * j] += w * lo[0]; v[4 * j + 1] += w * lo[1]; v[4 * j + 2] += w * hi[0]; v[4 * j + 3] += w * hi[1];
            }
        }
        ln_row(v, p.ln2_g, p.ln2_b, lane);
#pragma unroll
        for (int j = 0; j < 4; ++j) ((float4*)(p.out + (size_t)t * D))[lane + 64 * j] = make_float4(v[4 * j], v[4 * j + 1], v[4 * j + 2], v[4 * j + 3]);
    }
}

#define LAS __attribute__((address_space(3)))
#define XB_TMO      128
#define XB_XCNT(j)  (256  + 64 * (j))
#define XB_XSUB(j)  (1280 + 64 * (j))
#define XB_XGEN(j)  (2304 + 64 * (j))
#define XB_TOP      3328
#define XB_TOPGEN   3392
#define XCD_BAR_WORDS 3456
#define XB_SPIN_CAP (1u << 22)
constexpr int CW_BAR = 4096;
DI unsigned xb_ld(unsigned* p) { return __hip_atomic_load(p, __ATOMIC_RELAXED, __HIP_MEMORY_SCOPE_AGENT); }
DI unsigned xb_add(unsigned* p, unsigned v) { return __hip_atomic_fetch_add(p, v, __ATOMIC_RELAXED, __HIP_MEMORY_SCOPE_AGENT); }
DI unsigned xb_xcc_id() { return (unsigned)__builtin_amdgcn_s_getreg((3 << 11) | 20) & 0xFu; }
#define XB_SPIN(cond, bar) do { unsigned _sp = 0; while (cond) { __builtin_amdgcn_s_sleep(1); \
    if ((++_sp & 255u) == 0u) { if (xb_ld(&(bar)[XB_TMO])) break; if (_sp > XB_SPIN_CAP) { atomicAdd(&(bar)[XB_TMO], 1u); break; } } } } while (0)
struct XcdBarrier { unsigned* bar; unsigned x; volatile LAS unsigned* st; };
DI XcdBarrier xcd_barrier_post(unsigned* bar, volatile LAS unsigned* st) {
    XcdBarrier b; b.bar = bar; b.x = xb_xcc_id(); b.st = st;
    if (threadIdx.x == 0) (void)xb_add(&bar[XB_XCNT(b.x)], 1u);
    return b;
}
DI void xcd_barrier_complete(unsigned* bar, unsigned x, unsigned& nloc, unsigned& nx) {
    const unsigned G = gridDim.x * gridDim.y * gridDim.z;
    unsigned sum, cnt, mine, sp = 0u;
    for (;;) {
        sum = 0u; cnt = 0u; mine = 0u;
#pragma unroll
        for (unsigned j = 0; j < 16; ++j) { const unsigned c = xb_ld(&bar[XB_XCNT(j)]); sum += c; cnt += (c > 0u) ? 1u : 0u; mine = (j == x) ? c : mine; }
        if (sum == G) break;
        __builtin_amdgcn_s_sleep(1);
        if ((++sp & 255u) == 0u) { if (xb_ld(&bar[XB_TMO])) break; if (sp > XB_SPIN_CAP) { atomicAdd(&bar[XB_TMO], 1u); break; } }
    }
    nloc = mine > 0u ? mine : 1u; nx = cnt > 0u ? cnt : 1u;
}
DI void xcd_barrier(const XcdBarrier& b) {
    asm volatile("s_waitcnt vmcnt(0)" ::: "memory");
    __syncthreads();
    if (threadIdx.x == 0) {
        unsigned* bar = b.bar;
        __builtin_amdgcn_s_waitcnt(0);
        unsigned nloc = b.st[0], nx = b.st[1];
        if (nloc == 0u) { xcd_barrier_complete(bar, b.x, nloc, nx); b.st[0] = nloc; b.st[1] = nx; }
        const unsigned old = xb_add(&bar[XB_XSUB(b.x)], 1u);
        const unsigned gen = old / nloc;
        if (old + 1u == (gen + 1u) * nloc) {
            __builtin_amdgcn_fence(__ATOMIC_RELEASE, "agent");
            asm volatile("s_waitcnt vmcnt(0)" ::: "memory");
            const unsigned og = xb_add(&bar[XB_TOP], 1u);
            const unsigned tg = og / nx;
            if (og + 1u == (tg + 1u) * nx) xb_add(&bar[XB_TOPGEN], 1u);
            else XB_SPIN(xb_ld(&bar[XB_TOPGEN]) == tg, bar);
            __builtin_amdgcn_fence(__ATOMIC_ACQUIRE, "agent");
            xb_add(&bar[XB_XGEN(b.x)], 1u);
            asm volatile("s_waitcnt vmcnt(0)" ::: "memory");
        } else {
            XB_SPIN(xb_ld(&bar[XB_XGEN(b.x)]) == gen, bar);
            __builtin_amdgcn_fence(__ATOMIC_ACQUIRE, "agent");
            asm volatile("s_waitcnt vmcnt(0)" ::: "memory");
        }
    }
    __syncthreads();
}

constexpr int LDS_BYTES = 136 * 1024;
constexpr int LDS_BAR_OFF = LDS_BYTES - 16;
__global__ void __launch_bounds__(NT) fwd_megakernel(Params p) {
    extern __shared__ __attribute__((aligned(16))) float lds[];
    const int bid = blockIdx.x, nblk = gridDim.x;
    volatile LAS unsigned* st = (volatile LAS unsigned*)((LAS unsigned char*)lds + LDS_BAR_OFF);
    if (threadIdx.x < 4) st[threadIdx.x] = 0u;
    __syncthreads();
    XcdBarrier bar = xcd_barrier_post((unsigned*)(p.ws + OFF_CTL) + CW_BAR, st);
    phase_prep(p, bid, nblk, lds);      xcd_barrier(bar);
    phase_proj(p, bid, nblk, lds);      xcd_barrier(bar);
    phase_poolmean(p, bid, nblk, lds);
    phase_gla1(p, bid, nblk, lds);      xcd_barrier(bar);
    phase_pool(p, bid, nblk, lds);
    phase_gla2(p, bid, nblk, lds);      xcd_barrier(bar);
    phase_gla3(p, bid, nblk, lds);      xcd_barrier(bar);
    phase_out(p, bid, nblk, lds);       xcd_barrier(bar);
    phase_route(p, bid, nblk, lds);     xcd_barrier(bar);
    phase_e1(p, bid, nblk, lds);        xcd_barrier(bar);
    phase_e2(p, bid, nblk, lds);        xcd_barrier(bar);
    phase_combine(p, bid, nblk, lds);
}

extern "C" void kernel_launch(void* const* d_in, const int* in_sizes, int n_in, void* d_out, int out_size, void* d_ws, size_t ws_size, hipStream_t stream) {
    static int grid = 0;
    if (grid == 0) {
        if (n_in != 20 || ws_size < WS_NEED) { fprintf(stderr, "kernel_launch: unexpected n_in %d or ws_size %zu (< %zu)\n", n_in, ws_size, (size_t)WS_NEED); grid = -1; return; }
        int dev = 0, cus = 0, per_cu = 0;
        (void)hipGetDevice(&dev); (void)hipDeviceGetAttribute(&cus, hipDeviceAttributeMultiprocessorCount, dev);
        (void)hipFuncSetAttribute((const void*)fwd_megakernel, hipFuncAttributeMaxDynamicSharedMemorySize, LDS_BYTES);
        (void)hipOccupancyMaxActiveBlocksPerMultiprocessor(&per_cu, (const void*)fwd_megakernel, NT, LDS_BYTES);
        if (per_cu < 1 || cus < 1) { fprintf(stderr, "kernel_launch: occupancy query says %d blocks/CU on %d CUs\n", per_cu, cus); grid = -1; return; }
        grid = cus;
    }
    if (grid < 0) return;
    (void)hipMemsetAsync((char*)d_ws + OFF_CTL, 0, 64 * 1024, stream);
    Params p{};
    const float** pp = (const float**)&p;
    for (int i = 0; i < 20; ++i) pp[i] = (const float*)d_in[i];
    p.out = (float*)d_out; p.ws = (unsigned char*)d_ws;
    void* args[] = {&p};
    hipError_t e = hipLaunchCooperativeKernel((const void*)fwd_megakernel, dim3(grid), dim3(NT), args, LDS_BYTES, stream);
    if (e != hipSuccess) fprintf(stderr, "cooperative launch failed: %s (grid %d)\n", hipGetErrorString(e), grid);
}
```

```cpp
#include <hip/hip_runtime.h>
#include <stdint.h>
#include <cstdio>

#define DI __device__ __forceinline__
typedef unsigned short bf16_t;

constexpr int T = 16384, D = 1024, SEQ = 4096;
constexpr int DIN = 2064, NPROJ = 2048;
constexpr int P_OFF = 0, Q_OFF = 512, K_OFF = 768, V_OFF = 1024, R_OFF = 1536, GL_OFF = 2048;
constexpr int SC = 64;
constexpr int NSC = SEQ / SC;
constexpr int NE = 256, TOPK = 8, EDIM = 256;
constexpr int A_TOT = T * TOPK;
constexpr int LCAP = T;
constexpr float ALPHA = 1.189207115002721f;
constexpr float LN_EPS = 1e-5f, RMS_EPS = 1e-5f;
constexpr int NT = 512;

constexpr size_t MiB = 1u << 20;
constexpr size_t OFF_CTL = 0;
constexpr size_t OFF_XB = 1 * MiB;
constexpr size_t OFF_GLOW = OFF_XB + 32 * MiB;
constexpr size_t OFF_PROJ = OFF_GLOW + 1 * MiB;
constexpr size_t OFF_G = OFF_PROJ + 64 * MiB;
constexpr size_t OFF_SLOC = OFF_G + 16 * MiB;
constexpr size_t OFF_DEC = OFF_SLOC + 32 * MiB;
constexpr size_t OFF_SIN = OFF_DEC + 1 * MiB;
constexpr size_t OFF_MIX = OFF_SIN + 32 * MiB;
constexpr size_t OFF_H32 = OFF_MIX + 32 * MiB;
constexpr size_t OFF_HB = OFF_H32 + 64 * MiB;
constexpr size_t OFF_SCORES = OFF_HB + 32 * MiB;
constexpr size_t OFF_WBUF = OFF_SCORES + 16 * MiB;
constexpr size_t OFF_LIST = OFF_WBUF + 1 * MiB;
constexpr size_t OFF_HID = OFF_LIST + 16 * MiB;
constexpr size_t OFF_Y = OFF_HID + 76 * MiB;
constexpr size_t OFF_PM = OFF_Y + 304 * MiB;
constexpr size_t OFF_WB_IN = OFF_PM + 16 * MiB;
constexpr size_t OFF_WB_OUT = OFF_WB_IN + 4 * MiB;
constexpr size_t OFF_WB_RT = OFF_WB_OUT + 2 * MiB;
constexpr size_t OFF_WB_SGU = OFF_WB_RT + 1 * MiB;
constexpr size_t OFF_WB_SD = OFF_WB_SGU + 1 * MiB;
constexpr size_t WS_NEED = OFF_WB_SD + 1 * MiB;
constexpr int CW_CNT = 1024;

struct Params {
    const float *x, *w_in, *gate_w2, *gate_b, *norm_w, *pool_w, *pool_scale, *w_out, *ln1_g, *ln1_b;
    const float *router_w, *router_bias, *wg, *wu, *wd, *sg, *su, *sd, *ln2_g, *ln2_b;
    float* out;
    unsigned char* ws;
};

DI float bf2f(bf16_t v) { return __uint_as_float(((unsigned)v) << 16); }
DI bf16_t f2bf(float f) { unsigned u = __float_as_uint(f); u += 0x7fffu + ((u >> 16) & 1u); return (bf16_t)(u >> 16); }
DI unsigned pk2(float lo, float hi) { return (unsigned)f2bf(lo) | ((unsigned)f2bf(hi) << 16); }
DI float wave_sum(float v) {
#pragma unroll
    for (int o = 1; o < 64; o <<= 1) v += __shfl_xor(v, o);
    return v;
}
DI float sigmoidf_(float v) { return 1.f / (1.f + __expf(-v)); }
DI float logsigmoidf_(float z) { return fminf(z, 0.f) - log1pf(__expf(-fabsf(z))); }

constexpr int GT_LDS_FLOATS = 16 * 132 + 2 * 16 * 68;
template <bool DUAL, class AF, class BF, class EPI>
DI void gemm_tile_valu(int K, const AF& af, const BF& bfn, const EPI& epi, float* lds) {
    float* As = lds; float* Bs = lds + 16 * 132; float* Bs2 = Bs + 16 * 68;
    const int tid = threadIdx.x, ty = tid >> 4, tx = tid & 15;
    float acc[4][4], acc2[4][4];
#pragma unroll
    for (int i = 0; i < 4; ++i)
#pragma unroll
        for (int j = 0; j < 4; ++j) { acc[i][j] = 0.f; acc2[i][j] = 0.f; }
    for (int k0 = 0; k0 < K; k0 += 16) {
#pragma unroll
        for (int i = 0; i < 4; ++i) { const int e = tid + 512 * i, r = e >> 4, kk = e & 15; As[kk * 132 + r] = af(r, k0 + kk); }
#pragma unroll
        for (int i = 0; i < 2; ++i) { const int e = tid + 512 * i, kk = e >> 6, c = e & 63; Bs[kk * 68 + c] = bfn(0, k0 + kk, c); if (DUAL) Bs2[kk * 68 + c] = bfn(1, k0 + kk, c); }
        __syncthreads();
#pragma unroll
        for (int kk = 0; kk < 16; ++kk) {
            const float4 a = *(const float4*)&As[kk * 132 + ty * 4];
            const float4 b = *(const float4*)&Bs[kk * 68 + tx * 4];
            const float av[4] = {a.x, a.y, a.z, a.w}, bv[4] = {b.x, b.y, b.z, b.w};
#pragma unroll
            for (int i = 0; i < 4; ++i)
#pragma unroll
                for (int j = 0; j < 4; ++j) acc[i][j] += av[i] * bv[j];
            if (DUAL) {
                const float4 b2 = *(const float4*)&Bs2[kk * 68 + tx * 4];
                const float b2v[4] = {b2.x, b2.y, b2.z, b2.w};
#pragma unroll
                for (int i = 0; i < 4; ++i)
#pragma unroll
                    for (int j = 0; j < 4; ++j) acc2[i][j] += av[i] * b2v[j];
            }
        }
        __syncthreads();
    }
#pragma unroll
    for (int i = 0; i < 4; ++i)
#pragma unroll
        for (int j = 0; j < 4; ++j) epi(ty * 4 + i, tx * 4 + j, acc[i][j], acc2[i][j]);
}


typedef __bf16 bf16x8 __attribute__((ext_vector_type(8)));
typedef __bf16 bf16x4 __attribute__((ext_vector_type(4)));
typedef short s16x4 __attribute__((ext_vector_type(4)));
typedef float f32x4 __attribute__((ext_vector_type(4)));
typedef unsigned u32x4 __attribute__((ext_vector_type(4)));
#define LAS3 __attribute__((address_space(3)))
DI const float* uniform_ptr(const float* p) {
    const unsigned long long v = (unsigned long long)p;
    const unsigned lo = __builtin_amdgcn_readfirstlane((unsigned)v), hi = __builtin_amdgcn_readfirstlane((unsigned)(v >> 32));
    return (const float*)(((unsigned long long)hi << 32) | lo);
}
#define MFMA16(a, b, c) __builtin_amdgcn_mfma_f32_16x16x32_bf16((a), (b), (c), 0, 0, 0)
constexpr int GEMM_LDS_BYTES = 131072;
DI unsigned a_swz(unsigned x) { return (0x78u >> (2u * x)) & 3u; }
struct GemmRegs { u32x4 ra[2][2], rb[2][4]; };
template <bool DUAL, bool BK16, int OUTB, int LDB, int WN, class RowFn, class RowFnN, class Pre, class Fin>
DI void gemm_core(u32x4 (&Rra)[2][2], u32x4 (&Rrb)[2][4], unsigned (&aoffc)[2], bool preloaded, const bf16_t* Ab, const RowFn& rowoff, const float* B0, const float* B1, unsigned bbytes, int K, int rows,
                  bool has_next, const RowFnN& rowoff_n, const float* B0n, const float* B1n, unsigned bbytes_n, int rows_n, const Pre& pre, const Fin& fin, unsigned char* lds) {
    int tid_ = threadIdx.x; asm volatile("" : "+v"(tid_));
    const int tid = tid_, lane = tid & 63, w = __builtin_amdgcn_readfirstlane(tid >> 6), wm = w >> 2, wn = w & 3, l15 = lane & 15, kg = lane >> 4, t256 = tid & 255;
    const bool active = wn < WN;
    const int nrow_w = min(max(rows - 128 * wm, 0), 128), ngrp = (((nrow_w + 15) >> 4) + 1) >> 1;
    unsigned aoff[2];
#pragma unroll
    for (int i = 0; i < 2; ++i) aoff[i] = preloaded ? aoffc[i] : (rowoff(min(128 * wm + (t256 >> 2) + 64 * i, rows - 1)) + (t256 & 3) * 8) * 2u;
    const __amdgpu_buffer_rsrc_t ar = __builtin_amdgcn_make_buffer_rsrc((void*)Ab, 0, 0x7fffffff, 0x00020000);
    const unsigned awr = (128 * wm + (t256 >> 2)) * 128 + ((((unsigned)(t256 & 3)) ^ (unsigned)((t256 >> 3) & 7)) << 4);
    constexpr int NB = BK16 ? 2 : 4;
    const float* bsrc = uniform_ptr(DUAL && !BK16 ? ((wn >> 1) ? B1 : B0) : B0);
    const __amdgpu_buffer_rsrc_t br = __builtin_amdgcn_make_buffer_rsrc((void*)bsrc, 0, bbytes, 0x00020000);
    const unsigned bvoff = BK16 ? (unsigned)(((lane >> 5) * LDB + (lane & 31) * 8) * 2) : (DUAL ? (unsigned)(((lane >> 5) * LDB + (lane & 31) * 4) * 4) : (unsigned)(lane * 16));
    const int krow0 = BK16 ? 16 * wm + 2 * wn : (DUAL ? 16 * wm + 8 * (wn & 1) : 16 * wm + wn);
    constexpr int KSTEP = BK16 ? 8 : (DUAL ? 2 : 4), ESZ = BK16 ? 2 : 4;
    unsigned aoff_n[2];
#pragma unroll
    for (int i = 0; i < 2; ++i) aoff_n[i] = has_next ? (rowoff_n(min(128 * wm + (t256 >> 2) + 64 * i, rows_n - 1)) + (t256 & 3) * 8) * 2u : aoff[i];
    const float* bsrc_n = uniform_ptr(has_next ? (DUAL && !BK16 ? ((wn >> 1) ? B1n : B0n) : B0n) : bsrc);
    const __amdgpu_buffer_rsrc_t br_n = __builtin_amdgcn_make_buffer_rsrc((void*)bsrc_n, 0, has_next ? bbytes_n : bbytes, 0x00020000);
    unsigned bwr[NB];
#pragma unroll
    for (int i = 0; i < NB; ++i) {
        const int kb = krow0 + KSTEP * i + ((BK16 || DUAL) ? (lane >> 5) : 0);
        const int n = BK16 ? 8 * (lane & 31) : (DUAL ? (wn >> 1) * 128 + 4 * (lane & 31) : 4 * lane);
        const unsigned I = n >> 7, ch = (n & 127) >> 3, half = BK16 ? 0u : (unsigned)((n >> 2) & 1), xx = ((kb & 3) << 2) | ((kb >> 2) & 3);
        bwr[i] = 32768u + I * 16384u + 256u * kb + 16u * (ch ^ xx) + 8u * half;
    }
    const unsigned ard = (128 * wm + l15) * 128 + ((((unsigned)kg) ^ (unsigned)((l15 >> 1) & 7)) << 4);
    unsigned trd0, trd1;
    {
        const unsigned q = l15 >> 2, pp = l15 & 3, cbase = (DUAL ? 4u * wn : 8u * (wn & 1)) + (pp >> 1), ibase = DUAL ? 0u : (unsigned)(wn >> 1);
        const unsigned x0 = (q << 2) | ((2u * kg) & 3u), x1 = (q << 2) | ((2u * kg + 1u) & 3u);
        trd0 = 32768u + ibase * 16384u + 256u * (8u * kg + q) + 16u * (cbase ^ x0) + 8u * (pp & 1);
        trd1 = 32768u + ibase * 16384u + 256u * (8u * kg + 4u + q) + 16u * (cbase ^ x1) + 8u * (pp & 1);
    }
    f32x4 acc[8][4];
#pragma unroll
    for (int i = 0; i < 8; ++i)
#pragma unroll
        for (int f = 0; f < 4; ++f) acc[i][f] = (f32x4){0.f, 0.f, 0.f, 0.f};
    const int nj = K / 32;
#define LOAD_SET(S, j) { _Pragma("unroll") for (int i = 0; i < 2; ++i) Rra[S][i] = __builtin_bit_cast(u32x4, __builtin_amdgcn_raw_buffer_load_b128(ar, aoff[i], (j) * 64, 0)); \
        _Pragma("unroll") for (int i = 0; i < NB; ++i) Rrb[S][i] = __builtin_bit_cast(u32x4, __builtin_amdgcn_raw_buffer_load_b128(br, bvoff, ((j) * 32 + krow0 + KSTEP * i) * (LDB * ESZ), 0)); }
#define LOAD_SET_N(S, j) { _Pragma("unroll") for (int i = 0; i < 2; ++i) Rra[S][i] = __builtin_bit_cast(u32x4, __builtin_amdgcn_raw_buffer_load_b128(ar, aoff_n[i], (j) * 64, 0)); \
        _Pragma("unroll") for (int i = 0; i < NB; ++i) Rrb[S][i] = __builtin_bit_cast(u32x4, __builtin_amdgcn_raw_buffer_load_b128(br_n, bvoff, ((j) * 32 + krow0 + KSTEP * i) * (LDB * ESZ), 0)); }
#define WRITE_SET(S, st, h) { _Pragma("unroll") for (int i = 0; i < 2; ++i) *(u32x4*)(lds + (st) * 65536 + (awr ^ ((h) ? 64u : 0u)) + i * 8192) = Rra[S][i]; \
        _Pragma("unroll") for (int i = 0; i < NB; ++i) { if (BK16) *(u32x4*)(lds + (st) * 65536 + (h) * 8192 + bwr[i]) = Rrb[S][i]; else { \
            const f32x4 v = __builtin_bit_cast(f32x4, Rrb[S][i]); bf16x4 o; o[0] = (__bf16)v[0]; o[1] = (__bf16)v[1]; o[2] = (__bf16)v[2]; o[3] = (__bf16)v[3]; \
            *(bf16x4*)(lds + (st) * 65536 + (h) * 8192 + ((!DUAL) ? ((bwr[0] ^ (unsigned)(i << 4)) + 1024u * i) : bwr[i])) = o; } } }
#define LOAD_SEL(S, jl) { const bool nx_ = (jl) >= nj; const int jt_ = nx_ ? (jl) - nj : (jl); \
        _Pragma("unroll") for (int i = 0; i < 2; ++i) Rra[S][i] = __builtin_bit_cast(u32x4, __builtin_amdgcn_raw_buffer_load_b128(ar, nx_ ? aoff_n[i] : aoff[i], jt_ * 64, 0)); \
        if (nx_) { _Pragma("unroll") for (int i = 0; i < NB; ++i) Rrb[S][i] = __builtin_bit_cast(u32x4, __builtin_amdgcn_raw_buffer_load_b128(br_n, bvoff, (jt_ * 32 + krow0 + KSTEP * i) * (LDB * ESZ), 0)); } \
        else { _Pragma("unroll") for (int i = 0; i < NB; ++i) Rrb[S][i] = __builtin_bit_cast(u32x4, __builtin_amdgcn_raw_buffer_load_b128(br, bvoff, (jt_ * 32 + krow0 + KSTEP * i) * (LDB * ESZ), 0)); } }
#define TF_LOAD(dst, st, h, g) { _Pragma("unroll") for (int q_ = 0; q_ < 2; ++q_) dst[q_] = *(const bf16x8*)(lds + (st) * 65536 + ((g) * 2 + q_) * 2048 + (ard ^ ((h) ? 64u : 0u))); }
#define WF_LOAD(st, h) { _Pragma("unroll") for (int f = 0; f < 4; ++f) { \
        const unsigned fx = DUAL ? ((f & 1) << 5) : (f << 5), fo = (DUAL ? (f >> 1) * 16384 : 0) + (st) * 65536 + (h) * 8192; \
        const s16x4 lo = __builtin_amdgcn_ds_read_tr16_b64_v4i16((LAS3 s16x4*)(lds + ((trd0 ^ fx) + fo))); \
        const s16x4 hi = __builtin_amdgcn_ds_read_tr16_b64_v4i16((LAS3 s16x4*)(lds + ((trd1 ^ fx) + fo))); \
        wf[f] = __builtin_bit_cast(bf16x8, __builtin_shufflevector(lo, hi, 0, 1, 2, 3, 4, 5, 6, 7)); } }
#define STAGE_MMA(srcf, g) { _Pragma("unroll") for (int q_ = 0; q_ < 2; ++q_) _Pragma("unroll") for (int f = 0; f < 4; ++f) acc[(g) * 2 + q_][f] = MFMA16(wf[f], srcf[q_], acc[(g) * 2 + q_][f]); }
#define STAGE(st, h, g, cur, nxt) if ((g) < ngrp) { \
        if ((g) + 1 < 4 && (g) + 1 < ngrp) TF_LOAD(nxt, st, h, (g) + 1) \
        __builtin_amdgcn_sched_barrier(0); \
        STAGE_MMA(cur, g) \
        __builtin_amdgcn_sched_barrier(0); }
    const bool comp = active && ngrp > 0;
    bf16x8 fa[2], fb[2], wf[4];
#define HALF_MMA(st, h) if (comp) { STAGE(st, h, 0, fa, fb) STAGE(st, h, 1, fb, fa) STAGE(st, h, 2, fa, fb) STAGE(st, h, 3, fb, fa) }
#define PREFETCH(st, h) if (comp) { WF_LOAD(st, h) TF_LOAD(fa, st, h, 0) }
    const int nJ = K / 64;
    if (!preloaded) { LOAD_SET(0, 0) LOAD_SET(1, 1) }
    WRITE_SET(0, 0, 0) WRITE_SET(1, 0, 1)
    LOAD_SEL(0, 2) LOAD_SEL(1, 3)
    __syncthreads();
    int st = 0;
#pragma unroll 1
    for (int J = 0; J < nJ - 1; ++J) {
        PREFETCH(st, 0)
        HALF_MMA(st, 0)
        PREFETCH(st, 1)
        WRITE_SET(0, st ^ 1, 0) LOAD_SEL(0, 2 * J + 4)
        HALF_MMA(st, 1)
        WRITE_SET(1, st ^ 1, 1) LOAD_SEL(1, 2 * J + 5)
        __syncthreads();
        st ^= 1;
    }
    {
        PREFETCH(st, 0)
        HALF_MMA(st, 0)
        PREFETCH(st, 1)
        HALF_MMA(st, 1)
        __syncthreads();
    }
#undef HALF_MMA
#undef PREFETCH
#undef LOAD_SET
#undef LOAD_SET_N
#undef LOAD_SEL
#undef WRITE_SET
#undef TF_LOAD
#undef WF_LOAD
#undef STAGE_MMA
#undef STAGE
    aoffc[0] = aoff_n[0]; aoffc[1] = aoff_n[1];
    {
        constexpr int NF = DUAL ? 2 : 4, ROWB = NF * 16 * OUTB, NCH = ROWB / 16, RPR = (8192 / ROWB) < 128 ? (8192 / ROWB) : 128, RPI = 64 / NCH, NROUND = 128 / RPR;
        constexpr float FP8_SCALE = 128.f;
        unsigned char* stg = lds + w * 8192;
        int l15e = l15; asm volatile("" : "+v"(l15e));
        const int colbase = (DUAL ? 32 : 64) * wn;
#pragma unroll
        for (int rd = 0; rd < NROUND; ++rd) {
            if (active) {
#pragma unroll
                for (int mt = rd * (RPR / 16); mt < (rd + 1) * (RPR / 16); ++mt) {
                    if ((mt >> 1) < ngrp) {
                        const int rloc = mt * 16 - rd * RPR + l15e, row = 128 * wm + mt * 16 + l15e;
#pragma unroll
                        for (int f = 0; f < NF; ++f) {
                            const f32x4 v = DUAL ? pre(row, colbase + 16 * f + 4 * kg, acc[mt][f], acc[mt][f + 2]) : pre(row, colbase + 16 * f + 4 * kg, acc[mt][f], acc[mt][f]);
                            if (OUTB == 4) *(f32x4*)(stg + rloc * ROWB + ((((unsigned)(4 * f + kg)) ^ (unsigned)(rloc & (NCH - 1))) << 4)) = v;
                            else if (OUTB == 2) { bf16x4 o; o[0] = (__bf16)v[0]; o[1] = (__bf16)v[1]; o[2] = (__bf16)v[2]; o[3] = (__bf16)v[3];
                                *(bf16x4*)(stg + rloc * ROWB + ((((unsigned)(2 * f + (kg >> 1))) ^ (unsigned)(rloc & (NCH - 1))) << 4) + 8 * (kg & 1)) = o; }
                            else { int pk = 0; pk = __builtin_amdgcn_cvt_pk_fp8_f32(v[0] * FP8_SCALE, v[1] * FP8_SCALE, pk, false); pk = __builtin_amdgcn_cvt_pk_fp8_f32(v[2] * FP8_SCALE, v[3] * FP8_SCALE, pk, true);
                                *(int*)(stg + rloc * ROWB + ((((unsigned)f) ^ (unsigned)(rloc & (NCH - 1))) << 4) + 4 * kg) = pk; }
                        }
                    }
                }
                asm volatile("s_waitcnt lgkmcnt(0)" ::: "memory");
#pragma unroll
                for (int it = 0; it < RPR / RPI; ++it) {
                    const int rloc = it * RPI + lane / NCH, c = lane % NCH, row = 128 * wm + rd * RPR + rloc;
                    const u32x4 dv = *(const u32x4*)(stg + rloc * ROWB + ((((unsigned)c) ^ (unsigned)(rloc & (NCH - 1))) << 4));
                    if (row < rows) fin(row, colbase + c * (16 / OUTB), dv);
                }
                asm volatile("s_waitcnt lgkmcnt(0)" ::: "memory");
            }
        }
    }
    __syncthreads();
}

template <bool DUAL, bool BK16, int OUTB, int LDB, int WN, class RowFn, class Pre, class Fin>
DI void gemm_mfma(const bf16_t* Ab, const RowFn& rowoff, const float* B0, const float* B1, unsigned bbytes, int K, int rows, const Pre& pre, const Fin& fin, unsigned char* lds) {
    u32x4 ra[2][2], rb[2][4]; unsigned ao[2] = {0u, 0u};
    gemm_core<DUAL, BK16, OUTB, LDB, WN>(ra, rb, ao, false, Ab, rowoff, B0, B1, bbytes, K, rows, false, rowoff, B0, B1, bbytes, rows, pre, fin, lds);
}
#define PRE_ID [](int, int, f32x4 v, f32x4) { return v; }

DI void phase_prep(const Params& p, int bid, int nblk, float* lds) {
    const int tid = threadIdx.x, lane = tid & 63, wave = tid >> 6;
    bf16_t* xb = (bf16_t*)(p.ws + OFF_XB); float* glow = (float*)(p.ws + OFF_GLOW);
    f32x4* Wl = (f32x4*)lds;
    for (int idx = tid; idx < 4096; idx += NT) {
        const int k = idx >> 2, q = idx & 3, ln = (k >> 2) & 63, j = k >> 8, c = k & 3;
        Wl[((j * 4 + c) * 4 + q) * 64 + ln] = *(const f32x4*)(p.w_in + (size_t)k * DIN + GL_OFF + 4 * q);
    }
    __syncthreads();
    for (int row0 = (bid * 8 + wave) * 4; row0 < T; row0 += nblk * 32) {
        asm volatile("" ::: "memory");
        f32x4 xv[4][4];
#pragma unroll
        for (int r = 0; r < 4; ++r)
#pragma unroll
            for (int j = 0; j < 4; ++j) {
                xv[r][j] = ((const f32x4*)(p.x + (size_t)(row0 + r) * D))[lane + 64 * j];
                uint2 o; o.x = pk2(xv[r][j][0], xv[r][j][1]); o.y = pk2(xv[r][j][2], xv[r][j][3]);
                ((uint2*)(xb + (size_t)(row0 + r) * D))[lane + 64 * j] = o;
            }
        float acc[4][16];
#pragma unroll
        for (int r = 0; r < 4; ++r)
#pragma unroll
            for (int n = 0; n < 16; ++n) acc[r][n] = 0.f;
#pragma unroll
        for (int j = 0; j < 4; ++j)
#pragma unroll
            for (int c = 0; c < 4; ++c) {
                float wv[16];
#pragma unroll
                for (int q = 0; q < 4; ++q) { const f32x4 w4 = Wl[((j * 4 + c) * 4 + q) * 64 + lane]; wv[4 * q] = w4[0]; wv[4 * q + 1] = w4[1]; wv[4 * q + 2] = w4[2]; wv[4 * q + 3] = w4[3]; }
#pragma unroll
                for (int r = 0; r < 4; ++r) {
                    const float xs = xv[r][j][c];
#pragma unroll
                    for (int n = 0; n < 16; ++n) acc[r][n] += xs * wv[n];
                }
            }
#define RS_STEP(N, OFF) { const bool up = (lane & (OFF)) != 0; _Pragma("unroll") for (int i = 0; i < (N); ++i) { \
            const float a = acc[i / 16][i % 16], b = acc[(i + (N)) / 16][(i + (N)) % 16]; const float snd = up ? a : b, kp = up ? b : a; \
            acc[i / 16][i % 16] = kp + __shfl_xor(snd, (OFF)); } }
        RS_STEP(32, 32) RS_STEP(16, 16) RS_STEP(8, 8) RS_STEP(4, 4) RS_STEP(2, 2) RS_STEP(1, 1)
#undef RS_STEP
        glow[(size_t)row0 * 16 + lane] = acc[0][0];
    }
    {
        bf16_t* wbin = (bf16_t*)(p.ws + OFF_WB_IN); bf16_t* wbout = (bf16_t*)(p.ws + OFF_WB_OUT); bf16_t* wbrt = (bf16_t*)(p.ws + OFF_WB_RT);
        bf16_t* wbsgu = (bf16_t*)(p.ws + OFF_WB_SGU); bf16_t* wbsd = (bf16_t*)(p.ws + OFF_WB_SD);
        constexpr int N_IN = 1024 * 512, N_OUT = 1024 * 256, N_RT = 1024 * 64, N_SGU = 1024 * 128, N_SD = 256 * 256;
        for (int it = bid * NT + tid; it < N_IN + N_OUT + N_RT + N_SGU + N_SD; it += nblk * NT) {
            const float* s; bf16_t* d; int r = it;
            if (r < N_IN) { const int k = r >> 9, c = (r & 511) * 4; s = p.w_in + (size_t)k * DIN + c; d = wbin + (size_t)k * 2048 + c; }
            else if ((r -= N_IN) < N_OUT) { s = p.w_out + (size_t)r * 4; d = wbout + (size_t)r * 4; }
            else if ((r -= N_OUT) < N_RT) { s = p.router_w + (size_t)r * 4; d = wbrt + (size_t)r * 4; }
            else if ((r -= N_RT) < N_SGU) { const int k = r >> 7, c = (r & 127) * 4, nt = c >> 8, h = (c >> 7) & 1, cc = c & 127; s = (h ? p.su : p.sg) + (size_t)k * EDIM + nt * 128 + cc; d = wbsgu + (size_t)k * 512 + c; }
            else { r -= N_SGU; s = p.sd + (size_t)r * 4; d = wbsd + (size_t)r * 4; }
            const f32x4 v = *(const f32x4*)s; uint2 o; o.x = pk2(v[0], v[1]); o.y = pk2(v[2], v[3]); *(uint2*)d = o;
        }
    }
    __syncthreads();
}

DI void phase_proj(const Params& p, int bid, int nblk, float* lds) {
    const bf16_t* xb = (const bf16_t*)(p.ws + OFF_XB); bf16_t* proj = (bf16_t*)(p.ws + OFF_PROJ); const bf16_t* wbin = (const bf16_t*)(p.ws + OFF_WB_IN);
    u32x4 ra[2][2], rb[2][4]; unsigned ao[2] = {0u, 0u}; bool pre = false;
    const bool xl = (nblk == 256);
    for (int u = bid; u < 64 * 8; u += nblk) {
        const int un = u + nblk; const bool hn = un < 64 * 8;
        const int mt = xl ? 32 * (u >> 8) + 4 * (u & 7) + ((u & 255) >> 6) : u >> 3, nt = xl ? ((u & 255) >> 3) & 7 : u & 7;
        const int mtn = xl ? 32 * (un >> 8) + 4 * (un & 7) + ((un & 255) >> 6) : un >> 3, ntn = xl ? ((un & 255) >> 3) & 7 : un & 7;
        auto rowoff = [&](int r) { return (unsigned)((mt * 256 + r) * D); };
        auto rowoff_n = [&](int r) { return (unsigned)((mtn * 256 + r) * D); };
        auto fin = [&](int r, int c, u32x4 dv) { *(u32x4*)(proj + (size_t)(mt * 256 + r) * NPROJ + nt * 256 + c) = dv; };
        gemm_core<false, true, 2, NPROJ, 4>(ra, rb, ao, pre, xb, rowoff, (const float*)(wbin + nt * 256), nullptr, (unsigned)(((size_t)D * NPROJ - nt * 256) * 2), D, 256,
                                 hn, rowoff_n, (const float*)(wbin + ntn * 256), nullptr, (unsigned)(((size_t)D * NPROJ - ntn * 256) * 2), 256, PRE_ID, fin, (unsigned char*)lds);
        pre = hn;
    }
}

template <int W>
DI void poolmean_item(const bf16_t* proj, bf16_t* pm, int t0, int c2) {
    const int s0 = t0 & (SEQ - 1);
    float p0[48], p1[48]; unsigned raw[32];
    p0[0] = 0.f; p1[0] = 0.f;
#pragma unroll
    for (int i = 0; i < 47; ++i) {
        unsigned v = 0u;
        if (i >= 15 || s0 > 0) v = *(const unsigned*)(proj + (size_t)(t0 - 15 + i) * NPROJ + P_OFF + c2);
        if (i >= 15) raw[i - 15] = v;
        p0[i + 1] = p0[i] + __uint_as_float(v << 16); p1[i + 1] = p1[i] + __uint_as_float(v & 0xffff0000u);
    }
#pragma unroll
    for (int i = 0; i < 32; ++i) {
        const int s = s0 + i; const float inv = 1.f / (float)min(s + 1, W);
        const float m0 = (p0[i + 16] - p0[i + 16 - W]) * inv - __uint_as_float(raw[i] << 16);
        const float m1 = (p1[i + 16] - p1[i + 16 - W]) * inv - __uint_as_float(raw[i] & 0xffff0000u);
        *(unsigned*)(pm + (size_t)(t0 + i) * 512 + c2) = pk2(m0, m1);
    }
}
DI void phase_poolmean(const Params& p, int bid, int nblk, float* lds) {
    const bf16_t* proj = (const bf16_t*)(p.ws + OFF_PROJ); bf16_t* pm = (bf16_t*)(p.ws + OFF_PM);
    for (int item = bid * NT + threadIdx.x; item < 256 * (T / 32); item += nblk * NT) {
        const int pair = item & 255, t0 = (item >> 8) * 32, c2 = pair * 2, g = __builtin_amdgcn_readfirstlane(pair >> 6);
        if (g == 0) poolmean_item<2>(proj, pm, t0, c2);
        else if (g == 1) poolmean_item<4>(proj, pm, t0, c2);
        else if (g == 2) poolmean_item<8>(proj, pm, t0, c2);
        else poolmean_item<16>(proj, pm, t0, c2);
    }
}
DI void phase_pool(const Params& p, int bid, int nblk, float* lds) {
    const bf16_t* pm = (const bf16_t*)(p.ws + OFF_PM); bf16_t* mix = (bf16_t*)(p.ws + OFF_MIX);
    for (int u = bid; u < 64 * 4; u += nblk) {
        const int mt = u >> 2, g = u & 3;
        auto rowoff = [&](int r) { return (unsigned)((mt * 256 + r) * 512 + g * 128); };
        auto pre = [&](int r, int c, f32x4 v, f32x4) { const f32x4 sc = *(const f32x4*)(p.pool_scale + g * 128 + c); return v * sc; };
        auto fin = [&](int r, int c, u32x4 dv) { *(u32x4*)(mix + (size_t)(mt * 256 + r) * D + g * 128 + c) = dv; };
        gemm_mfma<false, false, 2, 128, 2>(pm, rowoff, p.pool_w + (size_t)g * 16384, nullptr, (unsigned)((4 - g) * 16384 * 4), 128, 256, pre, fin, (unsigned char*)lds);
    }
}

DI unsigned f1_off(unsigned row, unsigned chunk) { return row * 128u + ((chunk ^ ((row >> 1) & 7u)) << 4); }
DI unsigned f2_off(unsigned row, unsigned ch) { return 256u * row + 16u * (ch ^ (((row & 3u) << 2) | ((row >> 2) & 3u))); }
DI bf16x8 f1_frag(const unsigned char* img, int tile, int ks, int lane) { return *(const bf16x8*)(img + f1_off(16 * tile + (lane & 15), 4 * ks + (lane >> 4))); }
DI bf16x8 f2_frag(const unsigned char* img, int c, int ks, int lane) {
    const unsigned g = lane >> 4, q = (lane & 15) >> 2, pp = lane & 3;
    const unsigned a0 = f2_off(32 * ks + 8 * g + q, 2 * c + (pp >> 1)) + 8 * (pp & 1), a1 = f2_off(32 * ks + 8 * g + 4 + q, 2 * c + (pp >> 1)) + 8 * (pp & 1);
    const s16x4 lo = __builtin_amdgcn_ds_read_tr16_b64_v4i16((LAS3 s16x4*)(img + a0)), hi = __builtin_amdgcn_ds_read_tr16_b64_v4i16((LAS3 s16x4*)(img + a1));
    return __builtin_bit_cast(bf16x8, __builtin_shufflevector(lo, hi, 0, 1, 2, 3, 4, 5, 6, 7));
}
DI float bfbits2f(unsigned short v) { return __uint_as_float(((unsigned)v) << 16); }
typedef unsigned short u16x8 __attribute__((ext_vector_type(8)));
typedef unsigned short u16x4 __attribute__((ext_vector_type(4)));

DI void phase_gla1(const Params& p, int bid, int nblk, float* ldsf) {
    unsigned char* lds = (unsigned char*)ldsf;
    int tid_ = threadIdx.x; asm volatile("" : "+v"(tid_));
    const int tid = tid_, lane = tid & 63, w = __builtin_amdgcn_readfirstlane(tid >> 6), t = tid >> 3, ch = tid & 7;
    const bf16_t* proj = (const bf16_t*)(p.ws + OFF_PROJ); const float* glow = (const float*)(p.ws + OFF_GLOW);
    float* Gbuf = (float*)(p.ws + OFF_G); float* Sloc = (float*)(p.ws + OFF_SLOC); float* dec = (float*)(p.ws + OFF_DEC);
    float* G = (float*)lds; unsigned char* Kimg = lds + 16384; unsigned char* Vimg = lds + 32768; float* W2l = (float*)(lds + 49152); float* segtot = (float*)(lds + 53248);
    for (int unit = bid; unit < 1024; unit += nblk) {
        const int bh = unit >> 6, n = unit & 63, b = bh >> 2, h = bh & 3, t0 = b * SEQ + n * SC;
        for (int i = tid; i < 1024; i += NT) W2l[i] = p.gate_w2[(i >> 6) * 256 + h * 64 + (i & 63)];
#pragma unroll
        for (int i = 0; i < 2; ++i) { const int idx = tid + NT * i, tr = idx >> 4, c16 = idx & 15;
            *(u32x4*)(Vimg + f2_off(tr, c16)) = *(const u32x4*)(proj + (size_t)(t0 + tr) * NPROJ + V_OFF + h * 128 + 8 * c16); }
        __syncthreads();
        {
            float gl[16];
#pragma unroll
            for (int q = 0; q < 4; ++q) { const f32x4 v = *(const f32x4*)(glow + (size_t)(t0 + t) * 16 + 4 * q); gl[4 * q] = v[0]; gl[4 * q + 1] = v[1]; gl[4 * q + 2] = v[2]; gl[4 * q + 3] = v[3]; }
#pragma unroll
            for (int dd = 0; dd < 8; ++dd) { const int d = 8 * ch + dd; float z = p.gate_b[h * 64 + d];
#pragma unroll
                for (int r = 0; r < 16; ++r) z += gl[r] * W2l[r * 64 + d];
                G[t * 64 + d] = logsigmoidf_(z) * (1.f / 16.f); }
        }
        __syncthreads();
        {
            const int seg = tid >> 6, d = tid & 63; float run = 0.f;
#pragma unroll
            for (int tt = 0; tt < 8; ++tt) { run += G[(8 * seg + tt) * 64 + d]; G[(8 * seg + tt) * 64 + d] = run; }
            segtot[seg * 64 + d] = run;
            __syncthreads();
            float pre = 0.f;
            for (int s2 = 0; s2 < seg; ++s2) pre += segtot[s2 * 64 + d];
#pragma unroll
            for (int tt = 0; tt < 8; ++tt) G[(8 * seg + tt) * 64 + d] += pre;
        }
        __syncthreads();
        {
            const f32x4 g0 = *(const f32x4*)(G + t * 64 + 8 * ch), g1 = *(const f32x4*)(G + t * 64 + 8 * ch + 4);
            const f32x4 l0 = *(const f32x4*)(G + 63 * 64 + 8 * ch), l1 = *(const f32x4*)(G + 63 * 64 + 8 * ch + 4);
            *(f32x4*)(Gbuf + (size_t)(t0 + t) * 256 + h * 64 + 8 * ch) = g0; *(f32x4*)(Gbuf + (size_t)(t0 + t) * 256 + h * 64 + 8 * ch + 4) = g1;
            const u16x8 kv = *(const u16x8*)(proj + (size_t)(t0 + t) * NPROJ + K_OFF + h * 64 + 8 * ch);
            bf16x8 o;
#pragma unroll
            for (int dd = 0; dd < 4; ++dd) { o[dd] = (__bf16)(bfbits2f(kv[dd]) * __expf(l0[dd] - g0[dd])); o[dd + 4] = (__bf16)(bfbits2f(kv[dd + 4]) * __expf(l1[dd] - g1[dd])); }
            *(bf16x8*)(Kimg + f2_off(t, ch)) = o;
            if (t == 63) {
#pragma unroll
                for (int dd = 0; dd < 4; ++dd) { dec[unit * 64 + 8 * ch + dd] = __expf(l0[dd]); dec[unit * 64 + 8 * ch + 4 + dd] = __expf(l1[dd]); }
            }
        }
        __syncthreads();
        {
            f32x4 acc[4];
#pragma unroll
            for (int dt = 0; dt < 4; ++dt) acc[dt] = (f32x4){0.f, 0.f, 0.f, 0.f};
#pragma unroll
            for (int ks = 0; ks < 2; ++ks) {
                const bf16x8 xv = f2_frag(Vimg, w, ks, lane);
#pragma unroll
                for (int dt = 0; dt < 4; ++dt) acc[dt] = MFMA16(xv, f2_frag(Kimg, dt, ks, lane), acc[dt]);
            }
#pragma unroll
            for (int dt = 0; dt < 4; ++dt) *(f32x4*)(Sloc + (size_t)unit * 8192 + (16 * dt + (lane & 15)) * 128 + 16 * w + 4 * (lane >> 4)) = acc[dt];
        }
        __syncthreads();
    }
}

DI void phase_gla2(const Params& p, int bid, int nblk, float* lds) {
    const float* Sloc = (const float*)(p.ws + OFF_SLOC); const float* dec = (const float*)(p.ws + OFF_DEC); bf16_t* Sin = (bf16_t*)(p.ws + OFF_SIN);
    for (int gid = bid * NT + threadIdx.x; gid < 16 * 8192; gid += nblk * NT) {
        const int bh = gid >> 13, el = gid & 8191, d = el >> 7; float st = 0.f;
        for (int n0 = 0; n0 < NSC; n0 += 16) {
            float sl[16], dc[16]; bf16_t so[16];
#pragma unroll
            for (int i = 0; i < 16; ++i) { const int u = bh * 64 + n0 + i; sl[i] = Sloc[(size_t)u * 8192 + el]; dc[i] = dec[u * 64 + d]; }
#pragma unroll
            for (int i = 0; i < 16; ++i) { so[i] = f2bf(st); st = st * dc[i] + sl[i]; }
#pragma unroll
            for (int i = 0; i < 16; ++i) Sin[(size_t)(bh * 64 + n0 + i) * 8192 + el] = so[i];
        }
    }
}

DI void phase_gla3(const Params& p, int bid, int nblk, float* ldsf) {
    unsigned char* lds = (unsigned char*)ldsf;
    int tid_ = threadIdx.x; asm volatile("" : "+v"(tid_));
    const int tid = tid_, lane = tid & 63, w = __builtin_amdgcn_readfirstlane(tid >> 6), t = tid >> 3, ch = tid & 7, l15 = lane & 15, kg = lane >> 4;
    const bf16_t* proj = (const bf16_t*)(p.ws + OFF_PROJ); const float* Gbuf = (const float*)(p.ws + OFF_G); const bf16_t* Sin = (const bf16_t*)(p.ws + OFF_SIN);
    bf16_t* mix = (bf16_t*)(p.ws + OFF_MIX);
    unsigned char* Qimg = lds; unsigned char* Kimg = lds + 8192; unsigned char* Pimg = lds + 16384; unsigned char* Vimg = lds + 24576; unsigned char* Simg = lds + 40960;
    float* part = (float*)(lds + 57344);
    for (int unit = bid; unit < 1024; unit += nblk) {
        const int bh = unit >> 6, n = unit & 63, b = bh >> 2, h = bh & 3, t0 = b * SEQ + n * SC;
        {
            const f32x4 g0 = *(const f32x4*)(Gbuf + (size_t)(t0 + t) * 256 + h * 64 + 8 * ch), g1 = *(const f32x4*)(Gbuf + (size_t)(t0 + t) * 256 + h * 64 + 8 * ch + 4);
            const u16x8 qv = *(const u16x8*)(proj + (size_t)(t0 + t) * NPROJ + Q_OFF + h * 64 + 8 * ch), kv = *(const u16x8*)(proj + (size_t)(t0 + t) * NPROJ + K_OFF + h * 64 + 8 * ch);
            bf16x8 qo, ko;
#pragma unroll
            for (int dd = 0; dd < 4; ++dd) {
                qo[dd] = (__bf16)(bfbits2f(qv[dd]) * 0.125f * __expf(g0[dd])); qo[dd + 4] = (__bf16)(bfbits2f(qv[dd + 4]) * 0.125f * __expf(g1[dd]));
                ko[dd] = (__bf16)(bfbits2f(kv[dd]) * __expf(-g0[dd])); ko[dd + 4] = (__bf16)(bfbits2f(kv[dd + 4]) * __expf(-g1[dd]));
            }
            *(bf16x8*)(Qimg + f1_off(t, ch)) = qo; *(bf16x8*)(Kimg + f1_off(t, ch)) = ko;
        }
#pragma unroll
        for (int i = 0; i < 2; ++i) { const int idx = tid + NT * i, tr = idx >> 4, c16 = idx & 15;
            *(u32x4*)(Vimg + f2_off(tr, c16)) = *(const u32x4*)(proj + (size_t)(t0 + tr) * NPROJ + V_OFF + h * 128 + 8 * c16);
            *(u32x4*)(Simg + f2_off(tr, c16)) = *(const u32x4*)(Sin + (size_t)unit * 8192 + tr * 128 + 8 * c16); }
        __syncthreads();
        {
            const int it = w >> 1;
#pragma unroll
            for (int jj = 0; jj < 2; ++jj) {
                const int jt = 2 * (w & 1) + jj; f32x4 acc = {0.f, 0.f, 0.f, 0.f};
                if (jt <= it) {
#pragma unroll
                    for (int ks = 0; ks < 2; ++ks) acc = MFMA16(f1_frag(Kimg, jt, ks, lane), f1_frag(Qimg, it, ks, lane), acc);
                    if (jt == it) {
#pragma unroll
                        for (int r = 0; r < 4; ++r) if (4 * kg + r > l15) acc[r] = 0.f;
                    }
                }
                bf16x4 o; o[0] = (__bf16)acc[0]; o[1] = (__bf16)acc[1]; o[2] = (__bf16)acc[2]; o[3] = (__bf16)acc[3];
                *(bf16x4*)(Pimg + f1_off(16 * it + l15, 2 * jt + (kg >> 1)) + 8 * (kg & 1)) = o;
            }
        }
        __syncthreads();
        {
            f32x4 acc[4];
#pragma unroll
            for (int it = 0; it < 4; ++it) acc[it] = (f32x4){0.f, 0.f, 0.f, 0.f};
#pragma unroll
            for (int ks = 0; ks < 2; ++ks) {
                const bf16x8 xv = f2_frag(Vimg, w, ks, lane), xs = f2_frag(Simg, w, ks, lane);
#pragma unroll
                for (int it = 0; it < 4; ++it) {
                    if (2 * ks <= it) acc[it] = MFMA16(xv, f1_frag(Pimg, it, ks, lane), acc[it]);
                    acc[it] = MFMA16(xs, f1_frag(Qimg, it, ks, lane), acc[it]);
                }
            }
#pragma unroll
            for (int it = 0; it < 4; ++it) {
                float ss = acc[it][0] * acc[it][0] + acc[it][1] * acc[it][1] + acc[it][2] * acc[it][2] + acc[it][3] * acc[it][3];
                ss += __shfl_xor(ss, 16); ss += __shfl_xor(ss, 32);
                if (kg == 0) part[w * 64 + 16 * it + l15] = ss;
            }
            __syncthreads();
            const int e0 = 16 * w + 4 * kg; const f32x4 nw = *(const f32x4*)(p.norm_w + e0);
#pragma unroll
            for (int it = 0; it < 4; ++it) {
                const int i = 16 * it + l15; float tot = 0.f;
#pragma unroll
                for (int w2 = 0; w2 < 8; ++w2) tot += part[w2 * 64 + i];
                const float inv = rsqrtf(tot * (1.f / 128.f) + RMS_EPS);
                const u16x4 rv = *(const u16x4*)(proj + (size_t)(t0 + i) * NPROJ + R_OFF + h * 128 + e0);
                bf16x4 o;
#pragma unroll
                for (int r = 0; r < 4; ++r) { const float rr = bfbits2f(rv[r]); o[r] = (__bf16)(acc[it][r] * inv * nw[r] * (rr * sigmoidf_(rr))); }
                *(bf16x4*)(mix + (size_t)(t0 + i) * D + 512 + h * 128 + e0) = o;
            }
        }
        __syncthreads();
    }
}

DI void phase_out(const Params& p, int bid, int nblk, float* lds) {
    const bf16_t* mix = (const bf16_t*)(p.ws + OFF_MIX); float* h32 = (float*)(p.ws + OFF_H32);
    for (int u = bid; u < 64 * 4; u += nblk) {
        const int mt = (nblk == 256) ? 8 * (u & 7) + (u >> 5) : u >> 2, nt = (nblk == 256) ? (u >> 3) & 3 : u & 3;
        auto rowoff = [&](int r) { return (unsigned)((mt * 256 + r) * D); };
        auto fin = [&](int r, int c, u32x4 dv) { const size_t o = (size_t)(mt * 256 + r) * D + nt * 256 + c; const f32x4 xv = *(const f32x4*)(p.x + o); *(f32x4*)(h32 + o) = xv * ALPHA + __builtin_bit_cast(f32x4, dv); };
        gemm_mfma<false, true, 4, D, 4>(mix, rowoff, (const float*)((const bf16_t*)(p.ws + OFF_WB_OUT) + nt * 256), nullptr, (unsigned)(((size_t)D * D - nt * 256) * 2), D, 256, PRE_ID, fin, (unsigned char*)lds);
    }
}

DI void ln_row(float (&v)[16], const float* g, const float* b, int lane) {
    float s = 0.f;
#pragma unroll
    for (int i = 0; i < 16; ++i) s += v[i];
    const float mean = wave_sum(s) * (1.f / D); float q = 0.f;
#pragma unroll
    for (int i = 0; i < 16; ++i) { v[i] -= mean; q += v[i] * v[i]; }
    const float rstd = rsqrtf(wave_sum(q) * (1.f / D) + LN_EPS);
#pragma unroll
    for (int j = 0; j < 4; ++j) {
        const float4 gg = ((const float4*)g)[lane + 64 * j], bb = ((const float4*)b)[lane + 64 * j];
        v[4 * j] = v[4 * j] * rstd * gg.x + bb.x; v[4 * j + 1] = v[4 * j + 1] * rstd * gg.y + bb.y;
        v[4 * j + 2] = v[4 * j + 2] * rstd * gg.z + bb.z; v[4 * j + 3] = v[4 * j + 3] * rstd * gg.w + bb.w;
    }
}

DI void ln1_rows(const Params& p, int r0, int nrows) {
    int tid_ = threadIdx.x; asm volatile("" : "+v"(tid_));
    const int lane = tid_ & 63, wave = tid_ >> 6;
    float* h32 = (float*)(p.ws + OFF_H32); bf16_t* hb = (bf16_t*)(p.ws + OFF_HB);
    for (int row = r0 + wave; row < r0 + nrows; row += 8) {
        float4* hr = (float4*)(h32 + (size_t)row * D); float v[16];
#pragma unroll
        for (int j = 0; j < 4; ++j) { const float4 a = hr[lane + 64 * j]; v[4 * j] = a.x; v[4 * j + 1] = a.y; v[4 * j + 2] = a.z; v[4 * j + 3] = a.w; }
        ln_row(v, p.ln1_g, p.ln1_b, lane);
#pragma unroll
        for (int j = 0; j < 4; ++j) {
            uint2 o; o.x = pk2(v[4 * j], v[4 * j + 1]); o.y = pk2(v[4 * j + 2], v[4 * j + 3]);
            ((uint2*)(hb + (size_t)row * D))[lane + 64 * j] = o;
        }
    }
}

DI void topk_rows(const Params& p, int r0, int nrows) {
    int tid_ = threadIdx.x; asm volatile("" : "+v"(tid_));
    const int lane = tid_ & 63, wave = tid_ >> 6;
    const float* scores = (const float*)(p.ws + OFF_SCORES); float* wbuf = (float*)(p.ws + OFF_WBUF);
    int* list = (int*)(p.ws + OFF_LIST); unsigned* cnt = (unsigned*)(p.ws + OFF_CTL) + CW_CNT;
    const float NEG = -__builtin_inff();
    for (int t = r0 + wave; t < r0 + nrows; t += 8) {
        const float4 sv = ((const float4*)(scores + (size_t)t * NE))[lane], bv = ((const float4*)p.router_bias)[lane];
        const float s[4] = {sv.x, sv.y, sv.z, sv.w};
        float cand[4] = {sv.x + bv.x, sv.y + bv.y, sv.z + bv.z, sv.w + bv.w};
        float m1 = NEG, m2 = NEG;
#pragma unroll
        for (int j = 0; j < 4; ++j) { const float v = cand[j]; if (v > m1) { m2 = m1; m1 = v; } else if (v > m2) m2 = v; }
#pragma unroll
        for (int off = 1; off < 8; off <<= 1) {
            const float o1 = __shfl_xor(m1, off), o2 = __shfl_xor(m2, off);
            const float n1 = fmaxf(m1, o1), n2 = fmaxf(fminf(m1, o1), fmaxf(m2, o2)); m1 = n1; m2 = n2;
        }
        const float gs = m1 + m2; const int mygrp = lane >> 3; int rank = 0;
#pragma unroll
        for (int g2 = 0; g2 < 8; ++g2) { const float og = __shfl(gs, g2 * 8); if (og > gs || (og == gs && g2 < mygrp)) ++rank; }
        if (rank >= 4) { cand[0] = NEG; cand[1] = NEG; cand[2] = NEG; cand[3] = NEG; }
        int my_e = 0; float my_w = 0.f, wsum = 0.f;
#pragma unroll
        for (int k = 0; k < TOPK; ++k) {
            float bvv = cand[0]; int bj = 0;
#pragma unroll
            for (int j = 1; j < 4; ++j) if (cand[j] > bvv) { bvv = cand[j]; bj = j; }
            int bi = 4 * lane + bj;
#pragma unroll
            for (int off = 32; off >= 1; off >>= 1) {
                const float ov = __shfl_xor(bvv, off); const int oi = __shfl_xor(bi, off);
                if (ov > bvv || (ov == bvv && oi < bi)) { bvv = ov; bi = oi; }
            }
            const int wj = bi & 3, wl = bi >> 2;
            const float mys = wj == 0 ? s[0] : (wj == 1 ? s[1] : (wj == 2 ? s[2] : s[3]));
            const float wk = __shfl(mys, wl);
            wsum += wk;
            if (lane == k) { my_e = bi; my_w = wk; }
            if (lane == wl) {
#pragma unroll
                for (int j = 0; j < 4; ++j) if (j == wj) cand[j] = NEG;
            }
        }
        if (lane < TOPK) {
            const unsigned pos = atomicAdd(&cnt[my_e], 1u);
            list[(size_t)my_e * LCAP + pos] = t * TOPK + lane;
            wbuf[(size_t)t * TOPK + lane] = my_w / wsum * 2.5f;
        }
    }
}

DI void phase_route(const Params& p, int bid, int nblk, float* lds) {
    const bf16_t* hb = (const bf16_t*)(p.ws + OFF_HB); float* scores = (float*)(p.ws + OFF_SCORES);
    for (int mt = bid; mt < T / 64; mt += nblk) {
        ln1_rows(p, mt * 64, 64);
        __syncthreads();
        auto rowoff = [&](int r) { return (unsigned)((mt * 64 + r) * D); };
        auto pre = [&](int r, int c, f32x4 v, f32x4) { return (f32x4){sigmoidf_(v[0]), sigmoidf_(v[1]), sigmoidf_(v[2]), sigmoidf_(v[3])}; };
        auto fin = [&](int r, int c, u32x4 dv) { *(u32x4*)(scores + (size_t)(mt * 64 + r) * NE + c) = dv; };
        gemm_mfma<false, true, 4, NE, 4>(hb, rowoff, (const float*)(p.ws + OFF_WB_RT), nullptr, (unsigned)(D * NE * 2), D, 64, pre, fin, (unsigned char*)lds);
        __syncthreads();
        topk_rows(p, mt * 64, 64);
        __syncthreads();
    }
}

constexpr int EXP_TAB_OFF = GEMM_LDS_BYTES;
DI void build_tables(const Params& p, int* toff, int* roff) {
    const unsigned* cnt = (const unsigned*)(p.ws + OFF_CTL) + CW_CNT;
    int* cl = roff + 260;
    if (threadIdx.x < NE) cl[threadIdx.x] = (int)__hip_atomic_load(cnt + threadIdx.x, __ATOMIC_RELAXED, __HIP_MEMORY_SCOPE_AGENT);
    __syncthreads();
    if (threadIdx.x <= NE) {
        int ta = 0, ra = 0;
        for (int e = 0; e < (int)threadIdx.x; ++e) { const int c = cl[e]; ta += (c + 255) >> 8; ra += c; }
        toff[threadIdx.x] = ta; roff[threadIdx.x] = ra;
    }
    __syncthreads();
}
DI int find_expert(const int* toff, int tile) { int lo = 0, hi = NE - 1; while (lo < hi) { const int mid = (lo + hi + 1) >> 1; if (toff[mid] <= tile) lo = mid; else hi = mid - 1; } return lo; }
struct ExpUnit { int e, row0, rows, rowbase; };
DI ExpUnit exp_unit(const Params& p, const int* toff, const int* roff, int tile, int ntile) {
    const unsigned* cnt = (const unsigned*)(p.ws + OFF_CTL) + CW_CNT;
    ExpUnit u;
    if (tile < ntile) {
        u.e = find_expert(toff, tile); const int ui = tile - toff[u.e], c = (int)cnt[u.e];
        u.row0 = ui * 256; u.rows = min(256, c - u.row0); u.rowbase = roff[u.e] + u.row0;
    } else { u.e = NE; u.row0 = (tile - ntile) * 256; u.rows = 256; u.rowbase = A_TOT + u.row0; }
    u.e = __builtin_amdgcn_readfirstlane(u.e); u.row0 = __builtin_amdgcn_readfirstlane(u.row0); u.rows = __builtin_amdgcn_readfirstlane(u.rows);
    u.rowbase = __builtin_amdgcn_readfirstlane(u.rowbase);
    return u;
}

template <int NTL>
DI void exp_decode(const int* toff, int ntile, int u, int& tile, int& nt) {
    if (u < NTL * ntile) { const int e = find_expert(toff, u / NTL), ne = toff[e + 1] - toff[e], u2 = u - NTL * toff[e]; nt = u2 / ne; tile = toff[e] + (u2 - nt * ne); }
    else { const int us = u - NTL * ntile; nt = us / (T / 256); tile = ntile + (us - nt * (T / 256)); }
}

DI void phase_e1(const Params& p, int bid, int nblk, float* lds) {
    int* toff = (int*)((unsigned char*)lds + EXP_TAB_OFF); int* roff = toff + 260;
    const bf16_t* hb = (const bf16_t*)(p.ws + OFF_HB); bf16_t* hid = (bf16_t*)(p.ws + OFF_HID); const int* list = (const int*)(p.ws + OFF_LIST);
    build_tables(p, toff, roff);
    const int ntile = toff[NE], units = (ntile + T / 256) * 2;
    const int vb = (nblk & 7) ? bid : (bid & 7) * (nblk >> 3) + (bid >> 3);
    u32x4 ra[2][2], rb[2][4]; unsigned ao[2] = {0u, 0u}; bool pre = false;
    int tile_n = 0, nt_n = 0; ExpUnit xn;
    if (vb < units) { exp_decode<2>(toff, ntile, vb, tile_n, nt_n); xn = exp_unit(p, toff, roff, tile_n, ntile); }
    for (int u = vb; u < units; u += nblk) {
        const int nt = nt_n; const ExpUnit x = xn; const bool hn = u + nblk < units;
        if (hn) { exp_decode<2>(toff, ntile, u + nblk, tile_n, nt_n); xn = exp_unit(p, toff, roff, tile_n, ntile); }
        const float* wg = x.e < NE ? p.wg + (size_t)x.e * 262144 : p.sg; const float* wu = x.e < NE ? p.wu + (size_t)x.e * 262144 : p.su;
        const float* wgn = xn.e < NE ? p.wg + (size_t)xn.e * 262144 : p.sg; const float* wun = xn.e < NE ? p.wu + (size_t)xn.e * 262144 : p.su;
        auto rowoff = [&](int r) { const int tok = x.e < NE ? (list[(size_t)x.e * LCAP + x.row0 + r] >> 3) : (x.row0 + r); return (unsigned)(tok * D); };
        auto rowoff_n = [&](int r) { const int tok = xn.e < NE ? (list[(size_t)xn.e * LCAP + xn.row0 + r] >> 3) : (xn.row0 + r); return (unsigned)(tok * D); };
        auto prf = [&](int r, int c, f32x4 g, f32x4 uu) { return (f32x4){g[0] * sigmoidf_(g[0]) * uu[0], g[1] * sigmoidf_(g[1]) * uu[1], g[2] * sigmoidf_(g[2]) * uu[2], g[3] * sigmoidf_(g[3]) * uu[3]}; };
        auto fin = [&](int r, int c, u32x4 dv) { *(u32x4*)(hid + (size_t)(x.rowbase + r) * EDIM + nt * 128 + c) = dv; };
        gemm_core<true, false, 2, EDIM, 4>(ra, rb, ao, pre, hb, rowoff, wg + nt * 128, wu + nt * 128, (unsigned)((D * EDIM - nt * 128) * 4), D, x.rows,
                                 hn, rowoff_n, wgn + nt_n * 128, wun + nt_n * 128, (unsigned)((D * EDIM - nt_n * 128) * 4), xn.rows, prf, fin, (unsigned char*)lds);
        pre = hn;
    }
}

DI void phase_e2(const Params& p, int bid, int nblk, float* lds) {
    int* toff = (int*)((unsigned char*)lds + EXP_TAB_OFF); int* roff = toff + 260; int* rowa = roff + 520;
    const bf16_t* hid = (const bf16_t*)(p.ws + OFF_HID); unsigned char* Y = p.ws + OFF_Y; const int* list = (const int*)(p.ws + OFF_LIST);
    build_tables(p, toff, roff);
    const int ntile = toff[NE], units = (ntile + T / 256) * 4;
    const int vb = (nblk & 7) ? bid : (bid & 7) * (nblk >> 3) + (bid >> 3);
    u32x4 ra[2][2], rb[2][4]; unsigned ao[2] = {0u, 0u}; bool pre = false;
    int tile_n = 0, nt_n = 0; ExpUnit xn;
    if (vb < units) { exp_decode<4>(toff, ntile, vb, tile_n, nt_n); xn = exp_unit(p, toff, roff, tile_n, ntile); }
    for (int u = vb; u < units; u += nblk) {
        const int nt = nt_n; const ExpUnit x = xn; const bool hn = u + nblk < units;
        if (hn) { exp_decode<4>(toff, ntile, u + nblk, tile_n, nt_n); xn = exp_unit(p, toff, roff, tile_n, ntile); }
        const float* wd = x.e < NE ? p.wd + (size_t)x.e * 262144 : p.sd; const float* wdn = xn.e < NE ? p.wd + (size_t)xn.e * 262144 : p.sd;
        if (threadIdx.x < 256) { const int r = threadIdx.x; rowa[r] = x.e < NE ? (r < x.rows ? list[(size_t)x.e * LCAP + x.row0 + r] : 0) : (A_TOT + x.row0 + r); }
        __syncthreads();
        auto rowoff = [&](int r) { return (unsigned)((x.rowbase + r) * EDIM); };
        auto rowoff_n = [&](int r) { return (unsigned)((xn.rowbase + r) * EDIM); };
        auto fin = [&](int r, int c, u32x4 dv) { *(u32x4*)(Y + (size_t)rowa[r] * D + nt * 256 + c) = dv; };
        gemm_core<false, false, 1, D, 4>(ra, rb, ao, pre, hid, rowoff, wd + nt * 256, nullptr, (unsigned)((EDIM * D - nt * 256) * 4), EDIM, x.rows,
                               hn, rowoff_n, wdn + nt_n * 256, nullptr, (unsigned)((EDIM * D - nt_n * 256) * 4), xn.rows, PRE_ID, fin, (unsigned char*)lds);
        pre = hn;
        __syncthreads();
    }
}

DI void phase_combine(const Params& p, int bid, int nblk, float* lds) {
    const int lane = threadIdx.x & 63, wave = threadIdx.x >> 6;
    const bf16_t* hb = (const bf16_t*)(p.ws + OFF_HB); const unsigned char* Y = p.ws + OFF_Y; const float* wbuf = (const float*)(p.ws + OFF_WBUF);
    typedef float f32x2 __attribute__((ext_vector_type(2)));
    for (int t = bid * 8 + wave; t < T; t += nblk * 8) {
        float v[16];
#pragma unroll
        for (int j = 0; j < 4; ++j) { const uint2 a = ((const uint2*)(hb + (size_t)t * D))[lane + 64 * j];
            v[4 * j] = ALPHA * __uint_as_float(a.x << 16); v[4 * j + 1] = ALPHA * __uint_as_float(a.x & 0xffff0000u);
            v[4 * j + 2] = ALPHA * __uint_as_float(a.y << 16); v[4 * j + 3] = ALPHA * __uint_as_float(a.y & 0xffff0000u); }
#pragma unroll
        for (int k = 0; k < 9; ++k) {
            const size_t row = k < 8 ? (size_t)t * TOPK + k : (size_t)A_TOT + t; const float w = (k < 8 ? wbuf[(size_t)t * TOPK + k] : 1.f) * (1.f / 128.f);
#pragma unroll
            for (int j = 0; j < 4; ++j) {
                const int y = ((const int*)(Y + row * D))[lane + 64 * j];
                const f32x2 lo = __builtin_amdgcn_cvt_pk_f32_fp8(y, false), hi = __builtin_amdgcn_cvt_pk_f32_fp8(y, true);
                v[4 * j] += w * lo[0]; v[4 * j + 1] += w * lo[1]; v[4 * j + 2] += w * hi[0]; v[4 * j + 3] += w * hi[1];
            }
        }
        ln_row(v, p.ln2_g, p.ln2_b, lane);
#pragma unroll
        for (int j = 0; j < 4; ++j) ((float4*)(p.out + (size_t)t * D))[lane + 64 * j] = make_float4(v[4 * j], v[4 * j + 1], v[4 * j + 2], v[4 * j + 3]);
    }
}

#define LAS __attribute__((address_space(3)))
#define XB_TMO      128
#define XB_XCNT(j)  (256  + 64 * (j))
#define XB_XSUB(j)  (1280 + 64 * (j))
#define XB_XGEN(j)  (2304 + 64 * (j))
#define XB_TOP      3328
#define XB_TOPGEN   3392
#define XCD_BAR_WORDS 3456
#define XB_SPIN_CAP (1u << 22)
constexpr int CW_BAR = 4096;
DI unsigned xb_ld(unsigned* p) { return __hip_atomic_load(p, __ATOMIC_RELAXED, __HIP_MEMORY_SCOPE_AGENT); }
DI unsigned xb_add(unsigned* p, unsigned v) { return __hip_atomic_fetch_add(p, v, __ATOMIC_RELAXED, __HIP_MEMORY_SCOPE_AGENT); }
DI unsigned xb_xcc_id() { return (unsigned)__builtin_amdgcn_s_getreg((3 << 11) | 20) & 0xFu; }
#define XB_SPIN(cond, bar) do { unsigned _sp = 0; while (cond) { __builtin_amdgcn_s_sleep(1); \
    if ((++_sp & 255u) == 0u) { if (xb_ld(&(bar)[XB_TMO])) break; if (_sp > XB_SPIN_CAP) { atomicAdd(&(bar)[XB_TMO], 1u); break; } } } } while (0)
struct XcdBarrier { unsigned* bar; unsigned x; volatile LAS unsigned* st; };
DI XcdBarrier xcd_barrier_post(unsigned* bar, volatile LAS unsigned* st) {
    XcdBarrier b; b.bar = bar; b.x = xb_xcc_id(); b.st = st;
    if (threadIdx.x == 0) (void)xb_add(&bar[XB_XCNT(b.x)], 1u);
    return b;
}
DI void xcd_barrier_complete(unsigned* bar, unsigned x, unsigned& nloc, unsigned& nx) {
    const unsigned G = gridDim.x * gridDim.y * gridDim.z;
    unsigned sum, cnt, mine, sp = 0u;
    for (;;) {
        sum = 0u; cnt = 0u; mine = 0u;
#pragma unroll
        for (unsigned j = 0; j < 16; ++j) { const unsigned c = xb_ld(&bar[XB_XCNT(j)]); sum += c; cnt += (c > 0u) ? 1u : 0u; mine = (j == x) ? c : mine; }
        if (sum == G) break;
        __builtin_amdgcn_s_sleep(1);
        if ((++sp & 255u) == 0u) { if (xb_ld(&bar[XB_TMO])) break; if (sp > XB_SPIN_CAP) { atomicAdd(&bar[XB_TMO], 1u); break; } }
    }
    nloc = mine > 0u ? mine : 1u; nx = cnt > 0u ? cnt : 1u;
}
DI void xcd_barrier(const XcdBarrier& b) {
    asm volatile("s_waitcnt vmcnt(0)" ::: "memory");
    __syncthreads();
    if (threadIdx.x == 0) {
        unsigned* bar = b.bar;
        __builtin_amdgcn_s_waitcnt(0);
        unsigned nloc = b.st[0], nx = b.st[1];
        if (nloc == 0u) { xcd_barrier_complete(bar, b.x, nloc, nx); b.st[0] = nloc; b.st[1] = nx; }
        const unsigned old = xb_add(&bar[XB_XSUB(b.x)], 1u);
        const unsigned gen = old / nloc;
        if (old + 1u == (gen + 1u) * nloc) {
            __builtin_amdgcn_fence(__ATOMIC_RELEASE, "agent");
            asm volatile("s_waitcnt vmcnt(0)" ::: "memory");
            const unsigned og = xb_add(&bar[XB_TOP], 1u);
            const unsigned tg = og / nx;
            if (og + 1u == (tg + 1u) * nx) xb_add(&bar[XB_TOPGEN], 1u);
            else XB_SPIN(xb_ld(&bar[XB_TOPGEN]) == tg, bar);
            __builtin_amdgcn_fence(__ATOMIC_ACQUIRE, "agent");
            xb_add(&bar[XB_XGEN(b.x)], 1u);
            asm volatile("s_waitcnt vmcnt(0)" ::: "memory");
        } else {
            XB_SPIN(xb_ld(&bar[XB_XGEN(b.x)]) == gen, bar);
            __builtin_amdgcn_fence(__ATOMIC_ACQUIRE, "agent");
            asm volatile("s_waitcnt vmcnt(0)" ::: "memory");
        }
    }
    __syncthreads();
}

constexpr int LDS_BYTES = 136 * 1024;
constexpr int LDS_BAR_OFF = LDS_BYTES - 16;
__global__ void __launch_bounds__(NT) fwd_megakernel(Params p) {
    extern __shared__ __attribute__((aligned(16))) float lds[];
    const int bid = blockIdx.x, nblk = gridDim.x;
    volatile LAS unsigned* st = (volatile LAS unsigned*)((LAS unsigned char*)lds + LDS_BAR_OFF);
    if (threadIdx.x < 4) st[threadIdx.x] = 0u;
    __syncthreads();
    XcdBarrier bar = xcd_barrier_post((unsigned*)(p.ws + OFF_CTL) + CW_BAR, st);
    phase_prep(p, bid, nblk, lds);      xcd_barrier(bar);
    phase_proj(p, bid, nblk, lds);      xcd_barrier(bar);
    phase_poolmean(p, bid, nblk, lds);
    phase_gla1(p, bid, nblk, lds);      xcd_barrier(bar);
    phase_pool(p, bid, nblk, lds);
    phase_gla2(p, bid, nblk, lds);      xcd_barrier(bar);
    phase_gla3(p, bid, nblk, lds);      xcd_barrier(bar);
    phase_out(p, bid, nblk, lds);       xcd_barrier(bar);
    phase_route(p, bid, nblk, lds);     xcd_barrier(bar);
    phase_e1(p, bid, nblk, lds);        xcd_barrier(bar);
    phase_e2(p, bid, nblk, lds);        xcd_barrier(bar);
    phase_combine(p, bid, nblk, lds);
}

extern "C" void kernel_launch(void* const* d_in, const int* in_sizes, int n_in, void* d_out, int out_size, void* d_ws, size_t ws_size, hipStream_t stream) {
    static int grid = 0;
    if (grid == 0) {
        if (n_in != 20 || ws_size < WS_NEED) { fprintf(stderr, "kernel_launch: unexpected n_in %d or ws_size %zu (< %zu)\n", n_in, ws_size, (size_t)WS_NEED); grid = -1; return; }
        int dev = 0, cus = 0, per_cu = 0;
        (void)hipGetDevice(&dev); (void)hipDeviceGetAttribute(&cus, hipDeviceAttributeMultiprocessorCount, dev);
        (void)hipFuncSetAttribute((const void*)fwd_megakernel, hipFuncAttributeMaxDynamicSharedMemorySize, LDS_BYTES);
        (void)hipOccupancyMaxActiveBlocksPerMultiprocessor(&per_cu, (const void*)fwd_megakernel, NT, LDS_BYTES);
        if (per_cu < 1 || cus < 1) { fprintf(stderr, "kernel_launch: occupancy query says %d blocks/CU on %d CUs\n", per_cu, cus); grid = -1; return; }
        grid = cus;
    }
    if (grid < 0) return;
    (void)hipMemsetAsync((char*)d_ws + OFF_CTL, 0, 64 * 1024, stream);
    Params p{};
    const float** pp = (const float**)&p;
    for (int i = 0; i < 20; ++i) pp[i] = (const float*)d_in[i];
    p.out = (float*)d_out; p.ws = (unsigned char*)d_ws;
    void* args[] = {&p};
    hipError_t e = hipLaunchCooperativeKernel((const void*)fwd_megakernel, dim3(grid), dim3(NT), args, LDS_BYTES, stream);
    if (e != hipSuccess) fprintf(stderr, "cooperative launch failed: %s (grid %d)\n", hipGetErrorString(e), grid);
}
```

```cpp
#include <hip/hip_runtime.h>
#include <stdint.h>
#include <cstdio>

#define DI __device__ __forceinline__
typedef unsigned short bf16_t;

constexpr int T = 16384, D = 1024, SEQ = 4096;
constexpr int DIN = 2064, NPROJ = 2048;
constexpr int P_OFF = 0, Q_OFF = 512, K_OFF = 768, V_OFF = 1024, R_OFF = 1536, GL_OFF = 2048;
constexpr int SC = 64;
constexpr int NSC = SEQ / SC;
constexpr int NE = 256, TOPK = 8, EDIM = 256;
constexpr int A_TOT = T * TOPK;
constexpr int LCAP = T;
constexpr float ALPHA = 1.189207115002721f;
constexpr float LN_EPS = 1e-5f, RMS_EPS = 1e-5f;
constexpr int NT = 512;

constexpr size_t MiB = 1u << 20;
constexpr size_t OFF_CTL = 0;
constexpr size_t OFF_XB = 1 * MiB;
constexpr size_t OFF_GLOW = OFF_XB + 32 * MiB;
constexpr size_t OFF_PROJ = OFF_GLOW + 1 * MiB;
constexpr size_t OFF_G = OFF_PROJ + 64 * MiB;
constexpr size_t OFF_SLOC = OFF_G + 16 * MiB;
constexpr size_t OFF_DEC = OFF_SLOC + 32 * MiB;
constexpr size_t OFF_SIN = OFF_DEC + 1 * MiB;
constexpr size_t OFF_MIX = OFF_SIN + 32 * MiB;
constexpr size_t OFF_H32 = OFF_MIX + 32 * MiB;
constexpr size_t OFF_HB = OFF_H32 + 64 * MiB;
constexpr size_t OFF_SCORES = OFF_HB + 32 * MiB;
constexpr size_t OFF_WBUF = OFF_SCORES + 16 * MiB;
constexpr size_t OFF_LIST = OFF_WBUF + 1 * MiB;
constexpr size_t OFF_HID = OFF_LIST + 16 * MiB;
constexpr size_t OFF_Y = OFF_HID + 76 * MiB;
constexpr size_t OFF_PM = OFF_Y + 304 * MiB;
constexpr size_t OFF_WB_IN = OFF_PM + 16 * MiB;
constexpr size_t OFF_WB_OUT = OFF_WB_IN + 4 * MiB;
constexpr size_t OFF_WB_RT = OFF_WB_OUT + 2 * MiB;
constexpr size_t OFF_WB_SGU = OFF_WB_RT + 1 * MiB;
constexpr size_t OFF_WB_SD = OFF_WB_SGU + 1 * MiB;
constexpr size_t WS_NEED = OFF_WB_SD + 1 * MiB;
constexpr int CW_CNT = 1024;

struct Params {
    const float *x, *w_in, *gate_w2, *gate_b, *norm_w, *pool_w, *pool_scale, *w_out, *ln1_g, *ln1_b;
    const float *router_w, *router_bias, *wg, *wu, *wd, *sg, *su, *sd, *ln2_g, *ln2_b;
    float* out;
    unsigned char* ws;
};

DI float bf2f(bf16_t v) { return __uint_as_float(((unsigned)v) << 16); }
DI bf16_t f2bf(float f) { unsigned u = __float_as_uint(f); u += 0x7fffu + ((u >> 16) & 1u); return (bf16_t)(u >> 16); }
DI unsigned pk2(float lo, float hi) { return (unsigned)f2bf(lo) | ((unsigned)f2bf(hi) << 16); }
DI float wave_sum(float v) {
#pragma unroll
    for (int o = 1; o < 64; o <<= 1) v += __shfl_xor(v, o);
    return v;
}
DI float sigmoidf_(float v) { return 1.f / (1.f + __expf(-v)); }
DI float logsigmoidf_(float z) { return fminf(z, 0.f) - log1pf(__expf(-fabsf(z))); }

constexpr int GT_LDS_FLOATS = 16 * 132 + 2 * 16 * 68;
template <bool DUAL, class AF, class BF, class EPI>
DI void gemm_tile_valu(int K, const AF& af, const BF& bfn, const EPI& epi, float* lds) {
    float* As = lds; float* Bs = lds + 16 * 132; float* Bs2 = Bs + 16 * 68;
    const int tid = threadIdx.x, ty = tid >> 4, tx = tid & 15;
    float acc[4][4], acc2[4][4];
#pragma unroll
    for (int i = 0; i < 4; ++i)
#pragma unroll
        for (int j = 0; j < 4; ++j) { acc[i][j] = 0.f; acc2[i][j] = 0.f; }
    for (int k0 = 0; k0 < K; k0 += 16) {
#pragma unroll
        for (int i = 0; i < 4; ++i) { const int e = tid + 512 * i, r = e >> 4, kk = e & 15; As[kk * 132 + r] = af(r, k0 + kk); }
#pragma unroll
        for (int i = 0; i < 2; ++i) { const int e = tid + 512 * i, kk = e >> 6, c = e & 63; Bs[kk * 68 + c] = bfn(0, k0 + kk, c); if (DUAL) Bs2[kk * 68 + c] = bfn(1, k0 + kk, c); }
        __syncthreads();
#pragma unroll
        for (int kk = 0; kk < 16; ++kk) {
            const float4 a = *(const float4*)&As[kk * 132 + ty * 4];
            const float4 b = *(const float4*)&Bs[kk * 68 + tx * 4];
            const float av[4] = {a.x, a.y, a.z, a.w}, bv[4] = {b.x, b.y, b.z, b.w};
#pragma unroll
            for (int i = 0; i < 4; ++i)
#pragma unroll
                for (int j = 0; j < 4; ++j) acc[i][j] += av[i] * bv[j];
            if (DUAL) {
                const float4 b2 = *(const float4*)&Bs2[kk * 68 + tx * 4];
                const float b2v[4] = {b2.x, b2.y, b2.z, b2.w};
#pragma unroll
                for (int i = 0; i < 4; ++i)
#pragma unroll
                    for (int j = 0; j < 4; ++j) acc2[i][j] += av[i] * b2v[j];
            }
        }
        __syncthreads();
    }
#pragma unroll
    for (int i = 0; i < 4; ++i)
#pragma unroll
        for (int j = 0; j < 4; ++j) epi(ty * 4 + i, tx * 4 + j, acc[i][j], acc2[i][j]);
}


typedef __bf16 bf16x8 __attribute__((ext_vector_type(8)));
typedef __bf16 bf16x4 __attribute__((ext_vector_type(4)));
typedef short s16x4 __attribute__((ext_vector_type(4)));
typedef float f32x4 __attribute__((ext_vector_type(4)));
typedef unsigned u32x4 __attribute__((ext_vector_type(4)));
#define LAS3 __attribute__((address_space(3)))
DI const float* uniform_ptr(const float* p) {
    const unsigned long long v = (unsigned long long)p;
    const unsigned lo = __builtin_amdgcn_readfirstlane((unsigned)v), hi = __builtin_amdgcn_readfirstlane((unsigned)(v >> 32));
    return (const float*)(((unsigned long long)hi << 32) | lo);
}
#define MFMA16(a, b, c) __builtin_amdgcn_mfma_f32_16x16x32_bf16((a), (b), (c), 0, 0, 0)
constexpr int GEMM_LDS_BYTES = 131072;
DI unsigned a_swz(unsigned x) { return (0x78u >> (2u * x)) & 3u; }
struct GemmRegs { u32x4 ra[2][2], rb[2][4]; };
template <bool DUAL, bool BK16, int OUTB, int LDB, int WN, class RowFn, class RowFnN, class Pre, class Fin>
DI void gemm_core(u32x4 (&Rra)[2][2], u32x4 (&Rrb)[2][4], unsigned (&aoffc)[2], bool preloaded, const bf16_t* Ab, const RowFn& rowoff, const float* B0, const float* B1, unsigned bbytes, int K, int rows,
                  bool has_next, const RowFnN& rowoff_n, const float* B0n, const float* B1n, unsigned bbytes_n, int rows_n, const Pre& pre, const Fin& fin, unsigned char* lds) {
    int tid_ = threadIdx.x; asm volatile("" : "+v"(tid_));
    const int tid = tid_, lane = tid & 63, w = __builtin_amdgcn_readfirstlane(tid >> 6), wm = w >> 2, wn = w & 3, l15 = lane & 15, kg = lane >> 4, t256 = tid & 255;
    const bool active = wn < WN;
    const int nrow_w = min(max(rows - 128 * wm, 0), 128), ngrp = (((nrow_w + 15) >> 4) + 1) >> 1;
    unsigned aoff[2];
#pragma unroll
    for (int i = 0; i < 2; ++i) aoff[i] = preloaded ? aoffc[i] : (rowoff(min(128 * wm + (t256 >> 2) + 64 * i, rows - 1)) + (t256 & 3) * 8) * 2u;
    const __amdgpu_buffer_rsrc_t ar = __builtin_amdgcn_make_buffer_rsrc((void*)Ab, 0, 0x7fffffff, 0x00020000);
    const unsigned awr = (128 * wm + (t256 >> 2)) * 128 + ((((unsigned)(t256 & 3)) ^ (unsigned)((t256 >> 3) & 7)) << 4);
    constexpr int NB = BK16 ? 2 : 4;
    const float* bsrc = uniform_ptr(DUAL && !BK16 ? ((wn >> 1) ? B1 : B0) : B0);
    const __amdgpu_buffer_rsrc_t br = __builtin_amdgcn_make_buffer_rsrc((void*)bsrc, 0, bbytes, 0x00020000);
    const unsigned bvoff = BK16 ? (unsigned)(((lane >> 5) * LDB + (lane & 31) * 8) * 2) : (DUAL ? (unsigned)(((lane >> 5) * LDB + (lane & 31) * 4) * 4) : (unsigned)(lane * 16));
    const int krow0 = BK16 ? 16 * wm + 2 * wn : (DUAL ? 16 * wm + 8 * (wn & 1) : 16 * wm + wn);
    constexpr int KSTEP = BK16 ? 8 : (DUAL ? 2 : 4), ESZ = BK16 ? 2 : 4;
    unsigned aoff_n[2];
#pragma unroll
    for (int i = 0; i < 2; ++i) aoff_n[i] = has_next ? (rowoff_n(min(128 * wm + (t256 >> 2) + 64 * i, rows_n - 1)) + (t256 & 3) * 8) * 2u : aoff[i];
    const float* bsrc_n = uniform_ptr(has_next ? (DUAL && !BK16 ? ((wn >> 1) ? B1n : B0n) : B0n) : bsrc);
    const __amdgpu_buffer_rsrc_t br_n = __builtin_amdgcn_make_buffer_rsrc((void*)bsrc_n, 0, has_next ? bbytes_n : bbytes, 0x00020000);
    unsigned bwr[NB];
#pragma unroll
    for (int i = 0; i < NB; ++i) {
        const int kb = krow0 + KSTEP * i + ((BK16 || DUAL) ? (lane >> 5) : 0);
        const int n = BK16 ? 8 * (lane & 31) : (DUAL ? (wn >> 1) * 128 + 4 * (lane & 31) : 4 * lane);
        const unsigned I = n >> 7, ch = (n & 127) >> 3, half = BK16 ? 0u : (unsigned)((n >> 2) & 1), xx = ((kb & 3) << 2) | ((kb >> 2) & 3);
        bwr[i] = 32768u + I * 16384u + 256u * kb + 16u * (ch ^ xx) + 8u * half;
    }
    const unsigned ard = (128 * wm + l15) * 128 + ((((unsigned)kg) ^ (unsigned)((l15 >> 1) & 7)) << 4);
    unsigned trd0, trd1;
    {
        const unsigned q = l15 >> 2, pp = l15 & 3, cbase = (DUAL ? 4u * wn : 8u * (wn & 1)) + (pp >> 1), ibase = DUAL ? 0u : (unsigned)(wn >> 1);
        const unsigned x0 = (q << 2) | ((2u * kg) & 3u), x1 = (q << 2) | ((2u * kg + 1u) & 3u);
        trd0 = 32768u + ibase * 16384u + 256u * (8u * kg + q) + 16u * (cbase ^ x0) + 8u * (pp & 1);
        trd1 = 32768u + ibase * 16384u + 256u * (8u * kg + 4u + q) + 16u * (cbase ^ x1) + 8u * (pp & 1);
    }
    f32x4 acc[8][4];
#pragma unroll
    for (int i = 0; i < 8; ++i)
#pragma unroll
        for (int f = 0; f < 4; ++f) acc[i][f] = (f32x4){0.f, 0.f, 0.f, 0.f};
    const int nj = K / 32;
#define LOAD_SET(S, j) { _Pragma("unroll") for (int i = 0; i < 2; ++i) Rra[S][i] = __builtin_bit_cast(u32x4, __builtin_amdgcn_raw_buffer_load_b128(ar, aoff[i], (j) * 64, 0)); \
        _Pragma("unroll") for (int i = 0; i < NB; ++i) Rrb[S][i] = __builtin_bit_cast(u32x4, __builtin_amdgcn_raw_buffer_load_b128(br, bvoff, ((j) * 32 + krow0 + KSTEP * i) * (LDB * ESZ), 0)); }
#define LOAD_SET_N(S, j) { _Pragma("unroll") for (int i = 0; i < 2; ++i) Rra[S][i] = __builtin_bit_cast(u32x4, __builtin_amdgcn_raw_buffer_load_b128(ar, aoff_n[i], (j) * 64, 0)); \
        _Pragma("unroll") for (int i = 0; i < NB; ++i) Rrb[S][i] = __builtin_bit_cast(u32x4, __builtin_amdgcn_raw_buffer_load_b128(br_n, bvoff, ((j) * 32 + krow0 + KSTEP * i) * (LDB * ESZ), 0)); }
#define WRITE_SET(S, st, h) { _Pragma("unroll") for (int i = 0; i < 2; ++i) *(u32x4*)(lds + (st) * 65536 + (awr ^ ((h) ? 64u : 0u)) + i * 8192) = Rra[S][i]; \
        _Pragma("unroll") for (int i = 0; i < NB; ++i) { if (BK16) *(u32x4*)(lds + (st) * 65536 + (h) * 8192 + bwr[i]) = Rrb[S][i]; else { \
            const f32x4 v = __builtin_bit_cast(f32x4, Rrb[S][i]); bf16x4 o; o[0] = (__bf16)v[0]; o[1] = (__bf16)v[1]; o[2] = (__bf16)v[2]; o[3] = (__bf16)v[3]; \
            *(bf16x4*)(lds + (st) * 65536 + (h) * 8192 + ((!DUAL) ? ((bwr[0] ^ (unsigned)(i << 4)) + 1024u * i) : bwr[i])) = o; } } }
#define LOAD_SEL(S, jl) { const bool nx_ = (jl) >= nj; const int jt_ = nx_ ? (jl) - nj : (jl); \
        _Pragma("unroll") for (int i = 0; i < 2; ++i) Rra[S][i] = __builtin_bit_cast(u32x4, __builtin_amdgcn_raw_buffer_load_b128(ar, nx_ ? aoff_n[i] : aoff[i], jt_ * 64, 0)); \
        if (nx_) { _Pragma("unroll") for (int i = 0; i < NB; ++i) Rrb[S][i] = __builtin_bit_cast(u32x4, __builtin_amdgcn_raw_buffer_load_b128(br_n, bvoff, (jt_ * 32 + krow0 + KSTEP * i) * (LDB * ESZ), 0)); } \
        else { _Pragma("unroll") for (int i = 0; i < NB; ++i) Rrb[S][i] = __builtin_bit_cast(u32x4, __builtin_amdgcn_raw_buffer_load_b128(br, bvoff, (jt_ * 32 + krow0 + KSTEP * i) * (LDB * ESZ), 0)); } }
#define TF_LOAD(dst, st, h, g) { _Pragma("unroll") for (int q_ = 0; q_ < 2; ++q_) dst[q_] = *(const bf16x8*)(lds + (st) * 65536 + ((g) * 2 + q_) * 2048 + (ard ^ ((h) ? 64u : 0u))); }
#define WF_LOAD(st, h) { _Pragma("unroll") for (int f = 0; f < 4; ++f) { \
        const unsigned fx = DUAL ? ((f & 1) << 5) : (f << 5), fo = (DUAL ? (f >> 1) * 16384 : 0) + (st) * 65536 + (h) * 8192; \
        const s16x4 lo = __builtin_amdgcn_ds_read_tr16_b64_v4i16((LAS3 s16x4*)(lds + ((trd0 ^ fx) + fo))); \
        const s16x4 hi = __builtin_amdgcn_ds_read_tr16_b64_v4i16((LAS3 s16x4*)(lds + ((trd1 ^ fx) + fo))); \
        wf[f] = __builtin_bit_cast(bf16x8, __builtin_shufflevector(lo, hi, 0, 1, 2, 3, 4, 5, 6, 7)); } }
#define STAGE_MMA(srcf, g) { _Pragma("unroll") for (int q_ = 0; q_ < 2; ++q_) _Pragma("unroll") for (int f = 0; f < 4; ++f) acc[(g) * 2 + q_][f] = MFMA16(wf[f], srcf[q_], acc[(g) * 2 + q_][f]); }
#define STAGE(st, h, g, cur, nxt) if ((g) < ngrp) { \
        if ((g) + 1 < 4 && (g) + 1 < ngrp) TF_LOAD(nxt, st, h, (g) + 1) \
        __builtin_amdgcn_sched_barrier(0); \
        STAGE_MMA(cur, g) \
        __builtin_amdgcn_sched_barrier(0); }
    const bool comp = active && ngrp > 0;
    bf16x8 fa[2], fb[2], wf[4];
#define HALF_MMA(st, h) if (comp) { STAGE(st, h, 0, fa, fb) STAGE(st, h, 1, fb, fa) STAGE(st, h, 2, fa, fb) STAGE(st, h, 3, fb, fa) }
#define PREFETCH(st, h) if (comp) { WF_LOAD(st, h) TF_LOAD(fa, st, h, 0) }
    const int nJ = K / 64;
    if (!preloaded) { LOAD_SET(0, 0) LOAD_SET(1, 1) }
    WRITE_SET(0, 0, 0) WRITE_SET(1, 0, 1)
    LOAD_SEL(0, 2) LOAD_SEL(1, 3)
    __syncthreads();
    int st = 0;
#pragma unroll 1
    for (int J = 0; J < nJ - 1; ++J) {
        PREFETCH(st, 0)
        HALF_MMA(st, 0)
        PREFETCH(st, 1)
        WRITE_SET(0, st ^ 1, 0) LOAD_SEL(0, 2 * J + 4)
        HALF_MMA(st, 1)
        WRITE_SET(1, st ^ 1, 1) LOAD_SEL(1, 2 * J + 5)
        __syncthreads();
        st ^= 1;
    }
    {
        PREFETCH(st, 0)
        HALF_MMA(st, 0)
        PREFETCH(st, 1)
        HALF_MMA(st, 1)
        __syncthreads();
    }
#undef HALF_MMA
#undef PREFETCH
#undef LOAD_SET
#undef LOAD_SET_N
#undef LOAD_SEL
#undef WRITE_SET
#undef TF_LOAD
#undef WF_LOAD
#undef STAGE_MMA
#undef STAGE
    aoffc[0] = aoff_n[0]; aoffc[1] = aoff_n[1];
    {
        constexpr int NF = DUAL ? 2 : 4, ROWB = NF * 16 * OUTB, NCH = ROWB / 16, RPR = (8192 / ROWB) < 128 ? (8192 / ROWB) : 128, RPI = 64 / NCH, NROUND = 128 / RPR;
        constexpr float FP8_SCALE = 128.f;
        unsigned char* stg = lds + w * 8192;
        int l15e = l15; asm volatile("" : "+v"(l15e));
        const int colbase = (DUAL ? 32 : 64) * wn;
#pragma unroll
        for (int rd = 0; rd < NROUND; ++rd) {
            if (active) {
#pragma unroll
                for (int mt = rd * (RPR / 16); mt < (rd + 1) * (RPR / 16); ++mt) {
                    if ((mt >> 1) < ngrp) {
                        const int rloc = mt * 16 - rd * RPR + l15e, row = 128 * wm + mt * 16 + l15e;
#pragma unroll
                        for (int f = 0; f < NF; ++f) {
                            const f32x4 v = DUAL ? pre(row, colbase + 16 * f + 4 * kg, acc[mt][f], acc[mt][f + 2]) : pre(row, colbase + 16 * f + 4 * kg, acc[mt][f], acc[mt][f]);
                            if (OUTB == 4) *(f32x4*)(stg + rloc * ROWB + ((((unsigned)(4 * f + kg)) ^ (unsigned)(rloc & (NCH - 1))) << 4)) = v;
                            else if (OUTB == 2) { bf16x4 o; o[0] = (__bf16)v[0]; o[1] = (__bf16)v[1]; o[2] = (__bf16)v[2]; o[3] = (__bf16)v[3];
                                *(bf16x4*)(stg + rloc * ROWB + ((((unsigned)(2 * f + (kg >> 1))) ^ (unsigned)(rloc & (NCH - 1))) << 4) + 8 * (kg & 1)) = o; }
                            else { int pk = 0; pk = __builtin_amdgcn_cvt_pk_fp8_f32(v[0] * FP8_SCALE, v[1] * FP8_SCALE, pk, false); pk = __builtin_amdgcn_cvt_pk_fp8_f32(v[2] * FP8_SCALE, v[3] * FP8_SCALE, pk, true);
                                *(int*)(stg + rloc * ROWB + ((((unsigned)f) ^ (unsigned)(rloc & (NCH - 1))) << 4) + 4 * kg) = pk; }
                        }
                    }
                }
                asm volatile("s_waitcnt lgkmcnt(0)" ::: "memory");
#pragma unroll
                for (int it = 0; it < RPR / RPI; ++it) {
                    const int rloc = it * RPI + lane / NCH, c = lane % NCH, row = 128 * wm + rd * RPR + rloc;
                    const u32x4 dv = *(const u32x4*)(stg + rloc * ROWB + ((((unsigned)c) ^ (unsigned)(rloc & (NCH - 1))) << 4));
                    if (row < rows) fin(row, colbase + c * (16 / OUTB), dv);
                }
                asm volatile("s_waitcnt lgkmcnt(0)" ::: "memory");
            }
        }
    }
    __syncthreads();
}

template <bool DUAL, bool BK16, int OUTB, int LDB, int WN, class RowFn, class Pre, class Fin>
DI void gemm_mfma(const bf16_t* Ab, const RowFn& rowoff, const float* B0, const float* B1, unsigned bbytes, int K, int rows, const Pre& pre, const Fin& fin, unsigned char* lds) {
    u32x4 ra[2][2], rb[2][4]; unsigned ao[2] = {0u, 0u};
    gemm_core<DUAL, BK16, OUTB, LDB, WN>(ra, rb, ao, false, Ab, rowoff, B0, B1, bbytes, K, rows, false, rowoff, B0, B1, bbytes, rows, pre, fin, lds);
}
#define PRE_ID [](int, int, f32x4 v, f32x4) { return v; }

DI void phase_prep(const Params& p, int bid, int nblk, float* lds) {
    const int tid = threadIdx.x, lane = tid & 63, wave = tid >> 6;
    bf16_t* xb = (bf16_t*)(p.ws + OFF_XB); float* glow = (float*)(p.ws + OFF_GLOW);
    f32x4* Wl = (f32x4*)lds;
    for (int idx = tid; idx < 4096; idx += NT) {
        const int k = idx >> 2, q = idx & 3, ln = (k >> 2) & 63, j = k >> 8, c = k & 3;
        Wl[((j * 4 + c) * 4 + q) * 64 + ln] = *(const f32x4*)(p.w_in + (size_t)k * DIN + GL_OFF + 4 * q);
    }
    __syncthreads();
    for (int row0 = (bid * 8 + wave) * 4; row0 < T; row0 += nblk * 32) {
        asm volatile("" ::: "memory");
        f32x4 xv[4][4];
#pragma unroll
        for (int r = 0; r < 4; ++r)
#pragma unroll
            for (int j = 0; j < 4; ++j) {
                xv[r][j] = ((const f32x4*)(p.x + (size_t)(row0 + r) * D))[lane + 64 * j];
                uint2 o; o.x = pk2(xv[r][j][0], xv[r][j][1]); o.y = pk2(xv[r][j][2], xv[r][j][3]);
                ((uint2*)(xb + (size_t)(row0 + r) * D))[lane + 64 * j] = o;
            }
        float acc[4][16];
#pragma unroll
        for (int r = 0; r < 4; ++r)
#pragma unroll
            for (int n = 0; n < 16; ++n) acc[r][n] = 0.f;
#pragma unroll
        for (int j = 0; j < 4; ++j)
#pragma unroll
            for (int c = 0; c < 4; ++c) {
                float wv[16];
#pragma unroll
                for (int q = 0; q < 4; ++q) { const f32x4 w4 = Wl[((j * 4 + c) * 4 + q) * 64 + lane]; wv[4 * q] = w4[0]; wv[4 * q + 1] = w4[1]; wv[4 * q + 2] = w4[2]; wv[4 * q + 3] = w4[3]; }
#pragma unroll
                for (int r = 0; r < 4; ++r) {
                    const float xs = xv[r][j][c];
#pragma unroll
                    for (int n = 0; n < 16; ++n) acc[r][n] += xs * wv[n];
                }
            }
#define RS_STEP(N, OFF) { const bool up = (lane & (OFF)) != 0; _Pragma("unroll") for (int i = 0; i < (N); ++i) { \
            const float a = acc[i / 16][i % 16], b = acc[(i + (N)) / 16][(i + (N)) % 16]; const float snd = up ? a : b, kp = up ? b : a; \
            acc[i / 16][i % 16] = kp + __shfl_xor(snd, (OFF)); } }
        RS_STEP(32, 32) RS_STEP(16, 16) RS_STEP(8, 8) RS_STEP(4, 4) RS_STEP(2, 2) RS_STEP(1, 1)
#undef RS_STEP
        glow[(size_t)row0 * 16 + lane] = acc[0][0];
    }
    {
        bf16_t* wbin = (bf16_t*)(p.ws + OFF_WB_IN); bf16_t* wbout = (bf16_t*)(p.ws + OFF_WB_OUT); bf16_t* wbrt = (bf16_t*)(p.ws + OFF_WB_RT);
        bf16_t* wbsgu = (bf16_t*)(p.ws + OFF_WB_SGU); bf16_t* wbsd = (bf16_t*)(p.ws + OFF_WB_SD);
        constexpr int N_IN = 1024 * 512, N_OUT = 1024 * 256, N_RT = 1024 * 64, N_SGU = 1024 * 128, N_SD = 256 * 256;
        for (int it = bid * NT + tid; it < N_IN + N_OUT + N_RT + N_SGU + N_SD; it += nblk * NT) {
            const float* s; bf16_t* d; int r = it;
            if (r < N_IN) { const int k = r >> 9, c = (r & 511) * 4; s = p.w_in + (size_t)k * DIN + c; d = wbin + (size_t)k * 2048 + c; }
            else if ((r -= N_IN) < N_OUT) { s = p.w_out + (size_t)r * 4; d = wbout + (size_t)r * 4; }
            else if ((r -= N_OUT) < N_RT) { s = p.router_w + (size_t)r * 4; d = wbrt + (size_t)r * 4; }
            else if ((r -= N_RT) < N_SGU) { const int k = r >> 7, c = (r & 127) * 4, nt = c >> 8, h = (c >> 7) & 1, cc = c & 127; s = (h ? p.su : p.sg) + (size_t)k * EDIM + nt * 128 + cc; d = wbsgu + (size_t)k * 512 + c; }
            else { r -= N_SGU; s = p.sd + (size_t)r * 4; d = wbsd + (size_t)r * 4; }
            const f32x4 v = *(const f32x4*)s; uint2 o; o.x = pk2(v[0], v[1]); o.y = pk2(v[2], v[3]); *(uint2*)d = o;
        }
    }
    __syncthreads();
}

DI void phase_proj(const Params& p, int bid, int nblk, float* lds) {
    const bf16_t* xb = (const bf16_t*)(p.ws + OFF_XB); bf16_t* proj = (bf16_t*)(p.ws + OFF_PROJ); const bf16_t* wbin = (const bf16_t*)(p.ws + OFF_WB_IN);
    u32x4 ra[2][2], rb[2][4]; unsigned ao[2] = {0u, 0u}; bool pre = false;
    const bool xl = (nblk == 256);
    for (int u = bid; u < 64 * 8; u += nblk) {
        const int un = u + nblk; const bool hn = un < 64 * 8;
        const int mt = xl ? 32 * (u >> 8) + 4 * (u & 7) + ((u & 255) >> 6) : u >> 3, nt = xl ? ((u & 255) >> 3) & 7 : u & 7;
        const int mtn = xl ? 32 * (un >> 8) + 4 * (un & 7) + ((un & 255) >> 6) : un >> 3, ntn = xl ? ((un & 255) >> 3) & 7 : un & 7;
        auto rowoff = [&](int r) { return (unsigned)((mt * 256 + r) * D); };
        auto rowoff_n = [&](int r) { return (unsigned)((mtn * 256 + r) * D); };
        auto fin = [&](int r, int c, u32x4 dv) { *(u32x4*)(proj + (size_t)(mt * 256 + r) * NPROJ + nt * 256 + c) = dv; };
        gemm_core<false, true, 2, NPROJ, 4>(ra, rb, ao, pre, xb, rowoff, (const float*)(wbin + nt * 256), nullptr, (unsigned)(((size_t)D * NPROJ - nt * 256) * 2), D, 256,
                                 hn, rowoff_n, (const float*)(wbin + ntn * 256), nullptr, (unsigned)(((size_t)D * NPROJ - ntn * 256) * 2), 256, PRE_ID, fin, (unsigned char*)lds);
        pre = hn;
    }
}

template <int W>
DI void poolmean_item(const bf16_t* proj, bf16_t* pm, int t0, int c2) {
    const int s0 = t0 & (SEQ - 1);
    float p0[48], p1[48]; unsigned raw[32];
    p0[0] = 0.f; p1[0] = 0.f;
#pragma unroll
    for (int i = 0; i < 47; ++i) {
        unsigned v = 0u;
        if (i >= 15 || s0 > 0) v = *(const unsigned*)(proj + (size_t)(t0 - 15 + i) * NPROJ + P_OFF + c2);
        if (i >= 15) raw[i - 15] = v;
        p0[i + 1] = p0[i] + __uint_as_float(v << 16); p1[i + 1] = p1[i] + __uint_as_float(v & 0xffff0000u);
    }
#pragma unroll
    for (int i = 0; i < 32; ++i) {
        const int s = s0 + i; const float inv = 1.f / (float)min(s + 1, W);
        const float m0 = (p0[i + 16] - p0[i + 16 - W]) * inv - __uint_as_float(raw[i] << 16);
        const float m1 = (p1[i + 16] - p1[i + 16 - W]) * inv - __uint_as_float(raw[i] & 0xffff0000u);
        *(unsigned*)(pm + (size_t)(t0 + i) * 512 + c2) = pk2(m0, m1);
    }
}
DI void phase_poolmean(const Params& p, int bid, int nblk, float* lds) {
    const bf16_t* proj = (const bf16_t*)(p.ws + OFF_PROJ); bf16_t* pm = (bf16_t*)(p.ws + OFF_PM);
    for (int item = bid * NT + threadIdx.x; item < 256 * (T / 32); item += nblk * NT) {
        const int pair = item & 255, t0 = (item >> 8) * 32, c2 = pair * 2, g = __builtin_amdgcn_readfirstlane(pair >> 6);
        if (g == 0) poolmean_item<2>(proj, pm, t0, c2);
        else if (g == 1) poolmean_item<4>(proj, pm, t0, c2);
        else if (g == 2) poolmean_item<8>(proj, pm, t0, c2);
        else poolmean_item<16>(proj, pm, t0, c2);
    }
}
DI void phase_pool(const Params& p, int bid, int nblk, float* lds) {
    const bf16_t* pm = (const bf16_t*)(p.ws + OFF_PM); bf16_t* mix = (bf16_t*)(p.ws + OFF_MIX);
    for (int u = bid; u < 64 * 4; u += nblk) {
        const int mt = u >> 2, g = u & 3;
        auto rowoff = [&](int r) { return (unsigned)((mt * 256 + r) * 512 + g * 128); };
        auto pre = [&](int r, int c, f32x4 v, f32x4) { const f32x4 sc = *(const f32x4*)(p.pool_scale + g * 128 + c); return v * sc; };
        auto fin = [&](int r, int c, u32x4 dv) { *(u32x4*)(mix + (size_t)(mt * 256 + r) * D + g * 128 + c) = dv; };
        gemm_mfma<false, false, 2, 128, 2>(pm, rowoff, p.pool_w + (size_t)g * 16384, nullptr, (unsigned)((4 - g) * 16384 * 4), 128, 256, pre, fin, (unsigned char*)lds);
    }
}

DI unsigned f1_off(unsigned row, unsigned chunk) { return row * 128u + ((chunk ^ ((row >> 1) & 7u)) << 4); }
DI unsigned f2_off(unsigned row, unsigned ch) { return 256u * row + 16u * (ch ^ (((row & 3u) << 2) | ((row >> 2) & 3u))); }
DI bf16x8 f1_frag(const unsigned char* img, int tile, int ks, int lane) { return *(const bf16x8*)(img + f1_off(16 * tile + (lane & 15), 4 * ks + (lane >> 4))); }
DI bf16x8 f2_frag(const unsigned char* img, int c, int ks, int lane) {
    const unsigned g = lane >> 4, q = (lane & 15) >> 2, pp = lane & 3;
    const unsigned a0 = f2_off(32 * ks + 8 * g + q, 2 * c + (pp >> 1)) + 8 * (pp & 1), a1 = f2_off(32 * ks + 8 * g + 4 + q, 2 * c + (pp >> 1)) + 8 * (pp & 1);
    const s16x4 lo = __builtin_amdgcn_ds_read_tr16_b64_v4i16((LAS3 s16x4*)(img + a0)), hi = __builtin_amdgcn_ds_read_tr16_b64_v4i16((LAS3 s16x4*)(img + a1));
    return __builtin_bit_cast(bf16x8, __builtin_shufflevector(lo, hi, 0, 1, 2, 3, 4, 5, 6, 7));
}
DI float bfbits2f(unsigned short v) { return __uint_as_float(((unsigned)v) << 16); }
typedef unsigned short u16x8 __attribute__((ext_vector_type(8)));
typedef unsigned short u16x4 __attribute__((ext_vector_type(4)));

DI void phase_gla1(const Params& p, int bid, int nblk, float* ldsf) {
    unsigned char* lds = (unsigned char*)ldsf;
    int tid_ = threadIdx.x; asm volatile("" : "+v"(tid_));
    const int tid = tid_, lane = tid & 63, w = __builtin_amdgcn_readfirstlane(tid >> 6), t = tid >> 3, ch = tid & 7;
    const bf16_t* proj = (const bf16_t*)(p.ws + OFF_PROJ); const float* glow = (const float*)(p.ws + OFF_GLOW);
    float* Gbuf = (float*)(p.ws + OFF_G); float* Sloc = (float*)(p.ws + OFF_SLOC); float* dec = (float*)(p.ws + OFF_DEC);
    float* G = (float*)lds; unsigned char* Kimg = lds + 16384; unsigned char* Vimg = lds + 32768; float* W2l = (float*)(lds + 49152); float* segtot = (float*)(lds + 53248);
    for (int unit = bid; unit < 1024; unit += nblk) {
        const int bh = unit >> 6, n = unit & 63, b = bh >> 2, h = bh & 3, t0 = b * SEQ + n * SC;
        for (int i = tid; i < 1024; i += NT) W2l[i] = p.gate_w2[(i >> 6) * 256 + h * 64 + (i & 63)];
#pragma unroll
        for (int i = 0; i < 2; ++i) { const int idx = tid + NT * i, tr = idx >> 4, c16 = idx & 15;
            *(u32x4*)(Vimg + f2_off(tr, c16)) = *(const u32x4*)(proj + (size_t)(t0 + tr) * NPROJ + V_OFF + h * 128 + 8 * c16); }
        __syncthreads();
        {
            float gl[16];
#pragma unroll
            for (int q = 0; q < 4; ++q) { const f32x4 v = *(const f32x4*)(glow + (size_t)(t0 + t) * 16 + 4 * q); gl[4 * q] = v[0]; gl[4 * q + 1] = v[1]; gl[4 * q + 2] = v[2]; gl[4 * q + 3] = v[3]; }
#pragma unroll
            for (int dd = 0; dd < 8; ++dd) { const int d = 8 * ch + dd; float z = p.gate_b[h * 64 + d];
#pragma unroll
                for (int r = 0; r < 16; ++r) z += gl[r] * W2l[r * 64 + d];
                G[t * 64 + d] = logsigmoidf_(z) * (1.f / 16.f); }
        }
        __syncthreads();
        {
            const int seg = tid >> 6, d = tid & 63; float run = 0.f;
#pragma unroll
            for (int tt = 0; tt < 8; ++tt) { run += G[(8 * seg + tt) * 64 + d]; G[(8 * seg + tt) * 64 + d] = run; }
            segtot[seg * 64 + d] = run;
            __syncthreads();
            float pre = 0.f;
            for (int s2 = 0; s2 < seg; ++s2) pre += segtot[s2 * 64 + d];
#pragma unroll
            for (int tt = 0; tt < 8; ++tt) G[(8 * seg + tt) * 64 + d] += pre;
        }
        __syncthreads();
        {
            const f32x4 g0 = *(const f32x4*)(G + t * 64 + 8 * ch), g1 = *(const f32x4*)(G + t * 64 + 8 * ch + 4);
            const f32x4 l0 = *(const f32x4*)(G + 63 * 64 + 8 * ch), l1 = *(const f32x4*)(G + 63 * 64 + 8 * ch + 4);
            *(f32x4*)(Gbuf + (size_t)(t0 + t) * 256 + h * 64 + 8 * ch) = g0; *(f32x4*)(Gbuf + (size_t)(t0 + t) * 256 + h * 64 + 8 * ch + 4) = g1;
            const u16x8 kv = *(const u16x8*)(proj + (size_t)(t0 + t) * NPROJ + K_OFF + h * 64 + 8 * ch);
            bf16x8 o;
#pragma unroll
            for (int dd = 0; dd < 4; ++dd) { o[dd] = (__bf16)(bfbits2f(kv[dd]) * __expf(l0[dd] - g0[dd])); o[dd + 4] = (__bf16)(bfbits2f(kv[dd + 4]) * __expf(l1[dd] - g1[dd])); }
            *(bf16x8*)(Kimg + f2_off(t, ch)) = o;
            if (t == 63) {
#pragma unroll
                for (int dd = 0; dd < 4; ++dd) { dec[unit * 64 + 8 * ch + dd] = __expf(l0[dd]); dec[unit * 64 + 8 * ch + 4 + dd] = __expf(l1[dd]); }
            }
        }
        __syncthreads();
        {
            f32x4 acc[4];
#pragma unroll
            for (int dt = 0; dt < 4; ++dt) acc[dt] = (f32x4){0.f, 0.f, 0.f, 0.f};
#pragma unroll
            for (int ks = 0; ks < 2; ++ks) {
                const bf16x8 xv = f2_frag(Vimg, w, ks, lane);
#pragma unroll
                for (int dt = 0; dt < 4; ++dt) acc[dt] = MFMA16(xv, f2_frag(Kimg, dt, ks, lane), acc[dt]);
            }
#pragma unroll
            for (int dt = 0; dt < 4; ++dt) *(f32x4*)(Sloc + (size_t)unit * 8192 + (16 * dt + (lane & 15)) * 128 + 16 * w + 4 * (lane >> 4)) = acc[dt];
        }
        __syncthreads();
    }
}

DI void phase_gla2(const Params& p, int bid, int nblk, float* lds) {
    const float* Sloc = (const float*)(p.ws + OFF_SLOC); const float* dec = (const float*)(p.ws + OFF_DEC); bf16_t* Sin = (bf16_t*)(p.ws + OFF_SIN);
    for (int gid = bid * NT + threadIdx.x; gid < 16 * 8192; gid += nblk * NT) {
        const int bh = gid >> 13, el = gid & 8191, d = el >> 7; float st = 0.f;
        for (int n0 = 0; n0 < NSC; n0 += 16) {
            float sl[16], dc[16]; bf16_t so[16];
#pragma unroll
            for (int i = 0; i < 16; ++i) { const int u = bh * 64 + n0 + i; sl[i] = Sloc[(size_t)u * 8192 + el]; dc[i] = dec[u * 64 + d]; }
#pragma unroll
            for (int i = 0; i < 16; ++i) { so[i] = f2bf(st); st = st * dc[i] + sl[i]; }
#pragma unroll
            for (int i = 0; i < 16; ++i) Sin[(size_t)(bh * 64 + n0 + i) * 8192 + el] = so[i];
        }
    }
}

DI void phase_gla3(const Params& p, int bid, int nblk, float* ldsf) {
    unsigned char* lds = (unsigned char*)ldsf;
    int tid_ = threadIdx.x; asm volatile("" : "+v"(tid_));
    const int tid = tid_, lane = tid & 63, w = __builtin_amdgcn_readfirstlane(tid >> 6), t = tid >> 3, ch = tid & 7, l15 = lane & 15, kg = lane >> 4;
    const bf16_t* proj = (const bf16_t*)(p.ws + OFF_PROJ); const float* Gbuf = (const float*)(p.ws + OFF_G); const bf16_t* Sin = (const bf16_t*)(p.ws + OFF_SIN);
    bf16_t* mix = (bf16_t*)(p.ws + OFF_MIX);
    unsigned char* Qimg = lds; unsigned char* Kimg = lds + 8192; unsigned char* Pimg = lds + 16384; unsigned char* Vimg = lds + 24576; unsigned char* Simg = lds + 40960;
    float* part = (float*)(lds + 57344);
    for (int unit = bid; unit < 1024; unit += nblk) {
        const int bh = unit >> 6, n = unit & 63, b = bh >> 2, h = bh & 3, t0 = b * SEQ + n * SC;
        {
            const f32x4 g0 = *(const f32x4*)(Gbuf + (size_t)(t0 + t) * 256 + h * 64 + 8 * ch), g1 = *(const f32x4*)(Gbuf + (size_t)(t0 + t) * 256 + h * 64 + 8 * ch + 4);
            const u16x8 qv = *(const u16x8*)(proj + (size_t)(t0 + t) * NPROJ + Q_OFF + h * 64 + 8 * ch), kv = *(const u16x8*)(proj + (size_t)(t0 + t) * NPROJ + K_OFF + h * 64 + 8 * ch);
            bf16x8 qo, ko;
#pragma unroll
            for (int dd = 0; dd < 4; ++dd) {
                qo[dd] = (__bf16)(bfbits2f(qv[dd]) * 0.125f * __expf(g0[dd])); qo[dd + 4] = (__bf16)(bfbits2f(qv[dd + 4]) * 0.125f * __expf(g1[dd]));
                ko[dd] = (__bf16)(bfbits2f(kv[dd]) * __expf(-g0[dd])); ko[dd + 4] = (__bf16)(bfbits2f(kv[dd + 4]) * __expf(-g1[dd]));
            }
            *(bf16x8*)(Qimg + f1_off(t, ch)) = qo; *(bf16x8*)(Kimg + f1_off(t, ch)) = ko;
        }
#pragma unroll
        for (int i = 0; i < 2; ++i) { const int idx = tid + NT * i, tr = idx >> 4, c16 = idx & 15;
            *(u32x4*)(Vimg + f2_off(tr, c16)) = *(const u32x4*)(proj + (size_t)(t0 + tr) * NPROJ + V_OFF + h * 128 + 8 * c16);
            *(u32x4*)(Simg + f2_off(tr, c16)) = *(const u32x4*)(Sin + (size_t)unit * 8192 + tr * 128 + 8 * c16); }
        __syncthreads();
        {
            const int it = w >> 1;
#pragma unroll
            for (int jj = 0; jj < 2; ++jj) {
                const int jt = 2 * (w & 1) + jj; f32x4 acc = {0.f, 0.f, 0.f, 0.f};
                if (jt <= it) {
#pragma unroll
                    for (int ks = 0; ks < 2; ++ks) acc = MFMA16(f1_frag(Kimg, jt, ks, lane), f1_frag(Qimg, it, ks, lane), acc);
                    if (jt == it) {
#pragma unroll
                        for (int r = 0; r < 4; ++r) if (4 * kg + r > l15) acc[r] = 0.f;
                    }
                }
                bf16x4 o; o[0] = (__bf16)acc[0]; o[1] = (__bf16)acc[1]; o[2] = (__bf16)acc[2]; o[3] = (__bf16)acc[3];
                *(bf16x4*)(Pimg + f1_off(16 * it + l15, 2 * jt + (kg >> 1)) + 8 * (kg & 1)) = o;
            }
        }
        __syncthreads();
        {
            f32x4 acc[4];
#pragma unroll
            for (int it = 0; it < 4; ++it) acc[it] = (f32x4){0.f, 0.f, 0.f, 0.f};
#pragma unroll
            for (int ks = 0; ks < 2; ++ks) {
                const bf16x8 xv = f2_frag(Vimg, w, ks, lane), xs = f2_frag(Simg, w, ks, lane);
#pragma unroll
                for (int it = 0; it < 4; ++it) {
                    if (2 * ks <= it) acc[it] = MFMA16(xv, f1_frag(Pimg, it, ks, lane), acc[it]);
                    acc[it] = MFMA16(xs, f1_frag(Qimg, it, ks, lane), acc[it]);
                }
            }
#pragma unroll
            for (int it = 0; it < 4; ++it) {
                float ss = acc[it][0] * acc[it][0] + acc[it][1] * acc[it][1] + acc[it][2] * acc[it][2] + acc[it][3] * acc[it][3];
                ss += __shfl_xor(ss, 16); ss += __shfl_xor(ss, 32);
                if (kg == 0) part[w * 64 + 16 * it + l15] = ss;
            }
            __syncthreads();
            const int e0 = 16 * w + 4 * kg; const f32x4 nw = *(const f32x4*)(p.norm_w + e0);
#pragma unroll
            for (int it = 0; it < 4; ++it) {
                const int i = 16 * it + l15; float tot = 0.f;
#pragma unroll
                for (int w2 = 0; w2 < 8; ++w2) tot += part[w2 * 64 + i];
                const float inv = rsqrtf(tot * (1.f / 128.f) + RMS_EPS);
                const u16x4 rv = *(const u16x4*)(proj + (size_t)(t0 + i) * NPROJ + R_OFF + h * 128 + e0);
                bf16x4 o;
#pragma unroll
                for (int r = 0; r < 4; ++r) { const float rr = bfbits2f(rv[r]); o[r] = (__bf16)(acc[it][r] * inv * nw[r] * (rr * sigmoidf_(rr))); }
                *(bf16x4*)(mix + (size_t)(t0 + i) * D + 512 + h * 128 + e0) = o;
            }
        }
        __syncthreads();
    }
}

DI void phase_out(const Params& p, int bid, int nblk, float* lds) {
    const bf16_t* mix = (const bf16_t*)(p.ws + OFF_MIX); float* h32 = (float*)(p.ws + OFF_H32);
    for (int u = bid; u < 64 * 4; u += nblk) {
        const int mt = (nblk == 256) ? 8 * (u & 7) + (u >> 5) : u >> 2, nt = (nblk == 256) ? (u >> 3) & 3 : u & 3;
        auto rowoff = [&](int r) { return (unsigned)((mt * 256 + r) * D); };
        auto fin = [&](int r, int c, u32x4 dv) { const size_t o = (size_t)(mt * 256 + r) * D + nt * 256 + c; const f32x4 xv = *(const f32x4*)(p.x + o); *(f32x4*)(h32 + o) = xv * ALPHA + __builtin_bit_cast(f32x4, dv); };
        gemm_mfma<false, true, 4, D, 4>(mix, rowoff, (const float*)((const bf16_t*)(p.ws + OFF_WB_OUT) + nt * 256), nullptr, (unsigned)(((size_t)D * D - nt * 256) * 2), D, 256, PRE_ID, fin, (unsigned char*)lds);
    }
}

DI void ln_row(float (&v)[16], const float* g, const float* b, int lane) {
    float s = 0.f;
#pragma unroll
    for (int i = 0; i < 16; ++i) s += v[i];
    const float mean = wave_sum(s) * (1.f / D); float q = 0.f;
#pragma unroll
    for (int i = 0; i < 16; ++i) { v[i] -= mean; q += v[i] * v[i]; }
    const float rstd = rsqrtf(wave_sum(q) * (1.f / D) + LN_EPS);
#pragma unroll
    for (int j = 0; j < 4; ++j) {
        const float4 gg = ((const float4*)g)[lane + 64 * j], bb = ((const float4*)b)[lane + 64 * j];
        v[4 * j] = v[4 * j] * rstd * gg.x + bb.x; v[4 * j + 1] = v[4 * j + 1] * rstd * gg.y + bb.y;
        v[4 * j + 2] = v[4 * j + 2] * rstd * gg.z + bb.z; v[4 * j + 3] = v[4 * j + 3] * rstd * gg.w + bb.w;
    }
}

DI void ln1_rows(const Params& p, int r0, int nrows) {
    int tid_ = threadIdx.x; asm volatile("" : "+v"(tid_));
    const int lane = tid_ & 63, wave = tid_ >> 6;
    float* h32 = (float*)(p.ws + OFF_H32); bf16_t* hb = (bf16_t*)(p.ws + OFF_HB);
    for (int row = r0 + wave; row < r0 + nrows; row += 8) {
        float4* hr = (float4*)(h32 + (size_t)row * D); float v[16];
#pragma unroll
        for (int j = 0; j < 4; ++j) { const float4 a = hr[lane + 64 * j]; v[4 * j] = a.x; v[4 * j + 1] = a.y; v[4 * j + 2] = a.z; v[4 * j + 3] = a.w; }
        ln_row(v, p.ln1_g, p.ln1_b, lane);
#pragma unroll
        for (int j = 0; j < 4; ++j) {
            uint2 o; o.x = pk2(v[4 * j], v[4 * j + 1]); o.y = pk2(v[4 * j + 2], v[4 * j + 3]);
            ((uint2*)(hb + (size_t)row * D))[lane + 64 * j] = o;
        }
    }
}

DI void topk_rows(const Params& p, int r0, int nrows) {
    int tid_ = threadIdx.x; asm volatile("" : "+v"(tid_));
    const int lane = tid_ & 63, wave = tid_ >> 6;
    const float* scores = (const float*)(p.ws + OFF_SCORES); float* wbuf = (float*)(p.ws + OFF_WBUF);
    int* list = (int*)(p.ws + OFF_LIST); unsigned* cnt = (unsigned*)(p.ws + OFF_CTL) + CW_CNT;
    const float NEG = -__builtin_inff();
    for (int t = r0 + wave; t < r0 + nrows; t += 8) {
        const float4 sv = ((const float4*)(scores + (size_t)t * NE))[lane], bv = ((const float4*)p.router_bias)[lane];
        const float s[4] = {sv.x, sv.y, sv.z, sv.w};
        float cand[4] = {sv.x + bv.x, sv.y + bv.y, sv.z + bv.z, sv.w + bv.w};
        float m1 = NEG, m2 = NEG;
#pragma unroll
        for (int j = 0; j < 4; ++j) { const float v = cand[j]; if (v > m1) { m2 = m1; m1 = v; } else if (v > m2) m2 = v; }
#pragma unroll
        for (int off = 1; off < 8; off <<= 1) {
            const float o1 = __shfl_xor(m1, off), o2 = __shfl_xor(m2, off);
            const float n1 = fmaxf(m1, o1), n2 = fmaxf(fminf(m1, o1), fmaxf(m2, o2)); m1 = n1; m2 = n2;
        }
        const float gs = m1 + m2; const int mygrp = lane >> 3; int rank = 0;
#pragma unroll
        for (int g2 = 0; g2 < 8; ++g2) { const float og = __shfl(gs, g2 * 8); if (og > gs || (og == gs && g2 < mygrp)) ++rank; }
        if (rank >= 4) { cand[0] = NEG; cand[1] = NEG; cand[2] = NEG; cand[3] = NEG; }
        int my_e = 0; float my_w = 0.f, wsum = 0.f;
#pragma unroll
        for (int k = 0; k < TOPK; ++k) {
            float bvv = cand[0]; int bj = 0;
#pragma unroll
            for (int j = 1; j < 4; ++j) if (cand[j] > bvv) { bvv = cand[j]; bj = j; }
            int bi = 4 * lane + bj;
#pragma unroll
            for (int off = 32; off >= 1; off >>= 1) {
                const float ov = __shfl_xor(bvv, off); const int oi = __shfl_xor(bi, off);
                if (ov > bvv || (ov == bvv && oi < bi)) { bvv = ov; bi = oi; }
            }
            const int wj = bi & 3, wl = bi >> 2;
            const float mys = wj == 0 ? s[0] : (wj == 1 ? s[1] : (wj == 2 ? s[2] : s[3]));
            const float wk = __shfl(mys, wl);
            wsum += wk;
            if (lane == k) { my_e = bi; my_w = wk; }
            if (lane == wl) {
#pragma unroll
                for (int j = 0; j < 4; ++j) if (j == wj) cand[j] = NEG;
            }
        }
        if (lane < TOPK) {
            const unsigned pos = atomicAdd(&cnt[my_e], 1u);
            list[(size_t)my_e * LCAP + pos] = t * TOPK + lane;
            wbuf[(size_t)t * TOPK + lane] = my_w / wsum * 2.5f;
        }
    }
}

DI void phase_route(const Params& p, int bid, int nblk, float* lds) {
    const bf16_t* hb = (const bf16_t*)(p.ws + OFF_HB); float* scores = (float*)(p.ws + OFF_SCORES);
    for (int mt = bid; mt < T / 64; mt += nblk) {
        ln1_rows(p, mt * 64, 64);
        __syncthreads();
        auto rowoff = [&](int r) { return (unsigned)((mt * 64 + r) * D); };
        auto pre = [&](int r, int c, f32x4 v, f32x4) { return (f32x4){sigmoidf_(v[0]), sigmoidf_(v[1]), sigmoidf_(v[2]), sigmoidf_(v[3])}; };
        auto fin = [&](int r, int c, u32x4 dv) { *(u32x4*)(scores + (size_t)(mt * 64 + r) * NE + c) = dv; };
        gemm_mfma<false, true, 4, NE, 4>(hb, rowoff, (const float*)(p.ws + OFF_WB_RT), nullptr, (unsigned)(D * NE * 2), D, 64, pre, fin, (unsigned char*)lds);
        __syncthreads();
        topk_rows(p, mt * 64, 64);
        __syncthreads();
    }
}

constexpr int EXP_TAB_OFF = GEMM_LDS_BYTES;
DI void build_tables(const Params& p, int* toff, int* roff) {
    const unsigned* cnt = (const unsigned*)(p.ws + OFF_CTL) + CW_CNT;
    int* cl = roff + 260;
    if (threadIdx.x < NE) cl[threadIdx.x] = (int)__hip_atomic_load(cnt + threadIdx.x, __ATOMIC_RELAXED, __HIP_MEMORY_SCOPE_AGENT);
    __syncthreads();
    if (threadIdx.x <= NE) {
        int ta = 0, ra = 0;
        for (int e = 0; e < (int)threadIdx.x; ++e) { const int c = cl[e]; ta += (c + 255) >> 8; ra += c; }
        toff[threadIdx.x] = ta; roff[threadIdx.x] = ra;
    }
    __syncthreads();
}
DI int find_expert(const int* toff, int tile) { int lo = 0, hi = NE - 1; while (lo < hi) { const int mid = (lo + hi + 1) >> 1; if (toff[mid] <= tile) lo = mid; else hi = mid - 1; } return lo; }
struct ExpUnit { int e, row0, rows, rowbase; };
DI ExpUnit exp_unit(const int* toff, const int* roff, int e, int tile, int ntile) {
    const int* cl = roff + 260;
    ExpUnit u;
    if (tile < ntile) {
        u.e = e; const int ui = tile - toff[e], c = cl[e];
        u.row0 = ui * 256; u.rows = min(256, c - u.row0); u.rowbase = roff[e] + u.row0;
    } else { u.e = NE; u.row0 = (tile - ntile) * 256; u.rows = 256; u.rowbase = A_TOT + u.row0; }
    u.e = __builtin_amdgcn_readfirstlane(u.e); u.row0 = __builtin_amdgcn_readfirstlane(u.row0); u.rows = __builtin_amdgcn_readfirstlane(u.rows);
    u.rowbase = __builtin_amdgcn_readfirstlane(u.rowbase);
    return u;
}

template <int NTL>
DI int exp_decode(const int* toff, int ntile, int u, int& tile, int& nt) {
    if (u < NTL * ntile) { const int e = find_expert(toff, u / NTL), ne = toff[e + 1] - toff[e], u2 = u - NTL * toff[e]; nt = u2 / ne; tile = toff[e] + (u2 - nt * ne); return e; }
    else { const int us = u - NTL * ntile; nt = us / (T / 256); tile = ntile + (us - nt * (T / 256)); return NE; }
}

DI void phase_e1(const Params& p, int bid, int nblk, float* lds) {
    int* toff = (int*)((unsigned char*)lds + EXP_TAB_OFF); int* roff = toff + 260;
    const bf16_t* hb = (const bf16_t*)(p.ws + OFF_HB); bf16_t* hid = (bf16_t*)(p.ws + OFF_HID); const int* list = (const int*)(p.ws + OFF_LIST);
    build_tables(p, toff, roff);
    const int ntile = toff[NE], units = (ntile + T / 256) * 2;
    const int vb = (nblk & 7) ? bid : (bid & 7) * (nblk >> 3) + (bid >> 3);
    u32x4 ra[2][2], rb[2][4]; unsigned ao[2] = {0u, 0u}; bool pre = false;
    int tile_n = 0, nt_n = 0; ExpUnit xn;
    if (vb < units) { const int e_ = exp_decode<2>(toff, ntile, vb, tile_n, nt_n); xn = exp_unit(toff, roff, e_, tile_n, ntile); }
    for (int u = vb; u < units; u += nblk) {
        const int nt = nt_n; const ExpUnit x = xn; const bool hn = u + nblk < units;
        if (hn) { const int e_ = exp_decode<2>(toff, ntile, u + nblk, tile_n, nt_n); xn = exp_unit(toff, roff, e_, tile_n, ntile); }
        const float* wg = x.e < NE ? p.wg + (size_t)x.e * 262144 : p.sg; const float* wu = x.e < NE ? p.wu + (size_t)x.e * 262144 : p.su;
        const float* wgn = xn.e < NE ? p.wg + (size_t)xn.e * 262144 : p.sg; const float* wun = xn.e < NE ? p.wu + (size_t)xn.e * 262144 : p.su;
        auto rowoff = [&](int r) { const int tok = x.e < NE ? (list[(size_t)x.e * LCAP + x.row0 + r] >> 3) : (x.row0 + r); return (unsigned)(tok * D); };
        auto rowoff_n = [&](int r) { const int tok = xn.e < NE ? (list[(size_t)xn.e * LCAP + xn.row0 + r] >> 3) : (xn.row0 + r); return (unsigned)(tok * D); };
        auto prf = [&](int r, int c, f32x4 g, f32x4 uu) { return (f32x4){g[0] * sigmoidf_(g[0]) * uu[0], g[1] * sigmoidf_(g[1]) * uu[1], g[2] * sigmoidf_(g[2]) * uu[2], g[3] * sigmoidf_(g[3]) * uu[3]}; };
        auto fin = [&](int r, int c, u32x4 dv) { *(u32x4*)(hid + (size_t)(x.rowbase + r) * EDIM + nt * 128 + c) = dv; };
        gemm_core<true, false, 2, EDIM, 4>(ra, rb, ao, pre, hb, rowoff, wg + nt * 128, wu + nt * 128, (unsigned)((D * EDIM - nt * 128) * 4), D, x.rows,
                                 hn, rowoff_n, wgn + nt_n * 128, wun + nt_n * 128, (unsigned)((D * EDIM - nt_n * 128) * 4), xn.rows, prf, fin, (unsigned char*)lds);
        pre = hn;
    }
}

DI void phase_e2(const Params& p, int bid, int nblk, float* lds) {
    int* toff = (int*)((unsigned char*)lds + EXP_TAB_OFF); int* roff = toff + 260; int* rowa = roff + 520;
    const bf16_t* hid = (const bf16_t*)(p.ws + OFF_HID); unsigned char* Y = p.ws + OFF_Y; const int* list = (const int*)(p.ws + OFF_LIST);
    build_tables(p, toff, roff);
    const int ntile = toff[NE], units = (ntile + T / 256) * 4;
    const int vb = (nblk & 7) ? bid : (bid & 7) * (nblk >> 3) + (bid >> 3);
    u32x4 ra[2][2], rb[2][4]; unsigned ao[2] = {0u, 0u}; bool pre = false;
    int tile_n = 0, nt_n = 0; ExpUnit xn;
    auto rowa_val = [&](const ExpUnit& q, int r) { return q.e < NE ? (r < q.rows ? list[(size_t)q.e * LCAP + q.row0 + r] : 0) : (A_TOT + q.row0 + r); };
    if (vb < units) { const int e_ = exp_decode<4>(toff, ntile, vb, tile_n, nt_n); xn = exp_unit(toff, roff, e_, tile_n, ntile); if (threadIdx.x < 256) rowa[threadIdx.x] = rowa_val(xn, threadIdx.x); }
    __syncthreads();
    int cur = 0;
    for (int u = vb; u < units; u += nblk) {
        const int nt = nt_n; const ExpUnit x = xn; const bool hn = u + nblk < units;
        if (hn) { const int e_ = exp_decode<4>(toff, ntile, u + nblk, tile_n, nt_n); xn = exp_unit(toff, roff, e_, tile_n, ntile); }
        const float* wd = x.e < NE ? p.wd + (size_t)x.e * 262144 : p.sd; const float* wdn = xn.e < NE ? p.wd + (size_t)xn.e * 262144 : p.sd;
        int rnext = 0;
        if (hn && threadIdx.x < 256) rnext = rowa_val(xn, threadIdx.x);
        const int* rowa_c = rowa + cur * 256;
        auto rowoff = [&](int r) { return (unsigned)((x.rowbase + r) * EDIM); };
        auto rowoff_n = [&](int r) { return (unsigned)((xn.rowbase + r) * EDIM); };
        auto fin = [&](int r, int c, u32x4 dv) { *(u32x4*)(Y + (size_t)rowa_c[r] * D + nt * 256 + c) = dv; };
        gemm_core<false, false, 1, D, 4>(ra, rb, ao, pre, hid, rowoff, wd + nt * 256, nullptr, (unsigned)((EDIM * D - nt * 256) * 4), EDIM, x.rows,
                               hn, rowoff_n, wdn + nt_n * 256, nullptr, (unsigned)((EDIM * D - nt_n * 256) * 4), xn.rows, PRE_ID, fin, (unsigned char*)lds);
        pre = hn;
        cur ^= 1;
        if (threadIdx.x < 256) rowa[cur * 256 + threadIdx.x] = rnext;
    }
}

DI void phase_combine(const Params& p, int bid, int nblk, float* lds) {
    const int lane = threadIdx.x & 63, wave = threadIdx.x >> 6;
    const bf16_t* hb = (const bf16_t*)(p.ws + OFF_HB); const unsigned char* Y = p.ws + OFF_Y; const float* wbuf = (const float*)(p.ws + OFF_WBUF);
    typedef float f32x2 __attribute__((ext_vector_type(2)));
    for (int t = bid * 8 + wave; t < T; t += nblk * 8) {
        float v[16];
#pragma unroll
        for (int j = 0; j < 4; ++j) { const uint2 a = ((const uint2*)(hb + (size_t)t * D))[lane + 64 * j];
            v[4 * j] = ALPHA * __uint_as_float(a.x << 16); v[4 * j + 1] = ALPHA * __uint_as_float(a.x & 0xffff0000u);
            v[4 * j + 2] = ALPHA * __uint_as_float(a.y << 16); v[4 * j + 3] = ALPHA * __uint_as_float(a.y & 0xffff0000u); }
#pragma unroll
        for (int k = 0; k < 9; ++k) {
            const size_t row = k < 8 ? (size_t)t * TOPK + k : (size_t)A_TOT + t; const float w = (k < 8 ? wbuf[(size_t)t * TOPK + k] : 1.f) * (1.f / 128.f);
#pragma unroll
            for (int j = 0; j < 4; ++j) {
                const int y = ((const int*)(Y + row * D))[lane + 64 * j];
                const f32x2 lo = __builtin_amdgcn_cvt_pk_f32_fp8(y, false), hi = __builtin_amdgcn_cvt_pk_f32_fp8(y, true);
                v[4 * j] += w * lo[0]; v[4 * j + 1] += w * lo[1]; v[4 * j + 2] += w * hi[0]; v[4 * j + 3] += w * hi[1];
            }
        }
        ln_row(v, p.ln2_g, p.ln2_b, lane);
#pragma unroll
        for (int j = 0; j < 4; ++j) ((float4*)(p.out + (size_t)t * D))[lane + 64 * j] = make_float4(v[4 * j], v[4 * j + 1], v[4 * j + 2], v[4 * j + 3]);
    }
}

#define LAS __attribute__((address_space(3)))
#define XB_TMO      128
#define XB_XCNT(j)  (256  + 64 * (j))
#define XB_XSUB(j)  (1280 + 64 * (j))
#define XB_XGEN(j)  (2304 + 64 * (j))
#define XB_TOP      3328
#define XB_TOPGEN   3392
#define XCD_BAR_WORDS 3456
#define XB_SPIN_CAP (1u << 22)
constexpr int CW_BAR = 4096;
DI unsigned xb_ld(unsigned* p) { return __hip_atomic_load(p, __ATOMIC_RELAXED, __HIP_MEMORY_SCOPE_AGENT); }
DI unsigned xb_add(unsigned* p, unsigned v) { return __hip_atomic_fetch_add(p, v, __ATOMIC_RELAXED, __HIP_MEMORY_SCOPE_AGENT); }
DI unsigned xb_xcc_id() { return (unsigned)__builtin_amdgcn_s_getreg((3 << 11) | 20) & 0xFu; }
#define XB_SPIN(cond, bar) do { unsigned _sp = 0; while (cond) { __builtin_amdgcn_s_sleep(1); \
    if ((++_sp & 255u) == 0u) { if (xb_ld(&(bar)[XB_TMO])) break; if (_sp > XB_SPIN_CAP) { atomicAdd(&(bar)[XB_TMO], 1u); break; } } } } while (0)
struct XcdBarrier { unsigned* bar; unsigned x; volatile LAS unsigned* st; };
DI XcdBarrier xcd_barrier_post(unsigned* bar, volatile LAS unsigned* st) {
    XcdBarrier b; b.bar = bar; b.x = xb_xcc_id(); b.st = st;
    if (threadIdx.x == 0) (void)xb_add(&bar[XB_XCNT(b.x)], 1u);
    return b;
}
DI void xcd_barrier_complete(unsigned* bar, unsigned x, unsigned& nloc, unsigned& nx) {
    const unsigned G = gridDim.x * gridDim.y * gridDim.z;
    unsigned sum, cnt, mine, sp = 0u;
    for (;;) {
        sum = 0u; cnt = 0u; mine = 0u;
#pragma unroll
        for (unsigned j = 0; j < 16; ++j) { const unsigned c = xb_ld(&bar[XB_XCNT(j)]); sum += c; cnt += (c > 0u) ? 1u : 0u; mine = (j == x) ? c : mine; }
        if (sum == G) break;
        __builtin_amdgcn_s_sleep(1);
        if ((++sp & 255u) == 0u) { if (xb_ld(&bar[XB_TMO])) break; if (sp > XB_SPIN_CAP) { atomicAdd(&bar[XB_TMO], 1u); break; } }
    }
    nloc = mine > 0u ? mine : 1u; nx = cnt > 0u ? cnt : 1u;
}
DI void xcd_barrier(const XcdBarrier& b) {
    asm volatile("s_waitcnt vmcnt(0)" ::: "memory");
    __syncthreads();
    if (threadIdx.x == 0) {
        unsigned* bar = b.bar;
        __builtin_amdgcn_s_waitcnt(0);
        unsigned nloc = b.st[0], nx = b.st[1];
        if (nloc == 0u) { xcd_barrier_complete(bar, b.x, nloc, nx); b.st[0] = nloc; b.st[1] = nx; }
        const unsigned old = xb_add(&bar[XB_XSUB(b.x)], 1u);
        const unsigned gen = old / nloc;
        if (old + 1u == (gen + 1u) * nloc) {
            __builtin_amdgcn_fence(__ATOMIC_RELEASE, "agent");
            asm volatile("s_waitcnt vmcnt(0)" ::: "memory");
            const unsigned og = xb_add(&bar[XB_TOP], 1u);
            const unsigned tg = og / nx;
            if (og + 1u == (tg + 1u) * nx) xb_add(&bar[XB_TOPGEN], 1u);
            else XB_SPIN(xb_ld(&bar[XB_TOPGEN]) == tg, bar);
            __builtin_amdgcn_fence(__ATOMIC_ACQUIRE, "agent");
            xb_add(&bar[XB_XGEN(b.x)], 1u);
            asm volatile("s_waitcnt vmcnt(0)" ::: "memory");
        } else {
            XB_SPIN(xb_ld(&bar[XB_XGEN(b.x)]) == gen, bar);
            __builtin_amdgcn_fence(__ATOMIC_ACQUIRE, "agent");
            asm volatile("s_waitcnt vmcnt(0)" ::: "memory");
        }
    }
    __syncthreads();
}

constexpr int LDS_BYTES = 136 * 1024;
constexpr int LDS_BAR_OFF = LDS_BYTES - 16;
__global__ void __launch_bounds__(NT) fwd_megakernel(Params p) {
    extern __shared__ __attribute__((aligned(16))) float lds[];
    const int bid = blockIdx.x, nblk = gridDim.x;
    volatile LAS unsigned* st = (volatile LAS unsigned*)((LAS unsigned char*)lds + LDS_BAR_OFF);
    if (threadIdx.x < 4) st[threadIdx.x] = 0u;
    __syncthreads();
    XcdBarrier bar = xcd_barrier_post((unsigned*)(p.ws + OFF_CTL) + CW_BAR, st);
    phase_prep(p, bid, nblk, lds);      xcd_barrier(bar);
    phase_proj(p, bid, nblk, lds);      xcd_barrier(bar);
    phase_poolmean(p, bid, nblk, lds);
    phase_gla1(p, bid, nblk, lds);      xcd_barrier(bar);
    phase_pool(p, bid, nblk, lds);
    phase_gla2(p, bid, nblk, lds);      xcd_barrier(bar);
    phase_gla3(p, bid, nblk, lds);      xcd_barrier(bar);
    phase_out(p, bid, nblk, lds);       xcd_barrier(bar);
    phase_route(p, bid, nblk, lds);     xcd_barrier(bar);
    phase_e1(p, bid, nblk, lds);        xcd_barrier(bar);
    phase_e2(p, bid, nblk, lds);        xcd_barrier(bar);
    phase_combine(p, bid, nblk, lds);
}

extern "C" void kernel_launch(void* const* d_in, const int* in_sizes, int n_in, void* d_out, int out_size, void* d_ws, size_t ws_size, hipStream_t stream) {
    static int grid = 0;
    if (grid == 0) {
        if (n_in != 20 || ws_size < WS_NEED) { fprintf(stderr, "kernel_launch: unexpected n_in %d or ws_size %zu (< %zu)\n", n_in, ws_size, (size_t)WS_NEED); grid = -1; return; }
        int dev = 0, cus = 0, per_cu = 0;
        (void)hipGetDevice(&dev); (void)hipDeviceGetAttribute(&cus, hipDeviceAttributeMultiprocessorCount, dev);
        (void)hipFuncSetAttribute((const void*)fwd_megakernel, hipFuncAttributeMaxDynamicSharedMemorySize, LDS_BYTES);
        (void)hipOccupancyMaxActiveBlocksPerMultiprocessor(&per_cu, (const void*)fwd_megakernel, NT, LDS_BYTES);
        if (per_cu < 1 || cus < 1) { fprintf(stderr, "kernel_launch: occupancy query says %d blocks/CU on %d CUs\n", per_cu, cus); grid = -1; return; }
        grid = cus;
    }
    if (grid < 0) return;
    (void)hipMemsetAsync((char*)d_ws + OFF_CTL, 0, 64 * 1024, stream);
    Params p{};
    const float** pp = (const float**)&p;
    for (int i = 0; i < 20; ++i) pp[i] = (const float*)d_in[i];
    p.out = (float*)d_out; p.ws = (unsigned char*)d_ws;
    void* args[] = {&p};
    hipError_t e = hipLaunchCooperativeKernel((const void*)fwd_megakernel, dim3(grid), dim3(NT), args, LDS_BYTES, stream);
    if (e != hipSuccess) fprintf(stderr, "cooperative launch failed: %s (grid %d)\n", hipGetErrorString(e), grid);
}
```

```cpp
#include <hip/hip_runtime.h>
#include <stdint.h>
#include <cstdio>

#define DI __device__ __forceinline__
typedef unsigned short bf16_t;

constexpr int T = 16384, D = 1024, SEQ = 4096;
constexpr int DIN = 2064, NPROJ = 2048;
constexpr int P_OFF = 0, Q_OFF = 512, K_OFF = 768, V_OFF = 1024, R_OFF = 1536, GL_OFF = 2048;
constexpr int SC = 64;
constexpr int NSC = SEQ / SC;
constexpr int NE = 256, TOPK = 8, EDIM = 256;
constexpr int A_TOT = T * TOPK;
constexpr int LCAP = T;
constexpr float ALPHA = 1.189207115002721f;
constexpr float LN_EPS = 1e-5f, RMS_EPS = 1e-5f;
constexpr int NT = 512;

constexpr size_t MiB = 1u << 20;
constexpr size_t OFF_CTL = 0;
constexpr size_t OFF_XB = 1 * MiB;
constexpr size_t OFF_GLOW = OFF_XB + 32 * MiB;
constexpr size_t OFF_PROJ = OFF_GLOW + 1 * MiB;
constexpr size_t OFF_G = OFF_PROJ + 64 * MiB;
constexpr size_t OFF_SLOC = OFF_G + 16 * MiB;
constexpr size_t OFF_DEC = OFF_SLOC + 32 * MiB;
constexpr size_t OFF_SIN = OFF_DEC + 1 * MiB;
constexpr size_t OFF_MIX = OFF_SIN + 32 * MiB;
constexpr size_t OFF_H32 = OFF_MIX + 32 * MiB;
constexpr size_t OFF_HB = OFF_H32 + 64 * MiB;
constexpr size_t OFF_SCORES = OFF_HB + 32 * MiB;
constexpr size_t OFF_WBUF = OFF_SCORES + 16 * MiB;
constexpr size_t OFF_LIST = OFF_WBUF + 1 * MiB;
constexpr size_t OFF_HID = OFF_LIST + 16 * MiB;
constexpr size_t OFF_Y = OFF_HID + 76 * MiB;
constexpr size_t OFF_PM = OFF_Y + 304 * MiB;
constexpr size_t OFF_WB_IN = OFF_PM + 16 * MiB;
constexpr size_t OFF_WB_OUT = OFF_WB_IN + 4 * MiB;
constexpr size_t OFF_WB_RT = OFF_WB_OUT + 2 * MiB;
constexpr size_t OFF_WB_SGU = OFF_WB_RT + 1 * MiB;
constexpr size_t OFF_WB_SD = OFF_WB_SGU + 1 * MiB;
constexpr size_t WS_NEED = OFF_WB_SD + 1 * MiB;
constexpr int CW_CNT = 1024;

struct Params {
    const float *x, *w_in, *gate_w2, *gate_b, *norm_w, *pool_w, *pool_scale, *w_out, *ln1_g, *ln1_b;
    const float *router_w, *router_bias, *wg, *wu, *wd, *sg, *su, *sd, *ln2_g, *ln2_b;
    float* out;
    unsigned char* ws;
};

DI float bf2f(bf16_t v) { return __uint_as_float(((unsigned)v) << 16); }
DI bf16_t f2bf(float f) { unsigned u = __float_as_uint(f); u += 0x7fffu + ((u >> 16) & 1u); return (bf16_t)(u >> 16); }
DI unsigned pk2(float lo, float hi) { return (unsigned)f2bf(lo) | ((unsigned)f2bf(hi) << 16); }
DI float wave_sum(float v) {
#pragma unroll
    for (int o = 1; o < 64; o <<= 1) v += __shfl_xor(v, o);
    return v;
}
DI float sigmoidf_(float v) { return 1.f / (1.f + __expf(-v)); }
DI float logsigmoidf_(float z) { return fminf(z, 0.f) - log1pf(__expf(-fabsf(z))); }

constexpr int GT_LDS_FLOATS = 16 * 132 + 2 * 16 * 68;
template <bool DUAL, class AF, class BF, class EPI>
DI void gemm_tile_valu(int K, const AF& af, const BF& bfn, const EPI& epi, float* lds) {
    float* As = lds; float* Bs = lds + 16 * 132; float* Bs2 = Bs + 16 * 68;
    const int tid = threadIdx.x, ty = tid >> 4, tx = tid & 15;
    float acc[4][4], acc2[4][4];
#pragma unroll
    for (int i = 0; i < 4; ++i)
#pragma unroll
        for (int j = 0; j < 4; ++j) { acc[i][j] = 0.f; acc2[i][j] = 0.f; }
    for (int k0 = 0; k0 < K; k0 += 16) {
#pragma unroll
        for (int i = 0; i < 4; ++i) { const int e = tid + 512 * i, r = e >> 4, kk = e & 15; As[kk * 132 + r] = af(r, k0 + kk); }
#pragma unroll
        for (int i = 0; i < 2; ++i) { const int e = tid + 512 * i, kk = e >> 6, c = e & 63; Bs[kk * 68 + c] = bfn(0, k0 + kk, c); if (DUAL) Bs2[kk * 68 + c] = bfn(1, k0 + kk, c); }
        __syncthreads();
#pragma unroll
        for (int kk = 0; kk < 16; ++kk) {
            const float4 a = *(const float4*)&As[kk * 132 + ty * 4];
            const float4 b = *(const float4*)&Bs[kk * 68 + tx * 4];
            const float av[4] = {a.x, a.y, a.z, a.w}, bv[4] = {b.x, b.y, b.z, b.w};
#pragma unroll
            for (int i = 0; i < 4; ++i)
#pragma unroll
                for (int j = 0; j < 4; ++j) acc[i][j] += av[i] * bv[j];
            if (DUAL) {
                const float4 b2 = *(const float4*)&Bs2[kk * 68 + tx * 4];
                const float b2v[4] = {b2.x, b2.y, b2.z, b2.w};
#pragma unroll
                for (int i = 0; i < 4; ++i)
#pragma unroll
                    for (int j = 0; j < 4; ++j) acc2[i][j] += av[i] * b2v[j];
            }
        }
        __syncthreads();
    }
#pragma unroll
    for (int i = 0; i < 4; ++i)
#pragma unroll
        for (int j = 0; j < 4; ++j) epi(ty * 4 + i, tx * 4 + j, acc[i][j], acc2[i][j]);
}


typedef __bf16 bf16x8 __attribute__((ext_vector_type(8)));
typedef __bf16 bf16x4 __attribute__((ext_vector_type(4)));
typedef short s16x4 __attribute__((ext_vector_type(4)));
typedef float f32x4 __attribute__((ext_vector_type(4)));
typedef unsigned u32x4 __attribute__((ext_vector_type(4)));
#define LAS3 __attribute__((address_space(3)))
DI const float* uniform_ptr(const float* p) {
    const unsigned long long v = (unsigned long long)p;
    const unsigned lo = __builtin_amdgcn_readfirstlane((unsigned)v), hi = __builtin_amdgcn_readfirstlane((unsigned)(v >> 32));
    return (const float*)(((unsigned long long)hi << 32) | lo);
}
#define MFMA16(a, b, c) __builtin_amdgcn_mfma_f32_16x16x32_bf16((a), (b), (c), 0, 0, 0)
constexpr int GEMM_LDS_BYTES = 131072;
DI unsigned a_swz(unsigned x) { return (0x78u >> (2u * x)) & 3u; }
struct GemmRegs { u32x4 ra[2][2], rb[2][4]; };
template <bool DUAL, bool BK16, int OUTB, int LDB, int WN, class RowFn, class RowFnN, class Pre, class Fin>
DI void gemm_core(u32x4 (&Rra)[2][2], u32x4 (&Rrb)[2][4], unsigned (&aoffc)[2], bool preloaded, const bf16_t* Ab, const RowFn& rowoff, const float* B0, const float* B1, unsigned bbytes, int K, int rows,
                  bool has_next, const RowFnN& rowoff_n, const float* B0n, const float* B1n, unsigned bbytes_n, int rows_n, const Pre& pre, const Fin& fin, unsigned char* lds) {
    int tid_ = threadIdx.x; asm volatile("" : "+v"(tid_));
    const int tid = tid_, lane = tid & 63, w = __builtin_amdgcn_readfirstlane(tid >> 6), wm = w >> 2, wn = w & 3, l15 = lane & 15, kg = lane >> 4, t256 = tid & 255;
    const bool active = wn < WN;
    const int nrow_w = min(max(rows - 128 * wm, 0), 128), ngrp = (((nrow_w + 15) >> 4) + 1) >> 1;
    unsigned aoff[2];
#pragma unroll
    for (int i = 0; i < 2; ++i) aoff[i] = preloaded ? aoffc[i] : (rowoff(min(128 * wm + (t256 >> 2) + 64 * i, rows - 1)) + (t256 & 3) * 8) * 2u;
    const __amdgpu_buffer_rsrc_t ar = __builtin_amdgcn_make_buffer_rsrc((void*)Ab, 0, 0x7fffffff, 0x00020000);
    const unsigned awr = (128 * wm + (t256 >> 2)) * 128 + ((((unsigned)(t256 & 3)) ^ (unsigned)((t256 >> 3) & 7)) << 4);
    constexpr int NB = BK16 ? 2 : 4;
    const float* bsrc = uniform_ptr(DUAL && !BK16 ? ((wn >> 1) ? B1 : B0) : B0);
    const __amdgpu_buffer_rsrc_t br = __builtin_amdgcn_make_buffer_rsrc((void*)bsrc, 0, bbytes, 0x00020000);
    const unsigned bvoff = BK16 ? (unsigned)(((lane >> 5) * LDB + (lane & 31) * 8) * 2) : (DUAL ? (unsigned)(((lane >> 5) * LDB + (lane & 31) * 4) * 4) : (unsigned)(lane * 16));
    const int krow0 = BK16 ? 16 * wm + 2 * wn : (DUAL ? 16 * wm + 8 * (wn & 1) : 16 * wm + wn);
    constexpr int KSTEP = BK16 ? 8 : (DUAL ? 2 : 4), ESZ = BK16 ? 2 : 4;
    unsigned aoff_n[2];
#pragma unroll
    for (int i = 0; i < 2; ++i) aoff_n[i] = has_next ? (rowoff_n(min(128 * wm + (t256 >> 2) + 64 * i, rows_n - 1)) + (t256 & 3) * 8) * 2u : aoff[i];
    const float* bsrc_n = uniform_ptr(has_next ? (DUAL && !BK16 ? ((wn >> 1) ? B1n : B0n) : B0n) : bsrc);
    const __amdgpu_buffer_rsrc_t br_n = __builtin_amdgcn_make_buffer_rsrc((void*)bsrc_n, 0, has_next ? bbytes_n : bbytes, 0x00020000);
    unsigned bwr[NB];
#pragma unroll
    for (int i = 0; i < NB; ++i) {
        const int kb = krow0 + KSTEP * i + ((BK16 || DUAL) ? (lane >> 5) : 0);
        const int n = BK16 ? 8 * (lane & 31) : (DUAL ? (wn >> 1) * 128 + 4 * (lane & 31) : 4 * lane);
        const unsigned I = n >> 7, ch = (n & 127) >> 3, half = BK16 ? 0u : (unsigned)((n >> 2) & 1), xx = ((kb & 3) << 2) | ((kb >> 2) & 3);
        bwr[i] = 32768u + I * 16384u + 256u * kb + 16u * (ch ^ xx) + 8u * half;
    }
    const unsigned ard = (128 * wm + l15) * 128 + ((((unsigned)kg) ^ (unsigned)((l15 >> 1) & 7)) << 4);
    unsigned trd0, trd1;
    {
        const unsigned q = l15 >> 2, pp = l15 & 3, cbase = (DUAL ? 4u * wn : 8u * (wn & 1)) + (pp >> 1), ibase = DUAL ? 0u : (unsigned)(wn >> 1);
        const unsigned x0 = (q << 2) | ((2u * kg) & 3u), x1 = (q << 2) | ((2u * kg + 1u) & 3u);
        trd0 = 32768u + ibase * 16384u + 256u * (8u * kg + q) + 16u * (cbase ^ x0) + 8u * (pp & 1);
        trd1 = 32768u + ibase * 16384u + 256u * (8u * kg + 4u + q) + 16u * (cbase ^ x1) + 8u * (pp & 1);
    }
    f32x4 acc[8][4];
#pragma unroll
    for (int i = 0; i < 8; ++i)
#pragma unroll
        for (int f = 0; f < 4; ++f) acc[i][f] = (f32x4){0.f, 0.f, 0.f, 0.f};
    const int nj = K / 32;
#define LOAD_SET(S, j) { _Pragma("unroll") for (int i = 0; i < 2; ++i) Rra[S][i] = __builtin_bit_cast(u32x4, __builtin_amdgcn_raw_buffer_load_b128(ar, aoff[i], (j) * 64, 0)); \
        _Pragma("unroll") for (int i = 0; i < NB; ++i) Rrb[S][i] = __builtin_bit_cast(u32x4, __builtin_amdgcn_raw_buffer_load_b128(br, bvoff, ((j) * 32 + krow0 + KSTEP * i) * (LDB * ESZ), 0)); }
#define LOAD_SET_N(S, j) { _Pragma("unroll") for (int i = 0; i < 2; ++i) Rra[S][i] = __builtin_bit_cast(u32x4, __builtin_amdgcn_raw_buffer_load_b128(ar, aoff_n[i], (j) * 64, 0)); \
        _Pragma("unroll") for (int i = 0; i < NB; ++i) Rrb[S][i] = __builtin_bit_cast(u32x4, __builtin_amdgcn_raw_buffer_load_b128(br_n, bvoff, ((j) * 32 + krow0 + KSTEP * i) * (LDB * ESZ), 0)); }
#define WRITE_SET(S, st, h) { _Pragma("unroll") for (int i = 0; i < 2; ++i) *(u32x4*)(lds + (st) * 65536 + (awr ^ ((h) ? 64u : 0u)) + i * 8192) = Rra[S][i]; \
        _Pragma("unroll") for (int i = 0; i < NB; ++i) { if (BK16) *(u32x4*)(lds + (st) * 65536 + (h) * 8192 + bwr[i]) = Rrb[S][i]; else { \
            const f32x4 v = __builtin_bit_cast(f32x4, Rrb[S][i]); bf16x4 o; o[0] = (__bf16)v[0]; o[1] = (__bf16)v[1]; o[2] = (__bf16)v[2]; o[3] = (__bf16)v[3]; \
            *(bf16x4*)(lds + (st) * 65536 + (h) * 8192 + ((!DUAL) ? ((bwr[0] ^ (unsigned)(i << 4)) + 1024u * i) : bwr[i])) = o; } } }
#define LOAD_SEL(S, jl) { const bool nx_ = (jl) >= nj; const int jt_ = nx_ ? (jl) - nj : (jl); \
        _Pragma("unroll") for (int i = 0; i < 2; ++i) Rra[S][i] = __builtin_bit_cast(u32x4, __builtin_amdgcn_raw_buffer_load_b128(ar, nx_ ? aoff_n[i] : aoff[i], jt_ * 64, 0)); \
        if (nx_) { _Pragma("unroll") for (int i = 0; i < NB; ++i) Rrb[S][i] = __builtin_bit_cast(u32x4, __builtin_amdgcn_raw_buffer_load_b128(br_n, bvoff, (jt_ * 32 + krow0 + KSTEP * i) * (LDB * ESZ), 0)); } \
        else { _Pragma("unroll") for (int i = 0; i < NB; ++i) Rrb[S][i] = __builtin_bit_cast(u32x4, __builtin_amdgcn_raw_buffer_load_b128(br, bvoff, (jt_ * 32 + krow0 + KSTEP * i) * (LDB * ESZ), 0)); } }
#define WRITE_A(S, st, h) { _Pragma("unroll") for (int i = 0; i < 2; ++i) *(u32x4*)(lds + (st) * 65536 + (awr ^ ((h) ? 64u : 0u)) + i * 8192) = Rra[S][i]; }
#define WRITE_B(S, st, h, I0, I1) { _Pragma("unroll") for (int i = (I0); i < (I1); ++i) { if (BK16) *(u32x4*)(lds + (st) * 65536 + (h) * 8192 + bwr[i]) = Rrb[S][i]; else { \
            const f32x4 v = __builtin_bit_cast(f32x4, Rrb[S][i]); bf16x4 o; o[0] = (__bf16)v[0]; o[1] = (__bf16)v[1]; o[2] = (__bf16)v[2]; o[3] = (__bf16)v[3]; \
            *(bf16x4*)(lds + (st) * 65536 + (h) * 8192 + ((!DUAL) ? ((bwr[0] ^ (unsigned)(i << 4)) + 1024u * i) : bwr[i])) = o; } } }
#define LOAD_A(S, jl) { const bool nx_ = (jl) >= nj; const int jt_ = nx_ ? (jl) - nj : (jl); \
        _Pragma("unroll") for (int i = 0; i < 2; ++i) Rra[S][i] = __builtin_bit_cast(u32x4, __builtin_amdgcn_raw_buffer_load_b128(ar, nx_ ? aoff_n[i] : aoff[i], jt_ * 64, 0)); }
#define LOAD_B(S, jl) { const bool nx_ = (jl) >= nj; const int jt_ = nx_ ? (jl) - nj : (jl); \
        if (nx_) { _Pragma("unroll") for (int i = 0; i < NB; ++i) Rrb[S][i] = __builtin_bit_cast(u32x4, __builtin_amdgcn_raw_buffer_load_b128(br_n, bvoff, (jt_ * 32 + krow0 + KSTEP * i) * (LDB * ESZ), 0)); } \
        else { _Pragma("unroll") for (int i = 0; i < NB; ++i) Rrb[S][i] = __builtin_bit_cast(u32x4, __builtin_amdgcn_raw_buffer_load_b128(br, bvoff, (jt_ * 32 + krow0 + KSTEP * i) * (LDB * ESZ), 0)); } }
#define TF_LOAD(dst, st, h, g) { _Pragma("unroll") for (int q_ = 0; q_ < 2; ++q_) dst[q_] = *(const bf16x8*)(lds + (st) * 65536 + ((g) * 2 + q_) * 2048 + (ard ^ ((h) ? 64u : 0u))); }
#define WF_LOAD(st, h) { _Pragma("unroll") for (int f = 0; f < 4; ++f) { \
        const unsigned fx = DUAL ? ((f & 1) << 5) : (f << 5), fo = (DUAL ? (f >> 1) * 16384 : 0) + (st) * 65536 + (h) * 8192; \
        const s16x4 lo = __builtin_amdgcn_ds_read_tr16_b64_v4i16((LAS3 s16x4*)(lds + ((trd0 ^ fx) + fo))); \
        const s16x4 hi = __builtin_amdgcn_ds_read_tr16_b64_v4i16((LAS3 s16x4*)(lds + ((trd1 ^ fx) + fo))); \
        wf[f] = __builtin_bit_cast(bf16x8, __builtin_shufflevector(lo, hi, 0, 1, 2, 3, 4, 5, 6, 7)); } }
#define STAGE_MMA(srcf, g) { _Pragma("unroll") for (int q_ = 0; q_ < 2; ++q_) _Pragma("unroll") for (int f = 0; f < 4; ++f) acc[(g) * 2 + q_][f] = MFMA16(wf[f], srcf[q_], acc[(g) * 2 + q_][f]); }
#define STAGE(st, h, g, cur, nxt) if ((g) < ngrp) { \
        if ((g) + 1 < 4 && (g) + 1 < ngrp) TF_LOAD(nxt, st, h, (g) + 1) \
        __builtin_amdgcn_sched_barrier(0); \
        STAGE_MMA(cur, g) \
        __builtin_amdgcn_sched_barrier(0); }
    const bool comp = active && ngrp > 0;
    bf16x8 fa[2], fb[2], wf[4];
#define HALF_MMA(st, h) if (comp) { STAGE(st, h, 0, fa, fb) STAGE(st, h, 1, fb, fa) STAGE(st, h, 2, fa, fb) STAGE(st, h, 3, fb, fa) }
#define SLOT(st, h, g, cur, nxt, PIECE) { if (comp && (g) < ngrp) { if ((g) + 1 < 4 && (g) + 1 < ngrp) TF_LOAD(nxt, st, h, (g) + 1) } \
        PIECE \
        __builtin_amdgcn_sched_barrier(0); \
        if (comp && (g) < ngrp) { STAGE_MMA(cur, g) } \
        __builtin_amdgcn_sched_barrier(0); }
#define HALF_SLOTS(st, h, S, jl) { SLOT(st, h, 0, fa, fb, WRITE_A(S, (st) ^ 1, h) LOAD_A(S, jl)) SLOT(st, h, 1, fb, fa, WRITE_B(S, (st) ^ 1, h, 0, NB / 2)) \
        SLOT(st, h, 2, fa, fb, WRITE_B(S, (st) ^ 1, h, NB / 2, NB)) SLOT(st, h, 3, fb, fa, LOAD_B(S, jl)) }
#define PREFETCH(st, h) if (comp) { WF_LOAD(st, h) TF_LOAD(fa, st, h, 0) }
    const int nJ = K / 64;
    if (!preloaded) { LOAD_SET(0, 0) LOAD_SET(1, 1) }
    WRITE_SET(0, 0, 0) WRITE_SET(1, 0, 1)
    LOAD_SEL(0, 2) LOAD_SEL(1, 3)
    __syncthreads();
    int st = 0;
#pragma unroll 1
    for (int J = 0; J < nJ - 1; ++J) {
        PREFETCH(st, 0)
        HALF_SLOTS(st, 0, 0, 2 * J + 4)
        PREFETCH(st, 1)
        HALF_SLOTS(st, 1, 1, 2 * J + 5)
        __syncthreads();
        st ^= 1;
    }
    {
        PREFETCH(st, 0)
        HALF_MMA(st, 0)
        PREFETCH(st, 1)
        HALF_MMA(st, 1)
        __syncthreads();
    }
#undef HALF_MMA
#undef SLOT
#undef HALF_SLOTS
#undef WRITE_A
#undef WRITE_B
#undef LOAD_A
#undef LOAD_B
#undef PREFETCH
#undef LOAD_SET
#undef LOAD_SET_N
#undef LOAD_SEL
#undef WRITE_SET
#undef TF_LOAD
#undef WF_LOAD
#undef STAGE_MMA
#undef STAGE
    aoffc[0] = aoff_n[0]; aoffc[1] = aoff_n[1];
    {
        constexpr int NF = DUAL ? 2 : 4, ROWB = NF * 16 * OUTB, NCH = ROWB / 16, RPR = (8192 / ROWB) < 128 ? (8192 / ROWB) : 128, RPI = 64 / NCH, NROUND = 128 / RPR;
        constexpr float FP8_SCALE = 128.f;
        unsigned char* stg = lds + w * 8192;
        int l15e = l15; asm volatile("" : "+v"(l15e));
        const int colbase = (DUAL ? 32 : 64) * wn;
#pragma unroll
        for (int rd = 0; rd < NROUND; ++rd) {
            if (active) {
#pragma unroll
                for (int mt = rd * (RPR / 16); mt < (rd + 1) * (RPR / 16); ++mt) {
                    if ((mt >> 1) < ngrp) {
                        const int rloc = mt * 16 - rd * RPR + l15e, row = 128 * wm + mt * 16 + l15e;
#pragma unroll
                        for (int f = 0; f < NF; ++f) {
                            const f32x4 v = DUAL ? pre(row, colbase + 16 * f + 4 * kg, acc[mt][f], acc[mt][f + 2]) : pre(row, colbase + 16 * f + 4 * kg, acc[mt][f], acc[mt][f]);
                            if (OUTB == 4) *(f32x4*)(stg + rloc * ROWB + ((((unsigned)(4 * f + kg)) ^ (unsigned)(rloc & (NCH - 1))) << 4)) = v;
                            else if (OUTB == 2) { bf16x4 o; o[0] = (__bf16)v[0]; o[1] = (__bf16)v[1]; o[2] = (__bf16)v[2]; o[3] = (__bf16)v[3];
                                *(bf16x4*)(stg + rloc * ROWB + ((((unsigned)(2 * f + (kg >> 1))) ^ (unsigned)(rloc & (NCH - 1))) << 4) + 8 * (kg & 1)) = o; }
                            else { int pk = 0; pk = __builtin_amdgcn_cvt_pk_fp8_f32(v[0] * FP8_SCALE, v[1] * FP8_SCALE, pk, false); pk = __builtin_amdgcn_cvt_pk_fp8_f32(v[2] * FP8_SCALE, v[3] * FP8_SCALE, pk, true);
                                *(int*)(stg + rloc * ROWB + ((((unsigned)f) ^ (unsigned)(rloc & (NCH - 1))) << 4) + 4 * kg) = pk; }
                        }
                    }
                }
                asm volatile("s_waitcnt lgkmcnt(0)" ::: "memory");
#pragma unroll
                for (int it = 0; it < RPR / RPI; ++it) {
                    const int rloc = it * RPI + lane / NCH, c = lane % NCH, row = 128 * wm + rd * RPR + rloc;
                    const u32x4 dv = *(const u32x4*)(stg + rloc * ROWB + ((((unsigned)c) ^ (unsigned)(rloc & (NCH - 1))) << 4));
                    if (row < rows) fin(row, colbase + c * (16 / OUTB), dv);
                }
                asm volatile("s_waitcnt lgkmcnt(0)" ::: "memory");
            }
        }
    }
    __syncthreads();
}

template <bool DUAL, bool BK16, int OUTB, int LDB, int WN, class RowFn, class Pre, class Fin>
DI void gemm_mfma(const bf16_t* Ab, const RowFn& rowoff, const float* B0, const float* B1, unsigned bbytes, int K, int rows, const Pre& pre, const Fin& fin, unsigned char* lds) {
    u32x4 ra[2][2], rb[2][4]; unsigned ao[2] = {0u, 0u};
    gemm_core<DUAL, BK16, OUTB, LDB, WN>(ra, rb, ao, false, Ab, rowoff, B0, B1, bbytes, K, rows, false, rowoff, B0, B1, bbytes, rows, pre, fin, lds);
}
#define PRE_ID [](int, int, f32x4 v, f32x4) { return v; }

DI void phase_prep(const Params& p, int bid, int nblk, float* lds) {
    const int tid = threadIdx.x, lane = tid & 63, wave = tid >> 6;
    bf16_t* xb = (bf16_t*)(p.ws + OFF_XB); float* glow = (float*)(p.ws + OFF_GLOW);
    float tw = 0.f;
    {
        const int ti = (bid >> 3) * NT + tid;
        if (ti < 1536) { const int m = ti >> 9, j = ti & 511; const float* bp = m == 0 ? p.wg : (m == 1 ? p.wu : p.wd); tw = bp[(size_t)j * 131072]; }
    }
    f32x4* Wl = (f32x4*)lds;
    for (int idx = tid; idx < 4096; idx += NT) {
        const int k = idx >> 2, q = idx & 3, ln = (k >> 2) & 63, j = k >> 8, c = k & 3;
        Wl[((j * 4 + c) * 4 + q) * 64 + ln] = *(const f32x4*)(p.w_in + (size_t)k * DIN + GL_OFF + 4 * q);
    }
    __syncthreads();
    for (int row0 = (bid * 8 + wave) * 4; row0 < T; row0 += nblk * 32) {
        asm volatile("" ::: "memory");
        f32x4 xv[4][4];
#pragma unroll
        for (int r = 0; r < 4; ++r)
#pragma unroll
            for (int j = 0; j < 4; ++j) {
                xv[r][j] = ((const f32x4*)(p.x + (size_t)(row0 + r) * D))[lane + 64 * j];
                uint2 o; o.x = pk2(xv[r][j][0], xv[r][j][1]); o.y = pk2(xv[r][j][2], xv[r][j][3]);
                ((uint2*)(xb + (size_t)(row0 + r) * D))[lane + 64 * j] = o;
            }
        float acc[4][16];
#pragma unroll
        for (int r = 0; r < 4; ++r)
#pragma unroll
            for (int n = 0; n < 16; ++n) acc[r][n] = 0.f;
#pragma unroll
        for (int j = 0; j < 4; ++j)
#pragma unroll
            for (int c = 0; c < 4; ++c) {
                float wv[16];
#pragma unroll
                for (int q = 0; q < 4; ++q) { const f32x4 w4 = Wl[((j * 4 + c) * 4 + q) * 64 + lane]; wv[4 * q] = w4[0]; wv[4 * q + 1] = w4[1]; wv[4 * q + 2] = w4[2]; wv[4 * q + 3] = w4[3]; }
#pragma unroll
                for (int r = 0; r < 4; ++r) {
                    const float xs = xv[r][j][c];
#pragma unroll
                    for (int n = 0; n < 16; ++n) acc[r][n] += xs * wv[n];
                }
            }
#define RS_STEP(N, OFF) { const bool up = (lane & (OFF)) != 0; _Pragma("unroll") for (int i = 0; i < (N); ++i) { \
            const float a = acc[i / 16][i % 16], b = acc[(i + (N)) / 16][(i + (N)) % 16]; const float snd = up ? a : b, kp = up ? b : a; \
            acc[i / 16][i % 16] = kp + __shfl_xor(snd, (OFF)); } }
        RS_STEP(32, 32) RS_STEP(16, 16) RS_STEP(8, 8) RS_STEP(4, 4) RS_STEP(2, 2) RS_STEP(1, 1)
#undef RS_STEP
        glow[(size_t)row0 * 16 + lane] = acc[0][0];
    }
    {
        bf16_t* wbin = (bf16_t*)(p.ws + OFF_WB_IN); bf16_t* wbout = (bf16_t*)(p.ws + OFF_WB_OUT); bf16_t* wbrt = (bf16_t*)(p.ws + OFF_WB_RT);
        bf16_t* wbsgu = (bf16_t*)(p.ws + OFF_WB_SGU); bf16_t* wbsd = (bf16_t*)(p.ws + OFF_WB_SD);
        constexpr int N_IN = 1024 * 512, N_OUT = 1024 * 256, N_RT = 1024 * 64, N_SGU = 1024 * 128, N_SD = 256 * 256;
        for (int it = bid * NT + tid; it < N_IN + N_OUT + N_RT + N_SGU + N_SD; it += nblk * NT) {
            const float* s; bf16_t* d; int r = it;
            if (r < N_IN) { const int k = r >> 9, c = (r & 511) * 4; s = p.w_in + (size_t)k * DIN + c; d = wbin + (size_t)k * 2048 + c; }
            else if ((r -= N_IN) < N_OUT) { s = p.w_out + (size_t)r * 4; d = wbout + (size_t)r * 4; }
            else if ((r -= N_OUT) < N_RT) { s = p.router_w + (size_t)r * 4; d = wbrt + (size_t)r * 4; }
            else if ((r -= N_RT) < N_SGU) { const int k = r >> 7, c = (r & 127) * 4, nt = c >> 8, h = (c >> 7) & 1, cc = c & 127; s = (h ? p.su : p.sg) + (size_t)k * EDIM + nt * 128 + cc; d = wbsgu + (size_t)k * 512 + c; }
            else { r -= N_SGU; s = p.sd + (size_t)r * 4; d = wbsd + (size_t)r * 4; }
            const f32x4 v = *(const f32x4*)s; uint2 o; o.x = pk2(v[0], v[1]); o.y = pk2(v[2], v[3]); *(uint2*)d = o;
        }
    }
    asm volatile("" :: "v"(tw));
    __syncthreads();
}

DI void phase_proj(const Params& p, int bid, int nblk, float* lds) {
    const bf16_t* xb = (const bf16_t*)(p.ws + OFF_XB); bf16_t* proj = (bf16_t*)(p.ws + OFF_PROJ); const bf16_t* wbin = (const bf16_t*)(p.ws + OFF_WB_IN);
    u32x4 ra[2][2], rb[2][4]; unsigned ao[2] = {0u, 0u}; bool pre = false;
    const bool xl = (nblk == 256);
    for (int u = bid; u < 64 * 8; u += nblk) {
        const int un = u + nblk; const bool hn = un < 64 * 8;
        const int mt = xl ? 32 * (u >> 8) + 4 * (u & 7) + ((u & 255) >> 6) : u >> 3, nt = xl ? ((u & 255) >> 3) & 7 : u & 7;
        const int mtn = xl ? 32 * (un >> 8) + 4 * (un & 7) + ((un & 255) >> 6) : un >> 3, ntn = xl ? ((un & 255) >> 3) & 7 : un & 7;
        auto rowoff = [&](int r) { return (unsigned)((mt * 256 + r) * D); };
        auto rowoff_n = [&](int r) { return (unsigned)((mtn * 256 + r) * D); };
        auto fin = [&](int r, int c, u32x4 dv) { *(u32x4*)(proj + (size_t)(mt * 256 + r) * NPROJ + nt * 256 + c) = dv; };
        gemm_core<false, true, 2, NPROJ, 4>(ra, rb, ao, pre, xb, rowoff, (const float*)(wbin + nt * 256), nullptr, (unsigned)(((size_t)D * NPROJ - nt * 256) * 2), D, 256,
                                 hn, rowoff_n, (const float*)(wbin + ntn * 256), nullptr, (unsigned)(((size_t)D * NPROJ - ntn * 256) * 2), 256, PRE_ID, fin, (unsigned char*)lds);
        pre = hn;
    }
}

template <int W>
DI void poolmean_item(const bf16_t* proj, bf16_t* pm, int t0, int c2) {
    const int s0 = t0 & (SEQ - 1);
    float p0[48], p1[48]; unsigned raw[32];
    p0[0] = 0.f; p1[0] = 0.f;
#pragma unroll
    for (int i = 0; i < 47; ++i) {
        unsigned v = 0u;
        if (i >= 15 || s0 > 0) v = *(const unsigned*)(proj + (size_t)(t0 - 15 + i) * NPROJ + P_OFF + c2);
        if (i >= 15) raw[i - 15] = v;
        p0[i + 1] = p0[i] + __uint_as_float(v << 16); p1[i + 1] = p1[i] + __uint_as_float(v & 0xffff0000u);
    }
#pragma unroll
    for (int i = 0; i < 32; ++i) {
        const int s = s0 + i; const float inv = 1.f / (float)min(s + 1, W);
        const float m0 = (p0[i + 16] - p0[i + 16 - W]) * inv - __uint_as_float(raw[i] << 16);
        const float m1 = (p1[i + 16] - p1[i + 16 - W]) * inv - __uint_as_float(raw[i] & 0xffff0000u);
        *(unsigned*)(pm + (size_t)(t0 + i) * 512 + c2) = pk2(m0, m1);
    }
}
DI void phase_poolmean(const Params& p, int bid, int nblk, float* lds) {
    const bf16_t* proj = (const bf16_t*)(p.ws + OFF_PROJ); bf16_t* pm = (bf16_t*)(p.ws + OFF_PM);
    for (int item = bid * NT + threadIdx.x; item < 256 * (T / 32); item += nblk * NT) {
        const int pair = item & 255, t0 = (item >> 8) * 32, c2 = pair * 2, g = __builtin_amdgcn_readfirstlane(pair >> 6);
        if (g == 0) poolmean_item<2>(proj, pm, t0, c2);
        else if (g == 1) poolmean_item<4>(proj, pm, t0, c2);
        else if (g == 2) poolmean_item<8>(proj, pm, t0, c2);
        else poolmean_item<16>(proj, pm, t0, c2);
    }
}
DI void phase_pool(const Params& p, int bid, int nblk, float* lds) {
    const bf16_t* pm = (const bf16_t*)(p.ws + OFF_PM); bf16_t* mix = (bf16_t*)(p.ws + OFF_MIX);
    for (int u = bid; u < 64 * 4; u += nblk) {
        const int mt = u >> 2, g = u & 3;
        auto rowoff = [&](int r) { return (unsigned)((mt * 256 + r) * 512 + g * 128); };
        auto pre = [&](int r, int c, f32x4 v, f32x4) { const f32x4 sc = *(const f32x4*)(p.pool_scale + g * 128 + c); return v * sc; };
        auto fin = [&](int r, int c, u32x4 dv) { *(u32x4*)(mix + (size_t)(mt * 256 + r) * D + g * 128 + c) = dv; };
        gemm_mfma<false, false, 2, 128, 2>(pm, rowoff, p.pool_w + (size_t)g * 16384, nullptr, (unsigned)((4 - g) * 16384 * 4), 128, 256, pre, fin, (unsigned char*)lds);
    }
}

DI unsigned f1_off(unsigned row, unsigned chunk) { return row * 128u + ((chunk ^ ((row >> 1) & 7u)) << 4); }
DI unsigned f2_off(unsigned row, unsigned ch) { return 256u * row + 16u * (ch ^ (((row & 3u) << 2) | ((row >> 2) & 3u))); }
DI bf16x8 f1_frag(const unsigned char* img, int tile, int ks, int lane) { return *(const bf16x8*)(img + f1_off(16 * tile + (lane & 15), 4 * ks + (lane >> 4))); }
DI bf16x8 f2_frag(const unsigned char* img, int c, int ks, int lane) {
    const unsigned g = lane >> 4, q = (lane & 15) >> 2, pp = lane & 3;
    const unsigned a0 = f2_off(32 * ks + 8 * g + q, 2 * c + (pp >> 1)) + 8 * (pp & 1), a1 = f2_off(32 * ks + 8 * g + 4 + q, 2 * c + (pp >> 1)) + 8 * (pp & 1);
    const s16x4 lo = __builtin_amdgcn_ds_read_tr16_b64_v4i16((LAS3 s16x4*)(img + a0)), hi = __builtin_amdgcn_ds_read_tr16_b64_v4i16((LAS3 s16x4*)(img + a1));
    return __builtin_bit_cast(bf16x8, __builtin_shufflevector(lo, hi, 0, 1, 2, 3, 4, 5, 6, 7));
}
DI float bfbits2f(unsigned short v) { return __uint_as_float(((unsigned)v) << 16); }
typedef unsigned short u16x8 __attribute__((ext_vector_type(8)));
typedef unsigned short u16x4 __attribute__((ext_vector_type(4)));

DI void phase_gla1(const Params& p, int bid, int nblk, float* ldsf) {
    unsigned char* lds = (unsigned char*)ldsf;
    int tid_ = threadIdx.x; asm volatile("" : "+v"(tid_));
    const int tid = tid_, lane = tid & 63, w = __builtin_amdgcn_readfirstlane(tid >> 6), t = tid >> 3, ch = tid & 7;
    const bf16_t* proj = (const bf16_t*)(p.ws + OFF_PROJ); const float* glow = (const float*)(p.ws + OFF_GLOW);
    float* Gbuf = (float*)(p.ws + OFF_G); float* Sloc = (float*)(p.ws + OFF_SLOC); float* dec = (float*)(p.ws + OFF_DEC);
    float* G = (float*)lds; unsigned char* Kimg = lds + 16384; unsigned char* Vimg = lds + 32768; float* W2l = (float*)(lds + 49152); float* segtot = (float*)(lds + 53248);
    for (int unit = bid; unit < 1024; unit += nblk) {
        const int bh = unit >> 6, n = unit & 63, b = bh >> 2, h = bh & 3, t0 = b * SEQ + n * SC;
        for (int i = tid; i < 1024; i += NT) W2l[i] = p.gate_w2[(i >> 6) * 256 + h * 64 + (i & 63)];
#pragma unroll
        for (int i = 0; i < 2; ++i) { const int idx = tid + NT * i, tr = idx >> 4, c16 = idx & 15;
            *(u32x4*)(Vimg + f2_off(tr, c16)) = *(const u32x4*)(proj + (size_t)(t0 + tr) * NPROJ + V_OFF + h * 128 + 8 * c16); }
        __syncthreads();
        {
            float gl[16];
#pragma unroll
            for (int q = 0; q < 4; ++q) { const f32x4 v = *(const f32x4*)(glow + (size_t)(t0 + t) * 16 + 4 * q); gl[4 * q] = v[0]; gl[4 * q + 1] = v[1]; gl[4 * q + 2] = v[2]; gl[4 * q + 3] = v[3]; }
#pragma unroll
            for (int dd = 0; dd < 8; ++dd) { const int d = 8 * ch + dd; float z = p.gate_b[h * 64 + d];
#pragma unroll
                for (int r = 0; r < 16; ++r) z += gl[r] * W2l[r * 64 + d];
                G[t * 64 + d] = logsigmoidf_(z) * (1.f / 16.f); }
        }
        __syncthreads();
        {
            const int seg = tid >> 6, d = tid & 63; float run = 0.f;
#pragma unroll
            for (int tt = 0; tt < 8; ++tt) { run += G[(8 * seg + tt) * 64 + d]; G[(8 * seg + tt) * 64 + d] = run; }
            segtot[seg * 64 + d] = run;
            __syncthreads();
            float pre = 0.f;
            for (int s2 = 0; s2 < seg; ++s2) pre += segtot[s2 * 64 + d];
#pragma unroll
            for (int tt = 0; tt < 8; ++tt) G[(8 * seg + tt) * 64 + d] += pre;
        }
        __syncthreads();
        {
            const f32x4 g0 = *(const f32x4*)(G + t * 64 + 8 * ch), g1 = *(const f32x4*)(G + t * 64 + 8 * ch + 4);
            const f32x4 l0 = *(const f32x4*)(G + 63 * 64 + 8 * ch), l1 = *(const f32x4*)(G + 63 * 64 + 8 * ch + 4);
            *(f32x4*)(Gbuf + (size_t)(t0 + t) * 256 + h * 64 + 8 * ch) = g0; *(f32x4*)(Gbuf + (size_t)(t0 + t) * 256 + h * 64 + 8 * ch + 4) = g1;
            const u16x8 kv = *(const u16x8*)(proj + (size_t)(t0 + t) * NPROJ + K_OFF + h * 64 + 8 * ch);
            bf16x8 o;
#pragma unroll
            for (int dd = 0; dd < 4; ++dd) { o[dd] = (__bf16)(bfbits2f(kv[dd]) * __expf(l0[dd] - g0[dd])); o[dd + 4] = (__bf16)(bfbits2f(kv[dd + 4]) * __expf(l1[dd] - g1[dd])); }
            *(bf16x8*)(Kimg + f2_off(t, ch)) = o;
            if (t == 63) {
#pragma unroll
                for (int dd = 0; dd < 4; ++dd) { dec[unit * 64 + 8 * ch + dd] = __expf(l0[dd]); dec[unit * 64 + 8 * ch + 4 + dd] = __expf(l1[dd]); }
            }
        }
        __syncthreads();
        {
            f32x4 acc[4];
#pragma unroll
            for (int dt = 0; dt < 4; ++dt) acc[dt] = (f32x4){0.f, 0.f, 0.f, 0.f};
#pragma unroll
            for (int ks = 0; ks < 2; ++ks) {
                const bf16x8 xv = f2_frag(Vimg, w, ks, lane);
#pragma unroll
                for (int dt = 0; dt < 4; ++dt) acc[dt] = MFMA16(xv, f2_frag(Kimg, dt, ks, lane), acc[dt]);
            }
#pragma unroll
            for (int dt = 0; dt < 4; ++dt) *(f32x4*)(Sloc + (size_t)unit * 8192 + (16 * dt + (lane & 15)) * 128 + 16 * w + 4 * (lane >> 4)) = acc[dt];
        }
        __syncthreads();
    }
}

DI void phase_gla2(const Params& p, int bid, int nblk, float* lds) {
    const float* Sloc = (const float*)(p.ws + OFF_SLOC); const float* dec = (const float*)(p.ws + OFF_DEC); bf16_t* Sin = (bf16_t*)(p.ws + OFF_SIN);
    for (int gid = bid * NT + threadIdx.x; gid < 16 * 8192; gid += nblk * NT) {
        const int bh = gid >> 13, el = gid & 8191, d = el >> 7; float st = 0.f;
        for (int n0 = 0; n0 < NSC; n0 += 16) {
            float sl[16], dc[16]; bf16_t so[16];
#pragma unroll
            for (int i = 0; i < 16; ++i) { const int u = bh * 64 + n0 + i; sl[i] = Sloc[(size_t)u * 8192 + el]; dc[i] = dec[u * 64 + d]; }
#pragma unroll
            for (int i = 0; i < 16; ++i) { so[i] = f2bf(st); st = st * dc[i] + sl[i]; }
#pragma unroll
            for (int i = 0; i < 16; ++i) Sin[(size_t)(bh * 64 + n0 + i) * 8192 + el] = so[i];
        }
    }
}

DI void phase_gla3(const Params& p, int bid, int nblk, float* ldsf) {
    unsigned char* lds = (unsigned char*)ldsf;
    int tid_ = threadIdx.x; asm volatile("" : "+v"(tid_));
    const int tid = tid_, lane = tid & 63, w = __builtin_amdgcn_readfirstlane(tid >> 6), t = tid >> 3, ch = tid & 7, l15 = lane & 15, kg = lane >> 4;
    const bf16_t* proj = (const bf16_t*)(p.ws + OFF_PROJ); const float* Gbuf = (const float*)(p.ws + OFF_G); const bf16_t* Sin = (const bf16_t*)(p.ws + OFF_SIN);
    bf16_t* mix = (bf16_t*)(p.ws + OFF_MIX);
    unsigned char* Qimg = lds; unsigned char* Kimg = lds + 8192; unsigned char* Pimg = lds + 16384; unsigned char* Vimg = lds + 24576; unsigned char* Simg = lds + 40960;
    float* part = (float*)(lds + 57344);
    for (int unit = bid; unit < 1024; unit += nblk) {
        const int bh = unit >> 6, n = unit & 63, b = bh >> 2, h = bh & 3, t0 = b * SEQ + n * SC;
        {
            const f32x4 g0 = *(const f32x4*)(Gbuf + (size_t)(t0 + t) * 256 + h * 64 + 8 * ch), g1 = *(const f32x4*)(Gbuf + (size_t)(t0 + t) * 256 + h * 64 + 8 * ch + 4);
            const u16x8 qv = *(const u16x8*)(proj + (size_t)(t0 + t) * NPROJ + Q_OFF + h * 64 + 8 * ch), kv = *(const u16x8*)(proj + (size_t)(t0 + t) * NPROJ + K_OFF + h * 64 + 8 * ch);
            bf16x8 qo, ko;
#pragma unroll
            for (int dd = 0; dd < 4; ++dd) {
                qo[dd] = (__bf16)(bfbits2f(qv[dd]) * 0.125f * __expf(g0[dd])); qo[dd + 4] = (__bf16)(bfbits2f(qv[dd + 4]) * 0.125f * __expf(g1[dd]));
                ko[dd] = (__bf16)(bfbits2f(kv[dd]) * __expf(-g0[dd])); ko[dd + 4] = (__bf16)(bfbits2f(kv[dd + 4]) * __expf(-g1[dd]));
            }
            *(bf16x8*)(Qimg + f1_off(t, ch)) = qo; *(bf16x8*)(Kimg + f1_off(t, ch)) = ko;
        }
#pragma unroll
        for (int i = 0; i < 2; ++i) { const int idx = tid + NT * i, tr = idx >> 4, c16 = idx & 15;
            *(u32x4*)(Vimg + f2_off(tr, c16)) = *(const u32x4*)(proj + (size_t)(t0 + tr) * NPROJ + V_OFF + h * 128 + 8 * c16);
            *(u32x4*)(Simg + f2_off(tr, c16)) = *(const u32x4*)(Sin + (size_t)unit * 8192 + tr * 128 + 8 * c16); }
        __syncthreads();
        {
            const int it = w >> 1;
#pragma unroll
            for (int jj = 0; jj < 2; ++jj) {
                const int jt = 2 * (w & 1) + jj; f32x4 acc = {0.f, 0.f, 0.f, 0.f};
                if (jt <= it) {
#pragma unroll
                    for (int ks = 0; ks < 2; ++ks) acc = MFMA16(f1_frag(Kimg, jt, ks, lane), f1_frag(Qimg, it, ks, lane), acc);
                    if (jt == it) {
#pragma unroll
                        for (int r = 0; r < 4; ++r) if (4 * kg + r > l15) acc[r] = 0.f;
                    }
                }
                bf16x4 o; o[0] = (__bf16)acc[0]; o[1] = (__bf16)acc[1]; o[2] = (__bf16)acc[2]; o[3] = (__bf16)acc[3];
                *(bf16x4*)(Pimg + f1_off(16 * it + l15, 2 * jt + (kg >> 1)) + 8 * (kg & 1)) = o;
            }
        }
        __syncthreads();
        {
            f32x4 acc[4];
#pragma unroll
            for (int it = 0; it < 4; ++it) acc[it] = (f32x4){0.f, 0.f, 0.f, 0.f};
#pragma unroll
            for (int ks = 0; ks < 2; ++ks) {
                const bf16x8 xv = f2_frag(Vimg, w, ks, lane), xs = f2_frag(Simg, w, ks, lane);
#pragma unroll
                for (int it = 0; it < 4; ++it) {
                    if (2 * ks <= it) acc[it] = MFMA16(xv, f1_frag(Pimg, it, ks, lane), acc[it]);
                    acc[it] = MFMA16(xs, f1_frag(Qimg, it, ks, lane), acc[it]);
                }
            }
#pragma unroll
            for (int it = 0; it < 4; ++it) {
                float ss = acc[it][0] * acc[it][0] + acc[it][1] * acc[it][1] + acc[it][2] * acc[it][2] + acc[it][3] * acc[it][3];
                ss += __shfl_xor(ss, 16); ss += __shfl_xor(ss, 32);
                if (kg == 0) part[w * 64 + 16 * it + l15] = ss;
            }
            __syncthreads();
            const int e0 = 16 * w + 4 * kg; const f32x4 nw = *(const f32x4*)(p.norm_w + e0);
#pragma unroll
            for (int it = 0; it < 4; ++it) {
                const int i = 16 * it + l15; float tot = 0.f;
#pragma unroll
                for (int w2 = 0; w2 < 8; ++w2) tot += part[w2 * 64 + i];
                const float inv = rsqrtf(tot * (1.f / 128.f) + RMS_EPS);
                const u16x4 rv = *(const u16x4*)(proj + (size_t)(t0 + i) * NPROJ + R_OFF + h * 128 + e0);
                bf16x4 o;
#pragma unroll
                for (int r = 0; r < 4; ++r) { const float rr = bfbits2f(rv[r]); o[r] = (__bf16)(acc[it][r] * inv * nw[r] * (rr * sigmoidf_(rr))); }
                *(bf16x4*)(mix + (size_t)(t0 + i) * D + 512 + h * 128 + e0) = o;
            }
        }
        __syncthreads();
    }
}

DI void phase_out(const Params& p, int bid, int nblk, float* lds) {
    const bf16_t* mix = (const bf16_t*)(p.ws + OFF_MIX); float* h32 = (float*)(p.ws + OFF_H32);
    for (int u = bid; u < 64 * 4; u += nblk) {
        const int mt = (nblk == 256) ? 8 * (u & 7) + (u >> 5) : u >> 2, nt = (nblk == 256) ? (u >> 3) & 3 : u & 3;
        auto rowoff = [&](int r) { return (unsigned)((mt * 256 + r) * D); };
        auto fin = [&](int r, int c, u32x4 dv) { const size_t o = (size_t)(mt * 256 + r) * D + nt * 256 + c; const f32x4 xv = *(const f32x4*)(p.x + o); *(f32x4*)(h32 + o) = xv * ALPHA + __builtin_bit_cast(f32x4, dv); };
        gemm_mfma<false, true, 4, D, 4>(mix, rowoff, (const float*)((const bf16_t*)(p.ws + OFF_WB_OUT) + nt * 256), nullptr, (unsigned)(((size_t)D * D - nt * 256) * 2), D, 256, PRE_ID, fin, (unsigned char*)lds);
    }
}

DI void ln_row(float (&v)[16], const float* g, const float* b, int lane) {
    float s = 0.f;
#pragma unroll
    for (int i = 0; i < 16; ++i) s += v[i];
    const float mean = wave_sum(s) * (1.f / D); float q = 0.f;
#pragma unroll
    for (int i = 0; i < 16; ++i) { v[i] -= mean; q += v[i] * v[i]; }
    const float rstd = rsqrtf(wave_sum(q) * (1.f / D) + LN_EPS);
#pragma unroll
    for (int j = 0; j < 4; ++j) {
        const float4 gg = ((const float4*)g)[lane + 64 * j], bb = ((const float4*)b)[lane + 64 * j];
        v[4 * j] = v[4 * j] * rstd * gg.x + bb.x; v[4 * j + 1] = v[4 * j + 1] * rstd * gg.y + bb.y;
        v[4 * j + 2] = v[4 * j + 2] * rstd * gg.z + bb.z; v[4 * j + 3] = v[4 * j + 3] * rstd * gg.w + bb.w;
    }
}

DI void ln1_rows(const Params& p, int r0, int nrows) {
    int tid_ = threadIdx.x; asm volatile("" : "+v"(tid_));
    const int lane = tid_ & 63, wave = tid_ >> 6;
    float* h32 = (float*)(p.ws + OFF_H32); bf16_t* hb = (bf16_t*)(p.ws + OFF_HB);
    for (int row = r0 + wave; row < r0 + nrows; row += 8) {
        float4* hr = (float4*)(h32 + (size_t)row * D); float v[16];
#pragma unroll
        for (int j = 0; j < 4; ++j) { const float4 a = hr[lane + 64 * j]; v[4 * j] = a.x; v[4 * j + 1] = a.y; v[4 * j + 2] = a.z; v[4 * j + 3] = a.w; }
        ln_row(v, p.ln1_g, p.ln1_b, lane);
#pragma unroll
        for (int j = 0; j < 4; ++j) {
            uint2 o; o.x = pk2(v[4 * j], v[4 * j + 1]); o.y = pk2(v[4 * j + 2], v[4 * j + 3]);
            ((uint2*)(hb + (size_t)row * D))[lane + 64 * j] = o;
        }
    }
}

DI void topk_rows(const Params& p, int r0, int nrows) {
    int tid_ = threadIdx.x; asm volatile("" : "+v"(tid_));
    const int lane = tid_ & 63, wave = tid_ >> 6;
    const float* scores = (const float*)(p.ws + OFF_SCORES); float* wbuf = (float*)(p.ws + OFF_WBUF);
    int* list = (int*)(p.ws + OFF_LIST); unsigned* cnt = (unsigned*)(p.ws + OFF_CTL) + CW_CNT;
    const float NEG = -__builtin_inff();
    for (int t = r0 + wave; t < r0 + nrows; t += 8) {
        const float4 sv = ((const float4*)(scores + (size_t)t * NE))[lane], bv = ((const float4*)p.router_bias)[lane];
        const float s[4] = {sv.x, sv.y, sv.z, sv.w};
        float cand[4] = {sv.x + bv.x, sv.y + bv.y, sv.z + bv.z, sv.w + bv.w};
        float m1 = NEG, m2 = NEG;
#pragma unroll
        for (int j = 0; j < 4; ++j) { const float v = cand[j]; if (v > m1) { m2 = m1; m1 = v; } else if (v > m2) m2 = v; }
#pragma unroll
        for (int off = 1; off < 8; off <<= 1) {
            const float o1 = __shfl_xor(m1, off), o2 = __shfl_xor(m2, off);
            const float n1 = fmaxf(m1, o1), n2 = fmaxf(fminf(m1, o1), fmaxf(m2, o2)); m1 = n1; m2 = n2;
        }
        const float gs = m1 + m2; const int mygrp = lane >> 3; int rank = 0;
#pragma unroll
        for (int g2 = 0; g2 < 8; ++g2) { const float og = __shfl(gs, g2 * 8); if (og > gs || (og == gs && g2 < mygrp)) ++rank; }
        if (rank >= 4) { cand[0] = NEG; cand[1] = NEG; cand[2] = NEG; cand[3] = NEG; }
        int my_e = 0; float my_w = 0.f, wsum = 0.f;
#pragma unroll
        for (int k = 0; k < TOPK; ++k) {
            float bvv = cand[0]; int bj = 0;
#pragma unroll
            for (int j = 1; j < 4; ++j) if (cand[j] > bvv) { bvv = cand[j]; bj = j; }
            int bi = 4 * lane + bj;
#pragma unroll
            for (int off = 32; off >= 1; off >>= 1) {
                const float ov = __shfl_xor(bvv, off); const int oi = __shfl_xor(bi, off);
                if (ov > bvv || (ov == bvv && oi < bi)) { bvv = ov; bi = oi; }
            }
            const int wj = bi & 3, wl = bi >> 2;
            const float mys = wj == 0 ? s[0] : (wj == 1 ? s[1] : (wj == 2 ? s[2] : s[3]));
            const float wk = __shfl(mys, wl);
            wsum += wk;
            if (lane == k) { my_e = bi; my_w = wk; }
            if (lane == wl) {
#pragma unroll
                for (int j = 0; j < 4; ++j) if (j == wj) cand[j] = NEG;
            }
        }
        if (lane < TOPK) {
            const unsigned pos = atomicAdd(&cnt[my_e], 1u);
            list[(size_t)my_e * LCAP + pos] = t * TOPK + lane;
            wbuf[(size_t)t * TOPK + lane] = my_w / wsum * 2.5f;
        }
    }
}

DI void phase_route(const Params& p, int bid, int nblk, float* lds) {
    const bf16_t* hb = (const bf16_t*)(p.ws + OFF_HB); float* scores = (float*)(p.ws + OFF_SCORES);
    for (int mt = bid; mt < T / 64; mt += nblk) {
        ln1_rows(p, mt * 64, 64);
        __syncthreads();
        auto rowoff = [&](int r) { return (unsigned)((mt * 64 + r) * D); };
        auto pre = [&](int r, int c, f32x4 v, f32x4) { return (f32x4){sigmoidf_(v[0]), sigmoidf_(v[1]), sigmoidf_(v[2]), sigmoidf_(v[3])}; };
        auto fin = [&](int r, int c, u32x4 dv) { *(u32x4*)(scores + (size_t)(mt * 64 + r) * NE + c) = dv; };
        gemm_mfma<false, true, 4, NE, 4>(hb, rowoff, (const float*)(p.ws + OFF_WB_RT), nullptr, (unsigned)(D * NE * 2), D, 64, pre, fin, (unsigned char*)lds);
        __syncthreads();
        topk_rows(p, mt * 64, 64);
        __syncthreads();
    }
}

constexpr int EXP_TAB_OFF = GEMM_LDS_BYTES;
DI void build_tables(const Params& p, int* toff, int* roff) {
    const unsigned* cnt = (const unsigned*)(p.ws + OFF_CTL) + CW_CNT;
    int* cl = roff + 260;
    if (threadIdx.x < NE) cl[threadIdx.x] = (int)__hip_atomic_load(cnt + threadIdx.x, __ATOMIC_RELAXED, __HIP_MEMORY_SCOPE_AGENT);
    __syncthreads();
    if (threadIdx.x <= NE) {
        int ta = 0, ra = 0;
        for (int e = 0; e < (int)threadIdx.x; ++e) { const int c = cl[e]; ta += (c + 255) >> 8; ra += c; }
        toff[threadIdx.x] = ta; roff[threadIdx.x] = ra;
    }
    __syncthreads();
}
DI int find_expert(const int* toff, int tile) { int lo = 0, hi = NE - 1; while (lo < hi) { const int mid = (lo + hi + 1) >> 1; if (toff[mid] <= tile) lo = mid; else hi = mid - 1; } return lo; }
struct ExpUnit { int e, row0, rows, rowbase; };
DI ExpUnit exp_unit(const int* toff, const int* roff, int e, int tile, int ntile) {
    const int* cl = roff + 260;
    ExpUnit u;
    if (tile < ntile) {
        u.e = e; const int ui = tile - toff[e], c = cl[e];
        u.row0 = ui * 256; u.rows = min(256, c - u.row0); u.rowbase = roff[e] + u.row0;
    } else { u.e = NE; u.row0 = (tile - ntile) * 256; u.rows = 256; u.rowbase = A_TOT + u.row0; }
    u.e = __builtin_amdgcn_readfirstlane(u.e); u.row0 = __builtin_amdgcn_readfirstlane(u.row0); u.rows = __builtin_amdgcn_readfirstlane(u.rows);
    u.rowbase = __builtin_amdgcn_readfirstlane(u.rowbase);
    return u;
}

template <int NTL>
DI int exp_decode(const int* toff, int ntile, int u, int& tile, int& nt) {
    if (u < NTL * ntile) { const int e = find_expert(toff, u / NTL), ne = toff[e + 1] - toff[e], u2 = u - NTL * toff[e]; nt = u2 / ne; tile = toff[e] + (u2 - nt * ne); return e; }
    else { const int us = u - NTL * ntile; nt = us / (T / 256); tile = ntile + (us - nt * (T / 256)); return NE; }
}

DI void phase_e1(const Params& p, int bid, int nblk, float* lds) {
    int* toff = (int*)((unsigned char*)lds + EXP_TAB_OFF); int* roff = toff + 260;
    const bf16_t* hb = (const bf16_t*)(p.ws + OFF_HB); bf16_t* hid = (bf16_t*)(p.ws + OFF_HID); const int* list = (const int*)(p.ws + OFF_LIST);
    build_tables(p, toff, roff);
    const int ntile = toff[NE], units = (ntile + T / 256) * 2;
    const int vb = (nblk & 7) ? bid : (bid & 7) * (nblk >> 3) + (bid >> 3);
    u32x4 ra[2][2], rb[2][4]; unsigned ao[2] = {0u, 0u}; bool pre = false;
    int tile_n = 0, nt_n = 0; ExpUnit xn;
    if (vb < units) { const int e_ = exp_decode<2>(toff, ntile, vb, tile_n, nt_n); xn = exp_unit(toff, roff, e_, tile_n, ntile); }
    for (int u = vb; u < units; u += nblk) {
        const int nt = nt_n; const ExpUnit x = xn; const bool hn = u + nblk < units;
        if (hn) { const int e_ = exp_decode<2>(toff, ntile, u + nblk, tile_n, nt_n); xn = exp_unit(toff, roff, e_, tile_n, ntile); }
        const float* wg = x.e < NE ? p.wg + (size_t)x.e * 262144 : p.sg; const float* wu = x.e < NE ? p.wu + (size_t)x.e * 262144 : p.su;
        const float* wgn = xn.e < NE ? p.wg + (size_t)xn.e * 262144 : p.sg; const float* wun = xn.e < NE ? p.wu + (size_t)xn.e * 262144 : p.su;
        auto rowoff = [&](int r) { const int tok = x.e < NE ? (list[(size_t)x.e * LCAP + x.row0 + r] >> 3) : (x.row0 + r); return (unsigned)(tok * D); };
        auto rowoff_n = [&](int r) { const int tok = xn.e < NE ? (list[(size_t)xn.e * LCAP + xn.row0 + r] >> 3) : (xn.row0 + r); return (unsigned)(tok * D); };
        auto prf = [&](int r, int c, f32x4 g, f32x4 uu) { return (f32x4){g[0] * sigmoidf_(g[0]) * uu[0], g[1] * sigmoidf_(g[1]) * uu[1], g[2] * sigmoidf_(g[2]) * uu[2], g[3] * sigmoidf_(g[3]) * uu[3]}; };
        auto fin = [&](int r, int c, u32x4 dv) { *(u32x4*)(hid + (size_t)(x.rowbase + r) * EDIM + nt * 128 + c) = dv; };
        gemm_core<true, false, 2, EDIM, 4>(ra, rb, ao, pre, hb, rowoff, wg + nt * 128, wu + nt * 128, (unsigned)((D * EDIM - nt * 128) * 4), D, x.rows,
                                 hn, rowoff_n, wgn + nt_n * 128, wun + nt_n * 128, (unsigned)((D * EDIM - nt_n * 128) * 4), xn.rows, prf, fin, (unsigned char*)lds);
        pre = hn;
    }
}

DI void phase_e2(const Params& p, int bid, int nblk, float* lds) {
    int* toff = (int*)((unsigned char*)lds + EXP_TAB_OFF); int* roff = toff + 260; int* rowa = roff + 520;
    const bf16_t* hid = (const bf16_t*)(p.ws + OFF_HID); unsigned char* Y = p.ws + OFF_Y; const int* list = (const int*)(p.ws + OFF_LIST);
    build_tables(p, toff, roff);
    const int ntile = toff[NE], units = (ntile + T / 256) * 4;
    const int vb = (nblk & 7) ? bid : (bid & 7) * (nblk >> 3) + (bid >> 3);
    u32x4 ra[2][2], rb[2][4]; unsigned ao[2] = {0u, 0u}; bool pre = false;
    int tile_n = 0, nt_n = 0; ExpUnit xn;
    auto rowa_val = [&](const ExpUnit& q, int r) { return q.e < NE ? (r < q.rows ? list[(size_t)q.e * LCAP + q.row0 + r] : 0) : (A_TOT + q.row0 + r); };
    if (vb < units) { const int e_ = exp_decode<4>(toff, ntile, vb, tile_n, nt_n); xn = exp_unit(toff, roff, e_, tile_n, ntile); if (threadIdx.x < 256) rowa[threadIdx.x] = rowa_val(xn, threadIdx.x); }
    __syncthreads();
    int cur = 0;
    for (int u = vb; u < units; u += nblk) {
        const int nt = nt_n; const ExpUnit x = xn; const bool hn = u + nblk < units;
        if (hn) { const int e_ = exp_decode<4>(toff, ntile, u + nblk, tile_n, nt_n); xn = exp_unit(toff, roff, e_, tile_n, ntile); }
        const float* wd = x.e < NE ? p.wd + (size_t)x.e * 262144 : p.sd; const float* wdn = xn.e < NE ? p.wd + (size_t)xn.e * 262144 : p.sd;
        int rnext = 0;
        if (hn && threadIdx.x < 256) rnext = rowa_val(xn, threadIdx.x);
        const int* rowa_c = rowa + cur * 256;
        auto rowoff = [&](int r) { return (unsigned)((x.rowbase + r) * EDIM); };
        auto rowoff_n = [&](int r) { return (unsigned)((xn.rowbase + r) * EDIM); };
        auto fin = [&](int r, int c, u32x4 dv) { *(u32x4*)(Y + (size_t)rowa_c[r] * D + nt * 256 + c) = dv; };
        gemm_core<false, false, 1, D, 4>(ra, rb, ao, pre, hid, rowoff, wd + nt * 256, nullptr, (unsigned)((EDIM * D - nt * 256) * 4), EDIM, x.rows,
                               hn, rowoff_n, wdn + nt_n * 256, nullptr, (unsigned)((EDIM * D - nt_n * 256) * 4), xn.rows, PRE_ID, fin, (unsigned char*)lds);
        pre = hn;
        cur ^= 1;
        if (threadIdx.x < 256) rowa[cur * 256 + threadIdx.x] = rnext;
    }
}

DI void phase_combine(const Params& p, int bid, int nblk, float* lds) {
    const int lane = threadIdx.x & 63, wave = threadIdx.x >> 6;
    const bf16_t* hb = (const bf16_t*)(p.ws + OFF_HB); const unsigned char* Y = p.ws + OFF_Y; const float* wbuf = (const float*)(p.ws + OFF_WBUF);
    typedef float f32x2 __attribute__((ext_vector_type(2)));
    for (int t = bid * 8 + wave; t < T; t += nblk * 8) {
        float v[16];
#pragma unroll
        for (int j = 0; j < 4; ++j) { const uint2 a = ((const uint2*)(hb + (size_t)t * D))[lane + 64 * j];
            v[4 * j] = ALPHA * __uint_as_float(a.x << 16); v[4 * j + 1] = ALPHA * __uint_as_float(a.x & 0xffff0000u);
            v[4 * j + 2] = ALPHA * __uint_as_float(a.y << 16); v[4 * j + 3] = ALPHA * __uint_as_float(a.y & 0xffff0000u); }
#pragma unroll
        for (int k = 0; k < 9; ++k) {
            const size_t row = k < 8 ? (size_t)t * TOPK + k : (size_t)A_TOT + t; const float w = (k < 8 ? wbuf[(size_t)t * TOPK + k] : 1.f) * (1.f / 128.f);
#pragma unroll
            for (int j = 0; j < 4; ++j) {
                const int y = ((const int*)(Y + row * D))[lane + 64 * j];
                const f32x2 lo = __builtin_amdgcn_cvt_pk_f32_fp8(y, false), hi = __builtin_amdgcn_cvt_pk_f32_fp8(y, true);
                v[4 * j] += w * lo[0]; v[4 * j + 1] += w * lo[1]; v[4 * j + 2] += w * hi[0]; v[4 * j + 3] += w * hi[1];
            }
        }
        ln_row(v, p.ln2_g, p.ln2_b, lane);
#pragma unroll
        for (int j = 0; j < 4; ++j) ((float4*)(p.out + (size_t)t * D))[lane + 64 * j] = make_float4(v[4 * j], v[4 * j + 1], v[4 * j + 2], v[4 * j + 3]);
    }
}

#define LAS __attribute__((address_space(3)))
#define XB_TMO      128
#define XB_XCNT(j)  (256  + 64 * (j))
#define XB_XSUB(j)  (1280 + 64 * (j))
#define XB_XGEN(j)  (2304 + 64 * (j))
#define XB_TOP      3328
#define XB_TOPGEN   3392
#define XCD_BAR_WORDS 3456
#define XB_SPIN_CAP (1u << 22)
constexpr int CW_BAR = 4096;
DI unsigned xb_ld(unsigned* p) { return __hip_atomic_load(p, __ATOMIC_RELAXED, __HIP_MEMORY_SCOPE_AGENT); }
DI unsigned xb_add(unsigned* p, unsigned v) { return __hip_atomic_fetch_add(p, v, __ATOMIC_RELAXED, __HIP_MEMORY_SCOPE_AGENT); }
DI unsigned xb_xcc_id() { return (unsigned)__builtin_amdgcn_s_getreg((3 << 11) | 20) & 0xFu; }
#define XB_SPIN(cond, bar) do { unsigned _sp = 0; while (cond) { __builtin_amdgcn_s_sleep(1); \
    if ((++_sp & 255u) == 0u) { if (xb_ld(&(bar)[XB_TMO])) break; if (_sp > XB_SPIN_CAP) { atomicAdd(&(bar)[XB_TMO], 1u); break; } } } } while (0)
struct XcdBarrier { unsigned* bar; unsigned x; volatile LAS unsigned* st; };
DI XcdBarrier xcd_barrier_post(unsigned* bar, volatile LAS unsigned* st) {
    XcdBarrier b; b.bar = bar; b.x = xb_xcc_id(); b.st = st;
    if (threadIdx.x == 0) (void)xb_add(&bar[XB_XCNT(b.x)], 1u);
    return b;
}
DI void xcd_barrier_complete(unsigned* bar, unsigned x, unsigned& nloc, unsigned& nx) {
    const unsigned G = gridDim.x * gridDim.y * gridDim.z;
    unsigned sum, cnt, mine, sp = 0u;
    for (;;) {
        sum = 0u; cnt = 0u; mine = 0u;
#pragma unroll
        for (unsigned j = 0; j < 16; ++j) { const unsigned c = xb_ld(&bar[XB_XCNT(j)]); sum += c; cnt += (c > 0u) ? 1u : 0u; mine = (j == x) ? c : mine; }
        if (sum == G) break;
        __builtin_amdgcn_s_sleep(1);
        if ((++sp & 255u) == 0u) { if (xb_ld(&bar[XB_TMO])) break; if (sp > XB_SPIN_CAP) { atomicAdd(&bar[XB_TMO], 1u); break; } }
    }
    nloc = mine > 0u ? mine : 1u; nx = cnt > 0u ? cnt : 1u;
}
DI void xcd_barrier(const XcdBarrier& b) {
    asm volatile("s_waitcnt vmcnt(0)" ::: "memory");
    __syncthreads();
    if (threadIdx.x == 0) {
        unsigned* bar = b.bar;
        __builtin_amdgcn_s_waitcnt(0);
        unsigned nloc = b.st[0], nx = b.st[1];
        if (nloc == 0u) { xcd_barrier_complete(bar, b.x, nloc, nx); b.st[0] = nloc; b.st[1] = nx; }
        const unsigned old = xb_add(&bar[XB_XSUB(b.x)], 1u);
        const unsigned gen = old / nloc;
        if (old + 1u == (gen + 1u) * nloc) {
            __builtin_amdgcn_fence(__ATOMIC_RELEASE, "agent");
            asm volatile("s_waitcnt vmcnt(0)" ::: "memory");
            const unsigned og = xb_add(&bar[XB_TOP], 1u);
            const unsigned tg = og / nx;
            if (og + 1u == (tg + 1u) * nx) xb_add(&bar[XB_TOPGEN], 1u);
            else XB_SPIN(xb_ld(&bar[XB_TOPGEN]) == tg, bar);
            __builtin_amdgcn_fence(__ATOMIC_ACQUIRE, "agent");
            xb_add(&bar[XB_XGEN(b.x)], 1u);
            asm volatile("s_waitcnt vmcnt(0)" ::: "memory");
        } else {
            XB_SPIN(xb_ld(&bar[XB_XGEN(b.x)]) == gen, bar);
            __builtin_amdgcn_fence(__ATOMIC_ACQUIRE, "agent");
            asm volatile("s_waitcnt vmcnt(0)" ::: "memory");
        }
    }
    __syncthreads();
}

constexpr int LDS_BYTES = 136 * 1024;
constexpr int LDS_BAR_OFF = LDS_BYTES - 16;
__global__ void __launch_bounds__(NT) fwd_megakernel(Params p) {
    extern __shared__ __attribute__((aligned(16))) float lds[];
    const int bid = blockIdx.x, nblk = gridDim.x;
    volatile LAS unsigned* st = (volatile LAS unsigned*)((LAS unsigned char*)lds + LDS_BAR_OFF);
    if (threadIdx.x < 4) st[threadIdx.x] = 0u;
    __syncthreads();
    XcdBarrier bar = xcd_barrier_post((unsigned*)(p.ws + OFF_CTL) + CW_BAR, st);
    phase_prep(p, bid, nblk, lds);      xcd_barrier(bar);
    phase_proj(p, bid, nblk, lds);      xcd_barrier(bar);
    phase_poolmean(p, bid, nblk, lds);
    phase_gla1(p, bid, nblk, lds);      xcd_barrier(bar);
    phase_pool(p, bid, nblk, lds);
    phase_gla2(p, bid, nblk, lds);      xcd_barrier(bar);
    phase_gla3(p, bid, nblk, lds);      xcd_barrier(bar);
    phase_out(p, bid, nblk, lds);       xcd_barrier(bar);
    phase_route(p, bid, nblk, lds);     xcd_barrier(bar);
    phase_e1(p, bid, nblk, lds);        xcd_barrier(bar);
    phase_e2(p, bid, nblk, lds);        xcd_barrier(bar);
    phase_combine(p, bid, nblk, lds);
}

extern "C" void kernel_launch(void* const* d_in, const int* in_sizes, int n_in, void* d_out, int out_size, void* d_ws, size_t ws_size, hipStream_t stream) {
    static int grid = 0;
    if (grid == 0) {
        if (n_in != 20 || ws_size < WS_NEED) { fprintf(stderr, "kernel_launch: unexpected n_in %d or ws_size %zu (< %zu)\n", n_in, ws_size, (size_t)WS_NEED); grid = -1; return; }
        int dev = 0, cus = 0, per_cu = 0;
        (void)hipGetDevice(&dev); (void)hipDeviceGetAttribute(&cus, hipDeviceAttributeMultiprocessorCount, dev);
        (void)hipFuncSetAttribute((const void*)fwd_megakernel, hipFuncAttributeMaxDynamicSharedMemorySize, LDS_BYTES);
        (void)hipOccupancyMaxActiveBlocksPerMultiprocessor(&per_cu, (const void*)fwd_megakernel, NT, LDS_BYTES);
        if (per_cu < 1 || cus < 1) { fprintf(stderr, "kernel_launch: occupancy query says %d blocks/CU on %d CUs\n", per_cu, cus); grid = -1; return; }
        grid = cus;
    }
    if (grid < 0) return;
    (void)hipMemsetAsync((char*)d_ws + OFF_CTL, 0, 64 * 1024, stream);
    Params p{};
    const float** pp = (const float**)&p;
    for (int i = 0; i < 20; ++i) pp[i] = (const float*)d_in[i];
    p.out = (float*)d_out; p.ws = (unsigned char*)d_ws;
    void* args[] = {&p};
    hipError_t e = hipLaunchCooperativeKernel((const void*)fwd_megakernel, dim3(grid), dim3(NT), args, LDS_BYTES, stream);
    if (e != hipSuccess) fprintf(stderr, "cooperative launch failed: %s (grid %d)\n", hipGetErrorString(e), grid);
}
```

```cpp
#include <hip/hip_runtime.h>
#include <stdint.h>
#include <cstdio>

#define DI __device__ __forceinline__
typedef unsigned short bf16_t;

constexpr int T = 16384, D = 1024, SEQ = 4096;
constexpr int DIN = 2064, NPROJ = 2048;
constexpr int P_OFF = 0, Q_OFF = 512, K_OFF = 768, V_OFF = 1024, R_OFF = 1536, GL_OFF = 2048;
constexpr int SC = 64;
constexpr int NSC = SEQ / SC;
constexpr int NE = 256, TOPK = 8, EDIM = 256;
constexpr int A_TOT = T * TOPK;
constexpr int LCAP = T;
constexpr float ALPHA = 1.189207115002721f;
constexpr float LN_EPS = 1e-5f, RMS_EPS = 1e-5f;
constexpr int NT = 512;

constexpr size_t MiB = 1u << 20;
constexpr size_t OFF_CTL = 0;
constexpr size_t OFF_XB = 1 * MiB;
constexpr size_t OFF_GLOW = OFF_XB + 32 * MiB;
constexpr size_t OFF_PROJ = OFF_GLOW + 1 * MiB;
constexpr size_t OFF_G = OFF_PROJ + 64 * MiB;
constexpr size_t OFF_SLOC = OFF_G + 16 * MiB;
constexpr size_t OFF_DEC = OFF_SLOC + 32 * MiB;
constexpr size_t OFF_SIN = OFF_DEC + 1 * MiB;
constexpr size_t OFF_MIX = OFF_SIN + 32 * MiB;
constexpr size_t OFF_H32 = OFF_MIX + 32 * MiB;
constexpr size_t OFF_HB = OFF_H32 + 64 * MiB;
constexpr size_t OFF_SCORES = OFF_HB + 32 * MiB;
constexpr size_t OFF_WBUF = OFF_SCORES + 16 * MiB;
constexpr size_t OFF_LIST = OFF_WBUF + 1 * MiB;
constexpr size_t OFF_HID = OFF_LIST + 16 * MiB;
constexpr size_t OFF_Y = OFF_HID + 76 * MiB;
constexpr size_t OFF_PM = OFF_Y + 304 * MiB;
constexpr size_t OFF_WB_IN = OFF_PM + 16 * MiB;
constexpr size_t OFF_WB_OUT = OFF_WB_IN + 4 * MiB;
constexpr size_t OFF_WB_RT = OFF_WB_OUT + 2 * MiB;
constexpr size_t OFF_WB_SGU = OFF_WB_RT + 1 * MiB;
constexpr size_t OFF_WB_SD = OFF_WB_SGU + 1 * MiB;
constexpr size_t WS_NEED = OFF_WB_SD + 1 * MiB;
constexpr int CW_CNT = 1024;

struct Params {
    const float *x, *w_in, *gate_w2, *gate_b, *norm_w, *pool_w, *pool_scale, *w_out, *ln1_g, *ln1_b;
    const float *router_w, *router_bias, *wg, *wu, *wd, *sg, *su, *sd, *ln2_g, *ln2_b;
    float* out;
    unsigned char* ws;
};

DI float bf2f(bf16_t v) { return __uint_as_float(((unsigned)v) << 16); }
DI bf16_t f2bf(float f) { unsigned u = __float_as_uint(f); u += 0x7fffu + ((u >> 16) & 1u); return (bf16_t)(u >> 16); }
DI unsigned pk2(float lo, float hi) { return (unsigned)f2bf(lo) | ((unsigned)f2bf(hi) << 16); }
DI float wave_sum(float v) {
#pragma unroll
    for (int o = 1; o < 64; o <<= 1) v += __shfl_xor(v, o);
    return v;
}
DI float sigmoidf_(float v) { return 1.f / (1.f + __expf(-v)); }
DI float logsigmoidf_(float z) { return fminf(z, 0.f) - log1pf(__expf(-fabsf(z))); }

constexpr int GT_LDS_FLOATS = 16 * 132 + 2 * 16 * 68;
template <bool DUAL, class AF, class BF, class EPI>
DI void gemm_tile_valu(int K, const AF& af, const BF& bfn, const EPI& epi, float* lds) {
    float* As = lds; float* Bs = lds + 16 * 132; float* Bs2 = Bs + 16 * 68;
    const int tid = threadIdx.x, ty = tid >> 4, tx = tid & 15;
    float acc[4][4], acc2[4][4];
#pragma unroll
    for (int i = 0; i < 4; ++i)
#pragma unroll
        for (int j = 0; j < 4; ++j) { acc[i][j] = 0.f; acc2[i][j] = 0.f; }
    for (int k0 = 0; k0 < K; k0 += 16) {
#pragma unroll
        for (int i = 0; i < 4; ++i) { const int e = tid + 512 * i, r = e >> 4, kk = e & 15; As[kk * 132 + r] = af(r, k0 + kk); }
#pragma unroll
        for (int i = 0; i < 2; ++i) { const int e = tid + 512 * i, kk = e >> 6, c = e & 63; Bs[kk * 68 + c] = bfn(0, k0 + kk, c); if (DUAL) Bs2[kk * 68 + c] = bfn(1, k0 + kk, c); }
        __syncthreads();
#pragma unroll
        for (int kk = 0; kk < 16; ++kk) {
            const float4 a = *(const float4*)&As[kk * 132 + ty * 4];
            const float4 b = *(const float4*)&Bs[kk * 68 + tx * 4];
            const float av[4] = {a.x, a.y, a.z, a.w}, bv[4] = {b.x, b.y, b.z, b.w};
#pragma unroll
            for (int i = 0; i < 4; ++i)
#pragma unroll
                for (int j = 0; j < 4; ++j) acc[i][j] += av[i] * bv[j];
            if (DUAL) {
                const float4 b2 = *(const float4*)&Bs2[kk * 68 + tx * 4];
                const float b2v[4] = {b2.x, b2.y, b2.z, b2.w};
#pragma unroll
                for (int i = 0; i < 4; ++i)
#pragma unroll
                    for (int j = 0; j < 4; ++j) acc2[i][j] += av[i] * b2v[j];
            }
        }
        __syncthreads();
    }
#pragma unroll
    for (int i = 0; i < 4; ++i)
#pragma unroll
        for (int j = 0; j < 4; ++j) epi(ty * 4 + i, tx * 4 + j, acc[i][j], acc2[i][j]);
}


typedef __bf16 bf16x8 __attribute__((ext_vector_type(8)));
typedef __bf16 bf16x4 __attribute__((ext_vector_type(4)));
typedef short s16x4 __attribute__((ext_vector_type(4)));
typedef float f32x4 __attribute__((ext_vector_type(4)));
typedef unsigned u32x4 __attribute__((ext_vector_type(4)));
#define LAS3 __attribute__((address_space(3)))
DI const float* uniform_ptr(const float* p) {
    const unsigned long long v = (unsigned long long)p;
    const unsigned lo = __builtin_amdgcn_readfirstlane((unsigned)v), hi = __builtin_amdgcn_readfirstlane((unsigned)(v >> 32));
    return (const float*)(((unsigned long long)hi << 32) | lo);
}
#define MFMA16(a, b, c) __builtin_amdgcn_mfma_f32_16x16x32_bf16((a), (b), (c), 0, 0, 0)
constexpr int GEMM_LDS_BYTES = 131072;
DI unsigned a_swz(unsigned x) { return (0x78u >> (2u * x)) & 3u; }
struct GemmRegs { u32x4 ra[2][2], rb[2][4]; };
template <bool DUAL, bool BK16, int OUTB, int LDB, int WN, class RowFn, class RowFnN, class Pre, class Fin>
DI void gemm_core(u32x4 (&Rra)[2][2], u32x4 (&Rrb)[2][4], unsigned (&aoffc)[2], bool preloaded, const bf16_t* Ab, const RowFn& rowoff, const float* B0, const float* B1, unsigned bbytes, int K, int rows,
                  bool has_next, const RowFnN& rowoff_n, const float* B0n, const float* B1n, unsigned bbytes_n, int rows_n, const Pre& pre, const Fin& fin, unsigned char* lds) {
    int tid_ = threadIdx.x; asm volatile("" : "+v"(tid_));
    const int tid = tid_, lane = tid & 63, w = __builtin_amdgcn_readfirstlane(tid >> 6), wm = w >> 2, wn = w & 3, l15 = lane & 15, kg = lane >> 4, t256 = tid & 255;
    const bool active = wn < WN;
    const int nrow_w = min(max(rows - 128 * wm, 0), 128), ngrp = (((nrow_w + 15) >> 4) + 1) >> 1;
    unsigned aoff[2];
#pragma unroll
    for (int i = 0; i < 2; ++i) aoff[i] = preloaded ? aoffc[i] : (rowoff(min(128 * wm + (t256 >> 2) + 64 * i, rows - 1)) + (t256 & 3) * 8) * 2u;
    const __amdgpu_buffer_rsrc_t ar = __builtin_amdgcn_make_buffer_rsrc((void*)Ab, 0, 0x7fffffff, 0x00020000);
    const unsigned awr = (128 * wm + (t256 >> 2)) * 128 + ((((unsigned)(t256 & 3)) ^ (unsigned)((t256 >> 3) & 7)) << 4);
    constexpr int NB = BK16 ? 2 : 4;
    const float* bsrc = uniform_ptr(DUAL && !BK16 ? ((wn >> 1) ? B1 : B0) : B0);
    const __amdgpu_buffer_rsrc_t br = __builtin_amdgcn_make_buffer_rsrc((void*)bsrc, 0, bbytes, 0x00020000);
    const unsigned bvoff = BK16 ? (unsigned)(((lane >> 5) * LDB + (lane & 31) * 8) * 2) : (DUAL ? (unsigned)(((lane >> 5) * LDB + (lane & 31) * 4) * 4) : (unsigned)(lane * 16));
    const int krow0 = BK16 ? 16 * wm + 2 * wn : (DUAL ? 16 * wm + 8 * (wn & 1) : 16 * wm + wn);
    constexpr int KSTEP = BK16 ? 8 : (DUAL ? 2 : 4), ESZ = BK16 ? 2 : 4;
    unsigned aoff_n[2];
#pragma unroll
    for (int i = 0; i < 2; ++i) aoff_n[i] = has_next ? (rowoff_n(min(128 * wm + (t256 >> 2) + 64 * i, rows_n - 1)) + (t256 & 3) * 8) * 2u : aoff[i];
    const float* bsrc_n = uniform_ptr(has_next ? (DUAL && !BK16 ? ((wn >> 1) ? B1n : B0n) : B0n) : bsrc);
    const __amdgpu_buffer_rsrc_t br_n = __builtin_amdgcn_make_buffer_rsrc((void*)bsrc_n, 0, has_next ? bbytes_n : bbytes, 0x00020000);
    unsigned bwr[NB];
#pragma unroll
    for (int i = 0; i < NB; ++i) {
        const int kb = krow0 + KSTEP * i + ((BK16 || DUAL) ? (lane >> 5) : 0);
        const int n = BK16 ? 8 * (lane & 31) : (DUAL ? (wn >> 1) * 128 + 4 * (lane & 31) : 4 * lane);
        const unsigned I = n >> 7, ch = (n & 127) >> 3, half = BK16 ? 0u : (unsigned)((n >> 2) & 1), xx = ((kb & 3) << 2) | ((kb >> 2) & 3);
        bwr[i] = 32768u + I * 16384u + 256u * kb + 16u * (ch ^ xx) + 8u * half;
    }
    const unsigned ard = (128 * wm + l15) * 128 + ((((unsigned)kg) ^ (unsigned)((l15 >> 1) & 7)) << 4);
    unsigned trd0, trd1;
    {
        const unsigned q = l15 >> 2, pp = l15 & 3, cbase = (DUAL ? 4u * wn : 8u * (wn & 1)) + (pp >> 1), ibase = DUAL ? 0u : (unsigned)(wn >> 1);
        const unsigned x0 = (q << 2) | ((2u * kg) & 3u), x1 = (q << 2) | ((2u * kg + 1u) & 3u);
        trd0 = 32768u + ibase * 16384u + 256u * (8u * kg + q) + 16u * (cbase ^ x0) + 8u * (pp & 1);
        trd1 = 32768u + ibase * 16384u + 256u * (8u * kg + 4u + q) + 16u * (cbase ^ x1) + 8u * (pp & 1);
    }
    f32x4 acc[8][4];
#pragma unroll
    for (int i = 0; i < 8; ++i)
#pragma unroll
        for (int f = 0; f < 4; ++f) acc[i][f] = (f32x4){0.f, 0.f, 0.f, 0.f};
    const int nj = K / 32;
#define LOAD_SET(S, j) { _Pragma("unroll") for (int i = 0; i < 2; ++i) Rra[S][i] = __builtin_bit_cast(u32x4, __builtin_amdgcn_raw_buffer_load_b128(ar, aoff[i], (j) * 64, 0)); \
        _Pragma("unroll") for (int i = 0; i < NB; ++i) Rrb[S][i] = __builtin_bit_cast(u32x4, __builtin_amdgcn_raw_buffer_load_b128(br, bvoff, ((j) * 32 + krow0 + KSTEP * i) * (LDB * ESZ), 0)); }
#define LOAD_SET_N(S, j) { _Pragma("unroll") for (int i = 0; i < 2; ++i) Rra[S][i] = __builtin_bit_cast(u32x4, __builtin_amdgcn_raw_buffer_load_b128(ar, aoff_n[i], (j) * 64, 0)); \
        _Pragma("unroll") for (int i = 0; i < NB; ++i) Rrb[S][i] = __builtin_bit_cast(u32x4, __builtin_amdgcn_raw_buffer_load_b128(br_n, bvoff, ((j) * 32 + krow0 + KSTEP * i) * (LDB * ESZ), 0)); }
#define WRITE_SET(S, st, h) { _Pragma("unroll") for (int i = 0; i < 2; ++i) *(u32x4*)(lds + (st) * 65536 + (awr ^ ((h) ? 64u : 0u)) + i * 8192) = Rra[S][i]; \
        _Pragma("unroll") for (int i = 0; i < NB; ++i) { if (BK16) *(u32x4*)(lds + (st) * 65536 + (h) * 8192 + bwr[i]) = Rrb[S][i]; else { \
            const f32x4 v = __builtin_bit_cast(f32x4, Rrb[S][i]); bf16x4 o; o[0] = (__bf16)v[0]; o[1] = (__bf16)v[1]; o[2] = (__bf16)v[2]; o[3] = (__bf16)v[3]; \
            *(bf16x4*)(lds + (st) * 65536 + (h) * 8192 + ((!DUAL) ? ((bwr[0] ^ (unsigned)(i << 4)) + 1024u * i) : bwr[i])) = o; } } }
#define LOAD_SEL(S, jl) { const bool nx_ = (jl) >= nj; const int jt_ = nx_ ? (jl) - nj : (jl); \
        _Pragma("unroll") for (int i = 0; i < 2; ++i) Rra[S][i] = __builtin_bit_cast(u32x4, __builtin_amdgcn_raw_buffer_load_b128(ar, nx_ ? aoff_n[i] : aoff[i], jt_ * 64, 0)); \
        if (nx_) { _Pragma("unroll") for (int i = 0; i < NB; ++i) Rrb[S][i] = __builtin_bit_cast(u32x4, __builtin_amdgcn_raw_buffer_load_b128(br_n, bvoff, (jt_ * 32 + krow0 + KSTEP * i) * (LDB * ESZ), 0)); } \
        else { _Pragma("unroll") for (int i = 0; i < NB; ++i) Rrb[S][i] = __builtin_bit_cast(u32x4, __builtin_amdgcn_raw_buffer_load_b128(br, bvoff, (jt_ * 32 + krow0 + KSTEP * i) * (LDB * ESZ), 0)); } }
#define WRITE_A(S, st, h) { _Pragma("unroll") for (int i = 0; i < 2; ++i) *(u32x4*)(lds + (st) * 65536 + (awr ^ ((h) ? 64u : 0u)) + i * 8192) = Rra[S][i]; }
#define WRITE_B(S, st, h, I0, I1) { _Pragma("unroll") for (int i = (I0); i < (I1); ++i) { if (BK16) *(u32x4*)(lds + (st) * 65536 + (h) * 8192 + bwr[i]) = Rrb[S][i]; else { \
            const f32x4 v = __builtin_bit_cast(f32x4, Rrb[S][i]); bf16x4 o; o[0] = (__bf16)v[0]; o[1] = (__bf16)v[1]; o[2] = (__bf16)v[2]; o[3] = (__bf16)v[3]; \
            *(bf16x4*)(lds + (st) * 65536 + (h) * 8192 + ((!DUAL) ? ((bwr[0] ^ (unsigned)(i << 4)) + 1024u * i) : bwr[i])) = o; } } }
#define LOAD_A(S, jl) { const bool nx_ = (jl) >= nj; const int jt_ = nx_ ? (jl) - nj : (jl); \
        _Pragma("unroll") for (int i = 0; i < 2; ++i) Rra[S][i] = __builtin_bit_cast(u32x4, __builtin_amdgcn_raw_buffer_load_b128(ar, nx_ ? aoff_n[i] : aoff[i], jt_ * 64, 0)); }
#define LOAD_B(S, jl) { const bool nx_ = (jl) >= nj; const int jt_ = nx_ ? (jl) - nj : (jl); \
        if (nx_) { _Pragma("unroll") for (int i = 0; i < NB; ++i) Rrb[S][i] = __builtin_bit_cast(u32x4, __builtin_amdgcn_raw_buffer_load_b128(br_n, bvoff, (jt_ * 32 + krow0 + KSTEP * i) * (LDB * ESZ), 0)); } \
        else { _Pragma("unroll") for (int i = 0; i < NB; ++i) Rrb[S][i] = __builtin_bit_cast(u32x4, __builtin_amdgcn_raw_buffer_load_b128(br, bvoff, (jt_ * 32 + krow0 + KSTEP * i) * (LDB * ESZ), 0)); } }
#define TF_LOAD(dst, st, h, g) { _Pragma("unroll") for (int q_ = 0; q_ < 2; ++q_) dst[q_] = *(const bf16x8*)(lds + (st) * 65536 + ((g) * 2 + q_) * 2048 + (ard ^ ((h) ? 64u : 0u))); }
#define WF_LOAD(st, h) { _Pragma("unroll") for (int f = 0; f < 4; ++f) { \
        const unsigned fx = DUAL ? ((f & 1) << 5) : (f << 5), fo = (DUAL ? (f >> 1) * 16384 : 0) + (st) * 65536 + (h) * 8192; \
        const s16x4 lo = __builtin_amdgcn_ds_read_tr16_b64_v4i16((LAS3 s16x4*)(lds + ((trd0 ^ fx) + fo))); \
        const s16x4 hi = __builtin_amdgcn_ds_read_tr16_b64_v4i16((LAS3 s16x4*)(lds + ((trd1 ^ fx) + fo))); \
        wf[f] = __builtin_bit_cast(bf16x8, __builtin_shufflevector(lo, hi, 0, 1, 2, 3, 4, 5, 6, 7)); } }
#define STAGE_MMA(srcf, g) { _Pragma("unroll") for (int q_ = 0; q_ < 2; ++q_) _Pragma("unroll") for (int f = 0; f < 4; ++f) acc[(g) * 2 + q_][f] = MFMA16(wf[f], srcf[q_], acc[(g) * 2 + q_][f]); }
#define STAGE(st, h, g, cur, nxt) if ((g) < ngrp) { \
        if ((g) + 1 < 4 && (g) + 1 < ngrp) TF_LOAD(nxt, st, h, (g) + 1) \
        __builtin_amdgcn_sched_barrier(0); \
        STAGE_MMA(cur, g) \
        __builtin_amdgcn_sched_barrier(0); }
    const bool comp = active && ngrp > 0;
    bf16x8 fa[2], fb[2], wf[4];
#define HALF_MMA(st, h) if (comp) { STAGE(st, h, 0, fa, fb) STAGE(st, h, 1, fb, fa) STAGE(st, h, 2, fa, fb) STAGE(st, h, 3, fb, fa) }
#define SLOT(st, h, g, cur, nxt, PIECE) { if (comp && (g) < ngrp) { if ((g) + 1 < 4 && (g) + 1 < ngrp) TF_LOAD(nxt, st, h, (g) + 1) } \
        PIECE \
        __builtin_amdgcn_sched_barrier(0); \
        if (comp && (g) < ngrp) { STAGE_MMA(cur, g) } \
        __builtin_amdgcn_sched_barrier(0); }
#define HALF_SLOTS(st, h, S, jl) { SLOT(st, h, 0, fa, fb, WRITE_A(S, (st) ^ 1, h) LOAD_A(S, jl)) SLOT(st, h, 1, fb, fa, WRITE_B(S, (st) ^ 1, h, 0, NB / 2)) \
        SLOT(st, h, 2, fa, fb, WRITE_B(S, (st) ^ 1, h, NB / 2, NB)) SLOT(st, h, 3, fb, fa, LOAD_B(S, jl)) }
#define PREFETCH(st, h) if (comp) { WF_LOAD(st, h) TF_LOAD(fa, st, h, 0) }
    const int nJ = K / 64;
    if (!preloaded) { LOAD_SET(0, 0) LOAD_SET(1, 1) }
    WRITE_SET(0, 0, 0) WRITE_SET(1, 0, 1)
    LOAD_SEL(0, 2) LOAD_SEL(1, 3)
    __syncthreads();
    int st = 0;
#pragma unroll 1
    for (int J = 0; J < nJ - 1; ++J) {
        PREFETCH(st, 0)
        HALF_SLOTS(st, 0, 0, 2 * J + 4)
        PREFETCH(st, 1)
        HALF_SLOTS(st, 1, 1, 2 * J + 5)
        __syncthreads();
        st ^= 1;
    }
    {
        PREFETCH(st, 0)
        HALF_MMA(st, 0)
        PREFETCH(st, 1)
        HALF_MMA(st, 1)
        __syncthreads();
    }
#undef HALF_MMA
#undef SLOT
#undef HALF_SLOTS
#undef WRITE_A
#undef WRITE_B
#undef LOAD_A
#undef LOAD_B
#undef PREFETCH
#undef LOAD_SET
#undef LOAD_SET_N
#undef LOAD_SEL
#undef WRITE_SET
#undef TF_LOAD
#undef WF_LOAD
#undef STAGE_MMA
#undef STAGE
    aoffc[0] = aoff_n[0]; aoffc[1] = aoff_n[1];
    {
        constexpr int NF = DUAL ? 2 : 4, ROWB = NF * 16 * OUTB, NCH = ROWB / 16, RPR = (8192 / ROWB) < 128 ? (8192 / ROWB) : 128, RPI = 64 / NCH, NROUND = 128 / RPR;
        constexpr float FP8_SCALE = 128.f;
        unsigned char* stg = lds + w * 8192;
        int l15e = l15; asm volatile("" : "+v"(l15e));
        const int colbase = (DUAL ? 32 : 64) * wn;
#pragma unroll
        for (int rd = 0; rd < NROUND; ++rd) {
            if (active) {
#pragma unroll
                for (int mt = rd * (RPR / 16); mt < (rd + 1) * (RPR / 16); ++mt) {
                    if ((mt >> 1) < ngrp) {
                        const int rloc = mt * 16 - rd * RPR + l15e, row = 128 * wm + mt * 16 + l15e;
#pragma unroll
                        for (int f = 0; f < NF; ++f) {
                            const f32x4 v = DUAL ? pre(row, colbase + 16 * f + 4 * kg, acc[mt][f], acc[mt][f + 2]) : pre(row, colbase + 16 * f + 4 * kg, acc[mt][f], acc[mt][f]);
                            if (OUTB == 4) *(f32x4*)(stg + rloc * ROWB + ((((unsigned)(4 * f + kg)) ^ (unsigned)(rloc & (NCH - 1))) << 4)) = v;
                            else if (OUTB == 2) { bf16x4 o; o[0] = (__bf16)v[0]; o[1] = (__bf16)v[1]; o[2] = (__bf16)v[2]; o[3] = (__bf16)v[3];
                                *(bf16x4*)(stg + rloc * ROWB + ((((unsigned)(2 * f + (kg >> 1))) ^ (unsigned)(rloc & (NCH - 1))) << 4) + 8 * (kg & 1)) = o; }
                            else { int pk = 0; pk = __builtin_amdgcn_cvt_pk_fp8_f32(v[0] * FP8_SCALE, v[1] * FP8_SCALE, pk, false); pk = __builtin_amdgcn_cvt_pk_fp8_f32(v[2] * FP8_SCALE, v[3] * FP8_SCALE, pk, true);
                                *(int*)(stg + rloc * ROWB + ((((unsigned)f) ^ (unsigned)(rloc & (NCH - 1))) << 4) + 4 * kg) = pk; }
                        }
                    }
                }
                asm volatile("s_waitcnt lgkmcnt(0)" ::: "memory");
#pragma unroll
                for (int it = 0; it < RPR / RPI; ++it) {
                    const int rloc = it * RPI + lane / NCH, c = lane % NCH, row = 128 * wm + rd * RPR + rloc;
                    const u32x4 dv = *(const u32x4*)(stg + rloc * ROWB + ((((unsigned)c) ^ (unsigned)(rloc & (NCH - 1))) << 4));
                    if (row < rows) fin(row, colbase + c * (16 / OUTB), dv);
                }
                asm volatile("s_waitcnt lgkmcnt(0)" ::: "memory");
            }
        }
    }
    __syncthreads();
}

template <bool DUAL, bool BK16, int OUTB, int LDB, int WN, class RowFn, class Pre, class Fin>
DI void gemm_mfma(const bf16_t* Ab, const RowFn& rowoff, const float* B0, const float* B1, unsigned bbytes, int K, int rows, const Pre& pre, const Fin& fin, unsigned char* lds) {
    u32x4 ra[2][2], rb[2][4]; unsigned ao[2] = {0u, 0u};
    gemm_core<DUAL, BK16, OUTB, LDB, WN>(ra, rb, ao, false, Ab, rowoff, B0, B1, bbytes, K, rows, false, rowoff, B0, B1, bbytes, rows, pre, fin, lds);
}
#define PRE_ID [](int, int, f32x4 v, f32x4) { return v; }

DI void phase_prep(const Params& p, int bid, int nblk, float* lds) {
    const int tid = threadIdx.x, lane = tid & 63, wave = tid >> 6;
    bf16_t* xb = (bf16_t*)(p.ws + OFF_XB); float* glow = (float*)(p.ws + OFF_GLOW);
    float tw = 0.f;
    {
        const int ti = (bid >> 3) * NT + tid;
        if (ti < 1536) { const int m = ti >> 9, j = ti & 511; const float* bp = m == 0 ? p.wg : (m == 1 ? p.wu : p.wd); tw = bp[(size_t)j * 131072]; }
    }
    f32x4* Wl = (f32x4*)lds;
    for (int idx = tid; idx < 4096; idx += NT) {
        const int k = idx >> 2, q = idx & 3, ln = (k >> 2) & 63, j = k >> 8, c = k & 3;
        Wl[((j * 4 + c) * 4 + q) * 64 + ln] = *(const f32x4*)(p.w_in + (size_t)k * DIN + GL_OFF + 4 * q);
    }
    __syncthreads();
    for (int row0 = (bid * 8 + wave) * 4; row0 < T; row0 += nblk * 32) {
        asm volatile("" ::: "memory");
        f32x4 xv[4][4];
#pragma unroll
        for (int r = 0; r < 4; ++r)
#pragma unroll
            for (int j = 0; j < 4; ++j) {
                xv[r][j] = ((const f32x4*)(p.x + (size_t)(row0 + r) * D))[lane + 64 * j];
                uint2 o; o.x = pk2(xv[r][j][0], xv[r][j][1]); o.y = pk2(xv[r][j][2], xv[r][j][3]);
                ((uint2*)(xb + (size_t)(row0 + r) * D))[lane + 64 * j] = o;
            }
        float acc[4][16];
#pragma unroll
        for (int r = 0; r < 4; ++r)
#pragma unroll
            for (int n = 0; n < 16; ++n) acc[r][n] = 0.f;
#pragma unroll
        for (int j = 0; j < 4; ++j)
#pragma unroll
            for (int c = 0; c < 4; ++c) {
                float wv[16];
#pragma unroll
                for (int q = 0; q < 4; ++q) { const f32x4 w4 = Wl[((j * 4 + c) * 4 + q) * 64 + lane]; wv[4 * q] = w4[0]; wv[4 * q + 1] = w4[1]; wv[4 * q + 2] = w4[2]; wv[4 * q + 3] = w4[3]; }
#pragma unroll
                for (int r = 0; r < 4; ++r) {
                    const float xs = xv[r][j][c];
#pragma unroll
                    for (int n = 0; n < 16; ++n) acc[r][n] += xs * wv[n];
                }
            }
#define RS_STEP(N, OFF) { const bool up = (lane & (OFF)) != 0; _Pragma("unroll") for (int i = 0; i < (N); ++i) { \
            const float a = acc[i / 16][i % 16], b = acc[(i + (N)) / 16][(i + (N)) % 16]; const float snd = up ? a : b, kp = up ? b : a; \
            acc[i / 16][i % 16] = kp + __shfl_xor(snd, (OFF)); } }
        RS_STEP(32, 32) RS_STEP(16, 16) RS_STEP(8, 8) RS_STEP(4, 4) RS_STEP(2, 2) RS_STEP(1, 1)
#undef RS_STEP
        glow[(size_t)row0 * 16 + lane] = acc[0][0];
    }
    {
        bf16_t* wbin = (bf16_t*)(p.ws + OFF_WB_IN); bf16_t* wbout = (bf16_t*)(p.ws + OFF_WB_OUT); bf16_t* wbrt = (bf16_t*)(p.ws + OFF_WB_RT);
        bf16_t* wbsgu = (bf16_t*)(p.ws + OFF_WB_SGU); bf16_t* wbsd = (bf16_t*)(p.ws + OFF_WB_SD);
        constexpr int N_IN = 1024 * 512, N_OUT = 1024 * 256, N_RT = 1024 * 64, N_SGU = 1024 * 128, N_SD = 256 * 256;
        for (int it = bid * NT + tid; it < N_IN + N_OUT + N_RT + N_SGU + N_SD; it += nblk * NT) {
            const float* s; bf16_t* d; int r = it;
            if (r < N_IN) { const int k = r >> 9, c = (r & 511) * 4; s = p.w_in + (size_t)k * DIN + c; d = wbin + (size_t)k * 2048 + c; }
            else if ((r -= N_IN) < N_OUT) { s = p.w_out + (size_t)r * 4; d = wbout + (size_t)r * 4; }
            else if ((r -= N_OUT) < N_RT) { s = p.router_w + (size_t)r * 4; d = wbrt + (size_t)r * 4; }
            else if ((r -= N_RT) < N_SGU) { const int k = r >> 7, c = (r & 127) * 4, nt = c >> 8, h = (c >> 7) & 1, cc = c & 127; s = (h ? p.su : p.sg) + (size_t)k * EDIM + nt * 128 + cc; d = wbsgu + (size_t)k * 512 + c; }
            else { r -= N_SGU; s = p.sd + (size_t)r * 4; d = wbsd + (size_t)r * 4; }
            const f32x4 v = *(const f32x4*)s; uint2 o; o.x = pk2(v[0], v[1]); o.y = pk2(v[2], v[3]); *(uint2*)d = o;
        }
    }
    asm volatile("" :: "v"(tw));
    __syncthreads();
}

DI void phase_proj(const Params& p, int bid, int nblk, float* lds) {
    const bf16_t* xb = (const bf16_t*)(p.ws + OFF_XB); bf16_t* proj = (bf16_t*)(p.ws + OFF_PROJ); const bf16_t* wbin = (const bf16_t*)(p.ws + OFF_WB_IN);
    u32x4 ra[2][2], rb[2][4]; unsigned ao[2] = {0u, 0u}; bool pre = false;
    const bool xl = (nblk == 256);
    for (int u = bid; u < 64 * 8; u += nblk) {
        const int un = u + nblk; const bool hn = un < 64 * 8;
        const int mt = xl ? 32 * (u >> 8) + 4 * (u & 7) + ((u & 255) >> 6) : u >> 3, nt = xl ? ((u & 255) >> 3) & 7 : u & 7;
        const int mtn = xl ? 32 * (un >> 8) + 4 * (un & 7) + ((un & 255) >> 6) : un >> 3, ntn = xl ? ((un & 255) >> 3) & 7 : un & 7;
        auto rowoff = [&](int r) { return (unsigned)((mt * 256 + r) * D); };
        auto rowoff_n = [&](int r) { return (unsigned)((mtn * 256 + r) * D); };
        auto fin = [&](int r, int c, u32x4 dv) { *(u32x4*)(proj + (size_t)(mt * 256 + r) * NPROJ + nt * 256 + c) = dv; };
        gemm_core<false, true, 2, NPROJ, 4>(ra, rb, ao, pre, xb, rowoff, (const float*)(wbin + nt * 256), nullptr, (unsigned)(((size_t)D * NPROJ - nt * 256) * 2), D, 256,
                                 hn, rowoff_n, (const float*)(wbin + ntn * 256), nullptr, (unsigned)(((size_t)D * NPROJ - ntn * 256) * 2), 256, PRE_ID, fin, (unsigned char*)lds);
        pre = hn;
    }
}

template <int W>
DI void poolmean_item(const bf16_t* proj, bf16_t* pm, int t0, int c2) {
    const int s0 = t0 & (SEQ - 1);
    float p0[48], p1[48]; unsigned raw[32];
    p0[0] = 0.f; p1[0] = 0.f;
#pragma unroll
    for (int i = 0; i < 47; ++i) {
        unsigned v = 0u;
        if (i >= 15 || s0 > 0) v = *(const unsigned*)(proj + (size_t)(t0 - 15 + i) * NPROJ + P_OFF + c2);
        if (i >= 15) raw[i - 15] = v;
        p0[i + 1] = p0[i] + __uint_as_float(v << 16); p1[i + 1] = p1[i] + __uint_as_float(v & 0xffff0000u);
    }
#pragma unroll
    for (int i = 0; i < 32; ++i) {
        const int s = s0 + i; const float inv = 1.f / (float)min(s + 1, W);
        const float m0 = (p0[i + 16] - p0[i + 16 - W]) * inv - __uint_as_float(raw[i] << 16);
        const float m1 = (p1[i + 16] - p1[i + 16 - W]) * inv - __uint_as_float(raw[i] & 0xffff0000u);
        *(unsigned*)(pm + (size_t)(t0 + i) * 512 + c2) = pk2(m0, m1);
    }
}
DI void phase_poolmean(const Params& p, int bid, int nblk, float* lds) {
    const bf16_t* proj = (const bf16_t*)(p.ws + OFF_PROJ); bf16_t* pm = (bf16_t*)(p.ws + OFF_PM);
    for (int item = bid * NT + threadIdx.x; item < 256 * (T / 32); item += nblk * NT) {
        const int pair = item & 255, t0 = (item >> 8) * 32, c2 = pair * 2, g = __builtin_amdgcn_readfirstlane(pair >> 6);
        if (g == 0) poolmean_item<2>(proj, pm, t0, c2);
        else if (g == 1) poolmean_item<4>(proj, pm, t0, c2);
        else if (g == 2) poolmean_item<8>(proj, pm, t0, c2);
        else poolmean_item<16>(proj, pm, t0, c2);
    }
}
DI void phase_pool(const Params& p, int bid, int nblk, float* lds) {
    const bf16_t* pm = (const bf16_t*)(p.ws + OFF_PM); bf16_t* mix = (bf16_t*)(p.ws + OFF_MIX);
    for (int u = bid; u < 64 * 4; u += nblk) {
        const int mt = u >> 2, g = u & 3;
        auto rowoff = [&](int r) { return (unsigned)((mt * 256 + r) * 512 + g * 128); };
        auto pre = [&](int r, int c, f32x4 v, f32x4) { const f32x4 sc = *(const f32x4*)(p.pool_scale + g * 128 + c); return v * sc; };
        auto fin = [&](int r, int c, u32x4 dv) { *(u32x4*)(mix + (size_t)(mt * 256 + r) * D + g * 128 + c) = dv; };
        gemm_mfma<false, false, 2, 128, 2>(pm, rowoff, p.pool_w + (size_t)g * 16384, nullptr, (unsigned)((4 - g) * 16384 * 4), 128, 256, pre, fin, (unsigned char*)lds);
    }
}

DI unsigned f1_off(unsigned row, unsigned chunk) { return row * 128u + ((chunk ^ ((row >> 1) & 7u)) << 4); }
DI unsigned f2_off(unsigned row, unsigned ch) { return 256u * row + 16u * (ch ^ (((row & 3u) << 2) | ((row >> 2) & 3u))); }
DI bf16x8 f1_frag(const unsigned char* img, int tile, int ks, int lane) { return *(const bf16x8*)(img + f1_off(16 * tile + (lane & 15), 4 * ks + (lane >> 4))); }
DI bf16x8 f2_frag(const unsigned char* img, int c, int ks, int lane) {
    const unsigned g = lane >> 4, q = (lane & 15) >> 2, pp = lane & 3;
    const unsigned a0 = f2_off(32 * ks + 8 * g + q, 2 * c + (pp >> 1)) + 8 * (pp & 1), a1 = f2_off(32 * ks + 8 * g + 4 + q, 2 * c + (pp >> 1)) + 8 * (pp & 1);
    const s16x4 lo = __builtin_amdgcn_ds_read_tr16_b64_v4i16((LAS3 s16x4*)(img + a0)), hi = __builtin_amdgcn_ds_read_tr16_b64_v4i16((LAS3 s16x4*)(img + a1));
    return __builtin_bit_cast(bf16x8, __builtin_shufflevector(lo, hi, 0, 1, 2, 3, 4, 5, 6, 7));
}
DI float bfbits2f(unsigned short v) { return __uint_as_float(((unsigned)v) << 16); }
typedef unsigned short u16x8 __attribute__((ext_vector_type(8)));
typedef unsigned short u16x4 __attribute__((ext_vector_type(4)));

DI void phase_gla1(const Params& p, int bid, int nblk, float* ldsf) {
    unsigned char* lds = (unsigned char*)ldsf;
    int tid_ = threadIdx.x; asm volatile("" : "+v"(tid_));
    const int tid = tid_, lane = tid & 63, w = __builtin_amdgcn_readfirstlane(tid >> 6), t = tid >> 3, ch = tid & 7;
    const bf16_t* proj = (const bf16_t*)(p.ws + OFF_PROJ); const float* glow = (const float*)(p.ws + OFF_GLOW);
    float* Gbuf = (float*)(p.ws + OFF_G); float* Sloc = (float*)(p.ws + OFF_SLOC); float* dec = (float*)(p.ws + OFF_DEC);
    float* G = (float*)lds; unsigned char* Kimg = lds + 16384; unsigned char* Vimg = lds + 32768; float* W2l = (float*)(lds + 49152); float* segtot = (float*)(lds + 53248);
    for (int unit = bid; unit < 1024; unit += nblk) {
        const int bh = unit >> 6, n = unit & 63, b = bh >> 2, h = bh & 3, t0 = b * SEQ + n * SC;
        for (int i = tid; i < 1024; i += NT) W2l[i] = p.gate_w2[(i >> 6) * 256 + h * 64 + (i & 63)];
#pragma unroll
        for (int i = 0; i < 2; ++i) { const int idx = tid + NT * i, tr = idx >> 4, c16 = idx & 15;
            *(u32x4*)(Vimg + f2_off(tr, c16)) = *(const u32x4*)(proj + (size_t)(t0 + tr) * NPROJ + V_OFF + h * 128 + 8 * c16); }
        __syncthreads();
        {
            float gl[16];
#pragma unroll
            for (int q = 0; q < 4; ++q) { const f32x4 v = *(const f32x4*)(glow + (size_t)(t0 + t) * 16 + 4 * q); gl[4 * q] = v[0]; gl[4 * q + 1] = v[1]; gl[4 * q + 2] = v[2]; gl[4 * q + 3] = v[3]; }
#pragma unroll
            for (int dd = 0; dd < 8; ++dd) { const int d = 8 * ch + dd; float z = p.gate_b[h * 64 + d];
#pragma unroll
                for (int r = 0; r < 16; ++r) z += gl[r] * W2l[r * 64 + d];
                G[t * 64 + d] = logsigmoidf_(z) * (1.f / 16.f); }
        }
        __syncthreads();
        {
            const int seg = tid >> 6, d = tid & 63; float run = 0.f;
#pragma unroll
            for (int tt = 0; tt < 8; ++tt) { run += G[(8 * seg + tt) * 64 + d]; G[(8 * seg + tt) * 64 + d] = run; }
            segtot[seg * 64 + d] = run;
            __syncthreads();
            float pre = 0.f;
            for (int s2 = 0; s2 < seg; ++s2) pre += segtot[s2 * 64 + d];
#pragma unroll
            for (int tt = 0; tt < 8; ++tt) G[(8 * seg + tt) * 64 + d] += pre;
        }
        __syncthreads();
        {
            const f32x4 g0 = *(const f32x4*)(G + t * 64 + 8 * ch), g1 = *(const f32x4*)(G + t * 64 + 8 * ch + 4);
            const f32x4 l0 = *(const f32x4*)(G + 63 * 64 + 8 * ch), l1 = *(const f32x4*)(G + 63 * 64 + 8 * ch + 4);
            *(f32x4*)(Gbuf + (size_t)(t0 + t) * 256 + h * 64 + 8 * ch) = g0; *(f32x4*)(Gbuf + (size_t)(t0 + t) * 256 + h * 64 + 8 * ch + 4) = g1;
            const u16x8 kv = *(const u16x8*)(proj + (size_t)(t0 + t) * NPROJ + K_OFF + h * 64 + 8 * ch);
            bf16x8 o;
#pragma unroll
            for (int dd = 0; dd < 4; ++dd) { o[dd] = (__bf16)(bfbits2f(kv[dd]) * __expf(l0[dd] - g0[dd])); o[dd + 4] = (__bf16)(bfbits2f(kv[dd + 4]) * __expf(l1[dd] - g1[dd])); }
            *(bf16x8*)(Kimg + f2_off(t, ch)) = o;
            if (t == 63) {
#pragma unroll
                for (int dd = 0; dd < 4; ++dd) { dec[unit * 64 + 8 * ch + dd] = __expf(l0[dd]); dec[unit * 64 + 8 * ch + 4 + dd] = __expf(l1[dd]); }
            }
        }
        __syncthreads();
        {
            f32x4 acc[4];
#pragma unroll
            for (int dt = 0; dt < 4; ++dt) acc[dt] = (f32x4){0.f, 0.f, 0.f, 0.f};
#pragma unroll
            for (int ks = 0; ks < 2; ++ks) {
                const bf16x8 xv = f2_frag(Vimg, w, ks, lane);
#pragma unroll
                for (int dt = 0; dt < 4; ++dt) acc[dt] = MFMA16(xv, f2_frag(Kimg, dt, ks, lane), acc[dt]);
            }
#pragma unroll
            for (int dt = 0; dt < 4; ++dt) *(f32x4*)(Sloc + (size_t)unit * 8192 + (16 * dt + (lane & 15)) * 128 + 16 * w + 4 * (lane >> 4)) = acc[dt];
        }
        __syncthreads();
    }
}

DI void phase_gla2(const Params& p, int bid, int nblk, float* lds) {
    const float* Sloc = (const float*)(p.ws + OFF_SLOC); const float* dec = (const float*)(p.ws + OFF_DEC); bf16_t* Sin = (bf16_t*)(p.ws + OFF_SIN);
    for (int gid = bid * NT + threadIdx.x; gid < 16 * 8192; gid += nblk * NT) {
        const int bh = gid >> 13, el = gid & 8191, d = el >> 7; float st = 0.f;
        for (int n0 = 0; n0 < NSC; n0 += 16) {
            float sl[16], dc[16]; bf16_t so[16];
#pragma unroll
            for (int i = 0; i < 16; ++i) { const int u = bh * 64 + n0 + i; sl[i] = Sloc[(size_t)u * 8192 + el]; dc[i] = dec[u * 64 + d]; }
#pragma unroll
            for (int i = 0; i < 16; ++i) { so[i] = f2bf(st); st = st * dc[i] + sl[i]; }
#pragma unroll
            for (int i = 0; i < 16; ++i) Sin[(size_t)(bh * 64 + n0 + i) * 8192 + el] = so[i];
        }
    }
}

DI void phase_gla3(const Params& p, int bid, int nblk, float* ldsf) {
    unsigned char* lds = (unsigned char*)ldsf;
    int tid_ = threadIdx.x; asm volatile("" : "+v"(tid_));
    const int tid = tid_, lane = tid & 63, w = __builtin_amdgcn_readfirstlane(tid >> 6), t = tid >> 3, ch = tid & 7, l15 = lane & 15, kg = lane >> 4;
    const bf16_t* proj = (const bf16_t*)(p.ws + OFF_PROJ); const float* Gbuf = (const float*)(p.ws + OFF_G); const bf16_t* Sin = (const bf16_t*)(p.ws + OFF_SIN);
    bf16_t* mix = (bf16_t*)(p.ws + OFF_MIX);
    unsigned char* Qimg = lds; unsigned char* Kimg = lds + 8192; unsigned char* Pimg = lds + 16384; unsigned char* Vimg = lds + 24576; unsigned char* Simg = lds + 40960;
    float* part = (float*)(lds + 57344);
    for (int unit = bid; unit < 1024; unit += nblk) {
        const int bh = unit >> 6, n = unit & 63, b = bh >> 2, h = bh & 3, t0 = b * SEQ + n * SC;
        {
            const f32x4 g0 = *(const f32x4*)(Gbuf + (size_t)(t0 + t) * 256 + h * 64 + 8 * ch), g1 = *(const f32x4*)(Gbuf + (size_t)(t0 + t) * 256 + h * 64 + 8 * ch + 4);
            const u16x8 qv = *(const u16x8*)(proj + (size_t)(t0 + t) * NPROJ + Q_OFF + h * 64 + 8 * ch), kv = *(const u16x8*)(proj + (size_t)(t0 + t) * NPROJ + K_OFF + h * 64 + 8 * ch);
            bf16x8 qo, ko;
#pragma unroll
            for (int dd = 0; dd < 4; ++dd) {
                qo[dd] = (__bf16)(bfbits2f(qv[dd]) * 0.125f * __expf(g0[dd])); qo[dd + 4] = (__bf16)(bfbits2f(qv[dd + 4]) * 0.125f * __expf(g1[dd]));
                ko[dd] = (__bf16)(bfbits2f(kv[dd]) * __expf(-g0[dd])); ko[dd + 4] = (__bf16)(bfbits2f(kv[dd + 4]) * __expf(-g1[dd]));
            }
            *(bf16x8*)(Qimg + f1_off(t, ch)) = qo; *(bf16x8*)(Kimg + f1_off(t, ch)) = ko;
        }
#pragma unroll
        for (int i = 0; i < 2; ++i) { const int idx = tid + NT * i, tr = idx >> 4, c16 = idx & 15;
            *(u32x4*)(Vimg + f2_off(tr, c16)) = *(const u32x4*)(proj + (size_t)(t0 + tr) * NPROJ + V_OFF + h * 128 + 8 * c16);
            *(u32x4*)(Simg + f2_off(tr, c16)) = *(const u32x4*)(Sin + (size_t)unit * 8192 + tr * 128 + 8 * c16); }
        __syncthreads();
        {
            const int it = w >> 1;
#pragma unroll
            for (int jj = 0; jj < 2; ++jj) {
                const int jt = 2 * (w & 1) + jj; f32x4 acc = {0.f, 0.f, 0.f, 0.f};
                if (jt <= it) {
#pragma unroll
                    for (int ks = 0; ks < 2; ++ks) acc = MFMA16(f1_frag(Kimg, jt, ks, lane), f1_frag(Qimg, it, ks, lane), acc);
                    if (jt == it) {
#pragma unroll
                        for (int r = 0; r < 4; ++r) if (4 * kg + r > l15) acc[r] = 0.f;
                    }
                }
                bf16x4 o; o[0] = (__bf16)acc[0]; o[1] = (__bf16)acc[1]; o[2] = (__bf16)acc[2]; o[3] = (__bf16)acc[3];
                *(bf16x4*)(Pimg + f1_off(16 * it + l15, 2 * jt + (kg >> 1)) + 8 * (kg & 1)) = o;
            }
        }
        __syncthreads();
        {
            f32x4 acc[4];
#pragma unroll
            for (int it = 0; it < 4; ++it) acc[it] = (f32x4){0.f, 0.f, 0.f, 0.f};
#pragma unroll
            for (int ks = 0; ks < 2; ++ks) {
                const bf16x8 xv = f2_frag(Vimg, w, ks, lane), xs = f2_frag(Simg, w, ks, lane);
#pragma unroll
                for (int it = 0; it < 4; ++it) {
                    if (2 * ks <= it) acc[it] = MFMA16(xv, f1_frag(Pimg, it, ks, lane), acc[it]);
                    acc[it] = MFMA16(xs, f1_frag(Qimg, it, ks, lane), acc[it]);
                }
            }
#pragma unroll
            for (int it = 0; it < 4; ++it) {
                float ss = acc[it][0] * acc[it][0] + acc[it][1] * acc[it][1] + acc[it][2] * acc[it][2] + acc[it][3] * acc[it][3];
                ss += __shfl_xor(ss, 16); ss += __shfl_xor(ss, 32);
                if (kg == 0) part[w * 64 + 16 * it + l15] = ss;
            }
            __syncthreads();
            const int e0 = 16 * w + 4 * kg; const f32x4 nw = *(const f32x4*)(p.norm_w + e0);
#pragma unroll
            for (int it = 0; it < 4; ++it) {
                const int i = 16 * it + l15; float tot = 0.f;
#pragma unroll
                for (int w2 = 0; w2 < 8; ++w2) tot += part[w2 * 64 + i];
                const float inv = rsqrtf(tot * (1.f / 128.f) + RMS_EPS);
                const u16x4 rv = *(const u16x4*)(proj + (size_t)(t0 + i) * NPROJ + R_OFF + h * 128 + e0);
                bf16x4 o;
#pragma unroll
                for (int r = 0; r < 4; ++r) { const float rr = bfbits2f(rv[r]); o[r] = (__bf16)(acc[it][r] * inv * nw[r] * (rr * sigmoidf_(rr))); }
                *(bf16x4*)(mix + (size_t)(t0 + i) * D + 512 + h * 128 + e0) = o;
            }
        }
        __syncthreads();
    }
}

DI void phase_out(const Params& p, int bid, int nblk, float* lds) {
    const bf16_t* mix = (const bf16_t*)(p.ws + OFF_MIX); float* h32 = (float*)(p.ws + OFF_H32);
    for (int u = bid; u < 64 * 4; u += nblk) {
        const int mt = (nblk == 256) ? 8 * (u & 7) + (u >> 5) : u >> 2, nt = (nblk == 256) ? (u >> 3) & 3 : u & 3;
        auto rowoff = [&](int r) { return (unsigned)((mt * 256 + r) * D); };
        auto fin = [&](int r, int c, u32x4 dv) { const size_t o = (size_t)(mt * 256 + r) * D + nt * 256 + c; const f32x4 xv = *(const f32x4*)(p.x + o); *(f32x4*)(h32 + o) = xv * ALPHA + __builtin_bit_cast(f32x4, dv); };
        gemm_mfma<false, true, 4, D, 4>(mix, rowoff, (const float*)((const bf16_t*)(p.ws + OFF_WB_OUT) + nt * 256), nullptr, (unsigned)(((size_t)D * D - nt * 256) * 2), D, 256, PRE_ID, fin, (unsigned char*)lds);
    }
}

DI void ln_row(float (&v)[16], const float* g, const float* b, int lane) {
    float s = 0.f;
#pragma unroll
    for (int i = 0; i < 16; ++i) s += v[i];
    const float mean = wave_sum(s) * (1.f / D); float q = 0.f;
#pragma unroll
    for (int i = 0; i < 16; ++i) { v[i] -= mean; q += v[i] * v[i]; }
    const float rstd = rsqrtf(wave_sum(q) * (1.f / D) + LN_EPS);
#pragma unroll
    for (int j = 0; j < 4; ++j) {
        const float4 gg = ((const float4*)g)[lane + 64 * j], bb = ((const float4*)b)[lane + 64 * j];
        v[4 * j] = v[4 * j] * rstd * gg.x + bb.x; v[4 * j + 1] = v[4 * j + 1] * rstd * gg.y + bb.y;
        v[4 * j + 2] = v[4 * j + 2] * rstd * gg.z + bb.z; v[4 * j + 3] = v[4 * j + 3] * rstd * gg.w + bb.w;
    }
}

DI void ln1_rows(const Params& p, int r0, int nrows) {
    int tid_ = threadIdx.x; asm volatile("" : "+v"(tid_));
    const int lane = tid_ & 63, wave = tid_ >> 6;
    const float* h32 = (const float*)(p.ws + OFF_H32); bf16_t* hb = (bf16_t*)(p.ws + OFF_HB);
    for (int rb = r0 + wave; rb < r0 + nrows; rb += 32) {
        float v[4][16];
#pragma unroll
        for (int q = 0; q < 4; ++q) {
            const float4* hr = (const float4*)(h32 + (size_t)(rb + 8 * q) * D);
#pragma unroll
            for (int j = 0; j < 4; ++j) { const float4 a = hr[lane + 64 * j]; v[q][4 * j] = a.x; v[q][4 * j + 1] = a.y; v[q][4 * j + 2] = a.z; v[q][4 * j + 3] = a.w; }
        }
        float s[4], qq[4];
#pragma unroll
        for (int q = 0; q < 4; ++q) { s[q] = 0.f; _Pragma("unroll") for (int i = 0; i < 16; ++i) s[q] += v[q][i]; }
#pragma unroll
        for (int o = 1; o < 64; o <<= 1) { _Pragma("unroll") for (int q = 0; q < 4; ++q) s[q] += __shfl_xor(s[q], o); }
#pragma unroll
        for (int q = 0; q < 4; ++q) { const float mean = s[q] * (1.f / D); qq[q] = 0.f; _Pragma("unroll") for (int i = 0; i < 16; ++i) { v[q][i] -= mean; qq[q] += v[q][i] * v[q][i]; } }
#pragma unroll
        for (int o = 1; o < 64; o <<= 1) { _Pragma("unroll") for (int q = 0; q < 4; ++q) qq[q] += __shfl_xor(qq[q], o); }
#pragma unroll
        for (int j = 0; j < 4; ++j) {
            const float4 gg = ((const float4*)p.ln1_g)[lane + 64 * j], bb = ((const float4*)p.ln1_b)[lane + 64 * j];
#pragma unroll
            for (int q = 0; q < 4; ++q) {
                const float rstd = rsqrtf(qq[q] * (1.f / D) + LN_EPS);
                uint2 o; o.x = pk2(v[q][4 * j] * rstd * gg.x + bb.x, v[q][4 * j + 1] * rstd * gg.y + bb.y); o.y = pk2(v[q][4 * j + 2] * rstd * gg.z + bb.z, v[q][4 * j + 3] * rstd * gg.w + bb.w);
                ((uint2*)(hb + (size_t)(rb + 8 * q) * D))[lane + 64 * j] = o;
            }
        }
    }
}

DI void topk_rows(const Params& p, int r0, int nrows) {
    int tid_ = threadIdx.x; asm volatile("" : "+v"(tid_));
    const int lane = tid_ & 63, wave = tid_ >> 6;
    const float* scores = (const float*)(p.ws + OFF_SCORES); float* wbuf = (float*)(p.ws + OFF_WBUF);
    int* list = (int*)(p.ws + OFF_LIST); unsigned* cnt = (unsigned*)(p.ws + OFF_CTL) + CW_CNT;
    const float NEG = -__builtin_inff();
    for (int t = r0 + wave; t < r0 + nrows; t += 8) {
        const float4 sv = ((const float4*)(scores + (size_t)t * NE))[lane], bv = ((const float4*)p.router_bias)[lane];
        const float s[4] = {sv.x, sv.y, sv.z, sv.w};
        float cand[4] = {sv.x + bv.x, sv.y + bv.y, sv.z + bv.z, sv.w + bv.w};
        float m1 = NEG, m2 = NEG;
#pragma unroll
        for (int j = 0; j < 4; ++j) { const float v = cand[j]; if (v > m1) { m2 = m1; m1 = v; } else if (v > m2) m2 = v; }
#pragma unroll
        for (int off = 1; off < 8; off <<= 1) {
            const float o1 = __shfl_xor(m1, off), o2 = __shfl_xor(m2, off);
            const float n1 = fmaxf(m1, o1), n2 = fmaxf(fminf(m1, o1), fmaxf(m2, o2)); m1 = n1; m2 = n2;
        }
        const float gs = m1 + m2; const int mygrp = lane >> 3; int rank = 0;
#pragma unroll
        for (int g2 = 0; g2 < 8; ++g2) { const float og = __shfl(gs, g2 * 8); if (og > gs || (og == gs && g2 < mygrp)) ++rank; }
        if (rank >= 4) { cand[0] = NEG; cand[1] = NEG; cand[2] = NEG; cand[3] = NEG; }
        int my_e = 0; float my_w = 0.f, wsum = 0.f;
#pragma unroll
        for (int k = 0; k < TOPK; ++k) {
            float bvv = cand[0]; int bj = 0;
#pragma unroll
            for (int j = 1; j < 4; ++j) if (cand[j] > bvv) { bvv = cand[j]; bj = j; }
            int bi = 4 * lane + bj;
#pragma unroll
            for (int off = 32; off >= 1; off >>= 1) {
                const float ov = __shfl_xor(bvv, off); const int oi = __shfl_xor(bi, off);
                if (ov > bvv || (ov == bvv && oi < bi)) { bvv = ov; bi = oi; }
            }
            const int wj = bi & 3, wl = bi >> 2;
            const float mys = wj == 0 ? s[0] : (wj == 1 ? s[1] : (wj == 2 ? s[2] : s[3]));
            const float wk = __shfl(mys, wl);
            wsum += wk;
            if (lane == k) { my_e = bi; my_w = wk; }
            if (lane == wl) {
#pragma unroll
                for (int j = 0; j < 4; ++j) if (j == wj) cand[j] = NEG;
            }
        }
        if (lane < TOPK) {
            const unsigned pos = atomicAdd(&cnt[my_e], 1u);
            list[(size_t)my_e * LCAP + pos] = t * TOPK + lane;
            wbuf[(size_t)t * TOPK + lane] = my_w / wsum * 2.5f;
        }
    }
}

DI void phase_route(const Params& p, int bid, int nblk, float* lds) {
    const bf16_t* hb = (const bf16_t*)(p.ws + OFF_HB); float* scores = (float*)(p.ws + OFF_SCORES);
    for (int mt = bid; mt < T / 64; mt += nblk) {
        ln1_rows(p, mt * 64, 64);
        __syncthreads();
        auto rowoff = [&](int r) { return (unsigned)((mt * 64 + r) * D); };
        auto pre = [&](int r, int c, f32x4 v, f32x4) { return (f32x4){sigmoidf_(v[0]), sigmoidf_(v[1]), sigmoidf_(v[2]), sigmoidf_(v[3])}; };
        auto fin = [&](int r, int c, u32x4 dv) { *(u32x4*)(scores + (size_t)(mt * 64 + r) * NE + c) = dv; };
        gemm_mfma<false, true, 4, NE, 4>(hb, rowoff, (const float*)(p.ws + OFF_WB_RT), nullptr, (unsigned)(D * NE * 2), D, 64, pre, fin, (unsigned char*)lds);
        __syncthreads();
        topk_rows(p, mt * 64, 64);
        __syncthreads();
    }
}

constexpr int EXP_TAB_OFF = GEMM_LDS_BYTES;
DI void build_tables(const Params& p, int* toff, int* roff) {
    const unsigned* cnt = (const unsigned*)(p.ws + OFF_CTL) + CW_CNT;
    int* cl = roff + 260;
    if (threadIdx.x < NE) cl[threadIdx.x] = (int)__hip_atomic_load(cnt + threadIdx.x, __ATOMIC_RELAXED, __HIP_MEMORY_SCOPE_AGENT);
    __syncthreads();
    if (threadIdx.x <= NE) {
        int ta = 0, ra = 0;
        for (int e = 0; e < (int)threadIdx.x; ++e) { const int c = cl[e]; ta += (c + 255) >> 8; ra += c; }
        toff[threadIdx.x] = ta; roff[threadIdx.x] = ra;
    }
    __syncthreads();
    if (threadIdx.x < NE) { unsigned char* texp = (unsigned char*)(roff + 1040); for (int t = toff[threadIdx.x]; t < toff[threadIdx.x + 1]; ++t) texp[t] = (unsigned char)threadIdx.x; }
    __syncthreads();
}
DI int find_expert(const int* toff, int tile) { int lo = 0, hi = NE - 1; while (lo < hi) { const int mid = (lo + hi + 1) >> 1; if (toff[mid] <= tile) lo = mid; else hi = mid - 1; } return lo; }
struct ExpUnit { int e, row0, rows, rowbase; };
DI ExpUnit exp_unit(const int* toff, const int* roff, int e, int tile, int ntile) {
    const int* cl = roff + 260;
    ExpUnit u;
    if (tile < ntile) {
        u.e = e; const int ui = tile - toff[e], c = cl[e];
        u.row0 = ui * 256; u.rows = min(256, c - u.row0); u.rowbase = roff[e] + u.row0;
    } else { u.e = NE; u.row0 = (tile - ntile) * 256; u.rows = 256; u.rowbase = A_TOT + u.row0; }
    u.e = __builtin_amdgcn_readfirstlane(u.e); u.row0 = __builtin_amdgcn_readfirstlane(u.row0); u.rows = __builtin_amdgcn_readfirstlane(u.rows);
    u.rowbase = __builtin_amdgcn_readfirstlane(u.rowbase);
    return u;
}

template <int NTL>
DI int exp_decode(const int* toff, int ntile, int u, int& tile, int& nt) {
    if (u < NTL * ntile) {
        const unsigned char* texp = (const unsigned char*)(toff + 260 + 1040);
        const int e = texp[u / NTL], t0 = toff[e], ne = toff[e + 1] - t0; int u2 = u - NTL * t0; nt = 0;
#pragma unroll
        for (int i = 1; i < NTL; ++i) if (u2 >= ne) { u2 -= ne; ++nt; }
        tile = t0 + u2; return e;
    }
    else { const int us = u - NTL * ntile; nt = us / (T / 256); tile = ntile + (us - nt * (T / 256)); return NE; }
}

DI void phase_e1(const Params& p, int bid, int nblk, float* lds) {
    int* toff = (int*)((unsigned char*)lds + EXP_TAB_OFF); int* roff = toff + 260;
    const bf16_t* hb = (const bf16_t*)(p.ws + OFF_HB); bf16_t* hid = (bf16_t*)(p.ws + OFF_HID); const int* list = (const int*)(p.ws + OFF_LIST);
    build_tables(p, toff, roff);
    const int ntile = toff[NE], units = (ntile + T / 256) * 2;
    const int vb = (nblk & 7) ? bid : (bid & 7) * (nblk >> 3) + (bid >> 3);
    u32x4 ra[2][2], rb[2][4]; unsigned ao[2] = {0u, 0u}; bool pre = false;
    int tile_n = 0, nt_n = 0; ExpUnit xn;
    if (vb < units) { const int e_ = exp_decode<2>(toff, ntile, vb, tile_n, nt_n); xn = exp_unit(toff, roff, e_, tile_n, ntile); }
    for (int u = vb; u < units; u += nblk) {
        const int nt = nt_n; const ExpUnit x = xn; const bool hn = u + nblk < units;
        if (hn) { const int e_ = exp_decode<2>(toff, ntile, u + nblk, tile_n, nt_n); xn = exp_unit(toff, roff, e_, tile_n, ntile); }
        const float* wg = x.e < NE ? p.wg + (size_t)x.e * 262144 : p.sg; const float* wu = x.e < NE ? p.wu + (size_t)x.e * 262144 : p.su;
        const float* wgn = xn.e < NE ? p.wg + (size_t)xn.e * 262144 : p.sg; const float* wun = xn.e < NE ? p.wu + (size_t)xn.e * 262144 : p.su;
        auto rowoff = [&](int r) { const int tok = x.e < NE ? (list[(size_t)x.e * LCAP + x.row0 + r] >> 3) : (x.row0 + r); return (unsigned)(tok * D); };
        auto rowoff_n = [&](int r) { const int tok = xn.e < NE ? (list[(size_t)xn.e * LCAP + xn.row0 + r] >> 3) : (xn.row0 + r); return (unsigned)(tok * D); };
        auto prf = [&](int r, int c, f32x4 g, f32x4 uu) { return (f32x4){g[0] * sigmoidf_(g[0]) * uu[0], g[1] * sigmoidf_(g[1]) * uu[1], g[2] * sigmoidf_(g[2]) * uu[2], g[3] * sigmoidf_(g[3]) * uu[3]}; };
        auto fin = [&](int r, int c, u32x4 dv) { *(u32x4*)(hid + (size_t)(x.rowbase + r) * EDIM + nt * 128 + c) = dv; };
        gemm_core<true, false, 2, EDIM, 4>(ra, rb, ao, pre, hb, rowoff, wg + nt * 128, wu + nt * 128, (unsigned)((D * EDIM - nt * 128) * 4), D, x.rows,
                                 hn, rowoff_n, wgn + nt_n * 128, wun + nt_n * 128, (unsigned)((D * EDIM - nt_n * 128) * 4), xn.rows, prf, fin, (unsigned char*)lds);
        pre = hn;
    }
}

DI void phase_e2(const Params& p, int bid, int nblk, float* lds) {
    int* toff = (int*)((unsigned char*)lds + EXP_TAB_OFF); int* roff = toff + 260; int* rowa = roff + 520;
    const bf16_t* hid = (const bf16_t*)(p.ws + OFF_HID); unsigned char* Y = p.ws + OFF_Y; const int* list = (const int*)(p.ws + OFF_LIST);
    build_tables(p, toff, roff);
    const int ntile = toff[NE], units = (ntile + T / 256) * 4;
    const int vb = (nblk & 7) ? bid : (bid & 7) * (nblk >> 3) + (bid >> 3);
    u32x4 ra[2][2], rb[2][4]; unsigned ao[2] = {0u, 0u}; bool pre = false;
    int tile_n = 0, nt_n = 0; ExpUnit xn;
    auto rowa_val = [&](const ExpUnit& q, int r) { return q.e < NE ? (r < q.rows ? list[(size_t)q.e * LCAP + q.row0 + r] : 0) : (A_TOT + q.row0 + r); };
    if (vb < units) { const int e_ = exp_decode<4>(toff, ntile, vb, tile_n, nt_n); xn = exp_unit(toff, roff, e_, tile_n, ntile); if (threadIdx.x < 256) rowa[threadIdx.x] = rowa_val(xn, threadIdx.x); }
    __syncthreads();
    int cur = 0;
    for (int u = vb; u < units; u += nblk) {
        const int nt = nt_n; const ExpUnit x = xn; const bool hn = u + nblk < units;
        if (hn) { const int e_ = exp_decode<4>(toff, ntile, u + nblk, tile_n, nt_n); xn = exp_unit(toff, roff, e_, tile_n, ntile); }
        const float* wd = x.e < NE ? p.wd + (size_t)x.e * 262144 : p.sd; const float* wdn = xn.e < NE ? p.wd + (size_t)xn.e * 262144 : p.sd;
        int rnext = 0;
        if (hn && threadIdx.x < 256) rnext = rowa_val(xn, threadIdx.x);
        const int* rowa_c = rowa + cur * 256;
        auto rowoff = [&](int r) { return (unsigned)((x.rowbase + r) * EDIM); };
        auto rowoff_n = [&](int r) { return (unsigned)((xn.rowbase + r) * EDIM); };
        auto fin = [&](int r, int c, u32x4 dv) { *(u32x4*)(Y + (size_t)rowa_c[r] * D + nt * 256 + c) = dv; };
        gemm_core<false, false, 1, D, 4>(ra, rb, ao, pre, hid, rowoff, wd + nt * 256, nullptr, (unsigned)((EDIM * D - nt * 256) * 4), EDIM, x.rows,
                               hn, rowoff_n, wdn + nt_n * 256, nullptr, (unsigned)((EDIM * D - nt_n * 256) * 4), xn.rows, PRE_ID, fin, (unsigned char*)lds);
        pre = hn;
        cur ^= 1;
        if (threadIdx.x < 256) rowa[cur * 256 + threadIdx.x] = rnext;
    }
}

DI void phase_combine(const Params& p, int bid, int nblk, float* lds) {
    const int lane = threadIdx.x & 63, wave = threadIdx.x >> 6;
    const bf16_t* hb = (const bf16_t*)(p.ws + OFF_HB); const unsigned char* Y = p.ws + OFF_Y; const float* wbuf = (const float*)(p.ws + OFF_WBUF);
    typedef float f32x2 __attribute__((ext_vector_type(2)));
    for (int t = bid * 8 + wave; t < T; t += nblk * 8) {
        float v[16];
#pragma unroll
        for (int j = 0; j < 4; ++j) { const uint2 a = ((const uint2*)(hb + (size_t)t * D))[lane + 64 * j];
            v[4 * j] = ALPHA * __uint_as_float(a.x << 16); v[4 * j + 1] = ALPHA * __uint_as_float(a.x & 0xffff0000u);
            v[4 * j + 2] = ALPHA * __uint_as_float(a.y << 16); v[4 * j + 3] = ALPHA * __uint_as_float(a.y & 0xffff0000u); }
#pragma unroll
        for (int k = 0; k < 9; ++k) {
            const size_t row = k < 8 ? (size_t)t * TOPK + k : (size_t)A_TOT + t; const float w = (k < 8 ? wbuf[(size_t)t * TOPK + k] : 1.f) * (1.f / 128.f);
#pragma unroll
            for (int j = 0; j < 4; ++j) {
                const int y = ((const int*)(Y + row * D))[lane + 64 * j];
                const f32x2 lo = __builtin_amdgcn_cvt_pk_f32_fp8(y, false), hi = __builtin_amdgcn_cvt_pk_f32_fp8(y, true);
                v[4 * j] += w * lo[0]; v[4 * j + 1] += w * lo[1]; v[4 * j + 2] += w * hi[0]; v[4 * j + 3] += w * hi[1];
            }
        }
        ln_row(v, p.ln2_g, p.ln2_b, lane);
#pragma unroll
        for (int j = 0; j < 4; ++j) ((float4*)(p.out + (size_t)t * D))[lane + 64 * j] = make_float4(v[4 * j], v[4 * j + 1], v[4 * j + 2], v[4 * j + 3]);
    }
}

#define LAS __attribute__((address_space(3)))
#define XB_TMO      128
#define XB_XCNT(j)  (256  + 64 * (j))
#define XB_XSUB(j)  (1280 + 64 * (j))
#define XB_XGEN(j)  (2304 + 64 * (j))
#define XB_TOP      3328
#define XB_TOPGEN   3392
#define XCD_BAR_WORDS 3456
#define XB_SPIN_CAP (1u << 22)
constexpr int CW_BAR = 4096;
DI unsigned xb_ld(unsigned* p) { return __hip_atomic_load(p, __ATOMIC_RELAXED, __HIP_MEMORY_SCOPE_AGENT); }
DI unsigned xb_add(unsigned* p, unsigned v) { return __hip_atomic_fetch_add(p, v, __ATOMIC_RELAXED, __HIP_MEMORY_SCOPE_AGENT); }
DI unsigned xb_xcc_id() { return (unsigned)__builtin_amdgcn_s_getreg((3 << 11) | 20) & 0xFu; }
#define XB_SPIN(cond, bar) do { unsigned _sp = 0; while (cond) { __builtin_amdgcn_s_sleep(1); \
    if ((++_sp & 255u) == 0u) { if (xb_ld(&(bar)[XB_TMO])) break; if (_sp > XB_SPIN_CAP) { atomicAdd(&(bar)[XB_TMO], 1u); break; } } } } while (0)
struct XcdBarrier { unsigned* bar; unsigned x; volatile LAS unsigned* st; };
DI XcdBarrier xcd_barrier_post(unsigned* bar, volatile LAS unsigned* st) {
    XcdBarrier b; b.bar = bar; b.x = xb_xcc_id(); b.st = st;
    if (threadIdx.x == 0) (void)xb_add(&bar[XB_XCNT(b.x)], 1u);
    return b;
}
DI void xcd_barrier_complete(unsigned* bar, unsigned x, unsigned& nloc, unsigned& nx) {
    const unsigned G = gridDim.x * gridDim.y * gridDim.z;
    unsigned sum, cnt, mine, sp = 0u;
    for (;;) {
        sum = 0u; cnt = 0u; mine = 0u;
#pragma unroll
        for (unsigned j = 0; j < 16; ++j) { const unsigned c = xb_ld(&bar[XB_XCNT(j)]); sum += c; cnt += (c > 0u) ? 1u : 0u; mine = (j == x) ? c : mine; }
        if (sum == G) break;
        __builtin_amdgcn_s_sleep(1);
        if ((++sp & 255u) == 0u) { if (xb_ld(&bar[XB_TMO])) break; if (sp > XB_SPIN_CAP) { atomicAdd(&bar[XB_TMO], 1u); break; } }
    }
    nloc = mine > 0u ? mine : 1u; nx = cnt > 0u ? cnt : 1u;
}
DI void xcd_barrier(const XcdBarrier& b) {
    asm volatile("s_waitcnt vmcnt(0)" ::: "memory");
    __syncthreads();
    if (threadIdx.x == 0) {
        unsigned* bar = b.bar;
        __builtin_amdgcn_s_waitcnt(0);
        unsigned nloc = b.st[0], nx = b.st[1];
        if (nloc == 0u) { xcd_barrier_complete(bar, b.x, nloc, nx); b.st[0] = nloc; b.st[1] = nx; }
        const unsigned old = xb_add(&bar[XB_XSUB(b.x)], 1u);
        const unsigned gen = old / nloc;
        if (old + 1u == (gen + 1u) * nloc) {
            __builtin_amdgcn_fence(__ATOMIC_RELEASE, "agent");
            asm volatile("s_waitcnt vmcnt(0)" ::: "memory");
            const unsigned og = xb_add(&bar[XB_TOP], 1u);
            const unsigned tg = og / nx;
            if (og + 1u == (tg + 1u) * nx) xb_add(&bar[XB_TOPGEN], 1u);
            else XB_SPIN(xb_ld(&bar[XB_TOPGEN]) == tg, bar);
            __builtin_amdgcn_fence(__ATOMIC_ACQUIRE, "agent");
            xb_add(&bar[XB_XGEN(b.x)], 1u);
            asm volatile("s_waitcnt vmcnt(0)" ::: "memory");
        } else {
            XB_SPIN(xb_ld(&bar[XB_XGEN(b.x)]) == gen, bar);
            __builtin_amdgcn_fence(__ATOMIC_ACQUIRE, "agent");
            asm volatile("s_waitcnt vmcnt(0)" ::: "memory");
        }
    }
    __syncthreads();
}

constexpr int LDS_BYTES = 136 * 1024;
constexpr int LDS_BAR_OFF = LDS_BYTES - 16;
__global__ void __launch_bounds__(NT) fwd_megakernel(Params p) {
    extern __shared__ __attribute__((aligned(16))) float lds[];
    const int bid = blockIdx.x, nblk = gridDim.x;
    volatile LAS unsigned* st = (volatile LAS unsigned*)((LAS unsigned char*)lds + LDS_BAR_OFF);
    if (threadIdx.x < 4) st[threadIdx.x] = 0u;
    __syncthreads();
    XcdBarrier bar = xcd_barrier_post((unsigned*)(p.ws + OFF_CTL) + CW_BAR, st);
    phase_prep(p, bid, nblk, lds);      xcd_barrier(bar);
    phase_proj(p, bid, nblk, lds);      xcd_barrier(bar);
    phase_poolmean(p, bid, nblk, lds);
    phase_gla1(p, bid, nblk, lds);      xcd_barrier(bar);
    phase_pool(p, bid, nblk, lds);
    phase_gla2(p, bid, nblk, lds);      xcd_barrier(bar);
    phase_gla3(p, bid, nblk, lds);      xcd_barrier(bar);
    phase_out(p, bid, nblk, lds);       xcd_barrier(bar);
    phase_route(p, bid, nblk, lds);     xcd_barrier(bar);
    phase_e1(p, bid, nblk, lds);        xcd_barrier(bar);
    phase_e2(p, bid, nblk, lds);        xcd_barrier(bar);
    phase_combine(p, bid, nblk, lds);
}

extern "C" void kernel_launch(void* const* d_in, const int* in_sizes, int n_in, void* d_out, int out_size, void* d_ws, size_t ws_size, hipStream_t stream) {
    static int grid = 0;
    if (grid == 0) {
        if (n_in != 20 || ws_size < WS_NEED) { fprintf(stderr, "kernel_launch: unexpected n_in %d or ws_size %zu (< %zu)\n", n_in, ws_size, (size_t)WS_NEED); grid = -1; return; }
        int dev = 0, cus = 0, per_cu = 0;
        (void)hipGetDevice(&dev); (void)hipDeviceGetAttribute(&cus, hipDeviceAttributeMultiprocessorCount, dev);
        (void)hipFuncSetAttribute((const void*)fwd_megakernel, hipFuncAttributeMaxDynamicSharedMemorySize, LDS_BYTES);
        (void)hipOccupancyMaxActiveBlocksPerMultiprocessor(&per_cu, (const void*)fwd_megakernel, NT, LDS_BYTES);
        if (per_cu < 1 || cus < 1) { fprintf(stderr, "kernel_launch: occupancy query says %d blocks/CU on %d CUs\n", per_cu, cus); grid = -1; return; }
        grid = cus;
    }
    if (grid < 0) return;
    (void)hipMemsetAsync((char*)d_ws + OFF_CTL, 0, 64 * 1024, stream);
    Params p{};
    const float** pp = (const float**)&p;
    for (int i = 0; i < 20; ++i) pp[i] = (const float*)d_in[i];
    p.out = (float*)d_out; p.ws = (unsigned char*)d_ws;
    void* args[] = {&p};
    hipError_t e = hipLaunchCooperativeKernel((const void*)fwd_megakernel, dim3(grid), dim3(NT), args, LDS_BYTES, stream);
    if (e != hipSuccess) fprintf(stderr, "cooperative launch failed: %s (grid %d)\n", hipGetErrorString(e), grid);
}
```

```cpp
#include <hip/hip_runtime.h>
#include <stdint.h>
#include <cstdio>

#define DI __device__ __forceinline__
typedef unsigned short bf16_t;

constexpr int T = 16384, D = 1024, SEQ = 4096;
constexpr int DIN = 2064, NPROJ = 2048;
constexpr int P_OFF = 0, Q_OFF = 512, K_OFF = 768, V_OFF = 1024, R_OFF = 1536, GL_OFF = 2048;
constexpr int SC = 64;
constexpr int NSC = SEQ / SC;
constexpr int NE = 256, TOPK = 8, EDIM = 256;
constexpr int A_TOT = T * TOPK;
constexpr int LCAP = T;
constexpr float ALPHA = 1.189207115002721f;
constexpr float LN_EPS = 1e-5f, RMS_EPS = 1e-5f;
constexpr int NT = 512;

constexpr size_t MiB = 1u << 20;
constexpr size_t OFF_CTL = 0;
constexpr size_t OFF_XB = 1 * MiB;
constexpr size_t OFF_GLOW = OFF_XB + 32 * MiB;
constexpr size_t OFF_PROJ = OFF_GLOW + 1 * MiB;
constexpr size_t OFF_G = OFF_PROJ + 64 * MiB;
constexpr size_t OFF_SLOC = OFF_G + 16 * MiB;
constexpr size_t OFF_DEC = OFF_SLOC + 32 * MiB;
constexpr size_t OFF_SIN = OFF_DEC + 1 * MiB;
constexpr size_t OFF_MIX = OFF_SIN + 32 * MiB;
constexpr size_t OFF_H32 = OFF_MIX + 32 * MiB;
constexpr size_t OFF_HB = OFF_H32 + 64 * MiB;
constexpr size_t OFF_SCORES = OFF_HB + 32 * MiB;
constexpr size_t OFF_WBUF = OFF_SCORES + 16 * MiB;
constexpr size_t OFF_LIST = OFF_WBUF + 1 * MiB;
constexpr size_t OFF_HID = OFF_LIST + 16 * MiB;
constexpr size_t OFF_Y = OFF_HID + 76 * MiB;
constexpr size_t OFF_PM = OFF_Y + 304 * MiB;
constexpr size_t OFF_WB_IN = OFF_PM + 16 * MiB;
constexpr size_t OFF_WB_OUT = OFF_WB_IN + 4 * MiB;
constexpr size_t OFF_WB_RT = OFF_WB_OUT + 2 * MiB;
constexpr size_t OFF_WB_SGU = OFF_WB_RT + 1 * MiB;
constexpr size_t OFF_WB_SD = OFF_WB_SGU + 1 * MiB;
constexpr size_t WS_NEED = OFF_WB_SD + 1 * MiB;
constexpr int CW_CNT = 1024;

struct Params {
    const float *x, *w_in, *gate_w2, *gate_b, *norm_w, *pool_w, *pool_scale, *w_out, *ln1_g, *ln1_b;
    const float *router_w, *router_bias, *wg, *wu, *wd, *sg, *su, *sd, *ln2_g, *ln2_b;
    float* out;
    unsigned char* ws;
};

DI float bf2f(bf16_t v) { return __uint_as_float(((unsigned)v) << 16); }
DI bf16_t f2bf(float f) { unsigned u = __float_as_uint(f); u += 0x7fffu + ((u >> 16) & 1u); return (bf16_t)(u >> 16); }
DI unsigned pk2(float lo, float hi) { return (unsigned)f2bf(lo) | ((unsigned)f2bf(hi) << 16); }
DI float wave_sum(float v) {
#pragma unroll
    for (int o = 1; o < 64; o <<= 1) v += __shfl_xor(v, o);
    return v;
}
DI float sigmoidf_(float v) { return 1.f / (1.f + __expf(-v)); }
DI float logsigmoidf_(float z) { return fminf(z, 0.f) - log1pf(__expf(-fabsf(z))); }

constexpr int GT_LDS_FLOATS = 16 * 132 + 2 * 16 * 68;
template <bool DUAL, class AF, class BF, class EPI>
DI void gemm_tile_valu(int K, const AF& af, const BF& bfn, const EPI& epi, float* lds) {
    float* As = lds; float* Bs = lds + 16 * 132; float* Bs2 = Bs + 16 * 68;
    const int tid = threadIdx.x, ty = tid >> 4, tx = tid & 15;
    float acc[4][4], acc2[4][4];
#pragma unroll
    for (int i = 0; i < 4; ++i)
#pragma unroll
        for (int j = 0; j < 4; ++j) { acc[i][j] = 0.f; acc2[i][j] = 0.f; }
    for (int k0 = 0; k0 < K; k0 += 16) {
#pragma unroll
        for (int i = 0; i < 4; ++i) { const int e = tid + 512 * i, r = e >> 4, kk = e & 15; As[kk * 132 + r] = af(r, k0 + kk); }
#pragma unroll
        for (int i = 0; i < 2; ++i) { const int e = tid + 512 * i, kk = e >> 6, c = e & 63; Bs[kk * 68 + c] = bfn(0, k0 + kk, c); if (DUAL) Bs2[kk * 68 + c] = bfn(1, k0 + kk, c); }
        __syncthreads();
#pragma unroll
        for (int kk = 0; kk < 16; ++kk) {
            const float4 a = *(const float4*)&As[kk * 132 + ty * 4];
            const float4 b = *(const float4*)&Bs[kk * 68 + tx * 4];
            const float av[4] = {a.x, a.y, a.z, a.w}, bv[4] = {b.x, b.y, b.z, b.w};
#pragma unroll
            for (int i = 0; i < 4; ++i)
#pragma unroll
                for (int j = 0; j < 4; ++j) acc[i][j] += av[i] * bv[j];
            if (DUAL) {
                const float4 b2 = *(const float4*)&Bs2[kk * 68 + tx * 4];
                const float b2v[4] = {b2.x, b2.y, b2.z, b2.w};
#pragma unroll
                for (int i = 0; i < 4; ++i)
#pragma unroll
                    for (int j = 0; j < 4; ++j) acc2[i][j] += av[i] * b2v[j];
            }
        }
        __syncthreads();
    }
#pragma unroll
    for (int i = 0; i < 4; ++i)
#pragma unroll
        for (int j = 0; j < 4; ++j) epi(ty * 4 + i, tx * 4 + j, acc[i][j], acc2[i][j]);
}


typedef __bf16 bf16x8 __attribute__((ext_vector_type(8)));
typedef __bf16 bf16x4 __attribute__((ext_vector_type(4)));
typedef short s16x4 __attribute__((ext_vector_type(4)));
typedef float f32x4 __attribute__((ext_vector_type(4)));
typedef unsigned u32x4 __attribute__((ext_vector_type(4)));
#define LAS3 __attribute__((address_space(3)))
DI const float* uniform_ptr(const float* p) {
    const unsigned long long v = (unsigned long long)p;
    const unsigned lo = __builtin_amdgcn_readfirstlane((unsigned)v), hi = __builtin_amdgcn_readfirstlane((unsigned)(v >> 32));
    return (const float*)(((unsigned long long)hi << 32) | lo);
}
#define MFMA16(a, b, c) __builtin_amdgcn_mfma_f32_16x16x32_bf16((a), (b), (c), 0, 0, 0)
constexpr int GEMM_LDS_BYTES = 131072;
DI unsigned a_swz(unsigned x) { return (0x78u >> (2u * x)) & 3u; }
struct GemmRegs { u32x4 ra[2][2], rb[2][4]; };
template <bool DUAL, bool BK16, int OUTB, int LDB, int WN, class RowFn, class RowFnN, class Pre, class Fin>
DI void gemm_core(u32x4 (&Rra)[2][2], u32x4 (&Rrb)[2][4], unsigned (&aoffc)[2], bool preloaded, const bf16_t* Ab, const RowFn& rowoff, const float* B0, const float* B1, unsigned bbytes, int K, int rows,
                  bool has_next, const RowFnN& rowoff_n, const float* B0n, const float* B1n, unsigned bbytes_n, int rows_n, const Pre& pre, const Fin& fin, unsigned char* lds) {
    int tid_ = threadIdx.x; asm volatile("" : "+v"(tid_));
    const int tid = tid_, lane = tid & 63, w = __builtin_amdgcn_readfirstlane(tid >> 6), wm = w >> 2, wn = w & 3, l15 = lane & 15, kg = lane >> 4, t256 = tid & 255;
    const bool active = wn < WN;
    const int nrow_w = min(max(rows - 128 * wm, 0), 128), ngrp = (((nrow_w + 15) >> 4) + 1) >> 1;
    unsigned aoff[2];
#pragma unroll
    for (int i = 0; i < 2; ++i) aoff[i] = preloaded ? aoffc[i] : (rowoff(min(128 * wm + (t256 >> 2) + 64 * i, rows - 1)) + (t256 & 3) * 8) * 2u;
    const __amdgpu_buffer_rsrc_t ar = __builtin_amdgcn_make_buffer_rsrc((void*)Ab, 0, 0x7fffffff, 0x00020000);
    const unsigned awr = (128 * wm + (t256 >> 2)) * 128 + ((((unsigned)(t256 & 3)) ^ (unsigned)((t256 >> 3) & 7)) << 4);
    constexpr int NB = BK16 ? 2 : 4;
    const float* bsrc = uniform_ptr(DUAL && !BK16 ? ((wn >> 1) ? B1 : B0) : B0);
    const __amdgpu_buffer_rsrc_t br = __builtin_amdgcn_make_buffer_rsrc((void*)bsrc, 0, bbytes, 0x00020000);
    const unsigned bvoff = BK16 ? (unsigned)(((lane >> 5) * LDB + (lane & 31) * 8) * 2) : (DUAL ? (unsigned)(((lane >> 5) * LDB + (lane & 31) * 4) * 4) : (unsigned)(lane * 16));
    const int krow0 = BK16 ? 16 * wm + 2 * wn : (DUAL ? 16 * wm + 8 * (wn & 1) : 16 * wm + wn);
    constexpr int KSTEP = BK16 ? 8 : (DUAL ? 2 : 4), ESZ = BK16 ? 2 : 4;
    unsigned aoff_n[2];
#pragma unroll
    for (int i = 0; i < 2; ++i) aoff_n[i] = has_next ? (rowoff_n(min(128 * wm + (t256 >> 2) + 64 * i, rows_n - 1)) + (t256 & 3) * 8) * 2u : aoff[i];
    const float* bsrc_n = uniform_ptr(has_next ? (DUAL && !BK16 ? ((wn >> 1) ? B1n : B0n) : B0n) : bsrc);
    const __amdgpu_buffer_rsrc_t br_n = __builtin_amdgcn_make_buffer_rsrc((void*)bsrc_n, 0, has_next ? bbytes_n : bbytes, 0x00020000);
    unsigned bwr[NB];
#pragma unroll
    for (int i = 0; i < NB; ++i) {
        const int kb = krow0 + KSTEP * i + ((BK16 || DUAL) ? (lane >> 5) : 0);
        const int n = BK16 ? 8 * (lane & 31) : (DUAL ? (wn >> 1) * 128 + 4 * (lane & 31) : 4 * lane);
        const unsigned I = n >> 7, ch = (n & 127) >> 3, half = BK16 ? 0u : (unsigned)((n >> 2) & 1), xx = ((kb & 3) << 2) | ((kb >> 2) & 3);
        bwr[i] = 32768u + I * 16384u + 256u * kb + 16u * (ch ^ xx) + 8u * half;
    }
    const unsigned ard = (128 * wm + l15) * 128 + ((((unsigned)kg) ^ (unsigned)((l15 >> 1) & 7)) << 4);
    unsigned trd0, trd1;
    {
        const unsigned q = l15 >> 2, pp = l15 & 3, cbase = (DUAL ? 4u * wn : 8u * (wn & 1)) + (pp >> 1), ibase = DUAL ? 0u : (unsigned)(wn >> 1);
        const unsigned x0 = (q << 2) | ((2u * kg) & 3u), x1 = (q << 2) | ((2u * kg + 1u) & 3u);
        trd0 = 32768u + ibase * 16384u + 256u * (8u * kg + q) + 16u * (cbase ^ x0) + 8u * (pp & 1);
        trd1 = 32768u + ibase * 16384u + 256u * (8u * kg + 4u + q) + 16u * (cbase ^ x1) + 8u * (pp & 1);
    }
    f32x4 acc[8][4];
#pragma unroll
    for (int i = 0; i < 8; ++i)
#pragma unroll
        for (int f = 0; f < 4; ++f) acc[i][f] = (f32x4){0.f, 0.f, 0.f, 0.f};
    const int nj = K / 32;
#define LOAD_SET(S, j) { _Pragma("unroll") for (int i = 0; i < 2; ++i) Rra[S][i] = __builtin_bit_cast(u32x4, __builtin_amdgcn_raw_buffer_load_b128(ar, aoff[S], ((j) >> 1) * 128 + i * 64, 0)); \
        _Pragma("unroll") for (int i = 0; i < NB; ++i) Rrb[S][i] = __builtin_bit_cast(u32x4, __builtin_amdgcn_raw_buffer_load_b128(br, bvoff, ((j) * 32 + krow0 + KSTEP * i) * (LDB * ESZ), 0)); }
#define LOAD_SET_N(S, j) { _Pragma("unroll") for (int i = 0; i < 2; ++i) Rra[S][i] = __builtin_bit_cast(u32x4, __builtin_amdgcn_raw_buffer_load_b128(ar, aoff_n[S], ((j) >> 1) * 128 + i * 64, 0)); \
        _Pragma("unroll") for (int i = 0; i < NB; ++i) Rrb[S][i] = __builtin_bit_cast(u32x4, __builtin_amdgcn_raw_buffer_load_b128(br_n, bvoff, ((j) * 32 + krow0 + KSTEP * i) * (LDB * ESZ), 0)); }
#define WRITE_SET(S, st, h) { _Pragma("unroll") for (int i = 0; i < 2; ++i) *(u32x4*)(lds + (st) * 65536 + (awr ^ (i ? 64u : 0u)) + (S) * 8192) = Rra[S][i]; \
        _Pragma("unroll") for (int i = 0; i < NB; ++i) { if (BK16) *(u32x4*)(lds + (st) * 65536 + (h) * 8192 + bwr[i]) = Rrb[S][i]; else { \
            const f32x4 v = __builtin_bit_cast(f32x4, Rrb[S][i]); bf16x4 o; o[0] = (__bf16)v[0]; o[1] = (__bf16)v[1]; o[2] = (__bf16)v[2]; o[3] = (__bf16)v[3]; \
            *(bf16x4*)(lds + (st) * 65536 + (h) * 8192 + ((!DUAL) ? ((bwr[0] ^ (unsigned)(i << 4)) + 1024u * i) : bwr[i])) = o; } } }
#define LOAD_SEL(S, jl) { const bool nx_ = (jl) >= nj; const int jt_ = nx_ ? (jl) - nj : (jl); \
        _Pragma("unroll") for (int i = 0; i < 2; ++i) Rra[S][i] = __builtin_bit_cast(u32x4, __builtin_amdgcn_raw_buffer_load_b128(ar, nx_ ? aoff_n[S] : aoff[S], (jt_ >> 1) * 128 + i * 64, 0)); \
        if (nx_) { _Pragma("unroll") for (int i = 0; i < NB; ++i) Rrb[S][i] = __builtin_bit_cast(u32x4, __builtin_amdgcn_raw_buffer_load_b128(br_n, bvoff, (jt_ * 32 + krow0 + KSTEP * i) * (LDB * ESZ), 0)); } \
        else { _Pragma("unroll") for (int i = 0; i < NB; ++i) Rrb[S][i] = __builtin_bit_cast(u32x4, __builtin_amdgcn_raw_buffer_load_b128(br, bvoff, (jt_ * 32 + krow0 + KSTEP * i) * (LDB * ESZ), 0)); } }
#define WRITE_A(S, st, h) { _Pragma("unroll") for (int i = 0; i < 2; ++i) *(u32x4*)(lds + (st) * 65536 + (awr ^ (i ? 64u : 0u)) + (S) * 8192) = Rra[S][i]; }
#define WRITE_B(S, st, h, I0, I1) { _Pragma("unroll") for (int i = (I0); i < (I1); ++i) { if (BK16) *(u32x4*)(lds + (st) * 65536 + (h) * 8192 + bwr[i]) = Rrb[S][i]; else { \
            const f32x4 v = __builtin_bit_cast(f32x4, Rrb[S][i]); bf16x4 o; o[0] = (__bf16)v[0]; o[1] = (__bf16)v[1]; o[2] = (__bf16)v[2]; o[3] = (__bf16)v[3]; \
            *(bf16x4*)(lds + (st) * 65536 + (h) * 8192 + ((!DUAL) ? ((bwr[0] ^ (unsigned)(i << 4)) + 1024u * i) : bwr[i])) = o; } } }
#define LOAD_A(S, jl) { const bool nx_ = (jl) >= nj; const int jt_ = nx_ ? (jl) - nj : (jl); \
        _Pragma("unroll") for (int i = 0; i < 2; ++i) Rra[S][i] = __builtin_bit_cast(u32x4, __builtin_amdgcn_raw_buffer_load_b128(ar, nx_ ? aoff_n[S] : aoff[S], (jt_ >> 1) * 128 + i * 64, 0)); }
#define LOAD_B(S, jl) { const bool nx_ = (jl) >= nj; const int jt_ = nx_ ? (jl) - nj : (jl); \
        if (nx_) { _Pragma("unroll") for (int i = 0; i < NB; ++i) Rrb[S][i] = __builtin_bit_cast(u32x4, __builtin_amdgcn_raw_buffer_load_b128(br_n, bvoff, (jt_ * 32 + krow0 + KSTEP * i) * (LDB * ESZ), 0)); } \
        else { _Pragma("unroll") for (int i = 0; i < NB; ++i) Rrb[S][i] = __builtin_bit_cast(u32x4, __builtin_amdgcn_raw_buffer_load_b128(br, bvoff, (jt_ * 32 + krow0 + KSTEP * i) * (LDB * ESZ), 0)); } }
#define TF_LOAD(dst, st, h, g) { _Pragma("unroll") for (int q_ = 0; q_ < 2; ++q_) dst[q_] = *(const bf16x8*)(lds + (st) * 65536 + ((g) * 2 + q_) * 2048 + (ard ^ ((h) ? 64u : 0u))); }
#define WF_LOAD(st, h) { _Pragma("unroll") for (int f = 0; f < 4; ++f) { \
        const unsigned fx = DUAL ? ((f & 1) << 5) : (f << 5), fo = (DUAL ? (f >> 1) * 16384 : 0) + (st) * 65536 + (h) * 8192; \
        const s16x4 lo = __builtin_amdgcn_ds_read_tr16_b64_v4i16((LAS3 s16x4*)(lds + ((trd0 ^ fx) + fo))); \
        const s16x4 hi = __builtin_amdgcn_ds_read_tr16_b64_v4i16((LAS3 s16x4*)(lds + ((trd1 ^ fx) + fo))); \
        wf[f] = __builtin_bit_cast(bf16x8, __builtin_shufflevector(lo, hi, 0, 1, 2, 3, 4, 5, 6, 7)); } }
#define STAGE_MMA(srcf, g) { _Pragma("unroll") for (int q_ = 0; q_ < 2; ++q_) _Pragma("unroll") for (int f = 0; f < 4; ++f) acc[(g) * 2 + q_][f] = MFMA16(wf[f], srcf[q_], acc[(g) * 2 + q_][f]); }
#define STAGE(st, h, g, cur, nxt) if ((g) < ngrp) { \
        if ((g) + 1 < 4 && (g) + 1 < ngrp) TF_LOAD(nxt, st, h, (g) + 1) \
        __builtin_amdgcn_sched_barrier(0); \
        STAGE_MMA(cur, g) \
        __builtin_amdgcn_sched_barrier(0); }
    const bool comp = active && ngrp > 0;
    bf16x8 fa[2], fb[2], wf[4];
#define HALF_MMA(st, h) if (comp) { STAGE(st, h, 0, fa, fb) STAGE(st, h, 1, fb, fa) STAGE(st, h, 2, fa, fb) STAGE(st, h, 3, fb, fa) }
#define SLOT(st, h, g, cur, nxt, PIECE) { if (comp && (g) < ngrp) { if ((g) + 1 < 4 && (g) + 1 < ngrp) TF_LOAD(nxt, st, h, (g) + 1) } \
        PIECE \
        __builtin_amdgcn_sched_barrier(0); \
        if (comp && (g) < ngrp) { STAGE_MMA(cur, g) } \
        __builtin_amdgcn_sched_barrier(0); }
#define HALF_SLOTS(st, h, S, jl) { SLOT(st, h, 0, fa, fb, WRITE_A(S, (st) ^ 1, h) LOAD_A(S, jl)) SLOT(st, h, 1, fb, fa, WRITE_B(S, (st) ^ 1, h, 0, NB / 2)) \
        SLOT(st, h, 2, fa, fb, WRITE_B(S, (st) ^ 1, h, NB / 2, NB)) SLOT(st, h, 3, fb, fa, LOAD_B(S, jl)) }
#define PREFETCH(st, h) if (comp) { WF_LOAD(st, h) TF_LOAD(fa, st, h, 0) }
    const int nJ = K / 64;
    if (!preloaded) { LOAD_SET(0, 0) LOAD_SET(1, 1) }
    WRITE_SET(0, 0, 0) WRITE_SET(1, 0, 1)
    LOAD_SEL(0, 2) LOAD_SEL(1, 3)
    __syncthreads();
    int st = 0;
#pragma unroll 1
    for (int J = 0; J < nJ - 1; ++J) {
        PREFETCH(st, 0)
        HALF_SLOTS(st, 0, 0, 2 * J + 4)
        PREFETCH(st, 1)
        HALF_SLOTS(st, 1, 1, 2 * J + 5)
        __syncthreads();
        st ^= 1;
    }
    {
        PREFETCH(st, 0)
        HALF_MMA(st, 0)
        PREFETCH(st, 1)
        HALF_MMA(st, 1)
        __syncthreads();
    }
#undef HALF_MMA
#undef SLOT
#undef HALF_SLOTS
#undef WRITE_A
#undef WRITE_B
#undef LOAD_A
#undef LOAD_B
#undef PREFETCH
#undef LOAD_SET
#undef LOAD_SET_N
#undef LOAD_SEL
#undef WRITE_SET
#undef TF_LOAD
#undef WF_LOAD
#undef STAGE_MMA
#undef STAGE
    aoffc[0] = aoff_n[0]; aoffc[1] = aoff_n[1];
    {
        constexpr int NF = DUAL ? 2 : 4, ROWB = NF * 16 * OUTB, NCH = ROWB / 16, RPR = (8192 / ROWB) < 128 ? (8192 / ROWB) : 128, RPI = 64 / NCH, NROUND = 128 / RPR;
        constexpr float FP8_SCALE = 128.f;
        unsigned char* stg = lds + w * 8192;
        int l15e = l15; asm volatile("" : "+v"(l15e));
        const int colbase = (DUAL ? 32 : 64) * wn;
#pragma unroll
        for (int rd = 0; rd < NROUND; ++rd) {
            if (active) {
#pragma unroll
                for (int mt = rd * (RPR / 16); mt < (rd + 1) * (RPR / 16); ++mt) {
                    if ((mt >> 1) < ngrp) {
                        const int rloc = mt * 16 - rd * RPR + l15e, row = 128 * wm + mt * 16 + l15e;
#pragma unroll
                        for (int f = 0; f < NF; ++f) {
                            const f32x4 v = DUAL ? pre(row, colbase + 16 * f + 4 * kg, acc[mt][f], acc[mt][f + 2]) : pre(row, colbase + 16 * f + 4 * kg, acc[mt][f], acc[mt][f]);
                            if (OUTB == 4) *(f32x4*)(stg + rloc * ROWB + ((((unsigned)(4 * f + kg)) ^ (unsigned)(rloc & (NCH - 1))) << 4)) = v;
                            else if (OUTB == 2) { bf16x4 o; o[0] = (__bf16)v[0]; o[1] = (__bf16)v[1]; o[2] = (__bf16)v[2]; o[3] = (__bf16)v[3];
                                *(bf16x4*)(stg + rloc * ROWB + ((((unsigned)(2 * f + (kg >> 1))) ^ (unsigned)(rloc & (NCH - 1))) << 4) + 8 * (kg & 1)) = o; }
                            else { int pk = 0; pk = __builtin_amdgcn_cvt_pk_fp8_f32(v[0] * FP8_SCALE, v[1] * FP8_SCALE, pk, false); pk = __builtin_amdgcn_cvt_pk_fp8_f32(v[2] * FP8_SCALE, v[3] * FP8_SCALE, pk, true);
                                *(int*)(stg + rloc * ROWB + ((((unsigned)f) ^ (unsigned)(rloc & (NCH - 1))) << 4) + 4 * kg) = pk; }
                        }
                    }
                }
                asm volatile("s_waitcnt lgkmcnt(0)" ::: "memory");
#pragma unroll
                for (int it = 0; it < RPR / RPI; ++it) {
                    const int rloc = it * RPI + lane / NCH, c = lane % NCH, row = 128 * wm + rd * RPR + rloc;
                    const u32x4 dv = *(const u32x4*)(stg + rloc * ROWB + ((((unsigned)c) ^ (unsigned)(rloc & (NCH - 1))) << 4));
                    if (row < rows) fin(row, colbase + c * (16 / OUTB), dv);
                }
                asm volatile("s_waitcnt lgkmcnt(0)" ::: "memory");
            }
        }
    }
    __syncthreads();
}

template <bool DUAL, bool BK16, int OUTB, int LDB, int WN, class RowFn, class Pre, class Fin>
DI void gemm_mfma(const bf16_t* Ab, const RowFn& rowoff, const float* B0, const float* B1, unsigned bbytes, int K, int rows, const Pre& pre, const Fin& fin, unsigned char* lds) {
    u32x4 ra[2][2], rb[2][4]; unsigned ao[2] = {0u, 0u};
    gemm_core<DUAL, BK16, OUTB, LDB, WN>(ra, rb, ao, false, Ab, rowoff, B0, B1, bbytes, K, rows, false, rowoff, B0, B1, bbytes, rows, pre, fin, lds);
}
#define PRE_ID [](int, int, f32x4 v, f32x4) { return v; }

DI void phase_prep(const Params& p, int bid, int nblk, float* lds) {
    const int tid = threadIdx.x, lane = tid & 63, wave = tid >> 6;
    bf16_t* xb = (bf16_t*)(p.ws + OFF_XB); float* glow = (float*)(p.ws + OFF_GLOW);
    float tw = 0.f;
    {
        const int ti = (bid >> 3) * NT + tid;
        if (ti < 1536) { const int m = ti >> 9, j = ti & 511; const float* bp = m == 0 ? p.wg : (m == 1 ? p.wu : p.wd); tw = bp[(size_t)j * 131072]; }
    }
    f32x4* Wl = (f32x4*)lds;
    for (int idx = tid; idx < 4096; idx += NT) {
        const int k = idx >> 2, q = idx & 3, ln = (k >> 2) & 63, j = k >> 8, c = k & 3;
        Wl[((j * 4 + c) * 4 + q) * 64 + ln] = *(const f32x4*)(p.w_in + (size_t)k * DIN + GL_OFF + 4 * q);
    }
    __syncthreads();
    for (int row0 = (bid * 8 + wave) * 4; row0 < T; row0 += nblk * 32) {
        asm volatile("" ::: "memory");
        f32x4 xv[4][4];
#pragma unroll
        for (int r = 0; r < 4; ++r)
#pragma unroll
            for (int j = 0; j < 4; ++j) {
                xv[r][j] = ((const f32x4*)(p.x + (size_t)(row0 + r) * D))[lane + 64 * j];
                uint2 o; o.x = pk2(xv[r][j][0], xv[r][j][1]); o.y = pk2(xv[r][j][2], xv[r][j][3]);
                ((uint2*)(xb + (size_t)(row0 + r) * D))[lane + 64 * j] = o;
            }
        float acc[4][16];
#pragma unroll
        for (int r = 0; r < 4; ++r)
#pragma unroll
            for (int n = 0; n < 16; ++n) acc[r][n] = 0.f;
#pragma unroll
        for (int j = 0; j < 4; ++j)
#pragma unroll
            for (int c = 0; c < 4; ++c) {
                float wv[16];
#pragma unroll
                for (int q = 0; q < 4; ++q) { const f32x4 w4 = Wl[((j * 4 + c) * 4 + q) * 64 + lane]; wv[4 * q] = w4[0]; wv[4 * q + 1] = w4[1]; wv[4 * q + 2] = w4[2]; wv[4 * q + 3] = w4[3]; }
#pragma unroll
                for (int r = 0; r < 4; ++r) {
                    const float xs = xv[r][j][c];
#pragma unroll
                    for (int n = 0; n < 16; ++n) acc[r][n] += xs * wv[n];
                }
            }
#define RS_STEP(N, OFF) { const bool up = (lane & (OFF)) != 0; _Pragma("unroll") for (int i = 0; i < (N); ++i) { \
            const float a = acc[i / 16][i % 16], b = acc[(i + (N)) / 16][(i + (N)) % 16]; const float snd = up ? a : b, kp = up ? b : a; \
            acc[i / 16][i % 16] = kp + __shfl_xor(snd, (OFF)); } }
        RS_STEP(32, 32) RS_STEP(16, 16) RS_STEP(8, 8) RS_STEP(4, 4) RS_STEP(2, 2) RS_STEP(1, 1)
#undef RS_STEP
        glow[(size_t)row0 * 16 + lane] = acc[0][0];
    }
    {
        bf16_t* wbin = (bf16_t*)(p.ws + OFF_WB_IN); bf16_t* wbout = (bf16_t*)(p.ws + OFF_WB_OUT); bf16_t* wbrt = (bf16_t*)(p.ws + OFF_WB_RT);
        bf16_t* wbsgu = (bf16_t*)(p.ws + OFF_WB_SGU); bf16_t* wbsd = (bf16_t*)(p.ws + OFF_WB_SD);
        constexpr int N_IN = 1024 * 512, N_OUT = 1024 * 256, N_RT = 1024 * 64, N_SGU = 1024 * 128, N_SD = 256 * 256;
        for (int it = bid * NT + tid; it < N_IN + N_OUT + N_RT + N_SGU + N_SD; it += nblk * NT) {
            const float* s; bf16_t* d; int r = it;
            if (r < N_IN) { const int k = r >> 9, c = (r & 511) * 4; s = p.w_in + (size_t)k * DIN + c; d = wbin + (size_t)k * 2048 + c; }
            else if ((r -= N_IN) < N_OUT) { s = p.w_out + (size_t)r * 4; d = wbout + (size_t)r * 4; }
            else if ((r -= N_OUT) < N_RT) { s = p.router_w + (size_t)r * 4; d = wbrt + (size_t)r * 4; }
            else if ((r -= N_RT) < N_SGU) { const int k = r >> 7, c = (r & 127) * 4, nt = c >> 8, h = (c >> 7) & 1, cc = c & 127; s = (h ? p.su : p.sg) + (size_t)k * EDIM + nt * 128 + cc; d = wbsgu + (size_t)k * 512 + c; }
            else { r -= N_SGU; s = p.sd + (size_t)r * 4; d = wbsd + (size_t)r * 4; }
            const f32x4 v = *(const f32x4*)s; uint2 o; o.x = pk2(v[0], v[1]); o.y = pk2(v[2], v[3]); *(uint2*)d = o;
        }
    }
    asm volatile("" :: "v"(tw));
    __syncthreads();
}

DI void phase_proj(const Params& p, int bid, int nblk, float* lds) {
    const bf16_t* xb = (const bf16_t*)(p.ws + OFF_XB); bf16_t* proj = (bf16_t*)(p.ws + OFF_PROJ); const bf16_t* wbin = (const bf16_t*)(p.ws + OFF_WB_IN);
    u32x4 ra[2][2], rb[2][4]; unsigned ao[2] = {0u, 0u}; bool pre = false;
    const bool xl = (nblk == 256);
    for (int u = bid; u < 64 * 8; u += nblk) {
        const int un = u + nblk; const bool hn = un < 64 * 8;
        const int mt = xl ? 32 * (u >> 8) + 4 * (u & 7) + ((u & 255) >> 6) : u >> 3, nt = xl ? ((u & 255) >> 3) & 7 : u & 7;
        const int mtn = xl ? 32 * (un >> 8) + 4 * (un & 7) + ((un & 255) >> 6) : un >> 3, ntn = xl ? ((un & 255) >> 3) & 7 : un & 7;
        auto rowoff = [&](int r) { return (unsigned)((mt * 256 + r) * D); };
        auto rowoff_n = [&](int r) { return (unsigned)((mtn * 256 + r) * D); };
        auto fin = [&](int r, int c, u32x4 dv) { *(u32x4*)(proj + (size_t)(mt * 256 + r) * NPROJ + nt * 256 + c) = dv; };
        gemm_core<false, true, 2, NPROJ, 4>(ra, rb, ao, pre, xb, rowoff, (const float*)(wbin + nt * 256), nullptr, (unsigned)(((size_t)D * NPROJ - nt * 256) * 2), D, 256,
                                 hn, rowoff_n, (const float*)(wbin + ntn * 256), nullptr, (unsigned)(((size_t)D * NPROJ - ntn * 256) * 2), 256, PRE_ID, fin, (unsigned char*)lds);
        pre = hn;
    }
}

template <int W>
DI void poolmean_item(const bf16_t* proj, bf16_t* pm, int t0, int c2) {
    const int s0 = t0 & (SEQ - 1);
    float p0[48], p1[48]; unsigned raw[32];
    p0[0] = 0.f; p1[0] = 0.f;
#pragma unroll
    for (int i = 0; i < 47; ++i) {
        unsigned v = 0u;
        if (i >= 15 || s0 > 0) v = *(const unsigned*)(proj + (size_t)(t0 - 15 + i) * NPROJ + P_OFF + c2);
        if (i >= 15) raw[i - 15] = v;
        p0[i + 1] = p0[i] + __uint_as_float(v << 16); p1[i + 1] = p1[i] + __uint_as_float(v & 0xffff0000u);
    }
#pragma unroll
    for (int i = 0; i < 32; ++i) {
        const int s = s0 + i; const float inv = 1.f / (float)min(s + 1, W);
        const float m0 = (p0[i + 16] - p0[i + 16 - W]) * inv - __uint_as_float(raw[i] << 16);
        const float m1 = (p1[i + 16] - p1[i + 16 - W]) * inv - __uint_as_float(raw[i] & 0xffff0000u);
        *(unsigned*)(pm + (size_t)(t0 + i) * 512 + c2) = pk2(m0, m1);
    }
}
DI void phase_poolmean(const Params& p, int bid, int nblk, float* lds) {
    const bf16_t* proj = (const bf16_t*)(p.ws + OFF_PROJ); bf16_t* pm = (bf16_t*)(p.ws + OFF_PM);
    for (int item = bid * NT + threadIdx.x; item < 256 * (T / 32); item += nblk * NT) {
        const int pair = item & 255, t0 = (item >> 8) * 32, c2 = pair * 2, g = __builtin_amdgcn_readfirstlane(pair >> 6);
        if (g == 0) poolmean_item<2>(proj, pm, t0, c2);
        else if (g == 1) poolmean_item<4>(proj, pm, t0, c2);
        else if (g == 2) poolmean_item<8>(proj, pm, t0, c2);
        else poolmean_item<16>(proj, pm, t0, c2);
    }
}
DI void phase_pool(const Params& p, int bid, int nblk, float* lds) {
    const bf16_t* pm = (const bf16_t*)(p.ws + OFF_PM); bf16_t* mix = (bf16_t*)(p.ws + OFF_MIX);
    for (int u = bid; u < 64 * 4; u += nblk) {
        const int mt = u >> 2, g = u & 3;
        auto rowoff = [&](int r) { return (unsigned)((mt * 256 + r) * 512 + g * 128); };
        auto pre = [&](int r, int c, f32x4 v, f32x4) { const f32x4 sc = *(const f32x4*)(p.pool_scale + g * 128 + c); return v * sc; };
        auto fin = [&](int r, int c, u32x4 dv) { *(u32x4*)(mix + (size_t)(mt * 256 + r) * D + g * 128 + c) = dv; };
        gemm_mfma<false, false, 2, 128, 2>(pm, rowoff, p.pool_w + (size_t)g * 16384, nullptr, (unsigned)((4 - g) * 16384 * 4), 128, 256, pre, fin, (unsigned char*)lds);
    }
}

DI unsigned f1_off(unsigned row, unsigned chunk) { return row * 128u + ((chunk ^ ((row >> 1) & 7u)) << 4); }
DI unsigned f2_off(unsigned row, unsigned ch) { return 256u * row + 16u * (ch ^ (((row & 3u) << 2) | ((row >> 2) & 3u))); }
DI bf16x8 f1_frag(const unsigned char* img, int tile, int ks, int lane) { return *(const bf16x8*)(img + f1_off(16 * tile + (lane & 15), 4 * ks + (lane >> 4))); }
DI bf16x8 f2_frag(const unsigned char* img, int c, int ks, int lane) {
    const unsigned g = lane >> 4, q = (lane & 15) >> 2, pp = lane & 3;
    const unsigned a0 = f2_off(32 * ks + 8 * g + q, 2 * c + (pp >> 1)) + 8 * (pp & 1), a1 = f2_off(32 * ks + 8 * g + 4 + q, 2 * c + (pp >> 1)) + 8 * (pp & 1);
    const s16x4 lo = __builtin_amdgcn_ds_read_tr16_b64_v4i16((LAS3 s16x4*)(img + a0)), hi = __builtin_amdgcn_ds_read_tr16_b64_v4i16((LAS3 s16x4*)(img + a1));
    return __builtin_bit_cast(bf16x8, __builtin_shufflevector(lo, hi, 0, 1, 2, 3, 4, 5, 6, 7));
}
DI float bfbits2f(unsigned short v) { return __uint_as_float(((unsigned)v) << 16); }
typedef unsigned short u16x8 __attribute__((ext_vector_type(8)));
typedef unsigned short u16x4 __attribute__((ext_vector_type(4)));

DI void phase_gla1(const Params& p, int bid, int nblk, float* ldsf) {
    unsigned char* lds = (unsigned char*)ldsf;
    int tid_ = threadIdx.x; asm volatile("" : "+v"(tid_));
    const int tid = tid_, lane = tid & 63, w = __builtin_amdgcn_readfirstlane(tid >> 6), t = tid >> 3, ch = tid & 7;
    const bf16_t* proj = (const bf16_t*)(p.ws + OFF_PROJ); const float* glow = (const float*)(p.ws + OFF_GLOW);
    float* Gbuf = (float*)(p.ws + OFF_G); float* Sloc = (float*)(p.ws + OFF_SLOC); float* dec = (float*)(p.ws + OFF_DEC);
    float* G = (float*)lds; unsigned char* Kimg = lds + 16384; unsigned char* Vimg = lds + 32768; float* W2l = (float*)(lds + 49152); float* segtot = (float*)(lds + 53248);
    for (int unit = bid; unit < 1024; unit += nblk) {
        const int bh = unit >> 6, n = unit & 63, b = bh >> 2, h = bh & 3, t0 = b * SEQ + n * SC;
        for (int i = tid; i < 1024; i += NT) W2l[i] = p.gate_w2[(i >> 6) * 256 + h * 64 + (i & 63)];
#pragma unroll
        for (int i = 0; i < 2; ++i) { const int idx = tid + NT * i, tr = idx >> 4, c16 = idx & 15;
            *(u32x4*)(Vimg + f2_off(tr, c16)) = *(const u32x4*)(proj + (size_t)(t0 + tr) * NPROJ + V_OFF + h * 128 + 8 * c16); }
        __syncthreads();
        {
            float gl[16];
#pragma unroll
            for (int q = 0; q < 4; ++q) { const f32x4 v = *(const f32x4*)(glow + (size_t)(t0 + t) * 16 + 4 * q); gl[4 * q] = v[0]; gl[4 * q + 1] = v[1]; gl[4 * q + 2] = v[2]; gl[4 * q + 3] = v[3]; }
#pragma unroll
            for (int dd = 0; dd < 8; ++dd) { const int d = 8 * ch + dd; float z = p.gate_b[h * 64 + d];
#pragma unroll
                for (int r = 0; r < 16; ++r) z += gl[r] * W2l[r * 64 + d];
                G[t * 64 + d] = logsigmoidf_(z) * (1.f / 16.f); }
        }
        __syncthreads();
        {
            const int seg = tid >> 6, d = tid & 63; float run = 0.f;
#pragma unroll
            for (int tt = 0; tt < 8; ++tt) { run += G[(8 * seg + tt) * 64 + d]; G[(8 * seg + tt) * 64 + d] = run; }
            segtot[seg * 64 + d] = run;
            __syncthreads();
            float pre = 0.f;
            for (int s2 = 0; s2 < seg; ++s2) pre += segtot[s2 * 64 + d];
#pragma unroll
            for (int tt = 0; tt < 8; ++tt) G[(8 * seg + tt) * 64 + d] += pre;
        }
        __syncthreads();
        {
            const f32x4 g0 = *(const f32x4*)(G + t * 64 + 8 * ch), g1 = *(const f32x4*)(G + t * 64 + 8 * ch + 4);
            const f32x4 l0 = *(const f32x4*)(G + 63 * 64 + 8 * ch), l1 = *(const f32x4*)(G + 63 * 64 + 8 * ch + 4);
            *(f32x4*)(Gbuf + (size_t)(t0 + t) * 256 + h * 64 + 8 * ch) = g0; *(f32x4*)(Gbuf + (size_t)(t0 + t) * 256 + h * 64 + 8 * ch + 4) = g1;
            const u16x8 kv = *(const u16x8*)(proj + (size_t)(t0 + t) * NPROJ + K_OFF + h * 64 + 8 * ch);
            bf16x8 o;
#pragma unroll
            for (int dd = 0; dd < 4; ++dd) { o[dd] = (__bf16)(bfbits2f(kv[dd]) * __expf(l0[dd] - g0[dd])); o[dd + 4] = (__bf16)(bfbits2f(kv[dd + 4]) * __expf(l1[dd] - g1[dd])); }
            *(bf16x8*)(Kimg + f2_off(t, ch)) = o;
            if (t == 63) {
#pragma unroll
                for (int dd = 0; dd < 4; ++dd) { dec[unit * 64 + 8 * ch + dd] = __expf(l0[dd]); dec[unit * 64 + 8 * ch + 4 + dd] = __expf(l1[dd]); }
            }
        }
        __syncthreads();
        {
            f32x4 acc[4];
#pragma unroll
            for (int dt = 0; dt < 4; ++dt) acc[dt] = (f32x4){0.f, 0.f, 0.f, 0.f};
#pragma unroll
            for (int ks = 0; ks < 2; ++ks) {
                const bf16x8 xv = f2_frag(Vimg, w, ks, lane);
#pragma unroll
                for (int dt = 0; dt < 4; ++dt) acc[dt] = MFMA16(xv, f2_frag(Kimg, dt, ks, lane), acc[dt]);
            }
#pragma unroll
            for (int dt = 0; dt < 4; ++dt) *(f32x4*)(Sloc + (size_t)unit * 8192 + (16 * dt + (lane & 15)) * 128 + 16 * w + 4 * (lane >> 4)) = acc[dt];
        }
        __syncthreads();
    }
}

DI void phase_gla2(const Params& p, int bid, int nblk, float* lds) {
    const float* Sloc = (const float*)(p.ws + OFF_SLOC); const float* dec = (const float*)(p.ws + OFF_DEC); bf16_t* Sin = (bf16_t*)(p.ws + OFF_SIN);
    for (int gid = bid * NT + threadIdx.x; gid < 16 * 8192; gid += nblk * NT) {
        const int bh = gid >> 13, el = gid & 8191, d = el >> 7; float st = 0.f;
        for (int n0 = 0; n0 < NSC; n0 += 16) {
            float sl[16], dc[16]; bf16_t so[16];
#pragma unroll
            for (int i = 0; i < 16; ++i) { const int u = bh * 64 + n0 + i; sl[i] = Sloc[(size_t)u * 8192 + el]; dc[i] = dec[u * 64 + d]; }
#pragma unroll
            for (int i = 0; i < 16; ++i) { so[i] = f2bf(st); st = st * dc[i] + sl[i]; }
#pragma unroll
            for (int i = 0; i < 16; ++i) Sin[(size_t)(bh * 64 + n0 + i) * 8192 + el] = so[i];
        }
    }
}

DI void phase_gla3(const Params& p, int bid, int nblk, float* ldsf) {
    unsigned char* lds = (unsigned char*)ldsf;
    int tid_ = threadIdx.x; asm volatile("" : "+v"(tid_));
    const int tid = tid_, lane = tid & 63, w = __builtin_amdgcn_readfirstlane(tid >> 6), t = tid >> 3, ch = tid & 7, l15 = lane & 15, kg = lane >> 4;
    const bf16_t* proj = (const bf16_t*)(p.ws + OFF_PROJ); const float* Gbuf = (const float*)(p.ws + OFF_G); const bf16_t* Sin = (const bf16_t*)(p.ws + OFF_SIN);
    bf16_t* mix = (bf16_t*)(p.ws + OFF_MIX);
    unsigned char* Qimg = lds; unsigned char* Kimg = lds + 8192; unsigned char* Pimg = lds + 16384; unsigned char* Vimg = lds + 24576; unsigned char* Simg = lds + 40960;
    float* part = (float*)(lds + 57344);
    for (int unit = bid; unit < 1024; unit += nblk) {
        const int bh = unit >> 6, n = unit & 63, b = bh >> 2, h = bh & 3, t0 = b * SEQ + n * SC;
        {
            const f32x4 g0 = *(const f32x4*)(Gbuf + (size_t)(t0 + t) * 256 + h * 64 + 8 * ch), g1 = *(const f32x4*)(Gbuf + (size_t)(t0 + t) * 256 + h * 64 + 8 * ch + 4);
            const u16x8 qv = *(const u16x8*)(proj + (size_t)(t0 + t) * NPROJ + Q_OFF + h * 64 + 8 * ch), kv = *(const u16x8*)(proj + (size_t)(t0 + t) * NPROJ + K_OFF + h * 64 + 8 * ch);
            bf16x8 qo, ko;
#pragma unroll
            for (int dd = 0; dd < 4; ++dd) {
                qo[dd] = (__bf16)(bfbits2f(qv[dd]) * 0.125f * __expf(g0[dd])); qo[dd + 4] = (__bf16)(bfbits2f(qv[dd + 4]) * 0.125f * __expf(g1[dd]));
                ko[dd] = (__bf16)(bfbits2f(kv[dd]) * __expf(-g0[dd])); ko[dd + 4] = (__bf16)(bfbits2f(kv[dd + 4]) * __expf(-g1[dd]));
            }
            *(bf16x8*)(Qimg + f1_off(t, ch)) = qo; *(bf16x8*)(Kimg + f1_off(t, ch)) = ko;
        }
#pragma unroll
        for (int i = 0; i < 2; ++i) { const int idx = tid + NT * i, tr = idx >> 4, c16 = idx & 15;
            *(u32x4*)(Vimg + f2_off(tr, c16)) = *(const u32x4*)(proj + (size_t)(t0 + tr) * NPROJ + V_OFF + h * 128 + 8 * c16);
            *(u32x4*)(Simg + f2_off(tr, c16)) = *(const u32x4*)(Sin + (size_t)unit * 8192 + tr * 128 + 8 * c16); }
        __syncthreads();
        {
            const int it = w >> 1;
#pragma unroll
            for (int jj = 0; jj < 2; ++jj) {
                const int jt = 2 * (w & 1) + jj; f32x4 acc = {0.f, 0.f, 0.f, 0.f};
                if (jt <= it) {
#pragma unroll
                    for (int ks = 0; ks < 2; ++ks) acc = MFMA16(f1_frag(Kimg, jt, ks, lane), f1_frag(Qimg, it, ks, lane), acc);
                    if (jt == it) {
#pragma unroll
                        for (int r = 0; r < 4; ++r) if (4 * kg + r > l15) acc[r] = 0.f;
                    }
                }
                bf16x4 o; o[0] = (__bf16)acc[0]; o[1] = (__bf16)acc[1]; o[2] = (__bf16)acc[2]; o[3] = (__bf16)acc[3];
                *(bf16x4*)(Pimg + f1_off(16 * it + l15, 2 * jt + (kg >> 1)) + 8 * (kg & 1)) = o;
            }
        }
        __syncthreads();
        {
            f32x4 acc[4];
#pragma unroll
            for (int it = 0; it < 4; ++it) acc[it] = (f32x4){0.f, 0.f, 0.f, 0.f};
#pragma unroll
            for (int ks = 0; ks < 2; ++ks) {
                const bf16x8 xv = f2_frag(Vimg, w, ks, lane), xs = f2_frag(Simg, w, ks, lane);
#pragma unroll
                for (int it = 0; it < 4; ++it) {
                    if (2 * ks <= it) acc[it] = MFMA16(xv, f1_frag(Pimg, it, ks, lane), acc[it]);
                    acc[it] = MFMA16(xs, f1_frag(Qimg, it, ks, lane), acc[it]);
                }
            }
#pragma unroll
            for (int it = 0; it < 4; ++it) {
                float ss = acc[it][0] * acc[it][0] + acc[it][1] * acc[it][1] + acc[it][2] * acc[it][2] + acc[it][3] * acc[it][3];
                ss += __shfl_xor(ss, 16); ss += __shfl_xor(ss, 32);
                if (kg == 0) part[w * 64 + 16 * it + l15] = ss;
            }
            __syncthreads();
            const int e0 = 16 * w + 4 * kg; const f32x4 nw = *(const f32x4*)(p.norm_w + e0);
#pragma unroll
            for (int it = 0; it < 4; ++it) {
                const int i = 16 * it + l15; float tot = 0.f;
#pragma unroll
                for (int w2 = 0; w2 < 8; ++w2) tot += part[w2 * 64 + i];
                const float inv = rsqrtf(tot * (1.f / 128.f) + RMS_EPS);
                const u16x4 rv = *(const u16x4*)(proj + (size_t)(t0 + i) * NPROJ + R_OFF + h * 128 + e0);
                bf16x4 o;
#pragma unroll
                for (int r = 0; r < 4; ++r) { const float rr = bfbits2f(rv[r]); o[r] = (__bf16)(acc[it][r] * inv * nw[r] * (rr * sigmoidf_(rr))); }
                *(bf16x4*)(mix + (size_t)(t0 + i) * D + 512 + h * 128 + e0) = o;
            }
        }
        __syncthreads();
    }
}

DI void phase_out(const Params& p, int bid, int nblk, float* lds) {
    const bf16_t* mix = (const bf16_t*)(p.ws + OFF_MIX); float* h32 = (float*)(p.ws + OFF_H32);
    for (int u = bid; u < 64 * 4; u += nblk) {
        const int mt = (nblk == 256) ? 8 * (u & 7) + (u >> 5) : u >> 2, nt = (nblk == 256) ? (u >> 3) & 3 : u & 3;
        auto rowoff = [&](int r) { return (unsigned)((mt * 256 + r) * D); };
        auto fin = [&](int r, int c, u32x4 dv) { const size_t o = (size_t)(mt * 256 + r) * D + nt * 256 + c; const f32x4 xv = *(const f32x4*)(p.x + o); *(f32x4*)(h32 + o) = xv * ALPHA + __builtin_bit_cast(f32x4, dv); };
        gemm_mfma<false, true, 4, D, 4>(mix, rowoff, (const float*)((const bf16_t*)(p.ws + OFF_WB_OUT) + nt * 256), nullptr, (unsigned)(((size_t)D * D - nt * 256) * 2), D, 256, PRE_ID, fin, (unsigned char*)lds);
    }
}

DI void ln_row(float (&v)[16], const float* g, const float* b, int lane) {
    float s = 0.f;
#pragma unroll
    for (int i = 0; i < 16; ++i) s += v[i];
    const float mean = wave_sum(s) * (1.f / D); float q = 0.f;
#pragma unroll
    for (int i = 0; i < 16; ++i) { v[i] -= mean; q += v[i] * v[i]; }
    const float rstd = rsqrtf(wave_sum(q) * (1.f / D) + LN_EPS);
#pragma unroll
    for (int j = 0; j < 4; ++j) {
        const float4 gg = ((const float4*)g)[lane + 64 * j], bb = ((const float4*)b)[lane + 64 * j];
        v[4 * j] = v[4 * j] * rstd * gg.x + bb.x; v[4 * j + 1] = v[4 * j + 1] * rstd * gg.y + bb.y;
        v[4 * j + 2] = v[4 * j + 2] * rstd * gg.z + bb.z; v[4 * j + 3] = v[4 * j + 3] * rstd * gg.w + bb.w;
    }
}

DI void ln1_rows(const Params& p, int r0, int nrows) {
    int tid_ = threadIdx.x; asm volatile("" : "+v"(tid_));
    const int lane = tid_ & 63, wave = tid_ >> 6;
    const float* h32 = (const float*)(p.ws + OFF_H32); bf16_t* hb = (bf16_t*)(p.ws + OFF_HB);
    for (int rb = r0 + wave; rb < r0 + nrows; rb += 32) {
        float v[4][16];
#pragma unroll
        for (int q = 0; q < 4; ++q) {
            const float4* hr = (const float4*)(h32 + (size_t)(rb + 8 * q) * D);
#pragma unroll
            for (int j = 0; j < 4; ++j) { const float4 a = hr[lane + 64 * j]; v[q][4 * j] = a.x; v[q][4 * j + 1] = a.y; v[q][4 * j + 2] = a.z; v[q][4 * j + 3] = a.w; }
        }
        float s[4], qq[4];
#pragma unroll
        for (int q = 0; q < 4; ++q) { s[q] = 0.f; _Pragma("unroll") for (int i = 0; i < 16; ++i) s[q] += v[q][i]; }
#pragma unroll
        for (int o = 1; o < 64; o <<= 1) { _Pragma("unroll") for (int q = 0; q < 4; ++q) s[q] += __shfl_xor(s[q], o); }
#pragma unroll
        for (int q = 0; q < 4; ++q) { const float mean = s[q] * (1.f / D); qq[q] = 0.f; _Pragma("unroll") for (int i = 0; i < 16; ++i) { v[q][i] -= mean; qq[q] += v[q][i] * v[q][i]; } }
#pragma unroll
        for (int o = 1; o < 64; o <<= 1) { _Pragma("unroll") for (int q = 0; q < 4; ++q) qq[q] += __shfl_xor(qq[q], o); }
#pragma unroll
        for (int j = 0; j < 4; ++j) {
            const float4 gg = ((const float4*)p.ln1_g)[lane + 64 * j], bb = ((const float4*)p.ln1_b)[lane + 64 * j];
#pragma unroll
            for (int q = 0; q < 4; ++q) {
                const float rstd = rsqrtf(qq[q] * (1.f / D) + LN_EPS);
                uint2 o; o.x = pk2(v[q][4 * j] * rstd * gg.x + bb.x, v[q][4 * j + 1] * rstd * gg.y + bb.y); o.y = pk2(v[q][4 * j + 2] * rstd * gg.z + bb.z, v[q][4 * j + 3] * rstd * gg.w + bb.w);
                ((uint2*)(hb + (size_t)(rb + 8 * q) * D))[lane + 64 * j] = o;
            }
        }
    }
}

DI void topk_rows(const Params& p, int r0, int nrows) {
    int tid_ = threadIdx.x; asm volatile("" : "+v"(tid_));
    const int lane = tid_ & 63, wave = tid_ >> 6;
    const float* scores = (const float*)(p.ws + OFF_SCORES); float* wbuf = (float*)(p.ws + OFF_WBUF);
    int* list = (int*)(p.ws + OFF_LIST); unsigned* cnt = (unsigned*)(p.ws + OFF_CTL) + CW_CNT;
    const float NEG = -__builtin_inff();
    for (int t = r0 + wave; t < r0 + nrows; t += 8) {
        const float4 sv = ((const float4*)(scores + (size_t)t * NE))[lane], bv = ((const float4*)p.router_bias)[lane];
        const float s[4] = {sv.x, sv.y, sv.z, sv.w};
        float cand[4] = {sv.x + bv.x, sv.y + bv.y, sv.z + bv.z, sv.w + bv.w};
        float m1 = NEG, m2 = NEG;
#pragma unroll
        for (int j = 0; j < 4; ++j) { const float v = cand[j]; if (v > m1) { m2 = m1; m1 = v; } else if (v > m2) m2 = v; }
#pragma unroll
        for (int off = 1; off < 8; off <<= 1) {
            const float o1 = __shfl_xor(m1, off), o2 = __shfl_xor(m2, off);
            const float n1 = fmaxf(m1, o1), n2 = fmaxf(fminf(m1, o1), fmaxf(m2, o2)); m1 = n1; m2 = n2;
        }
        const float gs = m1 + m2; const int mygrp = lane >> 3; int rank = 0;
#pragma unroll
        for (int g2 = 0; g2 < 8; ++g2) { const float og = __shfl(gs, g2 * 8); if (og > gs || (og == gs && g2 < mygrp)) ++rank; }
        if (rank >= 4) { cand[0] = NEG; cand[1] = NEG; cand[2] = NEG; cand[3] = NEG; }
        int my_e = 0; float my_w = 0.f, wsum = 0.f;
#pragma unroll
        for (int k = 0; k < TOPK; ++k) {
            float bvv = cand[0]; int bj = 0;
#pragma unroll
            for (int j = 1; j < 4; ++j) if (cand[j] > bvv) { bvv = cand[j]; bj = j; }
            int bi = 4 * lane + bj;
#pragma unroll
            for (int off = 32; off >= 1; off >>= 1) {
                const float ov = __shfl_xor(bvv, off); const int oi = __shfl_xor(bi, off);
                if (ov > bvv || (ov == bvv && oi < bi)) { bvv = ov; bi = oi; }
            }
            const int wj = bi & 3, wl = bi >> 2;
            const float mys = wj == 0 ? s[0] : (wj == 1 ? s[1] : (wj == 2 ? s[2] : s[3]));
            const float wk = __shfl(mys, wl);
            wsum += wk;
            if (lane == k) { my_e = bi; my_w = wk; }
            if (lane == wl) {
#pragma unroll
                for (int j = 0; j < 4; ++j) if (j == wj) cand[j] = NEG;
            }
        }
        if (lane < TOPK) {
            const unsigned pos = atomicAdd(&cnt[my_e], 1u);
            list[(size_t)my_e * LCAP + pos] = t * TOPK + lane;
            wbuf[(size_t)t * TOPK + lane] = my_w / wsum * 2.5f;
        }
    }
}

DI void phase_route(const Params& p, int bid, int nblk, float* lds) {
    const bf16_t* hb = (const bf16_t*)(p.ws + OFF_HB); float* scores = (float*)(p.ws + OFF_SCORES);
    for (int mt = bid; mt < T / 64; mt += nblk) {
        ln1_rows(p, mt * 64, 64);
        __syncthreads();
        auto rowoff = [&](int r) { return (unsigned)((mt * 64 + r) * D); };
        auto pre = [&](int r, int c, f32x4 v, f32x4) { return (f32x4){sigmoidf_(v[0]), sigmoidf_(v[1]), sigmoidf_(v[2]), sigmoidf_(v[3])}; };
        auto fin = [&](int r, int c, u32x4 dv) { *(u32x4*)(scores + (size_t)(mt * 64 + r) * NE + c) = dv; };
        gemm_mfma<false, true, 4, NE, 4>(hb, rowoff, (const float*)(p.ws + OFF_WB_RT), nullptr, (unsigned)(D * NE * 2), D, 64, pre, fin, (unsigned char*)lds);
        __syncthreads();
        topk_rows(p, mt * 64, 64);
        __syncthreads();
    }
}

constexpr int EXP_TAB_OFF = GEMM_LDS_BYTES;
DI void build_tables(const Params& p, int* toff, int* roff) {
    const unsigned* cnt = (const unsigned*)(p.ws + OFF_CTL) + CW_CNT;
    int* cl = roff + 260;
    if (threadIdx.x < NE) cl[threadIdx.x] = (int)__hip_atomic_load(cnt + threadIdx.x, __ATOMIC_RELAXED, __HIP_MEMORY_SCOPE_AGENT);
    __syncthreads();
    if (threadIdx.x <= NE) {
        int ta = 0, ra = 0;
        for (int e = 0; e < (int)threadIdx.x; ++e) { const int c = cl[e]; ta += (c + 255) >> 8; ra += c; }
        toff[threadIdx.x] = ta; roff[threadIdx.x] = ra;
    }
    __syncthreads();
    if (threadIdx.x < NE) { unsigned char* texp = (unsigned char*)(roff + 1040); for (int t = toff[threadIdx.x]; t < toff[threadIdx.x + 1]; ++t) texp[t] = (unsigned char)threadIdx.x; }
    __syncthreads();
}
DI int find_expert(const int* toff, int tile) { int lo = 0, hi = NE - 1; while (lo < hi) { const int mid = (lo + hi + 1) >> 1; if (toff[mid] <= tile) lo = mid; else hi = mid - 1; } return lo; }
struct ExpUnit { int e, row0, rows, rowbase; };
DI ExpUnit exp_unit(const int* toff, const int* roff, int e, int tile, int ntile) {
    const int* cl = roff + 260;
    ExpUnit u;
    if (tile < ntile) {
        u.e = e; const int ui = tile - toff[e], c = cl[e];
        u.row0 = ui * 256; u.rows = min(256, c - u.row0); u.rowbase = roff[e] + u.row0;
    } else { u.e = NE; u.row0 = (tile - ntile) * 256; u.rows = 256; u.rowbase = A_TOT + u.row0; }
    u.e = __builtin_amdgcn_readfirstlane(u.e); u.row0 = __builtin_amdgcn_readfirstlane(u.row0); u.rows = __builtin_amdgcn_readfirstlane(u.rows);
    u.rowbase = __builtin_amdgcn_readfirstlane(u.rowbase);
    return u;
}

template <int NTL>
DI int exp_decode(const int* toff, int ntile, int u, int& tile, int& nt) {
    if (u < NTL * ntile) {
        const unsigned char* texp = (const unsigned char*)(toff + 260 + 1040);
        const int e = texp[u / NTL], t0 = toff[e], ne = toff[e + 1] - t0; int u2 = u - NTL * t0; nt = 0;
#pragma unroll
        for (int i = 1; i < NTL; ++i) if (u2 >= ne) { u2 -= ne; ++nt; }
        tile = t0 + u2; return e;
    }
    else { const int us = u - NTL * ntile; nt = us / (T / 256); tile = ntile + (us - nt * (T / 256)); return NE; }
}

DI void phase_e1(const Params& p, int bid, int nblk, float* lds) {
    int* toff = (int*)((unsigned char*)lds + EXP_TAB_OFF); int* roff = toff + 260;
    const bf16_t* hb = (const bf16_t*)(p.ws + OFF_HB); bf16_t* hid = (bf16_t*)(p.ws + OFF_HID); const int* list = (const int*)(p.ws + OFF_LIST);
    build_tables(p, toff, roff);
    const int ntile = toff[NE], units = (ntile + T / 256) * 2;
    const int vb = (nblk & 7) ? bid : (bid & 7) * (nblk >> 3) + (bid >> 3);
    u32x4 ra[2][2], rb[2][4]; unsigned ao[2] = {0u, 0u}; bool pre = false;
    int tile_n = 0, nt_n = 0; ExpUnit xn;
    if (vb < units) { const int e_ = exp_decode<2>(toff, ntile, vb, tile_n, nt_n); xn = exp_unit(toff, roff, e_, tile_n, ntile); }
    for (int u = vb; u < units; u += nblk) {
        const int nt = nt_n; const ExpUnit x = xn; const bool hn = u + nblk < units;
        if (hn) { const int e_ = exp_decode<2>(toff, ntile, u + nblk, tile_n, nt_n); xn = exp_unit(toff, roff, e_, tile_n, ntile); }
        const float* wg = x.e < NE ? p.wg + (size_t)x.e * 262144 : p.sg; const float* wu = x.e < NE ? p.wu + (size_t)x.e * 262144 : p.su;
        const float* wgn = xn.e < NE ? p.wg + (size_t)xn.e * 262144 : p.sg; const float* wun = xn.e < NE ? p.wu + (size_t)xn.e * 262144 : p.su;
        auto rowoff = [&](int r) { const int tok = x.e < NE ? (list[(size_t)x.e * LCAP + x.row0 + r] >> 3) : (x.row0 + r); return (unsigned)(tok * D); };
        auto rowoff_n = [&](int r) { const int tok = xn.e < NE ? (list[(size_t)xn.e * LCAP + xn.row0 + r] >> 3) : (xn.row0 + r); return (unsigned)(tok * D); };
        auto prf = [&](int r, int c, f32x4 g, f32x4 uu) { return (f32x4){g[0] * sigmoidf_(g[0]) * uu[0], g[1] * sigmoidf_(g[1]) * uu[1], g[2] * sigmoidf_(g[2]) * uu[2], g[3] * sigmoidf_(g[3]) * uu[3]}; };
        auto fin = [&](int r, int c, u32x4 dv) { *(u32x4*)(hid + (size_t)(x.rowbase + r) * EDIM + nt * 128 + c) = dv; };
        gemm_core<true, false, 2, EDIM, 4>(ra, rb, ao, pre, hb, rowoff, wg + nt * 128, wu + nt * 128, (unsigned)((D * EDIM - nt * 128) * 4), D, x.rows,
                                 hn, rowoff_n, wgn + nt_n * 128, wun + nt_n * 128, (unsigned)((D * EDIM - nt_n * 128) * 4), xn.rows, prf, fin, (unsigned char*)lds);
        pre = hn;
    }
}

DI void phase_e2(const Params& p, int bid, int nblk, float* lds) {
    int* toff = (int*)((unsigned char*)lds + EXP_TAB_OFF); int* roff = toff + 260; int* rowa = roff + 520;
    const bf16_t* hid = (const bf16_t*)(p.ws + OFF_HID); unsigned char* Y = p.ws + OFF_Y; const int* list = (const int*)(p.ws + OFF_LIST);
    build_tables(p, toff, roff);
    const int ntile = toff[NE], units = (ntile + T / 256) * 4;
    const int vb = (nblk & 7) ? bid : (bid & 7) * (nblk >> 3) + (bid >> 3);
    u32x4 ra[2][2], rb[2][4]; unsigned ao[2] = {0u, 0u}; bool pre = false;
    int tile_n = 0, nt_n = 0; ExpUnit xn;
    auto rowa_val = [&](const ExpUnit& q, int r) { return q.e < NE ? (r < q.rows ? list[(size_t)q.e * LCAP + q.row0 + r] : 0) : (A_TOT + q.row0 + r); };
    if (vb < units) { const int e_ = exp_decode<4>(toff, ntile, vb, tile_n, nt_n); xn = exp_unit(toff, roff, e_, tile_n, ntile); if (threadIdx.x < 256) rowa[threadIdx.x] = rowa_val(xn, threadIdx.x); }
    __syncthreads();
    int cur = 0;
    for (int u = vb; u < units; u += nblk) {
        const int nt = nt_n; const ExpUnit x = xn; const bool hn = u + nblk < units;
        if (hn) { const int e_ = exp_decode<4>(toff, ntile, u + nblk, tile_n, nt_n); xn = exp_unit(toff, roff, e_, tile_n, ntile); }
        const float* wd = x.e < NE ? p.wd + (size_t)x.e * 262144 : p.sd; const float* wdn = xn.e < NE ? p.wd + (size_t)xn.e * 262144 : p.sd;
        int rnext = 0;
        if (hn && threadIdx.x < 256) rnext = rowa_val(xn, threadIdx.x);
        const int* rowa_c = rowa + cur * 256;
        auto rowoff = [&](int r) { return (unsigned)((x.rowbase + r) * EDIM); };
        auto rowoff_n = [&](int r) { return (unsigned)((xn.rowbase + r) * EDIM); };
        auto fin = [&](int r, int c, u32x4 dv) { *(u32x4*)(Y + (size_t)rowa_c[r] * D + nt * 256 + c) = dv; };
        gemm_core<false, false, 1, D, 4>(ra, rb, ao, pre, hid, rowoff, wd + nt * 256, nullptr, (unsigned)((EDIM * D - nt * 256) * 4), EDIM, x.rows,
                               hn, rowoff_n, wdn + nt_n * 256, nullptr, (unsigned)((EDIM * D - nt_n * 256) * 4), xn.rows, PRE_ID, fin, (unsigned char*)lds);
        pre = hn;
        cur ^= 1;
        if (threadIdx.x < 256) rowa[cur * 256 + threadIdx.x] = rnext;
    }
}

DI void phase_combine(const Params& p, int bid, int nblk, float* lds) {
    const int lane = threadIdx.x & 63, wave = threadIdx.x >> 6;
    const bf16_t* hb = (const bf16_t*)(p.ws + OFF_HB); const unsigned char* Y = p.ws + OFF_Y; const float* wbuf = (const float*)(p.ws + OFF_WBUF);
    typedef float f32x2 __attribute__((ext_vector_type(2)));
    for (int t = bid * 8 + wave; t < T; t += nblk * 8) {
        float v[16];
#pragma unroll
        for (int j = 0; j < 4; ++j) { const uint2 a = ((const uint2*)(hb + (size_t)t * D))[lane + 64 * j];
            v[4 * j] = ALPHA * __uint_as_float(a.x << 16); v[4 * j + 1] = ALPHA * __uint_as_float(a.x & 0xffff0000u);
            v[4 * j + 2] = ALPHA * __uint_as_float(a.y << 16); v[4 * j + 3] = ALPHA * __uint_as_float(a.y & 0xffff0000u); }
#pragma unroll
        for (int k = 0; k < 9; ++k) {
            const size_t row = k < 8 ? (size_t)t * TOPK + k : (size_t)A_TOT + t; const float w = (k < 8 ? wbuf[(size_t)t * TOPK + k] : 1.f) * (1.f / 128.f);
#pragma unroll
            for (int j = 0; j < 4; ++j) {
                const int y = ((const int*)(Y + row * D))[lane + 64 * j];
                const f32x2 lo = __builtin_amdgcn_cvt_pk_f32_fp8(y, false), hi = __builtin_amdgcn_cvt_pk_f32_fp8(y, true);
                v[4 * j] += w * lo[0]; v[4 * j + 1] += w * lo[1]; v[4 * j + 2] += w * hi[0]; v[4 * j + 3] += w * hi[1];
            }
        }
        ln_row(v, p.ln2_g, p.ln2_b, lane);
#pragma unroll
        for (int j = 0; j < 4; ++j) ((float4*)(p.out + (size_t)t * D))[lane + 64 * j] = make_float4(v[4 * j], v[4 * j + 1], v[4 * j + 2], v[4 * j + 3]);
    }
}

#define LAS __attribute__((address_space(3)))
#define XB_TMO      128
#define XB_XCNT(j)  (256  + 64 * (j))
#define XB_XSUB(j)  (1280 + 64 * (j))
#define XB_XGEN(j)  (2304 + 64 * (j))
#define XB_TOP      3328
#define XB_TOPGEN   3392
#define XCD_BAR_WORDS 3456
#define XB_SPIN_CAP (1u << 22)
constexpr int CW_BAR = 4096;
DI unsigned xb_ld(unsigned* p) { return __hip_atomic_load(p, __ATOMIC_RELAXED, __HIP_MEMORY_SCOPE_AGENT); }
DI unsigned xb_add(unsigned* p, unsigned v) { return __hip_atomic_fetch_add(p, v, __ATOMIC_RELAXED, __HIP_MEMORY_SCOPE_AGENT); }
DI unsigned xb_xcc_id() { return (unsigned)__builtin_amdgcn_s_getreg((3 << 11) | 20) & 0xFu; }
#define XB_SPIN(cond, bar) do { unsigned _sp = 0; while (cond) { __builtin_amdgcn_s_sleep(1); \
    if ((++_sp & 255u) == 0u) { if (xb_ld(&(bar)[XB_TMO])) break; if (_sp > XB_SPIN_CAP) { atomicAdd(&(bar)[XB_TMO], 1u); break; } } } } while (0)
struct XcdBarrier { unsigned* bar; unsigned x; volatile LAS unsigned* st; };
DI XcdBarrier xcd_barrier_post(unsigned* bar, volatile LAS unsigned* st) {
    XcdBarrier b; b.bar = bar; b.x = xb_xcc_id(); b.st = st;
    if (threadIdx.x == 0) (void)xb_add(&bar[XB_XCNT(b.x)], 1u);
    return b;
}
DI void xcd_barrier_complete(unsigned* bar, unsigned x, unsigned& nloc, unsigned& nx) {
    const unsigned G = gridDim.x * gridDim.y * gridDim.z;
    unsigned sum, cnt, mine, sp = 0u;
    for (;;) {
        sum = 0u; cnt = 0u; mine = 0u;
#pragma unroll
        for (unsigned j = 0; j < 16; ++j) { const unsigned c = xb_ld(&bar[XB_XCNT(j)]); sum += c; cnt += (c > 0u) ? 1u : 0u; mine = (j == x) ? c : mine; }
        if (sum == G) break;
        __builtin_amdgcn_s_sleep(1);
        if ((++sp & 255u) == 0u) { if (xb_ld(&bar[XB_TMO])) break; if (sp > XB_SPIN_CAP) { atomicAdd(&bar[XB_TMO], 1u); break; } }
    }
    nloc = mine > 0u ? mine : 1u; nx = cnt > 0u ? cnt : 1u;
}
DI void xcd_barrier(const XcdBarrier& b) {
    asm volatile("s_waitcnt vmcnt(0)" ::: "memory");
    __syncthreads();
    if (threadIdx.x == 0) {
        unsigned* bar = b.bar;
        __builtin_amdgcn_s_waitcnt(0);
        unsigned nloc = b.st[0], nx = b.st[1];
        if (nloc == 0u) { xcd_barrier_complete(bar, b.x, nloc, nx); b.st[0] = nloc; b.st[1] = nx; }
        const unsigned old = xb_add(&bar[XB_XSUB(b.x)], 1u);
        const unsigned gen = old / nloc;
        if (old + 1u == (gen + 1u) * nloc) {
            __builtin_amdgcn_fence(__ATOMIC_RELEASE, "agent");
            asm volatile("s_waitcnt vmcnt(0)" ::: "memory");
            const unsigned og = xb_add(&bar[XB_TOP], 1u);
            const unsigned tg = og / nx;
            if (og + 1u == (tg + 1u) * nx) xb_add(&bar[XB_TOPGEN], 1u);
            else XB_SPIN(xb_ld(&bar[XB_TOPGEN]) == tg, bar);
            __builtin_amdgcn_fence(__ATOMIC_ACQUIRE, "agent");
            xb_add(&bar[XB_XGEN(b.x)], 1u);
            asm volatile("s_waitcnt vmcnt(0)" ::: "memory");
        } else {
            XB_SPIN(xb_ld(&bar[XB_XGEN(b.x)]) == gen, bar);
            __builtin_amdgcn_fence(__ATOMIC_ACQUIRE, "agent");
            asm volatile("s_waitcnt vmcnt(0)" ::: "memory");
        }
    }
    __syncthreads();
}

constexpr int LDS_BYTES = 136 * 1024;
constexpr int LDS_BAR_OFF = LDS_BYTES - 16;
__global__ void __launch_bounds__(NT) fwd_megakernel(Params p) {
    extern __shared__ __attribute__((aligned(16))) float lds[];
    const int bid = blockIdx.x, nblk = gridDim.x;
    volatile LAS unsigned* st = (volatile LAS unsigned*)((LAS unsigned char*)lds + LDS_BAR_OFF);
    if (threadIdx.x < 4) st[threadIdx.x] = 0u;
    __syncthreads();
    XcdBarrier bar = xcd_barrier_post((unsigned*)(p.ws + OFF_CTL) + CW_BAR, st);
    phase_prep(p, bid, nblk, lds);      xcd_barrier(bar);
    phase_proj(p, bid, nblk, lds);      xcd_barrier(bar);
    phase_poolmean(p, bid, nblk, lds);
    phase_gla1(p, bid, nblk, lds);      xcd_barrier(bar);
    phase_pool(p, bid, nblk, lds);
    phase_gla2(p, bid, nblk, lds);      xcd_barrier(bar);
    phase_gla3(p, bid, nblk, lds);      xcd_barrier(bar);
    phase_out(p, bid, nblk, lds);       xcd_barrier(bar);
    phase_route(p, bid, nblk, lds);     xcd_barrier(bar);
    phase_e1(p, bid, nblk, lds);        xcd_barrier(bar);
    phase_e2(p, bid, nblk, lds);        xcd_barrier(bar);
    phase_combine(p, bid, nblk, lds);
}

extern "C" void kernel_launch(void* const* d_in, const int* in_sizes, int n_in, void* d_out, int out_size, void* d_ws, size_t ws_size, hipStream_t stream) {
    static int grid = 0;
    if (grid == 0) {
        if (n_in != 20 || ws_size < WS_NEED) { fprintf(stderr, "kernel_launch: unexpected n_in %d or ws_size %zu (< %zu)\n", n_in, ws_size, (size_t)WS_NEED); grid = -1; return; }
        int dev = 0, cus = 0, per_cu = 0;
        (void)hipGetDevice(&dev); (void)hipDeviceGetAttribute(&cus, hipDeviceAttributeMultiprocessorCount, dev);
        (void)hipFuncSetAttribute((const void*)fwd_megakernel, hipFuncAttributeMaxDynamicSharedMemorySize, LDS_BYTES);
        (void)hipOccupancyMaxActiveBlocksPerMultiprocessor(&per_cu, (const void*)fwd_megakernel, NT, LDS_BYTES);
        if (per_cu < 1 || cus < 1) { fprintf(stderr, "kernel_launch: occupancy query says %d blocks/CU on %d CUs\n", per_cu, cus); grid = -1; return; }
        grid = cus;
    }
    if (grid < 0) return;
    (void)hipMemsetAsync((char*)d_ws + OFF_CTL, 0, 64 * 1024, stream);
    Params p{};
    const float** pp = (const float**)&p;
    for (int i = 0; i < 20; ++i) pp[i] = (const float*)d_in[i];
    p.out = (float*)d_out; p.ws = (unsigned char*)d_ws;
    void* args[] = {&p};
    hipError_t e = hipLaunchCooperativeKernel((const void*)fwd_megakernel, dim3(grid), dim3(NT), args, LDS_BYTES, stream);
    if (e != hipSuccess) fprintf(stderr, "cooperative launch failed: %s (grid %d)\n", hipGetErrorString(e), grid);
}
```

```cpp
#include <hip/hip_runtime.h>
#include <stdint.h>
#include <cstdio>

#define DI __device__ __forceinline__
typedef unsigned short bf16_t;

constexpr int T = 16384, D = 1024, SEQ = 4096;
constexpr int DIN = 2064, NPROJ = 2048;
constexpr int P_OFF = 0, Q_OFF = 512, K_OFF = 768, V_OFF = 1024, R_OFF = 1536, GL_OFF = 2048;
constexpr int SC = 64;
constexpr int NSC = SEQ / SC;
constexpr int NE = 256, TOPK = 8, EDIM = 256;
constexpr int A_TOT = T * TOPK;
constexpr int LCAP = T;
constexpr float ALPHA = 1.189207115002721f;
constexpr float LN_EPS = 1e-5f, RMS_EPS = 1e-5f;
constexpr int NT = 512;

constexpr size_t MiB = 1u << 20;
constexpr size_t OFF_CTL = 0;
constexpr size_t OFF_XB = 1 * MiB;
constexpr size_t OFF_GLOW = OFF_XB + 32 * MiB;
constexpr size_t OFF_PROJ = OFF_GLOW + 1 * MiB;
constexpr size_t OFF_G = OFF_PROJ + 64 * MiB;
constexpr size_t OFF_SLOC = OFF_G + 16 * MiB;
constexpr size_t OFF_DEC = OFF_SLOC + 32 * MiB;
constexpr size_t OFF_SIN = OFF_DEC + 1 * MiB;
constexpr size_t OFF_MIX = OFF_SIN + 32 * MiB;
constexpr size_t OFF_H32 = OFF_MIX + 32 * MiB;
constexpr size_t OFF_HB = OFF_H32 + 64 * MiB;
constexpr size_t OFF_SCORES = OFF_HB + 32 * MiB;
constexpr size_t OFF_WBUF = OFF_SCORES + 16 * MiB;
constexpr size_t OFF_LIST = OFF_WBUF + 1 * MiB;
constexpr size_t OFF_HID = OFF_LIST + 16 * MiB;
constexpr size_t OFF_Y = OFF_HID + 76 * MiB;
constexpr size_t OFF_PM = OFF_Y + 304 * MiB;
constexpr size_t OFF_WB_IN = OFF_PM + 16 * MiB;
constexpr size_t OFF_WB_OUT = OFF_WB_IN + 4 * MiB;
constexpr size_t OFF_WB_RT = OFF_WB_OUT + 2 * MiB;
constexpr size_t OFF_WB_SGU = OFF_WB_RT + 1 * MiB;
constexpr size_t OFF_WB_SD = OFF_WB_SGU + 1 * MiB;
constexpr size_t WS_NEED = OFF_WB_SD + 1 * MiB;
constexpr int CW_CNT = 1024;

struct Params {
    const float *x, *w_in, *gate_w2, *gate_b, *norm_w, *pool_w, *pool_scale, *w_out, *ln1_g, *ln1_b;
    const float *router_w, *router_bias, *wg, *wu, *wd, *sg, *su, *sd, *ln2_g, *ln2_b;
    float* out;
    unsigned char* ws;
};

DI float bf2f(bf16_t v) { return __uint_as_float(((unsigned)v) << 16); }
DI bf16_t f2bf(float f) { unsigned u = __float_as_uint(f); u += 0x7fffu + ((u >> 16) & 1u); return (bf16_t)(u >> 16); }
DI unsigned pk2(float lo, float hi) { return (unsigned)f2bf(lo) | ((unsigned)f2bf(hi) << 16); }
DI float wave_sum(float v) {
#pragma unroll
    for (int o = 1; o < 64; o <<= 1) v += __shfl_xor(v, o);
    return v;
}
DI float sigmoidf_(float v) { return 1.f / (1.f + __expf(-v)); }
DI float logsigmoidf_(float z) { return fminf(z, 0.f) - log1pf(__expf(-fabsf(z))); }

constexpr int GT_LDS_FLOATS = 16 * 132 + 2 * 16 * 68;
template <bool DUAL, class AF, class BF, class EPI>
DI void gemm_tile_valu(int K, const AF& af, const BF& bfn, const EPI& epi, float* lds) {
    float* As = lds; float* Bs = lds + 16 * 132; float* Bs2 = Bs + 16 * 68;
    const int tid = threadIdx.x, ty = tid >> 4, tx = tid & 15;
    float acc[4][4], acc2[4][4];
#pragma unroll
    for (int i = 0; i < 4; ++i)
#pragma unroll
        for (int j = 0; j < 4; ++j) { acc[i][j] = 0.f; acc2[i][j] = 0.f; }
    for (int k0 = 0; k0 < K; k0 += 16) {
#pragma unroll
        for (int i = 0; i < 4; ++i) { const int e = tid + 512 * i, r = e >> 4, kk = e & 15; As[kk * 132 + r] = af(r, k0 + kk); }
#pragma unroll
        for (int i = 0; i < 2; ++i) { const int e = tid + 512 * i, kk = e >> 6, c = e & 63; Bs[kk * 68 + c] = bfn(0, k0 + kk, c); if (DUAL) Bs2[kk * 68 + c] = bfn(1, k0 + kk, c); }
        __syncthreads();
#pragma unroll
        for (int kk = 0; kk < 16; ++kk) {
            const float4 a = *(const float4*)&As[kk * 132 + ty * 4];
            const float4 b = *(const float4*)&Bs[kk * 68 + tx * 4];
            const float av[4] = {a.x, a.y, a.z, a.w}, bv[4] = {b.x, b.y, b.z, b.w};
#pragma unroll
            for (int i = 0; i < 4; ++i)
#pragma unroll
                for (int j = 0; j < 4; ++j) acc[i][j] += av[i] * bv[j];
            if (DUAL) {
                const float4 b2 = *(const float4*)&Bs2[kk * 68 + tx * 4];
                const float b2v[4] = {b2.x, b2.y, b2.z, b2.w};
#pragma unroll
                for (int i = 0; i < 4; ++i)
#pragma unroll
                    for (int j = 0; j < 4; ++j) acc2[i][j] += av[i] * b2v[j];
            }
        }
        __syncthreads();
    }
#pragma unroll
    for (int i = 0; i < 4; ++i)
#pragma unroll
        for (int j = 0; j < 4; ++j) epi(ty * 4 + i, tx * 4 + j, acc[i][j], acc2[i][j]);
}


typedef __bf16 bf16x8 __attribute__((ext_vector_type(8)));
typedef __bf16 bf16x4 __attribute__((ext_vector_type(4)));
typedef short s16x4 __attribute__((ext_vector_type(4)));
typedef float f32x4 __attribute__((ext_vector_type(4)));
typedef unsigned u32x4 __attribute__((ext_vector_type(4)));
#define LAS3 __attribute__((address_space(3)))
DI const float* uniform_ptr(const float* p) {
    const unsigned long long v = (unsigned long long)p;
    const unsigned lo = __builtin_amdgcn_readfirstlane((unsigned)v), hi = __builtin_amdgcn_readfirstlane((unsigned)(v >> 32));
    return (const float*)(((unsigned long long)hi << 32) | lo);
}
#define MFMA16(a, b, c) __builtin_amdgcn_mfma_f32_16x16x32_bf16((a), (b), (c), 0, 0, 0)
constexpr int GEMM_LDS_BYTES = 131072;
DI unsigned a_swz(unsigned x) { return (0x78u >> (2u * x)) & 3u; }
struct GemmRegs { u32x4 ra[2][2], rb[2][4]; };
template <bool DUAL, bool BK16, int OUTB, int LDB, int WN, class RowFn, class RowFnN, class Pre, class Fin>
DI void gemm_core(u32x4 (&Rra)[2][2], u32x4 (&Rrb)[2][4], unsigned (&aoffc)[2], bool preloaded, const bf16_t* Ab, const RowFn& rowoff, const float* B0, const float* B1, unsigned bbytes, int K, int rows,
                  bool has_next, const RowFnN& rowoff_n, const float* B0n, const float* B1n, unsigned bbytes_n, int rows_n, const Pre& pre, const Fin& fin, unsigned char* lds) {
    int tid_ = threadIdx.x; asm volatile("" : "+v"(tid_));
    const int tid = tid_, lane = tid & 63, w = __builtin_amdgcn_readfirstlane(tid >> 6), wm = w >> 2, wn = w & 3, l15 = lane & 15, kg = lane >> 4, t256 = tid & 255;
    const bool active = wn < WN;
    const int nrow_w = min(max(rows - 128 * wm, 0), 128), ngrp = (((nrow_w + 15) >> 4) + 1) >> 1;
    unsigned aoff[2];
#pragma unroll
    for (int i = 0; i < 2; ++i) aoff[i] = preloaded ? aoffc[i] : (rowoff(min(128 * wm + (t256 >> 2) + 64 * i, rows - 1)) + (t256 & 3) * 8) * 2u;
    const __amdgpu_buffer_rsrc_t ar = __builtin_amdgcn_make_buffer_rsrc((void*)Ab, 0, 0x7fffffff, 0x00020000);
    const unsigned awr = (128 * wm + (t256 >> 2)) * 128 + ((((unsigned)(t256 & 3)) ^ (unsigned)((t256 >> 3) & 7)) << 4);
    constexpr int NB = BK16 ? 2 : 4;
    const float* bsrc = uniform_ptr(DUAL && !BK16 ? ((wn >> 1) ? B1 : B0) : B0);
    const __amdgpu_buffer_rsrc_t br = __builtin_amdgcn_make_buffer_rsrc((void*)bsrc, 0, bbytes, 0x00020000);
    const unsigned bvoff = BK16 ? (unsigned)(((lane >> 5) * LDB + (lane & 31) * 8) * 2) : (DUAL ? (unsigned)(((lane >> 5) * LDB + (lane & 31) * 4) * 4) : (unsigned)(lane * 16));
    const int krow0 = BK16 ? 16 * wm + 2 * wn : (DUAL ? 16 * wm + 8 * (wn & 1) : 16 * wm + wn);
    constexpr int KSTEP = BK16 ? 8 : (DUAL ? 2 : 4), ESZ = BK16 ? 2 : 4;
    unsigned aoff_n[2];
#pragma unroll
    for (int i = 0; i < 2; ++i) aoff_n[i] = has_next ? (rowoff_n(min(128 * wm + (t256 >> 2) + 64 * i, rows_n - 1)) + (t256 & 3) * 8) * 2u : aoff[i];
    const float* bsrc_n = uniform_ptr(has_next ? (DUAL && !BK16 ? ((wn >> 1) ? B1n : B0n) : B0n) : bsrc);
    const __amdgpu_buffer_rsrc_t br_n = __builtin_amdgcn_make_buffer_rsrc((void*)bsrc_n, 0, has_next ? bbytes_n : bbytes, 0x00020000);
    unsigned bwr[NB];
#pragma unroll
    for (int i = 0; i < NB; ++i) {
        const int kb = krow0 + KSTEP * i + ((BK16 || DUAL) ? (lane >> 5) : 0);
        const int n = BK16 ? 8 * (lane & 31) : (DUAL ? (wn >> 1) * 128 + 4 * (lane & 31) : 4 * lane);
        const unsigned I = n >> 7, ch = (n & 127) >> 3, half = BK16 ? 0u : (unsigned)((n >> 2) & 1), xx = ((kb & 3) << 2) | ((kb >> 2) & 3);
        bwr[i] = 32768u + I * 16384u + 256u * kb + 16u * (ch ^ xx) + 8u * half;
    }
    const unsigned ard = (128 * wm + l15) * 128 + ((((unsigned)kg) ^ (unsigned)((l15 >> 1) & 7)) << 4);
    unsigned trd0, trd1;
    {
        const unsigned q = l15 >> 2, pp = l15 & 3, cbase = (DUAL ? 4u * wn : 8u * (wn & 1)) + (pp >> 1), ibase = DUAL ? 0u : (unsigned)(wn >> 1);
        const unsigned x0 = (q << 2) | ((2u * kg) & 3u), x1 = (q << 2) | ((2u * kg + 1u) & 3u);
        trd0 = 32768u + ibase * 16384u + 256u * (8u * kg + q) + 16u * (cbase ^ x0) + 8u * (pp & 1);
        trd1 = 32768u + ibase * 16384u + 256u * (8u * kg + 4u + q) + 16u * (cbase ^ x1) + 8u * (pp & 1);
    }
    f32x4 acc[8][4];
#pragma unroll
    for (int i = 0; i < 8; ++i)
#pragma unroll
        for (int f = 0; f < 4; ++f) acc[i][f] = (f32x4){0.f, 0.f, 0.f, 0.f};
    const int nj = K / 32;
#define LOAD_SET(S, j) { _Pragma("unroll") for (int i = 0; i < 2; ++i) Rra[S][i] = __builtin_bit_cast(u32x4, __builtin_amdgcn_raw_buffer_load_b128(ar, aoff[S], ((j) >> 1) * 128 + i * 64, 0)); \
        _Pragma("unroll") for (int i = 0; i < NB; ++i) Rrb[S][i] = __builtin_bit_cast(u32x4, __builtin_amdgcn_raw_buffer_load_b128(br, bvoff, ((j) * 32 + krow0 + KSTEP * i) * (LDB * ESZ), 0)); }
#define LOAD_SET_N(S, j) { _Pragma("unroll") for (int i = 0; i < 2; ++i) Rra[S][i] = __builtin_bit_cast(u32x4, __builtin_amdgcn_raw_buffer_load_b128(ar, aoff_n[S], ((j) >> 1) * 128 + i * 64, 0)); \
        _Pragma("unroll") for (int i = 0; i < NB; ++i) Rrb[S][i] = __builtin_bit_cast(u32x4, __builtin_amdgcn_raw_buffer_load_b128(br_n, bvoff, ((j) * 32 + krow0 + KSTEP * i) * (LDB * ESZ), 0)); }
#define WRITE_SET(S, st, h) { _Pragma("unroll") for (int i = 0; i < 2; ++i) *(u32x4*)(lds + (st) * 65536 + (awr ^ (i ? 64u : 0u)) + (S) * 8192) = Rra[S][i]; \
        _Pragma("unroll") for (int i = 0; i < NB; ++i) { if (BK16) *(u32x4*)(lds + (st) * 65536 + (h) * 8192 + bwr[i]) = Rrb[S][i]; else { \
            const f32x4 v = __builtin_bit_cast(f32x4, Rrb[S][i]); bf16x4 o; o[0] = (__bf16)v[0]; o[1] = (__bf16)v[1]; o[2] = (__bf16)v[2]; o[3] = (__bf16)v[3]; \
            *(bf16x4*)(lds + (st) * 65536 + (h) * 8192 + ((!DUAL) ? ((bwr[0] ^ (unsigned)(i << 4)) + 1024u * i) : bwr[i])) = o; } } }
#define LOAD_SEL(S, jl) { const bool nx_ = (jl) >= nj; const int jt_ = nx_ ? (jl) - nj : (jl); \
        _Pragma("unroll") for (int i = 0; i < 2; ++i) Rra[S][i] = __builtin_bit_cast(u32x4, __builtin_amdgcn_raw_buffer_load_b128(ar, nx_ ? aoff_n[S] : aoff[S], (jt_ >> 1) * 128 + i * 64, 0)); \
        if (nx_) { _Pragma("unroll") for (int i = 0; i < NB; ++i) Rrb[S][i] = __builtin_bit_cast(u32x4, __builtin_amdgcn_raw_buffer_load_b128(br_n, bvoff, (jt_ * 32 + krow0 + KSTEP * i) * (LDB * ESZ), 0)); } \
        else { _Pragma("unroll") for (int i = 0; i < NB; ++i) Rrb[S][i] = __builtin_bit_cast(u32x4, __builtin_amdgcn_raw_buffer_load_b128(br, bvoff, (jt_ * 32 + krow0 + KSTEP * i) * (LDB * ESZ), 0)); } }
#define WRITE_A(S, st, h) { _Pragma("unroll") for (int i = 0; i < 2; ++i) *(u32x4*)(lds + (st) * 65536 + (awr ^ (i ? 64u : 0u)) + (S) * 8192) = Rra[S][i]; }
#define WRITE_B(S, st, h, I0, I1) { _Pragma("unroll") for (int i = (I0); i < (I1); ++i) { if (BK16) *(u32x4*)(lds + (st) * 65536 + (h) * 8192 + bwr[i]) = Rrb[S][i]; else { \
            const f32x4 v = __builtin_bit_cast(f32x4, Rrb[S][i]); bf16x4 o; o[0] = (__bf16)v[0]; o[1] = (__bf16)v[1]; o[2] = (__bf16)v[2]; o[3] = (__bf16)v[3]; \
            *(bf16x4*)(lds + (st) * 65536 + (h) * 8192 + ((!DUAL) ? ((bwr[0] ^ (unsigned)(i << 4)) + 1024u * i) : bwr[i])) = o; } } }
#define LOAD_A(S, jl) { const bool nx_ = (jl) >= nj; const int jt_ = nx_ ? (jl) - nj : (jl); \
        _Pragma("unroll") for (int i = 0; i < 2; ++i) Rra[S][i] = __builtin_bit_cast(u32x4, __builtin_amdgcn_raw_buffer_load_b128(ar, nx_ ? aoff_n[S] : aoff[S], (jt_ >> 1) * 128 + i * 64, 0)); }
#define LOAD_B(S, jl) { const bool nx_ = (jl) >= nj; const int jt_ = nx_ ? (jl) - nj : (jl); \
        if (nx_) { _Pragma("unroll") for (int i = 0; i < NB; ++i) Rrb[S][i] = __builtin_bit_cast(u32x4, __builtin_amdgcn_raw_buffer_load_b128(br_n, bvoff, (jt_ * 32 + krow0 + KSTEP * i) * (LDB * ESZ), 0)); } \
        else { _Pragma("unroll") for (int i = 0; i < NB; ++i) Rrb[S][i] = __builtin_bit_cast(u32x4, __builtin_amdgcn_raw_buffer_load_b128(br, bvoff, (jt_ * 32 + krow0 + KSTEP * i) * (LDB * ESZ), 0)); } }
#define TF_LOAD(dst, st, h, g) { _Pragma("unroll") for (int q_ = 0; q_ < 2; ++q_) dst[q_] = *(const bf16x8*)(lds + (st) * 65536 + ((g) * 2 + q_) * 2048 + (ard ^ ((h) ? 64u : 0u))); }
#define WF_LOAD(st, h) { _Pragma("unroll") for (int f = 0; f < 4; ++f) { \
        const unsigned fx = DUAL ? ((f & 1) << 5) : (f << 5), fo = (DUAL ? (f >> 1) * 16384 : 0) + (st) * 65536 + (h) * 8192; \
        const s16x4 lo = __builtin_amdgcn_ds_read_tr16_b64_v4i16((LAS3 s16x4*)(lds + ((trd0 ^ fx) + fo))); \
        const s16x4 hi = __builtin_amdgcn_ds_read_tr16_b64_v4i16((LAS3 s16x4*)(lds + ((trd1 ^ fx) + fo))); \
        wf[f] = __builtin_bit_cast(bf16x8, __builtin_shufflevector(lo, hi, 0, 1, 2, 3, 4, 5, 6, 7)); } }
#define STAGE_MMA(srcf, g) { _Pragma("unroll") for (int q_ = 0; q_ < 2; ++q_) _Pragma("unroll") for (int f = 0; f < 4; ++f) acc[(g) * 2 + q_][f] = MFMA16(wf[f], srcf[q_], acc[(g) * 2 + q_][f]); }
#define STAGE(st, h, g, cur, nxt) if ((g) < ngrp) { \
        if ((g) + 1 < 4 && (g) + 1 < ngrp) TF_LOAD(nxt, st, h, (g) + 1) \
        __builtin_amdgcn_sched_barrier(0); \
        STAGE_MMA(cur, g) \
        __builtin_amdgcn_sched_barrier(0); }
    const bool comp = active && ngrp > 0;
    bf16x8 fa[2], fb[2], wf[4];
#define HALF_MMA(st, h) if (comp) { STAGE(st, h, 0, fa, fb) STAGE(st, h, 1, fb, fa) STAGE(st, h, 2, fa, fb) STAGE(st, h, 3, fb, fa) }
#define SLOT(st, h, g, cur, nxt, PIECE) { if (comp && (g) < ngrp) { if ((g) + 1 < 4 && (g) + 1 < ngrp) TF_LOAD(nxt, st, h, (g) + 1) } \
        PIECE \
        __builtin_amdgcn_sched_barrier(0); \
        if (comp && (g) < ngrp) { STAGE_MMA(cur, g) } \
        __builtin_amdgcn_sched_barrier(0); }
#define HALF_SLOTS(st, h, S, jl) { SLOT(st, h, 0, fa, fb, WRITE_A(S, (st) ^ 1, h) LOAD_A(S, jl)) SLOT(st, h, 1, fb, fa, WRITE_B(S, (st) ^ 1, h, 0, NB / 2)) \
        SLOT(st, h, 2, fa, fb, WRITE_B(S, (st) ^ 1, h, NB / 2, NB)) SLOT(st, h, 3, fb, fa, LOAD_B(S, jl)) }
#define PREFETCH(st, h) if (comp) { WF_LOAD(st, h) TF_LOAD(fa, st, h, 0) }
    const int nJ = K / 64;
    if (!preloaded) { LOAD_SET(0, 0) LOAD_SET(1, 1) }
    WRITE_SET(0, 0, 0) WRITE_SET(1, 0, 1)
    LOAD_SEL(0, 2) LOAD_SEL(1, 3)
    __syncthreads();
    int st = 0;
#pragma unroll 1
    for (int J = 0; J < nJ - 1; ++J) {
        PREFETCH(st, 0)
        HALF_SLOTS(st, 0, 0, 2 * J + 4)
        PREFETCH(st, 1)
        HALF_SLOTS(st, 1, 1, 2 * J + 5)
        __syncthreads();
        st ^= 1;
    }
    {
        PREFETCH(st, 0)
        HALF_MMA(st, 0)
        PREFETCH(st, 1)
        HALF_MMA(st, 1)
        __syncthreads();
    }
#undef HALF_MMA
#undef SLOT
#undef HALF_SLOTS
#undef WRITE_A
#undef WRITE_B
#undef LOAD_A
#undef LOAD_B
#undef PREFETCH
#undef LOAD_SET
#undef LOAD_SET_N
#undef LOAD_SEL
#undef WRITE_SET
#undef TF_LOAD
#undef WF_LOAD
#undef STAGE_MMA
#undef STAGE
    aoffc[0] = aoff_n[0]; aoffc[1] = aoff_n[1];
    {
        constexpr int NF = DUAL ? 2 : 4, ROWB = NF * 16 * OUTB, NCH = ROWB / 16, RPR = (8192 / ROWB) < 128 ? (8192 / ROWB) : 128, RPI = 64 / NCH, NROUND = 128 / RPR;
        constexpr float FP8_SCALE = 128.f;
        unsigned char* stg = lds + w * 8192;
        int l15e = l15; asm volatile("" : "+v"(l15e));
        const int colbase = (DUAL ? 32 : 64) * wn;
#pragma unroll
        for (int rd = 0; rd < NROUND; ++rd) {
            if (active) {
#pragma unroll
                for (int mt = rd * (RPR / 16); mt < (rd + 1) * (RPR / 16); ++mt) {
                    if ((mt >> 1) < ngrp) {
                        const int rloc = mt * 16 - rd * RPR + l15e, row = 128 * wm + mt * 16 + l15e;
#pragma unroll
                        for (int f = 0; f < NF; ++f) {
                            const f32x4 v = DUAL ? pre(row, colbase + 16 * f + 4 * kg, acc[mt][f], acc[mt][f + 2]) : pre(row, colbase + 16 * f + 4 * kg, acc[mt][f], acc[mt][f]);
                            if (OUTB == 4) *(f32x4*)(stg + rloc * ROWB + ((((unsigned)(4 * f + kg)) ^ (unsigned)(rloc & (NCH - 1))) << 4)) = v;
                            else if (OUTB == 2) { bf16x4 o; o[0] = (__bf16)v[0]; o[1] = (__bf16)v[1]; o[2] = (__bf16)v[2]; o[3] = (__bf16)v[3];
                                *(bf16x4*)(stg + rloc * ROWB + ((((unsigned)(2 * f + (kg >> 1))) ^ (unsigned)(rloc & (NCH - 1))) << 4) + 8 * (kg & 1)) = o; }
                            else { int pk = 0; pk = __builtin_amdgcn_cvt_pk_fp8_f32(v[0] * FP8_SCALE, v[1] * FP8_SCALE, pk, false); pk = __builtin_amdgcn_cvt_pk_fp8_f32(v[2] * FP8_SCALE, v[3] * FP8_SCALE, pk, true);
                                *(int*)(stg + rloc * ROWB + ((((unsigned)f) ^ (unsigned)(rloc & (NCH - 1))) << 4) + 4 * kg) = pk; }
                        }
                    }
                }
                asm volatile("s_waitcnt lgkmcnt(0)" ::: "memory");
#pragma unroll
                for (int it = 0; it < RPR / RPI; ++it) {
                    const int rloc = it * RPI + lane / NCH, c = lane % NCH, row = 128 * wm + rd * RPR + rloc;
                    const u32x4 dv = *(const u32x4*)(stg + rloc * ROWB + ((((unsigned)c) ^ (unsigned)(rloc & (NCH - 1))) << 4));
                    if (row < rows) fin(row, colbase + c * (16 / OUTB), dv);
                }
                asm volatile("s_waitcnt lgkmcnt(0)" ::: "memory");
            }
        }
    }
    __syncthreads();
}

template <bool DUAL, bool BK16, int OUTB, int LDB, int WN, class RowFn, class Pre, class Fin>
DI void gemm_mfma(const bf16_t* Ab, const RowFn& rowoff, const float* B0, const float* B1, unsigned bbytes, int K, int rows, const Pre& pre, const Fin& fin, unsigned char* lds) {
    u32x4 ra[2][2], rb[2][4]; unsigned ao[2] = {0u, 0u};
    gemm_core<DUAL, BK16, OUTB, LDB, WN>(ra, rb, ao, false, Ab, rowoff, B0, B1, bbytes, K, rows, false, rowoff, B0, B1, bbytes, rows, pre, fin, lds);
}
#define PRE_ID [](int, int, f32x4 v, f32x4) { return v; }

DI void phase_prep(const Params& p, int bid, int nblk, float* lds) {
    const int tid = threadIdx.x, lane = tid & 63, wave = tid >> 6;
    bf16_t* xb = (bf16_t*)(p.ws + OFF_XB); float* glow = (float*)(p.ws + OFF_GLOW);
    float tw = 0.f;
    {
        const int ti = (bid >> 3) * NT + tid;
        if (ti < 1536) { const int m = ti >> 9, j = ti & 511; const float* bp = m == 0 ? p.wg : (m == 1 ? p.wu : p.wd); tw = bp[(size_t)j * 131072]; }
    }
    f32x4* Wl = (f32x4*)lds;
    for (int idx = tid; idx < 4096; idx += NT) {
        const int k = idx >> 2, q = idx & 3, ln = (k >> 2) & 63, j = k >> 8, c = k & 3;
        Wl[((j * 4 + c) * 4 + q) * 64 + ln] = *(const f32x4*)(p.w_in + (size_t)k * DIN + GL_OFF + 4 * q);
    }
    __syncthreads();
    for (int row0 = (bid * 8 + wave) * 4; row0 < T; row0 += nblk * 32) {
        asm volatile("" ::: "memory");
        f32x4 xv[4][4];
#pragma unroll
        for (int r = 0; r < 4; ++r)
#pragma unroll
            for (int j = 0; j < 4; ++j) {
                xv[r][j] = ((const f32x4*)(p.x + (size_t)(row0 + r) * D))[lane + 64 * j];
                uint2 o; o.x = pk2(xv[r][j][0], xv[r][j][1]); o.y = pk2(xv[r][j][2], xv[r][j][3]);
                ((uint2*)(xb + (size_t)(row0 + r) * D))[lane + 64 * j] = o;
            }
        float acc[4][16];
#pragma unroll
        for (int r = 0; r < 4; ++r)
#pragma unroll
            for (int n = 0; n < 16; ++n) acc[r][n] = 0.f;
#pragma unroll
        for (int j = 0; j < 4; ++j)
#pragma unroll
            for (int c = 0; c < 4; ++c) {
                float wv[16];
#pragma unroll
                for (int q = 0; q < 4; ++q) { const f32x4 w4 = Wl[((j * 4 + c) * 4 + q) * 64 + lane]; wv[4 * q] = w4[0]; wv[4 * q + 1] = w4[1]; wv[4 * q + 2] = w4[2]; wv[4 * q + 3] = w4[3]; }
#pragma unroll
                for (int r = 0; r < 4; ++r) {
                    const float xs = xv[r][j][c];
#pragma unroll
                    for (int n = 0; n < 16; ++n) acc[r][n] += xs * wv[n];
                }
            }
#define RS_STEP(N, OFF) { const bool up = (lane & (OFF)) != 0; _Pragma("unroll") for (int i = 0; i < (N); ++i) { \
            const float a = acc[i / 16][i % 16], b = acc[(i + (N)) / 16][(i + (N)) % 16]; const float snd = up ? a : b, kp = up ? b : a; \
            acc[i / 16][i % 16] = kp + __shfl_xor(snd, (OFF)); } }
        RS_STEP(32, 32) RS_STEP(16, 16) RS_STEP(8, 8) RS_STEP(4, 4) RS_STEP(2, 2) RS_STEP(1, 1)
#undef RS_STEP
        glow[(size_t)row0 * 16 + lane] = acc[0][0];
    }
    {
        bf16_t* wbin = (bf16_t*)(p.ws + OFF_WB_IN); bf16_t* wbout = (bf16_t*)(p.ws + OFF_WB_OUT); bf16_t* wbrt = (bf16_t*)(p.ws + OFF_WB_RT);
        bf16_t* wbsgu = (bf16_t*)(p.ws + OFF_WB_SGU); bf16_t* wbsd = (bf16_t*)(p.ws + OFF_WB_SD);
        constexpr int N_IN = 1024 * 512, N_OUT = 1024 * 256, N_RT = 1024 * 64, N_SGU = 1024 * 128, N_SD = 256 * 256;
        for (int it = bid * NT + tid; it < N_IN + N_OUT + N_RT + N_SGU + N_SD; it += nblk * NT) {
            const float* s; bf16_t* d; int r = it;
            if (r < N_IN) { const int k = r >> 9, c = (r & 511) * 4; s = p.w_in + (size_t)k * DIN + c; d = wbin + (size_t)k * 2048 + c; }
            else if ((r -= N_IN) < N_OUT) { s = p.w_out + (size_t)r * 4; d = wbout + (size_t)r * 4; }
            else if ((r -= N_OUT) < N_RT) { s = p.router_w + (size_t)r * 4; d = wbrt + (size_t)r * 4; }
            else if ((r -= N_RT) < N_SGU) { const int k = r >> 7, c = (r & 127) * 4, nt = c >> 8, h = (c >> 7) & 1, cc = c & 127; s = (h ? p.su : p.sg) + (size_t)k * EDIM + nt * 128 + cc; d = wbsgu + (size_t)k * 512 + c; }
            else { r -= N_SGU; s = p.sd + (size_t)r * 4; d = wbsd + (size_t)r * 4; }
            const f32x4 v = *(const f32x4*)s; uint2 o; o.x = pk2(v[0], v[1]); o.y = pk2(v[2], v[3]); *(uint2*)d = o;
        }
    }
    asm volatile("" :: "v"(tw));
    __syncthreads();
}

DI void phase_proj(const Params& p, int bid, int nblk, float* lds) {
    const bf16_t* xb = (const bf16_t*)(p.ws + OFF_XB); bf16_t* proj = (bf16_t*)(p.ws + OFF_PROJ); const bf16_t* wbin = (const bf16_t*)(p.ws + OFF_WB_IN);
    u32x4 ra[2][2], rb[2][4]; unsigned ao[2] = {0u, 0u}; bool pre = false;
    const bool xl = (nblk == 256);
    for (int u = bid; u < 64 * 8; u += nblk) {
        const int un = u + nblk; const bool hn = un < 64 * 8;
        const int mt = xl ? 32 * (u >> 8) + 4 * (u & 7) + ((u & 255) >> 6) : u >> 3, nt = xl ? ((u & 255) >> 3) & 7 : u & 7;
        const int mtn = xl ? 32 * (un >> 8) + 4 * (un & 7) + ((un & 255) >> 6) : un >> 3, ntn = xl ? ((un & 255) >> 3) & 7 : un & 7;
        auto rowoff = [&](int r) { return (unsigned)((mt * 256 + r) * D); };
        auto rowoff_n = [&](int r) { return (unsigned)((mtn * 256 + r) * D); };
        auto fin = [&](int r, int c, u32x4 dv) { *(u32x4*)(proj + (size_t)(mt * 256 + r) * NPROJ + nt * 256 + c) = dv; };
        gemm_core<false, true, 2, NPROJ, 4>(ra, rb, ao, pre, xb, rowoff, (const float*)(wbin + nt * 256), nullptr, (unsigned)(((size_t)D * NPROJ - nt * 256) * 2), D, 256,
                                 hn, rowoff_n, (const float*)(wbin + ntn * 256), nullptr, (unsigned)(((size_t)D * NPROJ - ntn * 256) * 2), 256, PRE_ID, fin, (unsigned char*)lds);
        pre = hn;
    }
}

template <int W>
DI void poolmean_item(const bf16_t* proj, bf16_t* pm, int t0, int c2) {
    const int s0 = t0 & (SEQ - 1);
    float p0[48], p1[48]; unsigned raw[32];
    p0[0] = 0.f; p1[0] = 0.f;
#pragma unroll
    for (int i = 0; i < 47; ++i) {
        unsigned v = 0u;
        if (i >= 15 || s0 > 0) v = *(const unsigned*)(proj + (size_t)(t0 - 15 + i) * NPROJ + P_OFF + c2);
        if (i >= 15) raw[i - 15] = v;
        p0[i + 1] = p0[i] + __uint_as_float(v << 16); p1[i + 1] = p1[i] + __uint_as_float(v & 0xffff0000u);
    }
#pragma unroll
    for (int i = 0; i < 32; ++i) {
        const int s = s0 + i; const float inv = 1.f / (float)min(s + 1, W);
        const float m0 = (p0[i + 16] - p0[i + 16 - W]) * inv - __uint_as_float(raw[i] << 16);
        const float m1 = (p1[i + 16] - p1[i + 16 - W]) * inv - __uint_as_float(raw[i] & 0xffff0000u);
        *(unsigned*)(pm + (size_t)(t0 + i) * 512 + c2) = pk2(m0, m1);
    }
}
DI void phase_poolmean(const Params& p, int bid, int nblk, float* lds) {
    const bf16_t* proj = (const bf16_t*)(p.ws + OFF_PROJ); bf16_t* pm = (bf16_t*)(p.ws + OFF_PM);
    for (int item = bid * NT + threadIdx.x; item < 256 * (T / 32); item += nblk * NT) {
        const int pair = item & 255, t0 = (item >> 8) * 32, c2 = pair * 2, g = __builtin_amdgcn_readfirstlane(pair >> 6);
        if (g == 0) poolmean_item<2>(proj, pm, t0, c2);
        else if (g == 1) poolmean_item<4>(proj, pm, t0, c2);
        else if (g == 2) poolmean_item<8>(proj, pm, t0, c2);
        else poolmean_item<16>(proj, pm, t0, c2);
    }
}
DI void phase_pool(const Params& p, int bid, int nblk, float* lds) {
    const bf16_t* pm = (const bf16_t*)(p.ws + OFF_PM); bf16_t* mix = (bf16_t*)(p.ws + OFF_MIX);
    for (int u = bid; u < 64 * 4; u += nblk) {
        const int mt = u >> 2, g = u & 3;
        auto rowoff = [&](int r) { return (unsigned)((mt * 256 + r) * 512 + g * 128); };
        auto pre = [&](int r, int c, f32x4 v, f32x4) { const f32x4 sc = *(const f32x4*)(p.pool_scale + g * 128 + c); return v * sc; };
        auto fin = [&](int r, int c, u32x4 dv) { *(u32x4*)(mix + (size_t)(mt * 256 + r) * D + g * 128 + c) = dv; };
        gemm_mfma<false, false, 2, 128, 2>(pm, rowoff, p.pool_w + (size_t)g * 16384, nullptr, (unsigned)((4 - g) * 16384 * 4), 128, 256, pre, fin, (unsigned char*)lds);
    }
}

DI unsigned f1_off(unsigned row, unsigned chunk) { return row * 128u + ((chunk ^ ((row >> 1) & 7u)) << 4); }
DI unsigned f2_off(unsigned row, unsigned ch) { return 256u * row + 16u * (ch ^ (((row & 3u) << 2) | ((row >> 2) & 3u))); }
DI bf16x8 f1_frag(const unsigned char* img, int tile, int ks, int lane) { return *(const bf16x8*)(img + f1_off(16 * tile + (lane & 15), 4 * ks + (lane >> 4))); }
DI bf16x8 f2_frag(const unsigned char* img, int c, int ks, int lane) {
    const unsigned g = lane >> 4, q = (lane & 15) >> 2, pp = lane & 3;
    const unsigned a0 = f2_off(32 * ks + 8 * g + q, 2 * c + (pp >> 1)) + 8 * (pp & 1), a1 = f2_off(32 * ks + 8 * g + 4 + q, 2 * c + (pp >> 1)) + 8 * (pp & 1);
    const s16x4 lo = __builtin_amdgcn_ds_read_tr16_b64_v4i16((LAS3 s16x4*)(img + a0)), hi = __builtin_amdgcn_ds_read_tr16_b64_v4i16((LAS3 s16x4*)(img + a1));
    return __builtin_bit_cast(bf16x8, __builtin_shufflevector(lo, hi, 0, 1, 2, 3, 4, 5, 6, 7));
}
DI float bfbits2f(unsigned short v) { return __uint_as_float(((unsigned)v) << 16); }
typedef unsigned short u16x8 __attribute__((ext_vector_type(8)));
typedef unsigned short u16x4 __attribute__((ext_vector_type(4)));

DI void phase_gla1(const Params& p, int bid, int nblk, float* ldsf) {
    unsigned char* lds = (unsigned char*)ldsf;
    int tid_ = threadIdx.x; asm volatile("" : "+v"(tid_));
    const int tid = tid_, lane = tid & 63, w = __builtin_amdgcn_readfirstlane(tid >> 6), t = tid >> 3, ch = tid & 7;
    const bf16_t* proj = (const bf16_t*)(p.ws + OFF_PROJ); const float* glow = (const float*)(p.ws + OFF_GLOW);
    float* Gbuf = (float*)(p.ws + OFF_G); float* Sloc = (float*)(p.ws + OFF_SLOC); float* dec = (float*)(p.ws + OFF_DEC);
    float* G = (float*)lds; unsigned char* Kimg = lds + 16384; unsigned char* Vimg = lds + 32768; float* W2l = (float*)(lds + 49152); float* segtot = (float*)(lds + 53248);
    for (int unit = bid; unit < 1024; unit += nblk) {
        const int bh = unit >> 6, n = unit & 63, b = bh >> 2, h = bh & 3, t0 = b * SEQ + n * SC;
        for (int i = tid; i < 1024; i += NT) W2l[i] = p.gate_w2[(i >> 6) * 256 + h * 64 + (i & 63)];
#pragma unroll
        for (int i = 0; i < 2; ++i) { const int idx = tid + NT * i, tr = idx >> 4, c16 = idx & 15;
            *(u32x4*)(Vimg + f2_off(tr, c16)) = *(const u32x4*)(proj + (size_t)(t0 + tr) * NPROJ + V_OFF + h * 128 + 8 * c16); }
        __syncthreads();
        {
            float gl[16];
#pragma unroll
            for (int q = 0; q < 4; ++q) { const f32x4 v = *(const f32x4*)(glow + (size_t)(t0 + t) * 16 + 4 * q); gl[4 * q] = v[0]; gl[4 * q + 1] = v[1]; gl[4 * q + 2] = v[2]; gl[4 * q + 3] = v[3]; }
#pragma unroll
            for (int dd = 0; dd < 8; ++dd) { const int d = 8 * ch + dd; float z = p.gate_b[h * 64 + d];
#pragma unroll
                for (int r = 0; r < 16; ++r) z += gl[r] * W2l[r * 64 + d];
                G[t * 64 + d] = logsigmoidf_(z) * (1.f / 16.f); }
        }
        __syncthreads();
        {
            const int seg = tid >> 6, d = tid & 63; float run = 0.f;
#pragma unroll
            for (int tt = 0; tt < 8; ++tt) { run += G[(8 * seg + tt) * 64 + d]; G[(8 * seg + tt) * 64 + d] = run; }
            segtot[seg * 64 + d] = run;
            __syncthreads();
            float pre = 0.f;
            for (int s2 = 0; s2 < seg; ++s2) pre += segtot[s2 * 64 + d];
#pragma unroll
            for (int tt = 0; tt < 8; ++tt) G[(8 * seg + tt) * 64 + d] += pre;
        }
        __syncthreads();
        {
            const f32x4 g0 = *(const f32x4*)(G + t * 64 + 8 * ch), g1 = *(const f32x4*)(G + t * 64 + 8 * ch + 4);
            const f32x4 l0 = *(const f32x4*)(G + 63 * 64 + 8 * ch), l1 = *(const f32x4*)(G + 63 * 64 + 8 * ch + 4);
            *(f32x4*)(Gbuf + (size_t)(t0 + t) * 256 + h * 64 + 8 * ch) = g0; *(f32x4*)(Gbuf + (size_t)(t0 + t) * 256 + h * 64 + 8 * ch + 4) = g1;
            const u16x8 kv = *(const u16x8*)(proj + (size_t)(t0 + t) * NPROJ + K_OFF + h * 64 + 8 * ch);
            bf16x8 o;
#pragma unroll
            for (int dd = 0; dd < 4; ++dd) { o[dd] = (__bf16)(bfbits2f(kv[dd]) * __expf(l0[dd] - g0[dd])); o[dd + 4] = (__bf16)(bfbits2f(kv[dd + 4]) * __expf(l1[dd] - g1[dd])); }
            *(bf16x8*)(Kimg + f2_off(t, ch)) = o;
            if (t == 63) {
#pragma unroll
                for (int dd = 0; dd < 4; ++dd) { dec[unit * 64 + 8 * ch + dd] = __expf(l0[dd]); dec[unit * 64 + 8 * ch + 4 + dd] = __expf(l1[dd]); }
            }
        }
        __syncthreads();
        {
            f32x4 acc[4];
#pragma unroll
            for (int dt = 0; dt < 4; ++dt) acc[dt] = (f32x4){0.f, 0.f, 0.f, 0.f};
#pragma unroll
            for (int ks = 0; ks < 2; ++ks) {
                const bf16x8 xv = f2_frag(Vimg, w, ks, lane);
#pragma unroll
                for (int dt = 0; dt < 4; ++dt) acc[dt] = MFMA16(xv, f2_frag(Kimg, dt, ks, lane), acc[dt]);
            }
#pragma unroll
            for (int dt = 0; dt < 4; ++dt) *(f32x4*)(Sloc + (size_t)unit * 8192 + (16 * dt + (lane & 15)) * 128 + 16 * w + 4 * (lane >> 4)) = acc[dt];
        }
        __syncthreads();
    }
}

DI void phase_gla2(const Params& p, int bid, int nblk, float* lds) {
    const float* Sloc = (const float*)(p.ws + OFF_SLOC); const float* dec = (const float*)(p.ws + OFF_DEC); bf16_t* Sin = (bf16_t*)(p.ws + OFF_SIN);
    for (int gid = bid * NT + threadIdx.x; gid < 16 * 8192; gid += nblk * NT) {
        const int bh = gid >> 13, el = gid & 8191, d = el >> 7; float st = 0.f;
        for (int n0 = 0; n0 < NSC; n0 += 16) {
            float sl[16], dc[16]; bf16_t so[16];
#pragma unroll
            for (int i = 0; i < 16; ++i) { const int u = bh * 64 + n0 + i; sl[i] = Sloc[(size_t)u * 8192 + el]; dc[i] = dec[u * 64 + d]; }
#pragma unroll
            for (int i = 0; i < 16; ++i) { so[i] = f2bf(st); st = st * dc[i] + sl[i]; }
#pragma unroll
            for (int i = 0; i < 16; ++i) Sin[(size_t)(bh * 64 + n0 + i) * 8192 + el] = so[i];
        }
    }
}

DI void phase_gla3(const Params& p, int bid, int nblk, float* ldsf) {
    unsigned char* lds = (unsigned char*)ldsf;
    int tid_ = threadIdx.x; asm volatile("" : "+v"(tid_));
    const int tid = tid_, lane = tid & 63, w = __builtin_amdgcn_readfirstlane(tid >> 6), t = tid >> 3, ch = tid & 7, l15 = lane & 15, kg = lane >> 4;
    const bf16_t* proj = (const bf16_t*)(p.ws + OFF_PROJ); const float* Gbuf = (const float*)(p.ws + OFF_G); const bf16_t* Sin = (const bf16_t*)(p.ws + OFF_SIN);
    bf16_t* mix = (bf16_t*)(p.ws + OFF_MIX);
    unsigned char* Qimg = lds; unsigned char* Kimg = lds + 8192; unsigned char* Pimg = lds + 16384; unsigned char* Vimg = lds + 24576; unsigned char* Simg = lds + 40960;
    float* part = (float*)(lds + 57344);
    for (int unit = bid; unit < 1024; unit += nblk) {
        const int bh = unit >> 6, n = unit & 63, b = bh >> 2, h = bh & 3, t0 = b * SEQ + n * SC;
        {
            const f32x4 g0 = *(const f32x4*)(Gbuf + (size_t)(t0 + t) * 256 + h * 64 + 8 * ch), g1 = *(const f32x4*)(Gbuf + (size_t)(t0 + t) * 256 + h * 64 + 8 * ch + 4);
            const u16x8 qv = *(const u16x8*)(proj + (size_t)(t0 + t) * NPROJ + Q_OFF + h * 64 + 8 * ch), kv = *(const u16x8*)(proj + (size_t)(t0 + t) * NPROJ + K_OFF + h * 64 + 8 * ch);
            bf16x8 qo, ko;
#pragma unroll
            for (int dd = 0; dd < 4; ++dd) {
                qo[dd] = (__bf16)(bfbits2f(qv[dd]) * 0.125f * __expf(g0[dd])); qo[dd + 4] = (__bf16)(bfbits2f(qv[dd + 4]) * 0.125f * __expf(g1[dd]));
                ko[dd] = (__bf16)(bfbits2f(kv[dd]) * __expf(-g0[dd])); ko[dd + 4] = (__bf16)(bfbits2f(kv[dd + 4]) * __expf(-g1[dd]));
            }
            *(bf16x8*)(Qimg + f1_off(t, ch)) = qo; *(bf16x8*)(Kimg + f1_off(t, ch)) = ko;
        }
#pragma unroll
        for (int i = 0; i < 2; ++i) { const int idx = tid + NT * i, tr = idx >> 4, c16 = idx & 15;
            *(u32x4*)(Vimg + f2_off(tr, c16)) = *(const u32x4*)(proj + (size_t)(t0 + tr) * NPROJ + V_OFF + h * 128 + 8 * c16);
            *(u32x4*)(Simg + f2_off(tr, c16)) = *(const u32x4*)(Sin + (size_t)unit * 8192 + tr * 128 + 8 * c16); }
        __syncthreads();
        {
            const int it = w >> 1;
#pragma unroll
            for (int jj = 0; jj < 2; ++jj) {
                const int jt = 2 * (w & 1) + jj; f32x4 acc = {0.f, 0.f, 0.f, 0.f};
                if (jt <= it) {
#pragma unroll
                    for (int ks = 0; ks < 2; ++ks) acc = MFMA16(f1_frag(Kimg, jt, ks, lane), f1_frag(Qimg, it, ks, lane), acc);
                    if (jt == it) {
#pragma unroll
                        for (int r = 0; r < 4; ++r) if (4 * kg + r > l15) acc[r] = 0.f;
                    }
                }
                bf16x4 o; o[0] = (__bf16)acc[0]; o[1] = (__bf16)acc[1]; o[2] = (__bf16)acc[2]; o[3] = (__bf16)acc[3];
                *(bf16x4*)(Pimg + f1_off(16 * it + l15, 2 * jt + (kg >> 1)) + 8 * (kg & 1)) = o;
            }
        }
        __syncthreads();
        {
            f32x4 acc[4];
#pragma unroll
            for (int it = 0; it < 4; ++it) acc[it] = (f32x4){0.f, 0.f, 0.f, 0.f};
#pragma unroll
            for (int ks = 0; ks < 2; ++ks) {
                const bf16x8 xv = f2_frag(Vimg, w, ks, lane), xs = f2_frag(Simg, w, ks, lane);
#pragma unroll
                for (int it = 0; it < 4; ++it) {
                    if (2 * ks <= it) acc[it] = MFMA16(xv, f1_frag(Pimg, it, ks, lane), acc[it]);
                    acc[it] = MFMA16(xs, f1_frag(Qimg, it, ks, lane), acc[it]);
                }
            }
#pragma unroll
            for (int it = 0; it < 4; ++it) {
                float ss = acc[it][0] * acc[it][0] + acc[it][1] * acc[it][1] + acc[it][2] * acc[it][2] + acc[it][3] * acc[it][3];
                ss += __shfl_xor(ss, 16); ss += __shfl_xor(ss, 32);
                if (kg == 0) part[w * 64 + 16 * it + l15] = ss;
            }
            __syncthreads();
            const int e0 = 16 * w + 4 * kg; const f32x4 nw = *(const f32x4*)(p.norm_w + e0);
#pragma unroll
            for (int it = 0; it < 4; ++it) {
                const int i = 16 * it + l15; float tot = 0.f;
#pragma unroll
                for (int w2 = 0; w2 < 8; ++w2) tot += part[w2 * 64 + i];
                const float inv = rsqrtf(tot * (1.f / 128.f) + RMS_EPS);
                const u16x4 rv = *(const u16x4*)(proj + (size_t)(t0 + i) * NPROJ + R_OFF + h * 128 + e0);
                bf16x4 o;
#pragma unroll
                for (int r = 0; r < 4; ++r) { const float rr = bfbits2f(rv[r]); o[r] = (__bf16)(acc[it][r] * inv * nw[r] * (rr * sigmoidf_(rr))); }
                *(bf16x4*)(mix + (size_t)(t0 + i) * D + 512 + h * 128 + e0) = o;
            }
        }
        __syncthreads();
    }
}

DI void phase_out(const Params& p, int bid, int nblk, float* lds) {
    const bf16_t* mix = (const bf16_t*)(p.ws + OFF_MIX); bf16_t* yb = (bf16_t*)(p.ws + OFF_H32);
    for (int u = bid; u < 64 * 4; u += nblk) {
        const int mt = (nblk == 256) ? 8 * (u & 7) + (u >> 5) : u >> 2, nt = (nblk == 256) ? (u >> 3) & 3 : u & 3;
        auto rowoff = [&](int r) { return (unsigned)((mt * 256 + r) * D); };
        auto fin = [&](int r, int c, u32x4 dv) {
            const size_t o = (size_t)(mt * 256 + r) * D + nt * 256 + c; const f32x4 x0 = *(const f32x4*)(p.x + o), x1 = *(const f32x4*)(p.x + o + 4);
            u32x4 ov;
            ov[0] = pk2(bf2f((bf16_t)(dv[0] & 0xffffu)) + ALPHA * x0[0], bf2f((bf16_t)(dv[0] >> 16)) + ALPHA * x0[1]);
            ov[1] = pk2(bf2f((bf16_t)(dv[1] & 0xffffu)) + ALPHA * x0[2], bf2f((bf16_t)(dv[1] >> 16)) + ALPHA * x0[3]);
            ov[2] = pk2(bf2f((bf16_t)(dv[2] & 0xffffu)) + ALPHA * x1[0], bf2f((bf16_t)(dv[2] >> 16)) + ALPHA * x1[1]);
            ov[3] = pk2(bf2f((bf16_t)(dv[3] & 0xffffu)) + ALPHA * x1[2], bf2f((bf16_t)(dv[3] >> 16)) + ALPHA * x1[3]);
            *(u32x4*)(yb + o) = ov; };
        gemm_mfma<false, true, 2, D, 4>(mix, rowoff, (const float*)((const bf16_t*)(p.ws + OFF_WB_OUT) + nt * 256), nullptr, (unsigned)(((size_t)D * D - nt * 256) * 2), D, 256, PRE_ID, fin, (unsigned char*)lds);
    }
}

DI void ln_row(float (&v)[16], const float* g, const float* b, int lane) {
    float s = 0.f;
#pragma unroll
    for (int i = 0; i < 16; ++i) s += v[i];
    const float mean = wave_sum(s) * (1.f / D); float q = 0.f;
#pragma unroll
    for (int i = 0; i < 16; ++i) { v[i] -= mean; q += v[i] * v[i]; }
    const float rstd = rsqrtf(wave_sum(q) * (1.f / D) + LN_EPS);
#pragma unroll
    for (int j = 0; j < 4; ++j) {
        const float4 gg = ((const float4*)g)[lane + 64 * j], bb = ((const float4*)b)[lane + 64 * j];
        v[4 * j] = v[4 * j] * rstd * gg.x + bb.x; v[4 * j + 1] = v[4 * j + 1] * rstd * gg.y + bb.y;
        v[4 * j + 2] = v[4 * j + 2] * rstd * gg.z + bb.z; v[4 * j + 3] = v[4 * j + 3] * rstd * gg.w + bb.w;
    }
}

DI void ln1_rows(const Params& p, int r0, int nrows) {
    int tid_ = threadIdx.x; asm volatile("" : "+v"(tid_));
    const int lane = tid_ & 63, wave = tid_ >> 6;
    const bf16_t* yb = (const bf16_t*)(p.ws + OFF_H32); bf16_t* hb = (bf16_t*)(p.ws + OFF_HB);
    for (int rb = r0 + wave; rb < r0 + nrows; rb += 32) {
        float v[4][16];
#pragma unroll
        for (int q = 0; q < 4; ++q) {
            const u32x4* hr = (const u32x4*)(yb + (size_t)(rb + 8 * q) * D);
#pragma unroll
            for (int j = 0; j < 2; ++j) { const u32x4 a = hr[lane + 64 * j];
                _Pragma("unroll") for (int k = 0; k < 4; ++k) { v[q][8 * j + 2 * k] = bf2f((bf16_t)(a[k] & 0xffffu)); v[q][8 * j + 2 * k + 1] = bf2f((bf16_t)(a[k] >> 16)); } }
        }
        float s[4], qq[4];
#pragma unroll
        for (int q = 0; q < 4; ++q) { s[q] = 0.f; _Pragma("unroll") for (int i = 0; i < 16; ++i) s[q] += v[q][i]; }
#pragma unroll
        for (int o = 1; o < 64; o <<= 1) { _Pragma("unroll") for (int q = 0; q < 4; ++q) s[q] += __shfl_xor(s[q], o); }
#pragma unroll
        for (int q = 0; q < 4; ++q) { const float mean = s[q] * (1.f / D); qq[q] = 0.f; _Pragma("unroll") for (int i = 0; i < 16; ++i) { v[q][i] -= mean; qq[q] += v[q][i] * v[q][i]; } }
#pragma unroll
        for (int o = 1; o < 64; o <<= 1) { _Pragma("unroll") for (int q = 0; q < 4; ++q) qq[q] += __shfl_xor(qq[q], o); }
#pragma unroll
        for (int j = 0; j < 2; ++j) {
            const float4 g0 = ((const float4*)p.ln1_g)[2 * (lane + 64 * j)], g1 = ((const float4*)p.ln1_g)[2 * (lane + 64 * j) + 1];
            const float4 b0 = ((const float4*)p.ln1_b)[2 * (lane + 64 * j)], b1 = ((const float4*)p.ln1_b)[2 * (lane + 64 * j) + 1];
#pragma unroll
            for (int q = 0; q < 4; ++q) {
                const float rstd = rsqrtf(qq[q] * (1.f / D) + LN_EPS); const float* w = &v[q][8 * j];
                u32x4 o;
                o[0] = pk2(w[0] * rstd * g0.x + b0.x, w[1] * rstd * g0.y + b0.y); o[1] = pk2(w[2] * rstd * g0.z + b0.z, w[3] * rstd * g0.w + b0.w);
                o[2] = pk2(w[4] * rstd * g1.x + b1.x, w[5] * rstd * g1.y + b1.y); o[3] = pk2(w[6] * rstd * g1.z + b1.z, w[7] * rstd * g1.w + b1.w);
                ((u32x4*)(hb + (size_t)(rb + 8 * q) * D))[lane + 64 * j] = o;
            }
        }
    }
}

DI void topk_rows(const Params& p, int r0, int nrows) {
    int tid_ = threadIdx.x; asm volatile("" : "+v"(tid_));
    const int lane = tid_ & 63, wave = tid_ >> 6;
    const float* scores = (const float*)(p.ws + OFF_SCORES); float* wbuf = (float*)(p.ws + OFF_WBUF);
    int* list = (int*)(p.ws + OFF_LIST); unsigned* cnt = (unsigned*)(p.ws + OFF_CTL) + CW_CNT;
    const float NEG = -__builtin_inff();
    for (int t = r0 + wave; t < r0 + nrows; t += 8) {
        const float4 sv = ((const float4*)(scores + (size_t)t * NE))[lane], bv = ((const float4*)p.router_bias)[lane];
        const float s[4] = {sv.x, sv.y, sv.z, sv.w};
        float cand[4] = {sv.x + bv.x, sv.y + bv.y, sv.z + bv.z, sv.w + bv.w};
        float m1 = NEG, m2 = NEG;
#pragma unroll
        for (int j = 0; j < 4; ++j) { const float v = cand[j]; if (v > m1) { m2 = m1; m1 = v; } else if (v > m2) m2 = v; }
#pragma unroll
        for (int off = 1; off < 8; off <<= 1) {
            const float o1 = __shfl_xor(m1, off), o2 = __shfl_xor(m2, off);
            const float n1 = fmaxf(m1, o1), n2 = fmaxf(fminf(m1, o1), fmaxf(m2, o2)); m1 = n1; m2 = n2;
        }
        const float gs = m1 + m2; const int mygrp = lane >> 3; int rank = 0;
#pragma unroll
        for (int g2 = 0; g2 < 8; ++g2) { const float og = __shfl(gs, g2 * 8); if (og > gs || (og == gs && g2 < mygrp)) ++rank; }
        if (rank >= 4) { cand[0] = NEG; cand[1] = NEG; cand[2] = NEG; cand[3] = NEG; }
        int my_e = 0; float my_w = 0.f, wsum = 0.f;
#pragma unroll
        for (int k = 0; k < TOPK; ++k) {
            float bvv = cand[0]; int bj = 0;
#pragma unroll
            for (int j = 1; j < 4; ++j) if (cand[j] > bvv) { bvv = cand[j]; bj = j; }
            int bi = 4 * lane + bj;
#pragma unroll
            for (int off = 32; off >= 1; off >>= 1) {
                const float ov = __shfl_xor(bvv, off); const int oi = __shfl_xor(bi, off);
                if (ov > bvv || (ov == bvv && oi < bi)) { bvv = ov; bi = oi; }
            }
            const int wj = bi & 3, wl = bi >> 2;
            const float mys = wj == 0 ? s[0] : (wj == 1 ? s[1] : (wj == 2 ? s[2] : s[3]));
            const float wk = __shfl(mys, wl);
            wsum += wk;
            if (lane == k) { my_e = bi; my_w = wk; }
            if (lane == wl) {
#pragma unroll
                for (int j = 0; j < 4; ++j) if (j == wj) cand[j] = NEG;
            }
        }
        if (lane < TOPK) {
            const unsigned pos = atomicAdd(&cnt[my_e], 1u);
            list[(size_t)my_e * LCAP + pos] = t * TOPK + lane;
            wbuf[(size_t)t * TOPK + lane] = my_w / wsum * 2.5f;
        }
    }
}

DI void phase_route(const Params& p, int bid, int nblk, float* lds) {
    const bf16_t* hb = (const bf16_t*)(p.ws + OFF_HB); float* scores = (float*)(p.ws + OFF_SCORES);
    for (int mt = bid; mt < T / 64; mt += nblk) {
        ln1_rows(p, mt * 64, 64);
        __syncthreads();
        auto rowoff = [&](int r) { return (unsigned)((mt * 64 + r) * D); };
        auto pre = [&](int r, int c, f32x4 v, f32x4) { return (f32x4){sigmoidf_(v[0]), sigmoidf_(v[1]), sigmoidf_(v[2]), sigmoidf_(v[3])}; };
        auto fin = [&](int r, int c, u32x4 dv) { *(u32x4*)(scores + (size_t)(mt * 64 + r) * NE + c) = dv; };
        gemm_mfma<false, true, 4, NE, 4>(hb, rowoff, (const float*)(p.ws + OFF_WB_RT), nullptr, (unsigned)(D * NE * 2), D, 64, pre, fin, (unsigned char*)lds);
        __syncthreads();
        topk_rows(p, mt * 64, 64);
        __syncthreads();
    }
}

constexpr int EXP_TAB_OFF = GEMM_LDS_BYTES;
DI void build_tables(const Params& p, int* toff, int* roff) {
    const unsigned* cnt = (const unsigned*)(p.ws + OFF_CTL) + CW_CNT;
    int* cl = roff + 260;
    if (threadIdx.x < NE) cl[threadIdx.x] = (int)__hip_atomic_load(cnt + threadIdx.x, __ATOMIC_RELAXED, __HIP_MEMORY_SCOPE_AGENT);
    __syncthreads();
    if (threadIdx.x <= NE) {
        int ta = 0, ra = 0;
        for (int e = 0; e < (int)threadIdx.x; ++e) { const int c = cl[e]; ta += (c + 255) >> 8; ra += c; }
        toff[threadIdx.x] = ta; roff[threadIdx.x] = ra;
    }
    __syncthreads();
    if (threadIdx.x < NE) { unsigned char* texp = (unsigned char*)(roff + 1040); for (int t = toff[threadIdx.x]; t < toff[threadIdx.x + 1]; ++t) texp[t] = (unsigned char)threadIdx.x; }
    __syncthreads();
}
DI int find_expert(const int* toff, int tile) { int lo = 0, hi = NE - 1; while (lo < hi) { const int mid = (lo + hi + 1) >> 1; if (toff[mid] <= tile) lo = mid; else hi = mid - 1; } return lo; }
struct ExpUnit { int e, row0, rows, rowbase; };
DI ExpUnit exp_unit(const int* toff, const int* roff, int e, int tile, int ntile) {
    const int* cl = roff + 260;
    ExpUnit u;
    if (tile < ntile) {
        u.e = e; const int ui = tile - toff[e], c = cl[e];
        u.row0 = ui * 256; u.rows = min(256, c - u.row0); u.rowbase = roff[e] + u.row0;
    } else { u.e = NE; u.row0 = (tile - ntile) * 256; u.rows = 256; u.rowbase = A_TOT + u.row0; }
    u.e = __builtin_amdgcn_readfirstlane(u.e); u.row0 = __builtin_amdgcn_readfirstlane(u.row0); u.rows = __builtin_amdgcn_readfirstlane(u.rows);
    u.rowbase = __builtin_amdgcn_readfirstlane(u.rowbase);
    return u;
}

template <int NTL>
DI int exp_decode(const int* toff, int ntile, int u, int& tile, int& nt) {
    if (u < NTL * ntile) {
        const unsigned char* texp = (const unsigned char*)(toff + 260 + 1040);
        const int e = texp[u / NTL], t0 = toff[e], ne = toff[e + 1] - t0; int u2 = u - NTL * t0; nt = 0;
#pragma unroll
        for (int i = 1; i < NTL; ++i) if (u2 >= ne) { u2 -= ne; ++nt; }
        tile = t0 + u2; return e;
    }
    else { const int us = u - NTL * ntile; nt = us / (T / 256); tile = ntile + (us - nt * (T / 256)); return NE; }
}

DI void phase_e1(const Params& p, int bid, int nblk, float* lds) {
    int* toff = (int*)((unsigned char*)lds + EXP_TAB_OFF); int* roff = toff + 260;
    const bf16_t* hb = (const bf16_t*)(p.ws + OFF_HB); bf16_t* hid = (bf16_t*)(p.ws + OFF_HID); const int* list = (const int*)(p.ws + OFF_LIST);
    build_tables(p, toff, roff);
    const int ntile = toff[NE], units = (ntile + T / 256) * 2;
    const int vb = (nblk & 7) ? bid : (bid & 7) * (nblk >> 3) + (bid >> 3);
    u32x4 ra[2][2], rb[2][4]; unsigned ao[2] = {0u, 0u}; bool pre = false;
    int tile_n = 0, nt_n = 0; ExpUnit xn;
    if (vb < units) { const int e_ = exp_decode<2>(toff, ntile, vb, tile_n, nt_n); xn = exp_unit(toff, roff, e_, tile_n, ntile); }
    for (int u = vb; u < units; u += nblk) {
        const int nt = nt_n; const ExpUnit x = xn; const bool hn = u + nblk < units;
        if (hn) { const int e_ = exp_decode<2>(toff, ntile, u + nblk, tile_n, nt_n); xn = exp_unit(toff, roff, e_, tile_n, ntile); }
        const float* wg = x.e < NE ? p.wg + (size_t)x.e * 262144 : p.sg; const float* wu = x.e < NE ? p.wu + (size_t)x.e * 262144 : p.su;
        const float* wgn = xn.e < NE ? p.wg + (size_t)xn.e * 262144 : p.sg; const float* wun = xn.e < NE ? p.wu + (size_t)xn.e * 262144 : p.su;
        auto rowoff = [&](int r) { const int tok = x.e < NE ? (list[(size_t)x.e * LCAP + x.row0 + r] >> 3) : (x.row0 + r); return (unsigned)(tok * D); };
        auto rowoff_n = [&](int r) { const int tok = xn.e < NE ? (list[(size_t)xn.e * LCAP + xn.row0 + r] >> 3) : (xn.row0 + r); return (unsigned)(tok * D); };
        auto prf = [&](int r, int c, f32x4 g, f32x4 uu) { return (f32x4){g[0] * sigmoidf_(g[0]) * uu[0], g[1] * sigmoidf_(g[1]) * uu[1], g[2] * sigmoidf_(g[2]) * uu[2], g[3] * sigmoidf_(g[3]) * uu[3]}; };
        auto fin = [&](int r, int c, u32x4 dv) { *(u32x4*)(hid + (size_t)(x.rowbase + r) * EDIM + nt * 128 + c) = dv; };
        gemm_core<true, false, 2, EDIM, 4>(ra, rb, ao, pre, hb, rowoff, wg + nt * 128, wu + nt * 128, (unsigned)((D * EDIM - nt * 128) * 4), D, x.rows,
                                 hn, rowoff_n, wgn + nt_n * 128, wun + nt_n * 128, (unsigned)((D * EDIM - nt_n * 128) * 4), xn.rows, prf, fin, (unsigned char*)lds);
        pre = hn;
    }
}

DI void phase_e2(const Params& p, int bid, int nblk, float* lds) {
    int* toff = (int*)((unsigned char*)lds + EXP_TAB_OFF); int* roff = toff + 260; int* rowa = roff + 520;
    const bf16_t* hid = (const bf16_t*)(p.ws + OFF_HID); unsigned char* Y = p.ws + OFF_Y; const int* list = (const int*)(p.ws + OFF_LIST);
    build_tables(p, toff, roff);
    const int ntile = toff[NE], units = (ntile + T / 256) * 4;
    const int vb = (nblk & 7) ? bid : (bid & 7) * (nblk >> 3) + (bid >> 3);
    u32x4 ra[2][2], rb[2][4]; unsigned ao[2] = {0u, 0u}; bool pre = false;
    int tile_n = 0, nt_n = 0; ExpUnit xn;
    auto rowa_val = [&](const ExpUnit& q, int r) { return q.e < NE ? (r < q.rows ? list[(size_t)q.e * LCAP + q.row0 + r] : 0) : (A_TOT + q.row0 + r); };
    if (vb < units) { const int e_ = exp_decode<4>(toff, ntile, vb, tile_n, nt_n); xn = exp_unit(toff, roff, e_, tile_n, ntile); if (threadIdx.x < 256) rowa[threadIdx.x] = rowa_val(xn, threadIdx.x); }
    __syncthreads();
    int cur = 0;
    for (int u = vb; u < units; u += nblk) {
        const int nt = nt_n; const ExpUnit x = xn; const bool hn = u + nblk < units;
        if (hn) { const int e_ = exp_decode<4>(toff, ntile, u + nblk, tile_n, nt_n); xn = exp_unit(toff, roff, e_, tile_n, ntile); }
        const float* wd = x.e < NE ? p.wd + (size_t)x.e * 262144 : p.sd; const float* wdn = xn.e < NE ? p.wd + (size_t)xn.e * 262144 : p.sd;
        int rnext = 0;
        if (hn && threadIdx.x < 256) rnext = rowa_val(xn, threadIdx.x);
        const int* rowa_c = rowa + cur * 256;
        auto rowoff = [&](int r) { return (unsigned)((x.rowbase + r) * EDIM); };
        auto rowoff_n = [&](int r) { return (unsigned)((xn.rowbase + r) * EDIM); };
        auto fin = [&](int r, int c, u32x4 dv) { *(u32x4*)(Y + (size_t)rowa_c[r] * D + nt * 256 + c) = dv; };
        gemm_core<false, false, 1, D, 4>(ra, rb, ao, pre, hid, rowoff, wd + nt * 256, nullptr, (unsigned)((EDIM * D - nt * 256) * 4), EDIM, x.rows,
                               hn, rowoff_n, wdn + nt_n * 256, nullptr, (unsigned)((EDIM * D - nt_n * 256) * 4), xn.rows, PRE_ID, fin, (unsigned char*)lds);
        pre = hn;
        cur ^= 1;
        if (threadIdx.x < 256) rowa[cur * 256 + threadIdx.x] = rnext;
    }
}

DI void phase_combine(const Params& p, int bid, int nblk, float* lds) {
    const int lane = threadIdx.x & 63, wave = threadIdx.x >> 6;
    const bf16_t* hb = (const bf16_t*)(p.ws + OFF_HB); const unsigned char* Y = p.ws + OFF_Y; const float* wbuf = (const float*)(p.ws + OFF_WBUF);
    typedef float f32x2 __attribute__((ext_vector_type(2)));
    for (int t = bid * 8 + wave; t < T; t += nblk * 8) {
        float v[16];
#pragma unroll
        for (int j = 0; j < 4; ++j) { const uint2 a = ((const uint2*)(hb + (size_t)t * D))[lane + 64 * j];
            v[4 * j] = ALPHA * __uint_as_float(a.x << 16); v[4 * j + 1] = ALPHA * __uint_as_float(a.x & 0xffff0000u);
            v[4 * j + 2] = ALPHA * __uint_as_float(a.y << 16); v[4 * j + 3] = ALPHA * __uint_as_float(a.y & 0xffff0000u); }
#pragma unroll
        for (int k = 0; k < 9; ++k) {
            const size_t row = k < 8 ? (size_t)t * TOPK + k : (size_t)A_TOT + t; const float w = (k < 8 ? wbuf[(size_t)t * TOPK + k] : 1.f) * (1.f / 128.f);
#pragma unroll
            for (int j = 0; j < 4; ++j) {
                const int y = ((const int*)(Y + row * D))[lane + 64 * j];
                const f32x2 lo = __builtin_amdgcn_cvt_pk_f32_fp8(y, false), hi = __builtin_amdgcn_cvt_pk_f32_fp8(y, true);
                v[4 * j] += w * lo[0]; v[4 * j + 1] += w * lo[1]; v[4 * j + 2] += w * hi[0]; v[4 * j + 3] += w * hi[1];
            }
        }
        ln_row(v, p.ln2_g, p.ln2_b, lane);
#pragma unroll
        for (int j = 0; j < 4; ++j) ((float4*)(p.out + (size_t)t * D))[lane + 64 * j] = make_float4(v[4 * j], v[4 * j + 1], v[4 * j + 2], v[4 * j + 3]);
    }
}

#define LAS __attribute__((address_space(3)))
#define XB_TMO      128
#define XB_XCNT(j)  (256  + 64 * (j))
#define XB_XSUB(j)  (1280 + 64 * (j))
#define XB_XGEN(j)  (2304 + 64 * (j))
#define XB_TOP      3328
#define XB_TOPGEN   3392
#define XCD_BAR_WORDS 3456
#define XB_SPIN_CAP (1u << 22)
constexpr int CW_BAR = 4096;
DI unsigned xb_ld(unsigned* p) { return __hip_atomic_load(p, __ATOMIC_RELAXED, __HIP_MEMORY_SCOPE_AGENT); }
DI unsigned xb_add(unsigned* p, unsigned v) { return __hip_atomic_fetch_add(p, v, __ATOMIC_RELAXED, __HIP_MEMORY_SCOPE_AGENT); }
DI unsigned xb_xcc_id() { return (unsigned)__builtin_amdgcn_s_getreg((3 << 11) | 20) & 0xFu; }
#define XB_SPIN(cond, bar) do { unsigned _sp = 0; while (cond) { __builtin_amdgcn_s_sleep(1); \
    if ((++_sp & 255u) == 0u) { if (xb_ld(&(bar)[XB_TMO])) break; if (_sp > XB_SPIN_CAP) { atomicAdd(&(bar)[XB_TMO], 1u); break; } } } } while (0)
struct XcdBarrier { unsigned* bar; unsigned x; volatile LAS unsigned* st; };
DI XcdBarrier xcd_barrier_post(unsigned* bar, volatile LAS unsigned* st) {
    XcdBarrier b; b.bar = bar; b.x = xb_xcc_id(); b.st = st;
    if (threadIdx.x == 0) (void)xb_add(&bar[XB_XCNT(b.x)], 1u);
    return b;
}
DI void xcd_barrier_complete(unsigned* bar, unsigned x, unsigned& nloc, unsigned& nx) {
    const unsigned G = gridDim.x * gridDim.y * gridDim.z;
    unsigned sum, cnt, mine, sp = 0u;
    for (;;) {
        sum = 0u; cnt = 0u; mine = 0u;
#pragma unroll
        for (unsigned j = 0; j < 16; ++j) { const unsigned c = xb_ld(&bar[XB_XCNT(j)]); sum += c; cnt += (c > 0u) ? 1u : 0u; mine = (j == x) ? c : mine; }
        if (sum == G) break;
        __builtin_amdgcn_s_sleep(1);
        if ((++sp & 255u) == 0u) { if (xb_ld(&bar[XB_TMO])) break; if (sp > XB_SPIN_CAP) { atomicAdd(&bar[XB_TMO], 1u); break; } }
    }
    nloc = mine > 0u ? mine : 1u; nx = cnt > 0u ? cnt : 1u;
}
DI void xcd_barrier(const XcdBarrier& b) {
    asm volatile("s_waitcnt vmcnt(0)" ::: "memory");
    __syncthreads();
    if (threadIdx.x == 0) {
        unsigned* bar = b.bar;
        __builtin_amdgcn_s_waitcnt(0);
        unsigned nloc = b.st[0], nx = b.st[1];
        if (nloc == 0u) { xcd_barrier_complete(bar, b.x, nloc, nx); b.st[0] = nloc; b.st[1] = nx; }
        const unsigned old = xb_add(&bar[XB_XSUB(b.x)], 1u);
        const unsigned gen = old / nloc;
        if (old + 1u == (gen + 1u) * nloc) {
            __builtin_amdgcn_fence(__ATOMIC_RELEASE, "agent");
            asm volatile("s_waitcnt vmcnt(0)" ::: "memory");
            const unsigned og = xb_add(&bar[XB_TOP], 1u);
            const unsigned tg = og / nx;
            if (og + 1u == (tg + 1u) * nx) xb_add(&bar[XB_TOPGEN], 1u);
            else XB_SPIN(xb_ld(&bar[XB_TOPGEN]) == tg, bar);
            __builtin_amdgcn_fence(__ATOMIC_ACQUIRE, "agent");
            xb_add(&bar[XB_XGEN(b.x)], 1u);
            asm volatile("s_waitcnt vmcnt(0)" ::: "memory");
        } else {
            XB_SPIN(xb_ld(&bar[XB_XGEN(b.x)]) == gen, bar);
            __builtin_amdgcn_fence(__ATOMIC_ACQUIRE, "agent");
            asm volatile("s_waitcnt vmcnt(0)" ::: "memory");
        }
    }
    __syncthreads();
}

constexpr int LDS_BYTES = 136 * 1024;
constexpr int LDS_BAR_OFF = LDS_BYTES - 16;
__global__ void __launch_bounds__(NT) fwd_megakernel(Params p) {
    extern __shared__ __attribute__((aligned(16))) float lds[];
    const int bid = blockIdx.x, nblk = gridDim.x;
    volatile LAS unsigned* st = (volatile LAS unsigned*)((LAS unsigned char*)lds + LDS_BAR_OFF);
    if (threadIdx.x < 4) st[threadIdx.x] = 0u;
    __syncthreads();
    XcdBarrier bar = xcd_barrier_post((unsigned*)(p.ws + OFF_CTL) + CW_BAR, st);
    phase_prep(p, bid, nblk, lds);      xcd_barrier(bar);
    phase_proj(p, bid, nblk, lds);      xcd_barrier(bar);
    phase_poolmean(p, bid, nblk, lds);
    phase_gla1(p, bid, nblk, lds);      xcd_barrier(bar);
    phase_pool(p, bid, nblk, lds);
    phase_gla2(p, bid, nblk, lds);      xcd_barrier(bar);
    phase_gla3(p, bid, nblk, lds);      xcd_barrier(bar);
    phase_out(p, bid, nblk, lds);       xcd_barrier(bar);
    phase_route(p, bid, nblk, lds);     xcd_barrier(bar);
    phase_e1(p, bid, nblk, lds);        xcd_barrier(bar);
    phase_e2(p, bid, nblk, lds);        xcd_barrier(bar);
    phase_combine(p, bid, nblk, lds);
}

extern "C" void kernel_launch(void* const* d_in, const int* in_sizes, int n_in, void* d_out, int out_size, void* d_ws, size_t ws_size, hipStream_t stream) {
    static int grid = 0;
    if (grid == 0) {
        if (n_in != 20 || ws_size < WS_NEED) { fprintf(stderr, "kernel_launch: unexpected n_in %d or ws_size %zu (< %zu)\n", n_in, ws_size, (size_t)WS_NEED); grid = -1; return; }
        int dev = 0, cus = 0, per_cu = 0;
        (void)hipGetDevice(&dev); (void)hipDeviceGetAttribute(&cus, hipDeviceAttributeMultiprocessorCount, dev);
        (void)hipFuncSetAttribute((const void*)fwd_megakernel, hipFuncAttributeMaxDynamicSharedMemorySize, LDS_BYTES);
        (void)hipOccupancyMaxActiveBlocksPerMultiprocessor(&per_cu, (const void*)fwd_megakernel, NT, LDS_BYTES);
        if (per_cu < 1 || cus < 1) { fprintf(stderr, "kernel_launch: occupancy query says %d blocks/CU on %d CUs\n", per_cu, cus); grid = -1; return; }
        grid = cus;
    }
    if (grid < 0) return;
    (void)hipMemsetAsync((char*)d_ws + OFF_CTL, 0, 64 * 1024, stream);
    Params p{};
    const float** pp = (const float**)&p;
    for (int i = 0; i < 20; ++i) pp[i] = (const float*)d_in[i];
    p.out = (float*)d_out; p.ws = (unsigned char*)d_ws;
    void* args[] = {&p};
    hipError_t e = hipLaunchCooperativeKernel((const void*)fwd_megakernel, dim3(grid), dim3(NT), args, LDS_BYTES, stream);
    if (e != hipSuccess) fprintf(stderr, "cooperative launch failed: %s (grid %d)\n", hipGetErrorString(e), grid);
}
```

```cpp
#include <hip/hip_runtime.h>
#include <stdint.h>
#include <cstdio>

#define DI __device__ __forceinline__
typedef unsigned short bf16_t;

constexpr int T = 16384, D = 1024, SEQ = 4096;
constexpr int DIN = 2064, NPROJ = 2048;
constexpr int P_OFF = 0, Q_OFF = 512, K_OFF = 768, V_OFF = 1024, R_OFF = 1536, GL_OFF = 2048;
constexpr int SC = 64;
constexpr int NSC = SEQ / SC;
constexpr int NE = 256, TOPK = 8, EDIM = 256;
constexpr int A_TOT = T * TOPK;
constexpr int LCAP = T;
constexpr float ALPHA = 1.189207115002721f;
constexpr float LN_EPS = 1e-5f, RMS_EPS = 1e-5f;
constexpr int NT = 512;

constexpr size_t MiB = 1u << 20;
constexpr size_t OFF_CTL = 0;
constexpr size_t OFF_XB = 1 * MiB;
constexpr size_t OFF_GLOW = OFF_XB + 32 * MiB;
constexpr size_t OFF_PROJ = OFF_GLOW + 1 * MiB;
constexpr size_t OFF_G = OFF_PROJ + 64 * MiB;
constexpr size_t OFF_SLOC = OFF_G + 16 * MiB;
constexpr size_t OFF_DEC = OFF_SLOC + 32 * MiB;
constexpr size_t OFF_SIN = OFF_DEC + 1 * MiB;
constexpr size_t OFF_MIX = OFF_SIN + 32 * MiB;
constexpr size_t OFF_H32 = OFF_MIX + 32 * MiB;
constexpr size_t OFF_HB = OFF_H32 + 64 * MiB;
constexpr size_t OFF_SCORES = OFF_HB + 32 * MiB;
constexpr size_t OFF_WBUF = OFF_SCORES + 16 * MiB;
constexpr size_t OFF_LIST = OFF_WBUF + 1 * MiB;
constexpr size_t OFF_HID = OFF_LIST + 16 * MiB;
constexpr size_t OFF_Y = OFF_HID + 76 * MiB;
constexpr size_t OFF_PM = OFF_Y + 304 * MiB;
constexpr size_t OFF_WB_IN = OFF_PM + 16 * MiB;
constexpr size_t OFF_WB_OUT = OFF_WB_IN + 4 * MiB;
constexpr size_t OFF_WB_RT = OFF_WB_OUT + 2 * MiB;
constexpr size_t OFF_WB_SGU = OFF_WB_RT + 1 * MiB;
constexpr size_t OFF_WB_SD = OFF_WB_SGU + 1 * MiB;
constexpr size_t WS_NEED = OFF_WB_SD + 1 * MiB;
constexpr int CW_CNT = 1024;

struct Params {
    const float *x, *w_in, *gate_w2, *gate_b, *norm_w, *pool_w, *pool_scale, *w_out, *ln1_g, *ln1_b;
    const float *router_w, *router_bias, *wg, *wu, *wd, *sg, *su, *sd, *ln2_g, *ln2_b;
    float* out;
    unsigned char* ws;
};

DI float bf2f(bf16_t v) { return __uint_as_float(((unsigned)v) << 16); }
DI bf16_t f2bf(float f) { unsigned u = __float_as_uint(f); u += 0x7fffu + ((u >> 16) & 1u); return (bf16_t)(u >> 16); }
DI unsigned pk2(float lo, float hi) { return (unsigned)f2bf(lo) | ((unsigned)f2bf(hi) << 16); }
DI float wave_sum(float v) {
#pragma unroll
    for (int o = 1; o < 64; o <<= 1) v += __shfl_xor(v, o);
    return v;
}
DI float sigmoidf_(float v) { return 1.f / (1.f + __expf(-v)); }
DI float logsigmoidf_(float z) { return fminf(z, 0.f) - log1pf(__expf(-fabsf(z))); }

constexpr int GT_LDS_FLOATS = 16 * 132 + 2 * 16 * 68;
template <bool DUAL, class AF, class BF, class EPI>
DI void gemm_tile_valu(int K, const AF& af, const BF& bfn, const EPI& epi, float* lds) {
    float* As = lds; float* Bs = lds + 16 * 132; float* Bs2 = Bs + 16 * 68;
    const int tid = threadIdx.x, ty = tid >> 4, tx = tid & 15;
    float acc[4][4], acc2[4][4];
#pragma unroll
    for (int i = 0; i < 4; ++i)
#pragma unroll
        for (int j = 0; j < 4; ++j) { acc[i][j] = 0.f; acc2[i][j] = 0.f; }
    for (int k0 = 0; k0 < K; k0 += 16) {
#pragma unroll
        for (int i = 0; i < 4; ++i) { const int e = tid + 512 * i, r = e >> 4, kk = e & 15; As[kk * 132 + r] = af(r, k0 + kk); }
#pragma unroll
        for (int i = 0; i < 2; ++i) { const int e = tid + 512 * i, kk = e >> 6, c = e & 63; Bs[kk * 68 + c] = bfn(0, k0 + kk, c); if (DUAL) Bs2[kk * 68 + c] = bfn(1, k0 + kk, c); }
        __syncthreads();
#pragma unroll
        for (int kk = 0; kk < 16; ++kk) {
            const float4 a = *(const float4*)&As[kk * 132 + ty * 4];
            const float4 b = *(const float4*)&Bs[kk * 68 + tx * 4];
            const float av[4] = {a.x, a.y, a.z, a.w}, bv[4] = {b.x, b.y, b.z, b.w};
#pragma unroll
            for (int i = 0; i < 4; ++i)
#pragma unroll
                for (int j = 0; j < 4; ++j) acc[i][j] += av[i] * bv[j];
            if (DUAL) {
                const float4 b2 = *(const float4*)&Bs2[kk * 68 + tx * 4];
                const float b2v[4] = {b2.x, b2.y, b2.z, b2.w};
#pragma unroll
                for (int i = 0; i < 4; ++i)
#pragma unroll
                    for (int j = 0; j < 4; ++j) acc2[i][j] += av[i] * b2v[j];
            }
        }
        __syncthreads();
    }
#pragma unroll
    for (int i = 0; i < 4; ++i)
#pragma unroll
        for (int j = 0; j < 4; ++j) epi(ty * 4 + i, tx * 4 + j, acc[i][j], acc2[i][j]);
}


typedef __bf16 bf16x8 __attribute__((ext_vector_type(8)));
typedef __bf16 bf16x4 __attribute__((ext_vector_type(4)));
typedef short s16x4 __attribute__((ext_vector_type(4)));
typedef float f32x4 __attribute__((ext_vector_type(4)));
typedef unsigned u32x4 __attribute__((ext_vector_type(4)));
#define LAS3 __attribute__((address_space(3)))
DI const float* uniform_ptr(const float* p) {
    const unsigned long long v = (unsigned long long)p;
    const unsigned lo = __builtin_amdgcn_readfirstlane((unsigned)v), hi = __builtin_amdgcn_readfirstlane((unsigned)(v >> 32));
    return (const float*)(((unsigned long long)hi << 32) | lo);
}
#define MFMA16(a, b, c) __builtin_amdgcn_mfma_f32_16x16x32_bf16((a), (b), (c), 0, 0, 0)
constexpr int GEMM_LDS_BYTES = 131072;
DI unsigned a_swz(unsigned x) { return (0x78u >> (2u * x)) & 3u; }
struct GemmRegs { u32x4 ra[2][2], rb[2][4]; };
template <bool DUAL, bool BK16, int OUTB, int LDB, int WN, class RowFn, class RowFnN, class Pre, class Fin>
DI void gemm_core(u32x4 (&Rra)[2][2], u32x4 (&Rrb)[2][4], unsigned (&aoffc)[2], bool preloaded, const bf16_t* Ab, const RowFn& rowoff, const float* B0, const float* B1, unsigned bbytes, int K, int rows,
                  bool has_next, const RowFnN& rowoff_n, const float* B0n, const float* B1n, unsigned bbytes_n, int rows_n, const Pre& pre, const Fin& fin, unsigned char* lds) {
    int tid_ = threadIdx.x; asm volatile("" : "+v"(tid_));
    const int tid = tid_, lane = tid & 63, w = __builtin_amdgcn_readfirstlane(tid >> 6), wm = w >> 2, wn = w & 3, l15 = lane & 15, kg = lane >> 4, t256 = tid & 255;
    const bool active = wn < WN;
    const int nrow_w = min(max(rows - 128 * wm, 0), 128), ngrp = (((nrow_w + 15) >> 4) + 1) >> 1;
    unsigned aoff[2];
#pragma unroll
    for (int i = 0; i < 2; ++i) aoff[i] = preloaded ? aoffc[i] : (rowoff(min(128 * wm + (t256 >> 2) + 64 * i, rows - 1)) + (t256 & 3) * 8) * 2u;
    const __amdgpu_buffer_rsrc_t ar = __builtin_amdgcn_make_buffer_rsrc((void*)Ab, 0, 0x7fffffff, 0x00020000);
    const unsigned awr = (128 * wm + (t256 >> 2)) * 128 + ((((unsigned)(t256 & 3)) ^ (unsigned)((t256 >> 3) & 7)) << 4);
    constexpr int NB = BK16 ? 2 : 4;
    const float* bsrc = uniform_ptr(DUAL && !BK16 ? ((wn >> 1) ? B1 : B0) : B0);
    const __amdgpu_buffer_rsrc_t br = __builtin_amdgcn_make_buffer_rsrc((void*)bsrc, 0, bbytes, 0x00020000);
    const unsigned bvoff = BK16 ? (unsigned)(((lane >> 5) * LDB + (lane & 31) * 8) * 2) : (DUAL ? (unsigned)(((lane >> 5) * LDB + (lane & 31) * 4) * 4) : (unsigned)(lane * 16));
    const int krow0 = BK16 ? 16 * wm + 2 * wn : (DUAL ? 16 * wm + 8 * (wn & 1) : 16 * wm + wn);
    constexpr int KSTEP = BK16 ? 8 : (DUAL ? 2 : 4), ESZ = BK16 ? 2 : 4;
    unsigned aoff_n[2];
#pragma unroll
    for (int i = 0; i < 2; ++i) aoff_n[i] = has_next ? (rowoff_n(min(128 * wm + (t256 >> 2) + 64 * i, rows_n - 1)) + (t256 & 3) * 8) * 2u : aoff[i];
    const float* bsrc_n = uniform_ptr(has_next ? (DUAL && !BK16 ? ((wn >> 1) ? B1n : B0n) : B0n) : bsrc);
    const __amdgpu_buffer_rsrc_t br_n = __builtin_amdgcn_make_buffer_rsrc((void*)bsrc_n, 0, has_next ? bbytes_n : bbytes, 0x00020000);
    unsigned bwr[NB];
#pragma unroll
    for (int i = 0; i < NB; ++i) {
        const int kb = krow0 + KSTEP * i + ((BK16 || DUAL) ? (lane >> 5) : 0);
        const int n = BK16 ? 8 * (lane & 31) : (DUAL ? (wn >> 1) * 128 + 4 * (lane & 31) : 4 * lane);
        const unsigned I = n >> 7, ch = (n & 127) >> 3, half = BK16 ? 0u : (unsigned)((n >> 2) & 1), xx = ((kb & 3) << 2) | ((kb >> 2) & 3);
        bwr[i] = 32768u + I * 16384u + 256u * kb + 16u * (ch ^ xx) + 8u * half;
    }
    const unsigned ard = (128 * wm + l15) * 128 + ((((unsigned)kg) ^ (unsigned)((l15 >> 1) & 7)) << 4);
    unsigned trd0, trd1;
    {
        const unsigned q = l15 >> 2, pp = l15 & 3, cbase = (DUAL ? 4u * wn : 8u * (wn & 1)) + (pp >> 1), ibase = DUAL ? 0u : (unsigned)(wn >> 1);
        const unsigned x0 = (q << 2) | ((2u * kg) & 3u), x1 = (q << 2) | ((2u * kg + 1u) & 3u);
        trd0 = 32768u + ibase * 16384u + 256u * (8u * kg + q) + 16u * (cbase ^ x0) + 8u * (pp & 1);
        trd1 = 32768u + ibase * 16384u + 256u * (8u * kg + 4u + q) + 16u * (cbase ^ x1) + 8u * (pp & 1);
    }
    f32x4 acc[8][4];
#pragma unroll
    for (int i = 0; i < 8; ++i)
#pragma unroll
        for (int f = 0; f < 4; ++f) acc[i][f] = (f32x4){0.f, 0.f, 0.f, 0.f};
    const int nj = K / 32;
#define LOAD_SET(S, j) { _Pragma("unroll") for (int i = 0; i < 2; ++i) Rra[S][i] = __builtin_bit_cast(u32x4, __builtin_amdgcn_raw_buffer_load_b128(ar, aoff[S], ((j) >> 1) * 128 + i * 64, 0)); \
        _Pragma("unroll") for (int i = 0; i < NB; ++i) Rrb[S][i] = __builtin_bit_cast(u32x4, __builtin_amdgcn_raw_buffer_load_b128(br, bvoff, ((j) * 32 + krow0 + KSTEP * i) * (LDB * ESZ), 0)); }
#define LOAD_SET_N(S, j) { _Pragma("unroll") for (int i = 0; i < 2; ++i) Rra[S][i] = __builtin_bit_cast(u32x4, __builtin_amdgcn_raw_buffer_load_b128(ar, aoff_n[S], ((j) >> 1) * 128 + i * 64, 0)); \
        _Pragma("unroll") for (int i = 0; i < NB; ++i) Rrb[S][i] = __builtin_bit_cast(u32x4, __builtin_amdgcn_raw_buffer_load_b128(br_n, bvoff, ((j) * 32 + krow0 + KSTEP * i) * (LDB * ESZ), 0)); }
#define WRITE_SET(S, st, h) { _Pragma("unroll") for (int i = 0; i < 2; ++i) *(u32x4*)(lds + (st) * 65536 + (awr ^ (i ? 64u : 0u)) + (S) * 8192) = Rra[S][i]; \
        _Pragma("unroll") for (int i = 0; i < NB; ++i) { if (BK16) *(u32x4*)(lds + (st) * 65536 + (h) * 8192 + bwr[i]) = Rrb[S][i]; else { \
            const f32x4 v = __builtin_bit_cast(f32x4, Rrb[S][i]); bf16x4 o; o[0] = (__bf16)v[0]; o[1] = (__bf16)v[1]; o[2] = (__bf16)v[2]; o[3] = (__bf16)v[3]; \
            *(bf16x4*)(lds + (st) * 65536 + (h) * 8192 + ((!DUAL) ? ((bwr[0] ^ (unsigned)(i << 4)) + 1024u * i) : bwr[i])) = o; } } }
#define LOAD_SEL(S, jl) { const bool nx_ = (jl) >= nj; const int jt_ = nx_ ? (jl) - nj : (jl); \
        _Pragma("unroll") for (int i = 0; i < 2; ++i) Rra[S][i] = __builtin_bit_cast(u32x4, __builtin_amdgcn_raw_buffer_load_b128(ar, nx_ ? aoff_n[S] : aoff[S], (jt_ >> 1) * 128 + i * 64, 0)); \
        if (nx_) { _Pragma("unroll") for (int i = 0; i < NB; ++i) Rrb[S][i] = __builtin_bit_cast(u32x4, __builtin_amdgcn_raw_buffer_load_b128(br_n, bvoff, (jt_ * 32 + krow0 + KSTEP * i) * (LDB * ESZ), 0)); } \
        else { _Pragma("unroll") for (int i = 0; i < NB; ++i) Rrb[S][i] = __builtin_bit_cast(u32x4, __builtin_amdgcn_raw_buffer_load_b128(br, bvoff, (jt_ * 32 + krow0 + KSTEP * i) * (LDB * ESZ), 0)); } }
#define WRITE_A(S, st, h) { _Pragma("unroll") for (int i = 0; i < 2; ++i) *(u32x4*)(lds + (st) * 65536 + (awr ^ (i ? 64u : 0u)) + (S) * 8192) = Rra[S][i]; }
#define WRITE_B(S, st, h, I0, I1) { _Pragma("unroll") for (int i = (I0); i < (I1); ++i) { if (BK16) *(u32x4*)(lds + (st) * 65536 + (h) * 8192 + bwr[i]) = Rrb[S][i]; else { \
            const f32x4 v = __builtin_bit_cast(f32x4, Rrb[S][i]); bf16x4 o; o[0] = (__bf16)v[0]; o[1] = (__bf16)v[1]; o[2] = (__bf16)v[2]; o[3] = (__bf16)v[3]; \
            *(bf16x4*)(lds + (st) * 65536 + (h) * 8192 + ((!DUAL) ? ((bwr[0] ^ (unsigned)(i << 4)) + 1024u * i) : bwr[i])) = o; } } }
#define LOAD_A(S, jl) { const bool nx_ = (jl) >= nj; const int jt_ = nx_ ? (jl) - nj : (jl); \
        _Pragma("unroll") for (int i = 0; i < 2; ++i) Rra[S][i] = __builtin_bit_cast(u32x4, __builtin_amdgcn_raw_buffer_load_b128(ar, nx_ ? aoff_n[S] : aoff[S], (jt_ >> 1) * 128 + i * 64, 0)); }
#define LOAD_B(S, jl) { const bool nx_ = (jl) >= nj; const int jt_ = nx_ ? (jl) - nj : (jl); \
        if (nx_) { _Pragma("unroll") for (int i = 0; i < NB; ++i) Rrb[S][i] = __builtin_bit_cast(u32x4, __builtin_amdgcn_raw_buffer_load_b128(br_n, bvoff, (jt_ * 32 + krow0 + KSTEP * i) * (LDB * ESZ), 0)); } \
        else { _Pragma("unroll") for (int i = 0; i < NB; ++i) Rrb[S][i] = __builtin_bit_cast(u32x4, __builtin_amdgcn_raw_buffer_load_b128(br, bvoff, (jt_ * 32 + krow0 + KSTEP * i) * (LDB * ESZ), 0)); } }
#define TF_LOAD(dst, st, h, g) { _Pragma("unroll") for (int q_ = 0; q_ < 2; ++q_) dst[q_] = *(const bf16x8*)(lds + (st) * 65536 + ((g) * 2 + q_) * 2048 + (ard ^ ((h) ? 64u : 0u))); }
#define WF_LOAD(st, h) { _Pragma("unroll") for (int f = 0; f < 4; ++f) { \
        const unsigned fx = DUAL ? ((f & 1) << 5) : (f << 5), fo = (DUAL ? (f >> 1) * 16384 : 0) + (st) * 65536 + (h) * 8192; \
        const s16x4 lo = __builtin_amdgcn_ds_read_tr16_b64_v4i16((LAS3 s16x4*)(lds + ((trd0 ^ fx) + fo))); \
        const s16x4 hi = __builtin_amdgcn_ds_read_tr16_b64_v4i16((LAS3 s16x4*)(lds + ((trd1 ^ fx) + fo))); \
        wf[f] = __builtin_bit_cast(bf16x8, __builtin_shufflevector(lo, hi, 0, 1, 2, 3, 4, 5, 6, 7)); } }
#define STAGE_MMA(srcf, g) { _Pragma("unroll") for (int q_ = 0; q_ < 2; ++q_) _Pragma("unroll") for (int f = 0; f < 4; ++f) acc[(g) * 2 + q_][f] = MFMA16(wf[f], srcf[q_], acc[(g) * 2 + q_][f]); }
#define STAGE(st, h, g, cur, nxt) if ((g) < ngrp) { \
        if ((g) + 1 < 4 && (g) + 1 < ngrp) TF_LOAD(nxt, st, h, (g) + 1) \
        __builtin_amdgcn_sched_barrier(0); \
        STAGE_MMA(cur, g) \
        __builtin_amdgcn_sched_barrier(0); }
    const bool comp = active && ngrp > 0;
    bf16x8 fa[2], fb[2], wf[4];
#define HALF_MMA(st, h) if (comp) { STAGE(st, h, 0, fa, fb) STAGE(st, h, 1, fb, fa) STAGE(st, h, 2, fa, fb) STAGE(st, h, 3, fb, fa) }
#define SLOT(st, h, g, cur, nxt, PIECE) { if (comp && (g) < ngrp) { if ((g) + 1 < 4 && (g) + 1 < ngrp) TF_LOAD(nxt, st, h, (g) + 1) } \
        PIECE \
        __builtin_amdgcn_sched_barrier(0); \
        if (comp && (g) < ngrp) { STAGE_MMA(cur, g) } \
        __builtin_amdgcn_sched_barrier(0); }
#define HALF_SLOTS(st, h, S, jl) { SLOT(st, h, 0, fa, fb, WRITE_A(S, (st) ^ 1, h) LOAD_A(S, jl)) SLOT(st, h, 1, fb, fa, WRITE_B(S, (st) ^ 1, h, 0, NB / 2)) \
        SLOT(st, h, 2, fa, fb, WRITE_B(S, (st) ^ 1, h, NB / 2, NB)) SLOT(st, h, 3, fb, fa, LOAD_B(S, jl)) }
#define PREFETCH(st, h) if (comp) { WF_LOAD(st, h) TF_LOAD(fa, st, h, 0) }
    const int nJ = K / 64;
    if (!preloaded) { LOAD_SET(0, 0) LOAD_SET(1, 1) }
    WRITE_SET(0, 0, 0) WRITE_SET(1, 0, 1)
    LOAD_SEL(0, 2) LOAD_SEL(1, 3)
    __syncthreads();
    int st = 0;
#pragma unroll 1
    for (int J = 0; J < nJ - 1; ++J) {
        PREFETCH(st, 0)
        HALF_SLOTS(st, 0, 0, 2 * J + 4)
        PREFETCH(st, 1)
        HALF_SLOTS(st, 1, 1, 2 * J + 5)
        __syncthreads();
        st ^= 1;
    }
    {
        PREFETCH(st, 0)
        HALF_MMA(st, 0)
        PREFETCH(st, 1)
        HALF_MMA(st, 1)
        __syncthreads();
    }
#undef HALF_MMA
#undef SLOT
#undef HALF_SLOTS
#undef WRITE_A
#undef WRITE_B
#undef LOAD_A
#undef LOAD_B
#undef PREFETCH
#undef LOAD_SET
#undef LOAD_SET_N
#undef LOAD_SEL
#undef WRITE_SET
#undef TF_LOAD
#undef WF_LOAD
#undef STAGE_MMA
#undef STAGE
    aoffc[0] = aoff_n[0]; aoffc[1] = aoff_n[1];
    {
        constexpr int NF = DUAL ? 2 : 4, ROWB = NF * 16 * OUTB, NCH = ROWB / 16, RPR = (8192 / ROWB) < 128 ? (8192 / ROWB) : 128, RPI = 64 / NCH, NROUND = 128 / RPR;
        constexpr float FP8_SCALE = 128.f;
        unsigned char* stg = lds + w * 8192;
        int l15e = l15; asm volatile("" : "+v"(l15e));
        const int colbase = (DUAL ? 32 : 64) * wn;
#pragma unroll
        for (int rd = 0; rd < NROUND; ++rd) {
            if (active) {
#pragma unroll
                for (int mt = rd * (RPR / 16); mt < (rd + 1) * (RPR / 16); ++mt) {
                    if ((mt >> 1) < ngrp) {
                        const int rloc = mt * 16 - rd * RPR + l15e, row = 128 * wm + mt * 16 + l15e;
#pragma unroll
                        for (int f = 0; f < NF; ++f) {
                            const f32x4 v = DUAL ? pre(row, colbase + 16 * f + 4 * kg, acc[mt][f], acc[mt][f + 2]) : pre(row, colbase + 16 * f + 4 * kg, acc[mt][f], acc[mt][f]);
                            if (OUTB == 4) *(f32x4*)(stg + rloc * ROWB + ((((unsigned)(4 * f + kg)) ^ (unsigned)(rloc & (NCH - 1))) << 4)) = v;
                            else if (OUTB == 2) { bf16x4 o; o[0] = (__bf16)v[0]; o[1] = (__bf16)v[1]; o[2] = (__bf16)v[2]; o[3] = (__bf16)v[3];
                                *(bf16x4*)(stg + rloc * ROWB + ((((unsigned)(2 * f + (kg >> 1))) ^ (unsigned)(rloc & (NCH - 1))) << 4) + 8 * (kg & 1)) = o; }
                            else { int pk = 0; pk = __builtin_amdgcn_cvt_pk_fp8_f32(v[0] * FP8_SCALE, v[1] * FP8_SCALE, pk, false); pk = __builtin_amdgcn_cvt_pk_fp8_f32(v[2] * FP8_SCALE, v[3] * FP8_SCALE, pk, true);
                                *(int*)(stg + rloc * ROWB + ((((unsigned)f) ^ (unsigned)(rloc & (NCH - 1))) << 4) + 4 * kg) = pk; }
                        }
                    }
                }
                asm volatile("s_waitcnt lgkmcnt(0)" ::: "memory");
#pragma unroll
                for (int it = 0; it < RPR / RPI; ++it) {
                    const int rloc = it * RPI + lane / NCH, c = lane % NCH, row = 128 * wm + rd * RPR + rloc;
                    const u32x4 dv = *(const u32x4*)(stg + rloc * ROWB + ((((unsigned)c) ^ (unsigned)(rloc & (NCH - 1))) << 4));
                    if (row < rows) fin(row, colbase + c * (16 / OUTB), dv);
                }
                asm volatile("s_waitcnt lgkmcnt(0)" ::: "memory");
            }
        }
    }
    __syncthreads();
}

template <bool DUAL, bool BK16, int OUTB, int LDB, int WN, class RowFn, class Pre, class Fin>
DI void gemm_mfma(const bf16_t* Ab, const RowFn& rowoff, const float* B0, const float* B1, unsigned bbytes, int K, int rows, const Pre& pre, const Fin& fin, unsigned char* lds) {
    u32x4 ra[2][2], rb[2][4]; unsigned ao[2] = {0u, 0u};
    gemm_core<DUAL, BK16, OUTB, LDB, WN>(ra, rb, ao, false, Ab, rowoff, B0, B1, bbytes, K, rows, false, rowoff, B0, B1, bbytes, rows, pre, fin, lds);
}
#define PRE_ID [](int, int, f32x4 v, f32x4) { return v; }

DI void phase_prep(const Params& p, int bid, int nblk, float* lds) {
    const int tid = threadIdx.x, lane = tid & 63, wave = tid >> 6;
    bf16_t* xb = (bf16_t*)(p.ws + OFF_XB); float* glow = (float*)(p.ws + OFF_GLOW);
    float tw = 0.f;
    {
        const int ti = (bid >> 3) * NT + tid;
        if (ti < 1536) { const int m = ti >> 9, j = ti & 511; const float* bp = m == 0 ? p.wg : (m == 1 ? p.wu : p.wd); tw = bp[(size_t)j * 131072]; }
    }
    f32x4* Wl = (f32x4*)lds;
    for (int idx = tid; idx < 4096; idx += NT) {
        const int k = idx >> 2, q = idx & 3, ln = (k >> 2) & 63, j = k >> 8, c = k & 3;
        Wl[((j * 4 + c) * 4 + q) * 64 + ln] = *(const f32x4*)(p.w_in + (size_t)k * DIN + GL_OFF + 4 * q);
    }
    __syncthreads();
    for (int row0 = (bid * 8 + wave) * 4; row0 < T; row0 += nblk * 32) {
        asm volatile("" ::: "memory");
        f32x4 xv[4][4];
#pragma unroll
        for (int r = 0; r < 4; ++r)
#pragma unroll
            for (int j = 0; j < 4; ++j) {
                xv[r][j] = ((const f32x4*)(p.x + (size_t)(row0 + r) * D))[lane + 64 * j];
                uint2 o; o.x = pk2(xv[r][j][0], xv[r][j][1]); o.y = pk2(xv[r][j][2], xv[r][j][3]);
                ((uint2*)(xb + (size_t)(row0 + r) * D))[lane + 64 * j] = o;
            }
        float acc[4][16];
#pragma unroll
        for (int r = 0; r < 4; ++r)
#pragma unroll
            for (int n = 0; n < 16; ++n) acc[r][n] = 0.f;
#pragma unroll
        for (int j = 0; j < 4; ++j)
#pragma unroll
            for (int c = 0; c < 4; ++c) {
                float wv[16];
#pragma unroll
                for (int q = 0; q < 4; ++q) { const f32x4 w4 = Wl[((j * 4 + c) * 4 + q) * 64 + lane]; wv[4 * q] = w4[0]; wv[4 * q + 1] = w4[1]; wv[4 * q + 2] = w4[2]; wv[4 * q + 3] = w4[3]; }
#pragma unroll
                for (int r = 0; r < 4; ++r) {
                    const float xs = xv[r][j][c];
#pragma unroll
                    for (int n = 0; n < 16; ++n) acc[r][n] += xs * wv[n];
                }
            }
#define RS_STEP(N, OFF) { const bool up = (lane & (OFF)) != 0; _Pragma("unroll") for (int i = 0; i < (N); ++i) { \
            const float a = acc[i / 16][i % 16], b = acc[(i + (N)) / 16][(i + (N)) % 16]; const float snd = up ? a : b, kp = up ? b : a; \
            acc[i / 16][i % 16] = kp + __shfl_xor(snd, (OFF)); } }
        RS_STEP(32, 32) RS_STEP(16, 16) RS_STEP(8, 8) RS_STEP(4, 4) RS_STEP(2, 2) RS_STEP(1, 1)
#undef RS_STEP
        glow[(size_t)row0 * 16 + lane] = acc[0][0];
    }
    {
        bf16_t* wbin = (bf16_t*)(p.ws + OFF_WB_IN); bf16_t* wbout = (bf16_t*)(p.ws + OFF_WB_OUT); bf16_t* wbrt = (bf16_t*)(p.ws + OFF_WB_RT);
        bf16_t* wbsgu = (bf16_t*)(p.ws + OFF_WB_SGU); bf16_t* wbsd = (bf16_t*)(p.ws + OFF_WB_SD);
        constexpr int N_IN = 1024 * 512, N_OUT = 1024 * 256, N_RT = 1024 * 64, N_SGU = 1024 * 128, N_SD = 256 * 256;
        for (int it = bid * NT + tid; it < N_IN + N_OUT + N_RT + N_SGU + N_SD; it += nblk * NT) {
            const float* s; bf16_t* d; int r = it;
            if (r < N_IN) { const int k = r >> 9, c = (r & 511) * 4; s = p.w_in + (size_t)k * DIN + c; d = wbin + (size_t)k * 2048 + c; }
            else if ((r -= N_IN) < N_OUT) { s = p.w_out + (size_t)r * 4; d = wbout + (size_t)r * 4; }
            else if ((r -= N_OUT) < N_RT) { s = p.router_w + (size_t)r * 4; d = wbrt + (size_t)r * 4; }
            else if ((r -= N_RT) < N_SGU) { const int k = r >> 7, c = (r & 127) * 4, nt = c >> 8, h = (c >> 7) & 1, cc = c & 127; s = (h ? p.su : p.sg) + (size_t)k * EDIM + nt * 128 + cc; d = wbsgu + (size_t)k * 512 + c; }
            else { r -= N_SGU; s = p.sd + (size_t)r * 4; d = wbsd + (size_t)r * 4; }
            const f32x4 v = *(const f32x4*)s; uint2 o; o.x = pk2(v[0], v[1]); o.y = pk2(v[2], v[3]); *(uint2*)d = o;
        }
    }
    asm volatile("" :: "v"(tw));
    __syncthreads();
}

DI void phase_proj(const Params& p, int bid, int nblk, float* lds) {
    const bf16_t* xb = (const bf16_t*)(p.ws + OFF_XB); bf16_t* proj = (bf16_t*)(p.ws + OFF_PROJ); const bf16_t* wbin = (const bf16_t*)(p.ws + OFF_WB_IN);
    u32x4 ra[2][2], rb[2][4]; unsigned ao[2] = {0u, 0u}; bool pre = false;
    const bool xl = (nblk == 256);
    for (int u = bid; u < 64 * 8; u += nblk) {
        const int un = u + nblk; const bool hn = un < 64 * 8;
        const int mt = xl ? 32 * (u >> 8) + 4 * (u & 7) + ((u & 255) >> 6) : u >> 3, nt = xl ? ((u & 255) >> 3) & 7 : u & 7;
        const int mtn = xl ? 32 * (un >> 8) + 4 * (un & 7) + ((un & 255) >> 6) : un >> 3, ntn = xl ? ((un & 255) >> 3) & 7 : un & 7;
        auto rowoff = [&](int r) { return (unsigned)((mt * 256 + r) * D); };
        auto rowoff_n = [&](int r) { return (unsigned)((mtn * 256 + r) * D); };
        auto fin = [&](int r, int c, u32x4 dv) { *(u32x4*)(proj + (size_t)(mt * 256 + r) * NPROJ + nt * 256 + c) = dv; };
        gemm_core<false, true, 2, NPROJ, 4>(ra, rb, ao, pre, xb, rowoff, (const float*)(wbin + nt * 256), nullptr, (unsigned)(((size_t)D * NPROJ - nt * 256) * 2), D, 256,
                                 hn, rowoff_n, (const float*)(wbin + ntn * 256), nullptr, (unsigned)(((size_t)D * NPROJ - ntn * 256) * 2), 256, PRE_ID, fin, (unsigned char*)lds);
        pre = hn;
    }
}

template <int W>
DI void poolmean_item(const bf16_t* proj, bf16_t* pm, int t0, int c2) {
    const int s0 = t0 & (SEQ - 1);
    float p0[48], p1[48]; unsigned raw[32];
    p0[0] = 0.f; p1[0] = 0.f;
#pragma unroll
    for (int i = 0; i < 47; ++i) {
        unsigned v = 0u;
        if (i >= 15 || s0 > 0) v = *(const unsigned*)(proj + (size_t)(t0 - 15 + i) * NPROJ + P_OFF + c2);
        if (i >= 15) raw[i - 15] = v;
        p0[i + 1] = p0[i] + __uint_as_float(v << 16); p1[i + 1] = p1[i] + __uint_as_float(v & 0xffff0000u);
    }
#pragma unroll
    for (int i = 0; i < 32; ++i) {
        const int s = s0 + i; const float inv = 1.f / (float)min(s + 1, W);
        const float m0 = (p0[i + 16] - p0[i + 16 - W]) * inv - __uint_as_float(raw[i] << 16);
        const float m1 = (p1[i + 16] - p1[i + 16 - W]) * inv - __uint_as_float(raw[i] & 0xffff0000u);
        *(unsigned*)(pm + (size_t)(t0 + i) * 512 + c2) = pk2(m0, m1);
    }
}
DI void phase_poolmean(const Params& p, int bid, int nblk, float* lds) {
    const bf16_t* proj = (const bf16_t*)(p.ws + OFF_PROJ); bf16_t* pm = (bf16_t*)(p.ws + OFF_PM);
    for (int item = bid * NT + threadIdx.x; item < 256 * (T / 32); item += nblk * NT) {
        const int pair = item & 255, t0 = (item >> 8) * 32, c2 = pair * 2, g = __builtin_amdgcn_readfirstlane(pair >> 6);
        if (g == 0) poolmean_item<2>(proj, pm, t0, c2);
        else if (g == 1) poolmean_item<4>(proj, pm, t0, c2);
        else if (g == 2) poolmean_item<8>(proj, pm, t0, c2);
        else poolmean_item<16>(proj, pm, t0, c2);
    }
}
DI void phase_pool(const Params& p, int bid, int nblk, float* lds) {
    const bf16_t* pm = (const bf16_t*)(p.ws + OFF_PM); bf16_t* mix = (bf16_t*)(p.ws + OFF_MIX);
    for (int u = bid; u < 64 * 4; u += nblk) {
        const int mt = u >> 2, g = u & 3;
        auto rowoff = [&](int r) { return (unsigned)((mt * 256 + r) * 512 + g * 128); };
        auto pre = [&](int r, int c, f32x4 v, f32x4) { const f32x4 sc = *(const f32x4*)(p.pool_scale + g * 128 + c); return v * sc; };
        auto fin = [&](int r, int c, u32x4 dv) { *(u32x4*)(mix + (size_t)(mt * 256 + r) * D + g * 128 + c) = dv; };
        gemm_mfma<false, false, 2, 128, 2>(pm, rowoff, p.pool_w + (size_t)g * 16384, nullptr, (unsigned)((4 - g) * 16384 * 4), 128, 256, pre, fin, (unsigned char*)lds);
    }
}

DI unsigned f1_off(unsigned row, unsigned chunk) { return row * 128u + ((chunk ^ ((row >> 1) & 7u)) << 4); }
DI unsigned f2_off(unsigned row, unsigned ch) { return 256u * row + 16u * (ch ^ (((row & 3u) << 2) | ((row >> 2) & 3u))); }
DI bf16x8 f1_frag(const unsigned char* img, int tile, int ks, int lane) { return *(const bf16x8*)(img + f1_off(16 * tile + (lane & 15), 4 * ks + (lane >> 4))); }
DI bf16x8 f2_frag(const unsigned char* img, int c, int ks, int lane) {
    const unsigned g = lane >> 4, q = (lane & 15) >> 2, pp = lane & 3;
    const unsigned a0 = f2_off(32 * ks + 8 * g + q, 2 * c + (pp >> 1)) + 8 * (pp & 1), a1 = f2_off(32 * ks + 8 * g + 4 + q, 2 * c + (pp >> 1)) + 8 * (pp & 1);
    const s16x4 lo = __builtin_amdgcn_ds_read_tr16_b64_v4i16((LAS3 s16x4*)(img + a0)), hi = __builtin_amdgcn_ds_read_tr16_b64_v4i16((LAS3 s16x4*)(img + a1));
    return __builtin_bit_cast(bf16x8, __builtin_shufflevector(lo, hi, 0, 1, 2, 3, 4, 5, 6, 7));
}
DI float bfbits2f(unsigned short v) { return __uint_as_float(((unsigned)v) << 16); }
typedef unsigned short u16x8 __attribute__((ext_vector_type(8)));
typedef unsigned short u16x4 __attribute__((ext_vector_type(4)));

DI void phase_gla1(const Params& p, int bid, int nblk, float* ldsf) {
    unsigned char* lds = (unsigned char*)ldsf;
    int tid_ = threadIdx.x; asm volatile("" : "+v"(tid_));
    const int tid = tid_, lane = tid & 63, w = __builtin_amdgcn_readfirstlane(tid >> 6), t = tid >> 3, ch = tid & 7;
    const bf16_t* proj = (const bf16_t*)(p.ws + OFF_PROJ); const float* glow = (const float*)(p.ws + OFF_GLOW);
    float* Gbuf = (float*)(p.ws + OFF_G); float* Sloc = (float*)(p.ws + OFF_SLOC); float* dec = (float*)(p.ws + OFF_DEC);
    float* G = (float*)lds; unsigned char* Kimg = lds + 16384; unsigned char* Vimg = lds + 32768; float* W2l = (float*)(lds + 49152); float* segtot = (float*)(lds + 53248);
    for (int unit = bid; unit < 1024; unit += nblk) {
        const int bh = unit >> 6, n = unit & 63, b = bh >> 2, h = bh & 3, t0 = b * SEQ + n * SC;
        for (int i = tid; i < 1024; i += NT) W2l[i] = p.gate_w2[(i >> 6) * 256 + h * 64 + (i & 63)];
#pragma unroll
        for (int i = 0; i < 2; ++i) { const int idx = tid + NT * i, tr = idx >> 4, c16 = idx & 15;
            *(u32x4*)(Vimg + f2_off(tr, c16)) = *(const u32x4*)(proj + (size_t)(t0 + tr) * NPROJ + V_OFF + h * 128 + 8 * c16); }
        __syncthreads();
        {
            float gl[16];
#pragma unroll
            for (int q = 0; q < 4; ++q) { const f32x4 v = *(const f32x4*)(glow + (size_t)(t0 + t) * 16 + 4 * q); gl[4 * q] = v[0]; gl[4 * q + 1] = v[1]; gl[4 * q + 2] = v[2]; gl[4 * q + 3] = v[3]; }
#pragma unroll
            for (int dd = 0; dd < 8; ++dd) { const int d = 8 * ch + dd; float z = p.gate_b[h * 64 + d];
#pragma unroll
                for (int r = 0; r < 16; ++r) z += gl[r] * W2l[r * 64 + d];
                G[t * 64 + d] = logsigmoidf_(z) * (1.f / 16.f); }
        }
        __syncthreads();
        {
            const int seg = tid >> 6, d = tid & 63; float run = 0.f;
#pragma unroll
            for (int tt = 0; tt < 8; ++tt) { run += G[(8 * seg + tt) * 64 + d]; G[(8 * seg + tt) * 64 + d] = run; }
            segtot[seg * 64 + d] = run;
            __syncthreads();
            float pre = 0.f;
            for (int s2 = 0; s2 < seg; ++s2) pre += segtot[s2 * 64 + d];
#pragma unroll
            for (int tt = 0; tt < 8; ++tt) G[(8 * seg + tt) * 64 + d] += pre;
        }
        __syncthreads();
        {
            const f32x4 g0 = *(const f32x4*)(G + t * 64 + 8 * ch), g1 = *(const f32x4*)(G + t * 64 + 8 * ch + 4);
            const f32x4 l0 = *(const f32x4*)(G + 63 * 64 + 8 * ch), l1 = *(const f32x4*)(G + 63 * 64 + 8 * ch + 4);
            *(f32x4*)(Gbuf + (size_t)(t0 + t) * 256 + h * 64 + 8 * ch) = g0; *(f32x4*)(Gbuf + (size_t)(t0 + t) * 256 + h * 64 + 8 * ch + 4) = g1;
            const u16x8 kv = *(const u16x8*)(proj + (size_t)(t0 + t) * NPROJ + K_OFF + h * 64 + 8 * ch);
            bf16x8 o;
#pragma unroll
            for (int dd = 0; dd < 4; ++dd) { o[dd] = (__bf16)(bfbits2f(kv[dd]) * __expf(l0[dd] - g0[dd])); o[dd + 4] = (__bf16)(bfbits2f(kv[dd + 4]) * __expf(l1[dd] - g1[dd])); }
            *(bf16x8*)(Kimg + f2_off(t, ch)) = o;
            if (t == 63) {
#pragma unroll
                for (int dd = 0; dd < 4; ++dd) { dec[unit * 64 + 8 * ch + dd] = __expf(l0[dd]); dec[unit * 64 + 8 * ch + 4 + dd] = __expf(l1[dd]); }
            }
        }
        __syncthreads();
        {
            f32x4 acc[4];
#pragma unroll
            for (int dt = 0; dt < 4; ++dt) acc[dt] = (f32x4){0.f, 0.f, 0.f, 0.f};
#pragma unroll
            for (int ks = 0; ks < 2; ++ks) {
                const bf16x8 xv = f2_frag(Vimg, w, ks, lane);
#pragma unroll
                for (int dt = 0; dt < 4; ++dt) acc[dt] = MFMA16(xv, f2_frag(Kimg, dt, ks, lane), acc[dt]);
            }
#pragma unroll
            for (int dt = 0; dt < 4; ++dt) *(f32x4*)(Sloc + (size_t)unit * 8192 + (16 * dt + (lane & 15)) * 128 + 16 * w + 4 * (lane >> 4)) = acc[dt];
        }
        __syncthreads();
    }
}

DI void phase_gla2(const Params& p, int bid, int nblk, float* lds) {
    const float* Sloc = (const float*)(p.ws + OFF_SLOC); const float* dec = (const float*)(p.ws + OFF_DEC); bf16_t* Sin = (bf16_t*)(p.ws + OFF_SIN);
    for (int gid = bid * NT + threadIdx.x; gid < 16 * 8192; gid += nblk * NT) {
        const int bh = gid >> 13, el = gid & 8191, d = el >> 7; float st = 0.f;
        for (int n0 = 0; n0 < NSC; n0 += 16) {
            float sl[16], dc[16]; bf16_t so[16];
#pragma unroll
            for (int i = 0; i < 16; ++i) { const int u = bh * 64 + n0 + i; sl[i] = Sloc[(size_t)u * 8192 + el]; dc[i] = dec[u * 64 + d]; }
#pragma unroll
            for (int i = 0; i < 16; ++i) { so[i] = f2bf(st); st = st * dc[i] + sl[i]; }
#pragma unroll
            for (int i = 0; i < 16; ++i) Sin[(size_t)(bh * 64 + n0 + i) * 8192 + el] = so[i];
        }
    }
}

DI void phase_gla3(const Params& p, int bid, int nblk, float* ldsf) {
    unsigned char* lds = (unsigned char*)ldsf;
    int tid_ = threadIdx.x; asm volatile("" : "+v"(tid_));
    const int tid = tid_, lane = tid & 63, w = __builtin_amdgcn_readfirstlane(tid >> 6), t = tid >> 3, ch = tid & 7, l15 = lane & 15, kg = lane >> 4;
    const bf16_t* proj = (const bf16_t*)(p.ws + OFF_PROJ); const float* Gbuf = (const float*)(p.ws + OFF_G); const bf16_t* Sin = (const bf16_t*)(p.ws + OFF_SIN);
    bf16_t* mix = (bf16_t*)(p.ws + OFF_MIX);
    unsigned char* Qimg = lds; unsigned char* Kimg = lds + 8192; unsigned char* Pimg = lds + 16384; unsigned char* Vimg = lds + 24576; unsigned char* Simg = lds + 40960;
    float* part = (float*)(lds + 57344);
    for (int unit = bid; unit < 1024; unit += nblk) {
        const int bh = unit >> 6, n = unit & 63, b = bh >> 2, h = bh & 3, t0 = b * SEQ + n * SC;
        {
            const f32x4 g0 = *(const f32x4*)(Gbuf + (size_t)(t0 + t) * 256 + h * 64 + 8 * ch), g1 = *(const f32x4*)(Gbuf + (size_t)(t0 + t) * 256 + h * 64 + 8 * ch + 4);
            const u16x8 qv = *(const u16x8*)(proj + (size_t)(t0 + t) * NPROJ + Q_OFF + h * 64 + 8 * ch), kv = *(const u16x8*)(proj + (size_t)(t0 + t) * NPROJ + K_OFF + h * 64 + 8 * ch);
            bf16x8 qo, ko;
#pragma unroll
            for (int dd = 0; dd < 4; ++dd) {
                qo[dd] = (__bf16)(bfbits2f(qv[dd]) * 0.125f * __expf(g0[dd])); qo[dd + 4] = (__bf16)(bfbits2f(qv[dd + 4]) * 0.125f * __expf(g1[dd]));
                ko[dd] = (__bf16)(bfbits2f(kv[dd]) * __expf(-g0[dd])); ko[dd + 4] = (__bf16)(bfbits2f(kv[dd + 4]) * __expf(-g1[dd]));
            }
            *(bf16x8*)(Qimg + f1_off(t, ch)) = qo; *(bf16x8*)(Kimg + f1_off(t, ch)) = ko;
        }
#pragma unroll
        for (int i = 0; i < 2; ++i) { const int idx = tid + NT * i, tr = idx >> 4, c16 = idx & 15;
            *(u32x4*)(Vimg + f2_off(tr, c16)) = *(const u32x4*)(proj + (size_t)(t0 + tr) * NPROJ + V_OFF + h * 128 + 8 * c16);
            *(u32x4*)(Simg + f2_off(tr, c16)) = *(const u32x4*)(Sin + (size_t)unit * 8192 + tr * 128 + 8 * c16); }
        __syncthreads();
        {
            const int it = w >> 1;
#pragma unroll
            for (int jj = 0; jj < 2; ++jj) {
                const int jt = 2 * (w & 1) + jj; f32x4 acc = {0.f, 0.f, 0.f, 0.f};
                if (jt <= it) {
#pragma unroll
                    for (int ks = 0; ks < 2; ++ks) acc = MFMA16(f1_frag(Kimg, jt, ks, lane), f1_frag(Qimg, it, ks, lane), acc);
                    if (jt == it) {
#pragma unroll
                        for (int r = 0; r < 4; ++r) if (4 * kg + r > l15) acc[r] = 0.f;
                    }
                }
                bf16x4 o; o[0] = (__bf16)acc[0]; o[1] = (__bf16)acc[1]; o[2] = (__bf16)acc[2]; o[3] = (__bf16)acc[3];
                *(bf16x4*)(Pimg + f1_off(16 * it + l15, 2 * jt + (kg >> 1)) + 8 * (kg & 1)) = o;
            }
        }
        __syncthreads();
        {
            f32x4 acc[4];
#pragma unroll
            for (int it = 0; it < 4; ++it) acc[it] = (f32x4){0.f, 0.f, 0.f, 0.f};
#pragma unroll
            for (int ks = 0; ks < 2; ++ks) {
                const bf16x8 xv = f2_frag(Vimg, w, ks, lane), xs = f2_frag(Simg, w, ks, lane);
#pragma unroll
                for (int it = 0; it < 4; ++it) {
                    if (2 * ks <= it) acc[it] = MFMA16(xv, f1_frag(Pimg, it, ks, lane), acc[it]);
                    acc[it] = MFMA16(xs, f1_frag(Qimg, it, ks, lane), acc[it]);
                }
            }
#pragma unroll
            for (int it = 0; it < 4; ++it) {
                float ss = acc[it][0] * acc[it][0] + acc[it][1] * acc[it][1] + acc[it][2] * acc[it][2] + acc[it][3] * acc[it][3];
                ss += __shfl_xor(ss, 16); ss += __shfl_xor(ss, 32);
                if (kg == 0) part[w * 64 + 16 * it + l15] = ss;
            }
            __syncthreads();
            const int e0 = 16 * w + 4 * kg; const f32x4 nw = *(const f32x4*)(p.norm_w + e0);
#pragma unroll
            for (int it = 0; it < 4; ++it) {
                const int i = 16 * it + l15; float tot = 0.f;
#pragma unroll
                for (int w2 = 0; w2 < 8; ++w2) tot += part[w2 * 64 + i];
                const float inv = rsqrtf(tot * (1.f / 128.f) + RMS_EPS);
                const u16x4 rv = *(const u16x4*)(proj + (size_t)(t0 + i) * NPROJ + R_OFF + h * 128 + e0);
                bf16x4 o;
#pragma unroll
                for (int r = 0; r < 4; ++r) { const float rr = bfbits2f(rv[r]); o[r] = (__bf16)(acc[it][r] * inv * nw[r] * (rr * sigmoidf_(rr))); }
                *(bf16x4*)(mix + (size_t)(t0 + i) * D + 512 + h * 128 + e0) = o;
            }
        }
        __syncthreads();
    }
}

DI void phase_out(const Params& p, int bid, int nblk, float* lds) {
    const bf16_t* mix = (const bf16_t*)(p.ws + OFF_MIX); const bf16_t* xb = (const bf16_t*)(p.ws + OFF_XB); bf16_t* yb = (bf16_t*)(p.ws + OFF_H32);
    for (int u = bid; u < 64 * 4; u += nblk) {
        const int mt = (nblk == 256) ? 8 * (u & 7) + (u >> 5) : u >> 2, nt = (nblk == 256) ? (u >> 3) & 3 : u & 3;
        auto rowoff = [&](int r) { return (unsigned)((mt * 256 + r) * D); };
        auto fin = [&](int r, int c, u32x4 dv) {
            const size_t o = (size_t)(mt * 256 + r) * D + nt * 256 + c; const u32x4 xr = *(const u32x4*)(xb + o);
            const f32x4 x0 = {bf2f((bf16_t)(xr[0] & 0xffffu)), bf2f((bf16_t)(xr[0] >> 16)), bf2f((bf16_t)(xr[1] & 0xffffu)), bf2f((bf16_t)(xr[1] >> 16))};
            const f32x4 x1 = {bf2f((bf16_t)(xr[2] & 0xffffu)), bf2f((bf16_t)(xr[2] >> 16)), bf2f((bf16_t)(xr[3] & 0xffffu)), bf2f((bf16_t)(xr[3] >> 16))};
            u32x4 ov;
            ov[0] = pk2(bf2f((bf16_t)(dv[0] & 0xffffu)) + ALPHA * x0[0], bf2f((bf16_t)(dv[0] >> 16)) + ALPHA * x0[1]);
            ov[1] = pk2(bf2f((bf16_t)(dv[1] & 0xffffu)) + ALPHA * x0[2], bf2f((bf16_t)(dv[1] >> 16)) + ALPHA * x0[3]);
            ov[2] = pk2(bf2f((bf16_t)(dv[2] & 0xffffu)) + ALPHA * x1[0], bf2f((bf16_t)(dv[2] >> 16)) + ALPHA * x1[1]);
            ov[3] = pk2(bf2f((bf16_t)(dv[3] & 0xffffu)) + ALPHA * x1[2], bf2f((bf16_t)(dv[3] >> 16)) + ALPHA * x1[3]);
            *(u32x4*)(yb + o) = ov; };
        gemm_mfma<false, true, 2, D, 4>(mix, rowoff, (const float*)((const bf16_t*)(p.ws + OFF_WB_OUT) + nt * 256), nullptr, (unsigned)(((size_t)D * D - nt * 256) * 2), D, 256, PRE_ID, fin, (unsigned char*)lds);
    }
}

DI void ln_row(float (&v)[16], const float* g, const float* b, int lane) {
    float s = 0.f;
#pragma unroll
    for (int i = 0; i < 16; ++i) s += v[i];
    const float mean = wave_sum(s) * (1.f / D); float q = 0.f;
#pragma unroll
    for (int i = 0; i < 16; ++i) { v[i] -= mean; q += v[i] * v[i]; }
    const float rstd = rsqrtf(wave_sum(q) * (1.f / D) + LN_EPS);
#pragma unroll
    for (int j = 0; j < 4; ++j) {
        const float4 gg = ((const float4*)g)[lane + 64 * j], bb = ((const float4*)b)[lane + 64 * j];
        v[4 * j] = v[4 * j] * rstd * gg.x + bb.x; v[4 * j + 1] = v[4 * j + 1] * rstd * gg.y + bb.y;
        v[4 * j + 2] = v[4 * j + 2] * rstd * gg.z + bb.z; v[4 * j + 3] = v[4 * j + 3] * rstd * gg.w + bb.w;
    }
}

DI void ln1_rows(const Params& p, int r0, int nrows) {
    int tid_ = threadIdx.x; asm volatile("" : "+v"(tid_));
    const int lane = tid_ & 63, wave = tid_ >> 6;
    const bf16_t* yb = (const bf16_t*)(p.ws + OFF_H32); bf16_t* hb = (bf16_t*)(p.ws + OFF_HB);
    for (int rb = r0 + wave; rb < r0 + nrows; rb += 32) {
        float v[4][16];
#pragma unroll
        for (int q = 0; q < 4; ++q) {
            const u32x4* hr = (const u32x4*)(yb + (size_t)(rb + 8 * q) * D);
#pragma unroll
            for (int j = 0; j < 2; ++j) { const u32x4 a = hr[lane + 64 * j];
                _Pragma("unroll") for (int k = 0; k < 4; ++k) { v[q][8 * j + 2 * k] = bf2f((bf16_t)(a[k] & 0xffffu)); v[q][8 * j + 2 * k + 1] = bf2f((bf16_t)(a[k] >> 16)); } }
        }
        float s[4], qq[4];
#pragma unroll
        for (int q = 0; q < 4; ++q) { s[q] = 0.f; _Pragma("unroll") for (int i = 0; i < 16; ++i) s[q] += v[q][i]; }
#pragma unroll
        for (int o = 1; o < 64; o <<= 1) { _Pragma("unroll") for (int q = 0; q < 4; ++q) s[q] += __shfl_xor(s[q], o); }
#pragma unroll
        for (int q = 0; q < 4; ++q) { const float mean = s[q] * (1.f / D); qq[q] = 0.f; _Pragma("unroll") for (int i = 0; i < 16; ++i) { v[q][i] -= mean; qq[q] += v[q][i] * v[q][i]; } }
#pragma unroll
        for (int o = 1; o < 64; o <<= 1) { _Pragma("unroll") for (int q = 0; q < 4; ++q) qq[q] += __shfl_xor(qq[q], o); }
#pragma unroll
        for (int j = 0; j < 2; ++j) {
            const float4 g0 = ((const float4*)p.ln1_g)[2 * (lane + 64 * j)], g1 = ((const float4*)p.ln1_g)[2 * (lane + 64 * j) + 1];
            const float4 b0 = ((const float4*)p.ln1_b)[2 * (lane + 64 * j)], b1 = ((const float4*)p.ln1_b)[2 * (lane + 64 * j) + 1];
#pragma unroll
            for (int q = 0; q < 4; ++q) {
                const float rstd = rsqrtf(qq[q] * (1.f / D) + LN_EPS); const float* w = &v[q][8 * j];
                u32x4 o;
                o[0] = pk2(w[0] * rstd * g0.x + b0.x, w[1] * rstd * g0.y + b0.y); o[1] = pk2(w[2] * rstd * g0.z + b0.z, w[3] * rstd * g0.w + b0.w);
                o[2] = pk2(w[4] * rstd * g1.x + b1.x, w[5] * rstd * g1.y + b1.y); o[3] = pk2(w[6] * rstd * g1.z + b1.z, w[7] * rstd * g1.w + b1.w);
                ((u32x4*)(hb + (size_t)(rb + 8 * q) * D))[lane + 64 * j] = o;
            }
        }
    }
}

DI void topk_rows(const Params& p, const float* sc_lds, int r0, int nrows) {
    int tid_ = threadIdx.x; asm volatile("" : "+v"(tid_));
    const int lane = tid_ & 63, wave = tid_ >> 6;
    float* wbuf = (float*)(p.ws + OFF_WBUF);
    int* list = (int*)(p.ws + OFF_LIST); unsigned* cnt = (unsigned*)(p.ws + OFF_CTL) + CW_CNT;
    const float NEG = -__builtin_inff();
    for (int t = r0 + wave; t < r0 + nrows; t += 8) {
        const float4 sv = ((const float4*)(sc_lds + (size_t)(t - r0) * NE))[lane], bv = ((const float4*)p.router_bias)[lane];
        const float s[4] = {sv.x, sv.y, sv.z, sv.w};
        float cand[4] = {sv.x + bv.x, sv.y + bv.y, sv.z + bv.z, sv.w + bv.w};
        float m1 = NEG, m2 = NEG;
#pragma unroll
        for (int j = 0; j < 4; ++j) { const float v = cand[j]; if (v > m1) { m2 = m1; m1 = v; } else if (v > m2) m2 = v; }
#pragma unroll
        for (int off = 1; off < 8; off <<= 1) {
            const float o1 = __shfl_xor(m1, off), o2 = __shfl_xor(m2, off);
            const float n1 = fmaxf(m1, o1), n2 = fmaxf(fminf(m1, o1), fmaxf(m2, o2)); m1 = n1; m2 = n2;
        }
        const float gs = m1 + m2; const int mygrp = lane >> 3; int rank = 0;
#pragma unroll
        for (int g2 = 0; g2 < 8; ++g2) { const float og = __shfl(gs, g2 * 8); if (og > gs || (og == gs && g2 < mygrp)) ++rank; }
        if (rank >= 4) { cand[0] = NEG; cand[1] = NEG; cand[2] = NEG; cand[3] = NEG; }
        int my_e = 0; float my_w = 0.f, wsum = 0.f;
#pragma unroll
        for (int k = 0; k < TOPK; ++k) {
            float bvv = cand[0]; int bj = 0;
#pragma unroll
            for (int j = 1; j < 4; ++j) if (cand[j] > bvv) { bvv = cand[j]; bj = j; }
            int bi = 4 * lane + bj;
#pragma unroll
            for (int off = 32; off >= 1; off >>= 1) {
                const float ov = __shfl_xor(bvv, off); const int oi = __shfl_xor(bi, off);
                if (ov > bvv || (ov == bvv && oi < bi)) { bvv = ov; bi = oi; }
            }
            const int wj = bi & 3, wl = bi >> 2;
            const float mys = wj == 0 ? s[0] : (wj == 1 ? s[1] : (wj == 2 ? s[2] : s[3]));
            const float wk = __shfl(mys, wl);
            wsum += wk;
            if (lane == k) { my_e = bi; my_w = wk; }
            if (lane == wl) {
#pragma unroll
                for (int j = 0; j < 4; ++j) if (j == wj) cand[j] = NEG;
            }
        }
        if (lane < TOPK) {
            const unsigned pos = atomicAdd(&cnt[my_e], 1u);
            list[(size_t)my_e * LCAP + pos] = t * TOPK + lane;
            wbuf[(size_t)t * TOPK + lane] = my_w / wsum * 2.5f;
        }
    }
}

DI void phase_route(const Params& p, int bid, int nblk, float* lds) {
    const bf16_t* hb = (const bf16_t*)(p.ws + OFF_HB); float* scores = (float*)(p.ws + OFF_SCORES);
    for (int mt = bid; mt < T / 64; mt += nblk) {
        ln1_rows(p, mt * 64, 64);
        __syncthreads();
        auto rowoff = [&](int r) { return (unsigned)((mt * 64 + r) * D); };
        auto pre = [&](int r, int c, f32x4 v, f32x4) { return (f32x4){sigmoidf_(v[0]), sigmoidf_(v[1]), sigmoidf_(v[2]), sigmoidf_(v[3])}; };
        auto fin = [&](int r, int c, u32x4 dv) { *(u32x4*)((unsigned char*)lds + 65536 + (r * NE + c) * 4) = dv; };
        gemm_mfma<false, true, 4, NE, 4>(hb, rowoff, (const float*)(p.ws + OFF_WB_RT), nullptr, (unsigned)(D * NE * 2), D, 64, pre, fin, (unsigned char*)lds);
        __syncthreads();
        topk_rows(p, (const float*)((unsigned char*)lds + 65536), mt * 64, 64);
        __syncthreads();
    }
}

constexpr int EXP_TAB_OFF = GEMM_LDS_BYTES;
DI void build_tables(const Params& p, int* toff, int* roff) {
    const unsigned* cnt = (const unsigned*)(p.ws + OFF_CTL) + CW_CNT;
    int* cl = roff + 260;
    if (threadIdx.x < NE) cl[threadIdx.x] = (int)__hip_atomic_load(cnt + threadIdx.x, __ATOMIC_RELAXED, __HIP_MEMORY_SCOPE_AGENT);
    __syncthreads();
    if (threadIdx.x <= NE) {
        int ta = 0, ra = 0;
        for (int e = 0; e < (int)threadIdx.x; ++e) { const int c = cl[e]; ta += (c + 255) >> 8; ra += c; }
        toff[threadIdx.x] = ta; roff[threadIdx.x] = ra;
    }
    __syncthreads();
    if (threadIdx.x < NE) { unsigned char* texp = (unsigned char*)(roff + 1040); for (int t = toff[threadIdx.x]; t < toff[threadIdx.x + 1]; ++t) texp[t] = (unsigned char)threadIdx.x; }
    __syncthreads();
}
DI int find_expert(const int* toff, int tile) { int lo = 0, hi = NE - 1; while (lo < hi) { const int mid = (lo + hi + 1) >> 1; if (toff[mid] <= tile) lo = mid; else hi = mid - 1; } return lo; }
struct ExpUnit { int e, row0, rows, rowbase; };
DI ExpUnit exp_unit(const int* toff, const int* roff, int e, int tile, int ntile) {
    const int* cl = roff + 260;
    ExpUnit u;
    if (tile < ntile) {
        u.e = e; const int ui = tile - toff[e], c = cl[e];
        u.row0 = ui * 256; u.rows = min(256, c - u.row0); u.rowbase = roff[e] + u.row0;
    } else { u.e = NE; u.row0 = (tile - ntile) * 256; u.rows = 256; u.rowbase = A_TOT + u.row0; }
    u.e = __builtin_amdgcn_readfirstlane(u.e); u.row0 = __builtin_amdgcn_readfirstlane(u.row0); u.rows = __builtin_amdgcn_readfirstlane(u.rows);
    u.rowbase = __builtin_amdgcn_readfirstlane(u.rowbase);
    return u;
}

template <int NTL>
DI int exp_decode(const int* toff, int ntile, int u, int& tile, int& nt) {
    if (u < NTL * ntile) {
        const unsigned char* texp = (const unsigned char*)(toff + 260 + 1040);
        const int e = texp[u / NTL], t0 = toff[e], ne = toff[e + 1] - t0; int u2 = u - NTL * t0; nt = 0;
#pragma unroll
        for (int i = 1; i < NTL; ++i) if (u2 >= ne) { u2 -= ne; ++nt; }
        tile = t0 + u2; return e;
    }
    else { const int us = u - NTL * ntile; nt = us / (T / 256); tile = ntile + (us - nt * (T / 256)); return NE; }
}

DI void phase_e1(const Params& p, int bid, int nblk, float* lds) {
    int* toff = (int*)((unsigned char*)lds + EXP_TAB_OFF); int* roff = toff + 260;
    const bf16_t* hb = (const bf16_t*)(p.ws + OFF_HB); bf16_t* hid = (bf16_t*)(p.ws + OFF_HID); const int* list = (const int*)(p.ws + OFF_LIST);
    build_tables(p, toff, roff);
    const int ntile = toff[NE], units = (ntile + T / 256) * 2;
    const int vb = (nblk & 7) ? bid : (bid & 7) * (nblk >> 3) + (bid >> 3);
    u32x4 ra[2][2], rb[2][4]; unsigned ao[2] = {0u, 0u}; bool pre = false;
    int tile_n = 0, nt_n = 0; ExpUnit xn;
    if (vb < units) { const int e_ = exp_decode<2>(toff, ntile, vb, tile_n, nt_n); xn = exp_unit(toff, roff, e_, tile_n, ntile); }
    for (int u = vb; u < units; u += nblk) {
        const int nt = nt_n; const ExpUnit x = xn; const bool hn = u + nblk < units;
        if (hn) { const int e_ = exp_decode<2>(toff, ntile, u + nblk, tile_n, nt_n); xn = exp_unit(toff, roff, e_, tile_n, ntile); }
        const float* wg = x.e < NE ? p.wg + (size_t)x.e * 262144 : p.sg; const float* wu = x.e < NE ? p.wu + (size_t)x.e * 262144 : p.su;
        const float* wgn = xn.e < NE ? p.wg + (size_t)xn.e * 262144 : p.sg; const float* wun = xn.e < NE ? p.wu + (size_t)xn.e * 262144 : p.su;
        auto rowoff = [&](int r) { const int tok = x.e < NE ? (list[(size_t)x.e * LCAP + x.row0 + r] >> 3) : (x.row0 + r); return (unsigned)(tok * D); };
        auto rowoff_n = [&](int r) { const int tok = xn.e < NE ? (list[(size_t)xn.e * LCAP + xn.row0 + r] >> 3) : (xn.row0 + r); return (unsigned)(tok * D); };
        auto prf = [&](int r, int c, f32x4 g, f32x4 uu) { return (f32x4){g[0] * sigmoidf_(g[0]) * uu[0], g[1] * sigmoidf_(g[1]) * uu[1], g[2] * sigmoidf_(g[2]) * uu[2], g[3] * sigmoidf_(g[3]) * uu[3]}; };
        auto fin = [&](int r, int c, u32x4 dv) { *(u32x4*)(hid + (size_t)(x.rowbase + r) * EDIM + nt * 128 + c) = dv; };
        gemm_core<true, false, 2, EDIM, 4>(ra, rb, ao, pre, hb, rowoff, wg + nt * 128, wu + nt * 128, (unsigned)((D * EDIM - nt * 128) * 4), D, x.rows,
                                 hn, rowoff_n, wgn + nt_n * 128, wun + nt_n * 128, (unsigned)((D * EDIM - nt_n * 128) * 4), xn.rows, prf, fin, (unsigned char*)lds);
        pre = hn;
    }
}

DI void phase_e2(const Params& p, int bid, int nblk, float* lds) {
    int* toff = (int*)((unsigned char*)lds + EXP_TAB_OFF); int* roff = toff + 260; int* rowa = roff + 520;
    const bf16_t* hid = (const bf16_t*)(p.ws + OFF_HID); unsigned char* Y = p.ws + OFF_Y; const int* list = (const int*)(p.ws + OFF_LIST);
    build_tables(p, toff, roff);
    const int ntile = toff[NE], units = (ntile + T / 256) * 4;
    const int vb = (nblk & 7) ? bid : (bid & 7) * (nblk >> 3) + (bid >> 3);
    u32x4 ra[2][2], rb[2][4]; unsigned ao[2] = {0u, 0u}; bool pre = false;
    int tile_n = 0, nt_n = 0; ExpUnit xn;
    auto rowa_val = [&](const ExpUnit& q, int r) { return q.e < NE ? (r < q.rows ? list[(size_t)q.e * LCAP + q.row0 + r] : 0) : (A_TOT + q.row0 + r); };
    if (vb < units) { const int e_ = exp_decode<4>(toff, ntile, vb, tile_n, nt_n); xn = exp_unit(toff, roff, e_, tile_n, ntile); if (threadIdx.x < 256) rowa[threadIdx.x] = rowa_val(xn, threadIdx.x); }
    __syncthreads();
    int cur = 0;
    for (int u = vb; u < units; u += nblk) {
        const int nt = nt_n; const ExpUnit x = xn; const bool hn = u + nblk < units;
        if (hn) { const int e_ = exp_decode<4>(toff, ntile, u + nblk, tile_n, nt_n); xn = exp_unit(toff, roff, e_, tile_n, ntile); }
        const float* wd = x.e < NE ? p.wd + (size_t)x.e * 262144 : p.sd; const float* wdn = xn.e < NE ? p.wd + (size_t)xn.e * 262144 : p.sd;
        int rnext = 0;
        if (hn && threadIdx.x < 256) rnext = rowa_val(xn, threadIdx.x);
        const int* rowa_c = rowa + cur * 256;
        auto rowoff = [&](int r) { return (unsigned)((x.rowbase + r) * EDIM); };
        auto rowoff_n = [&](int r) { return (unsigned)((xn.rowbase + r) * EDIM); };
        auto fin = [&](int r, int c, u32x4 dv) { *(u32x4*)(Y + (size_t)rowa_c[r] * D + nt * 256 + c) = dv; };
        gemm_core<false, false, 1, D, 4>(ra, rb, ao, pre, hid, rowoff, wd + nt * 256, nullptr, (unsigned)((EDIM * D - nt * 256) * 4), EDIM, x.rows,
                               hn, rowoff_n, wdn + nt_n * 256, nullptr, (unsigned)((EDIM * D - nt_n * 256) * 4), xn.rows, PRE_ID, fin, (unsigned char*)lds);
        pre = hn;
        cur ^= 1;
        if (threadIdx.x < 256) rowa[cur * 256 + threadIdx.x] = rnext;
    }
}

DI void phase_combine(const Params& p, int bid, int nblk, float* lds) {
    const int lane = threadIdx.x & 63, wave = threadIdx.x >> 6;
    const bf16_t* hb = (const bf16_t*)(p.ws + OFF_HB); const unsigned char* Y = p.ws + OFF_Y; const float* wbuf = (const float*)(p.ws + OFF_WBUF);
    typedef float f32x2 __attribute__((ext_vector_type(2)));
    for (int t = bid * 8 + wave; t < T; t += nblk * 8) {
        float v[16];
#pragma unroll
        for (int j = 0; j < 4; ++j) { const uint2 a = ((const uint2*)(hb + (size_t)t * D))[lane + 64 * j];
            v[4 * j] = ALPHA * __uint_as_float(a.x << 16); v[4 * j + 1] = ALPHA * __uint_as_float(a.x & 0xffff0000u);
            v[4 * j + 2] = ALPHA * __uint_as_float(a.y << 16); v[4 * j + 3] = ALPHA * __uint_as_float(a.y & 0xffff0000u); }
#pragma unroll
        for (int k = 0; k < 9; ++k) {
            const size_t row = k < 8 ? (size_t)t * TOPK + k : (size_t)A_TOT + t; const float w = (k < 8 ? wbuf[(size_t)t * TOPK + k] : 1.f) * (1.f / 128.f);
#pragma unroll
            for (int j = 0; j < 4; ++j) {
                const int y = ((const int*)(Y + row * D))[lane + 64 * j];
                const f32x2 lo = __builtin_amdgcn_cvt_pk_f32_fp8(y, false), hi = __builtin_amdgcn_cvt_pk_f32_fp8(y, true);
                v[4 * j] += w * lo[0]; v[4 * j + 1] += w * lo[1]; v[4 * j + 2] += w * hi[0]; v[4 * j + 3] += w * hi[1];
            }
        }
        ln_row(v, p.ln2_g, p.ln2_b, lane);
#pragma unroll
        for (int j = 0; j < 4; ++j) ((float4*)(p.out + (size_t)t * D))[lane + 64 * j] = make_float4(v[4 * j], v[4 * j + 1], v[4 * j + 2], v[4 * j + 3]);
    }
}

#define LAS __attribute__((address_space(3)))
#define XB_TMO      128
#define XB_XCNT(j)  (256  + 64 * (j))
#define XB_XSUB(j)  (1280 + 64 * (j))
#define XB_XGEN(j)  (2304 + 64 * (j))
#define XB_TOP      3328
#define XB_TOPGEN   3392
#define XCD_BAR_WORDS 3456
#define XB_SPIN_CAP (1u << 22)
constexpr int CW_BAR = 4096;
DI unsigned xb_ld(unsigned* p) { return __hip_atomic_load(p, __ATOMIC_RELAXED, __HIP_MEMORY_SCOPE_AGENT); }
DI unsigned xb_add(unsigned* p, unsigned v) { return __hip_atomic_fetch_add(p, v, __ATOMIC_RELAXED, __HIP_MEMORY_SCOPE_AGENT); }
DI unsigned xb_xcc_id() { return (unsigned)__builtin_amdgcn_s_getreg((3 << 11) | 20) & 0xFu; }
#define XB_SPIN(cond, bar) do { unsigned _sp = 0; while (cond) { __builtin_amdgcn_s_sleep(1); \
    if ((++_sp & 255u) == 0u) { if (xb_ld(&(bar)[XB_TMO])) break; if (_sp > XB_SPIN_CAP) { atomicAdd(&(bar)[XB_TMO], 1u); break; } } } } while (0)
struct XcdBarrier { unsigned* bar; unsigned x; volatile LAS unsigned* st; };
DI XcdBarrier xcd_barrier_post(unsigned* bar, volatile LAS unsigned* st) {
    XcdBarrier b; b.bar = bar; b.x = xb_xcc_id(); b.st = st;
    if (threadIdx.x == 0) (void)xb_add(&bar[XB_XCNT(b.x)], 1u);
    return b;
}
DI void xcd_barrier_complete(unsigned* bar, unsigned x, unsigned& nloc, unsigned& nx) {
    const unsigned G = gridDim.x * gridDim.y * gridDim.z;
    unsigned sum, cnt, mine, sp = 0u;
    for (;;) {
        sum = 0u; cnt = 0u; mine = 0u;
#pragma unroll
        for (unsigned j = 0; j < 16; ++j) { const unsigned c = xb_ld(&bar[XB_XCNT(j)]); sum += c; cnt += (c > 0u) ? 1u : 0u; mine = (j == x) ? c : mine; }
        if (sum == G) break;
        __builtin_amdgcn_s_sleep(1);
        if ((++sp & 255u) == 0u) { if (xb_ld(&bar[XB_TMO])) break; if (sp > XB_SPIN_CAP) { atomicAdd(&bar[XB_TMO], 1u); break; } }
    }
    nloc = mine > 0u ? mine : 1u; nx = cnt > 0u ? cnt : 1u;
}
DI void xcd_barrier(const XcdBarrier& b) {
    asm volatile("s_waitcnt vmcnt(0)" ::: "memory");
    __syncthreads();
    if (threadIdx.x == 0) {
        unsigned* bar = b.bar;
        __builtin_amdgcn_s_waitcnt(0);
        unsigned nloc = b.st[0], nx = b.st[1];
        if (nloc == 0u) { xcd_barrier_complete(bar, b.x, nloc, nx); b.st[0] = nloc; b.st[1] = nx; }
        const unsigned old = xb_add(&bar[XB_XSUB(b.x)], 1u);
        const unsigned gen = old / nloc;
        if (old + 1u == (gen + 1u) * nloc) {
            __builtin_amdgcn_fence(__ATOMIC_RELEASE, "agent");
            asm volatile("s_waitcnt vmcnt(0)" ::: "memory");
            const unsigned og = xb_add(&bar[XB_TOP], 1u);
            const unsigned tg = og / nx;
            if (og + 1u == (tg + 1u) * nx) xb_add(&bar[XB_TOPGEN], 1u);
            else XB_SPIN(xb_ld(&bar[XB_TOPGEN]) == tg, bar);
            __builtin_amdgcn_fence(__ATOMIC_ACQUIRE, "agent");
            xb_add(&bar[XB_XGEN(b.x)], 1u);
            asm volatile("s_waitcnt vmcnt(0)" ::: "memory");
        } else {
            XB_SPIN(xb_ld(&bar[XB_XGEN(b.x)]) == gen, bar);
            __builtin_amdgcn_fence(__ATOMIC_ACQUIRE, "agent");
            asm volatile("s_waitcnt vmcnt(0)" ::: "memory");
        }
    }
    __syncthreads();
}

constexpr int LDS_BYTES = 136 * 1024;
constexpr int LDS_BAR_OFF = LDS_BYTES - 16;
__global__ void __launch_bounds__(NT) fwd_megakernel(Params p) {
    extern __shared__ __attribute__((aligned(16))) float lds[];
    const int bid = blockIdx.x, nblk = gridDim.x;
    volatile LAS unsigned* st = (volatile LAS unsigned*)((LAS unsigned char*)lds + LDS_BAR_OFF);
    if (threadIdx.x < 4) st[threadIdx.x] = 0u;
    __syncthreads();
    XcdBarrier bar = xcd_barrier_post((unsigned*)(p.ws + OFF_CTL) + CW_BAR, st);
    phase_prep(p, bid, nblk, lds);      xcd_barrier(bar);
    phase_proj(p, bid, nblk, lds);      xcd_barrier(bar);
    phase_poolmean(p, bid, nblk, lds);
    phase_gla1(p, bid, nblk, lds);      xcd_barrier(bar);
    phase_pool(p, bid, nblk, lds);
    phase_gla2(p, bid, nblk, lds);      xcd_barrier(bar);
    phase_gla3(p, bid, nblk, lds);      xcd_barrier(bar);
    phase_out(p, bid, nblk, lds);       xcd_barrier(bar);
    phase_route(p, bid, nblk, lds);     xcd_barrier(bar);
    phase_e1(p, bid, nblk, lds);        xcd_barrier(bar);
    phase_e2(p, bid, nblk, lds);        xcd_barrier(bar);
    phase_combine(p, bid, nblk, lds);
}

extern "C" void kernel_launch(void* const* d_in, const int* in_sizes, int n_in, void* d_out, int out_size, void* d_ws, size_t ws_size, hipStream_t stream) {
    static int grid = 0;
    if (grid == 0) {
        if (n_in != 20 || ws_size < WS_NEED) { fprintf(stderr, "kernel_launch: unexpected n_in %d or ws_size %zu (< %zu)\n", n_in, ws_size, (size_t)WS_NEED); grid = -1; return; }
        int dev = 0, cus = 0, per_cu = 0;
        (void)hipGetDevice(&dev); (void)hipDeviceGetAttribute(&cus, hipDeviceAttributeMultiprocessorCount, dev);
        (void)hipFuncSetAttribute((const void*)fwd_megakernel, hipFuncAttributeMaxDynamicSharedMemorySize, LDS_BYTES);
        (void)hipOccupancyMaxActiveBlocksPerMultiprocessor(&per_cu, (const void*)fwd_megakernel, NT, LDS_BYTES);
        if (per_cu < 1 || cus < 1) { fprintf(stderr, "kernel_launch: occupancy query says %d blocks/CU on %d CUs\n", per_cu, cus); grid = -1; return; }
        grid = cus;
    }
    if (grid < 0) return;
    (void)hipMemsetAsync((char*)d_ws + OFF_CTL, 0, 64 * 1024, stream);
    Params p{};
    const float** pp = (const float**)&p;
    for (int i = 0; i < 20; ++i) pp[i] = (const float*)d_in[i];
    p.out = (float*)d_out; p.ws = (unsigned char*)d_ws;
    void* args[] = {&p};
    hipError_t e = hipLaunchCooperativeKernel((const void*)fwd_megakernel, dim3(grid), dim3(NT), args, LDS_BYTES, stream);
    if (e != hipSuccess) fprintf(stderr, "cooperative launch failed: %s (grid %d)\n", hipGetErrorString(e), grid);
}
```

```cpp
#include <hip/hip_runtime.h>
#include <stdint.h>
#include <cstdio>

#define DI __device__ __forceinline__
typedef unsigned short bf16_t;

constexpr int T = 16384, D = 1024, SEQ = 4096;
constexpr int DIN = 2064, NPROJ = 2048;
constexpr int P_OFF = 0, Q_OFF = 512, K_OFF = 768, V_OFF = 1024, R_OFF = 1536, GL_OFF = 2048;
constexpr int SC = 64;
constexpr int NSC = SEQ / SC;
constexpr int NE = 256, TOPK = 8, EDIM = 256;
constexpr int A_TOT = T * TOPK;
constexpr int LCAP = T;
constexpr float ALPHA = 1.189207115002721f;
constexpr float LN_EPS = 1e-5f, RMS_EPS = 1e-5f;
constexpr int NT = 512;

constexpr size_t MiB = 1u << 20;
constexpr size_t OFF_CTL = 0;
constexpr size_t OFF_XB = 1 * MiB;
constexpr size_t OFF_GLOW = OFF_XB + 32 * MiB;
constexpr size_t OFF_PROJ = OFF_GLOW + 1 * MiB;
constexpr size_t OFF_G = OFF_PROJ + 64 * MiB;
constexpr size_t OFF_SLOC = OFF_G + 16 * MiB;
constexpr size_t OFF_DEC = OFF_SLOC + 32 * MiB;
constexpr size_t OFF_SIN = OFF_DEC + 1 * MiB;
constexpr size_t OFF_MIX = OFF_SIN + 32 * MiB;
constexpr size_t OFF_H32 = OFF_MIX + 32 * MiB;
constexpr size_t OFF_HB = OFF_H32 + 64 * MiB;
constexpr size_t OFF_SCORES = OFF_HB + 32 * MiB;
constexpr size_t OFF_WBUF = OFF_SCORES + 16 * MiB;
constexpr size_t OFF_LIST = OFF_WBUF + 1 * MiB;
constexpr size_t OFF_HID = OFF_LIST + 16 * MiB;
constexpr size_t OFF_Y = OFF_HID + 76 * MiB;
constexpr size_t OFF_PM = OFF_Y + 304 * MiB;
constexpr size_t OFF_WB_IN = OFF_PM + 16 * MiB;
constexpr size_t OFF_WB_OUT = OFF_WB_IN + 4 * MiB;
constexpr size_t OFF_WB_RT = OFF_WB_OUT + 2 * MiB;
constexpr size_t OFF_WB_SGU = OFF_WB_RT + 1 * MiB;
constexpr size_t OFF_WB_SD = OFF_WB_SGU + 1 * MiB;
constexpr size_t WS_NEED = OFF_WB_SD + 1 * MiB;
constexpr int CW_CNT = 1024;

struct Params {
    const float *x, *w_in, *gate_w2, *gate_b, *norm_w, *pool_w, *pool_scale, *w_out, *ln1_g, *ln1_b;
    const float *router_w, *router_bias, *wg, *wu, *wd, *sg, *su, *sd, *ln2_g, *ln2_b;
    float* out;
    unsigned char* ws;
};

DI float bf2f(bf16_t v) { return __uint_as_float(((unsigned)v) << 16); }
DI bf16_t f2bf(float f) { unsigned u = __float_as_uint(f); u += 0x7fffu + ((u >> 16) & 1u); return (bf16_t)(u >> 16); }
DI unsigned pk2(float lo, float hi) { return (unsigned)f2bf(lo) | ((unsigned)f2bf(hi) << 16); }
DI float wave_sum(float v) {
#pragma unroll
    for (int o = 1; o < 64; o <<= 1) v += __shfl_xor(v, o);
    return v;
}
DI float sigmoidf_(float v) { return 1.f / (1.f + __expf(-v)); }
DI float logsigmoidf_(float z) { return fminf(z, 0.f) - log1pf(__expf(-fabsf(z))); }

constexpr int GT_LDS_FLOATS = 16 * 132 + 2 * 16 * 68;
template <bool DUAL, class AF, class BF, class EPI>
DI void gemm_tile_valu(int K, const AF& af, const BF& bfn, const EPI& epi, float* lds) {
    float* As = lds; float* Bs = lds + 16 * 132; float* Bs2 = Bs + 16 * 68;
    const int tid = threadIdx.x, ty = tid >> 4, tx = tid & 15;
    float acc[4][4], acc2[4][4];
#pragma unroll
    for (int i = 0; i < 4; ++i)
#pragma unroll
        for (int j = 0; j < 4; ++j) { acc[i][j] = 0.f; acc2[i][j] = 0.f; }
    for (int k0 = 0; k0 < K; k0 += 16) {
#pragma unroll
        for (int i = 0; i < 4; ++i) { const int e = tid + 512 * i, r = e >> 4, kk = e & 15; As[kk * 132 + r] = af(r, k0 + kk); }
#pragma unroll
        for (int i = 0; i < 2; ++i) { const int e = tid + 512 * i, kk = e >> 6, c = e & 63; Bs[kk * 68 + c] = bfn(0, k0 + kk, c); if (DUAL) Bs2[kk * 68 + c] = bfn(1, k0 + kk, c); }
        __syncthreads();
#pragma unroll
        for (int kk = 0; kk < 16; ++kk) {
            const float4 a = *(const float4*)&As[kk * 132 + ty * 4];
            const float4 b = *(const float4*)&Bs[kk * 68 + tx * 4];
            const float av[4] = {a.x, a.y, a.z, a.w}, bv[4] = {b.x, b.y, b.z, b.w};
#pragma unroll
            for (int i = 0; i < 4; ++i)
#pragma unroll
                for (int j = 0; j < 4; ++j) acc[i][j] += av[i] * bv[j];
            if (DUAL) {
                const float4 b2 = *(const float4*)&Bs2[kk * 68 + tx * 4];
                const float b2v[4] = {b2.x, b2.y, b2.z, b2.w};
#pragma unroll
                for (int i = 0; i < 4; ++i)
#pragma unroll
                    for (int j = 0; j < 4; ++j) acc2[i][j] += av[i] * b2v[j];
            }
        }
        __syncthreads();
    }
#pragma unroll
    for (int i = 0; i < 4; ++i)
#pragma unroll
        for (int j = 0; j < 4; ++j) epi(ty * 4 + i, tx * 4 + j, acc[i][j], acc2[i][j]);
}


typedef __bf16 bf16x8 __attribute__((ext_vector_type(8)));
typedef __bf16 bf16x4 __attribute__((ext_vector_type(4)));
typedef short s16x4 __attribute__((ext_vector_type(4)));
typedef float f32x4 __attribute__((ext_vector_type(4)));
typedef unsigned u32x4 __attribute__((ext_vector_type(4)));
#define LAS3 __attribute__((address_space(3)))
DI const float* uniform_ptr(const float* p) {
    const unsigned long long v = (unsigned long long)p;
    const unsigned lo = __builtin_amdgcn_readfirstlane((unsigned)v), hi = __builtin_amdgcn_readfirstlane((unsigned)(v >> 32));
    return (const float*)(((unsigned long long)hi << 32) | lo);
}
#define MFMA16(a, b, c) __builtin_amdgcn_mfma_f32_16x16x32_bf16((a), (b), (c), 0, 0, 0)
constexpr int GEMM_LDS_BYTES = 131072;
DI unsigned a_swz(unsigned x) { return (0x78u >> (2u * x)) & 3u; }
struct GemmRegs { u32x4 ra[2][2], rb[2][4]; };
template <bool DUAL, bool BK16, int OUTB, int LDB, int WN, class RowFn, class RowFnN, class Pre, class Fin>
DI void gemm_core(u32x4 (&Rra)[2][2], u32x4 (&Rrb)[2][4], unsigned (&aoffc)[2], bool preloaded, const bf16_t* Ab, const RowFn& rowoff, const float* B0, const float* B1, unsigned bbytes, int K, int rows,
                  bool has_next, const RowFnN& rowoff_n, const float* B0n, const float* B1n, unsigned bbytes_n, int rows_n, const Pre& pre, const Fin& fin, unsigned char* lds) {
    int tid_ = threadIdx.x; asm volatile("" : "+v"(tid_));
    const int tid = tid_, lane = tid & 63, w = __builtin_amdgcn_readfirstlane(tid >> 6), wm = w >> 2, wn = w & 3, l15 = lane & 15, kg = lane >> 4, t256 = tid & 255;
    const bool active = wn < WN;
    const int nrow_w = min(max(rows - 128 * wm, 0), 128), ngrp = (((nrow_w + 15) >> 4) + 1) >> 1;
    unsigned aoff[2];
#pragma unroll
    for (int i = 0; i < 2; ++i) aoff[i] = preloaded ? aoffc[i] : (rowoff(min(128 * wm + (t256 >> 2) + 64 * i, rows - 1)) + (t256 & 3) * 8) * 2u;
    const __amdgpu_buffer_rsrc_t ar = __builtin_amdgcn_make_buffer_rsrc((void*)Ab, 0, 0x7fffffff, 0x00020000);
    const unsigned awr = (128 * wm + (t256 >> 2)) * 128 + ((((unsigned)(t256 & 3)) ^ (unsigned)((t256 >> 3) & 7) ^ (unsigned)(t256 & 4)) << 4);
    constexpr int NB = BK16 ? 2 : 4;
    const float* bsrc = uniform_ptr(DUAL && !BK16 ? ((wn >> 1) ? B1 : B0) : B0);
    const __amdgpu_buffer_rsrc_t br = __builtin_amdgcn_make_buffer_rsrc((void*)bsrc, 0, bbytes, 0x00020000);
    const unsigned bvoff = BK16 ? (unsigned)(((lane >> 5) * LDB + (lane & 31) * 8) * 2) : (DUAL ? (unsigned)(((lane >> 5) * LDB + (lane & 31) * 4) * 4) : (unsigned)(lane * 16));
    const int krow0 = BK16 ? 16 * wm + 2 * wn : (DUAL ? 16 * wm + 8 * (wn & 1) : 16 * wm + wn);
    constexpr int KSTEP = BK16 ? 8 : (DUAL ? 2 : 4), ESZ = BK16 ? 2 : 4;
    unsigned aoff_n[2];
#pragma unroll
    for (int i = 0; i < 2; ++i) aoff_n[i] = has_next ? (rowoff_n(min(128 * wm + (t256 >> 2) + 64 * i, rows_n - 1)) + (t256 & 3) * 8) * 2u : aoff[i];
    const float* bsrc_n = uniform_ptr(has_next ? (DUAL && !BK16 ? ((wn >> 1) ? B1n : B0n) : B0n) : bsrc);
    const __amdgpu_buffer_rsrc_t br_n = __builtin_amdgcn_make_buffer_rsrc((void*)bsrc_n, 0, has_next ? bbytes_n : bbytes, 0x00020000);
    unsigned bwr[NB];
#pragma unroll
    for (int i = 0; i < NB; ++i) {
        const int kb = krow0 + KSTEP * i + ((BK16 || DUAL) ? (lane >> 5) : 0);
        const int n = BK16 ? 8 * (lane & 31) : (DUAL ? (wn >> 1) * 128 + 4 * (lane & 31) : 4 * lane);
        const unsigned I = n >> 7, ch = (n & 127) >> 3, half = BK16 ? 0u : (unsigned)((n >> 2) & 1), xx = ((kb & 3) << 2) | ((kb >> 2) & 3);
        bwr[i] = 32768u + I * 16384u + 256u * kb + 16u * (ch ^ xx) + 8u * half;
    }
    const unsigned ard = (128 * wm + l15) * 128 + ((((unsigned)kg) ^ (unsigned)((l15 >> 1) & 7) ^ (unsigned)((l15 & 1) << 2)) << 4);
    unsigned trd0, trd1;
    {
        const unsigned q = l15 >> 2, pp = l15 & 3, cbase = (DUAL ? 4u * wn : 8u * (wn & 1)) + (pp >> 1), ibase = DUAL ? 0u : (unsigned)(wn >> 1);
        const unsigned x0 = (q << 2) | ((2u * kg) & 3u), x1 = (q << 2) | ((2u * kg + 1u) & 3u);
        trd0 = 32768u + ibase * 16384u + 256u * (8u * kg + q) + 16u * (cbase ^ x0) + 8u * (pp & 1);
        trd1 = 32768u + ibase * 16384u + 256u * (8u * kg + 4u + q) + 16u * (cbase ^ x1) + 8u * (pp & 1);
    }
    f32x4 acc[8][4];
#pragma unroll
    for (int i = 0; i < 8; ++i)
#pragma unroll
        for (int f = 0; f < 4; ++f) acc[i][f] = (f32x4){0.f, 0.f, 0.f, 0.f};
    const int nj = K / 32;
#define LOAD_SET(S, j) { _Pragma("unroll") for (int i = 0; i < 2; ++i) Rra[S][i] = __builtin_bit_cast(u32x4, __builtin_amdgcn_raw_buffer_load_b128(ar, aoff[S], ((j) >> 1) * 128 + i * 64, 0)); \
        _Pragma("unroll") for (int i = 0; i < NB; ++i) Rrb[S][i] = __builtin_bit_cast(u32x4, __builtin_amdgcn_raw_buffer_load_b128(br, bvoff, ((j) * 32 + krow0 + KSTEP * i) * (LDB * ESZ), 0)); }
#define LOAD_SET_N(S, j) { _Pragma("unroll") for (int i = 0; i < 2; ++i) Rra[S][i] = __builtin_bit_cast(u32x4, __builtin_amdgcn_raw_buffer_load_b128(ar, aoff_n[S], ((j) >> 1) * 128 + i * 64, 0)); \
        _Pragma("unroll") for (int i = 0; i < NB; ++i) Rrb[S][i] = __builtin_bit_cast(u32x4, __builtin_amdgcn_raw_buffer_load_b128(br_n, bvoff, ((j) * 32 + krow0 + KSTEP * i) * (LDB * ESZ), 0)); }
#define WRITE_SET(S, st, h) { _Pragma("unroll") for (int i = 0; i < 2; ++i) *(u32x4*)(lds + (st) * 65536 + (awr ^ (i ? 64u : 0u)) + (S) * 8192) = Rra[S][i]; \
        _Pragma("unroll") for (int i = 0; i < NB; ++i) { if (BK16) *(u32x4*)(lds + (st) * 65536 + (h) * 8192 + bwr[i]) = Rrb[S][i]; else { \
            const f32x4 v = __builtin_bit_cast(f32x4, Rrb[S][i]); bf16x4 o; o[0] = (__bf16)v[0]; o[1] = (__bf16)v[1]; o[2] = (__bf16)v[2]; o[3] = (__bf16)v[3]; \
            *(bf16x4*)(lds + (st) * 65536 + (h) * 8192 + ((!DUAL) ? ((bwr[0] ^ (unsigned)(i << 4)) + 1024u * i) : bwr[i])) = o; } } }
#define LOAD_SEL(S, jl) { const bool nx_ = (jl) >= nj; const int jt_ = nx_ ? (jl) - nj : (jl); \
        _Pragma("unroll") for (int i = 0; i < 2; ++i) Rra[S][i] = __builtin_bit_cast(u32x4, __builtin_amdgcn_raw_buffer_load_b128(ar, nx_ ? aoff_n[S] : aoff[S], (jt_ >> 1) * 128 + i * 64, 0)); \
        if (nx_) { _Pragma("unroll") for (int i = 0; i < NB; ++i) Rrb[S][i] = __builtin_bit_cast(u32x4, __builtin_amdgcn_raw_buffer_load_b128(br_n, bvoff, (jt_ * 32 + krow0 + KSTEP * i) * (LDB * ESZ), 0)); } \
        else { _Pragma("unroll") for (int i = 0; i < NB; ++i) Rrb[S][i] = __builtin_bit_cast(u32x4, __builtin_amdgcn_raw_buffer_load_b128(br, bvoff, (jt_ * 32 + krow0 + KSTEP * i) * (LDB * ESZ), 0)); } }
#define WRITE_A(S, st, h) { _Pragma("unroll") for (int i = 0; i < 2; ++i) *(u32x4*)(lds + (st) * 65536 + (awr ^ (i ? 64u : 0u)) + (S) * 8192) = Rra[S][i]; }
#define WRITE_B(S, st, h, I0, I1) { _Pragma("unroll") for (int i = (I0); i < (I1); ++i) { if (BK16) *(u32x4*)(lds + (st) * 65536 + (h) * 8192 + bwr[i]) = Rrb[S][i]; else { \
            const f32x4 v = __builtin_bit_cast(f32x4, Rrb[S][i]); bf16x4 o; o[0] = (__bf16)v[0]; o[1] = (__bf16)v[1]; o[2] = (__bf16)v[2]; o[3] = (__bf16)v[3]; \
            *(bf16x4*)(lds + (st) * 65536 + (h) * 8192 + ((!DUAL) ? ((bwr[0] ^ (unsigned)(i << 4)) + 1024u * i) : bwr[i])) = o; } } }
#define LOAD_A(S, jl) { const bool nx_ = (jl) >= nj; const int jt_ = nx_ ? (jl) - nj : (jl); \
        _Pragma("unroll") for (int i = 0; i < 2; ++i) Rra[S][i] = __builtin_bit_cast(u32x4, __builtin_amdgcn_raw_buffer_load_b128(ar, nx_ ? aoff_n[S] : aoff[S], (jt_ >> 1) * 128 + i * 64, 0)); }
#define LOAD_B(S, jl) { const bool nx_ = (jl) >= nj; const int jt_ = nx_ ? (jl) - nj : (jl); \
        if (nx_) { _Pragma("unroll") for (int i = 0; i < NB; ++i) Rrb[S][i] = __builtin_bit_cast(u32x4, __builtin_amdgcn_raw_buffer_load_b128(br_n, bvoff, (jt_ * 32 + krow0 + KSTEP * i) * (LDB * ESZ), 0)); } \
        else { _Pragma("unroll") for (int i = 0; i < NB; ++i) Rrb[S][i] = __builtin_bit_cast(u32x4, __builtin_amdgcn_raw_buffer_load_b128(br, bvoff, (jt_ * 32 + krow0 + KSTEP * i) * (LDB * ESZ), 0)); } }
#define TF_LOAD(dst, st, h, g) { _Pragma("unroll") for (int q_ = 0; q_ < 2; ++q_) dst[q_] = *(const bf16x8*)(lds + (st) * 65536 + ((g) * 2 + q_) * 2048 + (ard ^ ((h) ? 64u : 0u))); }
#define WF_LOAD(st, h) { _Pragma("unroll") for (int f = 0; f < 4; ++f) { \
        const unsigned fx = DUAL ? ((f & 1) << 5) : (f << 5), fo = (DUAL ? (f >> 1) * 16384 : 0) + (st) * 65536 + (h) * 8192; \
        const s16x4 lo = __builtin_amdgcn_ds_read_tr16_b64_v4i16((LAS3 s16x4*)(lds + ((trd0 ^ fx) + fo))); \
        const s16x4 hi = __builtin_amdgcn_ds_read_tr16_b64_v4i16((LAS3 s16x4*)(lds + ((trd1 ^ fx) + fo))); \
        wf[f] = __builtin_bit_cast(bf16x8, __builtin_shufflevector(lo, hi, 0, 1, 2, 3, 4, 5, 6, 7)); } }
#define STAGE_MMA(srcf, g) { _Pragma("unroll") for (int q_ = 0; q_ < 2; ++q_) _Pragma("unroll") for (int f = 0; f < 4; ++f) acc[(g) * 2 + q_][f] = MFMA16(wf[f], srcf[q_], acc[(g) * 2 + q_][f]); }
#define STAGE(st, h, g, cur, nxt) if ((g) < ngrp) { \
        if ((g) + 1 < 4 && (g) + 1 < ngrp) TF_LOAD(nxt, st, h, (g) + 1) \
        __builtin_amdgcn_sched_barrier(0); \
        STAGE_MMA(cur, g) \
        __builtin_amdgcn_sched_barrier(0); }
    const bool comp = active && ngrp > 0;
    bf16x8 fa[2], fb[2], wf[4];
#define HALF_MMA(st, h) if (comp) { STAGE(st, h, 0, fa, fb) STAGE(st, h, 1, fb, fa) STAGE(st, h, 2, fa, fb) STAGE(st, h, 3, fb, fa) }
#define SLOT(st, h, g, cur, nxt, PIECE) { if (comp && (g) < ngrp) { if ((g) + 1 < 4 && (g) + 1 < ngrp) TF_LOAD(nxt, st, h, (g) + 1) } \
        PIECE \
        __builtin_amdgcn_sched_barrier(0); \
        if (comp && (g) < ngrp) { STAGE_MMA(cur, g) } \
        __builtin_amdgcn_sched_barrier(0); }
#define HALF_SLOTS(st, h, S, jl) { SLOT(st, h, 0, fa, fb, WRITE_A(S, (st) ^ 1, h) LOAD_A(S, jl)) SLOT(st, h, 1, fb, fa, WRITE_B(S, (st) ^ 1, h, 0, NB / 2)) \
        SLOT(st, h, 2, fa, fb, WRITE_B(S, (st) ^ 1, h, NB / 2, NB)) SLOT(st, h, 3, fb, fa, LOAD_B(S, jl)) }
#define PREFETCH(st, h) if (comp) { WF_LOAD(st, h) TF_LOAD(fa, st, h, 0) }
    const int nJ = K / 64;
    if (!preloaded) { LOAD_SET(0, 0) LOAD_SET(1, 1) }
    WRITE_SET(0, 0, 0) WRITE_SET(1, 0, 1)
    LOAD_SEL(0, 2) LOAD_SEL(1, 3)
    __syncthreads();
    int st = 0;
#pragma unroll 1
    for (int J = 0; J < nJ - 1; ++J) {
        PREFETCH(st, 0)
        HALF_SLOTS(st, 0, 0, 2 * J + 4)
        PREFETCH(st, 1)
        HALF_SLOTS(st, 1, 1, 2 * J + 5)
        __syncthreads();
        st ^= 1;
    }
    {
        PREFETCH(st, 0)
        HALF_MMA(st, 0)
        PREFETCH(st, 1)
        HALF_MMA(st, 1)
        __syncthreads();
    }
#undef HALF_MMA
#undef SLOT
#undef HALF_SLOTS
#undef WRITE_A
#undef WRITE_B
#undef LOAD_A
#undef LOAD_B
#undef PREFETCH
#undef LOAD_SET
#undef LOAD_SET_N
#undef LOAD_SEL
#undef WRITE_SET
#undef TF_LOAD
#undef WF_LOAD
#undef STAGE_MMA
#undef STAGE
    aoffc[0] = aoff_n[0]; aoffc[1] = aoff_n[1];
    {
        constexpr int NF = DUAL ? 2 : 4, ROWB = NF * 16 * OUTB, NCH = ROWB / 16, RPR = (8192 / ROWB) < 128 ? (8192 / ROWB) : 128, RPI = 64 / NCH, NROUND = 128 / RPR;
        constexpr float FP8_SCALE = 128.f;
        unsigned char* stg = lds + w * 8192;
        int l15e = l15; asm volatile("" : "+v"(l15e));
        const int colbase = (DUAL ? 32 : 64) * wn;
#pragma unroll
        for (int rd = 0; rd < NROUND; ++rd) {
            if (active) {
#pragma unroll
                for (int mt = rd * (RPR / 16); mt < (rd + 1) * (RPR / 16); ++mt) {
                    if ((mt >> 1) < ngrp) {
                        const int rloc = mt * 16 - rd * RPR + l15e, row = 128 * wm + mt * 16 + l15e;
#pragma unroll
                        for (int f = 0; f < NF; ++f) {
                            const f32x4 v = DUAL ? pre(row, colbase + 16 * f + 4 * kg, acc[mt][f], acc[mt][f + 2]) : pre(row, colbase + 16 * f + 4 * kg, acc[mt][f], acc[mt][f]);
                            if (OUTB == 4) *(f32x4*)(stg + rloc * ROWB + ((((unsigned)(4 * f + kg)) ^ (unsigned)(rloc & (NCH - 1))) << 4)) = v;
                            else if (OUTB == 2) { bf16x4 o; o[0] = (__bf16)v[0]; o[1] = (__bf16)v[1]; o[2] = (__bf16)v[2]; o[3] = (__bf16)v[3];
                                *(bf16x4*)(stg + rloc * ROWB + ((((unsigned)(2 * f + (kg >> 1))) ^ (unsigned)(rloc & (NCH - 1))) << 4) + 8 * (kg & 1)) = o; }
                            else { int pk = 0; pk = __builtin_amdgcn_cvt_pk_fp8_f32(v[0] * FP8_SCALE, v[1] * FP8_SCALE, pk, false); pk = __builtin_amdgcn_cvt_pk_fp8_f32(v[2] * FP8_SCALE, v[3] * FP8_SCALE, pk, true);
                                *(int*)(stg + rloc * ROWB + ((((unsigned)f) ^ (unsigned)(rloc & (NCH - 1))) << 4) + 4 * kg) = pk; }
                        }
                    }
                }
                asm volatile("s_waitcnt lgkmcnt(0)" ::: "memory");
#pragma unroll
                for (int it = 0; it < RPR / RPI; ++it) {
                    const int rloc = it * RPI + lane / NCH, c = lane % NCH, row = 128 * wm + rd * RPR + rloc;
                    const u32x4 dv = *(const u32x4*)(stg + rloc * ROWB + ((((unsigned)c) ^ (unsigned)(rloc & (NCH - 1))) << 4));
                    if (row < rows) fin(row, colbase + c * (16 / OUTB), dv);
                }
                asm volatile("s_waitcnt lgkmcnt(0)" ::: "memory");
            }
        }
    }
    __syncthreads();
}

template <bool DUAL, bool BK16, int OUTB, int LDB, int WN, class RowFn, class Pre, class Fin>
DI void gemm_mfma(const bf16_t* Ab, const RowFn& rowoff, const float* B0, const float* B1, unsigned bbytes, int K, int rows, const Pre& pre, const Fin& fin, unsigned char* lds) {
    u32x4 ra[2][2], rb[2][4]; unsigned ao[2] = {0u, 0u};
    gemm_core<DUAL, BK16, OUTB, LDB, WN>(ra, rb, ao, false, Ab, rowoff, B0, B1, bbytes, K, rows, false, rowoff, B0, B1, bbytes, rows, pre, fin, lds);
}
#define PRE_ID [](int, int, f32x4 v, f32x4) { return v; }

DI void phase_prep(const Params& p, int bid, int nblk, float* lds) {
    const int tid = threadIdx.x, lane = tid & 63, wave = tid >> 6;
    bf16_t* xb = (bf16_t*)(p.ws + OFF_XB); float* glow = (float*)(p.ws + OFF_GLOW);
    float tw = 0.f;
    {
        const int ti = (bid >> 3) * NT + tid;
        if (ti < 1536) { const int m = ti >> 9, j = ti & 511; const float* bp = m == 0 ? p.wg : (m == 1 ? p.wu : p.wd); tw = bp[(size_t)j * 131072]; }
    }
    f32x4* Wl = (f32x4*)lds;
    for (int idx = tid; idx < 4096; idx += NT) {
        const int k = idx >> 2, q = idx & 3, ln = (k >> 2) & 63, j = k >> 8, c = k & 3;
        Wl[((j * 4 + c) * 4 + q) * 64 + ln] = *(const f32x4*)(p.w_in + (size_t)k * DIN + GL_OFF + 4 * q);
    }
    __syncthreads();
    for (int row0 = (bid * 8 + wave) * 4; row0 < T; row0 += nblk * 32) {
        asm volatile("" ::: "memory");
        f32x4 xv[4][4];
#pragma unroll
        for (int r = 0; r < 4; ++r)
#pragma unroll
            for (int j = 0; j < 4; ++j) {
                xv[r][j] = ((const f32x4*)(p.x + (size_t)(row0 + r) * D))[lane + 64 * j];
                uint2 o; o.x = pk2(xv[r][j][0], xv[r][j][1]); o.y = pk2(xv[r][j][2], xv[r][j][3]);
                ((uint2*)(xb + (size_t)(row0 + r) * D))[lane + 64 * j] = o;
            }
        float acc[4][16];
#pragma unroll
        for (int r = 0; r < 4; ++r)
#pragma unroll
            for (int n = 0; n < 16; ++n) acc[r][n] = 0.f;
#pragma unroll
        for (int j = 0; j < 4; ++j)
#pragma unroll
            for (int c = 0; c < 4; ++c) {
                float wv[16];
#pragma unroll
                for (int q = 0; q < 4; ++q) { const f32x4 w4 = Wl[((j * 4 + c) * 4 + q) * 64 + lane]; wv[4 * q] = w4[0]; wv[4 * q + 1] = w4[1]; wv[4 * q + 2] = w4[2]; wv[4 * q + 3] = w4[3]; }
#pragma unroll
                for (int r = 0; r < 4; ++r) {
                    const float xs = xv[r][j][c];
#pragma unroll
                    for (int n = 0; n < 16; ++n) acc[r][n] += xs * wv[n];
                }
            }
#define RS_STEP(N, OFF) { const bool up = (lane & (OFF)) != 0; _Pragma("unroll") for (int i = 0; i < (N); ++i) { \
            const float a = acc[i / 16][i % 16], b = acc[(i + (N)) / 16][(i + (N)) % 16]; const float snd = up ? a : b, kp = up ? b : a; \
            acc[i / 16][i % 16] = kp + __shfl_xor(snd, (OFF)); } }
        RS_STEP(32, 32) RS_STEP(16, 16) RS_STEP(8, 8) RS_STEP(4, 4) RS_STEP(2, 2) RS_STEP(1, 1)
#undef RS_STEP
        glow[(size_t)row0 * 16 + lane] = acc[0][0];
    }
    {
        bf16_t* wbin = (bf16_t*)(p.ws + OFF_WB_IN); bf16_t* wbout = (bf16_t*)(p.ws + OFF_WB_OUT); bf16_t* wbrt = (bf16_t*)(p.ws + OFF_WB_RT);
        bf16_t* wbsgu = (bf16_t*)(p.ws + OFF_WB_SGU); bf16_t* wbsd = (bf16_t*)(p.ws + OFF_WB_SD);
        constexpr int N_IN = 1024 * 512, N_OUT = 1024 * 256, N_RT = 1024 * 64, N_SGU = 1024 * 128, N_SD = 256 * 256;
        for (int it = bid * NT + tid; it < N_IN + N_OUT + N_RT + N_SGU + N_SD; it += nblk * NT) {
            const float* s; bf16_t* d; int r = it;
            if (r < N_IN) { const int k = r >> 9, c = (r & 511) * 4; s = p.w_in + (size_t)k * DIN + c; d = wbin + (size_t)k * 2048 + c; }
            else if ((r -= N_IN) < N_OUT) { s = p.w_out + (size_t)r * 4; d = wbout + (size_t)r * 4; }
            else if ((r -= N_OUT) < N_RT) { s = p.router_w + (size_t)r * 4; d = wbrt + (size_t)r * 4; }
            else if ((r -= N_RT) < N_SGU) { const int k = r >> 7, c = (r & 127) * 4, nt = c >> 8, h = (c >> 7) & 1, cc = c & 127; s = (h ? p.su : p.sg) + (size_t)k * EDIM + nt * 128 + cc; d = wbsgu + (size_t)k * 512 + c; }
            else { r -= N_SGU; s = p.sd + (size_t)r * 4; d = wbsd + (size_t)r * 4; }
            const f32x4 v = *(const f32x4*)s; uint2 o; o.x = pk2(v[0], v[1]); o.y = pk2(v[2], v[3]); *(uint2*)d = o;
        }
    }
    asm volatile("" :: "v"(tw));
    __syncthreads();
}

DI void phase_proj(const Params& p, int bid, int nblk, float* lds) {
    const bf16_t* xb = (const bf16_t*)(p.ws + OFF_XB); bf16_t* proj = (bf16_t*)(p.ws + OFF_PROJ); const bf16_t* wbin = (const bf16_t*)(p.ws + OFF_WB_IN);
    u32x4 ra[2][2], rb[2][4]; unsigned ao[2] = {0u, 0u}; bool pre = false;
    const bool xl = (nblk == 256);
    for (int u = bid; u < 64 * 8; u += nblk) {
        const int un = u + nblk; const bool hn = un < 64 * 8;
        const int mt = xl ? 32 * (u >> 8) + 4 * (u & 7) + ((u & 255) >> 6) : u >> 3, nt = xl ? ((u & 255) >> 3) & 7 : u & 7;
        const int mtn = xl ? 32 * (un >> 8) + 4 * (un & 7) + ((un & 255) >> 6) : un >> 3, ntn = xl ? ((un & 255) >> 3) & 7 : un & 7;
        auto rowoff = [&](int r) { return (unsigned)((mt * 256 + r) * D); };
        auto rowoff_n = [&](int r) { return (unsigned)((mtn * 256 + r) * D); };
        auto fin = [&](int r, int c, u32x4 dv) { *(u32x4*)(proj + (size_t)(mt * 256 + r) * NPROJ + nt * 256 + c) = dv; };
        gemm_core<false, true, 2, NPROJ, 4>(ra, rb, ao, pre, xb, rowoff, (const float*)(wbin + nt * 256), nullptr, (unsigned)(((size_t)D * NPROJ - nt * 256) * 2), D, 256,
                                 hn, rowoff_n, (const float*)(wbin + ntn * 256), nullptr, (unsigned)(((size_t)D * NPROJ - ntn * 256) * 2), 256, PRE_ID, fin, (unsigned char*)lds);
        pre = hn;
    }
}

template <int W>
DI void poolmean_item(const bf16_t* proj, bf16_t* pm, int t0, int c2) {
    const int s0 = t0 & (SEQ - 1);
    float p0[48], p1[48]; unsigned raw[32];
    p0[0] = 0.f; p1[0] = 0.f;
#pragma unroll
    for (int i = 0; i < 47; ++i) {
        unsigned v = 0u;
        if (i >= 15 || s0 > 0) v = *(const unsigned*)(proj + (size_t)(t0 - 15 + i) * NPROJ + P_OFF + c2);
        if (i >= 15) raw[i - 15] = v;
        p0[i + 1] = p0[i] + __uint_as_float(v << 16); p1[i + 1] = p1[i] + __uint_as_float(v & 0xffff0000u);
    }
#pragma unroll
    for (int i = 0; i < 32; ++i) {
        const int s = s0 + i; const float inv = 1.f / (float)min(s + 1, W);
        const float m0 = (p0[i + 16] - p0[i + 16 - W]) * inv - __uint_as_float(raw[i] << 16);
        const float m1 = (p1[i + 16] - p1[i + 16 - W]) * inv - __uint_as_float(raw[i] & 0xffff0000u);
        *(unsigned*)(pm + (size_t)(t0 + i) * 512 + c2) = pk2(m0, m1);
    }
}
DI void phase_poolmean(const Params& p, int bid, int nblk, float* lds) {
    const bf16_t* proj = (const bf16_t*)(p.ws + OFF_PROJ); bf16_t* pm = (bf16_t*)(p.ws + OFF_PM);
    for (int item = bid * NT + threadIdx.x; item < 256 * (T / 32); item += nblk * NT) {
        const int pair = item & 255, t0 = (item >> 8) * 32, c2 = pair * 2, g = __builtin_amdgcn_readfirstlane(pair >> 6);
        if (g == 0) poolmean_item<2>(proj, pm, t0, c2);
        else if (g == 1) poolmean_item<4>(proj, pm, t0, c2);
        else if (g == 2) poolmean_item<8>(proj, pm, t0, c2);
        else poolmean_item<16>(proj, pm, t0, c2);
    }
}
DI void phase_pool(const Params& p, int bid, int nblk, float* lds) {
    const bf16_t* pm = (const bf16_t*)(p.ws + OFF_PM); bf16_t* mix = (bf16_t*)(p.ws + OFF_MIX);
    for (int u = bid; u < 64 * 4; u += nblk) {
        const int mt = u >> 2, g = u & 3;
        auto rowoff = [&](int r) { return (unsigned)((mt * 256 + r) * 512 + g * 128); };
        auto pre = [&](int r, int c, f32x4 v, f32x4) { const f32x4 sc = *(const f32x4*)(p.pool_scale + g * 128 + c); return v * sc; };
        auto fin = [&](int r, int c, u32x4 dv) { *(u32x4*)(mix + (size_t)(mt * 256 + r) * D + g * 128 + c) = dv; };
        gemm_mfma<false, false, 2, 128, 2>(pm, rowoff, p.pool_w + (size_t)g * 16384, nullptr, (unsigned)((4 - g) * 16384 * 4), 128, 256, pre, fin, (unsigned char*)lds);
    }
}

DI unsigned f1_off(unsigned row, unsigned chunk) { return row * 128u + ((chunk ^ ((row >> 1) & 7u)) << 4); }
DI unsigned f2_off(unsigned row, unsigned ch) { return 256u * row + 16u * (ch ^ (((row & 3u) << 2) | ((row >> 2) & 3u))); }
DI bf16x8 f1_frag(const unsigned char* img, int tile, int ks, int lane) { return *(const bf16x8*)(img + f1_off(16 * tile + (lane & 15), 4 * ks + (lane >> 4))); }
DI bf16x8 f2_frag(const unsigned char* img, int c, int ks, int lane) {
    const unsigned g = lane >> 4, q = (lane & 15) >> 2, pp = lane & 3;
    const unsigned a0 = f2_off(32 * ks + 8 * g + q, 2 * c + (pp >> 1)) + 8 * (pp & 1), a1 = f2_off(32 * ks + 8 * g + 4 + q, 2 * c + (pp >> 1)) + 8 * (pp & 1);
    const s16x4 lo = __builtin_amdgcn_ds_read_tr16_b64_v4i16((LAS3 s16x4*)(img + a0)), hi = __builtin_amdgcn_ds_read_tr16_b64_v4i16((LAS3 s16x4*)(img + a1));
    return __builtin_bit_cast(bf16x8, __builtin_shufflevector(lo, hi, 0, 1, 2, 3, 4, 5, 6, 7));
}
DI float bfbits2f(unsigned short v) { return __uint_as_float(((unsigned)v) << 16); }
typedef unsigned short u16x8 __attribute__((ext_vector_type(8)));
typedef unsigned short u16x4 __attribute__((ext_vector_type(4)));

DI void phase_gla1(const Params& p, int bid, int nblk, float* ldsf) {
    unsigned char* lds = (unsigned char*)ldsf;
    int tid_ = threadIdx.x; asm volatile("" : "+v"(tid_));
    const int tid = tid_, lane = tid & 63, w = __builtin_amdgcn_readfirstlane(tid >> 6), t = tid >> 3, ch = tid & 7;
    const bf16_t* proj = (const bf16_t*)(p.ws + OFF_PROJ); const float* glow = (const float*)(p.ws + OFF_GLOW);
    float* Gbuf = (float*)(p.ws + OFF_G); float* Sloc = (float*)(p.ws + OFF_SLOC); float* dec = (float*)(p.ws + OFF_DEC);
    float* G = (float*)lds; unsigned char* Kimg = lds + 16384; unsigned char* Vimg = lds + 32768; float* W2l = (float*)(lds + 49152); float* segtot = (float*)(lds + 53248);
    for (int unit = bid; unit < 1024; unit += nblk) {
        const int bh = unit >> 6, n = unit & 63, b = bh >> 2, h = bh & 3, t0 = b * SEQ + n * SC;
        for (int i = tid; i < 1024; i += NT) W2l[i] = p.gate_w2[(i >> 6) * 256 + h * 64 + (i & 63)];
#pragma unroll
        for (int i = 0; i < 2; ++i) { const int idx = tid + NT * i, tr = idx >> 4, c16 = idx & 15;
            *(u32x4*)(Vimg + f2_off(tr, c16)) = *(const u32x4*)(proj + (size_t)(t0 + tr) * NPROJ + V_OFF + h * 128 + 8 * c16); }
        __syncthreads();
        {
            float gl[16];
#pragma unroll
            for (int q = 0; q < 4; ++q) { const f32x4 v = *(const f32x4*)(glow + (size_t)(t0 + t) * 16 + 4 * q); gl[4 * q] = v[0]; gl[4 * q + 1] = v[1]; gl[4 * q + 2] = v[2]; gl[4 * q + 3] = v[3]; }
#pragma unroll
            for (int dd = 0; dd < 8; ++dd) { const int d = 8 * ch + dd; float z = p.gate_b[h * 64 + d];
#pragma unroll
                for (int r = 0; r < 16; ++r) z += gl[r] * W2l[r * 64 + d];
                G[t * 64 + d] = logsigmoidf_(z) * (1.f / 16.f); }
        }
        __syncthreads();
        {
            const int seg = tid >> 6, d = tid & 63; float run = 0.f;
#pragma unroll
            for (int tt = 0; tt < 8; ++tt) { run += G[(8 * seg + tt) * 64 + d]; G[(8 * seg + tt) * 64 + d] = run; }
            segtot[seg * 64 + d] = run;
            __syncthreads();
            float pre = 0.f;
            for (int s2 = 0; s2 < seg; ++s2) pre += segtot[s2 * 64 + d];
#pragma unroll
            for (int tt = 0; tt < 8; ++tt) G[(8 * seg + tt) * 64 + d] += pre;
        }
        __syncthreads();
        {
            const f32x4 g0 = *(const f32x4*)(G + t * 64 + 8 * ch), g1 = *(const f32x4*)(G + t * 64 + 8 * ch + 4);
            const f32x4 l0 = *(const f32x4*)(G + 63 * 64 + 8 * ch), l1 = *(const f32x4*)(G + 63 * 64 + 8 * ch + 4);
            *(f32x4*)(Gbuf + (size_t)(t0 + t) * 256 + h * 64 + 8 * ch) = g0; *(f32x4*)(Gbuf + (size_t)(t0 + t) * 256 + h * 64 + 8 * ch + 4) = g1;
            const u16x8 kv = *(const u16x8*)(proj + (size_t)(t0 + t) * NPROJ + K_OFF + h * 64 + 8 * ch);
            bf16x8 o;
#pragma unroll
            for (int dd = 0; dd < 4; ++dd) { o[dd] = (__bf16)(bfbits2f(kv[dd]) * __expf(l0[dd] - g0[dd])); o[dd + 4] = (__bf16)(bfbits2f(kv[dd + 4]) * __expf(l1[dd] - g1[dd])); }
            *(bf16x8*)(Kimg + f2_off(t, ch)) = o;
            if (t == 63) {
#pragma unroll
                for (int dd = 0; dd < 4; ++dd) { dec[unit * 64 + 8 * ch + dd] = __expf(l0[dd]); dec[unit * 64 + 8 * ch + 4 + dd] = __expf(l1[dd]); }
            }
        }
        __syncthreads();
        {
            f32x4 acc[4];
#pragma unroll
            for (int dt = 0; dt < 4; ++dt) acc[dt] = (f32x4){0.f, 0.f, 0.f, 0.f};
#pragma unroll
            for (int ks = 0; ks < 2; ++ks) {
                const bf16x8 xv = f2_frag(Vimg, w, ks, lane);
#pragma unroll
                for (int dt = 0; dt < 4; ++dt) acc[dt] = MFMA16(xv, f2_frag(Kimg, dt, ks, lane), acc[dt]);
            }
#pragma unroll
            for (int dt = 0; dt < 4; ++dt) *(f32x4*)(Sloc + (size_t)unit * 8192 + (16 * dt + (lane & 15)) * 128 + 16 * w + 4 * (lane >> 4)) = acc[dt];
        }
        __syncthreads();
    }
}

DI void phase_gla2(const Params& p, int bid, int nblk, float* lds) {
    const float* Sloc = (const float*)(p.ws + OFF_SLOC); const float* dec = (const float*)(p.ws + OFF_DEC); bf16_t* Sin = (bf16_t*)(p.ws + OFF_SIN);
    for (int gid = bid * NT + threadIdx.x; gid < 16 * 8192; gid += nblk * NT) {
        const int bh = gid >> 13, el = gid & 8191, d = el >> 7; float st = 0.f;
        for (int n0 = 0; n0 < NSC; n0 += 16) {
            float sl[16], dc[16]; bf16_t so[16];
#pragma unroll
            for (int i = 0; i < 16; ++i) { const int u = bh * 64 + n0 + i; sl[i] = Sloc[(size_t)u * 8192 + el]; dc[i] = dec[u * 64 + d]; }
#pragma unroll
            for (int i = 0; i < 16; ++i) { so[i] = f2bf(st); st = st * dc[i] + sl[i]; }
#pragma unroll
            for (int i = 0; i < 16; ++i) Sin[(size_t)(bh * 64 + n0 + i) * 8192 + el] = so[i];
        }
    }
}

DI void phase_gla3(const Params& p, int bid, int nblk, float* ldsf) {
    unsigned char* lds = (unsigned char*)ldsf;
    int tid_ = threadIdx.x; asm volatile("" : "+v"(tid_));
    const int tid = tid_, lane = tid & 63, w = __builtin_amdgcn_readfirstlane(tid >> 6), t = tid >> 3, ch = tid & 7, l15 = lane & 15, kg = lane >> 4;
    const bf16_t* proj = (const bf16_t*)(p.ws + OFF_PROJ); const float* Gbuf = (const float*)(p.ws + OFF_G); const bf16_t* Sin = (const bf16_t*)(p.ws + OFF_SIN);
    bf16_t* mix = (bf16_t*)(p.ws + OFF_MIX);
    unsigned char* Qimg = lds; unsigned char* Kimg = lds + 8192; unsigned char* Pimg = lds + 16384; unsigned char* Vimg = lds + 24576; unsigned char* Simg = lds + 40960;
    float* part = (float*)(lds + 57344);
    for (int unit = bid; unit < 1024; unit += nblk) {
        const int bh = unit >> 6, n = unit & 63, b = bh >> 2, h = bh & 3, t0 = b * SEQ + n * SC;
        {
            const f32x4 g0 = *(const f32x4*)(Gbuf + (size_t)(t0 + t) * 256 + h * 64 + 8 * ch), g1 = *(const f32x4*)(Gbuf + (size_t)(t0 + t) * 256 + h * 64 + 8 * ch + 4);
            const u16x8 qv = *(const u16x8*)(proj + (size_t)(t0 + t) * NPROJ + Q_OFF + h * 64 + 8 * ch), kv = *(const u16x8*)(proj + (size_t)(t0 + t) * NPROJ + K_OFF + h * 64 + 8 * ch);
            bf16x8 qo, ko;
#pragma unroll
            for (int dd = 0; dd < 4; ++dd) {
                qo[dd] = (__bf16)(bfbits2f(qv[dd]) * 0.125f * __expf(g0[dd])); qo[dd + 4] = (__bf16)(bfbits2f(qv[dd + 4]) * 0.125f * __expf(g1[dd]));
                ko[dd] = (__bf16)(bfbits2f(kv[dd]) * __expf(-g0[dd])); ko[dd + 4] = (__bf16)(bfbits2f(kv[dd + 4]) * __expf(-g1[dd]));
            }
            *(bf16x8*)(Qimg + f1_off(t, ch)) = qo; *(bf16x8*)(Kimg + f1_off(t, ch)) = ko;
        }
#pragma unroll
        for (int i = 0; i < 2; ++i) { const int idx = tid + NT * i, tr = idx >> 4, c16 = idx & 15;
            *(u32x4*)(Vimg + f2_off(tr, c16)) = *(const u32x4*)(proj + (size_t)(t0 + tr) * NPROJ + V_OFF + h * 128 + 8 * c16);
            *(u32x4*)(Simg + f2_off(tr, c16)) = *(const u32x4*)(Sin + (size_t)unit * 8192 + tr * 128 + 8 * c16); }
        __syncthreads();
        {
            const int it = w >> 1;
#pragma unroll
            for (int jj = 0; jj < 2; ++jj) {
                const int jt = 2 * (w & 1) + jj; f32x4 acc = {0.f, 0.f, 0.f, 0.f};
                if (jt <= it) {
#pragma unroll
                    for (int ks = 0; ks < 2; ++ks) acc = MFMA16(f1_frag(Kimg, jt, ks, lane), f1_frag(Qimg, it, ks, lane), acc);
                    if (jt == it) {
#pragma unroll
                        for (int r = 0; r < 4; ++r) if (4 * kg + r > l15) acc[r] = 0.f;
                    }
                }
                bf16x4 o; o[0] = (__bf16)acc[0]; o[1] = (__bf16)acc[1]; o[2] = (__bf16)acc[2]; o[3] = (__bf16)acc[3];
                *(bf16x4*)(Pimg + f1_off(16 * it + l15, 2 * jt + (kg >> 1)) + 8 * (kg & 1)) = o;
            }
        }
        __syncthreads();
        {
            f32x4 acc[4];
#pragma unroll
            for (int it = 0; it < 4; ++it) acc[it] = (f32x4){0.f, 0.f, 0.f, 0.f};
#pragma unroll
            for (int ks = 0; ks < 2; ++ks) {
                const bf16x8 xv = f2_frag(Vimg, w, ks, lane), xs = f2_frag(Simg, w, ks, lane);
#pragma unroll
                for (int it = 0; it < 4; ++it) {
                    if (2 * ks <= it) acc[it] = MFMA16(xv, f1_frag(Pimg, it, ks, lane), acc[it]);
                    acc[it] = MFMA16(xs, f1_frag(Qimg, it, ks, lane), acc[it]);
                }
            }
#pragma unroll
            for (int it = 0; it < 4; ++it) {
                float ss = acc[it][0] * acc[it][0] + acc[it][1] * acc[it][1] + acc[it][2] * acc[it][2] + acc[it][3] * acc[it][3];
                ss += __shfl_xor(ss, 16); ss += __shfl_xor(ss, 32);
                if (kg == 0) part[w * 64 + 16 * it + l15] = ss;
            }
            __syncthreads();
            const int e0 = 16 * w + 4 * kg; const f32x4 nw = *(const f32x4*)(p.norm_w + e0);
#pragma unroll
            for (int it = 0; it < 4; ++it) {
                const int i = 16 * it + l15; float tot = 0.f;
#pragma unroll
                for (int w2 = 0; w2 < 8; ++w2) tot += part[w2 * 64 + i];
                const float inv = rsqrtf(tot * (1.f / 128.f) + RMS_EPS);
                const u16x4 rv = *(const u16x4*)(proj + (size_t)(t0 + i) * NPROJ + R_OFF + h * 128 + e0);
                bf16x4 o;
#pragma unroll
                for (int r = 0; r < 4; ++r) { const float rr = bfbits2f(rv[r]); o[r] = (__bf16)(acc[it][r] * inv * nw[r] * (rr * sigmoidf_(rr))); }
                *(bf16x4*)(mix + (size_t)(t0 + i) * D + 512 + h * 128 + e0) = o;
            }
        }
        __syncthreads();
    }
}

DI void phase_out(const Params& p, int bid, int nblk, float* lds) {
    const bf16_t* mix = (const bf16_t*)(p.ws + OFF_MIX); const bf16_t* xb = (const bf16_t*)(p.ws + OFF_XB); bf16_t* yb = (bf16_t*)(p.ws + OFF_H32);
    for (int u = bid; u < 64 * 4; u += nblk) {
        const int mt = (nblk == 256) ? 8 * (u & 7) + (u >> 5) : u >> 2, nt = (nblk == 256) ? (u >> 3) & 3 : u & 3;
        auto rowoff = [&](int r) { return (unsigned)((mt * 256 + r) * D); };
        auto fin = [&](int r, int c, u32x4 dv) {
            const size_t o = (size_t)(mt * 256 + r) * D + nt * 256 + c; const u32x4 xr = *(const u32x4*)(xb + o);
            const f32x4 x0 = {bf2f((bf16_t)(xr[0] & 0xffffu)), bf2f((bf16_t)(xr[0] >> 16)), bf2f((bf16_t)(xr[1] & 0xffffu)), bf2f((bf16_t)(xr[1] >> 16))};
            const f32x4 x1 = {bf2f((bf16_t)(xr[2] & 0xffffu)), bf2f((bf16_t)(xr[2] >> 16)), bf2f((bf16_t)(xr[3] & 0xffffu)), bf2f((bf16_t)(xr[3] >> 16))};
            u32x4 ov;
            ov[0] = pk2(bf2f((bf16_t)(dv[0] & 0xffffu)) + ALPHA * x0[0], bf2f((bf16_t)(dv[0] >> 16)) + ALPHA * x0[1]);
            ov[1] = pk2(bf2f((bf16_t)(dv[1] & 0xffffu)) + ALPHA * x0[2], bf2f((bf16_t)(dv[1] >> 16)) + ALPHA * x0[3]);
            ov[2] = pk2(bf2f((bf16_t)(dv[2] & 0xffffu)) + ALPHA * x1[0], bf2f((bf16_t)(dv[2] >> 16)) + ALPHA * x1[1]);
            ov[3] = pk2(bf2f((bf16_t)(dv[3] & 0xffffu)) + ALPHA * x1[2], bf2f((bf16_t)(dv[3] >> 16)) + ALPHA * x1[3]);
            *(u32x4*)(yb + o) = ov; };
        gemm_mfma<false, true, 2, D, 4>(mix, rowoff, (const float*)((const bf16_t*)(p.ws + OFF_WB_OUT) + nt * 256), nullptr, (unsigned)(((size_t)D * D - nt * 256) * 2), D, 256, PRE_ID, fin, (unsigned char*)lds);
    }
}

DI void ln_row(float (&v)[16], const float* g, const float* b, int lane) {
    float s = 0.f;
#pragma unroll
    for (int i = 0; i < 16; ++i) s += v[i];
    const float mean = wave_sum(s) * (1.f / D); float q = 0.f;
#pragma unroll
    for (int i = 0; i < 16; ++i) { v[i] -= mean; q += v[i] * v[i]; }
    const float rstd = rsqrtf(wave_sum(q) * (1.f / D) + LN_EPS);
#pragma unroll
    for (int j = 0; j < 4; ++j) {
        const float4 gg = ((const float4*)g)[lane + 64 * j], bb = ((const float4*)b)[lane + 64 * j];
        v[4 * j] = v[4 * j] * rstd * gg.x + bb.x; v[4 * j + 1] = v[4 * j + 1] * rstd * gg.y + bb.y;
        v[4 * j + 2] = v[4 * j + 2] * rstd * gg.z + bb.z; v[4 * j + 3] = v[4 * j + 3] * rstd * gg.w + bb.w;
    }
}

DI void ln1_rows(const Params& p, int r0, int nrows) {
    int tid_ = threadIdx.x; asm volatile("" : "+v"(tid_));
    const int lane = tid_ & 63, wave = tid_ >> 6;
    const bf16_t* yb = (const bf16_t*)(p.ws + OFF_H32); bf16_t* hb = (bf16_t*)(p.ws + OFF_HB);
    for (int rb = r0 + wave; rb < r0 + nrows; rb += 32) {
        float v[4][16];
#pragma unroll
        for (int q = 0; q < 4; ++q) {
            const u32x4* hr = (const u32x4*)(yb + (size_t)(rb + 8 * q) * D);
#pragma unroll
            for (int j = 0; j < 2; ++j) { const u32x4 a = hr[lane + 64 * j];
                _Pragma("unroll") for (int k = 0; k < 4; ++k) { v[q][8 * j + 2 * k] = bf2f((bf16_t)(a[k] & 0xffffu)); v[q][8 * j + 2 * k + 1] = bf2f((bf16_t)(a[k] >> 16)); } }
        }
        float s[4], qq[4];
#pragma unroll
        for (int q = 0; q < 4; ++q) { s[q] = 0.f; _Pragma("unroll") for (int i = 0; i < 16; ++i) s[q] += v[q][i]; }
#pragma unroll
        for (int o = 1; o < 64; o <<= 1) { _Pragma("unroll") for (int q = 0; q < 4; ++q) s[q] += __shfl_xor(s[q], o); }
#pragma unroll
        for (int q = 0; q < 4; ++q) { const float mean = s[q] * (1.f / D); qq[q] = 0.f; _Pragma("unroll") for (int i = 0; i < 16; ++i) { v[q][i] -= mean; qq[q] += v[q][i] * v[q][i]; } }
#pragma unroll
        for (int o = 1; o < 64; o <<= 1) { _Pragma("unroll") for (int q = 0; q < 4; ++q) qq[q] += __shfl_xor(qq[q], o); }
#pragma unroll
        for (int j = 0; j < 2; ++j) {
            const float4 g0 = ((const float4*)p.ln1_g)[2 * (lane + 64 * j)], g1 = ((const float4*)p.ln1_g)[2 * (lane + 64 * j) + 1];
            const float4 b0 = ((const float4*)p.ln1_b)[2 * (lane + 64 * j)], b1 = ((const float4*)p.ln1_b)[2 * (lane + 64 * j) + 1];
#pragma unroll
            for (int q = 0; q < 4; ++q) {
                const float rstd = rsqrtf(qq[q] * (1.f / D) + LN_EPS); const float* w = &v[q][8 * j];
                u32x4 o;
                o[0] = pk2(w[0] * rstd * g0.x + b0.x, w[1] * rstd * g0.y + b0.y); o[1] = pk2(w[2] * rstd * g0.z + b0.z, w[3] * rstd * g0.w + b0.w);
                o[2] = pk2(w[4] * rstd * g1.x + b1.x, w[5] * rstd * g1.y + b1.y); o[3] = pk2(w[6] * rstd * g1.z + b1.z, w[7] * rstd * g1.w + b1.w);
                ((u32x4*)(hb + (size_t)(rb + 8 * q) * D))[lane + 64 * j] = o;
            }
        }
    }
}

DI void topk_rows(const Params& p, const float* sc_lds, int r0, int nrows) {
    int tid_ = threadIdx.x; asm volatile("" : "+v"(tid_));
    const int lane = tid_ & 63, wave = tid_ >> 6;
    float* wbuf = (float*)(p.ws + OFF_WBUF);
    int* list = (int*)(p.ws + OFF_LIST); unsigned* cnt = (unsigned*)(p.ws + OFF_CTL) + CW_CNT;
    const float NEG = -__builtin_inff();
    for (int t = r0 + wave; t < r0 + nrows; t += 8) {
        const float4 sv = ((const float4*)(sc_lds + (size_t)(t - r0) * NE))[lane], bv = ((const float4*)p.router_bias)[lane];
        const float s[4] = {sv.x, sv.y, sv.z, sv.w};
        float cand[4] = {sv.x + bv.x, sv.y + bv.y, sv.z + bv.z, sv.w + bv.w};
        float m1 = NEG, m2 = NEG;
#pragma unroll
        for (int j = 0; j < 4; ++j) { const float v = cand[j]; if (v > m1) { m2 = m1; m1 = v; } else if (v > m2) m2 = v; }
#pragma unroll
        for (int off = 1; off < 8; off <<= 1) {
            const float o1 = __shfl_xor(m1, off), o2 = __shfl_xor(m2, off);
            const float n1 = fmaxf(m1, o1), n2 = fmaxf(fminf(m1, o1), fmaxf(m2, o2)); m1 = n1; m2 = n2;
        }
        const float gs = m1 + m2; const int mygrp = lane >> 3; int rank = 0;
#pragma unroll
        for (int g2 = 0; g2 < 8; ++g2) { const float og = __shfl(gs, g2 * 8); if (og > gs || (og == gs && g2 < mygrp)) ++rank; }
        if (rank >= 4) { cand[0] = NEG; cand[1] = NEG; cand[2] = NEG; cand[3] = NEG; }
        int my_e = 0; float my_w = 0.f, wsum = 0.f;
#pragma unroll
        for (int k = 0; k < TOPK; ++k) {
            float bvv = cand[0]; int bj = 0;
#pragma unroll
            for (int j = 1; j < 4; ++j) if (cand[j] > bvv) { bvv = cand[j]; bj = j; }
            int bi = 4 * lane + bj;
#pragma unroll
            for (int off = 32; off >= 1; off >>= 1) {
                const float ov = __shfl_xor(bvv, off); const int oi = __shfl_xor(bi, off);
                if (ov > bvv || (ov == bvv && oi < bi)) { bvv = ov; bi = oi; }
            }
            const int wj = bi & 3, wl = bi >> 2;
            const float mys = wj == 0 ? s[0] : (wj == 1 ? s[1] : (wj == 2 ? s[2] : s[3]));
            const float wk = __shfl(mys, wl);
            wsum += wk;
            if (lane == k) { my_e = bi; my_w = wk; }
            if (lane == wl) {
#pragma unroll
                for (int j = 0; j < 4; ++j) if (j == wj) cand[j] = NEG;
            }
        }
        if (lane < TOPK) {
            const unsigned pos = atomicAdd(&cnt[my_e], 1u);
            list[(size_t)my_e * LCAP + pos] = t * TOPK + lane;
            wbuf[(size_t)t * TOPK + lane] = my_w / wsum * 2.5f;
        }
    }
}

DI void phase_route(const Params& p, int bid, int nblk, float* lds) {
    const bf16_t* hb = (const bf16_t*)(p.ws + OFF_HB); float* scores = (float*)(p.ws + OFF_SCORES);
    for (int mt = bid; mt < T / 64; mt += nblk) {
        ln1_rows(p, mt * 64, 64);
        __syncthreads();
        auto rowoff = [&](int r) { return (unsigned)((mt * 64 + r) * D); };
        auto pre = [&](int r, int c, f32x4 v, f32x4) { return (f32x4){sigmoidf_(v[0]), sigmoidf_(v[1]), sigmoidf_(v[2]), sigmoidf_(v[3])}; };
        auto fin = [&](int r, int c, u32x4 dv) { *(u32x4*)((unsigned char*)lds + 65536 + (r * NE + c) * 4) = dv; };
        gemm_mfma<false, true, 4, NE, 4>(hb, rowoff, (const float*)(p.ws + OFF_WB_RT), nullptr, (unsigned)(D * NE * 2), D, 64, pre, fin, (unsigned char*)lds);
        __syncthreads();
        topk_rows(p, (const float*)((unsigned char*)lds + 65536), mt * 64, 64);
        __syncthreads();
    }
}

constexpr int EXP_TAB_OFF = GEMM_LDS_BYTES;
DI void build_tables(const Params& p, int* toff, int* roff) {
    const unsigned* cnt = (const unsigned*)(p.ws + OFF_CTL) + CW_CNT;
    int* cl = roff + 260;
    if (threadIdx.x < NE) cl[threadIdx.x] = (int)__hip_atomic_load(cnt + threadIdx.x, __ATOMIC_RELAXED, __HIP_MEMORY_SCOPE_AGENT);
    __syncthreads();
    if (threadIdx.x <= NE) {
        int ta = 0, ra = 0;
        for (int e = 0; e < (int)threadIdx.x; ++e) { const int c = cl[e]; ta += (c + 255) >> 8; ra += c; }
        toff[threadIdx.x] = ta; roff[threadIdx.x] = ra;
    }
    __syncthreads();
    if (threadIdx.x < NE) { unsigned char* texp = (unsigned char*)(roff + 1040); for (int t = toff[threadIdx.x]; t < toff[threadIdx.x + 1]; ++t) texp[t] = (unsigned char)threadIdx.x; }
    __syncthreads();
}
DI int find_expert(const int* toff, int tile) { int lo = 0, hi = NE - 1; while (lo < hi) { const int mid = (lo + hi + 1) >> 1; if (toff[mid] <= tile) lo = mid; else hi = mid - 1; } return lo; }
struct ExpUnit { int e, row0, rows, rowbase; };
DI ExpUnit exp_unit(const int* toff, const int* roff, int e, int tile, int ntile) {
    const int* cl = roff + 260;
    ExpUnit u;
    if (tile < ntile) {
        u.e = e; const int ui = tile - toff[e], c = cl[e];
        u.row0 = ui * 256; u.rows = min(256, c - u.row0); u.rowbase = roff[e] + u.row0;
    } else { u.e = NE; u.row0 = (tile - ntile) * 256; u.rows = 256; u.rowbase = A_TOT + u.row0; }
    u.e = __builtin_amdgcn_readfirstlane(u.e); u.row0 = __builtin_amdgcn_readfirstlane(u.row0); u.rows = __builtin_amdgcn_readfirstlane(u.rows);
    u.rowbase = __builtin_amdgcn_readfirstlane(u.rowbase);
    return u;
}

template <int NTL>
DI int exp_decode(const int* toff, int ntile, int u, int& tile, int& nt) {
    if (u < NTL * ntile) {
        const unsigned char* texp = (const unsigned char*)(toff + 260 + 1040);
        const int e = texp[u / NTL], t0 = toff[e], ne = toff[e + 1] - t0; int u2 = u - NTL * t0; nt = 0;
#pragma unroll
        for (int i = 1; i < NTL; ++i) if (u2 >= ne) { u2 -= ne; ++nt; }
        tile = t0 + u2; return e;
    }
    else { const int us = u - NTL * ntile; nt = us / (T / 256); tile = ntile + (us - nt * (T / 256)); return NE; }
}

DI void phase_e1(const Params& p, int bid, int nblk, float* lds) {
    int* toff = (int*)((unsigned char*)lds + EXP_TAB_OFF); int* roff = toff + 260;
    const bf16_t* hb = (const bf16_t*)(p.ws + OFF_HB); bf16_t* hid = (bf16_t*)(p.ws + OFF_HID); const int* list = (const int*)(p.ws + OFF_LIST);
    build_tables(p, toff, roff);
    const int ntile = toff[NE], units = (ntile + T / 256) * 2;
    const int vb = (nblk & 7) ? bid : (bid & 7) * (nblk >> 3) + (bid >> 3);
    u32x4 ra[2][2], rb[2][4]; unsigned ao[2] = {0u, 0u}; bool pre = false;
    int tile_n = 0, nt_n = 0; ExpUnit xn;
    if (vb < units) { const int e_ = exp_decode<2>(toff, ntile, vb, tile_n, nt_n); xn = exp_unit(toff, roff, e_, tile_n, ntile); }
    for (int u = vb; u < units; u += nblk) {
        const int nt = nt_n; const ExpUnit x = xn; const bool hn = u + nblk < units;
        if (hn) { const int e_ = exp_decode<2>(toff, ntile, u + nblk, tile_n, nt_n); xn = exp_unit(toff, roff, e_, tile_n, ntile); }
        const float* wg = x.e < NE ? p.wg + (size_t)x.e * 262144 : p.sg; const float* wu = x.e < NE ? p.wu + (size_t)x.e * 262144 : p.su;
        const float* wgn = xn.e < NE ? p.wg + (size_t)xn.e * 262144 : p.sg; const float* wun = xn.e < NE ? p.wu + (size_t)xn.e * 262144 : p.su;
        auto rowoff = [&](int r) { const int tok = x.e < NE ? (list[(size_t)x.e * LCAP + x.row0 + r] >> 3) : (x.row0 + r); return (unsigned)(tok * D); };
        auto rowoff_n = [&](int r) { const int tok = xn.e < NE ? (list[(size_t)xn.e * LCAP + xn.row0 + r] >> 3) : (xn.row0 + r); return (unsigned)(tok * D); };
        auto prf = [&](int r, int c, f32x4 g, f32x4 uu) { return (f32x4){g[0] * sigmoidf_(g[0]) * uu[0], g[1] * sigmoidf_(g[1]) * uu[1], g[2] * sigmoidf_(g[2]) * uu[2], g[3] * sigmoidf_(g[3]) * uu[3]}; };
        auto fin = [&](int r, int c, u32x4 dv) { *(u32x4*)(hid + (size_t)(x.rowbase + r) * EDIM + nt * 128 + c) = dv; };
        gemm_core<true, false, 2, EDIM, 4>(ra, rb, ao, pre, hb, rowoff, wg + nt * 128, wu + nt * 128, (unsigned)((D * EDIM - nt * 128) * 4), D, x.rows,
                                 hn, rowoff_n, wgn + nt_n * 128, wun + nt_n * 128, (unsigned)((D * EDIM - nt_n * 128) * 4), xn.rows, prf, fin, (unsigned char*)lds);
        pre = hn;
    }
}

DI void phase_e2(const Params& p, int bid, int nblk, float* lds) {
    int* toff = (int*)((unsigned char*)lds + EXP_TAB_OFF); int* roff = toff + 260; int* rowa = roff + 520;
    const bf16_t* hid = (const bf16_t*)(p.ws + OFF_HID); unsigned char* Y = p.ws + OFF_Y; const int* list = (const int*)(p.ws + OFF_LIST);
    build_tables(p, toff, roff);
    const int ntile = toff[NE], units = (ntile + T / 256) * 4;
    const int vb = (nblk & 7) ? bid : (bid & 7) * (nblk >> 3) + (bid >> 3);
    u32x4 ra[2][2], rb[2][4]; unsigned ao[2] = {0u, 0u}; bool pre = false;
    int tile_n = 0, nt_n = 0; ExpUnit xn;
    auto rowa_val = [&](const ExpUnit& q, int r) { return q.e < NE ? (r < q.rows ? list[(size_t)q.e * LCAP + q.row0 + r] : 0) : (A_TOT + q.row0 + r); };
    if (vb < units) { const int e_ = exp_decode<4>(toff, ntile, vb, tile_n, nt_n); xn = exp_unit(toff, roff, e_, tile_n, ntile); if (threadIdx.x < 256) rowa[threadIdx.x] = rowa_val(xn, threadIdx.x); }
    __syncthreads();
    int cur = 0;
    for (int u = vb; u < units; u += nblk) {
        const int nt = nt_n; const ExpUnit x = xn; const bool hn = u + nblk < units;
        if (hn) { const int e_ = exp_decode<4>(toff, ntile, u + nblk, tile_n, nt_n); xn = exp_unit(toff, roff, e_, tile_n, ntile); }
        const float* wd = x.e < NE ? p.wd + (size_t)x.e * 262144 : p.sd; const float* wdn = xn.e < NE ? p.wd + (size_t)xn.e * 262144 : p.sd;
        int rnext = 0;
        if (hn && threadIdx.x < 256) rnext = rowa_val(xn, threadIdx.x);
        const int* rowa_c = rowa + cur * 256;
        auto rowoff = [&](int r) { return (unsigned)((x.rowbase + r) * EDIM); };
        auto rowoff_n = [&](int r) { return (unsigned)((xn.rowbase + r) * EDIM); };
        auto fin = [&](int r, int c, u32x4 dv) { *(u32x4*)(Y + (size_t)rowa_c[r] * D + nt * 256 + c) = dv; };
        gemm_core<false, false, 1, D, 4>(ra, rb, ao, pre, hid, rowoff, wd + nt * 256, nullptr, (unsigned)((EDIM * D - nt * 256) * 4), EDIM, x.rows,
                               hn, rowoff_n, wdn + nt_n * 256, nullptr, (unsigned)((EDIM * D - nt_n * 256) * 4), xn.rows, PRE_ID, fin, (unsigned char*)lds);
        pre = hn;
        cur ^= 1;
        if (threadIdx.x < 256) rowa[cur * 256 + threadIdx.x] = rnext;
    }
}

DI void phase_combine(const Params& p, int bid, int nblk, float* lds) {
    const int lane = threadIdx.x & 63, wave = threadIdx.x >> 6;
    const bf16_t* hb = (const bf16_t*)(p.ws + OFF_HB); const unsigned char* Y = p.ws + OFF_Y; const float* wbuf = (const float*)(p.ws + OFF_WBUF);
    typedef float f32x2 __attribute__((ext_vector_type(2)));
    for (int t = bid * 8 + wave; t < T; t += nblk * 8) {
        float v[16];
#pragma unroll
        for (int j = 0; j < 4; ++j) { const uint2 a = ((const uint2*)(hb + (size_t)t * D))[lane + 64 * j];
            v[4 * j] = ALPHA * __uint_as_float(a.x << 16); v[4 * j + 1] = ALPHA * __uint_as_float(a.x & 0xffff0000u);
            v[4 * j + 2] = ALPHA * __uint_as_float(a.y << 16); v[4 * j + 3] = ALPHA * __uint_as_float(a.y & 0xffff0000u); }
#pragma unroll
        for (int k = 0; k < 9; ++k) {
            const size_t row = k < 8 ? (size_t)t * TOPK + k : (size_t)A_TOT + t; const float w = (k < 8 ? wbuf[(size_t)t * TOPK + k] : 1.f) * (1.f / 128.f);
#pragma unroll
            for (int j = 0; j < 4; ++j) {
                const int y = ((const int*)(Y + row * D))[lane + 64 * j];
                const f32x2 lo = __builtin_amdgcn_cvt_pk_f32_fp8(y, false), hi = __builtin_amdgcn_cvt_pk_f32_fp8(y, true);
                v[4 * j] += w * lo[0]; v[4 * j + 1] += w * lo[1]; v[4 * j + 2] += w * hi[0]; v[4 * j + 3] += w * hi[1];
            }
        }
        ln_row(v, p.ln2_g, p.ln2_b, lane);
#pragma unroll
        for (int j = 0; j < 4; ++j) ((float4*)(p.out + (size_t)t * D))[lane + 64 * j] = make_float4(v[4 * j], v[4 * j + 1], v[4 * j + 2], v[4 * j + 3]);
    }
}

#define LAS __attribute__((address_space(3)))
#define XB_TMO      128
#define XB_XCNT(j)  (256  + 64 * (j))
#define XB_XSUB(j)  (1280 + 64 * (j))
#define XB_XGEN(j)  (2304 + 64 * (j))
#define XB_TOP      3328
#define XB_TOPGEN   3392
#define XCD_BAR_WORDS 3456
#define XB_SPIN_CAP (1u << 22)
constexpr int CW_BAR = 4096;
DI unsigned xb_ld(unsigned* p) { return __hip_atomic_load(p, __ATOMIC_RELAXED, __HIP_MEMORY_SCOPE_AGENT); }
DI unsigned xb_add(unsigned* p, unsigned v) { return __hip_atomic_fetch_add(p, v, __ATOMIC_RELAXED, __HIP_MEMORY_SCOPE_AGENT); }
DI unsigned xb_xcc_id() { return (unsigned)__builtin_amdgcn_s_getreg((3 << 11) | 20) & 0xFu; }
#define XB_SPIN(cond, bar) do { unsigned _sp = 0; while (cond) { __builtin_amdgcn_s_sleep(1); \
    if ((++_sp & 255u) == 0u) { if (xb_ld(&(bar)[XB_TMO])) break; if (_sp > XB_SPIN_CAP) { atomicAdd(&(bar)[XB_TMO], 1u); break; } } } } while (0)
struct XcdBarrier { unsigned* bar; unsigned x; volatile LAS unsigned* st; };
DI XcdBarrier xcd_barrier_post(unsigned* bar, volatile LAS unsigned* st) {
    XcdBarrier b; b.bar = bar; b.x = xb_xcc_id(); b.st = st;
    if (threadIdx.x == 0) (void)xb_add(&bar[XB_XCNT(b.x)], 1u);
    return b;
}
DI void xcd_barrier_complete(unsigned* bar, unsigned x, unsigned& nloc, unsigned& nx) {
    const unsigned G = gridDim.x * gridDim.y * gridDim.z;
    unsigned sum, cnt, mine, sp = 0u;
    for (;;) {
        sum = 0u; cnt = 0u; mine = 0u;
#pragma unroll
        for (unsigned j = 0; j < 16; ++j) { const unsigned c = xb_ld(&bar[XB_XCNT(j)]); sum += c; cnt += (c > 0u) ? 1u : 0u; mine = (j == x) ? c : mine; }
        if (sum == G) break;
        __builtin_amdgcn_s_sleep(1);
        if ((++sp & 255u) == 0u) { if (xb_ld(&bar[XB_TMO])) break; if (sp > XB_SPIN_CAP) { atomicAdd(&bar[XB_TMO], 1u); break; } }
    }
    nloc = mine > 0u ? mine : 1u; nx = cnt > 0u ? cnt : 1u;
}
DI void xcd_barrier(const XcdBarrier& b) {
    asm volatile("s_waitcnt vmcnt(0)" ::: "memory");
    __syncthreads();
    if (threadIdx.x == 0) {
        unsigned* bar = b.bar;
        __builtin_amdgcn_s_waitcnt(0);
        unsigned nloc = b.st[0], nx = b.st[1];
        if (nloc == 0u) { xcd_barrier_complete(bar, b.x, nloc, nx); b.st[0] = nloc; b.st[1] = nx; }
        const unsigned old = xb_add(&bar[XB_XSUB(b.x)], 1u);
        const unsigned gen = old / nloc;
        if (old + 1u == (gen + 1u) * nloc) {
            __builtin_amdgcn_fence(__ATOMIC_RELEASE, "agent");
            asm volatile("s_waitcnt vmcnt(0)" ::: "memory");
            const unsigned og = xb_add(&bar[XB_TOP], 1u);
            const unsigned tg = og / nx;
            if (og + 1u == (tg + 1u) * nx) xb_add(&bar[XB_TOPGEN], 1u);
            else XB_SPIN(xb_ld(&bar[XB_TOPGEN]) == tg, bar);
            __builtin_amdgcn_fence(__ATOMIC_ACQUIRE, "agent");
            xb_add(&bar[XB_XGEN(b.x)], 1u);
            asm volatile("s_waitcnt vmcnt(0)" ::: "memory");
        } else {
            XB_SPIN(xb_ld(&bar[XB_XGEN(b.x)]) == gen, bar);
            __builtin_amdgcn_fence(__ATOMIC_ACQUIRE, "agent");
            asm volatile("s_waitcnt vmcnt(0)" ::: "memory");
        }
    }
    __syncthreads();
}

constexpr int LDS_BYTES = 136 * 1024;
constexpr int LDS_BAR_OFF = LDS_BYTES - 16;
__global__ void __launch_bounds__(NT) fwd_megakernel(Params p) {
    extern __shared__ __attribute__((aligned(16))) float lds[];
    const int bid = blockIdx.x, nblk = gridDim.x;
    volatile LAS unsigned* st = (volatile LAS unsigned*)((LAS unsigned char*)lds + LDS_BAR_OFF);
    if (threadIdx.x < 4) st[threadIdx.x] = 0u;
    __syncthreads();
    XcdBarrier bar = xcd_barrier_post((unsigned*)(p.ws + OFF_CTL) + CW_BAR, st);
    phase_prep(p, bid, nblk, lds);      xcd_barrier(bar);
    phase_proj(p, bid, nblk, lds);      xcd_barrier(bar);
    phase_poolmean(p, bid, nblk, lds);
    phase_gla1(p, bid, nblk, lds);      xcd_barrier(bar);
    phase_pool(p, bid, nblk, lds);
    phase_gla2(p, bid, nblk, lds);      xcd_barrier(bar);
    phase_gla3(p, bid, nblk, lds);      xcd_barrier(bar);
    phase_out(p, bid, nblk, lds);       xcd_barrier(bar);
    phase_route(p, bid, nblk, lds);     xcd_barrier(bar);
    phase_e1(p, bid, nblk, lds);        xcd_barrier(bar);
    phase_e2(p, bid, nblk, lds);        xcd_barrier(bar);
    phase_combine(p, bid, nblk, lds);
}

extern "C" void kernel_launch(void* const* d_in, const int* in_sizes, int n_in, void* d_out, int out_size, void* d_ws, size_t ws_size, hipStream_t stream) {
    static int grid = 0;
    if (grid == 0) {
        if (n_in != 20 || ws_size < WS_NEED) { fprintf(stderr, "kernel_launch: unexpected n_in %d or ws_size %zu (< %zu)\n", n_in, ws_size, (size_t)WS_NEED); grid = -1; return; }
        int dev = 0, cus = 0, per_cu = 0;
        (void)hipGetDevice(&dev); (void)hipDeviceGetAttribute(&cus, hipDeviceAttributeMultiprocessorCount, dev);
        (void)hipFuncSetAttribute((const void*)fwd_megakernel, hipFuncAttributeMaxDynamicSharedMemorySize, LDS_BYTES);
        (void)hipOccupancyMaxActiveBlocksPerMultiprocessor(&per_cu, (const void*)fwd_megakernel, NT, LDS_BYTES);
        if (per_cu < 1 || cus < 1) { fprintf(stderr, "kernel_launch: occupancy query says %d blocks/CU on %d CUs\n", per_cu, cus); grid = -1; return; }
        grid = cus;
    }
    if (grid < 0) return;
    (void)hipMemsetAsync((char*)d_ws + OFF_CTL, 0, 64 * 1024, stream);
    Params p{};
    const float** pp = (const float**)&p;
    for (int i = 0; i < 20; ++i) pp[i] = (const float*)d_in[i];
    p.out = (float*)d_out; p.ws = (unsigned char*)d_ws;
    void* args[] = {&p};
    hipError_t e = hipLaunchCooperativeKernel((const void*)fwd_megakernel, dim3(grid), dim3(NT), args, LDS_BYTES, stream);
    if (e != hipSuccess) fprintf(stderr, "cooperative launch failed: %s (grid %d)\n", hipGetErrorString(e), grid);
}
```

```cpp
#include <hip/hip_runtime.h>
#include <stdint.h>
#include <cstdio>

#define DI __device__ __forceinline__
typedef unsigned short bf16_t;

constexpr int T = 16384, D = 1024, SEQ = 4096;
constexpr int DIN = 2064, NPROJ = 2048;
constexpr int P_OFF = 0, Q_OFF = 512, K_OFF = 768, V_OFF = 1024, R_OFF = 1536, GL_OFF = 2048;
constexpr int SC = 64;
constexpr int NSC = SEQ / SC;
constexpr int NE = 256, TOPK = 8, EDIM = 256;
constexpr int A_TOT = T * TOPK;
constexpr int LCAP = T;
constexpr float ALPHA = 1.189207115002721f;
constexpr float LN_EPS = 1e-5f, RMS_EPS = 1e-5f;
constexpr int NT = 512;

constexpr size_t MiB = 1u << 20;
constexpr size_t OFF_CTL = 0;
constexpr size_t OFF_XB = 1 * MiB;
constexpr size_t OFF_GLOW = OFF_XB + 32 * MiB;
constexpr size_t OFF_PROJ = OFF_GLOW + 1 * MiB;
constexpr size_t OFF_G = OFF_PROJ + 64 * MiB;
constexpr size_t OFF_SLOC = OFF_G + 16 * MiB;
constexpr size_t OFF_DEC = OFF_SLOC + 32 * MiB;
constexpr size_t OFF_SIN = OFF_DEC + 1 * MiB;
constexpr size_t OFF_MIX = OFF_SIN + 32 * MiB;
constexpr size_t OFF_H32 = OFF_MIX + 32 * MiB;
constexpr size_t OFF_HB = OFF_H32 + 64 * MiB;
constexpr size_t OFF_SCORES = OFF_HB + 32 * MiB;
constexpr size_t OFF_WBUF = OFF_SCORES + 16 * MiB;
constexpr size_t OFF_LIST = OFF_WBUF + 1 * MiB;
constexpr size_t OFF_HID = OFF_LIST + 16 * MiB;
constexpr size_t OFF_Y = OFF_HID + 76 * MiB;
constexpr size_t OFF_PM = OFF_Y + 304 * MiB;
constexpr size_t OFF_WB_IN = OFF_PM + 16 * MiB;
constexpr size_t OFF_WB_OUT = OFF_WB_IN + 4 * MiB;
constexpr size_t OFF_WB_RT = OFF_WB_OUT + 2 * MiB;
constexpr size_t OFF_WB_SGU = OFF_WB_RT + 1 * MiB;
constexpr size_t OFF_WB_SD = OFF_WB_SGU + 1 * MiB;
constexpr size_t WS_NEED = OFF_WB_SD + 1 * MiB;
constexpr int CW_CNT = 1024;

struct Params {
    const float *x, *w_in, *gate_w2, *gate_b, *norm_w, *pool_w, *pool_scale, *w_out, *ln1_g, *ln1_b;
    const float *router_w, *router_bias, *wg, *wu, *wd, *sg, *su, *sd, *ln2_g, *ln2_b;
    float* out;
    unsigned char* ws;
};

DI float bf2f(bf16_t v) { return __uint_as_float(((unsigned)v) << 16); }
DI bf16_t f2bf(float f) { unsigned u = __float_as_uint(f); u += 0x7fffu + ((u >> 16) & 1u); return (bf16_t)(u >> 16); }
DI unsigned pk2(float lo, float hi) { return (unsigned)f2bf(lo) | ((unsigned)f2bf(hi) << 16); }
DI float wave_sum(float v) {
#pragma unroll
    for (int o = 1; o < 64; o <<= 1) v += __shfl_xor(v, o);
    return v;
}
DI float sigmoidf_(float v) { return __builtin_amdgcn_rcpf(1.f + __expf(-v)); }
DI float logsigmoidf_(float z) { return fminf(z, 0.f) - log1pf(__expf(-fabsf(z))); }

constexpr int GT_LDS_FLOATS = 16 * 132 + 2 * 16 * 68;
template <bool DUAL, class AF, class BF, class EPI>
DI void gemm_tile_valu(int K, const AF& af, const BF& bfn, const EPI& epi, float* lds) {
    float* As = lds; float* Bs = lds + 16 * 132; float* Bs2 = Bs + 16 * 68;
    const int tid = threadIdx.x, ty = tid >> 4, tx = tid & 15;
    float acc[4][4], acc2[4][4];
#pragma unroll
    for (int i = 0; i < 4; ++i)
#pragma unroll
        for (int j = 0; j < 4; ++j) { acc[i][j] = 0.f; acc2[i][j] = 0.f; }
    for (int k0 = 0; k0 < K; k0 += 16) {
#pragma unroll
        for (int i = 0; i < 4; ++i) { const int e = tid + 512 * i, r = e >> 4, kk = e & 15; As[kk * 132 + r] = af(r, k0 + kk); }
#pragma unroll
        for (int i = 0; i < 2; ++i) { const int e = tid + 512 * i, kk = e >> 6, c = e & 63; Bs[kk * 68 + c] = bfn(0, k0 + kk, c); if (DUAL) Bs2[kk * 68 + c] = bfn(1, k0 + kk, c); }
        __syncthreads();
#pragma unroll
        for (int kk = 0; kk < 16; ++kk) {
            const float4 a = *(const float4*)&As[kk * 132 + ty * 4];
            const float4 b = *(const float4*)&Bs[kk * 68 + tx * 4];
            const float av[4] = {a.x, a.y, a.z, a.w}, bv[4] = {b.x, b.y, b.z, b.w};
#pragma unroll
            for (int i = 0; i < 4; ++i)
#pragma unroll
                for (int j = 0; j < 4; ++j) acc[i][j] += av[i] * bv[j];
            if (DUAL) {
                const float4 b2 = *(const float4*)&Bs2[kk * 68 + tx * 4];
                const float b2v[4] = {b2.x, b2.y, b2.z, b2.w};
#pragma unroll
                for (int i = 0; i < 4; ++i)
#pragma unroll
                    for (int j = 0; j < 4; ++j) acc2[i][j] += av[i] * b2v[j];
            }
        }
        __syncthreads();
    }
#pragma unroll
    for (int i = 0; i < 4; ++i)
#pragma unroll
        for (int j = 0; j < 4; ++j) epi(ty * 4 + i, tx * 4 + j, acc[i][j], acc2[i][j]);
}


typedef __bf16 bf16x8 __attribute__((ext_vector_type(8)));
typedef __bf16 bf16x4 __attribute__((ext_vector_type(4)));
typedef short s16x4 __attribute__((ext_vector_type(4)));
typedef float f32x4 __attribute__((ext_vector_type(4)));
typedef unsigned u32x4 __attribute__((ext_vector_type(4)));
#define LAS3 __attribute__((address_space(3)))
DI const float* uniform_ptr(const float* p) {
    const unsigned long long v = (unsigned long long)p;
    const unsigned lo = __builtin_amdgcn_readfirstlane((unsigned)v), hi = __builtin_amdgcn_readfirstlane((unsigned)(v >> 32));
    return (const float*)(((unsigned long long)hi << 32) | lo);
}
#define MFMA16(a, b, c) __builtin_amdgcn_mfma_f32_16x16x32_bf16((a), (b), (c), 0, 0, 0)
constexpr int GEMM_LDS_BYTES = 131072;
DI unsigned a_swz(unsigned x) { return (0x78u >> (2u * x)) & 3u; }
struct GemmRegs { u32x4 ra[2][2], rb[2][4]; };
template <bool DUAL, bool BK16, int OUTB, int LDB, int WN, class RowFn, class RowFnN, class Pre, class Fin>
DI void gemm_core(u32x4 (&Rra)[2][2], u32x4 (&Rrb)[2][4], unsigned (&aoffc)[2], bool preloaded, const bf16_t* Ab, const RowFn& rowoff, const float* B0, const float* B1, unsigned bbytes, int K, int rows,
                  bool has_next, const RowFnN& rowoff_n, const float* B0n, const float* B1n, unsigned bbytes_n, int rows_n, const Pre& pre, const Fin& fin, unsigned char* lds) {
    int tid_ = threadIdx.x; asm volatile("" : "+v"(tid_));
    const int tid = tid_, lane = tid & 63, w = __builtin_amdgcn_readfirstlane(tid >> 6), wm = w >> 2, wn = w & 3, l15 = lane & 15, kg = lane >> 4, t256 = tid & 255;
    const bool active = wn < WN;
    const int nrow_w = min(max(rows - 128 * wm, 0), 128), ngrp = (((nrow_w + 15) >> 4) + 1) >> 1;
    unsigned aoff[2];
#pragma unroll
    for (int i = 0; i < 2; ++i) aoff[i] = preloaded ? aoffc[i] : (rowoff(min(128 * wm + (t256 >> 2) + 64 * i, rows - 1)) + (t256 & 3) * 8) * 2u;
    const __amdgpu_buffer_rsrc_t ar = __builtin_amdgcn_make_buffer_rsrc((void*)Ab, 0, 0x7fffffff, 0x00020000);
    const unsigned awr = (128 * wm + (t256 >> 2)) * 128 + ((((unsigned)(t256 & 3)) ^ (unsigned)((t256 >> 3) & 7) ^ (unsigned)(t256 & 4)) << 4);
    constexpr int NB = BK16 ? 2 : 4;
    const float* bsrc = uniform_ptr(DUAL && !BK16 ? ((wn >> 1) ? B1 : B0) : B0);
    const __amdgpu_buffer_rsrc_t br = __builtin_amdgcn_make_buffer_rsrc((void*)bsrc, 0, bbytes, 0x00020000);
    const unsigned bvoff = BK16 ? (unsigned)(((lane >> 5) * LDB + (lane & 31) * 8) * 2) : (DUAL ? (unsigned)(((lane >> 5) * LDB + (lane & 31) * 4) * 4) : (unsigned)(lane * 16));
    const int krow0 = BK16 ? 16 * wm + 2 * wn : (DUAL ? 16 * wm + 8 * (wn & 1) : 16 * wm + wn);
    constexpr int KSTEP = BK16 ? 8 : (DUAL ? 2 : 4), ESZ = BK16 ? 2 : 4;
    unsigned aoff_n[2];
#pragma unroll
    for (int i = 0; i < 2; ++i) aoff_n[i] = has_next ? (rowoff_n(min(128 * wm + (t256 >> 2) + 64 * i, rows_n - 1)) + (t256 & 3) * 8) * 2u : aoff[i];
    const float* bsrc_n = uniform_ptr(has_next ? (DUAL && !BK16 ? ((wn >> 1) ? B1n : B0n) : B0n) : bsrc);
    const __amdgpu_buffer_rsrc_t br_n = __builtin_amdgcn_make_buffer_rsrc((void*)bsrc_n, 0, has_next ? bbytes_n : bbytes, 0x00020000);
    unsigned bwr[NB];
#pragma unroll
    for (int i = 0; i < NB; ++i) {
        const int kb = krow0 + KSTEP * i + ((BK16 || DUAL) ? (lane >> 5) : 0);
        const int n = BK16 ? 8 * (lane & 31) : (DUAL ? (wn >> 1) * 128 + 4 * (lane & 31) : 4 * lane);
        const unsigned I = n >> 7, ch = (n & 127) >> 3, half = BK16 ? 0u : (unsigned)((n >> 2) & 1), xx = ((kb & 3) << 2) | ((kb >> 2) & 3);
        bwr[i] = 32768u + I * 16384u + 256u * kb + 16u * (ch ^ xx) + 8u * half;
    }
    const unsigned ard = (128 * wm + l15) * 128 + ((((unsigned)kg) ^ (unsigned)((l15 >> 1) & 7) ^ (unsigned)((l15 & 1) << 2)) << 4);
    unsigned trd0, trd1;
    {
        const unsigned q = l15 >> 2, pp = l15 & 3, cbase = (DUAL ? 4u * wn : 8u * (wn & 1)) + (pp >> 1), ibase = DUAL ? 0u : (unsigned)(wn >> 1);
        const unsigned x0 = (q << 2) | ((2u * kg) & 3u), x1 = (q << 2) | ((2u * kg + 1u) & 3u);
        trd0 = 32768u + ibase * 16384u + 256u * (8u * kg + q) + 16u * (cbase ^ x0) + 8u * (pp & 1);
        trd1 = 32768u + ibase * 16384u + 256u * (8u * kg + 4u + q) + 16u * (cbase ^ x1) + 8u * (pp & 1);
    }
    f32x4 acc[8][4];
#pragma unroll
    for (int i = 0; i < 8; ++i)
#pragma unroll
        for (int f = 0; f < 4; ++f) acc[i][f] = (f32x4){0.f, 0.f, 0.f, 0.f};
    const int nj = K / 32;
#define LOAD_SET(S, j) { _Pragma("unroll") for (int i = 0; i < 2; ++i) Rra[S][i] = __builtin_bit_cast(u32x4, __builtin_amdgcn_raw_buffer_load_b128(ar, aoff[S], ((j) >> 1) * 128 + i * 64, 0)); \
        _Pragma("unroll") for (int i = 0; i < NB; ++i) Rrb[S][i] = __builtin_bit_cast(u32x4, __builtin_amdgcn_raw_buffer_load_b128(br, bvoff, ((j) * 32 + krow0 + KSTEP * i) * (LDB * ESZ), 0)); }
#define LOAD_SET_N(S, j) { _Pragma("unroll") for (int i = 0; i < 2; ++i) Rra[S][i] = __builtin_bit_cast(u32x4, __builtin_amdgcn_raw_buffer_load_b128(ar, aoff_n[S], ((j) >> 1) * 128 + i * 64, 0)); \
        _Pragma("unroll") for (int i = 0; i < NB; ++i) Rrb[S][i] = __builtin_bit_cast(u32x4, __builtin_amdgcn_raw_buffer_load_b128(br_n, bvoff, ((j) * 32 + krow0 + KSTEP * i) * (LDB * ESZ), 0)); }
#define WRITE_SET(S, st, h) { _Pragma("unroll") for (int i = 0; i < 2; ++i) *(u32x4*)(lds + (st) * 65536 + (awr ^ (i ? 64u : 0u)) + (S) * 8192) = Rra[S][i]; \
        _Pragma("unroll") for (int i = 0; i < NB; ++i) { if (BK16) *(u32x4*)(lds + (st) * 65536 + (h) * 8192 + bwr[i]) = Rrb[S][i]; else { \
            const f32x4 v = __builtin_bit_cast(f32x4, Rrb[S][i]); bf16x4 o; o[0] = (__bf16)v[0]; o[1] = (__bf16)v[1]; o[2] = (__bf16)v[2]; o[3] = (__bf16)v[3]; \
            *(bf16x4*)(lds + (st) * 65536 + (h) * 8192 + ((!DUAL) ? ((bwr[0] ^ (unsigned)(i << 4)) + 1024u * i) : bwr[i])) = o; } } }
#define LOAD_SEL(S, jl) { const bool nx_ = (jl) >= nj; const int jt_ = nx_ ? (jl) - nj : (jl); \
        _Pragma("unroll") for (int i = 0; i < 2; ++i) Rra[S][i] = __builtin_bit_cast(u32x4, __builtin_amdgcn_raw_buffer_load_b128(ar, nx_ ? aoff_n[S] : aoff[S], (jt_ >> 1) * 128 + i * 64, 0)); \
        if (nx_) { _Pragma("unroll") for (int i = 0; i < NB; ++i) Rrb[S][i] = __builtin_bit_cast(u32x4, __builtin_amdgcn_raw_buffer_load_b128(br_n, bvoff, (jt_ * 32 + krow0 + KSTEP * i) * (LDB * ESZ), 0)); } \
        else { _Pragma("unroll") for (int i = 0; i < NB; ++i) Rrb[S][i] = __builtin_bit_cast(u32x4, __builtin_amdgcn_raw_buffer_load_b128(br, bvoff, (jt_ * 32 + krow0 + KSTEP * i) * (LDB * ESZ), 0)); } }
#define WRITE_A(S, st, h) { _Pragma("unroll") for (int i = 0; i < 2; ++i) *(u32x4*)(lds + (st) * 65536 + (awr ^ (i ? 64u : 0u)) + (S) * 8192) = Rra[S][i]; }
#define WRITE_B(S, st, h, I0, I1) { _Pragma("unroll") for (int i = (I0); i < (I1); ++i) { if (BK16) *(u32x4*)(lds + (st) * 65536 + (h) * 8192 + bwr[i]) = Rrb[S][i]; else { \
            const f32x4 v = __builtin_bit_cast(f32x4, Rrb[S][i]); bf16x4 o; o[0] = (__bf16)v[0]; o[1] = (__bf16)v[1]; o[2] = (__bf16)v[2]; o[3] = (__bf16)v[3]; \
            *(bf16x4*)(lds + (st) * 65536 + (h) * 8192 + ((!DUAL) ? ((bwr[0] ^ (unsigned)(i << 4)) + 1024u * i) : bwr[i])) = o; } } }
#define LOAD_A(S, jl) { const bool nx_ = (jl) >= nj; const int jt_ = nx_ ? (jl) - nj : (jl); \
        _Pragma("unroll") for (int i = 0; i < 2; ++i) Rra[S][i] = __builtin_bit_cast(u32x4, __builtin_amdgcn_raw_buffer_load_b128(ar, nx_ ? aoff_n[S] : aoff[S], (jt_ >> 1) * 128 + i * 64, 0)); }
#define LOAD_B(S, jl) { const bool nx_ = (jl) >= nj; const int jt_ = nx_ ? (jl) - nj : (jl); \
        if (nx_) { _Pragma("unroll") for (int i = 0; i < NB; ++i) Rrb[S][i] = __builtin_bit_cast(u32x4, __builtin_amdgcn_raw_buffer_load_b128(br_n, bvoff, (jt_ * 32 + krow0 + KSTEP * i) * (LDB * ESZ), 0)); } \
        else { _Pragma("unroll") for (int i = 0; i < NB; ++i) Rrb[S][i] = __builtin_bit_cast(u32x4, __builtin_amdgcn_raw_buffer_load_b128(br, bvoff, (jt_ * 32 + krow0 + KSTEP * i) * (LDB * ESZ), 0)); } }
#define TF_LOAD(dst, st, h, g) { _Pragma("unroll") for (int q_ = 0; q_ < 2; ++q_) dst[q_] = *(const bf16x8*)(lds + (st) * 65536 + ((g) * 2 + q_) * 2048 + (ard ^ ((h) ? 64u : 0u))); }
#define WF_LOAD(st, h) { _Pragma("unroll") for (int f = 0; f < 4; ++f) { \
        const unsigned fx = DUAL ? ((f & 1) << 5) : (f << 5), fo = (DUAL ? (f >> 1) * 16384 : 0) + (st) * 65536 + (h) * 8192; \
        const s16x4 lo = __builtin_amdgcn_ds_read_tr16_b64_v4i16((LAS3 s16x4*)(lds + ((trd0 ^ fx) + fo))); \
        const s16x4 hi = __builtin_amdgcn_ds_read_tr16_b64_v4i16((LAS3 s16x4*)(lds + ((trd1 ^ fx) + fo))); \
        wf[f] = __builtin_bit_cast(bf16x8, __builtin_shufflevector(lo, hi, 0, 1, 2, 3, 4, 5, 6, 7)); } }
#define STAGE_MMA(srcf, g) { _Pragma("unroll") for (int q_ = 0; q_ < 2; ++q_) _Pragma("unroll") for (int f = 0; f < 4; ++f) acc[(g) * 2 + q_][f] = MFMA16(wf[f], srcf[q_], acc[(g) * 2 + q_][f]); }
#define STAGE(st, h, g, cur, nxt) if ((g) < ngrp) { \
        if ((g) + 1 < 4 && (g) + 1 < ngrp) TF_LOAD(nxt, st, h, (g) + 1) \
        __builtin_amdgcn_sched_barrier(0); \
        STAGE_MMA(cur, g) \
        __builtin_amdgcn_sched_barrier(0); }
    const bool comp = active && ngrp > 0;
    bf16x8 fa[2], fb[2], wf[4];
#define HALF_MMA(st, h) if (comp) { STAGE(st, h, 0, fa, fb) STAGE(st, h, 1, fb, fa) STAGE(st, h, 2, fa, fb) STAGE(st, h, 3, fb, fa) }
#define SLOT(st, h, g, cur, nxt, PIECE) { if (comp && (g) < ngrp) { if ((g) + 1 < 4 && (g) + 1 < ngrp) TF_LOAD(nxt, st, h, (g) + 1) } \
        PIECE \
        __builtin_amdgcn_sched_barrier(0); \
        if (comp && (g) < ngrp) { STAGE_MMA(cur, g) } \
        __builtin_amdgcn_sched_barrier(0); }
#define HALF_SLOTS(st, h, S, jl) { SLOT(st, h, 0, fa, fb, WRITE_A(S, (st) ^ 1, h) LOAD_A(S, jl)) SLOT(st, h, 1, fb, fa, WRITE_B(S, (st) ^ 1, h, 0, NB / 2)) \
        SLOT(st, h, 2, fa, fb, WRITE_B(S, (st) ^ 1, h, NB / 2, NB)) SLOT(st, h, 3, fb, fa, LOAD_B(S, jl)) }
#define PREFETCH(st, h) if (comp) { WF_LOAD(st, h) TF_LOAD(fa, st, h, 0) }
    const int nJ = K / 64;
    if (!preloaded) { LOAD_SET(0, 0) LOAD_SET(1, 1) }
    WRITE_SET(0, 0, 0) WRITE_SET(1, 0, 1)
    LOAD_SEL(0, 2) LOAD_SEL(1, 3)
    __syncthreads();
    int st = 0;
#pragma unroll 1
    for (int J = 0; J < nJ - 1; ++J) {
        PREFETCH(st, 0)
        HALF_SLOTS(st, 0, 0, 2 * J + 4)
        PREFETCH(st, 1)
        HALF_SLOTS(st, 1, 1, 2 * J + 5)
        __syncthreads();
        st ^= 1;
    }
    {
        PREFETCH(st, 0)
        HALF_MMA(st, 0)
        PREFETCH(st, 1)
        HALF_MMA(st, 1)
        __syncthreads();
    }
#undef HALF_MMA
#undef SLOT
#undef HALF_SLOTS
#undef WRITE_A
#undef WRITE_B
#undef LOAD_A
#undef LOAD_B
#undef PREFETCH
#undef LOAD_SET
#undef LOAD_SET_N
#undef LOAD_SEL
#undef WRITE_SET
#undef TF_LOAD
#undef WF_LOAD
#undef STAGE_MMA
#undef STAGE
    aoffc[0] = aoff_n[0]; aoffc[1] = aoff_n[1];
    {
        constexpr int NF = DUAL ? 2 : 4, ROWB = NF * 16 * OUTB, NCH = ROWB / 16, RPR = (8192 / ROWB) < 128 ? (8192 / ROWB) : 128, RPI = 64 / NCH, NROUND = 128 / RPR;
        constexpr float FP8_SCALE = 128.f;
        unsigned char* stg = lds + w * 8192;
        int l15e = l15; asm volatile("" : "+v"(l15e));
        const int colbase = (DUAL ? 32 : 64) * wn;
#pragma unroll
        for (int rd = 0; rd < NROUND; ++rd) {
            if (active) {
#pragma unroll
                for (int mt = rd * (RPR / 16); mt < (rd + 1) * (RPR / 16); ++mt) {
                    if ((mt >> 1) < ngrp) {
                        const int rloc = mt * 16 - rd * RPR + l15e, row = 128 * wm + mt * 16 + l15e;
#pragma unroll
                        for (int f = 0; f < NF; ++f) {
                            const f32x4 v = DUAL ? pre(row, colbase + 16 * f + 4 * kg, acc[mt][f], acc[mt][f + 2]) : pre(row, colbase + 16 * f + 4 * kg, acc[mt][f], acc[mt][f]);
                            if (OUTB == 4) *(f32x4*)(stg + rloc * ROWB + ((((unsigned)(4 * f + kg)) ^ (unsigned)(rloc & (NCH - 1))) << 4)) = v;
                            else if (OUTB == 2) { bf16x4 o; o[0] = (__bf16)v[0]; o[1] = (__bf16)v[1]; o[2] = (__bf16)v[2]; o[3] = (__bf16)v[3];
                                *(bf16x4*)(stg + rloc * ROWB + ((((unsigned)(2 * f + (kg >> 1))) ^ (unsigned)(rloc & (NCH - 1))) << 4) + 8 * (kg & 1)) = o; }
                            else { int pk = 0; pk = __builtin_amdgcn_cvt_pk_fp8_f32(v[0] * FP8_SCALE, v[1] * FP8_SCALE, pk, false); pk = __builtin_amdgcn_cvt_pk_fp8_f32(v[2] * FP8_SCALE, v[3] * FP8_SCALE, pk, true);
                                *(int*)(stg + rloc * ROWB + ((((unsigned)f) ^ (unsigned)(rloc & (NCH - 1))) << 4) + 4 * kg) = pk; }
                        }
                    }
                }
                asm volatile("s_waitcnt lgkmcnt(0)" ::: "memory");
#pragma unroll
                for (int it = 0; it < RPR / RPI; ++it) {
                    const int rloc = it * RPI + lane / NCH, c = lane % NCH, row = 128 * wm + rd * RPR + rloc;
                    const u32x4 dv = *(const u32x4*)(stg + rloc * ROWB + ((((unsigned)c) ^ (unsigned)(rloc & (NCH - 1))) << 4));
                    if (row < rows) fin(row, colbase + c * (16 / OUTB), dv);
                }
                asm volatile("s_waitcnt lgkmcnt(0)" ::: "memory");
            }
        }
    }
    __syncthreads();
}

template <bool DUAL, bool BK16, int OUTB, int LDB, int WN, class RowFn, class Pre, class Fin>
DI void gemm_mfma(const bf16_t* Ab, const RowFn& rowoff, const float* B0, const float* B1, unsigned bbytes, int K, int rows, const Pre& pre, const Fin& fin, unsigned char* lds) {
    u32x4 ra[2][2], rb[2][4]; unsigned ao[2] = {0u, 0u};
    gemm_core<DUAL, BK16, OUTB, LDB, WN>(ra, rb, ao, false, Ab, rowoff, B0, B1, bbytes, K, rows, false, rowoff, B0, B1, bbytes, rows, pre, fin, lds);
}
#define PRE_ID [](int, int, f32x4 v, f32x4) { return v; }

DI void phase_prep(const Params& p, int bid, int nblk, float* lds) {
    const int tid = threadIdx.x, lane = tid & 63, wave = tid >> 6;
    bf16_t* xb = (bf16_t*)(p.ws + OFF_XB); float* glow = (float*)(p.ws + OFF_GLOW);
    float tw = 0.f;
    {
        const int ti = (bid >> 3) * NT + tid;
        if (ti < 1536) { const int m = ti >> 9, j = ti & 511; const float* bp = m == 0 ? p.wg : (m == 1 ? p.wu : p.wd); tw = bp[(size_t)j * 131072]; }
    }
    f32x4* Wl = (f32x4*)lds;
    for (int idx = tid; idx < 4096; idx += NT) {
        const int k = idx >> 2, q = idx & 3, ln = (k >> 2) & 63, j = k >> 8, c = k & 3;
        Wl[((j * 4 + c) * 4 + q) * 64 + ln] = *(const f32x4*)(p.w_in + (size_t)k * DIN + GL_OFF + 4 * q);
    }
    __syncthreads();
    for (int row0 = (bid * 8 + wave) * 4; row0 < T; row0 += nblk * 32) {
        asm volatile("" ::: "memory");
        f32x4 xv[4][4];
#pragma unroll
        for (int r = 0; r < 4; ++r)
#pragma unroll
            for (int j = 0; j < 4; ++j) {
                xv[r][j] = ((const f32x4*)(p.x + (size_t)(row0 + r) * D))[lane + 64 * j];
                uint2 o; o.x = pk2(xv[r][j][0], xv[r][j][1]); o.y = pk2(xv[r][j][2], xv[r][j][3]);
                ((uint2*)(xb + (size_t)(row0 + r) * D))[lane + 64 * j] = o;
            }
        float acc[4][16];
#pragma unroll
        for (int r = 0; r < 4; ++r)
#pragma unroll
            for (int n = 0; n < 16; ++n) acc[r][n] = 0.f;
#pragma unroll
        for (int j = 0; j < 4; ++j)
#pragma unroll
            for (int c = 0; c < 4; ++c) {
                float wv[16];
#pragma unroll
                for (int q = 0; q < 4; ++q) { const f32x4 w4 = Wl[((j * 4 + c) * 4 + q) * 64 + lane]; wv[4 * q] = w4[0]; wv[4 * q + 1] = w4[1]; wv[4 * q + 2] = w4[2]; wv[4 * q + 3] = w4[3]; }
#pragma unroll
                for (int r = 0; r < 4; ++r) {
                    const float xs = xv[r][j][c];
#pragma unroll
                    for (int n = 0; n < 16; ++n) acc[r][n] += xs * wv[n];
                }
            }
#define RS_STEP(N, OFF) { const bool up = (lane & (OFF)) != 0; _Pragma("unroll") for (int i = 0; i < (N); ++i) { \
            const float a = acc[i / 16][i % 16], b = acc[(i + (N)) / 16][(i + (N)) % 16]; const float snd = up ? a : b, kp = up ? b : a; \
            acc[i / 16][i % 16] = kp + __shfl_xor(snd, (OFF)); } }
        RS_STEP(32, 32) RS_STEP(16, 16) RS_STEP(8, 8) RS_STEP(4, 4) RS_STEP(2, 2) RS_STEP(1, 1)
#undef RS_STEP
        glow[(size_t)row0 * 16 + lane] = acc[0][0];
    }
    {
        bf16_t* wbin = (bf16_t*)(p.ws + OFF_WB_IN); bf16_t* wbout = (bf16_t*)(p.ws + OFF_WB_OUT); bf16_t* wbrt = (bf16_t*)(p.ws + OFF_WB_RT);
        bf16_t* wbsgu = (bf16_t*)(p.ws + OFF_WB_SGU); bf16_t* wbsd = (bf16_t*)(p.ws + OFF_WB_SD);
        constexpr int N_IN = 1024 * 512, N_OUT = 1024 * 256, N_RT = 1024 * 64, N_SGU = 1024 * 128, N_SD = 256 * 256;
        for (int it = bid * NT + tid; it < N_IN + N_OUT + N_RT + N_SGU + N_SD; it += nblk * NT) {
            const float* s; bf16_t* d; int r = it;
            if (r < N_IN) { const int k = r >> 9, c = (r & 511) * 4; s = p.w_in + (size_t)k * DIN + c; d = wbin + (size_t)k * 2048 + c; }
            else if ((r -= N_IN) < N_OUT) { s = p.w_out + (size_t)r * 4; d = wbout + (size_t)r * 4; }
            else if ((r -= N_OUT) < N_RT) { s = p.router_w + (size_t)r * 4; d = wbrt + (size_t)r * 4; }
            else if ((r -= N_RT) < N_SGU) { const int k = r >> 7, c = (r & 127) * 4, nt = c >> 8, h = (c >> 7) & 1, cc = c & 127; s = (h ? p.su : p.sg) + (size_t)k * EDIM + nt * 128 + cc; d = wbsgu + (size_t)k * 512 + c; }
            else { r -= N_SGU; s = p.sd + (size_t)r * 4; d = wbsd + (size_t)r * 4; }
            const f32x4 v = *(const f32x4*)s; uint2 o; o.x = pk2(v[0], v[1]); o.y = pk2(v[2], v[3]); *(uint2*)d = o;
        }
    }
    asm volatile("" :: "v"(tw));
    __syncthreads();
}

DI void phase_proj(const Params& p, int bid, int nblk, float* lds) {
    const bf16_t* xb = (const bf16_t*)(p.ws + OFF_XB); bf16_t* proj = (bf16_t*)(p.ws + OFF_PROJ); const bf16_t* wbin = (const bf16_t*)(p.ws + OFF_WB_IN);
    u32x4 ra[2][2], rb[2][4]; unsigned ao[2] = {0u, 0u}; bool pre = false;
    const bool xl = (nblk == 256);
    for (int u = bid; u < 64 * 8; u += nblk) {
        const int un = u + nblk; const bool hn = un < 64 * 8;
        const int mt = xl ? 32 * (u >> 8) + 4 * (u & 7) + ((u & 255) >> 6) : u >> 3, nt = xl ? ((u & 255) >> 3) & 7 : u & 7;
        const int mtn = xl ? 32 * (un >> 8) + 4 * (un & 7) + ((un & 255) >> 6) : un >> 3, ntn = xl ? ((un & 255) >> 3) & 7 : un & 7;
        auto rowoff = [&](int r) { return (unsigned)((mt * 256 + r) * D); };
        auto rowoff_n = [&](int r) { return (unsigned)((mtn * 256 + r) * D); };
        auto fin = [&](int r, int c, u32x4 dv) { *(u32x4*)(proj + (size_t)(mt * 256 + r) * NPROJ + nt * 256 + c) = dv; };
        gemm_core<false, true, 2, NPROJ, 4>(ra, rb, ao, pre, xb, rowoff, (const float*)(wbin + nt * 256), nullptr, (unsigned)(((size_t)D * NPROJ - nt * 256) * 2), D, 256,
                                 hn, rowoff_n, (const float*)(wbin + ntn * 256), nullptr, (unsigned)(((size_t)D * NPROJ - ntn * 256) * 2), 256, PRE_ID, fin, (unsigned char*)lds);
        pre = hn;
    }
}

template <int W>
DI void poolmean_item(const bf16_t* proj, bf16_t* pm, int t0, int c2) {
    const int s0 = t0 & (SEQ - 1);
    float p0[48], p1[48]; unsigned raw[32];
    p0[0] = 0.f; p1[0] = 0.f;
#pragma unroll
    for (int i = 0; i < 47; ++i) {
        unsigned v = 0u;
        if (i >= 15 || s0 > 0) v = *(const unsigned*)(proj + (size_t)(t0 - 15 + i) * NPROJ + P_OFF + c2);
        if (i >= 15) raw[i - 15] = v;
        p0[i + 1] = p0[i] + __uint_as_float(v << 16); p1[i + 1] = p1[i] + __uint_as_float(v & 0xffff0000u);
    }
#pragma unroll
    for (int i = 0; i < 32; ++i) {
        const int s = s0 + i; const float inv = 1.f / (float)min(s + 1, W);
        const float m0 = (p0[i + 16] - p0[i + 16 - W]) * inv - __uint_as_float(raw[i] << 16);
        const float m1 = (p1[i + 16] - p1[i + 16 - W]) * inv - __uint_as_float(raw[i] & 0xffff0000u);
        *(unsigned*)(pm + (size_t)(t0 + i) * 512 + c2) = pk2(m0, m1);
    }
}
DI void phase_poolmean(const Params& p, int bid, int nblk, float* lds) {
    const bf16_t* proj = (const bf16_t*)(p.ws + OFF_PROJ); bf16_t* pm = (bf16_t*)(p.ws + OFF_PM);
    for (int item = bid * NT + threadIdx.x; item < 256 * (T / 32); item += nblk * NT) {
        const int pair = item & 255, t0 = (item >> 8) * 32, c2 = pair * 2, g = __builtin_amdgcn_readfirstlane(pair >> 6);
        if (g == 0) poolmean_item<2>(proj, pm, t0, c2);
        else if (g == 1) poolmean_item<4>(proj, pm, t0, c2);
        else if (g == 2) poolmean_item<8>(proj, pm, t0, c2);
        else poolmean_item<16>(proj, pm, t0, c2);
    }
}
DI void phase_pool(const Params& p, int bid, int nblk, float* lds) {
    const bf16_t* pm = (const bf16_t*)(p.ws + OFF_PM); bf16_t* mix = (bf16_t*)(p.ws + OFF_MIX);
    for (int u = bid; u < 64 * 4; u += nblk) {
        const int mt = u >> 2, g = u & 3;
        auto rowoff = [&](int r) { return (unsigned)((mt * 256 + r) * 512 + g * 128); };
        auto pre = [&](int r, int c, f32x4 v, f32x4) { const f32x4 sc = *(const f32x4*)(p.pool_scale + g * 128 + c); return v * sc; };
        auto fin = [&](int r, int c, u32x4 dv) { *(u32x4*)(mix + (size_t)(mt * 256 + r) * D + g * 128 + c) = dv; };
        gemm_mfma<false, false, 2, 128, 2>(pm, rowoff, p.pool_w + (size_t)g * 16384, nullptr, (unsigned)((4 - g) * 16384 * 4), 128, 256, pre, fin, (unsigned char*)lds);
    }
}

DI unsigned f1_off(unsigned row, unsigned chunk) { return row * 128u + ((chunk ^ ((row >> 1) & 7u)) << 4); }
DI unsigned f2_off(unsigned row, unsigned ch) { return 256u * row + 16u * (ch ^ (((row & 3u) << 2) | ((row >> 2) & 3u))); }
DI bf16x8 f1_frag(const unsigned char* img, int tile, int ks, int lane) { return *(const bf16x8*)(img + f1_off(16 * tile + (lane & 15), 4 * ks + (lane >> 4))); }
DI bf16x8 f2_frag(const unsigned char* img, int c, int ks, int lane) {
    const unsigned g = lane >> 4, q = (lane & 15) >> 2, pp = lane & 3;
    const unsigned a0 = f2_off(32 * ks + 8 * g + q, 2 * c + (pp >> 1)) + 8 * (pp & 1), a1 = f2_off(32 * ks + 8 * g + 4 + q, 2 * c + (pp >> 1)) + 8 * (pp & 1);
    const s16x4 lo = __builtin_amdgcn_ds_read_tr16_b64_v4i16((LAS3 s16x4*)(img + a0)), hi = __builtin_amdgcn_ds_read_tr16_b64_v4i16((LAS3 s16x4*)(img + a1));
    return __builtin_bit_cast(bf16x8, __builtin_shufflevector(lo, hi, 0, 1, 2, 3, 4, 5, 6, 7));
}
DI float bfbits2f(unsigned short v) { return __uint_as_float(((unsigned)v) << 16); }
typedef unsigned short u16x8 __attribute__((ext_vector_type(8)));
typedef unsigned short u16x4 __attribute__((ext_vector_type(4)));

DI void phase_gla1(const Params& p, int bid, int nblk, float* ldsf) {
    unsigned char* lds = (unsigned char*)ldsf;
    int tid_ = threadIdx.x; asm volatile("" : "+v"(tid_));
    const int tid = tid_, lane = tid & 63, w = __builtin_amdgcn_readfirstlane(tid >> 6), t = tid >> 3, ch = tid & 7;
    const bf16_t* proj = (const bf16_t*)(p.ws + OFF_PROJ); const float* glow = (const float*)(p.ws + OFF_GLOW);
    float* Gbuf = (float*)(p.ws + OFF_G); float* Sloc = (float*)(p.ws + OFF_SLOC); float* dec = (float*)(p.ws + OFF_DEC);
    float* G = (float*)lds; unsigned char* Kimg = lds + 16384; unsigned char* Vimg = lds + 32768; float* W2l = (float*)(lds + 49152); float* segtot = (float*)(lds + 53248);
    for (int unit = bid; unit < 1024; unit += nblk) {
        const int bh = unit >> 6, n = unit & 63, b = bh >> 2, h = bh & 3, t0 = b * SEQ + n * SC;
        for (int i = tid; i < 1024; i += NT) W2l[i] = p.gate_w2[(i >> 6) * 256 + h * 64 + (i & 63)];
#pragma unroll
        for (int i = 0; i < 2; ++i) { const int idx = tid + NT * i, tr = idx >> 4, c16 = idx & 15;
            *(u32x4*)(Vimg + f2_off(tr, c16)) = *(const u32x4*)(proj + (size_t)(t0 + tr) * NPROJ + V_OFF + h * 128 + 8 * c16); }
        __syncthreads();
        {
            float gl[16];
#pragma unroll
            for (int q = 0; q < 4; ++q) { const f32x4 v = *(const f32x4*)(glow + (size_t)(t0 + t) * 16 + 4 * q); gl[4 * q] = v[0]; gl[4 * q + 1] = v[1]; gl[4 * q + 2] = v[2]; gl[4 * q + 3] = v[3]; }
#pragma unroll
            for (int dd = 0; dd < 8; ++dd) { const int d = 8 * ch + dd; float z = p.gate_b[h * 64 + d];
#pragma unroll
                for (int r = 0; r < 16; ++r) z += gl[r] * W2l[r * 64 + d];
                G[t * 64 + d] = logsigmoidf_(z) * (1.f / 16.f); }
        }
        __syncthreads();
        {
            const int seg = tid >> 6, d = tid & 63; float run = 0.f;
#pragma unroll
            for (int tt = 0; tt < 8; ++tt) { run += G[(8 * seg + tt) * 64 + d]; G[(8 * seg + tt) * 64 + d] = run; }
            segtot[seg * 64 + d] = run;
            __syncthreads();
            float pre = 0.f;
            for (int s2 = 0; s2 < seg; ++s2) pre += segtot[s2 * 64 + d];
#pragma unroll
            for (int tt = 0; tt < 8; ++tt) G[(8 * seg + tt) * 64 + d] += pre;
        }
        __syncthreads();
        {
            const f32x4 g0 = *(const f32x4*)(G + t * 64 + 8 * ch), g1 = *(const f32x4*)(G + t * 64 + 8 * ch + 4);
            const f32x4 l0 = *(const f32x4*)(G + 63 * 64 + 8 * ch), l1 = *(const f32x4*)(G + 63 * 64 + 8 * ch + 4);
            *(f32x4*)(Gbuf + (size_t)(t0 + t) * 256 + h * 64 + 8 * ch) = g0; *(f32x4*)(Gbuf + (size_t)(t0 + t) * 256 + h * 64 + 8 * ch + 4) = g1;
            const u16x8 kv = *(const u16x8*)(proj + (size_t)(t0 + t) * NPROJ + K_OFF + h * 64 + 8 * ch);
            bf16x8 o;
#pragma unroll
            for (int dd = 0; dd < 4; ++dd) { o[dd] = (__bf16)(bfbits2f(kv[dd]) * __expf(l0[dd] - g0[dd])); o[dd + 4] = (__bf16)(bfbits2f(kv[dd + 4]) * __expf(l1[dd] - g1[dd])); }
            *(bf16x8*)(Kimg + f2_off(t, ch)) = o;
            if (t == 63) {
#pragma unroll
                for (int dd = 0; dd < 4; ++dd) { dec[unit * 64 + 8 * ch + dd] = __expf(l0[dd]); dec[unit * 64 + 8 * ch + 4 + dd] = __expf(l1[dd]); }
            }
        }
        __syncthreads();
        {
            f32x4 acc[4];
#pragma unroll
            for (int dt = 0; dt < 4; ++dt) acc[dt] = (f32x4){0.f, 0.f, 0.f, 0.f};
#pragma unroll
            for (int ks = 0; ks < 2; ++ks) {
                const bf16x8 xv = f2_frag(Vimg, w, ks, lane);
#pragma unroll
                for (int dt = 0; dt < 4; ++dt) acc[dt] = MFMA16(xv, f2_frag(Kimg, dt, ks, lane), acc[dt]);
            }
#pragma unroll
            for (int dt = 0; dt < 4; ++dt) *(f32x4*)(Sloc + (size_t)unit * 8192 + (16 * dt + (lane & 15)) * 128 + 16 * w + 4 * (lane >> 4)) = acc[dt];
        }
        __syncthreads();
    }
}

DI void phase_gla2(const Params& p, int bid, int nblk, float* lds) {
    const float* Sloc = (const float*)(p.ws + OFF_SLOC); const float* dec = (const float*)(p.ws + OFF_DEC); bf16_t* Sin = (bf16_t*)(p.ws + OFF_SIN);
    for (int gid = bid * NT + threadIdx.x; gid < 16 * 8192; gid += nblk * NT) {
        const int bh = gid >> 13, el = gid & 8191, d = el >> 7; float st = 0.f;
        for (int n0 = 0; n0 < NSC; n0 += 16) {
            float sl[16], dc[16]; bf16_t so[16];
#pragma unroll
            for (int i = 0; i < 16; ++i) { const int u = bh * 64 + n0 + i; sl[i] = Sloc[(size_t)u * 8192 + el]; dc[i] = dec[u * 64 + d]; }
#pragma unroll
            for (int i = 0; i < 16; ++i) { so[i] = f2bf(st); st = st * dc[i] + sl[i]; }
#pragma unroll
            for (int i = 0; i < 16; ++i) Sin[(size_t)(bh * 64 + n0 + i) * 8192 + el] = so[i];
        }
    }
}

DI void phase_gla3(const Params& p, int bid, int nblk, float* ldsf) {
    unsigned char* lds = (unsigned char*)ldsf;
    int tid_ = threadIdx.x; asm volatile("" : "+v"(tid_));
    const int tid = tid_, lane = tid & 63, w = __builtin_amdgcn_readfirstlane(tid >> 6), t = tid >> 3, ch = tid & 7, l15 = lane & 15, kg = lane >> 4;
    const bf16_t* proj = (const bf16_t*)(p.ws + OFF_PROJ); const float* Gbuf = (const float*)(p.ws + OFF_G); const bf16_t* Sin = (const bf16_t*)(p.ws + OFF_SIN);
    bf16_t* mix = (bf16_t*)(p.ws + OFF_MIX);
    unsigned char* Qimg = lds; unsigned char* Kimg = lds + 8192; unsigned char* Pimg = lds + 16384; unsigned char* Vimg = lds + 24576; unsigned char* Simg = lds + 40960;
    float* part = (float*)(lds + 57344);
    for (int unit = bid; unit < 1024; unit += nblk) {
        const int bh = unit >> 6, n = unit & 63, b = bh >> 2, h = bh & 3, t0 = b * SEQ + n * SC;
        {
            const f32x4 g0 = *(const f32x4*)(Gbuf + (size_t)(t0 + t) * 256 + h * 64 + 8 * ch), g1 = *(const f32x4*)(Gbuf + (size_t)(t0 + t) * 256 + h * 64 + 8 * ch + 4);
            const u16x8 qv = *(const u16x8*)(proj + (size_t)(t0 + t) * NPROJ + Q_OFF + h * 64 + 8 * ch), kv = *(const u16x8*)(proj + (size_t)(t0 + t) * NPROJ + K_OFF + h * 64 + 8 * ch);
            bf16x8 qo, ko;
#pragma unroll
            for (int dd = 0; dd < 4; ++dd) {
                qo[dd] = (__bf16)(bfbits2f(qv[dd]) * 0.125f * __expf(g0[dd])); qo[dd + 4] = (__bf16)(bfbits2f(qv[dd + 4]) * 0.125f * __expf(g1[dd]));
                ko[dd] = (__bf16)(bfbits2f(kv[dd]) * __expf(-g0[dd])); ko[dd + 4] = (__bf16)(bfbits2f(kv[dd + 4]) * __expf(-g1[dd]));
            }
            *(bf16x8*)(Qimg + f1_off(t, ch)) = qo; *(bf16x8*)(Kimg + f1_off(t, ch)) = ko;
        }
#pragma unroll
        for (int i = 0; i < 2; ++i) { const int idx = tid + NT * i, tr = idx >> 4, c16 = idx & 15;
            *(u32x4*)(Vimg + f2_off(tr, c16)) = *(const u32x4*)(proj + (size_t)(t0 + tr) * NPROJ + V_OFF + h * 128 + 8 * c16);
            *(u32x4*)(Simg + f2_off(tr, c16)) = *(const u32x4*)(Sin + (size_t)unit * 8192 + tr * 128 + 8 * c16); }
        __syncthreads();
        {
            const int it = w >> 1;
#pragma unroll
            for (int jj = 0; jj < 2; ++jj) {
                const int jt = 2 * (w & 1) + jj; f32x4 acc = {0.f, 0.f, 0.f, 0.f};
                if (jt <= it) {
#pragma unroll
                    for (int ks = 0; ks < 2; ++ks) acc = MFMA16(f1_frag(Kimg, jt, ks, lane), f1_frag(Qimg, it, ks, lane), acc);
                    if (jt == it) {
#pragma unroll
                        for (int r = 0; r < 4; ++r) if (4 * kg + r > l15) acc[r] = 0.f;
                    }
                }
                bf16x4 o; o[0] = (__bf16)acc[0]; o[1] = (__bf16)acc[1]; o[2] = (__bf16)acc[2]; o[3] = (__bf16)acc[3];
                *(bf16x4*)(Pimg + f1_off(16 * it + l15, 2 * jt + (kg >> 1)) + 8 * (kg & 1)) = o;
            }
        }
        __syncthreads();
        {
            f32x4 acc[4];
#pragma unroll
            for (int it = 0; it < 4; ++it) acc[it] = (f32x4){0.f, 0.f, 0.f, 0.f};
#pragma unroll
            for (int ks = 0; ks < 2; ++ks) {
                const bf16x8 xv = f2_frag(Vimg, w, ks, lane), xs = f2_frag(Simg, w, ks, lane);
#pragma unroll
                for (int it = 0; it < 4; ++it) {
                    if (2 * ks <= it) acc[it] = MFMA16(xv, f1_frag(Pimg, it, ks, lane), acc[it]);
                    acc[it] = MFMA16(xs, f1_frag(Qimg, it, ks, lane), acc[it]);
                }
            }
#pragma unroll
            for (int it = 0; it < 4; ++it) {
                float ss = acc[it][0] * acc[it][0] + acc[it][1] * acc[it][1] + acc[it][2] * acc[it][2] + acc[it][3] * acc[it][3];
                ss += __shfl_xor(ss, 16); ss += __shfl_xor(ss, 32);
                if (kg == 0) part[w * 64 + 16 * it + l15] = ss;
            }
            __syncthreads();
            const int e0 = 16 * w + 4 * kg; const f32x4 nw = *(const f32x4*)(p.norm_w + e0);
#pragma unroll
            for (int it = 0; it < 4; ++it) {
                const int i = 16 * it + l15; float tot = 0.f;
#pragma unroll
                for (int w2 = 0; w2 < 8; ++w2) tot += part[w2 * 64 + i];
                const float inv = rsqrtf(tot * (1.f / 128.f) + RMS_EPS);
                const u16x4 rv = *(const u16x4*)(proj + (size_t)(t0 + i) * NPROJ + R_OFF + h * 128 + e0);
                bf16x4 o;
#pragma unroll
                for (int r = 0; r < 4; ++r) { const float rr = bfbits2f(rv[r]); o[r] = (__bf16)(acc[it][r] * inv * nw[r] * (rr * sigmoidf_(rr))); }
                *(bf16x4*)(mix + (size_t)(t0 + i) * D + 512 + h * 128 + e0) = o;
            }
        }
        __syncthreads();
    }
}

DI void phase_out(const Params& p, int bid, int nblk, float* lds) {
    const bf16_t* mix = (const bf16_t*)(p.ws + OFF_MIX); const bf16_t* xb = (const bf16_t*)(p.ws + OFF_XB); bf16_t* yb = (bf16_t*)(p.ws + OFF_H32);
    for (int u = bid; u < 64 * 4; u += nblk) {
        const int mt = (nblk == 256) ? 8 * (u & 7) + (u >> 5) : u >> 2, nt = (nblk == 256) ? (u >> 3) & 3 : u & 3;
        auto rowoff = [&](int r) { return (unsigned)((mt * 256 + r) * D); };
        auto fin = [&](int r, int c, u32x4 dv) {
            const size_t o = (size_t)(mt * 256 + r) * D + nt * 256 + c; const u32x4 xr = *(const u32x4*)(xb + o);
            const f32x4 x0 = {bf2f((bf16_t)(xr[0] & 0xffffu)), bf2f((bf16_t)(xr[0] >> 16)), bf2f((bf16_t)(xr[1] & 0xffffu)), bf2f((bf16_t)(xr[1] >> 16))};
            const f32x4 x1 = {bf2f((bf16_t)(xr[2] & 0xffffu)), bf2f((bf16_t)(xr[2] >> 16)), bf2f((bf16_t)(xr[3] & 0xffffu)), bf2f((bf16_t)(xr[3] >> 16))};
            u32x4 ov;
            ov[0] = pk2(bf2f((bf16_t)(dv[0] & 0xffffu)) + ALPHA * x0[0], bf2f((bf16_t)(dv[0] >> 16)) + ALPHA * x0[1]);
            ov[1] = pk2(bf2f((bf16_t)(dv[1] & 0xffffu)) + ALPHA * x0[2], bf2f((bf16_t)(dv[1] >> 16)) + ALPHA * x0[3]);
            ov[2] = pk2(bf2f((bf16_t)(dv[2] & 0xffffu)) + ALPHA * x1[0], bf2f((bf16_t)(dv[2] >> 16)) + ALPHA * x1[1]);
            ov[3] = pk2(bf2f((bf16_t)(dv[3] & 0xffffu)) + ALPHA * x1[2], bf2f((bf16_t)(dv[3] >> 16)) + ALPHA * x1[3]);
            *(u32x4*)(yb + o) = ov; };
        gemm_mfma<false, true, 2, D, 4>(mix, rowoff, (const float*)((const bf16_t*)(p.ws + OFF_WB_OUT) + nt * 256), nullptr, (unsigned)(((size_t)D * D - nt * 256) * 2), D, 256, PRE_ID, fin, (unsigned char*)lds);
    }
}

DI void ln_row(float (&v)[16], const float* g, const float* b, int lane) {
    float s = 0.f;
#pragma unroll
    for (int i = 0; i < 16; ++i) s += v[i];
    const float mean = wave_sum(s) * (1.f / D); float q = 0.f;
#pragma unroll
    for (int i = 0; i < 16; ++i) { v[i] -= mean; q += v[i] * v[i]; }
    const float rstd = rsqrtf(wave_sum(q) * (1.f / D) + LN_EPS);
#pragma unroll
    for (int j = 0; j < 4; ++j) {
        const float4 gg = ((const float4*)g)[lane + 64 * j], bb = ((const float4*)b)[lane + 64 * j];
        v[4 * j] = v[4 * j] * rstd * gg.x + bb.x; v[4 * j + 1] = v[4 * j + 1] * rstd * gg.y + bb.y;
        v[4 * j + 2] = v[4 * j + 2] * rstd * gg.z + bb.z; v[4 * j + 3] = v[4 * j + 3] * rstd * gg.w + bb.w;
    }
}

DI void ln1_rows(const Params& p, int r0, int nrows) {
    int tid_ = threadIdx.x; asm volatile("" : "+v"(tid_));
    const int lane = tid_ & 63, wave = tid_ >> 6;
    const bf16_t* yb = (const bf16_t*)(p.ws + OFF_H32); bf16_t* hb = (bf16_t*)(p.ws + OFF_HB);
    for (int rb = r0 + wave; rb < r0 + nrows; rb += 32) {
        float v[4][16];
#pragma unroll
        for (int q = 0; q < 4; ++q) {
            const u32x4* hr = (const u32x4*)(yb + (size_t)(rb + 8 * q) * D);
#pragma unroll
            for (int j = 0; j < 2; ++j) { const u32x4 a = hr[lane + 64 * j];
                _Pragma("unroll") for (int k = 0; k < 4; ++k) { v[q][8 * j + 2 * k] = bf2f((bf16_t)(a[k] & 0xffffu)); v[q][8 * j + 2 * k + 1] = bf2f((bf16_t)(a[k] >> 16)); } }
        }
        float s[4], qq[4];
#pragma unroll
        for (int q = 0; q < 4; ++q) { s[q] = 0.f; _Pragma("unroll") for (int i = 0; i < 16; ++i) s[q] += v[q][i]; }
#pragma unroll
        for (int o = 1; o < 64; o <<= 1) { _Pragma("unroll") for (int q = 0; q < 4; ++q) s[q] += __shfl_xor(s[q], o); }
#pragma unroll
        for (int q = 0; q < 4; ++q) { const float mean = s[q] * (1.f / D); qq[q] = 0.f; _Pragma("unroll") for (int i = 0; i < 16; ++i) { v[q][i] -= mean; qq[q] += v[q][i] * v[q][i]; } }
#pragma unroll
        for (int o = 1; o < 64; o <<= 1) { _Pragma("unroll") for (int q = 0; q < 4; ++q) qq[q] += __shfl_xor(qq[q], o); }
#pragma unroll
        for (int j = 0; j < 2; ++j) {
            const float4 g0 = ((const float4*)p.ln1_g)[2 * (lane + 64 * j)], g1 = ((const float4*)p.ln1_g)[2 * (lane + 64 * j) + 1];
            const float4 b0 = ((const float4*)p.ln1_b)[2 * (lane + 64 * j)], b1 = ((const float4*)p.ln1_b)[2 * (lane + 64 * j) + 1];
#pragma unroll
            for (int q = 0; q < 4; ++q) {
                const float rstd = rsqrtf(qq[q] * (1.f / D) + LN_EPS); const float* w = &v[q][8 * j];
                u32x4 o;
                o[0] = pk2(w[0] * rstd * g0.x + b0.x, w[1] * rstd * g0.y + b0.y); o[1] = pk2(w[2] * rstd * g0.z + b0.z, w[3] * rstd * g0.w + b0.w);
                o[2] = pk2(w[4] * rstd * g1.x + b1.x, w[5] * rstd * g1.y + b1.y); o[3] = pk2(w[6] * rstd * g1.z + b1.z, w[7] * rstd * g1.w + b1.w);
                ((u32x4*)(hb + (size_t)(rb + 8 * q) * D))[lane + 64 * j] = o;
            }
        }
    }
}

DI void topk_rows(const Params& p, const float* sc_lds, int r0, int nrows) {
    int tid_ = threadIdx.x; asm volatile("" : "+v"(tid_));
    const int lane = tid_ & 63, wave = tid_ >> 6;
    float* wbuf = (float*)(p.ws + OFF_WBUF);
    int* list = (int*)(p.ws + OFF_LIST); unsigned* cnt = (unsigned*)(p.ws + OFF_CTL) + CW_CNT;
    const float NEG = -__builtin_inff();
    for (int t = r0 + wave; t < r0 + nrows; t += 8) {
        const float4 sv = ((const float4*)(sc_lds + (size_t)(t - r0) * NE))[lane], bv = ((const float4*)p.router_bias)[lane];
        const float s[4] = {sv.x, sv.y, sv.z, sv.w};
        float cand[4] = {sv.x + bv.x, sv.y + bv.y, sv.z + bv.z, sv.w + bv.w};
        float m1 = NEG, m2 = NEG;
#pragma unroll
        for (int j = 0; j < 4; ++j) { const float v = cand[j]; if (v > m1) { m2 = m1; m1 = v; } else if (v > m2) m2 = v; }
#pragma unroll
        for (int off = 1; off < 8; off <<= 1) {
            const float o1 = __shfl_xor(m1, off), o2 = __shfl_xor(m2, off);
            const float n1 = fmaxf(m1, o1), n2 = fmaxf(fminf(m1, o1), fmaxf(m2, o2)); m1 = n1; m2 = n2;
        }
        const float gs = m1 + m2; const int mygrp = lane >> 3; int rank = 0;
#pragma unroll
        for (int g2 = 0; g2 < 8; ++g2) { const float og = __shfl(gs, g2 * 8); if (og > gs || (og == gs && g2 < mygrp)) ++rank; }
        if (rank >= 4) { cand[0] = NEG; cand[1] = NEG; cand[2] = NEG; cand[3] = NEG; }
        int my_e = 0; float my_w = 0.f, wsum = 0.f;
#pragma unroll
        for (int k = 0; k < TOPK; ++k) {
            float bvv = cand[0]; int bj = 0;
#pragma unroll
            for (int j = 1; j < 4; ++j) if (cand[j] > bvv) { bvv = cand[j]; bj = j; }
            int bi = 4 * lane + bj;
#pragma unroll
            for (int off = 32; off >= 1; off >>= 1) {
                const float ov = __shfl_xor(bvv, off); const int oi = __shfl_xor(bi, off);
                if (ov > bvv || (ov == bvv && oi < bi)) { bvv = ov; bi = oi; }
            }
            const int wj = bi & 3, wl = bi >> 2;
            const float mys = wj == 0 ? s[0] : (wj == 1 ? s[1] : (wj == 2 ? s[2] : s[3]));
            const float wk = __shfl(mys, wl);
            wsum += wk;
            if (lane == k) { my_e = bi; my_w = wk; }
            if (lane == wl) {
#pragma unroll
                for (int j = 0; j < 4; ++j) if (j == wj) cand[j] = NEG;
            }
        }
        if (lane < TOPK) {
            const unsigned pos = atomicAdd(&cnt[my_e], 1u);
            list[(size_t)my_e * LCAP + pos] = t * TOPK + lane;
            wbuf[(size_t)t * TOPK + lane] = my_w / wsum * 2.5f;
        }
    }
}

DI void phase_route(const Params& p, int bid, int nblk, float* lds) {
    const bf16_t* hb = (const bf16_t*)(p.ws + OFF_HB); float* scores = (float*)(p.ws + OFF_SCORES);
    for (int mt = bid; mt < T / 64; mt += nblk) {
        ln1_rows(p, mt * 64, 64);
        __syncthreads();
        auto rowoff = [&](int r) { return (unsigned)((mt * 64 + r) * D); };
        auto pre = [&](int r, int c, f32x4 v, f32x4) { return (f32x4){sigmoidf_(v[0]), sigmoidf_(v[1]), sigmoidf_(v[2]), sigmoidf_(v[3])}; };
        auto fin = [&](int r, int c, u32x4 dv) { *(u32x4*)((unsigned char*)lds + 65536 + (r * NE + c) * 4) = dv; };
        gemm_mfma<false, true, 4, NE, 4>(hb, rowoff, (const float*)(p.ws + OFF_WB_RT), nullptr, (unsigned)(D * NE * 2), D, 64, pre, fin, (unsigned char*)lds);
        __syncthreads();
        topk_rows(p, (const float*)((unsigned char*)lds + 65536), mt * 64, 64);
        __syncthreads();
    }
}

constexpr int EXP_TAB_OFF = GEMM_LDS_BYTES;
DI void build_tables(const Params& p, int* toff, int* roff) {
    const unsigned* cnt = (const unsigned*)(p.ws + OFF_CTL) + CW_CNT;
    int* cl = roff + 260;
    if (threadIdx.x < NE) cl[threadIdx.x] = (int)__hip_atomic_load(cnt + threadIdx.x, __ATOMIC_RELAXED, __HIP_MEMORY_SCOPE_AGENT);
    __syncthreads();
    if (threadIdx.x <= NE) {
        int ta = 0, ra = 0;
        for (int e = 0; e < (int)threadIdx.x; ++e) { const int c = cl[e]; ta += (c + 255) >> 8; ra += c; }
        toff[threadIdx.x] = ta; roff[threadIdx.x] = ra;
    }
    __syncthreads();
    if (threadIdx.x < NE) { unsigned char* texp = (unsigned char*)(roff + 1040); for (int t = toff[threadIdx.x]; t < toff[threadIdx.x + 1]; ++t) texp[t] = (unsigned char)threadIdx.x; }
    __syncthreads();
}
DI int find_expert(const int* toff, int tile) { int lo = 0, hi = NE - 1; while (lo < hi) { const int mid = (lo + hi + 1) >> 1; if (toff[mid] <= tile) lo = mid; else hi = mid - 1; } return lo; }
struct ExpUnit { int e, row0, rows, rowbase; };
DI ExpUnit exp_unit(const int* toff, const int* roff, int e, int tile, int ntile) {
    const int* cl = roff + 260;
    ExpUnit u;
    if (tile < ntile) {
        u.e = e; const int ui = tile - toff[e], c = cl[e];
        u.row0 = ui * 256; u.rows = min(256, c - u.row0); u.rowbase = roff[e] + u.row0;
    } else { u.e = NE; u.row0 = (tile - ntile) * 256; u.rows = 256; u.rowbase = A_TOT + u.row0; }
    u.e = __builtin_amdgcn_readfirstlane(u.e); u.row0 = __builtin_amdgcn_readfirstlane(u.row0); u.rows = __builtin_amdgcn_readfirstlane(u.rows);
    u.rowbase = __builtin_amdgcn_readfirstlane(u.rowbase);
    return u;
}

template <int NTL>
DI int exp_decode(const int* toff, int ntile, int u, int& tile, int& nt) {
    if (u < NTL * ntile) {
        const unsigned char* texp = (const unsigned char*)(toff + 260 + 1040);
        const int e = texp[u / NTL], t0 = toff[e], ne = toff[e + 1] - t0; int u2 = u - NTL * t0; nt = 0;
#pragma unroll
        for (int i = 1; i < NTL; ++i) if (u2 >= ne) { u2 -= ne; ++nt; }
        tile = t0 + u2; return e;
    }
    else { const int us = u - NTL * ntile; nt = us / (T / 256); tile = ntile + (us - nt * (T / 256)); return NE; }
}

DI void phase_e1(const Params& p, int bid, int nblk, float* lds) {
    int* toff = (int*)((unsigned char*)lds + EXP_TAB_OFF); int* roff = toff + 260;
    const bf16_t* hb = (const bf16_t*)(p.ws + OFF_HB); bf16_t* hid = (bf16_t*)(p.ws + OFF_HID); const int* list = (const int*)(p.ws + OFF_LIST);
    build_tables(p, toff, roff);
    const int ntile = toff[NE], units = (ntile + T / 256) * 2;
    const int vb = (nblk & 7) ? bid : (bid & 7) * (nblk >> 3) + (bid >> 3);
    u32x4 ra[2][2], rb[2][4]; unsigned ao[2] = {0u, 0u}; bool pre = false;
    int tile_n = 0, nt_n = 0; ExpUnit xn;
    if (vb < units) { const int e_ = exp_decode<2>(toff, ntile, vb, tile_n, nt_n); xn = exp_unit(toff, roff, e_, tile_n, ntile); }
    for (int u = vb; u < units; u += nblk) {
        const int nt = nt_n; const ExpUnit x = xn; const bool hn = u + nblk < units;
        if (hn) { const int e_ = exp_decode<2>(toff, ntile, u + nblk, tile_n, nt_n); xn = exp_unit(toff, roff, e_, tile_n, ntile); }
        const float* wg = x.e < NE ? p.wg + (size_t)x.e * 262144 : p.sg; const float* wu = x.e < NE ? p.wu + (size_t)x.e * 262144 : p.su;
        const float* wgn = xn.e < NE ? p.wg + (size_t)xn.e * 262144 : p.sg; const float* wun = xn.e < NE ? p.wu + (size_t)xn.e * 262144 : p.su;
        auto rowoff = [&](int r) { const int tok = x.e < NE ? (list[(size_t)x.e * LCAP + x.row0 + r] >> 3) : (x.row0 + r); return (unsigned)(tok * D); };
        auto rowoff_n = [&](int r) { const int tok = xn.e < NE ? (list[(size_t)xn.e * LCAP + xn.row0 + r] >> 3) : (xn.row0 + r); return (unsigned)(tok * D); };
        auto prf = [&](int r, int c, f32x4 g, f32x4 uu) { return (f32x4){g[0] * sigmoidf_(g[0]) * uu[0], g[1] * sigmoidf_(g[1]) * uu[1], g[2] * sigmoidf_(g[2]) * uu[2], g[3] * sigmoidf_(g[3]) * uu[3]}; };
        auto fin = [&](int r, int c, u32x4 dv) { *(u32x4*)(hid + (size_t)(x.rowbase + r) * EDIM + nt * 128 + c) = dv; };
        gemm_core<true, false, 2, EDIM, 4>(ra, rb, ao, pre, hb, rowoff, wg + nt * 128, wu + nt * 128, (unsigned)((D * EDIM - nt * 128) * 4), D, x.rows,
                                 hn, rowoff_n, wgn + nt_n * 128, wun + nt_n * 128, (unsigned)((D * EDIM - nt_n * 128) * 4), xn.rows, prf, fin, (unsigned char*)lds);
        pre = hn;
    }
}

DI void phase_e2(const Params& p, int bid, int nblk, float* lds) {
    int* toff = (int*)((unsigned char*)lds + EXP_TAB_OFF); int* roff = toff + 260; int* rowa = roff + 520;
    const bf16_t* hid = (const bf16_t*)(p.ws + OFF_HID); unsigned char* Y = p.ws + OFF_Y; const int* list = (const int*)(p.ws + OFF_LIST);
    build_tables(p, toff, roff);
    const int ntile = toff[NE], units = (ntile + T / 256) * 4;
    const int vb = (nblk & 7) ? bid : (bid & 7) * (nblk >> 3) + (bid >> 3);
    u32x4 ra[2][2], rb[2][4]; unsigned ao[2] = {0u, 0u}; bool pre = false;
    int tile_n = 0, nt_n = 0; ExpUnit xn;
    auto rowa_val = [&](const ExpUnit& q, int r) { return q.e < NE ? (r < q.rows ? list[(size_t)q.e * LCAP + q.row0 + r] : 0) : (A_TOT + q.row0 + r); };
    if (vb < units) { const int e_ = exp_decode<4>(toff, ntile, vb, tile_n, nt_n); xn = exp_unit(toff, roff, e_, tile_n, ntile); if (threadIdx.x < 256) rowa[threadIdx.x] = rowa_val(xn, threadIdx.x); }
    __syncthreads();
    int cur = 0;
    for (int u = vb; u < units; u += nblk) {
        const int nt = nt_n; const ExpUnit x = xn; const bool hn = u + nblk < units;
        if (hn) { const int e_ = exp_decode<4>(toff, ntile, u + nblk, tile_n, nt_n); xn = exp_unit(toff, roff, e_, tile_n, ntile); }
        const float* wd = x.e < NE ? p.wd + (size_t)x.e * 262144 : p.sd; const float* wdn = xn.e < NE ? p.wd + (size_t)xn.e * 262144 : p.sd;
        int rnext = 0;
        if (hn && threadIdx.x < 256) rnext = rowa_val(xn, threadIdx.x);
        const int* rowa_c = rowa + cur * 256;
        auto rowoff = [&](int r) { return (unsigned)((x.rowbase + r) * EDIM); };
        auto rowoff_n = [&](int r) { return (unsigned)((xn.rowbase + r) * EDIM); };
        auto fin = [&](int r, int c, u32x4 dv) { *(u32x4*)(Y + (size_t)rowa_c[r] * D + nt * 256 + c) = dv; };
        gemm_core<false, false, 1, D, 4>(ra, rb, ao, pre, hid, rowoff, wd + nt * 256, nullptr, (unsigned)((EDIM * D - nt * 256) * 4), EDIM, x.rows,
                               hn, rowoff_n, wdn + nt_n * 256, nullptr, (unsigned)((EDIM * D - nt_n * 256) * 4), xn.rows, PRE_ID, fin, (unsigned char*)lds);
        pre = hn;
        cur ^= 1;
        if (threadIdx.x < 256) rowa[cur * 256 + threadIdx.x] = rnext;
    }
}

DI void phase_combine(const Params& p, int bid, int nblk, float* lds) {
    const int lane = threadIdx.x & 63, wave = threadIdx.x >> 6;
    const bf16_t* hb = (const bf16_t*)(p.ws + OFF_HB); const unsigned char* Y = p.ws + OFF_Y; const float* wbuf = (const float*)(p.ws + OFF_WBUF);
    typedef float f32x2 __attribute__((ext_vector_type(2)));
    for (int t = bid * 8 + wave; t < T; t += nblk * 8) {
        float v[16];
#pragma unroll
        for (int j = 0; j < 4; ++j) { const uint2 a = ((const uint2*)(hb + (size_t)t * D))[lane + 64 * j];
            v[4 * j] = ALPHA * __uint_as_float(a.x << 16); v[4 * j + 1] = ALPHA * __uint_as_float(a.x & 0xffff0000u);
            v[4 * j + 2] = ALPHA * __uint_as_float(a.y << 16); v[4 * j + 3] = ALPHA * __uint_as_float(a.y & 0xffff0000u); }
#pragma unroll
        for (int k = 0; k < 9; ++k) {
            const size_t row = k < 8 ? (size_t)t * TOPK + k : (size_t)A_TOT + t; const float w = (k < 8 ? wbuf[(size_t)t * TOPK + k] : 1.f) * (1.f / 128.f);
#pragma unroll
            for (int j = 0; j < 4; ++j) {
                const int y = ((const int*)(Y + row * D))[lane + 64 * j];
                const f32x2 lo = __builtin_amdgcn_cvt_pk_f32_fp8(y, false), hi = __builtin_amdgcn_cvt_pk_f32_fp8(y, true);
                v[4 * j] += w * lo[0]; v[4 * j + 1] += w * lo[1]; v[4 * j + 2] += w * hi[0]; v[4 * j + 3] += w * hi[1];
            }
        }
        ln_row(v, p.ln2_g, p.ln2_b, lane);
#pragma unroll
        for (int j = 0; j < 4; ++j) ((float4*)(p.out + (size_t)t * D))[lane + 64 * j] = make_float4(v[4 * j], v[4 * j + 1], v[4 * j + 2], v[4 * j + 3]);
    }
}

#define LAS __attribute__((address_space(3)))
#define XB_TMO      128
#define XB_XCNT(j)  (256  + 64 * (j))
#define XB_XSUB(j)  (1280 + 64 * (j))
#define XB_XGEN(j)  (2304 + 64 * (j))
#define XB_TOP      3328
#define XB_TOPGEN   3392
#define XCD_BAR_WORDS 3456
#define XB_SPIN_CAP (1u << 22)
constexpr int CW_BAR = 4096;
DI unsigned xb_ld(unsigned* p) { return __hip_atomic_load(p, __ATOMIC_RELAXED, __HIP_MEMORY_SCOPE_AGENT); }
DI unsigned xb_add(unsigned* p, unsigned v) { return __hip_atomic_fetch_add(p, v, __ATOMIC_RELAXED, __HIP_MEMORY_SCOPE_AGENT); }
DI unsigned xb_xcc_id() { return (unsigned)__builtin_amdgcn_s_getreg((3 << 11) | 20) & 0xFu; }
#define XB_SPIN(cond, bar) do { unsigned _sp = 0; while (cond) { __builtin_amdgcn_s_sleep(1); \
    if ((++_sp & 255u) == 0u) { if (xb_ld(&(bar)[XB_TMO])) break; if (_sp > XB_SPIN_CAP) { atomicAdd(&(bar)[XB_TMO], 1u); break; } } } } while (0)
struct XcdBarrier { unsigned* bar; unsigned x; volatile LAS unsigned* st; };
DI XcdBarrier xcd_barrier_post(unsigned* bar, volatile LAS unsigned* st) {
    XcdBarrier b; b.bar = bar; b.x = xb_xcc_id(); b.st = st;
    if (threadIdx.x == 0) (void)xb_add(&bar[XB_XCNT(b.x)], 1u);
    return b;
}
DI void xcd_barrier_complete(unsigned* bar, unsigned x, unsigned& nloc, unsigned& nx) {
    const unsigned G = gridDim.x * gridDim.y * gridDim.z;
    unsigned sum, cnt, mine, sp = 0u;
    for (;;) {
        sum = 0u; cnt = 0u; mine = 0u;
#pragma unroll
        for (unsigned j = 0; j < 16; ++j) { const unsigned c = xb_ld(&bar[XB_XCNT(j)]); sum += c; cnt += (c > 0u) ? 1u : 0u; mine = (j == x) ? c : mine; }
        if (sum == G) break;
        __builtin_amdgcn_s_sleep(1);
        if ((++sp & 255u) == 0u) { if (xb_ld(&bar[XB_TMO])) break; if (sp > XB_SPIN_CAP) { atomicAdd(&bar[XB_TMO], 1u); break; } }
    }
    nloc = mine > 0u ? mine : 1u; nx = cnt > 0u ? cnt : 1u;
}
DI void xcd_barrier(const XcdBarrier& b) {
    asm volatile("s_waitcnt vmcnt(0)" ::: "memory");
    __syncthreads();
    if (threadIdx.x == 0) {
        unsigned* bar = b.bar;
        __builtin_amdgcn_s_waitcnt(0);
        unsigned nloc = b.st[0], nx = b.st[1];
        if (nloc == 0u) { xcd_barrier_complete(bar, b.x, nloc, nx); b.st[0] = nloc; b.st[1] = nx; }
        const unsigned old = xb_add(&bar[XB_XSUB(b.x)], 1u);
        const unsigned gen = old / nloc;
        if (old + 1u == (gen + 1u) * nloc) {
            __builtin_amdgcn_fence(__ATOMIC_RELEASE, "agent");
            asm volatile("s_waitcnt vmcnt(0)" ::: "memory");
            const unsigned og = xb_add(&bar[XB_TOP], 1u);
            const unsigned tg = og / nx;
            if (og + 1u == (tg + 1u) * nx) xb_add(&bar[XB_TOPGEN], 1u);
            else XB_SPIN(xb_ld(&bar[XB_TOPGEN]) == tg, bar);
            __builtin_amdgcn_fence(__ATOMIC_ACQUIRE, "agent");
            xb_add(&bar[XB_XGEN(b.x)], 1u);
            asm volatile("s_waitcnt vmcnt(0)" ::: "memory");
        } else {
            XB_SPIN(xb_ld(&bar[XB_XGEN(b.x)]) == gen, bar);
            __builtin_amdgcn_fence(__ATOMIC_ACQUIRE, "agent");
            asm volatile("s_waitcnt vmcnt(0)" ::: "memory");
        }
    }
    __syncthreads();
}

constexpr int LDS_BYTES = 136 * 1024;
constexpr int LDS_BAR_OFF = LDS_BYTES - 16;
__global__ void __launch_bounds__(NT) fwd_megakernel(Params p) {
    extern __shared__ __attribute__((aligned(16))) float lds[];
    const int bid = blockIdx.x, nblk = gridDim.x;
    volatile LAS unsigned* st = (volatile LAS unsigned*)((LAS unsigned char*)lds + LDS_BAR_OFF);
    if (threadIdx.x < 4) st[threadIdx.x] = 0u;
    __syncthreads();
    XcdBarrier bar = xcd_barrier_post((unsigned*)(p.ws + OFF_CTL) + CW_BAR, st);
    phase_prep(p, bid, nblk, lds);      xcd_barrier(bar);
    phase_proj(p, bid, nblk, lds);      xcd_barrier(bar);
    phase_poolmean(p, bid, nblk, lds);
    phase_gla1(p, bid, nblk, lds);      xcd_barrier(bar);
    phase_pool(p, bid, nblk, lds);
    phase_gla2(p, bid, nblk, lds);      xcd_barrier(bar);
    phase_gla3(p, bid, nblk, lds);      xcd_barrier(bar);
    phase_out(p, bid, nblk, lds);       xcd_barrier(bar);
    phase_route(p, bid, nblk, lds);     xcd_barrier(bar);
    phase_e1(p, bid, nblk, lds);        xcd_barrier(bar);
    phase_e2(p, bid, nblk, lds);        xcd_barrier(bar);
    phase_combine(p, bid, nblk, lds);
}

extern "C" void kernel_launch(void* const* d_in, const int* in_sizes, int n_in, void* d_out, int out_size, void* d_ws, size_t ws_size, hipStream_t stream) {
    static int grid = 0;
    if (grid == 0) {
        if (n_in != 20 || ws_size < WS_NEED) { fprintf(stderr, "kernel_launch: unexpected n_in %d or ws_size %zu (< %zu)\n", n_in, ws_size, (size_t)WS_NEED); grid = -1; return; }
        int dev = 0, cus = 0, per_cu = 0;
        (void)hipGetDevice(&dev); (void)hipDeviceGetAttribute(&cus, hipDeviceAttributeMultiprocessorCount, dev);
        (void)hipFuncSetAttribute((const void*)fwd_megakernel, hipFuncAttributeMaxDynamicSharedMemorySize, LDS_BYTES);
        (void)hipOccupancyMaxActiveBlocksPerMultiprocessor(&per_cu, (const void*)fwd_megakernel, NT, LDS_BYTES);
        if (per_cu < 1 || cus < 1) { fprintf(stderr, "kernel_launch: occupancy query says %d blocks/CU on %d CUs\n", per_cu, cus); grid = -1; return; }
        grid = cus;
    }
    if (grid < 0) return;
    (void)hipMemsetAsync((char*)d_ws + OFF_CTL, 0, 64 * 1024, stream);
    Params p{};
    const float** pp = (const float**)&p;
    for (int i = 0; i < 20; ++i) pp[i] = (const float*)d_in[i];
    p.out = (float*)d_out; p.ws = (unsigned char*)d_ws;
    void* args[] = {&p};
    hipError_t e = hipLaunchCooperativeKernel((const void*)fwd_megakernel, dim3(grid), dim3(NT), args, LDS_BYTES, stream);
    if (e != hipSuccess) fprintf(stderr, "cooperative launch failed: %s (grid %d)\n", hipGetErrorString(e), grid);
}
```

```cpp
#include <hip/hip_runtime.h>
#include <stdint.h>
#include <cstdio>

#define DI __device__ __forceinline__
typedef unsigned short bf16_t;

constexpr int T = 16384, D = 1024, SEQ = 4096;
constexpr int DIN = 2064, NPROJ = 2048;
constexpr int P_OFF = 0, Q_OFF = 512, K_OFF = 768, V_OFF = 1024, R_OFF = 1536, GL_OFF = 2048;
constexpr int SC = 64;
constexpr int NSC = SEQ / SC;
constexpr int NE = 256, TOPK = 8, EDIM = 256;
constexpr int A_TOT = T * TOPK;
constexpr int LCAP = T;
constexpr float ALPHA = 1.189207115002721f;
constexpr float LN_EPS = 1e-5f, RMS_EPS = 1e-5f;
constexpr int NT = 512;

constexpr size_t MiB = 1u << 20;
constexpr size_t OFF_CTL = 0;
constexpr size_t OFF_XB = 1 * MiB;
constexpr size_t OFF_GLOW = OFF_XB + 32 * MiB;
constexpr size_t OFF_PROJ = OFF_GLOW + 1 * MiB;
constexpr size_t OFF_G = OFF_PROJ + 64 * MiB;
constexpr size_t OFF_SLOC = OFF_G + 16 * MiB;
constexpr size_t OFF_DEC = OFF_SLOC + 32 * MiB;
constexpr size_t OFF_SIN = OFF_DEC + 1 * MiB;
constexpr size_t OFF_MIX = OFF_SIN + 32 * MiB;
constexpr size_t OFF_H32 = OFF_MIX + 32 * MiB;
constexpr size_t OFF_HB = OFF_H32 + 64 * MiB;
constexpr size_t OFF_SCORES = OFF_HB + 32 * MiB;
constexpr size_t OFF_WBUF = OFF_SCORES + 16 * MiB;
constexpr size_t OFF_LIST = OFF_WBUF + 1 * MiB;
constexpr size_t OFF_HID = OFF_LIST + 16 * MiB;
constexpr size_t OFF_Y = OFF_HID + 76 * MiB;
constexpr size_t OFF_PM = OFF_Y + 304 * MiB;
constexpr size_t OFF_WB_IN = OFF_PM + 16 * MiB;
constexpr size_t OFF_WB_OUT = OFF_WB_IN + 4 * MiB;
constexpr size_t OFF_WB_RT = OFF_WB_OUT + 2 * MiB;
constexpr size_t OFF_WB_SGU = OFF_WB_RT + 1 * MiB;
constexpr size_t OFF_WB_SD = OFF_WB_SGU + 1 * MiB;
constexpr size_t WS_NEED = OFF_WB_SD + 1 * MiB;
constexpr int CW_CNT = 1024;

struct Params {
    const float *x, *w_in, *gate_w2, *gate_b, *norm_w, *pool_w, *pool_scale, *w_out, *ln1_g, *ln1_b;
    const float *router_w, *router_bias, *wg, *wu, *wd, *sg, *su, *sd, *ln2_g, *ln2_b;
    float* out;
    unsigned char* ws;
};

DI float bf2f(bf16_t v) { return __uint_as_float(((unsigned)v) << 16); }
DI bf16_t f2bf(float f) { unsigned u = __float_as_uint(f); u += 0x7fffu + ((u >> 16) & 1u); return (bf16_t)(u >> 16); }
DI unsigned pk2(float lo, float hi) { typedef __bf16 bf2_ __attribute__((ext_vector_type(2))); bf2_ v; v[0] = (__bf16)lo; v[1] = (__bf16)hi; return __builtin_bit_cast(unsigned, v); }
DI float wave_sum(float v) {
#pragma unroll
    for (int o = 1; o < 64; o <<= 1) v += __shfl_xor(v, o);
    return v;
}
DI float sigmoidf_(float v) { return __builtin_amdgcn_rcpf(1.f + __expf(-v)); }
DI float logsigmoidf_(float z) { return fminf(z, 0.f) - log1pf(__expf(-fabsf(z))); }

constexpr int GT_LDS_FLOATS = 16 * 132 + 2 * 16 * 68;
template <bool DUAL, class AF, class BF, class EPI>
DI void gemm_tile_valu(int K, const AF& af, const BF& bfn, const EPI& epi, float* lds) {
    float* As = lds; float* Bs = lds + 16 * 132; float* Bs2 = Bs + 16 * 68;
    const int tid = threadIdx.x, ty = tid >> 4, tx = tid & 15;
    float acc[4][4], acc2[4][4];
#pragma unroll
    for (int i = 0; i < 4; ++i)
#pragma unroll
        for (int j = 0; j < 4; ++j) { acc[i][j] = 0.f; acc2[i][j] = 0.f; }
    for (int k0 = 0; k0 < K; k0 += 16) {
#pragma unroll
        for (int i = 0; i < 4; ++i) { const int e = tid + 512 * i, r = e >> 4, kk = e & 15; As[kk * 132 + r] = af(r, k0 + kk); }
#pragma unroll
        for (int i = 0; i < 2; ++i) { const int e = tid + 512 * i, kk = e >> 6, c = e & 63; Bs[kk * 68 + c] = bfn(0, k0 + kk, c); if (DUAL) Bs2[kk * 68 + c] = bfn(1, k0 + kk, c); }
        __syncthreads();
#pragma unroll
        for (int kk = 0; kk < 16; ++kk) {
            const float4 a = *(const float4*)&As[kk * 132 + ty * 4];
            const float4 b = *(const float4*)&Bs[kk * 68 + tx * 4];
            const float av[4] = {a.x, a.y, a.z, a.w}, bv[4] = {b.x, b.y, b.z, b.w};
#pragma unroll
            for (int i = 0; i < 4; ++i)
#pragma unroll
                for (int j = 0; j < 4; ++j) acc[i][j] += av[i] * bv[j];
            if (DUAL) {
                const float4 b2 = *(const float4*)&Bs2[kk * 68 + tx * 4];
                const float b2v[4] = {b2.x, b2.y, b2.z, b2.w};
#pragma unroll
                for (int i = 0; i < 4; ++i)
#pragma unroll
                    for (int j = 0; j < 4; ++j) acc2[i][j] += av[i] * b2v[j];
            }
        }
        __syncthreads();
    }
#pragma unroll
    for (int i = 0; i < 4; ++i)
#pragma unroll
        for (int j = 0; j < 4; ++j) epi(ty * 4 + i, tx * 4 + j, acc[i][j], acc2[i][j]);
}


typedef __bf16 bf16x8 __attribute__((ext_vector_type(8)));
typedef __bf16 bf16x4 __attribute__((ext_vector_type(4)));
typedef short s16x4 __attribute__((ext_vector_type(4)));
typedef float f32x4 __attribute__((ext_vector_type(4)));
typedef unsigned u32x4 __attribute__((ext_vector_type(4)));
#define LAS3 __attribute__((address_space(3)))
DI const float* uniform_ptr(const float* p) {
    const unsigned long long v = (unsigned long long)p;
    const unsigned lo = __builtin_amdgcn_readfirstlane((unsigned)v), hi = __builtin_amdgcn_readfirstlane((unsigned)(v >> 32));
    return (const float*)(((unsigned long long)hi << 32) | lo);
}
#define MFMA16(a, b, c) __builtin_amdgcn_mfma_f32_16x16x32_bf16((a), (b), (c), 0, 0, 0)
constexpr int GEMM_LDS_BYTES = 131072;
DI unsigned a_swz(unsigned x) { return (0x78u >> (2u * x)) & 3u; }
struct GemmRegs { u32x4 ra[2][2], rb[2][4]; };
template <bool DUAL, bool BK16, int OUTB, int LDB, int WN, class RowFn, class RowFnN, class Pre, class Fin>
DI void gemm_core(u32x4 (&Rra)[2][2], u32x4 (&Rrb)[2][4], unsigned (&aoffc)[2], bool preloaded, const bf16_t* Ab, const RowFn& rowoff, const float* B0, const float* B1, unsigned bbytes, int K, int rows,
                  bool has_next, const RowFnN& rowoff_n, const float* B0n, const float* B1n, unsigned bbytes_n, int rows_n, const Pre& pre, const Fin& fin, unsigned char* lds) {
    int tid_ = threadIdx.x; asm volatile("" : "+v"(tid_));
    const int tid = tid_, lane = tid & 63, w = __builtin_amdgcn_readfirstlane(tid >> 6), wm = w >> 2, wn = w & 3, l15 = lane & 15, kg = lane >> 4, t256 = tid & 255;
    const bool active = wn < WN;
    const int nrow_w = min(max(rows - 128 * wm, 0), 128), ngrp = (((nrow_w + 15) >> 4) + 1) >> 1;
    unsigned aoff[2];
#pragma unroll
    for (int i = 0; i < 2; ++i) aoff[i] = preloaded ? aoffc[i] : (rowoff(min(128 * wm + (t256 >> 2) + 64 * i, rows - 1)) + (t256 & 3) * 8) * 2u;
    const __amdgpu_buffer_rsrc_t ar = __builtin_amdgcn_make_buffer_rsrc((void*)Ab, 0, 0x7fffffff, 0x00020000);
    const unsigned awr = (128 * wm + (t256 >> 2)) * 128 + ((((unsigned)(t256 & 3)) ^ (unsigned)((t256 >> 3) & 7) ^ (unsigned)(t256 & 4)) << 4);
    constexpr int NB = BK16 ? 2 : 4;
    const float* bsrc = uniform_ptr(DUAL && !BK16 ? ((wn >> 1) ? B1 : B0) : B0);
    const __amdgpu_buffer_rsrc_t br = __builtin_amdgcn_make_buffer_rsrc((void*)bsrc, 0, bbytes, 0x00020000);
    const unsigned bvoff = BK16 ? (unsigned)(((lane >> 5) * LDB + (lane & 31) * 8) * 2) : (DUAL ? (unsigned)(((lane >> 5) * LDB + (lane & 31) * 4) * 4) : (unsigned)(lane * 16));
    const int krow0 = BK16 ? 16 * wm + 2 * wn : (DUAL ? 16 * wm + 8 * (wn & 1) : 16 * wm + wn);
    constexpr int KSTEP = BK16 ? 8 : (DUAL ? 2 : 4), ESZ = BK16 ? 2 : 4;
    unsigned aoff_n[2];
#pragma unroll
    for (int i = 0; i < 2; ++i) aoff_n[i] = has_next ? (rowoff_n(min(128 * wm + (t256 >> 2) + 64 * i, rows_n - 1)) + (t256 & 3) * 8) * 2u : aoff[i];
    const float* bsrc_n = uniform_ptr(has_next ? (DUAL && !BK16 ? ((wn >> 1) ? B1n : B0n) : B0n) : bsrc);
    const __amdgpu_buffer_rsrc_t br_n = __builtin_amdgcn_make_buffer_rsrc((void*)bsrc_n, 0, has_next ? bbytes_n : bbytes, 0x00020000);
    unsigned bwr[NB];
#pragma unroll
    for (int i = 0; i < NB; ++i) {
        const int kb = krow0 + KSTEP * i + ((BK16 || DUAL) ? (lane >> 5) : 0);
        const int n = BK16 ? 8 * (lane & 31) : (DUAL ? (wn >> 1) * 128 + 4 * (lane & 31) : 4 * lane);
        const unsigned I = n >> 7, ch = (n & 127) >> 3, half = BK16 ? 0u : (unsigned)((n >> 2) & 1), xx = ((kb & 3) << 2) | ((kb >> 2) & 3);
        bwr[i] = 32768u + I * 16384u + 256u * kb + 16u * (ch ^ xx) + 8u * half;
    }
    const unsigned ard = (128 * wm + l15) * 128 + ((((unsigned)kg) ^ (unsigned)((l15 >> 1) & 7) ^ (unsigned)((l15 & 1) << 2)) << 4);
    unsigned trd0, trd1;
    {
        const unsigned q = l15 >> 2, pp = l15 & 3, cbase = (DUAL ? 4u * wn : 8u * (wn & 1)) + (pp >> 1), ibase = DUAL ? 0u : (unsigned)(wn >> 1);
        const unsigned x0 = (q << 2) | ((2u * kg) & 3u), x1 = (q << 2) | ((2u * kg + 1u) & 3u);
        trd0 = 32768u + ibase * 16384u + 256u * (8u * kg + q) + 16u * (cbase ^ x0) + 8u * (pp & 1);
        trd1 = 32768u + ibase * 16384u + 256u * (8u * kg + 4u + q) + 16u * (cbase ^ x1) + 8u * (pp & 1);
    }
    f32x4 acc[8][4];
#pragma unroll
    for (int i = 0; i < 8; ++i)
#pragma unroll
        for (int f = 0; f < 4; ++f) acc[i][f] = (f32x4){0.f, 0.f, 0.f, 0.f};
    const int nj = K / 32;
#define LOAD_SET(S, j) { _Pragma("unroll") for (int i = 0; i < 2; ++i) Rra[S][i] = __builtin_bit_cast(u32x4, __builtin_amdgcn_raw_buffer_load_b128(ar, aoff[S], ((j) >> 1) * 128 + i * 64, 0)); \
        _Pragma("unroll") for (int i = 0; i < NB; ++i) Rrb[S][i] = __builtin_bit_cast(u32x4, __builtin_amdgcn_raw_buffer_load_b128(br, bvoff, ((j) * 32 + krow0 + KSTEP * i) * (LDB * ESZ), 0)); }
#define LOAD_SET_N(S, j) { _Pragma("unroll") for (int i = 0; i < 2; ++i) Rra[S][i] = __builtin_bit_cast(u32x4, __builtin_amdgcn_raw_buffer_load_b128(ar, aoff_n[S], ((j) >> 1) * 128 + i * 64, 0)); \
        _Pragma("unroll") for (int i = 0; i < NB; ++i) Rrb[S][i] = __builtin_bit_cast(u32x4, __builtin_amdgcn_raw_buffer_load_b128(br_n, bvoff, ((j) * 32 + krow0 + KSTEP * i) * (LDB * ESZ), 0)); }
#define WRITE_SET(S, st, h) { _Pragma("unroll") for (int i = 0; i < 2; ++i) *(u32x4*)(lds + (st) * 65536 + (awr ^ (i ? 64u : 0u)) + (S) * 8192) = Rra[S][i]; \
        _Pragma("unroll") for (int i = 0; i < NB; ++i) { if (BK16) *(u32x4*)(lds + (st) * 65536 + (h) * 8192 + bwr[i]) = Rrb[S][i]; else { \
            const f32x4 v = __builtin_bit_cast(f32x4, Rrb[S][i]); bf16x4 o; o[0] = (__bf16)v[0]; o[1] = (__bf16)v[1]; o[2] = (__bf16)v[2]; o[3] = (__bf16)v[3]; \
            *(bf16x4*)(lds + (st) * 65536 + (h) * 8192 + ((!DUAL) ? ((bwr[0] ^ (unsigned)(i << 4)) + 1024u * i) : bwr[i])) = o; } } }
#define LOAD_SEL(S, jl) { const bool nx_ = (jl) >= nj; const int jt_ = nx_ ? (jl) - nj : (jl); \
        _Pragma("unroll") for (int i = 0; i < 2; ++i) Rra[S][i] = __builtin_bit_cast(u32x4, __builtin_amdgcn_raw_buffer_load_b128(ar, nx_ ? aoff_n[S] : aoff[S], (jt_ >> 1) * 128 + i * 64, 0)); \
        if (nx_) { _Pragma("unroll") for (int i = 0; i < NB; ++i) Rrb[S][i] = __builtin_bit_cast(u32x4, __builtin_amdgcn_raw_buffer_load_b128(br_n, bvoff, (jt_ * 32 + krow0 + KSTEP * i) * (LDB * ESZ), 0)); } \
        else { _Pragma("unroll") for (int i = 0; i < NB; ++i) Rrb[S][i] = __builtin_bit_cast(u32x4, __builtin_amdgcn_raw_buffer_load_b128(br, bvoff, (jt_ * 32 + krow0 + KSTEP * i) * (LDB * ESZ), 0)); } }
#define WRITE_A(S, st, h) { _Pragma("unroll") for (int i = 0; i < 2; ++i) *(u32x4*)(lds + (st) * 65536 + (awr ^ (i ? 64u : 0u)) + (S) * 8192) = Rra[S][i]; }
#define WRITE_B(S, st, h, I0, I1) { _Pragma("unroll") for (int i = (I0); i < (I1); ++i) { if (BK16) *(u32x4*)(lds + (st) * 65536 + (h) * 8192 + bwr[i]) = Rrb[S][i]; else { \
            const f32x4 v = __builtin_bit_cast(f32x4, Rrb[S][i]); bf16x4 o; o[0] = (__bf16)v[0]; o[1] = (__bf16)v[1]; o[2] = (__bf16)v[2]; o[3] = (__bf16)v[3]; \
            *(bf16x4*)(lds + (st) * 65536 + (h) * 8192 + ((!DUAL) ? ((bwr[0] ^ (unsigned)(i << 4)) + 1024u * i) : bwr[i])) = o; } } }
#define LOAD_A(S, jl) { const bool nx_ = (jl) >= nj; const int jt_ = nx_ ? (jl) - nj : (jl); \
        _Pragma("unroll") for (int i = 0; i < 2; ++i) Rra[S][i] = __builtin_bit_cast(u32x4, __builtin_amdgcn_raw_buffer_load_b128(ar, nx_ ? aoff_n[S] : aoff[S], (jt_ >> 1) * 128 + i * 64, 0)); }
#define LOAD_B(S, jl) { const bool nx_ = (jl) >= nj; const int jt_ = nx_ ? (jl) - nj : (jl); \
        if (nx_) { _Pragma("unroll") for (int i = 0; i < NB; ++i) Rrb[S][i] = __builtin_bit_cast(u32x4, __builtin_amdgcn_raw_buffer_load_b128(br_n, bvoff, (jt_ * 32 + krow0 + KSTEP * i) * (LDB * ESZ), 0)); } \
        else { _Pragma("unroll") for (int i = 0; i < NB; ++i) Rrb[S][i] = __builtin_bit_cast(u32x4, __builtin_amdgcn_raw_buffer_load_b128(br, bvoff, (jt_ * 32 + krow0 + KSTEP * i) * (LDB * ESZ), 0)); } }
#define TF_LOAD(dst, st, h, g) { _Pragma("unroll") for (int q_ = 0; q_ < 2; ++q_) dst[q_] = *(const bf16x8*)(lds + (st) * 65536 + ((g) * 2 + q_) * 2048 + (ard ^ ((h) ? 64u : 0u))); }
#define WF_LOAD(st, h) { _Pragma("unroll") for (int f = 0; f < 4; ++f) { \
        const unsigned fx = DUAL ? ((f & 1) << 5) : (f << 5), fo = (DUAL ? (f >> 1) * 16384 : 0) + (st) * 65536 + (h) * 8192; \
        const s16x4 lo = __builtin_amdgcn_ds_read_tr16_b64_v4i16((LAS3 s16x4*)(lds + ((trd0 ^ fx) + fo))); \
        const s16x4 hi = __builtin_amdgcn_ds_read_tr16_b64_v4i16((LAS3 s16x4*)(lds + ((trd1 ^ fx) + fo))); \
        wf[f] = __builtin_bit_cast(bf16x8, __builtin_shufflevector(lo, hi, 0, 1, 2, 3, 4, 5, 6, 7)); } }
#define STAGE_MMA(srcf, g) { _Pragma("unroll") for (int q_ = 0; q_ < 2; ++q_) _Pragma("unroll") for (int f = 0; f < 4; ++f) acc[(g) * 2 + q_][f] = MFMA16(wf[f], srcf[q_], acc[(g) * 2 + q_][f]); }
#define STAGE(st, h, g, cur, nxt) if ((g) < ngrp) { \
        if ((g) + 1 < 4 && (g) + 1 < ngrp) TF_LOAD(nxt, st, h, (g) + 1) \
        __builtin_amdgcn_sched_barrier(0); \
        STAGE_MMA(cur, g) \
        __builtin_amdgcn_sched_barrier(0); }
    const bool comp = active && ngrp > 0;
    bf16x8 fa[2], fb[2], wf[4];
#define HALF_MMA(st, h) if (comp) { STAGE(st, h, 0, fa, fb) STAGE(st, h, 1, fb, fa) STAGE(st, h, 2, fa, fb) STAGE(st, h, 3, fb, fa) }
#define SLOT(st, h, g, cur, nxt, PIECE) { if (comp && (g) < ngrp) { if ((g) + 1 < 4 && (g) + 1 < ngrp) TF_LOAD(nxt, st, h, (g) + 1) } \
        PIECE \
        __builtin_amdgcn_sched_barrier(0); \
        if (comp && (g) < ngrp) { STAGE_MMA(cur, g) } \
        __builtin_amdgcn_sched_barrier(0); }
#define HALF_SLOTS(st, h, S, jl) { SLOT(st, h, 0, fa, fb, WRITE_A(S, (st) ^ 1, h) LOAD_A(S, jl)) SLOT(st, h, 1, fb, fa, WRITE_B(S, (st) ^ 1, h, 0, NB / 2)) \
        SLOT(st, h, 2, fa, fb, WRITE_B(S, (st) ^ 1, h, NB / 2, NB)) SLOT(st, h, 3, fb, fa, LOAD_B(S, jl)) }
#define PREFETCH(st, h) if (comp) { WF_LOAD(st, h) TF_LOAD(fa, st, h, 0) }
    const int nJ = K / 64;
    if (!preloaded) { LOAD_SET(0, 0) LOAD_SET(1, 1) }
    WRITE_SET(0, 0, 0) WRITE_SET(1, 0, 1)
    LOAD_SEL(0, 2) LOAD_SEL(1, 3)
    __syncthreads();
    int st = 0;
#pragma unroll 1
    for (int J = 0; J < nJ - 1; ++J) {
        PREFETCH(st, 0)
        HALF_SLOTS(st, 0, 0, 2 * J + 4)
        PREFETCH(st, 1)
        HALF_SLOTS(st, 1, 1, 2 * J + 5)
        __syncthreads();
        st ^= 1;
    }
    {
        PREFETCH(st, 0)
        HALF_MMA(st, 0)
        PREFETCH(st, 1)
        HALF_MMA(st, 1)
        __syncthreads();
    }
#undef HALF_MMA
#undef SLOT
#undef HALF_SLOTS
#undef WRITE_A
#undef WRITE_B
#undef LOAD_A
#undef LOAD_B
#undef PREFETCH
#undef LOAD_SET
#undef LOAD_SET_N
#undef LOAD_SEL
#undef WRITE_SET
#undef TF_LOAD
#undef WF_LOAD
#undef STAGE_MMA
#undef STAGE
    aoffc[0] = aoff_n[0]; aoffc[1] = aoff_n[1];
    {
        constexpr int NF = DUAL ? 2 : 4, ROWB = NF * 16 * OUTB, NCH = ROWB / 16, RPR = (8192 / ROWB) < 128 ? (8192 / ROWB) : 128, RPI = 64 / NCH, NROUND = 128 / RPR;
        constexpr float FP8_SCALE = 128.f;
        unsigned char* stg = lds + w * 8192;
        int l15e = l15; asm volatile("" : "+v"(l15e));
        const int colbase = (DUAL ? 32 : 64) * wn;
#pragma unroll
        for (int rd = 0; rd < NROUND; ++rd) {
            if (active) {
#pragma unroll
                for (int mt = rd * (RPR / 16); mt < (rd + 1) * (RPR / 16); ++mt) {
                    if ((mt >> 1) < ngrp) {
                        const int rloc = mt * 16 - rd * RPR + l15e, row = 128 * wm + mt * 16 + l15e;
#pragma unroll
                        for (int f = 0; f < NF; ++f) {
                            const f32x4 v = DUAL ? pre(row, colbase + 16 * f + 4 * kg, acc[mt][f], acc[mt][f + 2]) : pre(row, colbase + 16 * f + 4 * kg, acc[mt][f], acc[mt][f]);
                            if (OUTB == 4) *(f32x4*)(stg + rloc * ROWB + ((((unsigned)(4 * f + kg)) ^ (unsigned)(rloc & (NCH - 1))) << 4)) = v;
                            else if (OUTB == 2) { bf16x4 o; o[0] = (__bf16)v[0]; o[1] = (__bf16)v[1]; o[2] = (__bf16)v[2]; o[3] = (__bf16)v[3];
                                *(bf16x4*)(stg + rloc * ROWB + ((((unsigned)(2 * f + (kg >> 1))) ^ (unsigned)(rloc & (NCH - 1))) << 4) + 8 * (kg & 1)) = o; }
                            else { int pk = 0; pk = __builtin_amdgcn_cvt_pk_fp8_f32(v[0] * FP8_SCALE, v[1] * FP8_SCALE, pk, false); pk = __builtin_amdgcn_cvt_pk_fp8_f32(v[2] * FP8_SCALE, v[3] * FP8_SCALE, pk, true);
                                *(int*)(stg + rloc * ROWB + ((((unsigned)f) ^ (unsigned)(rloc & (NCH - 1))) << 4) + 4 * kg) = pk; }
                        }
                    }
                }
                asm volatile("s_waitcnt lgkmcnt(0)" ::: "memory");
#pragma unroll
                for (int it = 0; it < RPR / RPI; ++it) {
                    const int rloc = it * RPI + lane / NCH, c = lane % NCH, row = 128 * wm + rd * RPR + rloc;
                    const u32x4 dv = *(const u32x4*)(stg + rloc * ROWB + ((((unsigned)c) ^ (unsigned)(rloc & (NCH - 1))) << 4));
                    if (row < rows) fin(row, colbase + c * (16 / OUTB), dv);
                }
                asm volatile("s_waitcnt lgkmcnt(0)" ::: "memory");
            }
        }
    }
    __syncthreads();
}

template <bool DUAL, bool BK16, int OUTB, int LDB, int WN, class RowFn, class Pre, class Fin>
DI void gemm_mfma(const bf16_t* Ab, const RowFn& rowoff, const float* B0, const float* B1, unsigned bbytes, int K, int rows, const Pre& pre, const Fin& fin, unsigned char* lds) {
    u32x4 ra[2][2], rb[2][4]; unsigned ao[2] = {0u, 0u};
    gemm_core<DUAL, BK16, OUTB, LDB, WN>(ra, rb, ao, false, Ab, rowoff, B0, B1, bbytes, K, rows, false, rowoff, B0, B1, bbytes, rows, pre, fin, lds);
}
#define PRE_ID [](int, int, f32x4 v, f32x4) { return v; }

DI void phase_prep(const Params& p, int bid, int nblk, float* lds) {
    const int tid = threadIdx.x, lane = tid & 63, wave = tid >> 6;
    bf16_t* xb = (bf16_t*)(p.ws + OFF_XB); float* glow = (float*)(p.ws + OFF_GLOW);
    float tw = 0.f;
    {
        const int ti = (bid >> 3) * NT + tid;
        if (ti < 1536) { const int m = ti >> 9, j = ti & 511; const float* bp = m == 0 ? p.wg : (m == 1 ? p.wu : p.wd); tw = bp[(size_t)j * 131072]; }
    }
    f32x4* Wl = (f32x4*)lds;
    for (int idx = tid; idx < 4096; idx += NT) {
        const int k = idx >> 2, q = idx & 3, ln = (k >> 2) & 63, j = k >> 8, c = k & 3;
        Wl[((j * 4 + c) * 4 + q) * 64 + ln] = *(const f32x4*)(p.w_in + (size_t)k * DIN + GL_OFF + 4 * q);
    }
    __syncthreads();
    for (int row0 = (bid * 8 + wave) * 4; row0 < T; row0 += nblk * 32) {
        asm volatile("" ::: "memory");
        f32x4 xv[4][4];
#pragma unroll
        for (int r = 0; r < 4; ++r)
#pragma unroll
            for (int j = 0; j < 4; ++j) {
                xv[r][j] = ((const f32x4*)(p.x + (size_t)(row0 + r) * D))[lane + 64 * j];
                uint2 o; o.x = pk2(xv[r][j][0], xv[r][j][1]); o.y = pk2(xv[r][j][2], xv[r][j][3]);
                ((uint2*)(xb + (size_t)(row0 + r) * D))[lane + 64 * j] = o;
            }
        float acc[4][16];
#pragma unroll
        for (int r = 0; r < 4; ++r)
#pragma unroll
            for (int n = 0; n < 16; ++n) acc[r][n] = 0.f;
#pragma unroll
        for (int j = 0; j < 4; ++j)
#pragma unroll
            for (int c = 0; c < 4; ++c) {
                float wv[16];
#pragma unroll
                for (int q = 0; q < 4; ++q) { const f32x4 w4 = Wl[((j * 4 + c) * 4 + q) * 64 + lane]; wv[4 * q] = w4[0]; wv[4 * q + 1] = w4[1]; wv[4 * q + 2] = w4[2]; wv[4 * q + 3] = w4[3]; }
#pragma unroll
                for (int r = 0; r < 4; ++r) {
                    const float xs = xv[r][j][c];
#pragma unroll
                    for (int n = 0; n < 16; ++n) acc[r][n] += xs * wv[n];
                }
            }
#define RS_STEP(N, OFF) { const bool up = (lane & (OFF)) != 0; _Pragma("unroll") for (int i = 0; i < (N); ++i) { \
            const float a = acc[i / 16][i % 16], b = acc[(i + (N)) / 16][(i + (N)) % 16]; const float snd = up ? a : b, kp = up ? b : a; \
            acc[i / 16][i % 16] = kp + __shfl_xor(snd, (OFF)); } }
        RS_STEP(32, 32) RS_STEP(16, 16) RS_STEP(8, 8) RS_STEP(4, 4) RS_STEP(2, 2) RS_STEP(1, 1)
#undef RS_STEP
        glow[(size_t)row0 * 16 + lane] = acc[0][0];
    }
    {
        bf16_t* wbin = (bf16_t*)(p.ws + OFF_WB_IN); bf16_t* wbout = (bf16_t*)(p.ws + OFF_WB_OUT); bf16_t* wbrt = (bf16_t*)(p.ws + OFF_WB_RT);
        bf16_t* wbsgu = (bf16_t*)(p.ws + OFF_WB_SGU); bf16_t* wbsd = (bf16_t*)(p.ws + OFF_WB_SD);
        constexpr int N_IN = 1024 * 512, N_OUT = 1024 * 256, N_RT = 1024 * 64, N_SGU = 1024 * 128, N_SD = 256 * 256;
        for (int it = bid * NT + tid; it < N_IN + N_OUT + N_RT + N_SGU + N_SD; it += nblk * NT) {
            const float* s; bf16_t* d; int r = it;
            if (r < N_IN) { const int k = r >> 9, c = (r & 511) * 4; s = p.w_in + (size_t)k * DIN + c; d = wbin + (size_t)k * 2048 + c; }
            else if ((r -= N_IN) < N_OUT) { s = p.w_out + (size_t)r * 4; d = wbout + (size_t)r * 4; }
            else if ((r -= N_OUT) < N_RT) { s = p.router_w + (size_t)r * 4; d = wbrt + (size_t)r * 4; }
            else if ((r -= N_RT) < N_SGU) { const int k = r >> 7, c = (r & 127) * 4, nt = c >> 8, h = (c >> 7) & 1, cc = c & 127; s = (h ? p.su : p.sg) + (size_t)k * EDIM + nt * 128 + cc; d = wbsgu + (size_t)k * 512 + c; }
            else { r -= N_SGU; s = p.sd + (size_t)r * 4; d = wbsd + (size_t)r * 4; }
            const f32x4 v = *(const f32x4*)s; uint2 o; o.x = pk2(v[0], v[1]); o.y = pk2(v[2], v[3]); *(uint2*)d = o;
        }
    }
    asm volatile("" :: "v"(tw));
    __syncthreads();
}

DI void phase_proj(const Params& p, int bid, int nblk, float* lds) {
    const bf16_t* xb = (const bf16_t*)(p.ws + OFF_XB); bf16_t* proj = (bf16_t*)(p.ws + OFF_PROJ); const bf16_t* wbin = (const bf16_t*)(p.ws + OFF_WB_IN);
    u32x4 ra[2][2], rb[2][4]; unsigned ao[2] = {0u, 0u}; bool pre = false;
    const bool xl = (nblk == 256);
    for (int u = bid; u < 64 * 8; u += nblk) {
        const int un = u + nblk; const bool hn = un < 64 * 8;
        const int mt = xl ? 32 * (u >> 8) + 4 * (u & 7) + ((u & 255) >> 6) : u >> 3, nt = xl ? ((u & 255) >> 3) & 7 : u & 7;
        const int mtn = xl ? 32 * (un >> 8) + 4 * (un & 7) + ((un & 255) >> 6) : un >> 3, ntn = xl ? ((un & 255) >> 3) & 7 : un & 7;
        auto rowoff = [&](int r) { return (unsigned)((mt * 256 + r) * D); };
        auto rowoff_n = [&](int r) { return (unsigned)((mtn * 256 + r) * D); };
        auto fin = [&](int r, int c, u32x4 dv) { *(u32x4*)(proj + (size_t)(mt * 256 + r) * NPROJ + nt * 256 + c) = dv; };
        gemm_core<false, true, 2, NPROJ, 4>(ra, rb, ao, pre, xb, rowoff, (const float*)(wbin + nt * 256), nullptr, (unsigned)(((size_t)D * NPROJ - nt * 256) * 2), D, 256,
                                 hn, rowoff_n, (const float*)(wbin + ntn * 256), nullptr, (unsigned)(((size_t)D * NPROJ - ntn * 256) * 2), 256, PRE_ID, fin, (unsigned char*)lds);
        pre = hn;
    }
}

template <int W>
DI void poolmean_item(const bf16_t* proj, bf16_t* pm, int t0, int c2) {
    const int s0 = t0 & (SEQ - 1);
    float p0[48], p1[48]; unsigned raw[32];
    p0[0] = 0.f; p1[0] = 0.f;
#pragma unroll
    for (int i = 0; i < 47; ++i) {
        unsigned v = 0u;
        if (i >= 15 || s0 > 0) v = *(const unsigned*)(proj + (size_t)(t0 - 15 + i) * NPROJ + P_OFF + c2);
        if (i >= 15) raw[i - 15] = v;
        p0[i + 1] = p0[i] + __uint_as_float(v << 16); p1[i + 1] = p1[i] + __uint_as_float(v & 0xffff0000u);
    }
#pragma unroll
    for (int i = 0; i < 32; ++i) {
        const int s = s0 + i; const float inv = 1.f / (float)min(s + 1, W);
        const float m0 = (p0[i + 16] - p0[i + 16 - W]) * inv - __uint_as_float(raw[i] << 16);
        const float m1 = (p1[i + 16] - p1[i + 16 - W]) * inv - __uint_as_float(raw[i] & 0xffff0000u);
        *(unsigned*)(pm + (size_t)(t0 + i) * 512 + c2) = pk2(m0, m1);
    }
}
DI void phase_poolmean(const Params& p, int bid, int nblk, float* lds) {
    const bf16_t* proj = (const bf16_t*)(p.ws + OFF_PROJ); bf16_t* pm = (bf16_t*)(p.ws + OFF_PM);
    for (int item = bid * NT + threadIdx.x; item < 256 * (T / 32); item += nblk * NT) {
        const int pair = item & 255, t0 = (item >> 8) * 32, c2 = pair * 2, g = __builtin_amdgcn_readfirstlane(pair >> 6);
        if (g == 0) poolmean_item<2>(proj, pm, t0, c2);
        else if (g == 1) poolmean_item<4>(proj, pm, t0, c2);
        else if (g == 2) poolmean_item<8>(proj, pm, t0, c2);
        else poolmean_item<16>(proj, pm, t0, c2);
    }
}
DI void phase_pool(const Params& p, int bid, int nblk, float* lds) {
    const bf16_t* pm = (const bf16_t*)(p.ws + OFF_PM); bf16_t* mix = (bf16_t*)(p.ws + OFF_MIX);
    for (int u = bid; u < 64 * 4; u += nblk) {
        const int mt = u >> 2, g = u & 3;
        auto rowoff = [&](int r) { return (unsigned)((mt * 256 + r) * 512 + g * 128); };
        auto pre = [&](int r, int c, f32x4 v, f32x4) { const f32x4 sc = *(const f32x4*)(p.pool_scale + g * 128 + c); return v * sc; };
        auto fin = [&](int r, int c, u32x4 dv) { *(u32x4*)(mix + (size_t)(mt * 256 + r) * D + g * 128 + c) = dv; };
        gemm_mfma<false, false, 2, 128, 2>(pm, rowoff, p.pool_w + (size_t)g * 16384, nullptr, (unsigned)((4 - g) * 16384 * 4), 128, 256, pre, fin, (unsigned char*)lds);
    }
}

DI unsigned f1_off(unsigned row, unsigned chunk) { return row * 128u + ((chunk ^ ((row >> 1) & 7u)) << 4); }
DI unsigned f2_off(unsigned row, unsigned ch) { return 256u * row + 16u * (ch ^ (((row & 3u) << 2) | ((row >> 2) & 3u))); }
DI bf16x8 f1_frag(const unsigned char* img, int tile, int ks, int lane) { return *(const bf16x8*)(img + f1_off(16 * tile + (lane & 15), 4 * ks + (lane >> 4))); }
DI bf16x8 f2_frag(const unsigned char* img, int c, int ks, int lane) {
    const unsigned g = lane >> 4, q = (lane & 15) >> 2, pp = lane & 3;
    const unsigned a0 = f2_off(32 * ks + 8 * g + q, 2 * c + (pp >> 1)) + 8 * (pp & 1), a1 = f2_off(32 * ks + 8 * g + 4 + q, 2 * c + (pp >> 1)) + 8 * (pp & 1);
    const s16x4 lo = __builtin_amdgcn_ds_read_tr16_b64_v4i16((LAS3 s16x4*)(img + a0)), hi = __builtin_amdgcn_ds_read_tr16_b64_v4i16((LAS3 s16x4*)(img + a1));
    return __builtin_bit_cast(bf16x8, __builtin_shufflevector(lo, hi, 0, 1, 2, 3, 4, 5, 6, 7));
}
DI float bfbits2f(unsigned short v) { return __uint_as_float(((unsigned)v) << 16); }
typedef unsigned short u16x8 __attribute__((ext_vector_type(8)));
typedef unsigned short u16x4 __attribute__((ext_vector_type(4)));

DI void phase_gla1(const Params& p, int bid, int nblk, float* ldsf) {
    unsigned char* lds = (unsigned char*)ldsf;
    int tid_ = threadIdx.x; asm volatile("" : "+v"(tid_));
    const int tid = tid_, lane = tid & 63, w = __builtin_amdgcn_readfirstlane(tid >> 6), t = tid >> 3, ch = tid & 7;
    const bf16_t* proj = (const bf16_t*)(p.ws + OFF_PROJ); const float* glow = (const float*)(p.ws + OFF_GLOW);
    float* Gbuf = (float*)(p.ws + OFF_G); float* Sloc = (float*)(p.ws + OFF_SLOC); float* dec = (float*)(p.ws + OFF_DEC);
    float* G = (float*)lds; unsigned char* Kimg = lds + 16384; unsigned char* Vimg = lds + 32768; float* W2l = (float*)(lds + 49152); float* segtot = (float*)(lds + 53248);
    for (int unit = bid; unit < 1024; unit += nblk) {
        const int bh = unit >> 6, n = unit & 63, b = bh >> 2, h = bh & 3, t0 = b * SEQ + n * SC;
        for (int i = tid; i < 1024; i += NT) W2l[i] = p.gate_w2[(i >> 6) * 256 + h * 64 + (i & 63)];
#pragma unroll
        for (int i = 0; i < 2; ++i) { const int idx = tid + NT * i, tr = idx >> 4, c16 = idx & 15;
            *(u32x4*)(Vimg + f2_off(tr, c16)) = *(const u32x4*)(proj + (size_t)(t0 + tr) * NPROJ + V_OFF + h * 128 + 8 * c16); }
        __syncthreads();
        {
            float gl[16];
#pragma unroll
            for (int q = 0; q < 4; ++q) { const f32x4 v = *(const f32x4*)(glow + (size_t)(t0 + t) * 16 + 4 * q); gl[4 * q] = v[0]; gl[4 * q + 1] = v[1]; gl[4 * q + 2] = v[2]; gl[4 * q + 3] = v[3]; }
#pragma unroll
            for (int dd = 0; dd < 8; ++dd) { const int d = 8 * ch + dd; float z = p.gate_b[h * 64 + d];
#pragma unroll
                for (int r = 0; r < 16; ++r) z += gl[r] * W2l[r * 64 + d];
                G[t * 64 + d] = logsigmoidf_(z) * (1.f / 16.f); }
        }
        __syncthreads();
        {
            const int seg = tid >> 6, d = tid & 63; float run = 0.f;
#pragma unroll
            for (int tt = 0; tt < 8; ++tt) { run += G[(8 * seg + tt) * 64 + d]; G[(8 * seg + tt) * 64 + d] = run; }
            segtot[seg * 64 + d] = run;
            __syncthreads();
            float pre = 0.f;
            for (int s2 = 0; s2 < seg; ++s2) pre += segtot[s2 * 64 + d];
#pragma unroll
            for (int tt = 0; tt < 8; ++tt) G[(8 * seg + tt) * 64 + d] += pre;
        }
        __syncthreads();
        {
            const f32x4 g0 = *(const f32x4*)(G + t * 64 + 8 * ch), g1 = *(const f32x4*)(G + t * 64 + 8 * ch + 4);
            const f32x4 l0 = *(const f32x4*)(G + 63 * 64 + 8 * ch), l1 = *(const f32x4*)(G + 63 * 64 + 8 * ch + 4);
            *(f32x4*)(Gbuf + (size_t)(t0 + t) * 256 + h * 64 + 8 * ch) = g0; *(f32x4*)(Gbuf + (size_t)(t0 + t) * 256 + h * 64 + 8 * ch + 4) = g1;
            const u16x8 kv = *(const u16x8*)(proj + (size_t)(t0 + t) * NPROJ + K_OFF + h * 64 + 8 * ch);
            bf16x8 o;
#pragma unroll
            for (int dd = 0; dd < 4; ++dd) { o[dd] = (__bf16)(bfbits2f(kv[dd]) * __expf(l0[dd] - g0[dd])); o[dd + 4] = (__bf16)(bfbits2f(kv[dd + 4]) * __expf(l1[dd] - g1[dd])); }
            *(bf16x8*)(Kimg + f2_off(t, ch)) = o;
            if (t == 63) {
#pragma unroll
                for (int dd = 0; dd < 4; ++dd) { dec[unit * 64 + 8 * ch + dd] = __expf(l0[dd]); dec[unit * 64 + 8 * ch + 4 + dd] = __expf(l1[dd]); }
            }
        }
        __syncthreads();
        {
            f32x4 acc[4];
#pragma unroll
            for (int dt = 0; dt < 4; ++dt) acc[dt] = (f32x4){0.f, 0.f, 0.f, 0.f};
#pragma unroll
            for (int ks = 0; ks < 2; ++ks) {
                const bf16x8 xv = f2_frag(Vimg, w, ks, lane);
#pragma unroll
                for (int dt = 0; dt < 4; ++dt) acc[dt] = MFMA16(xv, f2_frag(Kimg, dt, ks, lane), acc[dt]);
            }
#pragma unroll
            for (int dt = 0; dt < 4; ++dt) *(f32x4*)(Sloc + (size_t)unit * 8192 + (16 * dt + (lane & 15)) * 128 + 16 * w + 4 * (lane >> 4)) = acc[dt];
        }
        __syncthreads();
    }
}

DI void phase_gla2(const Params& p, int bid, int nblk, float* lds) {
    const float* Sloc = (const float*)(p.ws + OFF_SLOC); const float* dec = (const float*)(p.ws + OFF_DEC); bf16_t* Sin = (bf16_t*)(p.ws + OFF_SIN);
    for (int gid = bid * NT + threadIdx.x; gid < 16 * 8192; gid += nblk * NT) {
        const int bh = gid >> 13, el = gid & 8191, d = el >> 7; float st = 0.f;
        for (int n0 = 0; n0 < NSC; n0 += 16) {
            float sl[16], dc[16]; bf16_t so[16];
#pragma unroll
            for (int i = 0; i < 16; ++i) { const int u = bh * 64 + n0 + i; sl[i] = Sloc[(size_t)u * 8192 + el]; dc[i] = dec[u * 64 + d]; }
#pragma unroll
            for (int i = 0; i < 16; ++i) { so[i] = f2bf(st); st = st * dc[i] + sl[i]; }
#pragma unroll
            for (int i = 0; i < 16; ++i) Sin[(size_t)(bh * 64 + n0 + i) * 8192 + el] = so[i];
        }
    }
}

DI void phase_gla3(const Params& p, int bid, int nblk, float* ldsf) {
    unsigned char* lds = (unsigned char*)ldsf;
    int tid_ = threadIdx.x; asm volatile("" : "+v"(tid_));
    const int tid = tid_, lane = tid & 63, w = __builtin_amdgcn_readfirstlane(tid >> 6), t = tid >> 3, ch = tid & 7, l15 = lane & 15, kg = lane >> 4;
    const bf16_t* proj = (const bf16_t*)(p.ws + OFF_PROJ); const float* Gbuf = (const float*)(p.ws + OFF_G); const bf16_t* Sin = (const bf16_t*)(p.ws + OFF_SIN);
    bf16_t* mix = (bf16_t*)(p.ws + OFF_MIX);
    unsigned char* Qimg = lds; unsigned char* Kimg = lds + 8192; unsigned char* Pimg = lds + 16384; unsigned char* Vimg = lds + 24576; unsigned char* Simg = lds + 40960;
    float* part = (float*)(lds + 57344);
    for (int unit = bid; unit < 1024; unit += nblk) {
        const int bh = unit >> 6, n = unit & 63, b = bh >> 2, h = bh & 3, t0 = b * SEQ + n * SC;
        {
            const f32x4 g0 = *(const f32x4*)(Gbuf + (size_t)(t0 + t) * 256 + h * 64 + 8 * ch), g1 = *(const f32x4*)(Gbuf + (size_t)(t0 + t) * 256 + h * 64 + 8 * ch + 4);
            const u16x8 qv = *(const u16x8*)(proj + (size_t)(t0 + t) * NPROJ + Q_OFF + h * 64 + 8 * ch), kv = *(const u16x8*)(proj + (size_t)(t0 + t) * NPROJ + K_OFF + h * 64 + 8 * ch);
            bf16x8 qo, ko;
#pragma unroll
            for (int dd = 0; dd < 4; ++dd) {
                qo[dd] = (__bf16)(bfbits2f(qv[dd]) * 0.125f * __expf(g0[dd])); qo[dd + 4] = (__bf16)(bfbits2f(qv[dd + 4]) * 0.125f * __expf(g1[dd]));
                ko[dd] = (__bf16)(bfbits2f(kv[dd]) * __expf(-g0[dd])); ko[dd + 4] = (__bf16)(bfbits2f(kv[dd + 4]) * __expf(-g1[dd]));
            }
            *(bf16x8*)(Qimg + f1_off(t, ch)) = qo; *(bf16x8*)(Kimg + f1_off(t, ch)) = ko;
        }
#pragma unroll
        for (int i = 0; i < 2; ++i) { const int idx = tid + NT * i, tr = idx >> 4, c16 = idx & 15;
            *(u32x4*)(Vimg + f2_off(tr, c16)) = *(const u32x4*)(proj + (size_t)(t0 + tr) * NPROJ + V_OFF + h * 128 + 8 * c16);
            *(u32x4*)(Simg + f2_off(tr, c16)) = *(const u32x4*)(Sin + (size_t)unit * 8192 + tr * 128 + 8 * c16); }
        __syncthreads();
        {
            const int it = w >> 1;
#pragma unroll
            for (int jj = 0; jj < 2; ++jj) {
                const int jt = 2 * (w & 1) + jj; f32x4 acc = {0.f, 0.f, 0.f, 0.f};
                if (jt <= it) {
#pragma unroll
                    for (int ks = 0; ks < 2; ++ks) acc = MFMA16(f1_frag(Kimg, jt, ks, lane), f1_frag(Qimg, it, ks, lane), acc);
                    if (jt == it) {
#pragma unroll
                        for (int r = 0; r < 4; ++r) if (4 * kg + r > l15) acc[r] = 0.f;
                    }
                }
                bf16x4 o; o[0] = (__bf16)acc[0]; o[1] = (__bf16)acc[1]; o[2] = (__bf16)acc[2]; o[3] = (__bf16)acc[3];
                *(bf16x4*)(Pimg + f1_off(16 * it + l15, 2 * jt + (kg >> 1)) + 8 * (kg & 1)) = o;
            }
        }
        __syncthreads();
        {
            f32x4 acc[4];
#pragma unroll
            for (int it = 0; it < 4; ++it) acc[it] = (f32x4){0.f, 0.f, 0.f, 0.f};
#pragma unroll
            for (int ks = 0; ks < 2; ++ks) {
                const bf16x8 xv = f2_frag(Vimg, w, ks, lane), xs = f2_frag(Simg, w, ks, lane);
#pragma unroll
                for (int it = 0; it < 4; ++it) {
                    if (2 * ks <= it) acc[it] = MFMA16(xv, f1_frag(Pimg, it, ks, lane), acc[it]);
                    acc[it] = MFMA16(xs, f1_frag(Qimg, it, ks, lane), acc[it]);
                }
            }
#pragma unroll
            for (int it = 0; it < 4; ++it) {
                float ss = acc[it][0] * acc[it][0] + acc[it][1] * acc[it][1] + acc[it][2] * acc[it][2] + acc[it][3] * acc[it][3];
                ss += __shfl_xor(ss, 16); ss += __shfl_xor(ss, 32);
                if (kg == 0) part[w * 64 + 16 * it + l15] = ss;
            }
            __syncthreads();
            const int e0 = 16 * w + 4 * kg; const f32x4 nw = *(const f32x4*)(p.norm_w + e0);
#pragma unroll
            for (int it = 0; it < 4; ++it) {
                const int i = 16 * it + l15; float tot = 0.f;
#pragma unroll
                for (int w2 = 0; w2 < 8; ++w2) tot += part[w2 * 64 + i];
                const float inv = rsqrtf(tot * (1.f / 128.f) + RMS_EPS);
                const u16x4 rv = *(const u16x4*)(proj + (size_t)(t0 + i) * NPROJ + R_OFF + h * 128 + e0);
                bf16x4 o;
#pragma unroll
                for (int r = 0; r < 4; ++r) { const float rr = bfbits2f(rv[r]); o[r] = (__bf16)(acc[it][r] * inv * nw[r] * (rr * sigmoidf_(rr))); }
                *(bf16x4*)(mix + (size_t)(t0 + i) * D + 512 + h * 128 + e0) = o;
            }
        }
        __syncthreads();
    }
}

DI void phase_out(const Params& p, int bid, int nblk, float* lds) {
    const bf16_t* mix = (const bf16_t*)(p.ws + OFF_MIX); const bf16_t* xb = (const bf16_t*)(p.ws + OFF_XB); bf16_t* yb = (bf16_t*)(p.ws + OFF_H32);
    for (int u = bid; u < 64 * 4; u += nblk) {
        const int mt = (nblk == 256) ? 8 * (u & 7) + (u >> 5) : u >> 2, nt = (nblk == 256) ? (u >> 3) & 3 : u & 3;
        auto rowoff = [&](int r) { return (unsigned)((mt * 256 + r) * D); };
        auto fin = [&](int r, int c, u32x4 dv) {
            const size_t o = (size_t)(mt * 256 + r) * D + nt * 256 + c; const u32x4 xr = *(const u32x4*)(xb + o);
            const f32x4 x0 = {bf2f((bf16_t)(xr[0] & 0xffffu)), bf2f((bf16_t)(xr[0] >> 16)), bf2f((bf16_t)(xr[1] & 0xffffu)), bf2f((bf16_t)(xr[1] >> 16))};
            const f32x4 x1 = {bf2f((bf16_t)(xr[2] & 0xffffu)), bf2f((bf16_t)(xr[2] >> 16)), bf2f((bf16_t)(xr[3] & 0xffffu)), bf2f((bf16_t)(xr[3] >> 16))};
            u32x4 ov;
            ov[0] = pk2(bf2f((bf16_t)(dv[0] & 0xffffu)) + ALPHA * x0[0], bf2f((bf16_t)(dv[0] >> 16)) + ALPHA * x0[1]);
            ov[1] = pk2(bf2f((bf16_t)(dv[1] & 0xffffu)) + ALPHA * x0[2], bf2f((bf16_t)(dv[1] >> 16)) + ALPHA * x0[3]);
            ov[2] = pk2(bf2f((bf16_t)(dv[2] & 0xffffu)) + ALPHA * x1[0], bf2f((bf16_t)(dv[2] >> 16)) + ALPHA * x1[1]);
            ov[3] = pk2(bf2f((bf16_t)(dv[3] & 0xffffu)) + ALPHA * x1[2], bf2f((bf16_t)(dv[3] >> 16)) + ALPHA * x1[3]);
            *(u32x4*)(yb + o) = ov; };
        gemm_mfma<false, true, 2, D, 4>(mix, rowoff, (const float*)((const bf16_t*)(p.ws + OFF_WB_OUT) + nt * 256), nullptr, (unsigned)(((size_t)D * D - nt * 256) * 2), D, 256, PRE_ID, fin, (unsigned char*)lds);
    }
}

DI void ln_row(float (&v)[16], const float* g, const float* b, int lane) {
    float s = 0.f;
#pragma unroll
    for (int i = 0; i < 16; ++i) s += v[i];
    const float mean = wave_sum(s) * (1.f / D); float q = 0.f;
#pragma unroll
    for (int i = 0; i < 16; ++i) { v[i] -= mean; q += v[i] * v[i]; }
    const float rstd = rsqrtf(wave_sum(q) * (1.f / D) + LN_EPS);
#pragma unroll
    for (int j = 0; j < 4; ++j) {
        const float4 gg = ((const float4*)g)[lane + 64 * j], bb = ((const float4*)b)[lane + 64 * j];
        v[4 * j] = v[4 * j] * rstd * gg.x + bb.x; v[4 * j + 1] = v[4 * j + 1] * rstd * gg.y + bb.y;
        v[4 * j + 2] = v[4 * j + 2] * rstd * gg.z + bb.z; v[4 * j + 3] = v[4 * j + 3] * rstd * gg.w + bb.w;
    }
}

DI void ln1_rows(const Params& p, int r0, int nrows) {
    int tid_ = threadIdx.x; asm volatile("" : "+v"(tid_));
    const int lane = tid_ & 63, wave = tid_ >> 6;
    const bf16_t* yb = (const bf16_t*)(p.ws + OFF_H32); bf16_t* hb = (bf16_t*)(p.ws + OFF_HB);
    for (int rb = r0 + wave; rb < r0 + nrows; rb += 32) {
        float v[4][16];
#pragma unroll
        for (int q = 0; q < 4; ++q) {
            const u32x4* hr = (const u32x4*)(yb + (size_t)(rb + 8 * q) * D);
#pragma unroll
            for (int j = 0; j < 2; ++j) { const u32x4 a = hr[lane + 64 * j];
                _Pragma("unroll") for (int k = 0; k < 4; ++k) { v[q][8 * j + 2 * k] = bf2f((bf16_t)(a[k] & 0xffffu)); v[q][8 * j + 2 * k + 1] = bf2f((bf16_t)(a[k] >> 16)); } }
        }
        float s[4], qq[4];
#pragma unroll
        for (int q = 0; q < 4; ++q) { s[q] = 0.f; _Pragma("unroll") for (int i = 0; i < 16; ++i) s[q] += v[q][i]; }
#pragma unroll
        for (int o = 1; o < 64; o <<= 1) { _Pragma("unroll") for (int q = 0; q < 4; ++q) s[q] += __shfl_xor(s[q], o); }
#pragma unroll
        for (int q = 0; q < 4; ++q) { const float mean = s[q] * (1.f / D); qq[q] = 0.f; _Pragma("unroll") for (int i = 0; i < 16; ++i) { v[q][i] -= mean; qq[q] += v[q][i] * v[q][i]; } }
#pragma unroll
        for (int o = 1; o < 64; o <<= 1) { _Pragma("unroll") for (int q = 0; q < 4; ++q) qq[q] += __shfl_xor(qq[q], o); }
#pragma unroll
        for (int j = 0; j < 2; ++j) {
            const float4 g0 = ((const float4*)p.ln1_g)[2 * (lane + 64 * j)], g1 = ((const float4*)p.ln1_g)[2 * (lane + 64 * j) + 1];
            const float4 b0 = ((const float4*)p.ln1_b)[2 * (lane + 64 * j)], b1 = ((const float4*)p.ln1_b)[2 * (lane + 64 * j) + 1];
#pragma unroll
            for (int q = 0; q < 4; ++q) {
                const float rstd = rsqrtf(qq[q] * (1.f / D) + LN_EPS); const float* w = &v[q][8 * j];
                u32x4 o;
                o[0] = pk2(w[0] * rstd * g0.x + b0.x, w[1] * rstd * g0.y + b0.y); o[1] = pk2(w[2] * rstd * g0.z + b0.z, w[3] * rstd * g0.w + b0.w);
                o[2] = pk2(w[4] * rstd * g1.x + b1.x, w[5] * rstd * g1.y + b1.y); o[3] = pk2(w[6] * rstd * g1.z + b1.z, w[7] * rstd * g1.w + b1.w);
                ((u32x4*)(hb + (size_t)(rb + 8 * q) * D))[lane + 64 * j] = o;
            }
        }
    }
}

DI void topk_rows(const Params& p, const float* sc_lds, int r0, int nrows) {
    int tid_ = threadIdx.x; asm volatile("" : "+v"(tid_));
    const int lane = tid_ & 63, wave = tid_ >> 6;
    float* wbuf = (float*)(p.ws + OFF_WBUF);
    int* list = (int*)(p.ws + OFF_LIST); unsigned* cnt = (unsigned*)(p.ws + OFF_CTL) + CW_CNT;
    const float NEG = -__builtin_inff();
    for (int t = r0 + wave; t < r0 + nrows; t += 8) {
        const float4 sv = ((const float4*)(sc_lds + (size_t)(t - r0) * NE))[lane], bv = ((const float4*)p.router_bias)[lane];
        const float s[4] = {sv.x, sv.y, sv.z, sv.w};
        float cand[4] = {sv.x + bv.x, sv.y + bv.y, sv.z + bv.z, sv.w + bv.w};
        float m1 = NEG, m2 = NEG;
#pragma unroll
        for (int j = 0; j < 4; ++j) { const float v = cand[j]; if (v > m1) { m2 = m1; m1 = v; } else if (v > m2) m2 = v; }
#pragma unroll
        for (int off = 1; off < 8; off <<= 1) {
            const float o1 = __shfl_xor(m1, off), o2 = __shfl_xor(m2, off);
            const float n1 = fmaxf(m1, o1), n2 = fmaxf(fminf(m1, o1), fmaxf(m2, o2)); m1 = n1; m2 = n2;
        }
        const float gs = m1 + m2; const int mygrp = lane >> 3; int rank = 0;
#pragma unroll
        for (int g2 = 0; g2 < 8; ++g2) { const float og = __shfl(gs, g2 * 8); if (og > gs || (og == gs && g2 < mygrp)) ++rank; }
        if (rank >= 4) { cand[0] = NEG; cand[1] = NEG; cand[2] = NEG; cand[3] = NEG; }
        int my_e = 0; float my_w = 0.f, wsum = 0.f;
#pragma unroll
        for (int k = 0; k < TOPK; ++k) {
            float bvv = cand[0]; int bj = 0;
#pragma unroll
            for (int j = 1; j < 4; ++j) if (cand[j] > bvv) { bvv = cand[j]; bj = j; }
            int bi = 4 * lane + bj;
#pragma unroll
            for (int off = 32; off >= 1; off >>= 1) {
                const float ov = __shfl_xor(bvv, off); const int oi = __shfl_xor(bi, off);
                if (ov > bvv || (ov == bvv && oi < bi)) { bvv = ov; bi = oi; }
            }
            const int wj = bi & 3, wl = bi >> 2;
            const float mys = wj == 0 ? s[0] : (wj == 1 ? s[1] : (wj == 2 ? s[2] : s[3]));
            const float wk = __shfl(mys, wl);
            wsum += wk;
            if (lane == k) { my_e = bi; my_w = wk; }
            if (lane == wl) {
#pragma unroll
                for (int j = 0; j < 4; ++j) if (j == wj) cand[j] = NEG;
            }
        }
        if (lane < TOPK) {
            const unsigned pos = atomicAdd(&cnt[my_e], 1u);
            list[(size_t)my_e * LCAP + pos] = t * TOPK + lane;
            wbuf[(size_t)t * TOPK + lane] = my_w / wsum * 2.5f;
        }
    }
}

DI void phase_route(const Params& p, int bid, int nblk, float* lds) {
    const bf16_t* hb = (const bf16_t*)(p.ws + OFF_HB); float* scores = (float*)(p.ws + OFF_SCORES);
    for (int mt = bid; mt < T / 64; mt += nblk) {
        ln1_rows(p, mt * 64, 64);
        __syncthreads();
        auto rowoff = [&](int r) { return (unsigned)((mt * 64 + r) * D); };
        auto pre = [&](int r, int c, f32x4 v, f32x4) { return (f32x4){sigmoidf_(v[0]), sigmoidf_(v[1]), sigmoidf_(v[2]), sigmoidf_(v[3])}; };
        auto fin = [&](int r, int c, u32x4 dv) { *(u32x4*)((unsigned char*)lds + 65536 + (r * NE + c) * 4) = dv; };
        gemm_mfma<false, true, 4, NE, 4>(hb, rowoff, (const float*)(p.ws + OFF_WB_RT), nullptr, (unsigned)(D * NE * 2), D, 64, pre, fin, (unsigned char*)lds);
        __syncthreads();
        topk_rows(p, (const float*)((unsigned char*)lds + 65536), mt * 64, 64);
        __syncthreads();
    }
}

constexpr int EXP_TAB_OFF = GEMM_LDS_BYTES;
DI void build_tables(const Params& p, int* toff, int* roff) {
    const unsigned* cnt = (const unsigned*)(p.ws + OFF_CTL) + CW_CNT;
    int* cl = roff + 260;
    if (threadIdx.x < NE) cl[threadIdx.x] = (int)__hip_atomic_load(cnt + threadIdx.x, __ATOMIC_RELAXED, __HIP_MEMORY_SCOPE_AGENT);
    __syncthreads();
    if (threadIdx.x <= NE) {
        int ta = 0, ra = 0;
        for (int e = 0; e < (int)threadIdx.x; ++e) { const int c = cl[e]; ta += (c + 255) >> 8; ra += c; }
        toff[threadIdx.x] = ta; roff[threadIdx.x] = ra;
    }
    __syncthreads();
    if (threadIdx.x < NE) { unsigned char* texp = (unsigned char*)(roff + 1040); for (int t = toff[threadIdx.x]; t < toff[threadIdx.x + 1]; ++t) texp[t] = (unsigned char)threadIdx.x; }
    __syncthreads();
}
DI int find_expert(const int* toff, int tile) { int lo = 0, hi = NE - 1; while (lo < hi) { const int mid = (lo + hi + 1) >> 1; if (toff[mid] <= tile) lo = mid; else hi = mid - 1; } return lo; }
struct ExpUnit { int e, row0, rows, rowbase; };
DI ExpUnit exp_unit(const int* toff, const int* roff, int e, int tile, int ntile) {
    const int* cl = roff + 260;
    ExpUnit u;
    if (tile < ntile) {
        u.e = e; const int ui = tile - toff[e], c = cl[e];
        u.row0 = ui * 256; u.rows = min(256, c - u.row0); u.rowbase = roff[e] + u.row0;
    } else { u.e = NE; u.row0 = (tile - ntile) * 256; u.rows = 256; u.rowbase = A_TOT + u.row0; }
    u.e = __builtin_amdgcn_readfirstlane(u.e); u.row0 = __builtin_amdgcn_readfirstlane(u.row0); u.rows = __builtin_amdgcn_readfirstlane(u.rows);
    u.rowbase = __builtin_amdgcn_readfirstlane(u.rowbase);
    return u;
}

template <int NTL>
DI int exp_decode(const int* toff, int ntile, int u, int& tile, int& nt) {
    if (u < NTL * ntile) {
        const unsigned char* texp = (const unsigned char*)(toff + 260 + 1040);
        const int e = texp[u / NTL], t0 = toff[e], ne = toff[e + 1] - t0; int u2 = u - NTL * t0; nt = 0;
#pragma unroll
        for (int i = 1; i < NTL; ++i) if (u2 >= ne) { u2 -= ne; ++nt; }
        tile = t0 + u2; return e;
    }
    else { const int us = u - NTL * ntile; nt = us / (T / 256); tile = ntile + (us - nt * (T / 256)); return NE; }
}

DI void phase_e1(const Params& p, int bid, int nblk, float* lds) {
    int* toff = (int*)((unsigned char*)lds + EXP_TAB_OFF); int* roff = toff + 260;
    const bf16_t* hb = (const bf16_t*)(p.ws + OFF_HB); bf16_t* hid = (bf16_t*)(p.ws + OFF_HID); const int* list = (const int*)(p.ws + OFF_LIST);
    build_tables(p, toff, roff);
    const int ntile = toff[NE], units = (ntile + T / 256) * 2;
    const int vb = (nblk & 7) ? bid : (bid & 7) * (nblk >> 3) + (bid >> 3);
    u32x4 ra[2][2], rb[2][4]; unsigned ao[2] = {0u, 0u}; bool pre = false;
    int tile_n = 0, nt_n = 0; ExpUnit xn;
    if (vb < units) { const int e_ = exp_decode<2>(toff, ntile, vb, tile_n, nt_n); xn = exp_unit(toff, roff, e_, tile_n, ntile); }
    for (int u = vb; u < units; u += nblk) {
        const int nt = nt_n; const ExpUnit x = xn; const bool hn = u + nblk < units;
        if (hn) { const int e_ = exp_decode<2>(toff, ntile, u + nblk, tile_n, nt_n); xn = exp_unit(toff, roff, e_, tile_n, ntile); }
        const float* wg = x.e < NE ? p.wg + (size_t)x.e * 262144 : p.sg; const float* wu = x.e < NE ? p.wu + (size_t)x.e * 262144 : p.su;
        const float* wgn = xn.e < NE ? p.wg + (size_t)xn.e * 262144 : p.sg; const float* wun = xn.e < NE ? p.wu + (size_t)xn.e * 262144 : p.su;
        auto rowoff = [&](int r) { const int tok = x.e < NE ? (list[(size_t)x.e * LCAP + x.row0 + r] >> 3) : (x.row0 + r); return (unsigned)(tok * D); };
        auto rowoff_n = [&](int r) { const int tok = xn.e < NE ? (list[(size_t)xn.e * LCAP + xn.row0 + r] >> 3) : (xn.row0 + r); return (unsigned)(tok * D); };
        auto prf = [&](int r, int c, f32x4 g, f32x4 uu) { return (f32x4){g[0] * sigmoidf_(g[0]) * uu[0], g[1] * sigmoidf_(g[1]) * uu[1], g[2] * sigmoidf_(g[2]) * uu[2], g[3] * sigmoidf_(g[3]) * uu[3]}; };
        auto fin = [&](int r, int c, u32x4 dv) { *(u32x4*)(hid + (size_t)(x.rowbase + r) * EDIM + nt * 128 + c) = dv; };
        gemm_core<true, false, 2, EDIM, 4>(ra, rb, ao, pre, hb, rowoff, wg + nt * 128, wu + nt * 128, (unsigned)((D * EDIM - nt * 128) * 4), D, x.rows,
                                 hn, rowoff_n, wgn + nt_n * 128, wun + nt_n * 128, (unsigned)((D * EDIM - nt_n * 128) * 4), xn.rows, prf, fin, (unsigned char*)lds);
        pre = hn;
    }
}

DI void phase_e2(const Params& p, int bid, int nblk, float* lds) {
    int* toff = (int*)((unsigned char*)lds + EXP_TAB_OFF); int* roff = toff + 260; int* rowa = roff + 520;
    const bf16_t* hid = (const bf16_t*)(p.ws + OFF_HID); unsigned char* Y = p.ws + OFF_Y; const int* list = (const int*)(p.ws + OFF_LIST);
    build_tables(p, toff, roff);
    const int ntile = toff[NE], units = (ntile + T / 256) * 4;
    const int vb = (nblk & 7) ? bid : (bid & 7) * (nblk >> 3) + (bid >> 3);
    u32x4 ra[2][2], rb[2][4]; unsigned ao[2] = {0u, 0u}; bool pre = false;
    int tile_n = 0, nt_n = 0; ExpUnit xn;
    auto rowa_val = [&](const ExpUnit& q, int r) { return q.e < NE ? (r < q.rows ? list[(size_t)q.e * LCAP + q.row0 + r] : 0) : (A_TOT + q.row0 + r); };
    if (vb < units) { const int e_ = exp_decode<4>(toff, ntile, vb, tile_n, nt_n); xn = exp_unit(toff, roff, e_, tile_n, ntile); if (threadIdx.x < 256) rowa[threadIdx.x] = rowa_val(xn, threadIdx.x); }
    __syncthreads();
    int cur = 0;
    for (int u = vb; u < units; u += nblk) {
        const int nt = nt_n; const ExpUnit x = xn; const bool hn = u + nblk < units;
        if (hn) { const int e_ = exp_decode<4>(toff, ntile, u + nblk, tile_n, nt_n); xn = exp_unit(toff, roff, e_, tile_n, ntile); }
        const float* wd = x.e < NE ? p.wd + (size_t)x.e * 262144 : p.sd; const float* wdn = xn.e < NE ? p.wd + (size_t)xn.e * 262144 : p.sd;
        int rnext = 0;
        if (hn && threadIdx.x < 256) rnext = rowa_val(xn, threadIdx.x);
        const int* rowa_c = rowa + cur * 256;
        auto rowoff = [&](int r) { return (unsigned)((x.rowbase + r) * EDIM); };
        auto rowoff_n = [&](int r) { return (unsigned)((xn.rowbase + r) * EDIM); };
        auto fin = [&](int r, int c, u32x4 dv) { *(u32x4*)(Y + (size_t)rowa_c[r] * D + nt * 256 + c) = dv; };
        gemm_core<false, false, 1, D, 4>(ra, rb, ao, pre, hid, rowoff, wd + nt * 256, nullptr, (unsigned)((EDIM * D - nt * 256) * 4), EDIM, x.rows,
                               hn, rowoff_n, wdn + nt_n * 256, nullptr, (unsigned)((EDIM * D - nt_n * 256) * 4), xn.rows, PRE_ID, fin, (unsigned char*)lds);
        pre = hn;
        cur ^= 1;
        if (threadIdx.x < 256) rowa[cur * 256 + threadIdx.x] = rnext;
    }
}

DI void phase_combine(const Params& p, int bid, int nblk, float* lds) {
    const int lane = threadIdx.x & 63, wave = threadIdx.x >> 6;
    const bf16_t* hb = (const bf16_t*)(p.ws + OFF_HB); const unsigned char* Y = p.ws + OFF_Y; const float* wbuf = (const float*)(p.ws + OFF_WBUF);
    typedef float f32x2 __attribute__((ext_vector_type(2)));
    for (int t = bid * 8 + wave; t < T; t += nblk * 8) {
        float v[16];
#pragma unroll
        for (int j = 0; j < 4; ++j) { const uint2 a = ((const uint2*)(hb + (size_t)t * D))[lane + 64 * j];
            v[4 * j] = ALPHA * __uint_as_float(a.x << 16); v[4 * j + 1] = ALPHA * __uint_as_float(a.x & 0xffff0000u);
            v[4 * j + 2] = ALPHA * __uint_as_float(a.y << 16); v[4 * j + 3] = ALPHA * __uint_as_float(a.y & 0xffff0000u); }
#pragma unroll
        for (int k = 0; k < 9; ++k) {
            const size_t row = k < 8 ? (size_t)t * TOPK + k : (size_t)A_TOT + t; const float w = (k < 8 ? wbuf[(size_t)t * TOPK + k] : 1.f) * (1.f / 128.f);
#pragma unroll
            for (int j = 0; j < 4; ++j) {
                const int y = ((const int*)(Y + row * D))[lane + 64 * j];
                const f32x2 lo = __builtin_amdgcn_cvt_pk_f32_fp8(y, false), hi = __builtin_amdgcn_cvt_pk_f32_fp8(y, true);
                v[4 * j] += w * lo[0]; v[4 * j + 1] += w * lo[1]; v[4 * j + 2] += w * hi[0]; v[4 * j + 3] += w * hi[1];
            }
        }
        ln_row(v, p.ln2_g, p.ln2_b, lane);
#pragma unroll
        for (int j = 0; j < 4; ++j) ((float4*)(p.out + (size_t)t * D))[lane + 64 * j] = make_float4(v[4 * j], v[4 * j + 1], v[4 * j + 2], v[4 * j + 3]);
    }
}

#define LAS __attribute__((address_space(3)))
#define XB_TMO      128
#define XB_XCNT(j)  (256  + 64 * (j))
#define XB_XSUB(j)  (1280 + 64 * (j))
#define XB_XGEN(j)  (2304 + 64 * (j))
#define XB_TOP      3328
#define XB_TOPGEN   3392
#define XCD_BAR_WORDS 3456
#define XB_SPIN_CAP (1u << 22)
constexpr int CW_BAR = 4096;
DI unsigned xb_ld(unsigned* p) { return __hip_atomic_load(p, __ATOMIC_RELAXED, __HIP_MEMORY_SCOPE_AGENT); }
DI unsigned xb_add(unsigned* p, unsigned v) { return __hip_atomic_fetch_add(p, v, __ATOMIC_RELAXED, __HIP_MEMORY_SCOPE_AGENT); }
DI unsigned xb_xcc_id() { return (unsigned)__builtin_amdgcn_s_getreg((3 << 11) | 20) & 0xFu; }
#define XB_SPIN(cond, bar) do { unsigned _sp = 0; while (cond) { __builtin_amdgcn_s_sleep(1); \
    if ((++_sp & 255u) == 0u) { if (xb_ld(&(bar)[XB_TMO])) break; if (_sp > XB_SPIN_CAP) { atomicAdd(&(bar)[XB_TMO], 1u); break; } } } } while (0)
struct XcdBarrier { unsigned* bar; unsigned x; volatile LAS unsigned* st; };
DI XcdBarrier xcd_barrier_post(unsigned* bar, volatile LAS unsigned* st) {
    XcdBarrier b; b.bar = bar; b.x = xb_xcc_id(); b.st = st;
    if (threadIdx.x == 0) (void)xb_add(&bar[XB_XCNT(b.x)], 1u);
    return b;
}
DI void xcd_barrier_complete(unsigned* bar, unsigned x, unsigned& nloc, unsigned& nx) {
    const unsigned G = gridDim.x * gridDim.y * gridDim.z;
    unsigned sum, cnt, mine, sp = 0u;
    for (;;) {
        sum = 0u; cnt = 0u; mine = 0u;
#pragma unroll
        for (unsigned j = 0; j < 16; ++j) { const unsigned c = xb_ld(&bar[XB_XCNT(j)]); sum += c; cnt += (c > 0u) ? 1u : 0u; mine = (j == x) ? c : mine; }
        if (sum == G) break;
        __builtin_amdgcn_s_sleep(1);
        if ((++sp & 255u) == 0u) { if (xb_ld(&bar[XB_TMO])) break; if (sp > XB_SPIN_CAP) { atomicAdd(&bar[XB_TMO], 1u); break; } }
    }
    nloc = mine > 0u ? mine : 1u; nx = cnt > 0u ? cnt : 1u;
}
DI void xcd_barrier(const XcdBarrier& b) {
    asm volatile("s_waitcnt vmcnt(0)" ::: "memory");
    __syncthreads();
    if (threadIdx.x == 0) {
        unsigned* bar = b.bar;
        __builtin_amdgcn_s_waitcnt(0);
        unsigned nloc = b.st[0], nx = b.st[1];
        if (nloc == 0u) { xcd_barrier_complete(bar, b.x, nloc, nx); b.st[0] = nloc; b.st[1] = nx; }
        const unsigned old = xb_add(&bar[XB_XSUB(b.x)], 1u);
        const unsigned gen = old / nloc;
        if (old + 1u == (gen + 1u) * nloc) {
            __builtin_amdgcn_fence(__ATOMIC_RELEASE, "agent");
            asm volatile("s_waitcnt vmcnt(0)" ::: "memory");
            const unsigned og = xb_add(&bar[XB_TOP], 1u);
            const unsigned tg = og / nx;
            if (og + 1u == (tg + 1u) * nx) xb_add(&bar[XB_TOPGEN], 1u);
            else XB_SPIN(xb_ld(&bar[XB_TOPGEN]) == tg, bar);
            __builtin_amdgcn_fence(__ATOMIC_ACQUIRE, "agent");
            xb_add(&bar[XB_XGEN(b.x)], 1u);
            asm volatile("s_waitcnt vmcnt(0)" ::: "memory");
        } else {
            XB_SPIN(xb_ld(&bar[XB_XGEN(b.x)]) == gen, bar);
            __builtin_amdgcn_fence(__ATOMIC_ACQUIRE, "agent");
            asm volatile("s_waitcnt vmcnt(0)" ::: "memory");
        }
    }
    __syncthreads();
}

constexpr int LDS_BYTES = 136 * 1024;
constexpr int LDS_BAR_OFF = LDS_BYTES - 16;
__global__ void __launch_bounds__(NT) fwd_megakernel(Params p) {
    extern __shared__ __attribute__((aligned(16))) float lds[];
    const int bid = blockIdx.x, nblk = gridDim.x;
    volatile LAS unsigned* st = (volatile LAS unsigned*)((LAS unsigned char*)lds + LDS_BAR_OFF);
    if (threadIdx.x < 4) st[threadIdx.x] = 0u;
    __syncthreads();
    XcdBarrier bar = xcd_barrier_post((unsigned*)(p.ws + OFF_CTL) + CW_BAR, st);
    phase_prep(p, bid, nblk, lds);      xcd_barrier(bar);
    phase_proj(p, bid, nblk, lds);      xcd_barrier(bar);
    phase_poolmean(p, bid, nblk, lds);
    phase_gla1(p, bid, nblk, lds);      xcd_barrier(bar);
    phase_pool(p, bid, nblk, lds);
    phase_gla2(p, bid, nblk, lds);      xcd_barrier(bar);
    phase_gla3(p, bid, nblk, lds);      xcd_barrier(bar);
    phase_out(p, bid, nblk, lds);       xcd_barrier(bar);
    phase_route(p, bid, nblk, lds);     xcd_barrier(bar);
    phase_e1(p, bid, nblk, lds);        xcd_barrier(bar);
    phase_e2(p, bid, nblk, lds);        xcd_barrier(bar);
    phase_combine(p, bid, nblk, lds);
}

extern "C" void kernel_launch(void* const* d_in, const int* in_sizes, int n_in, void* d_out, int out_size, void* d_ws, size_t ws_size, hipStream_t stream) {
    static int grid = 0;
    if (grid == 0) {
        if (n_in != 20 || ws_size < WS_NEED) { fprintf(stderr, "kernel_launch: unexpected n_in %d or ws_size %zu (< %zu)\n", n_in, ws_size, (size_t)WS_NEED); grid = -1; return; }
        int dev = 0, cus = 0, per_cu = 0;
        (void)hipGetDevice(&dev); (void)hipDeviceGetAttribute(&cus, hipDeviceAttributeMultiprocessorCount, dev);
        (void)hipFuncSetAttribute((const void*)fwd_megakernel, hipFuncAttributeMaxDynamicSharedMemorySize, LDS_BYTES);
        (void)hipOccupancyMaxActiveBlocksPerMultiprocessor(&per_cu, (const void*)fwd_megakernel, NT, LDS_BYTES);
        if (per_cu < 1 || cus < 1) { fprintf(stderr, "kernel_launch: occupancy query says %d blocks/CU on %d CUs\n", per_cu, cus); grid = -1; return; }
        grid = cus;
    }
    if (grid < 0) return;
    (void)hipMemsetAsync((char*)d_ws + OFF_CTL, 0, 64 * 1024, stream);
    Params p{};
    const float** pp = (const float**)&p;
    for (int i = 0; i < 20; ++i) pp[i] = (const float*)d_in[i];
    p.out = (float*)d_out; p.ws = (unsigned char*)d_ws;
    void* args[] = {&p};
    hipError_t e = hipLaunchCooperativeKernel((const void*)fwd_megakernel, dim3(grid), dim3(NT), args, LDS_BYTES, stream);
    if (e != hipSuccess) fprintf(stderr, "cooperative launch failed: %s (grid %d)\n", hipGetErrorString(e), grid);
}
```
